# Optimizing an MI355X kernel written in HIP

```python
import math
import jax, jax.numpy as jnp
from jax import lax
import numpy as np

D_MODEL = 1024
BATCH = 4
SEQ = 8192
DEPTH = 2
DEC_BATCH = 8
DEC_SEQ = 16
PAST_LEN = 4096

CHUNK = 64
QBLOCK = 128
HA = 8
DHA = 64
DVA = 2 * DHA
HM = 4
DKM = 256
DVM = 256
CONV_M = 4
D_FF = 2816
CONV_F = 3
ROPE_THETA = 10000.0
LN_EPS = 1e-5
ALPHA = (2 * DEPTH) ** 0.25
BETA = (8 * DEPTH) ** -0.25

MIX_A = HA * DVA
MIX_B = HM * DVM
W_QA = HA * 2 * DHA
W_KA = HA * 2 * DHA
W_VA = HA * DVA
W_QKM = 2 * HM * DKM
W_VM = HM * DVM
W_OM = HM * DVM
W_GIF = 2 * HM
W_GA = MIX_A
W_GB = MIX_B
IN_SIZES = (W_QA, W_KA, W_VA, W_QKM, W_VM, W_OM, W_GIF, W_GA, W_GB)
D_IN = W_QA + W_KA + W_VA + W_QKM + W_VM + W_OM + W_GIF + W_GA + W_GB

kernel_name = 'hybrid_diffattn_mlstm_convffn_stream_step'


def _split_in(z):
    out = []
    o = 0
    for s in IN_SIZES:
        out.append(z[..., o:o + s])
        o += s
    return out


def _layernorm(x, g, b):
    xf = x.astype(jnp.float32)
    mu = jnp.mean(xf, axis=-1, keepdims=True)
    var = jnp.mean(jnp.square(xf - mu), axis=-1, keepdims=True)
    return ((xf - mu) * lax.rsqrt(var + LN_EPS) * g + b).astype(x.dtype)


def _rms(x):
    xf = x.astype(jnp.float32)
    return xf * lax.rsqrt(jnp.mean(jnp.square(xf), axis=-1, keepdims=True) + LN_EPS)


def _head_ln(h):
    mu = jnp.mean(h, axis=-1, keepdims=True)
    var = jnp.mean(jnp.square(h - mu), axis=-1, keepdims=True)
    return (h - mu) * lax.rsqrt(var + LN_EPS)


def _rope(x, pos):
    half = DHA // 2
    inv = ROPE_THETA ** (-jnp.arange(half, dtype=jnp.float32) * 2.0 / DHA)
    ang = pos.astype(jnp.float32)[:, None] * inv[None, :]
    cos = jnp.cos(ang)[None, :, None, None, :]
    sin = jnp.sin(ang)[None, :, None, None, :]
    xf = x.astype(jnp.float32)
    x1, x2 = xf[..., :half], xf[..., half:]
    return jnp.concatenate([x1 * cos - x2 * sin, x2 * cos + x1 * sin], axis=-1).astype(x.dtype)


def _causal_dwconv(x, buf, w, b):
    width = w.shape[0]
    L = x.shape[1]
    xp = jnp.concatenate([buf.astype(x.dtype), x], axis=1)
    y = b
    for j in range(width):
        y = y + w[j] * xp[:, j:j + L]
    return y.astype(x.dtype), xp[:, xp.shape[1] - (width - 1):]


def _diff_attn_block(q, k, v, lam, mask):
    s = jnp.einsum('bqhcd,bkhcd->bhcqk', q, k).astype(jnp.float32) * (DHA ** -0.5)
    if mask is not None:
        s = jnp.where(mask, s, -jnp.inf)
    pr = jax.nn.softmax(s, axis=-1)
    a = pr[:, :, 0] - lam * pr[:, :, 1]
    return jnp.einsum('bhqk,bkhv->bqhv', a.astype(v.dtype), v)


def _diff_attn_prompt(q, k, v, lam):
    B, S = q.shape[0], q.shape[1]
    nb = S // QBLOCK
    qb = q.reshape(B, nb, QBLOCK, HA, 2, DHA).swapaxes(0, 1)
    key_pos = jnp.arange(S)

    def block(args):
        qi, bi = args
        qpos = bi * QBLOCK + jnp.arange(QBLOCK)
        vis_end = (qpos // CHUNK + 1) * CHUNK
        mask = key_pos[None, :] < vis_end[:, None]
        return _diff_attn_block(qi, k, v, lam, mask)

    o = lax.map(block, (qb, jnp.arange(nb)))
    return o.swapaxes(0, 1).reshape(B, S, HA, DVA)


def _mlstm_chunk(carry, inp):
    C, n, m = carry
    q, k, v, ig, lf = inp
    L = q.shape[1]
    bcum = jnp.cumsum(lf, axis=1)
    causal = jnp.tril(jnp.ones((L, L), dtype=bool))[None, :, :, None]
    d = bcum[:, :, None, :] - bcum[:, None, :, :] + ig[:, None, :, :]
    d = jnp.where(causal, d, -jnp.inf)
    inter = bcum + m[:, None, :]
    m_t = jnp.maximum(inter, jnp.max(d, axis=2))
    w = jnp.exp(d - m_t[:, :, None, :])
    g = jnp.exp(inter - m_t)
    s = jnp.einsum('bthd,bshd->btsh', q, k) * w
    num = jnp.einsum('btsh,bshv->bthv', s, v) + g[..., None] * jnp.einsum('bthd,bhdv->bthv', q, C)
    den = jnp.sum(s, axis=2) + g * jnp.einsum('bthd,bhd->bth', q, n)
    den = jnp.maximum(jnp.abs(den), jnp.exp(-m_t))
    h = num / den[..., None]
    m_end = m_t[:, -1]
    w_end = jnp.exp(bcum[:, -1:] - bcum + ig - m_end[:, None, :])
    g_end = jnp.exp(bcum[:, -1] + m - m_end)
    kw = k * w_end[..., None]
    C_new = g_end[..., None, None] * C + jnp.einsum('bshd,bshv->bhdv', kw, v)
    n_new = g_end[..., None] * n + jnp.sum(kw, axis=1)
    return (C_new, n_new, m_end), h


def _mlstm_prompt(q, k, v, ig, lf):
    B, S = q.shape[0], q.shape[1]
    nc = S // CHUNK

    def to_chunks(a):
        return a.reshape((B, nc, CHUNK) + a.shape[2:]).swapaxes(0, 1)

    init = (jnp.zeros((B, HM, DKM, DVM), jnp.float32),
            jnp.zeros((B, HM, DKM), jnp.float32),
            jnp.zeros((B, HM), jnp.float32))
    state, h = lax.scan(_mlstm_chunk, init, tuple(map(to_chunks, (q, k, v, ig, lf))))
    return h.swapaxes(0, 1).reshape(B, S, HM, DVM), state


def _layer(x, pos, kv_cache, conv_m_buf, m_state, ffn_buf, p, lam_init):
    f32 = jnp.float32
    B, L = x.shape[0], x.shape[1]
    qa, ka, va, qkm, vm, om, gif, ga, gb = _split_in(x @ p['w_in'])
    qa = _rope(qa.reshape(B, L, HA, 2, DHA), pos)
    ka = _rope(ka.reshape(B, L, HA, 2, DHA), pos)
    va = va.reshape(B, L, HA, DVA)
    lp = p['lam'].astype(f32)
    lam = jnp.exp(jnp.sum(lp[0] * lp[1])) - jnp.exp(jnp.sum(lp[2] * lp[3])) + lam_init
    if kv_cache is None:
        oa = _diff_attn_prompt(qa, ka, va, lam)
    else:
        ck, cv = kv_cache
        k_all = jnp.concatenate([ck.reshape(B, ck.shape[1], HA, 2, DHA).astype(ka.dtype), ka], axis=1)
        v_all = jnp.concatenate([cv.astype(va.dtype), va], axis=1)
        oa = _diff_attn_block(qa, k_all, v_all, lam, None)
    oa = (_rms(oa) * p['subln_g'] * (1.0 - lam_init)).astype(x.dtype).reshape(B, L, MIX_A)
    qk, new_conv_m = _causal_dwconv(qkm, conv_m_buf, p['conv_m_w'], p['conv_m_b'])
    qk = jax.nn.silu(qk).astype(f32)
    qm = qk[..., :HM * DKM].reshape(B, L, HM, DKM)
    km = qk[..., HM * DKM:].reshape(B, L, HM, DKM) * (DKM ** -0.5)
    vmh = vm.astype(f32).reshape(B, L, HM, DVM)
    gif = gif.astype(f32) + p['b_if'].astype(f32)
    ig = gif[..., :HM]
    lf = jax.nn.log_sigmoid(gif[..., HM:])
    if m_state is None:
        hm, (C, n, m) = _mlstm_prompt(qm, km, vmh, ig, lf)
    else:
        init = (m_state[0].astype(f32), m_state[1].astype(f32), m_state[2].astype(f32))
        (C, n, m), hm = _mlstm_chunk(init, (qm, km, vmh, ig, lf))
    hm = (_head_ln(hm).reshape(B, L, MIX_B) * p['mh_g']).astype(x.dtype) * jax.nn.sigmoid(om)
    y = jax.nn.sigmoid(ga) * oa + jax.nn.sigmoid(gb) * hm
    x = _layernorm(ALPHA * x + y @ p['w_out'], p['ln1_g'], p['ln1_b'])
    u, new_ffn = _causal_dwconv(x @ p['w_up'], ffn_buf, p['ffn_conv_w'], p['ffn_conv_b'])
    h = jax.nn.gelu(u[..., :D_FF], approximate=False) * u[..., D_FF:]
    x = _layernorm(ALPHA * x + h @ p['w_down'], p['ln2_g'], p['ln2_b'])
    new_k = ka.reshape(B, L, HA, 2 * DHA)
    return x, (new_k, va, new_conv_m, C, n, m, new_ffn)


def setup_inputs(seed: int = 0) -> dict:
    key = jax.random.key(seed)
    ks = jax.random.split(key, 26)
    f32 = jnp.float32

    def nrm(k, shape, scale=1.0):
        return scale * jax.random.normal(k, shape, f32)

    b_if = jnp.concatenate([nrm(ks[10], (DEPTH, HM), 0.1),
                            jnp.linspace(3.0, 6.0, HM, dtype=f32)[None, :] + nrm(ks[11], (DEPTH, HM), 0.01)], axis=-1)
    return {
        'x_prompt': nrm(ks[0], (BATCH, SEQ, D_MODEL)),
        'x_sample': nrm(ks[1], (DEC_BATCH, DEC_SEQ, D_MODEL)),
        'cache_k': nrm(ks[2], (DEPTH, DEC_BATCH, PAST_LEN, HA, 2 * DHA)),
        'cache_v': nrm(ks[3], (DEPTH, DEC_BATCH, PAST_LEN, HA, DVA)),
        'state_mlstm_conv': nrm(ks[4], (DEPTH, DEC_BATCH, CONV_M - 1, W_QKM)),
        'state_mlstm_C': nrm(ks[5], (DEPTH, DEC_BATCH, HM, DKM, DVM), 0.05),
        'state_mlstm_n': nrm(ks[6], (DEPTH, DEC_BATCH, HM, DKM), 0.05),
        'state_mlstm_m': nrm(ks[7], (DEPTH, DEC_BATCH, HM)),
        'state_ffn_conv': nrm(ks[8], (DEPTH, DEC_BATCH, CONV_F - 1, 2 * D_FF)),
        'w_in': nrm(ks[9], (DEPTH, D_MODEL, D_IN), D_MODEL ** -0.5),
        'b_if': b_if,
        'mlstm_conv_w': nrm(ks[12], (DEPTH, CONV_M, W_QKM), CONV_M ** -0.5),
        'mlstm_conv_b': nrm(ks[13], (DEPTH, W_QKM), 0.01),
        'diff_lambda': nrm(ks[14], (DEPTH, 4, DHA), 0.1),
        'diff_subln_g': 1.0 + nrm(ks[15], (DEPTH, DVA), 0.01),
        'mlstm_norm_g': 1.0 + nrm(ks[16], (DEPTH, MIX_B), 0.01),
        'w_out': nrm(ks[17], (DEPTH, MIX_A, D_MODEL), BETA * MIX_A ** -0.5),
        'ln1_g': 1.0 + nrm(ks[18], (DEPTH, D_MODEL), 0.01),
        'ln1_b': nrm(ks[19], (DEPTH, D_MODEL), 0.01),
        'w_up': nrm(ks[20], (DEPTH, D_MODEL, 2 * D_FF), D_MODEL ** -0.5),
        'ffn_conv_w': nrm(ks[21], (DEPTH, CONV_F, 2 * D_FF), CONV_F ** -0.5),
        'ffn_conv_b': nrm(ks[22], (DEPTH, 2 * D_FF), 0.01),
        'w_down': nrm(ks[23], (DEPTH, D_FF, D_MODEL), BETA * D_FF ** -0.5),
        'ln2_g': 1.0 + nrm(ks[24], (DEPTH, D_MODEL), 0.01),
        'ln2_b': nrm(ks[25], (DEPTH, D_MODEL), 0.01),
    }


def _stk(lst, i):
    return jnp.stack([s[i] for s in lst])


def reference(x_prompt, x_sample, cache_k, cache_v, state_mlstm_conv, state_mlstm_C, state_mlstm_n,
              state_mlstm_m, state_ffn_conv, w_in, b_if, mlstm_conv_w, mlstm_conv_b, diff_lambda,
              diff_subln_g, mlstm_norm_g, w_out, ln1_g, ln1_b, w_up, ffn_conv_w, ffn_conv_b, w_down,
              ln2_g, ln2_b):
    xp, xs = x_prompt, x_sample
    bp = xp.shape[0]
    pos_p = jnp.arange(xp.shape[1])
    pos_s = PAST_LEN + jnp.arange(xs.shape[1])
    sp, ss = [], []
    for l in range(DEPTH):
        p = {'w_in': w_in[l], 'b_if': b_if[l], 'conv_m_w': mlstm_conv_w[l], 'conv_m_b': mlstm_conv_b[l],
             'lam': diff_lambda[l], 'subln_g': diff_subln_g[l], 'mh_g': mlstm_norm_g[l], 'w_out': w_out[l],
             'ln1_g': ln1_g[l], 'ln1_b': ln1_b[l], 'w_up': w_up[l], 'ffn_conv_w': ffn_conv_w[l],
             'ffn_conv_b': ffn_conv_b[l], 'w_down': w_down[l], 'ln2_g': ln2_g[l], 'ln2_b': ln2_b[l]}
        lam_init = 0.8 - 0.6 * math.exp(-0.3 * l)
        conv_m0 = jnp.zeros((bp, CONV_M - 1, W_QKM), xp.dtype)
        ffn0 = jnp.zeros((bp, CONV_F - 1, 2 * D_FF), xp.dtype)
        xp, st_p = _layer(xp, pos_p, None, conv_m0, None, ffn0, p, lam_init)
        xs, st_s = _layer(xs, pos_s, (cache_k[l], cache_v[l]), state_mlstm_conv[l],
                          (state_mlstm_C[l], state_mlstm_n[l], state_mlstm_m[l]), state_ffn_conv[l], p, lam_init)
        sp.append(st_p)
        ss.append(st_s)
    return (xp, xs,
            _stk(sp, 0), _stk(sp, 1), _stk(sp, 2), _stk(sp, 3), _stk(sp, 4), _stk(sp, 5), _stk(sp, 6),
            _stk(ss, 0), _stk(ss, 1), _stk(ss, 2), _stk(ss, 3), _stk(ss, 4), _stk(ss, 5), _stk(ss, 6))
```

```cpp
#include <hip/hip_runtime.h>
#include <hip/hip_cooperative_groups.h>
#include <cstdio>
namespace cg = cooperative_groups;

#ifndef MULTI_LAUNCH
#define MULTI_LAUNCH 0
#endif

typedef unsigned short bf16_t;
typedef short bf16x8 __attribute__((ext_vector_type(8)));
typedef short s16x4 __attribute__((ext_vector_type(4)));
typedef float f32x16 __attribute__((ext_vector_type(16)));
typedef float f32x4 __attribute__((ext_vector_type(4)));
typedef unsigned u32x4 __attribute__((ext_vector_type(4)));
typedef unsigned u32x2 __attribute__((ext_vector_type(2)));
#define DI __device__ __forceinline__
#define MFMA32(a, b, c) __builtin_amdgcn_mfma_f32_32x32x16_bf16((a), (b), (c), 0, 0, 0)

constexpr int NTH = 512;
constexpr int D = 1024, SEQ = 8192, NB = 4, MP = NB * SEQ, MS = 128, M = MP + MS, NTM = 129;
constexpr int DIN = 9224, NIN = 9216, DFF = 2816, NUP = 5632;
constexpr int PAST = 4096, NKS = PAST + 16;
constexpr float ALPHA = 1.4142135623730951f;
constexpr float LN_EPS = 1e-5f;
constexpr float LOG2E = 1.4426950408889634f;

constexpr size_t O_YP = 0;
constexpr size_t O_YS = O_YP + (size_t)MP * D;
constexpr size_t O_KP = O_YS + (size_t)MS * D;
constexpr size_t O_VP = O_KP + (size_t)2 * MP * 1024;
constexpr size_t O_MCP = O_VP + (size_t)2 * MP * 1024;
constexpr size_t O_CP = O_MCP + (size_t)2 * 4 * 3 * 2048;
constexpr size_t O_NP = O_CP + (size_t)2 * 4 * 4 * 65536;
constexpr size_t O_MPP = O_NP + (size_t)2 * 4 * 4 * 256;
constexpr size_t O_FCP = O_MPP + 32;
constexpr size_t O_KS = O_FCP + (size_t)2 * 4 * 2 * NUP;
constexpr size_t O_VS = O_KS + (size_t)2 * MS * 1024;
constexpr size_t O_MCS = O_VS + (size_t)2 * MS * 1024;
constexpr size_t O_CS = O_MCS + (size_t)2 * 8 * 3 * 2048;
constexpr size_t O_NS = O_CS + (size_t)2 * 8 * 4 * 65536;
constexpr size_t O_MSS = O_NS + (size_t)2 * 8 * 4 * 256;
constexpr size_t O_FCS = O_MSS + 64;
constexpr size_t O_END = O_FCS + (size_t)2 * 8 * 2 * NUP;

constexpr size_t W_Z = 0;
constexpr size_t W_H = W_Z + (size_t)M * NIN * 2;
constexpr size_t W_AB = W_H + (size_t)M * D * 2;
constexpr size_t W_KA = W_AB + (size_t)M * D * 2;
constexpr size_t W_R = W_KA + (size_t)M * D * 2;
constexpr size_t W_WIN = W_R + (size_t)M * D * 4;
constexpr size_t W_WOUT = W_WIN + (size_t)2 * NIN * D * 2;
constexpr size_t W_WUP = W_WOUT + (size_t)2 * D * D * 2;
constexpr size_t W_WDN = W_WUP + (size_t)2 * NUP * D * 2;
constexpr size_t W_GIF = W_WDN + (size_t)2 * D * DFF * 2;
constexpr size_t W_ROPE = W_GIF + (size_t)M * 8 * 4;
constexpr size_t W_MISC = W_ROPE + (size_t)8192 * 32 * 8;
constexpr size_t W_END = W_MISC + 4096;

struct Params {
  const float* in[25];
  float* out;
  unsigned char* ws;
};

DI unsigned f2bf(float x) { unsigned u = __float_as_uint(x); u += 0x7fffu + ((u >> 16) & 1u); return u >> 16; }
DI unsigned pk2(float a, float b) { return f2bf(a) | (f2bf(b) << 16); }
DI float bflo(unsigned u) { return __uint_as_float(u << 16); }
DI float bfhi(unsigned u) { return __uint_as_float(u & 0xffff0000u); }
DI float sigmoidf_(float x) { return 1.f / (1.f + __expf(-x)); }
DI float wave_sum(float v) {
#pragma unroll
  for (int o = 1; o < 64; o <<= 1) v += __shfl_xor(v, o);
  return v;
}
DI int crow(int i, int h) { return (i & 3) + 8 * (i >> 2) + 4 * h; }
DI bf16x8 pack8(const f32x16& x, int s) {
  u32x4 p;
  p[0] = pk2(x[8 * s + 0], x[8 * s + 1]); p[1] = pk2(x[8 * s + 2], x[8 * s + 3]);
  p[2] = pk2(x[8 * s + 4], x[8 * s + 5]); p[3] = pk2(x[8 * s + 6], x[8 * s + 7]);
  return __builtin_bit_cast(bf16x8, p);
}
DI void unpack8(u32x4 v, float* f) {
  f[0] = bflo(v[0]); f[1] = bfhi(v[0]); f[2] = bflo(v[1]); f[3] = bfhi(v[1]);
  f[4] = bflo(v[2]); f[5] = bfhi(v[2]); f[6] = bflo(v[3]); f[7] = bfhi(v[3]);
}
DI bf16x8 tr_frag(unsigned a_lo, unsigned a_hi) {
  s16x4 lo, hi;
  asm volatile("ds_read_b64_tr_b16 %0, %2\n\tds_read_b64_tr_b16 %1, %3\n\ts_waitcnt lgkmcnt(0)"
               : "=&v"(lo), "=&v"(hi) : "v"(a_lo), "v"(a_hi) : "memory");
  return __builtin_shufflevector(lo, hi, 0, 1, 2, 3, 4, 5, 6, 7);
}
template <int STEP, int HIOFF>
DI void tr_frag4(unsigned a, bf16x8 (&f)[4]) {
  s16x4 l0, h0, l1, h1, l2, h2, l3, h3;
  asm volatile(
      "ds_read_b64_tr_b16 %0, %8 offset:%9\n\tds_read_b64_tr_b16 %1, %8 offset:%10\n\t"
      "ds_read_b64_tr_b16 %2, %8 offset:%11\n\tds_read_b64_tr_b16 %3, %8 offset:%12\n\t"
      "ds_read_b64_tr_b16 %4, %8 offset:%13\n\tds_read_b64_tr_b16 %5, %8 offset:%14\n\t"
      "ds_read_b64_tr_b16 %6, %8 offset:%15\n\tds_read_b64_tr_b16 %7, %8 offset:%16\n\t"
      "s_waitcnt lgkmcnt(0)"
      : "=&v"(l0), "=&v"(h0), "=&v"(l1), "=&v"(h1), "=&v"(l2), "=&v"(h2), "=&v"(l3), "=&v"(h3)
      : "v"(a), "i"(0), "i"(HIOFF), "i"(STEP), "i"(STEP + HIOFF), "i"(2 * STEP), "i"(2 * STEP + HIOFF), "i"(3 * STEP), "i"(3 * STEP + HIOFF)
      : "memory");
  f[0] = __builtin_shufflevector(l0, h0, 0, 1, 2, 3, 4, 5, 6, 7);
  f[1] = __builtin_shufflevector(l1, h1, 0, 1, 2, 3, 4, 5, 6, 7);
  f[2] = __builtin_shufflevector(l2, h2, 0, 1, 2, 3, 4, 5, 6, 7);
  f[3] = __builtin_shufflevector(l3, h3, 0, 1, 2, 3, 4, 5, 6, 7);
}
DI int otid() { int t = threadIdx.x; asm volatile("" : "+v"(t)); return t; }
DI int uni(int v) { return __builtin_amdgcn_readfirstlane(v); }
DI unsigned lds_addr(const void* p) { return (unsigned)(size_t)p; }

DI const float* xrow_ptr(const Params& p, int l, int row) {
  if (l == 0) return row < MP ? p.in[0] + (size_t)row * D : p.in[1] + (size_t)(row - MP) * D;
  return (const float*)(p.ws + W_R) + (size_t)row * D;
}

DI void transpose_w(const float* W, int K, int N, int src_ld, bf16_t* WT, bool remap, char* lds) {
  float* scr = (float*)lds;
  const int nkb = K / 64, nnb = N / 64, tid = otid();
  for (int it = blockIdx.x; it < nkb * nnb; it += gridDim.x) {
    const int kb = it / nnb, nb = it % nnb, k0 = kb * 64, n0 = nb * 64;
    const int ns = (remap && n0 >= 7168) ? n0 + 8 : n0;
#pragma unroll
    for (int i = 0; i < 8; ++i) {
      const int kk = (tid >> 6) + 8 * i, nn = tid & 63;
      scr[kk * 65 + nn] = W[(size_t)(k0 + kk) * src_ld + ns + nn];
    }
    __syncthreads();
    {
      const int n = tid >> 3, c = tid & 7;
      const float* s = scr + (8 * c) * 65 + n;
      u32x4 o;
      o[0] = pk2(s[0], s[65]); o[1] = pk2(s[2 * 65], s[3 * 65]); o[2] = pk2(s[4 * 65], s[5 * 65]); o[3] = pk2(s[6 * 65], s[7 * 65]);
      *(u32x4*)(WT + (size_t)(n0 + n) * K + k0 + 8 * c) = o;
    }
    __syncthreads();
  }
}

DI void phase0(const Params& p, char* lds) {
  const int tid = otid();
  for (int l = 0; l < 2; ++l) {
    transpose_w(p.in[9] + (size_t)l * D * DIN, D, NIN, DIN, (bf16_t*)(p.ws + W_WIN) + (size_t)l * NIN * D, true, lds);
    transpose_w(p.in[16] + (size_t)l * D * D, D, D, D, (bf16_t*)(p.ws + W_WOUT) + (size_t)l * D * D, false, lds);
    transpose_w(p.in[19] + (size_t)l * D * NUP, D, NUP, NUP, (bf16_t*)(p.ws + W_WUP) + (size_t)l * NUP * D, false, lds);
    transpose_w(p.in[22] + (size_t)l * DFF * D, DFF, D, D, (bf16_t*)(p.ws + W_WDN) + (size_t)l * D * DFF, false, lds);
  }
  bf16_t* ab = (bf16_t*)(p.ws + W_AB);
  for (size_t c = (size_t)blockIdx.x * NTH + tid; c < (size_t)M * 128; c += (size_t)gridDim.x * NTH) {
    const int row = (int)(c >> 7), cc = (int)(c & 127);
    const float* src = xrow_ptr(p, 0, row) + cc * 8;
    f32x4 a = *(const f32x4*)src, b = *(const f32x4*)(src + 4);
    u32x4 o; o[0] = pk2(a[0], a[1]); o[1] = pk2(a[2], a[3]); o[2] = pk2(b[0], b[1]); o[3] = pk2(b[2], b[3]);
    *(u32x4*)(ab + (size_t)row * D + cc * 8) = o;
  }
  float2* rope = (float2*)(p.ws + W_ROPE);
  for (int i = blockIdx.x * NTH + tid; i < 8192 * 32; i += gridDim.x * NTH) {
    const int pos = i >> 5, d = i & 31;
    const double inv = exp2(-(double)d * (13.287712379549449 / 32.0));
    double ang = (double)pos * inv;
    const double twopi = 6.283185307179586476925;
    ang -= twopi * rint(ang / twopi);
    float s, c; sincosf((float)ang, &s, &c);
    rope[i] = make_float2(c, s);
  }
  if (blockIdx.x == 0 && tid < 128) {
    const int l = tid >> 6, ln = tid & 63;
    const float* lp = p.in[13] + (size_t)l * 4 * 64;
    const float s1 = wave_sum(lp[ln] * lp[64 + ln]), s2 = wave_sum(lp[128 + ln] * lp[192 + ln]);
    const float lam_init = (l == 0) ? 0.2f : (0.8f - 0.6f * 0.74081822068171788f);
    if (ln == 0) ((float*)(p.ws + W_MISC))[l] = __expf(s1) - __expf(s2) + lam_init;
  }
  if (blockIdx.x == 0 && tid < 8) ((unsigned*)(p.ws + W_MISC))[16 + tid] = 0u;
}

constexpr int G_LDT = 144;
constexpr int G_TILE = 256 * G_LDT;
enum { EPI_IN = 0, EPI_OUT = 1, EPI_UP = 2, EPI_DOWN = 3 };

template <int MODE>
DI void gemm_epilogue(const Params& p, int l, const f32x16 (&acc)[4][2], int tm, int tn, int wr, int wc, int lane) {
  const int r = lane & 31, h = lane >> 5;
  const int col0 = tn * 256 + wc * 64;
  const int rowb = tm * 256 + wr * 128;
  if (MODE == EPI_IN) {
    bf16_t* Z = (bf16_t*)(p.ws + W_Z);
    const int seg = col0 >> 10;
    if (seg <= 1) {
      const float2* rope = (const float2*)(p.ws + W_ROPE);
      const float qs = (seg == 0) ? 0.125f : 1.f;
#pragma unroll
      for (int mt = 0; mt < 4; ++mt)
#pragma unroll
        for (int i = 0; i < 16; ++i) {
          const int row = rowb + mt * 32 + crow(i, h);
          if (row < M) {
            const int pos = row < MP ? (row & (SEQ - 1)) : PAST + ((row - MP) & 15);
            const float2 cs = rope[pos * 32 + r];
            const float x1 = acc[mt][0][i], x2 = acc[mt][1][i];
            const float o1 = x1 * cs.x - x2 * cs.y, o2 = x2 * cs.x + x1 * cs.y;
            Z[(size_t)row * NIN + col0 + r] = (bf16_t)f2bf(o1 * qs);
            Z[(size_t)row * NIN + col0 + 32 + r] = (bf16_t)f2bf(o2 * qs);
            if (seg == 1) {
              float* o = row < MP ? p.out + O_KP + ((size_t)l * MP + row) * 1024 : p.out + O_KS + ((size_t)l * MS + row - MP) * 1024;
              o[col0 - 1024 + r] = o1; o[col0 - 1024 + 32 + r] = o2;
            }
          }
        }
    } else {
#pragma unroll
      for (int mt = 0; mt < 4; ++mt)
#pragma unroll
        for (int nt = 0; nt < 2; ++nt)
#pragma unroll
          for (int i = 0; i < 16; ++i) {
            const int row = rowb + mt * 32 + crow(i, h);
            const int col = col0 + nt * 32 + r;
            if (row < M) {
              const float v = acc[mt][nt][i];
              Z[(size_t)row * NIN + col] = (bf16_t)f2bf(v);
              if (seg == 2) {
                float* o = row < MP ? p.out + O_VP + ((size_t)l * MP + row) * 1024 : p.out + O_VS + ((size_t)l * MS + row - MP) * 1024;
                o[col - 2048] = v;
              } else if (seg == 3 || seg == 4) {
                if (row < MP) { const int s = row & (SEQ - 1); if (s >= SEQ - 3) p.out[O_MCP + ((size_t)(l * 4 + (row >> 13)) * 3 + (s - (SEQ - 3))) * 2048 + col - 3072] = v; }
                else { const int t = (row - MP) & 15, b = (row - MP) >> 4; if (t >= 13) p.out[O_MCS + ((size_t)(l * 8 + b) * 3 + (t - 13)) * 2048 + col - 3072] = v; }
              }
            }
          }
    }
  } else if (MODE == EPI_OUT || MODE == EPI_DOWN) {
    float* R = (float*)(p.ws + W_R);
#pragma unroll
    for (int mt = 0; mt < 4; ++mt)
#pragma unroll
      for (int nt = 0; nt < 2; ++nt)
#pragma unroll
        for (int i = 0; i < 16; ++i) {
          const int row = rowb + mt * 32 + crow(i, h);
          const int col = col0 + nt * 32 + r;
          if (row < M) {
            float res;
            if (MODE == EPI_OUT) res = xrow_ptr(p, l, row)[col]; else res = R[(size_t)row * D + col];
            R[(size_t)row * D + col] = ALPHA * res + acc[mt][nt][i];
          }
        }
  } else {
    bf16_t* U = (bf16_t*)(p.ws + W_Z);
#pragma unroll
    for (int mt = 0; mt < 4; ++mt)
#pragma unroll
      for (int nt = 0; nt < 2; ++nt)
#pragma unroll
        for (int i = 0; i < 16; ++i) {
          const int row = rowb + mt * 32 + crow(i, h);
          const int col = col0 + nt * 32 + r;
          if (row < M) {
            const float v = acc[mt][nt][i];
            U[(size_t)row * NUP + col] = (bf16_t)f2bf(v);
            if (row < MP) { const int s = row & (SEQ - 1); if (s >= SEQ - 2) p.out[O_FCP + ((size_t)(l * 4 + (row >> 13)) * 2 + (s - (SEQ - 2))) * NUP + col] = v; }
            else { const int t = (row - MP) & 15, b = (row - MP) >> 4; if (t >= 14) p.out[O_FCS + ((size_t)(l * 8 + b) * 2 + (t - 14)) * NUP + col] = v; }
          }
        }
  }
}

template <int MODE>
DI void gemm_phase(const Params& p, int l, const bf16_t* A, int lda, const bf16_t* Bt, int K, int ntn, char* lds) {
  const int ntiles = NTM * ntn, KT = K / 64;
  for (int t = blockIdx.x; t < ntiles; t += gridDim.x) {
    const int tid = otid(), lane = tid & 63, wave = uni(tid >> 6);
    const int wr = wave >> 2, wc = wave & 3, r = lane & 31, h = lane >> 5;
    const int lrow = tid >> 3, kc = tid & 7;
    const unsigned wofs = lrow * G_LDT + kc * 16;
    const int tm = t / ntn, tn = t % ntn;
    f32x16 acc[4][2];
#pragma unroll
    for (int a = 0; a < 4; ++a)
#pragma unroll
      for (int b = 0; b < 2; ++b)
#pragma unroll
        for (int i = 0; i < 16; ++i) acc[a][b][i] = 0.f;
    const bf16_t* ap0; const bf16_t* ap1; const bf16_t* ap2; const bf16_t* ap3;
    { int g;
      g = tm * 256 + lrow;       ap0 = A + (size_t)(g < M ? g : M - 1) * lda + kc * 8;
      g = tm * 256 + lrow + 64;  ap1 = A + (size_t)(g < M ? g : M - 1) * lda + kc * 8;
      g = tm * 256 + lrow + 128; ap2 = A + (size_t)(g < M ? g : M - 1) * lda + kc * 8;
      g = tm * 256 + lrow + 192; ap3 = A + (size_t)(g < M ? g : M - 1) * lda + kc * 8; }
    const bf16_t* bp = Bt + (size_t)(tn * 256 + lrow) * K + kc * 8;
    const size_t bstep = (size_t)64 * K;
    u32x4 ra0, ra1, ra2, ra3, rb0, rb1, rb2, rb3;
    ra0 = *(const u32x4*)ap0; ra1 = *(const u32x4*)ap1; ra2 = *(const u32x4*)ap2; ra3 = *(const u32x4*)ap3;
    rb0 = *(const u32x4*)bp; rb1 = *(const u32x4*)(bp + bstep); rb2 = *(const u32x4*)(bp + 2 * bstep); rb3 = *(const u32x4*)(bp + 3 * bstep);
    {
      char* a = lds + wofs; char* b = lds + G_TILE + wofs;
      *(u32x4*)a = ra0; *(u32x4*)(a + 64 * G_LDT) = ra1; *(u32x4*)(a + 128 * G_LDT) = ra2; *(u32x4*)(a + 192 * G_LDT) = ra3;
      *(u32x4*)b = rb0; *(u32x4*)(b + 64 * G_LDT) = rb1; *(u32x4*)(b + 128 * G_LDT) = rb2; *(u32x4*)(b + 192 * G_LDT) = rb3;
    }
    __syncthreads();
    for (int kt = 0; kt < KT; ++kt) {
      const bool more = kt + 1 < KT;
      if (more) {
        const int ko = (kt + 1) * 64;
        ra0 = *(const u32x4*)(ap0 + ko); ra1 = *(const u32x4*)(ap1 + ko); ra2 = *(const u32x4*)(ap2 + ko); ra3 = *(const u32x4*)(ap3 + ko);
        rb0 = *(const u32x4*)(bp + ko); rb1 = *(const u32x4*)(bp + bstep + ko); rb2 = *(const u32x4*)(bp + 2 * bstep + ko); rb3 = *(const u32x4*)(bp + 3 * bstep + ko);
      }
      const char* sa = lds + (kt & 1) * (2 * G_TILE) + (wr * 128 + r) * G_LDT + h * 16;
      const char* sb = lds + (kt & 1) * (2 * G_TILE) + G_TILE + (wc * 64 + r) * G_LDT + h * 16;
#pragma unroll
      for (int ks = 0; ks < 4; ++ks) {
        bf16x8 af[4], bf[2];
#pragma unroll
        for (int mt = 0; mt < 4; ++mt) af[mt] = *(const bf16x8*)(sa + mt * 32 * G_LDT + ks * 32);
#pragma unroll
        for (int nt = 0; nt < 2; ++nt) bf[nt] = *(const bf16x8*)(sb + nt * 32 * G_LDT + ks * 32);
#pragma unroll
        for (int mt = 0; mt < 4; ++mt)
#pragma unroll
          for (int nt = 0; nt < 2; ++nt) acc[mt][nt] = MFMA32(af[mt], bf[nt], acc[mt][nt]);
      }
      if (more) {
        char* a = lds + ((kt + 1) & 1) * (2 * G_TILE) + wofs; char* b = a + G_TILE;
        *(u32x4*)a = ra0; *(u32x4*)(a + 64 * G_LDT) = ra1; *(u32x4*)(a + 128 * G_LDT) = ra2; *(u32x4*)(a + 192 * G_LDT) = ra3;
        *(u32x4*)b = rb0; *(u32x4*)(b + 64 * G_LDT) = rb1; *(u32x4*)(b + 128 * G_LDT) = rb2; *(u32x4*)(b + 192 * G_LDT) = rb3;
      }
      __syncthreads();
    }
    gemm_epilogue<MODE>(p, l, acc, tm, tn, wr, wc, lane);
  }
}

DI void gif_phase(const Params& p, int l) {
  const int tidq = otid(); const int lane = tidq & 63, gw = blockIdx.x * 8 + (tidq >> 6), ngw = gridDim.x * 8;
  const float* w = p.in[9] + (size_t)l * D * DIN + 7168;
  const float* bif = p.in[10] + l * 8;
  float* gif = (float*)(p.ws + W_GIF);
  for (int rg = gw; rg < M / 4; rg += ngw) {
    float acc[4][8];
#pragma unroll
    for (int a = 0; a < 4; ++a)
#pragma unroll
      for (int j = 0; j < 8; ++j) acc[a][j] = 0.f;
    const float* x0 = xrow_ptr(p, l, rg * 4);
#pragma unroll 2
    for (int kk = 0; kk < 16; ++kk) {
      const int k = kk * 64 + lane;
      const f32x4 w0 = *(const f32x4*)(w + (size_t)k * DIN), w1 = *(const f32x4*)(w + (size_t)k * DIN + 4);
#pragma unroll
      for (int a = 0; a < 4; ++a) {
        const float xv = x0[(size_t)a * D + k];
        acc[a][0] += xv * w0[0]; acc[a][1] += xv * w0[1]; acc[a][2] += xv * w0[2]; acc[a][3] += xv * w0[3];
        acc[a][4] += xv * w1[0]; acc[a][5] += xv * w1[1]; acc[a][6] += xv * w1[2]; acc[a][7] += xv * w1[3];
      }
    }
#pragma unroll
    for (int a = 0; a < 4; ++a)
#pragma unroll
      for (int j = 0; j < 8; ++j) {
        const float s = wave_sum(acc[a][j]);
        if (lane == 0) gif[(size_t)(rg * 4 + a) * 8 + j] = s + bif[j];
      }
  }
}

DI void qkconv_phase(const Params& p, int l) {
  const bf16_t* Z = (const bf16_t*)(p.ws + W_Z);
  bf16_t* QA = (bf16_t*)(p.ws + W_AB); bf16_t* KA = (bf16_t*)(p.ws + W_KA);
  const float* cw = p.in[11] + (size_t)l * 4 * 2048; const float* cb = p.in[12] + (size_t)l * 2048;
  const size_t total = (size_t)(M / 4) * 256;
  for (size_t it = (size_t)blockIdx.x * NTH + otid(); it < total; it += (size_t)gridDim.x * NTH) {
    const int cc = (int)(it & 255), rg = (int)(it >> 8), col = cc * 8, row0 = rg * 4;
    int t0, hist_rows;
    const float* st = nullptr;
    if (row0 < MP) { t0 = row0 & (SEQ - 1); }
    else { t0 = (row0 - MP) & 15; st = p.in[4] + ((size_t)(l * 8 + ((row0 - MP) >> 4)) * 3) * 2048 + col; }
    (void)hist_rows;
    float w[4][8], bias[8];
#pragma unroll
    for (int j = 0; j < 4; ++j) { f32x4 a = *(const f32x4*)(cw + j * 2048 + col), b = *(const f32x4*)(cw + j * 2048 + col + 4);
      w[j][0] = a[0]; w[j][1] = a[1]; w[j][2] = a[2]; w[j][3] = a[3]; w[j][4] = b[0]; w[j][5] = b[1]; w[j][6] = b[2]; w[j][7] = b[3]; }
    { f32x4 a = *(const f32x4*)(cb + col), b = *(const f32x4*)(cb + col + 4);
      bias[0] = a[0]; bias[1] = a[1]; bias[2] = a[2]; bias[3] = a[3]; bias[4] = b[0]; bias[5] = b[1]; bias[6] = b[2]; bias[7] = b[3]; }
    float x[7][8];
#pragma unroll
    for (int j = 0; j < 7; ++j) {
      const int t = t0 - 3 + j;
      if (t >= 0) { u32x4 v = *(const u32x4*)(Z + (size_t)(row0 - 3 + j) * NIN + 3072 + col); unpack8(v, x[j]); }
      else if (st) { f32x4 a = *(const f32x4*)(st + (size_t)(3 + t) * 2048), b = *(const f32x4*)(st + (size_t)(3 + t) * 2048 + 4);
        x[j][0] = a[0]; x[j][1] = a[1]; x[j][2] = a[2]; x[j][3] = a[3]; x[j][4] = b[0]; x[j][5] = b[1]; x[j][6] = b[2]; x[j][7] = b[3]; }
      else {
#pragma unroll
        for (int e = 0; e < 8; ++e) x[j][e] = 0.f; }
    }
    const float sc = col >= 1024 ? 0.0625f : 1.f;
    bf16_t* dst = col >= 1024 ? KA + (col - 1024) : QA + col;
#pragma unroll
    for (int a = 0; a < 4; ++a) {
      float o[8];
#pragma unroll
      for (int e = 0; e < 8; ++e) {
        float u = bias[e] + w[0][e] * x[a][e] + w[1][e] * x[a + 1][e] + w[2][e] * x[a + 2][e] + w[3][e] * x[a + 3][e];
        o[e] = u * sigmoidf_(u) * sc;
      }
      u32x4 ov; ov[0] = pk2(o[0], o[1]); ov[1] = pk2(o[2], o[3]); ov[2] = pk2(o[4], o[5]); ov[3] = pk2(o[6], o[7]);
      *(u32x4*)(dst + (size_t)(row0 + a) * D) = ov;
    }
  }
}

constexpr int A_LD = 272;
constexpr int A_TILE = 64 * A_LD;
template <int KIND>
DI void attn_item(const Params& p, int l, int b, int ha, int qb, char* lds) {
  const int tid = otid(), lane = tid & 63, wave = uni(tid >> 6);
  const int map = wave >> 2, qt = wave & 3, r = lane & 31, h = lane >> 5;
  const bf16_t* Z = (const bf16_t*)(p.ws + W_Z);
  const int NT = KIND == 0 ? 2 * (qb + 1) : (NKS + 63) / 64;
  const int ntw = KIND == 0 ? 2 * qb + (qt >> 1) + 1 : NT;
  const bool active = KIND == 0 ? true : (qt == 0);
  int qrow;
  if (KIND == 0) qrow = b * SEQ + qb * 128 + qt * 32 + r; else qrow = MP + b * 16 + (r < 16 ? r : 15);
  bf16x8 qf[4];
#pragma unroll
  for (int ks = 0; ks < 4; ++ks) qf[ks] = *(const bf16x8*)(Z + (size_t)qrow * NIN + ha * 128 + map * 64 + ks * 16 + h * 8);
  const int skey = tid >> 4, part = tid & 15;
  u32x4 rk0, rk1, rv0, rv1;
  auto gload = [&](int j) {
    if (KIND == 0) {
      const bf16_t* base = Z + (size_t)(b * SEQ + j * 64 + skey) * NIN + 1024 + ha * 128 + part * 8;
      rk0 = *(const u32x4*)base; rk1 = *(const u32x4*)(base + (size_t)32 * NIN);
      rv0 = *(const u32x4*)(base + 1024); rv1 = *(const u32x4*)(base + (size_t)32 * NIN + 1024);
    } else {
#pragma unroll
      for (int i = 0; i < 2; ++i) {
        int kk = j * 64 + skey + 32 * i; if (kk > NKS - 1) kk = NKS - 1;
        const float *ks_, *vs_;
        if (kk < PAST) { const size_t o = (((size_t)(l * 8 + b) * PAST + kk) * 8 + ha) * 128 + part * 8; ks_ = p.in[2] + o; vs_ = p.in[3] + o; }
        else { const size_t o = (((size_t)l * MS + b * 16 + (kk - PAST)) * 8 + ha) * 128 + part * 8; ks_ = p.out + O_KS + o; vs_ = p.out + O_VS + o; }
        const f32x4 a0 = *(const f32x4*)ks_, a1 = *(const f32x4*)(ks_ + 4), c0 = *(const f32x4*)vs_, c1 = *(const f32x4*)(vs_ + 4);
        u32x4 ko, vo;
        ko[0] = pk2(a0[0], a0[1]); ko[1] = pk2(a0[2], a0[3]); ko[2] = pk2(a1[0], a1[1]); ko[3] = pk2(a1[2], a1[3]);
        vo[0] = pk2(c0[0], c0[1]); vo[1] = pk2(c0[2], c0[3]); vo[2] = pk2(c1[0], c1[1]); vo[3] = pk2(c1[2], c1[3]);
        if (i == 0) { rk0 = ko; rv0 = vo; } else { rk1 = ko; rv1 = vo; }
      }
    }
  };
  auto lwrite = [&](int buf) {
    char* kb = lds + buf * (2 * A_TILE) + skey * A_LD + part * 16; char* vb = kb + A_TILE;
    *(u32x4*)kb = rk0; *(u32x4*)(kb + 32 * A_LD) = rk1; *(u32x4*)vb = rv0; *(u32x4*)(vb + 32 * A_LD) = rv1;
  };
  f32x16 O[4];
#pragma unroll
  for (int v = 0; v < 4; ++v)
#pragma unroll
    for (int i = 0; i < 16; ++i) O[v][i] = 0.f;
  float m_run = -1e30f, l_run = 0.f;
  gload(0); lwrite(0);
  __syncthreads();
  const int q4 = (lane & 15) >> 2, p4 = lane & 3, blk = (lane >> 4) & 1;
  for (int j = 0; j < NT; ++j) {
    if (j + 1 < NT) gload(j + 1);
    if (active && j < ntw) {
      const char* kb = lds + (j & 1) * (2 * A_TILE);
      const char* vb = kb + A_TILE;
      f32x16 st[2];
#pragma unroll
      for (int kt = 0; kt < 2; ++kt) {
#pragma unroll
        for (int i = 0; i < 16; ++i) st[kt][i] = 0.f;
#pragma unroll
        for (int ks = 0; ks < 4; ++ks) {
          const bf16x8 kf = *(const bf16x8*)(kb + (kt * 32 + r) * A_LD + (map * 64 + ks * 16 + h * 8) * 2);
          st[kt] = MFMA32(kf, qf[ks], st[kt]);
        }
      }
      if (KIND == 1 && j == NT - 1) {
#pragma unroll
        for (int kt = 0; kt < 2; ++kt)
#pragma unroll
          for (int i = 0; i < 16; ++i) if (j * 64 + kt * 32 + crow(i, h) >= NKS) st[kt][i] = -1e30f;
      }
      float mx = st[0][0];
#pragma unroll
      for (int kt = 0; kt < 2; ++kt)
#pragma unroll
        for (int i = 0; i < 16; ++i) mx = fmaxf(mx, st[kt][i]);
      mx = fmaxf(mx, __shfl_xor(mx, 32));
      const float m_new = fmaxf(m_run, mx);
      const float alpha = exp2f((m_run - m_new) * LOG2E);
      const float mb = m_new * LOG2E;
      float rs = 0.f;
#pragma unroll
      for (int kt = 0; kt < 2; ++kt)
#pragma unroll
        for (int i = 0; i < 16; ++i) { const float e = exp2f(st[kt][i] * LOG2E - mb); st[kt][i] = e; rs += e; }
      rs += __shfl_xor(rs, 32);
      l_run = l_run * alpha + rs; m_run = m_new;
#pragma unroll
      for (int v = 0; v < 4; ++v)
#pragma unroll
        for (int i = 0; i < 16; ++i) O[v][i] *= alpha;
      bf16x8 pk[4];
      pk[0] = pack8(st[0], 0); pk[1] = pack8(st[0], 1); pk[2] = pack8(st[1], 0); pk[3] = pack8(st[1], 1);
      const unsigned vaddr = lds_addr(vb) + (4 * h + q4) * A_LD + (16 * blk + 4 * p4) * 2;
#pragma unroll
      for (int vt = 0; vt < 4; ++vt) {
        bf16x8 vf[4];
        tr_frag4<16 * A_LD, 8 * A_LD>(vaddr + vt * 64, vf);
#pragma unroll
        for (int ks = 0; ks < 4; ++ks) O[vt] = MFMA32(vf[ks], pk[ks], O[vt]);
      }
    }
    if (j + 1 < NT) lwrite((j + 1) & 1);
    __syncthreads();
  }
  float* ex = (float*)lds;
  const float inv_l = 1.f / l_run;
  if (map == 1) {
#pragma unroll
    for (int vt = 0; vt < 4; ++vt)
#pragma unroll
      for (int g = 0; g < 4; ++g) {
        f32x4 o; o[0] = O[vt][4 * g] * inv_l; o[1] = O[vt][4 * g + 1] * inv_l; o[2] = O[vt][4 * g + 2] * inv_l; o[3] = O[vt][4 * g + 3] * inv_l;
        *(f32x4*)(ex + (qt * 32 + r) * 132 + vt * 32 + 8 * g + 4 * h) = o;
      }
  }
  __syncthreads();
  if (map == 0) {
    const float lam = ((const float*)(p.ws + W_MISC))[l];
    const float lam_init = (l == 0) ? 0.2f : (0.8f - 0.6f * 0.74081822068171788f);
    float ssq = 0.f;
#pragma unroll
    for (int vt = 0; vt < 4; ++vt)
#pragma unroll
      for (int g = 0; g < 4; ++g) {
        const f32x4 o2 = *(const f32x4*)(ex + (qt * 32 + r) * 132 + vt * 32 + 8 * g + 4 * h);
#pragma unroll
        for (int e = 0; e < 4; ++e) { const float o = O[vt][4 * g + e] * inv_l - lam * o2[e]; O[vt][4 * g + e] = o; ssq += o * o; }
      }
    ssq += __shfl_xor(ssq, 32);
    const float rms = rsqrtf(ssq * (1.f / 128.f) + LN_EPS) * (1.f - lam_init);
    const float* sg = p.in[14] + l * 128;
    const bool valid = KIND == 0 ? true : (qt == 0 && r < 16);
    if (valid) {
      bf16_t* dst = (bf16_t*)(p.ws + W_Z) + (size_t)qrow * NIN + ha * 128;
#pragma unroll
      for (int vt = 0; vt < 4; ++vt)
#pragma unroll
        for (int g = 0; g < 4; ++g) {
          const int v0 = vt * 32 + 8 * g + 4 * h;
          const f32x4 gg = *(const f32x4*)(sg + v0);
          u32x2 o; o[0] = pk2(O[vt][4 * g] * rms * gg[0], O[vt][4 * g + 1] * rms * gg[1]); o[1] = pk2(O[vt][4 * g + 2] * rms * gg[2], O[vt][4 * g + 3] * rms * gg[3]);
          *(u32x2*)(dst + v0) = o;
        }
    }
  }
  __syncthreads();
}

constexpr int L_LD = 528;
constexpr int L_Q = 0, L_K = 64 * L_LD, L_V = 2 * 64 * L_LD, L_VW = 3 * 64 * L_LD, L_SW = 4 * 64 * L_LD;
constexpr int L_SWLD = 144;
constexpr int L_SC = L_SW + 64 * L_SWLD;
constexpr int S_A = 0, S_MX = 64, S_G = 128, S_WE = 192, S_EMT = 256, S_DS0 = 320, S_DS1 = 384, S_QN = 448  , S_NV = 960  , S_LNS = 1216  , S_GEND = 2240, S_MEND = 2241, S_END = 2248;
static_assert(L_SC + S_END * 4 <= 160 * 1024, "lds");
constexpr int LDS_BYTES = L_SC + S_END * 4;

template <int KIND>
DI void mlstm_item(const Params& p, int l, int b, int hm, char* lds) {
  const int tid0 = otid(), wave = uni(tid0 >> 6);
  const bf16_t* QA = (const bf16_t*)(p.ws + W_AB); const bf16_t* KA = (const bf16_t*)(p.ws + W_KA);
  const bf16_t* Z = (const bf16_t*)(p.ws + W_Z); bf16_t* H = (bf16_t*)(p.ws + W_H);
  const float* GIF = (const float*)(p.ws + W_GIF);
  float* sc = (float*)(lds + L_SC);
  const int nchunks = KIND == 0 ? SEQ / 64 : 1, Lv = KIND == 0 ? 64 : 16;
  f32x16 C[8];
  float nreg = 0.f, m_prev = 0.f;
  { const int tid = tid0, lane = tid & 63, r = lane & 31, h = lane >> 5; (void)r; (void)h;
  if (KIND == 0) {
#pragma unroll
    for (int d = 0; d < 8; ++d)
#pragma unroll
      for (int i = 0; i < 16; ++i) C[d][i] = 0.f;
  } else {
    const float* cp = p.in[5] + ((size_t)(l * 8 + b) * 4 + hm) * 65536 + (size_t)(4 * h) * 256 + wave * 32 + r;
#pragma unroll
    for (int d = 0; d < 8; ++d)
#pragma unroll
      for (int g = 0; g < 4; ++g) {
        C[d][4 * g] = cp[0]; C[d][4 * g + 1] = cp[256]; C[d][4 * g + 2] = cp[512]; C[d][4 * g + 3] = cp[768];
        cp += 2048; asm volatile("" : "+v"(cp));
      }
    if (tid < 256) nreg = p.in[6][((size_t)(l * 8 + b) * 4 + hm) * 256 + tid];
    m_prev = p.in[7][(l * 8 + b) * 4 + hm];
  }
  }
  for (int c = 0; c < nchunks; ++c) {
    int tid = tid0; asm volatile("" : "+v"(tid));
    const int lane = tid & 63, r = lane & 31, h = lane >> 5;
    const int q4 = (lane & 15) >> 2, p4 = lane & 3, blk = (lane >> 4) & 1;
    const float* mhg = p.in[15] + (size_t)l * D + hm * 256;
    const int rowbase = KIND == 0 ? b * SEQ + c * 64 : MP + b * 16;
    {
#pragma unroll
      for (int i = 0; i < 4; ++i) {
        const int cidx = tid + 512 * i, t = cidx >> 5, pc = cidx & 31;
        const int row = rowbase + (t < Lv ? t : Lv - 1);
        const u32x4 qv = *(const u32x4*)(QA + (size_t)row * D + hm * 256 + pc * 8);
        const u32x4 kv = *(const u32x4*)(KA + (size_t)row * D + hm * 256 + pc * 8);
        *(u32x4*)(lds + L_Q + t * L_LD + pc * 16) = qv;
        *(u32x4*)(lds + L_K + t * L_LD + pc * 16) = kv;
      }
    }
    if (wave == 0) {
      const int t = lane; const bool valid = t < Lv;
      const float gi = valid ? GIF[(size_t)(rowbase + t) * 8 + hm] : -1e30f;
      const float gf = valid ? GIF[(size_t)(rowbase + t) * 8 + 4 + hm] : 0.f;
      float lf = valid ? (fminf(gf, 0.f) - log1pf(__expf(-fabsf(gf)))) : 0.f;
      float bc = lf;
#pragma unroll
      for (int o = 1; o < 64; o <<= 1) { const float v = __shfl_up(bc, o); if (lane >= o) bc += v; }
      const float a = gi - bc;
      float cm = a;
#pragma unroll
      for (int o = 1; o < 64; o <<= 1) { const float v = __shfl_up(cm, o); if (lane >= o) cm = fmaxf(cm, v); }
      const float mxv = fmaxf(m_prev, cm);
      const float m_t = bc + mxv;
      const float g = __expf(m_prev - mxv);
      const float m_end = __shfl(m_t, 63), bc_end = __shfl(bc, 63);
      const float w_end = __expf(bc_end + a - m_end);
      const float g_end = __expf(bc_end + m_prev - m_end);
      sc[S_A + t] = a; sc[S_MX + t] = mxv; sc[S_G + t] = g; sc[S_WE + t] = w_end; sc[S_EMT + t] = __expf(-m_t);
      if (lane == 0) { sc[S_GEND] = g_end; sc[S_MEND] = m_end; }
    }
    if (tid < 256) sc[S_NV + tid] = nreg;
    __syncthreads();
    {
#pragma unroll
      for (int i = 0; i < 4; ++i) {
        const int cidx = tid + 512 * i, t = cidx >> 5, pc = cidx & 31;
        const int row = rowbase + (t < Lv ? t : Lv - 1);
        const u32x4 vv = *(const u32x4*)(Z + (size_t)row * NIN + 5120 + hm * 256 + pc * 8);
        *(u32x4*)(lds + L_V + t * L_LD + pc * 16) = vv;
        float f[8]; unpack8(vv, f);
        const float we = sc[S_WE + t];
        u32x4 o; o[0] = pk2(f[0] * we, f[1] * we); o[1] = pk2(f[2] * we, f[3] * we); o[2] = pk2(f[4] * we, f[5] * we); o[3] = pk2(f[6] * we, f[7] * we);
        *(u32x4*)(lds + L_VW + t * L_LD + pc * 16) = o;
      }
    }
    m_prev = sc[S_MEND];
    const float g_end = sc[S_GEND];
    __syncthreads();
    {
      const int t = tid & 63, part = tid >> 6;
      const char* qp = lds + L_Q + t * L_LD + part * 64;
      float s = 0.f;
#pragma unroll
      for (int e = 0; e < 4; ++e) {
        const u32x4 qv = *(const u32x4*)(qp + e * 16); float f[8]; unpack8(qv, f);
#pragma unroll
        for (int z = 0; z < 8; ++z) s += f[z] * sc[S_NV + part * 32 + e * 8 + z];
      }
      sc[S_QN + part * 64 + t] = s;
    }
    if (wave < 3) {
      const int stl = wave == 2 ? 1 : 0, tt = wave == 0 ? 0 : 1;
      f32x16 S;
#pragma unroll
      for (int i = 0; i < 16; ++i) S[i] = 0.f;
      const char* ka = lds + L_K + (stl * 32 + r) * L_LD + h * 16;
      const char* qa = lds + L_Q + (tt * 32 + r) * L_LD + h * 16;
#pragma unroll 4
      for (int ks = 0; ks < 16; ++ks) S = MFMA32(*(const bf16x8*)(ka + ks * 32), *(const bf16x8*)(qa + ks * 32), S);
      const int t = tt * 32 + r;
      const float mxt = sc[S_MX + t];
      float rs = 0.f;
#pragma unroll
      for (int g = 0; g < 4; ++g) {
        float wv[4];
#pragma unroll
        for (int e = 0; e < 4; ++e) {
          const int s = stl * 32 + 8 * g + 4 * h + e;
          float w = __expf(fminf(sc[S_A + s] - mxt, 0.f)); w = s <= t ? w : 0.f;
          wv[e] = S[4 * g + e] * w; rs += wv[e];
        }
        u32x2 o; o[0] = pk2(wv[0], wv[1]); o[1] = pk2(wv[2], wv[3]);
        *(u32x2*)(lds + L_SW + t * L_SWLD + (stl * 32 + 8 * g + 4 * h) * 2) = o;
      }
      rs += __shfl_xor(rs, 32);
      if (h == 0) {
        if (wave == 0) { sc[S_DS0 + t] = rs; sc[S_DS1 + t] = 0.f; }
        else if (wave == 1) sc[S_DS0 + t] = rs;
        else sc[S_DS1 + t] = rs;
      }
    } else if (wave == 3) {
      const int t = lane >> 1, hs = lane & 1;
      u32x4 z; z[0] = 0; z[1] = 0; z[2] = 0; z[3] = 0;
      *(u32x4*)(lds + L_SW + t * L_SWLD + 64 + hs * 32) = z; *(u32x4*)(lds + L_SW + t * L_SWLD + 64 + hs * 32 + 16) = z;
    }
    __builtin_amdgcn_sched_barrier(0);
    f32x16 accB[2];
#pragma unroll
    for (int tt = 0; tt < 2; ++tt)
#pragma unroll
      for (int i = 0; i < 16; ++i) accB[tt][i] = 0.f;
#pragma unroll
    for (int d = 0; d < 8; ++d)
#pragma unroll
      for (int s = 0; s < 2; ++s) {
        __builtin_amdgcn_sched_barrier(0);
        const bf16x8 cf = pack8(C[d], s);
#pragma unroll
        for (int tt = 0; tt < 2; ++tt) {
          const char* qp = lds + L_Q + (tt * 32 + r) * L_LD + (d * 32 + 16 * s + 4 * h) * 2;
          const s16x4 lo = *(const s16x4*)qp, hi = *(const s16x4*)(qp + 16);
          const bf16x8 qfr = __builtin_shufflevector(lo, hi, 0, 1, 2, 3, 4, 5, 6, 7);
          accB[tt] = MFMA32(cf, qfr, accB[tt]);
        }
      }
    __builtin_amdgcn_sched_barrier(0);
    {
      const unsigned vwa = lds_addr(lds + L_VW) + (8 * h + q4) * L_LD + (wave * 32 + 16 * blk + 4 * p4) * 2;
#pragma unroll
      for (int d = 0; d < 8; ++d) {
#pragma unroll
        for (int i = 0; i < 16; ++i) C[d][i] *= g_end;
        bf16x8 kf[4];
        tr_frag4<16 * L_LD, 4 * L_LD>(lds_addr(lds + L_K) + (8 * h + q4) * L_LD + (d * 32 + 16 * blk + 4 * p4) * 2, kf);
#pragma unroll
        for (int ks = 0; ks < 4; ++ks) {
          const bf16x8 vwf = tr_frag(vwa + ks * 16 * L_LD, vwa + ks * 16 * L_LD + 4 * L_LD);
          C[d] = MFMA32(kf[ks], vwf, C[d]);
        }
      }
    }
    __syncthreads();
    float hsum = 0.f, hsq = 0.f;
    {
      bf16x8 vf[4];
      tr_frag4<16 * L_LD, 4 * L_LD>(lds_addr(lds + L_V) + (8 * h + q4) * L_LD + (wave * 32 + 16 * blk + 4 * p4) * 2, vf);
#pragma unroll
      for (int tt = 0; tt < 2; ++tt) {
        const int t = tt * 32 + r;
        const float g = sc[S_G + t];
#pragma unroll
        for (int i = 0; i < 16; ++i) accB[tt][i] *= g;
        const char* sp = lds + L_SW + (tt * 32 + r) * L_SWLD + h * 16;
#pragma unroll
        for (int ks = 0; ks < 4; ++ks) accB[tt] = MFMA32(vf[ks], *(const bf16x8*)(sp + ks * 32), accB[tt]);
        float qn = 0.f;
#pragma unroll
        for (int pz = 0; pz < 8; ++pz) qn += sc[S_QN + pz * 64 + t];
        float den = sc[S_DS0 + t] + sc[S_DS1 + t] + g * qn;
        den = fmaxf(fabsf(den), sc[S_EMT + t]);
        const float rden = 1.f / den;
        float ps = 0.f, pq = 0.f;
#pragma unroll
        for (int i = 0; i < 16; ++i) { const float hv = accB[tt][i] * rden; accB[tt][i] = hv; ps += hv; pq += hv * hv; }
        ps += __shfl_xor(ps, 32); pq += __shfl_xor(pq, 32);
        if (h == 0) { sc[S_LNS + (wave * 64 + t) * 2] = ps; sc[S_LNS + (wave * 64 + t) * 2 + 1] = pq; }
      }
    }
    (void)hsum; (void)hsq;
    if (tid < 256) {
      float s = 0.f;
      for (int t = 0; t < 64; ++t) s += sc[S_WE + t] * bflo((unsigned)*(const bf16_t*)(lds + L_K + t * L_LD + tid * 2));
      nreg = g_end * nreg + s;
    }
    __syncthreads();
#pragma unroll
    for (int tt = 0; tt < 2; ++tt) {
      const int t = tt * 32 + r;
      float ps = 0.f, pq = 0.f;
#pragma unroll
      for (int w8 = 0; w8 < 8; ++w8) { ps += sc[S_LNS + (w8 * 64 + t) * 2]; pq += sc[S_LNS + (w8 * 64 + t) * 2 + 1]; }
      const float mean = ps * (1.f / 256.f);
      const float var = fmaxf(pq * (1.f / 256.f) - mean * mean, 0.f);
      const float rstd = rsqrtf(var + LN_EPS);
      if (t < Lv) {
        bf16_t* dst = H + (size_t)(rowbase + t) * D + hm * 256 + wave * 32;
#pragma unroll
        for (int g = 0; g < 4; ++g) {
          const int dv = 8 * g + 4 * h;
          const f32x4 gg = *(const f32x4*)(mhg + wave * 32 + dv);
          u32x2 o; o[0] = pk2((accB[tt][4 * g] - mean) * rstd * gg[0], (accB[tt][4 * g + 1] - mean) * rstd * gg[1]);
          o[1] = pk2((accB[tt][4 * g + 2] - mean) * rstd * gg[2], (accB[tt][4 * g + 3] - mean) * rstd * gg[3]);
          *(u32x2*)(dst + dv) = o;
        }
      }
    }
    __syncthreads();
  }
  {
    const int tid = tid0, lane = tid & 63, r = lane & 31, h = lane >> 5;
    const size_t bh = KIND == 0 ? (size_t)(l * 4 + b) * 4 + hm : (size_t)(l * 8 + b) * 4 + hm;
    float* co = p.out + (KIND == 0 ? O_CP : O_CS) + bh * 65536 + (size_t)(4 * h) * 256 + wave * 32 + r;
#pragma unroll
    for (int d = 0; d < 8; ++d)
#pragma unroll
      for (int g = 0; g < 4; ++g) {
        co[0] = C[d][4 * g]; co[256] = C[d][4 * g + 1]; co[512] = C[d][4 * g + 2]; co[768] = C[d][4 * g + 3];
        co += 2048; asm volatile("" : "+v"(co));
      }
    if (tid < 256) p.out[(KIND == 0 ? O_NP : O_NS) + bh * 256 + tid] = nreg;
    if (tid == 0) p.out[(KIND == 0 ? O_MPP : O_MSS) + bh] = m_prev;
  }
}

DI void mixer_phase(const Params& p, int l, char* lds) {
  unsigned* ctr = (unsigned*)(p.ws + W_MISC) + 16 + l;
  int* s_item = (int*)(lds + LDS_BYTES - 16);
  const int total = 16 + 32 + 64 + 2048;
  for (;;) {
    __syncthreads();
    if (threadIdx.x == 0) *s_item = (int)atomicAdd(ctr, 1u);
    __syncthreads();
    const int it = *s_item;
    __syncthreads();
    if (it >= total) break;
#ifndef NO_ML0
    if (it < 16) { mlstm_item<0>(p, l, it >> 2, it & 3, lds); continue; }
#endif
#ifndef NO_ML1
    if (it >= 16 && it < 48) { mlstm_item<1>(p, l, (it - 16) >> 2, (it - 16) & 3, lds); continue; }
#endif
#ifndef NO_AT1
    if (it >= 48 && it < 112) { attn_item<1>(p, l, (it - 48) >> 3, (it - 48) & 7, 0, lds); continue; }
#endif
#ifndef NO_AT0
    if (it >= 112) { const int x = it - 112; attn_item<0>(p, l, (x & 31) >> 3, x & 7, 63 - (x >> 5), lds); }
#endif
  }
}

DI void merge_phase(const Params& p) {
  const bf16_t* Z = (const bf16_t*)(p.ws + W_Z); const bf16_t* H = (const bf16_t*)(p.ws + W_H); bf16_t* Y = (bf16_t*)(p.ws + W_AB);
  const size_t total = (size_t)M * 128;
  for (size_t it = (size_t)blockIdx.x * NTH + otid(); it < total; it += (size_t)gridDim.x * NTH) {
    const size_t row = it >> 7; const int col = (int)(it & 127) * 8;
    const bf16_t* z = Z + row * NIN + col;
    float oa[8], om[8], ga[8], gb[8], hn[8];
    unpack8(*(const u32x4*)z, oa); unpack8(*(const u32x4*)(z + 6144), om); unpack8(*(const u32x4*)(z + 7168), ga); unpack8(*(const u32x4*)(z + 8192), gb);
    unpack8(*(const u32x4*)(H + row * D + col), hn);
    float y[8];
#pragma unroll
    for (int e = 0; e < 8; ++e) {
      const float hmv = __uint_as_float(f2bf(hn[e]) << 16) * sigmoidf_(om[e]);
      y[e] = sigmoidf_(ga[e]) * oa[e] + sigmoidf_(gb[e]) * hmv;
    }
    u32x4 o; o[0] = pk2(y[0], y[1]); o[1] = pk2(y[2], y[3]); o[2] = pk2(y[4], y[5]); o[3] = pk2(y[6], y[7]);
    *(u32x4*)(Y + row * D + col) = o;
  }
}

DI void ln_phase(const Params& p, const float* g, const float* bta, bool final_out) {
  const int tidq = otid(); const int lane = tidq & 63, gw = blockIdx.x * 8 + (tidq >> 6), ngw = gridDim.x * 8;
  float* R = (float*)(p.ws + W_R); bf16_t* AB = (bf16_t*)(p.ws + W_AB);
  for (int row = gw; row < M; row += ngw) {
    float* xr = R + (size_t)row * D;
    f32x4 v[4]; float s = 0.f;
#pragma unroll
    for (int j = 0; j < 4; ++j) { v[j] = *(const f32x4*)(xr + j * 256 + lane * 4); s += (v[j][0] + v[j][1]) + (v[j][2] + v[j][3]); }
    const float mean = wave_sum(s) * (1.f / D);
    float s2 = 0.f;
#pragma unroll
    for (int j = 0; j < 4; ++j) { v[j] = v[j] - mean; s2 += (v[j][0] * v[j][0] + v[j][1] * v[j][1]) + (v[j][2] * v[j][2] + v[j][3] * v[j][3]); }
    const float rstd = rsqrtf(wave_sum(s2) * (1.f / D) + LN_EPS);
    float* dst = final_out ? (row < MP ? p.out + O_YP + (size_t)row * D : p.out + O_YS + (size_t)(row - MP) * D) : xr;
#pragma unroll
    for (int j = 0; j < 4; ++j) {
      const int c = j * 256 + lane * 4;
      const f32x4 gg = *(const f32x4*)(g + c), bb = *(const f32x4*)(bta + c);
      f32x4 o = v[j] * rstd * gg + bb;
      *(f32x4*)(dst + c) = o;
      if (!final_out) { u32x2 ob; ob[0] = pk2(o[0], o[1]); ob[1] = pk2(o[2], o[3]); *(u32x2*)(AB + (size_t)row * D + c) = ob; }
    }
  }
}

DI void ffnconv_phase(const Params& p, int l) {
  const bf16_t* U = (const bf16_t*)(p.ws + W_Z); bf16_t* HF = (bf16_t*)(p.ws + W_Z + (size_t)M * NUP * 2);
  const float* cw = p.in[20] + (size_t)l * 3 * NUP; const float* cb = p.in[21] + (size_t)l * NUP;
  const size_t total = (size_t)M * 352;
  for (size_t it = (size_t)blockIdx.x * NTH + otid(); it < total; it += (size_t)gridDim.x * NTH) {
    const int row = (int)(it / 352), col = (int)(it % 352) * 8;
    int t; const float* st = nullptr;
    if (row < MP) t = row & (SEQ - 1); else { t = (row - MP) & 15; st = p.in[8] + ((size_t)(l * 8 + ((row - MP) >> 4)) * 2) * NUP; }
    float u[2][8];
#pragma unroll
    for (int hf = 0; hf < 2; ++hf) {
      const int cc = col + hf * DFF;
      f32x4 a = *(const f32x4*)(cb + cc), b = *(const f32x4*)(cb + cc + 4);
      u[hf][0] = a[0]; u[hf][1] = a[1]; u[hf][2] = a[2]; u[hf][3] = a[3]; u[hf][4] = b[0]; u[hf][5] = b[1]; u[hf][6] = b[2]; u[hf][7] = b[3];
#pragma unroll
      for (int j = 0; j < 3; ++j) {
        const int tj = t - 2 + j;
        float x[8];
        if (tj >= 0) unpack8(*(const u32x4*)(U + (size_t)(row - 2 + j) * NUP + cc), x);
        else if (st) { const float* s = st + (size_t)(2 + tj) * NUP + cc; f32x4 a2 = *(const f32x4*)s, b2 = *(const f32x4*)(s + 4);
          x[0] = a2[0]; x[1] = a2[1]; x[2] = a2[2]; x[3] = a2[3]; x[4] = b2[0]; x[5] = b2[1]; x[6] = b2[2]; x[7] = b2[3]; }
        else {
#pragma unroll
          for (int e = 0; e < 8; ++e) x[e] = 0.f; }
        const f32x4 w0 = *(const f32x4*)(cw + j * NUP + cc), w1 = *(const f32x4*)(cw + j * NUP + cc + 4);
        u[hf][0] += w0[0] * x[0]; u[hf][1] += w0[1] * x[1]; u[hf][2] += w0[2] * x[2]; u[hf][3] += w0[3] * x[3];
        u[hf][4] += w1[0] * x[4]; u[hf][5] += w1[1] * x[5]; u[hf][6] += w1[2] * x[6]; u[hf][7] += w1[3] * x[7];
      }
    }
    float o[8];
#pragma unroll
    for (int e = 0; e < 8; ++e) { const float a = u[0][e]; o[e] = 0.5f * a * (1.f + erff(a * 0.70710678118654752f)) * u[1][e]; }
    u32x4 ov; ov[0] = pk2(o[0], o[1]); ov[1] = pk2(o[2], o[3]); ov[2] = pk2(o[4], o[5]); ov[3] = pk2(o[6], o[7]);
    *(u32x4*)(HF + (size_t)row * DFF + col) = ov;
  }
}

constexpr int NPH = 21;
DI void run_phase(const Params& p, int ph, char* lds) {
#ifndef ONLY
  if (ph == 0) { phase0(p, lds); return; }
#else
  if (ph == 0) return;
#endif
  const int l = (ph - 1) / 10, s = (ph - 1) % 10;
#ifdef ONLY
  if (s != ONLY) return;
#endif
  switch (s) {
    case 0: gemm_phase<EPI_IN>(p, l, (const bf16_t*)(p.ws + W_AB), D, (const bf16_t*)(p.ws + W_WIN) + (size_t)l * NIN * D, D, NIN / 256, lds); break;
    case 1: qkconv_phase(p, l); gif_phase(p, l); break;
    case 2: mixer_phase(p, l, lds); break;
    case 3: merge_phase(p); break;
    case 4: gemm_phase<EPI_OUT>(p, l, (const bf16_t*)(p.ws + W_AB), D, (const bf16_t*)(p.ws + W_WOUT) + (size_t)l * D * D, D, D / 256, lds); break;
    case 5: ln_phase(p, p.in[17] + l * D, p.in[18] + l * D, false); break;
    case 6: gemm_phase<EPI_UP>(p, l, (const bf16_t*)(p.ws + W_AB), D, (const bf16_t*)(p.ws + W_WUP) + (size_t)l * NUP * D, D, NUP / 256, lds); break;
    case 7: ffnconv_phase(p, l); break;
    case 8: gemm_phase<EPI_DOWN>(p, l, (const bf16_t*)(p.ws + W_Z + (size_t)M * NUP * 2), DFF, (const bf16_t*)(p.ws + W_WDN) + (size_t)l * D * DFF, DFF, D / 256, lds); break;
    case 9: ln_phase(p, p.in[23] + l * D, p.in[24] + l * D, l == 1); break;
  }
}

__global__ void __launch_bounds__(NTH) mega(Params p, int ph_lo, int ph_hi) {
  extern __shared__ __attribute__((aligned(16))) char lds[];
#if MULTI_LAUNCH
  for (int ph = ph_lo; ph < ph_hi; ++ph) run_phase(p, ph, lds);
#else
  cg::grid_group grid = cg::this_grid();
  phase0(p, lds);
  grid.sync();
  for (int l = 0; l < 2; ++l) {
    gemm_phase<EPI_IN>(p, l, (const bf16_t*)(p.ws + W_AB), D, (const bf16_t*)(p.ws + W_WIN) + (size_t)l * NIN * D, D, NIN / 256, lds);
    grid.sync();
    qkconv_phase(p, l); gif_phase(p, l);
    grid.sync();
    mixer_phase(p, l, lds);
    grid.sync();
    merge_phase(p);
    grid.sync();
    gemm_phase<EPI_OUT>(p, l, (const bf16_t*)(p.ws + W_AB), D, (const bf16_t*)(p.ws + W_WOUT) + (size_t)l * D * D, D, D / 256, lds);
    grid.sync();
    ln_phase(p, p.in[17] + l * D, p.in[18] + l * D, false);
    grid.sync();
    gemm_phase<EPI_UP>(p, l, (const bf16_t*)(p.ws + W_AB), D, (const bf16_t*)(p.ws + W_WUP) + (size_t)l * NUP * D, D, NUP / 256, lds);
    grid.sync();
    ffnconv_phase(p, l);
    grid.sync();
    gemm_phase<EPI_DOWN>(p, l, (const bf16_t*)(p.ws + W_Z + (size_t)M * NUP * 2), DFF, (const bf16_t*)(p.ws + W_WDN) + (size_t)l * D * DFF, DFF, D / 256, lds);
    grid.sync();
    ln_phase(p, p.in[23] + l * D, p.in[24] + l * D, l == 1);
    if (l == 0) grid.sync();
  }
#endif
}

extern "C" void kernel_launch(void* const* d_in, const int* in_sizes, int n_in, void* d_out, int out_size, void* d_ws, size_t ws_size, hipStream_t stream) {
  static int grid = 0;
  if (grid == 0) {
    if (n_in != 25 || (size_t)out_size != O_END || ws_size < W_END) { fprintf(stderr, "kernel_launch: unexpected sizes n_in %d out %d (want %zu) ws %zu (want %zu)\n", n_in, out_size, (size_t)O_END, ws_size, (size_t)W_END); grid = -1; return; }
    int dev = 0, cus = 0, per_cu = 0;
    hipGetDevice(&dev);
    hipDeviceGetAttribute(&cus, hipDeviceAttributeMultiprocessorCount, dev);
    if (hipFuncSetAttribute((const void*)mega, hipFuncAttributeMaxDynamicSharedMemorySize, LDS_BYTES) != hipSuccess) { fprintf(stderr, "hipFuncSetAttribute failed\n"); grid = -1; return; }
    hipOccupancyMaxActiveBlocksPerMultiprocessor(&per_cu, (const void*)mega, NTH, LDS_BYTES);
    if (per_cu < 1) per_cu = 1;
    grid = cus * 1;
    (void)hipGetLastError();
  }
  if (grid < 0) return;
  Params p{};
  for (int i = 0; i < 25; ++i) p.in[i] = (const float*)d_in[i];
  p.out = (float*)d_out; p.ws = (unsigned char*)d_ws;
#if MULTI_LAUNCH
  for (int ph = 0; ph < NPH; ++ph) hipLaunchKernelGGL(mega, dim3(grid), dim3(NTH), LDS_BYTES, stream, p, ph, ph + 1);
#else
  int lo = 0, hi = NPH;
  void* args[] = {&p, &lo, &hi};
  hipError_t e = hipLaunchCooperativeKernel((const void*)mega, dim3(grid), dim3(NTH), args, LDS_BYTES, stream);
  if (e != hipSuccess) fprintf(stderr, "cooperative launch failed: %s (grid %d)\n", hipGetErrorString(e), grid);
#endif
}
```

```cpp
#include <hip/hip_runtime.h>
#include <hip/hip_cooperative_groups.h>
#include <cstdio>
namespace cg = cooperative_groups;

#ifndef MULTI_LAUNCH
#define MULTI_LAUNCH 0
#endif

typedef unsigned short bf16_t;
typedef short bf16x8 __attribute__((ext_vector_type(8)));
typedef short s16x4 __attribute__((ext_vector_type(4)));
typedef float f32x16 __attribute__((ext_vector_type(16)));
typedef float f32x4 __attribute__((ext_vector_type(4)));
typedef unsigned u32x4 __attribute__((ext_vector_type(4)));
typedef unsigned u32x2 __attribute__((ext_vector_type(2)));
#define DI __device__ __forceinline__
#define MFMA32(a, b, c) __builtin_amdgcn_mfma_f32_32x32x16_bf16((a), (b), (c), 0, 0, 0)

constexpr int NTH = 512;
constexpr int D = 1024, SEQ = 8192, NB = 4, MP = NB * SEQ, MS = 128, M = MP + MS, NTM = 129;
constexpr int DIN = 9224, NIN = 9216, DFF = 2816, NUP = 5632;
constexpr int PAST = 4096, NKS = PAST + 16;
constexpr float ALPHA = 1.4142135623730951f;
constexpr float LN_EPS = 1e-5f;
constexpr float LOG2E = 1.4426950408889634f;

constexpr size_t O_YP = 0;
constexpr size_t O_YS = O_YP + (size_t)MP * D;
constexpr size_t O_KP = O_YS + (size_t)MS * D;
constexpr size_t O_VP = O_KP + (size_t)2 * MP * 1024;
constexpr size_t O_MCP = O_VP + (size_t)2 * MP * 1024;
constexpr size_t O_CP = O_MCP + (size_t)2 * 4 * 3 * 2048;
constexpr size_t O_NP = O_CP + (size_t)2 * 4 * 4 * 65536;
constexpr size_t O_MPP = O_NP + (size_t)2 * 4 * 4 * 256;
constexpr size_t O_FCP = O_MPP + 32;
constexpr size_t O_KS = O_FCP + (size_t)2 * 4 * 2 * NUP;
constexpr size_t O_VS = O_KS + (size_t)2 * MS * 1024;
constexpr size_t O_MCS = O_VS + (size_t)2 * MS * 1024;
constexpr size_t O_CS = O_MCS + (size_t)2 * 8 * 3 * 2048;
constexpr size_t O_NS = O_CS + (size_t)2 * 8 * 4 * 65536;
constexpr size_t O_MSS = O_NS + (size_t)2 * 8 * 4 * 256;
constexpr size_t O_FCS = O_MSS + 64;
constexpr size_t O_END = O_FCS + (size_t)2 * 8 * 2 * NUP;

constexpr size_t W_Z = 0;
constexpr size_t W_H = W_Z + (size_t)M * NIN * 2;
constexpr size_t W_AB = W_H + (size_t)M * D * 2;
constexpr size_t W_KA = W_AB + (size_t)M * D * 2;
constexpr size_t W_R = W_KA + (size_t)M * D * 2;
constexpr size_t W_WIN = W_R + (size_t)M * D * 4;
constexpr size_t W_WOUT = W_WIN + (size_t)2 * NIN * D * 2;
constexpr size_t W_WUP = W_WOUT + (size_t)2 * D * D * 2;
constexpr size_t W_WDN = W_WUP + (size_t)2 * NUP * D * 2;
constexpr size_t W_GIF = W_WDN + (size_t)2 * D * DFF * 2;
constexpr size_t W_ROPE = W_GIF + (size_t)M * 8 * 4;
constexpr size_t W_MISC = W_ROPE + (size_t)8192 * 32 * 8;
constexpr size_t W_END = W_MISC + 4096;

struct Params {
  const float* in[25];
  float* out;
  unsigned char* ws;
};

DI unsigned f2bf(float x) { unsigned u = __float_as_uint(x); u += 0x7fffu + ((u >> 16) & 1u); return u >> 16; }
typedef __bf16 bf16v2 __attribute__((ext_vector_type(2)));
typedef float f32x2 __attribute__((ext_vector_type(2)));
DI unsigned pk2(float a, float b) { f32x2 v; v[0] = a; v[1] = b; return __builtin_bit_cast(unsigned, __builtin_convertvector(v, bf16v2)); }
DI float bflo(unsigned u) { return __uint_as_float(u << 16); }
DI float bfhi(unsigned u) { return __uint_as_float(u & 0xffff0000u); }
DI float sigmoidf_(float x) { return 1.f / (1.f + __expf(-x)); }
DI float wave_sum(float v) {
#pragma unroll
  for (int o = 1; o < 64; o <<= 1) v += __shfl_xor(v, o);
  return v;
}
DI int crow(int i, int h) { return (i & 3) + 8 * (i >> 2) + 4 * h; }
DI bf16x8 pack8(const f32x16& x, int s) {
  u32x4 p;
  p[0] = pk2(x[8 * s + 0], x[8 * s + 1]); p[1] = pk2(x[8 * s + 2], x[8 * s + 3]);
  p[2] = pk2(x[8 * s + 4], x[8 * s + 5]); p[3] = pk2(x[8 * s + 6], x[8 * s + 7]);
  return __builtin_bit_cast(bf16x8, p);
}
DI void unpack8(u32x4 v, float* f) {
  f[0] = bflo(v[0]); f[1] = bfhi(v[0]); f[2] = bflo(v[1]); f[3] = bfhi(v[1]);
  f[4] = bflo(v[2]); f[5] = bfhi(v[2]); f[6] = bflo(v[3]); f[7] = bfhi(v[3]);
}
DI bf16x8 tr_frag(unsigned a_lo, unsigned a_hi) {
  s16x4 lo, hi;
  asm volatile("ds_read_b64_tr_b16 %0, %2\n\tds_read_b64_tr_b16 %1, %3\n\ts_waitcnt lgkmcnt(0)"
               : "=&v"(lo), "=&v"(hi) : "v"(a_lo), "v"(a_hi) : "memory");
  return __builtin_shufflevector(lo, hi, 0, 1, 2, 3, 4, 5, 6, 7);
}
template <int STEP, int HIOFF>
DI void tr_frag4(unsigned a, bf16x8 (&f)[4]) {
  s16x4 l0, h0, l1, h1, l2, h2, l3, h3;
  asm volatile(
      "ds_read_b64_tr_b16 %0, %8 offset:%9\n\tds_read_b64_tr_b16 %1, %8 offset:%10\n\t"
      "ds_read_b64_tr_b16 %2, %8 offset:%11\n\tds_read_b64_tr_b16 %3, %8 offset:%12\n\t"
      "ds_read_b64_tr_b16 %4, %8 offset:%13\n\tds_read_b64_tr_b16 %5, %8 offset:%14\n\t"
      "ds_read_b64_tr_b16 %6, %8 offset:%15\n\tds_read_b64_tr_b16 %7, %8 offset:%16\n\t"
      "s_waitcnt lgkmcnt(0)"
      : "=&v"(l0), "=&v"(h0), "=&v"(l1), "=&v"(h1), "=&v"(l2), "=&v"(h2), "=&v"(l3), "=&v"(h3)
      : "v"(a), "i"(0), "i"(HIOFF), "i"(STEP), "i"(STEP + HIOFF), "i"(2 * STEP), "i"(2 * STEP + HIOFF), "i"(3 * STEP), "i"(3 * STEP + HIOFF)
      : "memory");
  f[0] = __builtin_shufflevector(l0, h0, 0, 1, 2, 3, 4, 5, 6, 7);
  f[1] = __builtin_shufflevector(l1, h1, 0, 1, 2, 3, 4, 5, 6, 7);
  f[2] = __builtin_shufflevector(l2, h2, 0, 1, 2, 3, 4, 5, 6, 7);
  f[3] = __builtin_shufflevector(l3, h3, 0, 1, 2, 3, 4, 5, 6, 7);
}
DI int otid() { int t = threadIdx.x; asm volatile("" : "+v"(t)); return t; }
DI int uni(int v) { return __builtin_amdgcn_readfirstlane(v); }
DI unsigned lds_addr(const void* p) { return (unsigned)(size_t)p; }

DI const float* xrow_ptr(const Params& p, int l, int row) {
  if (l == 0) return row < MP ? p.in[0] + (size_t)row * D : p.in[1] + (size_t)(row - MP) * D;
  return (const float*)(p.ws + W_R) + (size_t)row * D;
}

DI void transpose_w(const float* W, int K, int N, int src_ld, bf16_t* WT, bool remap, char* lds) {
  float* scr = (float*)lds;
  const int nkb = K / 64, nnb = N / 64, tid = otid();
  for (int it = blockIdx.x; it < nkb * nnb; it += gridDim.x) {
    const int kb = it / nnb, nb = it % nnb, k0 = kb * 64, n0 = nb * 64;
    const int ns = (remap && n0 >= 7168) ? n0 + 8 : n0;
#pragma unroll
    for (int i = 0; i < 8; ++i) {
      const int kk = (tid >> 6) + 8 * i, nn = tid & 63;
      scr[kk * 65 + nn] = W[(size_t)(k0 + kk) * src_ld + ns + nn];
    }
    __syncthreads();
    {
      const int n = tid >> 3, c = tid & 7;
      const float* s = scr + (8 * c) * 65 + n;
      u32x4 o;
      o[0] = pk2(s[0], s[65]); o[1] = pk2(s[2 * 65], s[3 * 65]); o[2] = pk2(s[4 * 65], s[5 * 65]); o[3] = pk2(s[6 * 65], s[7 * 65]);
      const int nd = (remap && n0 < 2048) ? ((n < 32) ? 2 * n : 2 * (n - 32) + 1) : n;
      *(u32x4*)(WT + (size_t)(n0 + nd) * K + k0 + 8 * c) = o;
    }
    __syncthreads();
  }
}

DI void phase0(const Params& p, char* lds) {
  const int tid = otid();
  for (int l = 0; l < 2; ++l) {
    transpose_w(p.in[9] + (size_t)l * D * DIN, D, NIN, DIN, (bf16_t*)(p.ws + W_WIN) + (size_t)l * NIN * D, true, lds);
    transpose_w(p.in[16] + (size_t)l * D * D, D, D, D, (bf16_t*)(p.ws + W_WOUT) + (size_t)l * D * D, false, lds);
    transpose_w(p.in[19] + (size_t)l * D * NUP, D, NUP, NUP, (bf16_t*)(p.ws + W_WUP) + (size_t)l * NUP * D, false, lds);
    transpose_w(p.in[22] + (size_t)l * DFF * D, DFF, D, D, (bf16_t*)(p.ws + W_WDN) + (size_t)l * D * DFF, false, lds);
  }
  bf16_t* ab = (bf16_t*)(p.ws + W_AB);
  for (size_t c = (size_t)blockIdx.x * NTH + tid; c < (size_t)M * 128; c += (size_t)gridDim.x * NTH) {
    const int row = (int)(c >> 7), cc = (int)(c & 127);
    const float* src = xrow_ptr(p, 0, row) + cc * 8;
    f32x4 a = *(const f32x4*)src, b = *(const f32x4*)(src + 4);
    u32x4 o; o[0] = pk2(a[0], a[1]); o[1] = pk2(a[2], a[3]); o[2] = pk2(b[0], b[1]); o[3] = pk2(b[2], b[3]);
    *(u32x4*)(ab + (size_t)row * D + cc * 8) = o;
  }
  float2* rope = (float2*)(p.ws + W_ROPE);
  for (int i = blockIdx.x * NTH + tid; i < 8192 * 32; i += gridDim.x * NTH) {
    const int pos = i >> 5, d = i & 31;
    const double inv = exp2(-(double)d * (13.287712379549449 / 32.0));
    double ang = (double)pos * inv;
    const double twopi = 6.283185307179586476925;
    ang -= twopi * rint(ang / twopi);
    float s, c; sincosf((float)ang, &s, &c);
    rope[i] = make_float2(c, s);
  }
  if (blockIdx.x == 0 && tid < 128) {
    const int l = tid >> 6, ln = tid & 63;
    const float* lp = p.in[13] + (size_t)l * 4 * 64;
    const float s1 = wave_sum(lp[ln] * lp[64 + ln]), s2 = wave_sum(lp[128 + ln] * lp[192 + ln]);
    const float lam_init = (l == 0) ? 0.2f : (0.8f - 0.6f * 0.74081822068171788f);
    if (ln == 0) ((float*)(p.ws + W_MISC))[l] = __expf(s1) - __expf(s2) + lam_init;
  }
  if (blockIdx.x == 0 && tid < 8) ((unsigned*)(p.ws + W_MISC))[16 + tid] = 0u;
}

namespace pg8 {
#define PG8_LAS __attribute__((address_space(3)))
typedef unsigned short bf16_t;
typedef short bf16x8 __attribute__((ext_vector_type(8)));
typedef float f32x4 __attribute__((ext_vector_type(4)));
typedef unsigned u32x4 __attribute__((ext_vector_type(4)));
constexpr int BM = 256, BK = 64, HALF = 128, HTB = HALF * BK * 2  , STAGE_BYTES = 8 * HTB, NXCD = 8, WGM = 8;

__host__ __device__ __forceinline__ int lds_byte(int r, int c) { const int st = (r >> 4) * 2 + (c >> 5), rr = r & 15, cc = c & 31, ob = rr * 64 + cc * 2; return st * 1024 + (ob ^ (((ob >> 9) & 1) << 5)); }
__host__ __device__ __forceinline__ void stage_rc(int b, int& R, int& C) { const int st = b / 1024, sb = b % 1024, swz = sb ^ (((sb >> 9) & 1) << 5); R = (st >> 1) * 16 + swz / 64; C = (st & 1) * 32 + (swz % 64) / 2; }
__host__ __device__ __forceinline__ int perm32(int rho) { const int n = rho >> 4, i = rho & 15; return 8 * (i >> 2) + 4 * n + (i & 3); }

struct Unit { int pm, pn; };
struct Gemm { const bf16_t* A; const bf16_t* Bt; int M, N, K; };

struct StaticOrder {
    int nM, nN, nwg, G, c;
    __host__ __device__ void init(int M, int N, int G_, int c_) { nM = M / BM; nN = N / BM; nwg = nM * nN; G = G_; c = c_; }
    __host__ __device__ bool next(int i, Unit& u) const {
        const long L = (long)i * G + c; if (L >= nwg) return false;
        int wgid = (int)L; { const int q = nwg / NXCD, r = nwg % NXCD, xcd = wgid % NXCD, off = wgid / NXCD; wgid = (xcd < r ? xcd * (q + 1) : r * (q + 1) + (xcd - r) * q) + off; }
        const int nig = WGM * nN, gid = wgid / nig, fm = gid * WGM, gsz = (nM - fm) < WGM ? (nM - fm) : WGM;
        u.pm = fm + ((wgid % nig) % gsz); u.pn = (wgid % nig) / gsz; return true;
    }
    __device__ __forceinline__ void a_ready(const Unit&) const {}
    __device__ __forceinline__ void done(const Unit&) const {}
};
template <class Epi, class Sched, bool STAMP = false>
__device__ __forceinline__ void gemm_phase(PG8_LAS unsigned char* lds, const Gemm g, const Sched& S, const Epi& E, unsigned long long* stamps) {
    const int tid = otid(), wid = __builtin_amdgcn_readfirstlane(tid >> 6), lane = tid & 63, wr = wid >> 2, wc = wid & 3, fr = lane & 15, fq = lane >> 4;
    const int K = g.K, nt = K / BK;
    int ts_lo = 0, ts_hi = 0, nts = 0; const unsigned long long rt_entry = STAMP ? (unsigned long long)wall_clock64() : 0ull;
#define PG8_STAMP() do { if (STAMP && wid == 0 && nts < 64) { const unsigned long long _c = (unsigned long long)clock64(); \
        ts_lo = (lane == nts) ? (int)(unsigned)_c : ts_lo; ts_hi = (lane == nts) ? (int)(unsigned)(_c >> 32) : ts_hi; ++nts; } } while (0)
    PG8_STAMP();
    unsigned voffA[2], voffB[2];
#pragma unroll
    for (int i = 0; i < 2; ++i) { int R, C; stage_rc(tid * 16 + i * 8192, R, C); const int Rb = Epi::PERM ? ((R & ~31) + perm32(R & 31)) : R;
        voffA[i] = (unsigned)(R * K + C) * 2u; voffB[i] = (unsigned)(Rb * K + C) * 2u; }
    const size_t kstep = (size_t)(BK * 2);
    const size_t hstep = (size_t)HALF * K * 2;
    const size_t tstep = 2 * hstep;
    const unsigned ldsw = (unsigned)wid * 1024u;
    const int aoff = lds_byte(wr * 64 + fr, fq * 8), boff = lds_byte(wc * 32 + fr, fq * 8);
#define PG8_SA(b, h) (((b) * 2 + (h)) * HTB)
#define PG8_SB(b, h) ((4 + (b) * 2 + (h)) * HTB)
#define PG8_STAGE(bufoff, gbase, voff) do { _Pragma("unroll") for (int _i = 0; _i < 2; ++_i) \
        __builtin_amdgcn_global_load_lds((const unsigned*)((const char*)(gbase) + (voff)[_i]), (PG8_LAS unsigned*)(lds + (bufoff) + ldsw + _i * 8192), 16, 0, 0); } while (0)
#define PG8_LDA(dst, b, h) do { _Pragma("unroll") for (int m = 0; m < 4; ++m) _Pragma("unroll") for (int k = 0; k < 2; ++k) dst[m][k] = *(const PG8_LAS bf16x8*)(lds + PG8_SA(b, h) + aoff + m * 2048 + k * 1024); } while (0)
#define PG8_LDB(dst, b, h) do { _Pragma("unroll") for (int n = 0; n < 2; ++n) _Pragma("unroll") for (int k = 0; k < 2; ++k) dst[n][k] = *(const PG8_LAS bf16x8*)(lds + PG8_SB(b, h) + boff + n * 2048 + k * 1024); } while (0)
#define PG8_MMA(ai, bj, At, Bt) do { __builtin_amdgcn_s_setprio(1); _Pragma("unroll") for (int m = 0; m < 4; ++m) _Pragma("unroll") for (int n = 0; n < 2; ++n) _Pragma("unroll") for (int k = 0; k < 2; ++k) \
        acc[ai][bj][m][n] = __builtin_amdgcn_mfma_f32_16x16x32_bf16(Bt[n][k], At[m][k], acc[ai][bj][m][n], 0, 0, 0); __builtin_amdgcn_s_setprio(0); } while (0)
#define PG8_WAIT_V(n) asm volatile("s_waitcnt vmcnt(" #n ")" ::: "memory")
#define PG8_WAIT_L(n) asm volatile("s_waitcnt lgkmcnt(" #n ")" ::: "memory")
#define PG8_BAR __builtin_amdgcn_s_barrier()
#define PG8_SCHED __builtin_amdgcn_sched_barrier(0)
    Unit cur, nxt; int ui = 0;
    if (!S.next(0, cur)) return;
    f32x4 acc[2][2][4][2];
#pragma unroll
    for (int a = 0; a < 2; ++a)
#pragma unroll
        for (int b = 0; b < 2; ++b)
#pragma unroll
            for (int m = 0; m < 4; ++m)
#pragma unroll
                for (int n = 0; n < 2; ++n) acc[a][b][m][n] = (f32x4){0.f, 0.f, 0.f, 0.f};
    bf16x8 At[4][2], B0[2][2], B1[2][2];
    const char* cA = (const char*)g.A + (size_t)cur.pm * tstep; const char* cB = (const char*)g.Bt + (size_t)cur.pn * tstep;
    S.a_ready(cur);
    PG8_STAGE(PG8_SB(0, 0), cB, voffB); PG8_STAGE(PG8_SA(0, 0), cA, voffA); PG8_STAGE(PG8_SB(0, 1), cB + hstep, voffB); PG8_STAGE(PG8_SA(0, 1), cA + hstep, voffA);
    if (wr == 1) PG8_BAR;
    PG8_WAIT_V(4); PG8_BAR;
    PG8_STAGE(PG8_SB(1, 0), cB + kstep, voffB); PG8_STAGE(PG8_SA(1, 0), cA + kstep, voffA); PG8_STAGE(PG8_SB(1, 1), cB + hstep + kstep, voffB);
    PG8_WAIT_V(6); PG8_BAR;
    PG8_STAMP();
    for (;;) {
        const bool has_next = S.next(ui + 1, nxt);
        const char* nA = has_next ? (const char*)g.A + (size_t)nxt.pm * tstep : cA; const char* nB = has_next ? (const char*)g.Bt + (size_t)nxt.pn * tstep : cB;
        for (int t = 0; t < nt; t += 2) {
            const bool last = (t == nt - 2);
            const char* a1 = cA + (size_t)(t + 1) * kstep;
            const char* a2 = last ? nA : cA + (size_t)(t + 2) * kstep; const char* b2 = last ? nB : cB + (size_t)(t + 2) * kstep;
            const char* a3 = a2 + kstep; const char* b3 = b2 + kstep;
            if (last && has_next) S.a_ready(nxt);
            PG8_LDB(B0, 0, 0); PG8_SCHED; PG8_LDA(At, 0, 0); PG8_STAGE(PG8_SA(1, 1), a1 + hstep, voffA);
            PG8_WAIT_L(8); PG8_BAR; PG8_WAIT_L(0); PG8_MMA(0, 0, At, B0); PG8_BAR; PG8_SCHED;
            PG8_LDB(B1, 0, 1); PG8_STAGE(PG8_SB(0, 0), b2, voffB);
            PG8_BAR; PG8_WAIT_L(0); PG8_MMA(0, 1, At, B1); PG8_BAR;
            PG8_LDA(At, 0, 1); PG8_STAGE(PG8_SA(0, 0), a2, voffA);
            PG8_BAR; PG8_WAIT_L(0); PG8_MMA(1, 0, At, B0); PG8_BAR; PG8_SCHED;
            PG8_STAGE(PG8_SB(0, 1), b2 + hstep, voffB);
            PG8_WAIT_V(6); PG8_BAR; PG8_MMA(1, 1, At, B1); PG8_BAR;
            PG8_LDB(B0, 1, 0); PG8_SCHED; PG8_LDA(At, 1, 0); PG8_STAGE(PG8_SA(0, 1), a2 + hstep, voffA);
            PG8_WAIT_L(8); PG8_BAR; PG8_WAIT_L(0); PG8_MMA(0, 0, At, B0); PG8_BAR; PG8_SCHED;
            PG8_LDB(B1, 1, 1); PG8_STAGE(PG8_SB(1, 0), b3, voffB);
            PG8_BAR; PG8_WAIT_L(0); PG8_MMA(0, 1, At, B1); PG8_BAR;
            PG8_LDA(At, 1, 1); PG8_STAGE(PG8_SA(1, 0), a3, voffA);
            PG8_BAR; PG8_WAIT_L(0); PG8_MMA(1, 0, At, B0); PG8_BAR; PG8_SCHED;
            PG8_STAGE(PG8_SB(1, 1), b3 + hstep, voffB);
            PG8_WAIT_V(6); PG8_BAR; PG8_MMA(1, 1, At, B1); PG8_BAR;
        }
        PG8_STAMP();
        if constexpr (!Epi::AFTER_DRAIN) { E(acc, cur, wr, wc, fr, fq); S.done(cur); }
        PG8_STAMP();
        if (!has_next) break;
#pragma unroll
        for (int a = 0; a < 2; ++a)
#pragma unroll
            for (int b = 0; b < 2; ++b)
#pragma unroll
                for (int m = 0; m < 4; ++m)
#pragma unroll
                    for (int n = 0; n < 2; ++n) acc[a][b][m][n] = (f32x4){0.f, 0.f, 0.f, 0.f};
        cur = nxt; cA = nA; cB = nB; ++ui;
    }
    PG8_WAIT_V(0);
    if (wr == 0) PG8_BAR;
    PG8_BAR;
    if constexpr (Epi::AFTER_DRAIN) { E.fused(acc, cur, wr, wc, fr, fq, lds, wid, lane); S.done(cur); }
    PG8_STAMP();
    if (STAMP && wid == 0) { stamps[lane] = lane < nts ? (((unsigned long long)(unsigned)ts_hi << 32) | (unsigned)ts_lo) : 0ull;
        if (lane == 62) stamps[62] = rt_entry; if (lane == 63) stamps[63] = (unsigned long long)wall_clock64(); }
#undef PG8_STAMP
#undef PG8_SA
#undef PG8_SB
#undef PG8_STAGE
#undef PG8_LDA
#undef PG8_LDB
#undef PG8_MMA
#undef PG8_WAIT_V
#undef PG8_WAIT_L
#undef PG8_BAR
#undef PG8_SCHED
}
}

enum { EPI_IN = 0, EPI_OUT = 1, EPI_UP = 2, EPI_DOWN = 3 };
template <int MODE>
struct Epi {
  static constexpr bool PERM = true, AFTER_DRAIN = false;
  Params p; int l;
  DI void operator()(const f32x4 (&acc)[2][2][4][2], const pg8::Unit& u, int wr, int wc, int fr, int fq) const {
    const int colb = u.pn * 256 + wc * 32 + 8 * fq;
#pragma unroll
    for (int ai = 0; ai < 2; ++ai)
#pragma unroll
      for (int m = 0; m < 4; ++m) {
        const int row = u.pm * 256 + ai * 128 + wr * 64 + m * 16 + fr;
        if (row < M) {
#pragma unroll
          for (int bj = 0; bj < 2; ++bj) {
            const int col = colb + bj * 128;
            const f32x4 v0 = acc[ai][bj][m][0], v1 = acc[ai][bj][m][1];
            if (MODE == EPI_IN) {
              bf16_t* Z = (bf16_t*)(p.ws + W_Z);
              const int seg = u.pn >> 2;
              if (seg <= 1) {
                const int pos = row < MP ? (row & (SEQ - 1)) : PAST + ((row - MP) & 15);
                const int d0 = (col & 63) >> 1;
                const f32x4* rp = (const f32x4*)((const float2*)(p.ws + W_ROPE) + pos * 32 + d0);
                const f32x4 c01 = rp[0], c23 = rp[1];
                const float a0 = v0[0] * c01[0] - v0[1] * c01[1], b0 = v0[1] * c01[0] + v0[0] * c01[1];
                const float a1 = v0[2] * c01[2] - v0[3] * c01[3], b1 = v0[3] * c01[2] + v0[2] * c01[3];
                const float a2 = v1[0] * c23[0] - v1[1] * c23[1], b2 = v1[1] * c23[0] + v1[0] * c23[1];
                const float a3 = v1[2] * c23[2] - v1[3] * c23[3], b3 = v1[3] * c23[2] + v1[2] * c23[3];
                const float qs = seg == 0 ? 0.125f : 1.f;
                u32x4 o; o[0] = pk2(a0 * qs, b0 * qs); o[1] = pk2(a1 * qs, b1 * qs); o[2] = pk2(a2 * qs, b2 * qs); o[3] = pk2(a3 * qs, b3 * qs);
                *(u32x4*)(Z + (size_t)row * NIN + col) = o;
                if (seg == 1) {
                  float* ob = (row < MP ? p.out + O_KP + ((size_t)l * MP + row) * 1024 : p.out + O_KS + ((size_t)l * MS + row - MP) * 1024) + ((col - 1024) & ~63) + d0;
                  f32x4 o1, o2; o1[0] = a0; o1[1] = a1; o1[2] = a2; o1[3] = a3; o2[0] = b0; o2[1] = b1; o2[2] = b2; o2[3] = b3;
                  *(f32x4*)ob = o1; *(f32x4*)(ob + 32) = o2;
                }
              } else {
                u32x4 o; o[0] = pk2(v0[0], v0[1]); o[1] = pk2(v0[2], v0[3]); o[2] = pk2(v1[0], v1[1]); o[3] = pk2(v1[2], v1[3]);
                *(u32x4*)(Z + (size_t)row * NIN + col) = o;
                if (seg == 2) {
                  float* ob = (row < MP ? p.out + O_VP + ((size_t)l * MP + row) * 1024 : p.out + O_VS + ((size_t)l * MS + row - MP) * 1024) + (col - 2048);
                  *(f32x4*)ob = v0; *(f32x4*)(ob + 4) = v1;
                } else if (seg == 3 || seg == 4) {
                  float* ob = nullptr;
                  if (row < MP) { const int s = row & (SEQ - 1); if (s >= SEQ - 3) ob = p.out + O_MCP + ((size_t)(l * 4 + (row >> 13)) * 3 + (s - (SEQ - 3))) * 2048 + col - 3072; }
                  else { const int t = (row - MP) & 15, b = (row - MP) >> 4; if (t >= 13) ob = p.out + O_MCS + ((size_t)(l * 8 + b) * 3 + (t - 13)) * 2048 + col - 3072; }
                  if (ob) { *(f32x4*)ob = v0; *(f32x4*)(ob + 4) = v1; }
                }
              }
            } else if (MODE == EPI_OUT || MODE == EPI_DOWN) {
              float* R = (float*)(p.ws + W_R) + (size_t)row * D + col;
              const float* rs = MODE == EPI_OUT ? xrow_ptr(p, l, row) + col : R;
              const f32x4 r0 = *(const f32x4*)rs, r1 = *(const f32x4*)(rs + 4);
              *(f32x4*)R = r0 * ALPHA + v0; *(f32x4*)(R + 4) = r1 * ALPHA + v1;
            } else {
              bf16_t* U = (bf16_t*)(p.ws + W_Z);
              u32x4 o; o[0] = pk2(v0[0], v0[1]); o[1] = pk2(v0[2], v0[3]); o[2] = pk2(v1[0], v1[1]); o[3] = pk2(v1[2], v1[3]);
              *(u32x4*)(U + (size_t)row * NUP + col) = o;
              float* ob = nullptr;
              if (row < MP) { const int s = row & (SEQ - 1); if (s >= SEQ - 2) ob = p.out + O_FCP + ((size_t)(l * 4 + (row >> 13)) * 2 + (s - (SEQ - 2))) * NUP + col; }
              else { const int t = (row - MP) & 15, b = (row - MP) >> 4; if (t >= 14) ob = p.out + O_FCS + ((size_t)(l * 8 + b) * 2 + (t - 14)) * NUP + col; }
              if (ob) { *(f32x4*)ob = v0; *(f32x4*)(ob + 4) = v1; }
            }
          }
        }
      }
  }
};

template <int MODE>
DI void gemm_phase(const Params& p, int l, const bf16_t* A, int lda, const bf16_t* Bt, int K, int ntn, char* lds) {
  (void)lda;
  pg8::Gemm g; g.A = A; g.Bt = Bt; g.M = NTM * 256; g.N = ntn * 256; g.K = K;
  pg8::StaticOrder S; S.init(g.M, g.N, (int)gridDim.x, (int)blockIdx.x);
  Epi<MODE> E; E.p = p; E.l = l;
  pg8::gemm_phase<Epi<MODE>, pg8::StaticOrder, false>((PG8_LAS unsigned char*)lds, g, S, E, nullptr);
  __syncthreads();
}

DI void gif_phase(const Params& p, int l) {
  const int tidq = otid(); const int lane = tidq & 63, gw = blockIdx.x * 8 + (tidq >> 6), ngw = gridDim.x * 8;
  const float* w = p.in[9] + (size_t)l * D * DIN + 7168;
  const float* bif = p.in[10] + l * 8;
  float* gif = (float*)(p.ws + W_GIF);
  for (int rg = gw; rg < M / 4; rg += ngw) {
    float acc[4][8];
#pragma unroll
    for (int a = 0; a < 4; ++a)
#pragma unroll
      for (int j = 0; j < 8; ++j) acc[a][j] = 0.f;
    const float* x0 = xrow_ptr(p, l, rg * 4);
#pragma unroll 2
    for (int kk = 0; kk < 16; ++kk) {
      const int k = kk * 64 + lane;
      const f32x4 w0 = *(const f32x4*)(w + (size_t)k * DIN), w1 = *(const f32x4*)(w + (size_t)k * DIN + 4);
#pragma unroll
      for (int a = 0; a < 4; ++a) {
        const float xv = x0[(size_t)a * D + k];
        acc[a][0] += xv * w0[0]; acc[a][1] += xv * w0[1]; acc[a][2] += xv * w0[2]; acc[a][3] += xv * w0[3];
        acc[a][4] += xv * w1[0]; acc[a][5] += xv * w1[1]; acc[a][6] += xv * w1[2]; acc[a][7] += xv * w1[3];
      }
    }
#pragma unroll
    for (int a = 0; a < 4; ++a)
#pragma unroll
      for (int j = 0; j < 8; ++j) {
        const float s = wave_sum(acc[a][j]);
        if (lane == 0) gif[(size_t)(rg * 4 + a) * 8 + j] = s + bif[j];
      }
  }
}

DI void qkconv_phase(const Params& p, int l) {
  const bf16_t* Z = (const bf16_t*)(p.ws + W_Z);
  bf16_t* QA = (bf16_t*)(p.ws + W_AB); bf16_t* KA = (bf16_t*)(p.ws + W_KA);
  const float* cw = p.in[11] + (size_t)l * 4 * 2048; const float* cb = p.in[12] + (size_t)l * 2048;
  const size_t total = (size_t)(M / 4) * 256;
  for (size_t it = (size_t)blockIdx.x * NTH + otid(); it < total; it += (size_t)gridDim.x * NTH) {
    const int cc = (int)(it & 255), rg = (int)(it >> 8), col = cc * 8, row0 = rg * 4;
    int t0, hist_rows;
    const float* st = nullptr;
    if (row0 < MP) { t0 = row0 & (SEQ - 1); }
    else { t0 = (row0 - MP) & 15; st = p.in[4] + ((size_t)(l * 8 + ((row0 - MP) >> 4)) * 3) * 2048 + col; }
    (void)hist_rows;
    float w[4][8], bias[8];
#pragma unroll
    for (int j = 0; j < 4; ++j) { f32x4 a = *(const f32x4*)(cw + j * 2048 + col), b = *(const f32x4*)(cw + j * 2048 + col + 4);
      w[j][0] = a[0]; w[j][1] = a[1]; w[j][2] = a[2]; w[j][3] = a[3]; w[j][4] = b[0]; w[j][5] = b[1]; w[j][6] = b[2]; w[j][7] = b[3]; }
    { f32x4 a = *(const f32x4*)(cb + col), b = *(const f32x4*)(cb + col + 4);
      bias[0] = a[0]; bias[1] = a[1]; bias[2] = a[2]; bias[3] = a[3]; bias[4] = b[0]; bias[5] = b[1]; bias[6] = b[2]; bias[7] = b[3]; }
    float x[7][8];
#pragma unroll
    for (int j = 0; j < 7; ++j) {
      const int t = t0 - 3 + j;
      if (t >= 0) { u32x4 v = *(const u32x4*)(Z + (size_t)(row0 - 3 + j) * NIN + 3072 + col); unpack8(v, x[j]); }
      else if (st) { f32x4 a = *(const f32x4*)(st + (size_t)(3 + t) * 2048), b = *(const f32x4*)(st + (size_t)(3 + t) * 2048 + 4);
        x[j][0] = a[0]; x[j][1] = a[1]; x[j][2] = a[2]; x[j][3] = a[3]; x[j][4] = b[0]; x[j][5] = b[1]; x[j][6] = b[2]; x[j][7] = b[3]; }
      else {
#pragma unroll
        for (int e = 0; e < 8; ++e) x[j][e] = 0.f; }
    }
    const float sc = col >= 1024 ? 0.0625f : 1.f;
    bf16_t* dst = col >= 1024 ? KA + (col - 1024) : QA + col;
#pragma unroll
    for (int a = 0; a < 4; ++a) {
      float o[8];
#pragma unroll
      for (int e = 0; e < 8; ++e) {
        float u = bias[e] + w[0][e] * x[a][e] + w[1][e] * x[a + 1][e] + w[2][e] * x[a + 2][e] + w[3][e] * x[a + 3][e];
        o[e] = u * sigmoidf_(u) * sc;
      }
      u32x4 ov; ov[0] = pk2(o[0], o[1]); ov[1] = pk2(o[2], o[3]); ov[2] = pk2(o[4], o[5]); ov[3] = pk2(o[6], o[7]);
      *(u32x4*)(dst + (size_t)(row0 + a) * D) = ov;
    }
  }
}

constexpr int A_LD = 272;
constexpr int A_TILE = 64 * A_LD;
template <int KIND>
DI void attn_item(const Params& p, int l, int b, int ha, int qb, char* lds) {
  const int tid = otid(), lane = tid & 63, wave = uni(tid >> 6);
  const int map = wave >> 2, qt = wave & 3, r = lane & 31, h = lane >> 5;
  const bf16_t* Z = (const bf16_t*)(p.ws + W_Z);
  const int NT = KIND == 0 ? 2 * (qb + 1) : (NKS + 63) / 64;
  const int ntw = KIND == 0 ? 2 * qb + (qt >> 1) + 1 : NT;
  const bool active = KIND == 0 ? true : (qt == 0);
  int qrow;
  if (KIND == 0) qrow = b * SEQ + qb * 128 + qt * 32 + r; else qrow = MP + b * 16 + (r < 16 ? r : 15);
  bf16x8 qf[4];
#pragma unroll
  for (int ks = 0; ks < 4; ++ks) {
    if (KIND == 0) qf[ks] = *(const bf16x8*)(Z + (size_t)qrow * NIN + ha * 128 + map * 64 + ks * 16 + h * 8);
    else {
      const int dn = ks * 16 + h * 8, par = dn >> 5, dd = dn & 31;
      const bf16_t* src = Z + (size_t)qrow * NIN + ha * 128 + map * 64 + 2 * dd;
      const u32x4 lo = *(const u32x4*)src, hi = *(const u32x4*)(src + 8);
      unsigned e[8];
#pragma unroll
      for (int i = 0; i < 4; ++i) { e[i] = par ? (lo[i] >> 16) : (lo[i] & 0xffffu); e[4 + i] = par ? (hi[i] >> 16) : (hi[i] & 0xffffu); }
      u32x4 o; o[0] = e[0] | (e[1] << 16); o[1] = e[2] | (e[3] << 16); o[2] = e[4] | (e[5] << 16); o[3] = e[6] | (e[7] << 16);
      qf[ks] = __builtin_bit_cast(bf16x8, o);
    }
  }
  const int skey = tid >> 4, part = tid & 15;
  u32x4 rk0, rk1, rv0, rv1;
  auto gload = [&](int j) {
    if (KIND == 0) {
      const bf16_t* base = Z + (size_t)(b * SEQ + j * 64 + skey) * NIN + 1024 + ha * 128 + part * 8;
      rk0 = *(const u32x4*)base; rk1 = *(const u32x4*)(base + (size_t)32 * NIN);
      rv0 = *(const u32x4*)(base + 1024); rv1 = *(const u32x4*)(base + (size_t)32 * NIN + 1024);
    } else {
#pragma unroll
      for (int i = 0; i < 2; ++i) {
        int kk = j * 64 + skey + 32 * i; if (kk > NKS - 1) kk = NKS - 1;
        const float *ks_, *vs_;
        if (kk < PAST) { const size_t o = (((size_t)(l * 8 + b) * PAST + kk) * 8 + ha) * 128 + part * 8; ks_ = p.in[2] + o; vs_ = p.in[3] + o; }
        else { const size_t o = (((size_t)l * MS + b * 16 + (kk - PAST)) * 8 + ha) * 128 + part * 8; ks_ = p.out + O_KS + o; vs_ = p.out + O_VS + o; }
        const f32x4 a0 = *(const f32x4*)ks_, a1 = *(const f32x4*)(ks_ + 4), c0 = *(const f32x4*)vs_, c1 = *(const f32x4*)(vs_ + 4);
        u32x4 ko, vo;
        ko[0] = pk2(a0[0], a0[1]); ko[1] = pk2(a0[2], a0[3]); ko[2] = pk2(a1[0], a1[1]); ko[3] = pk2(a1[2], a1[3]);
        vo[0] = pk2(c0[0], c0[1]); vo[1] = pk2(c0[2], c0[3]); vo[2] = pk2(c1[0], c1[1]); vo[3] = pk2(c1[2], c1[3]);
        if (i == 0) { rk0 = ko; rv0 = vo; } else { rk1 = ko; rv1 = vo; }
      }
    }
  };
  auto lwrite = [&](int buf) {
    char* kb = lds + buf * (2 * A_TILE) + skey * A_LD + part * 16; char* vb = kb + A_TILE;
    *(u32x4*)kb = rk0; *(u32x4*)(kb + 32 * A_LD) = rk1; *(u32x4*)vb = rv0; *(u32x4*)(vb + 32 * A_LD) = rv1;
  };
  f32x16 O[4];
#pragma unroll
  for (int v = 0; v < 4; ++v)
#pragma unroll
    for (int i = 0; i < 16; ++i) O[v][i] = 0.f;
  float m_run = -1e30f, l_run = 0.f;
  gload(0); lwrite(0);
  __syncthreads();
  const int q4 = (lane & 15) >> 2, p4 = lane & 3, blk = (lane >> 4) & 1;
  for (int j = 0; j < NT; ++j) {
    if (j + 1 < NT) gload(j + 1);
    if (active && j < ntw) {
      const char* kb = lds + (j & 1) * (2 * A_TILE);
      const char* vb = kb + A_TILE;
      f32x16 st[2];
#pragma unroll
      for (int kt = 0; kt < 2; ++kt) {
#pragma unroll
        for (int i = 0; i < 16; ++i) st[kt][i] = 0.f;
#pragma unroll
        for (int ks = 0; ks < 4; ++ks) {
          const bf16x8 kf = *(const bf16x8*)(kb + (kt * 32 + r) * A_LD + (map * 64 + ks * 16 + h * 8) * 2);
          st[kt] = MFMA32(kf, qf[ks], st[kt]);
        }
      }
      if (KIND == 1 && j == NT - 1) {
#pragma unroll
        for (int kt = 0; kt < 2; ++kt)
#pragma unroll
          for (int i = 0; i < 16; ++i) if (j * 64 + kt * 32 + crow(i, h) >= NKS) st[kt][i] = -1e30f;
      }
      float mx = st[0][0];
#pragma unroll
      for (int kt = 0; kt < 2; ++kt)
#pragma unroll
        for (int i = 0; i < 16; ++i) mx = fmaxf(mx, st[kt][i]);
      mx = fmaxf(mx, __shfl_xor(mx, 32));
      const float m_new = fmaxf(m_run, mx);
      const float alpha = __builtin_amdgcn_exp2f((m_run - m_new) * LOG2E);
      const float mb = m_new * LOG2E;
      float rs = 0.f;
#pragma unroll
      for (int kt = 0; kt < 2; ++kt)
#pragma unroll
        for (int i = 0; i < 16; ++i) { const float e = __builtin_amdgcn_exp2f(st[kt][i] * LOG2E - mb); st[kt][i] = e; rs += e; }
      rs += __shfl_xor(rs, 32);
      l_run = l_run * alpha + rs; m_run = m_new;
      if (__builtin_amdgcn_ballot_w64(alpha != 1.f) != 0ull) {
#pragma unroll
        for (int v = 0; v < 4; ++v)
#pragma unroll
          for (int i = 0; i < 16; ++i) O[v][i] *= alpha;
      }
      bf16x8 pk[4];
      pk[0] = pack8(st[0], 0); pk[1] = pack8(st[0], 1); pk[2] = pack8(st[1], 0); pk[3] = pack8(st[1], 1);
      const unsigned vaddr = lds_addr(vb) + (4 * h + q4) * A_LD + (16 * blk + 4 * p4) * 2;
#pragma unroll
      for (int vt = 0; vt < 4; ++vt) {
        bf16x8 vf[4];
        tr_frag4<16 * A_LD, 8 * A_LD>(vaddr + vt * 64, vf);
#pragma unroll
        for (int ks = 0; ks < 4; ++ks) O[vt] = MFMA32(vf[ks], pk[ks], O[vt]);
      }
    }
    if (j + 1 < NT) lwrite((j + 1) & 1);
    __syncthreads();
  }
  float* ex = (float*)lds;
  const float inv_l = 1.f / l_run;
  if (map == 1) {
#pragma unroll
    for (int vt = 0; vt < 4; ++vt)
#pragma unroll
      for (int g = 0; g < 4; ++g) {
        f32x4 o; o[0] = O[vt][4 * g] * inv_l; o[1] = O[vt][4 * g + 1] * inv_l; o[2] = O[vt][4 * g + 2] * inv_l; o[3] = O[vt][4 * g + 3] * inv_l;
        *(f32x4*)(ex + (qt * 32 + r) * 132 + vt * 32 + 8 * g + 4 * h) = o;
      }
  }
  __syncthreads();
  if (map == 0) {
    const float lam = ((const float*)(p.ws + W_MISC))[l];
    const float lam_init = (l == 0) ? 0.2f : (0.8f - 0.6f * 0.74081822068171788f);
    float ssq = 0.f;
#pragma unroll
    for (int vt = 0; vt < 4; ++vt)
#pragma unroll
      for (int g = 0; g < 4; ++g) {
        const f32x4 o2 = *(const f32x4*)(ex + (qt * 32 + r) * 132 + vt * 32 + 8 * g + 4 * h);
#pragma unroll
        for (int e = 0; e < 4; ++e) { const float o = O[vt][4 * g + e] * inv_l - lam * o2[e]; O[vt][4 * g + e] = o; ssq += o * o; }
      }
    ssq += __shfl_xor(ssq, 32);
    const float rms = rsqrtf(ssq * (1.f / 128.f) + LN_EPS) * (1.f - lam_init);
    const float* sg = p.in[14] + l * 128;
    const bool valid = KIND == 0 ? true : (qt == 0 && r < 16);
    if (valid) {
      bf16_t* dst = (bf16_t*)(p.ws + W_Z) + (size_t)qrow * NIN + 3072 + ha * 128;
#pragma unroll
      for (int vt = 0; vt < 4; ++vt)
#pragma unroll
        for (int g = 0; g < 4; ++g) {
          const int v0 = vt * 32 + 8 * g + 4 * h;
          const f32x4 gg = *(const f32x4*)(sg + v0);
          u32x2 o; o[0] = pk2(O[vt][4 * g] * rms * gg[0], O[vt][4 * g + 1] * rms * gg[1]); o[1] = pk2(O[vt][4 * g + 2] * rms * gg[2], O[vt][4 * g + 3] * rms * gg[3]);
          *(u32x2*)(dst + v0) = o;
        }
    }
  }
  __syncthreads();
}

constexpr int L_LD = 528;
constexpr int L_Q = 0, L_K = 64 * L_LD, L_V = 2 * 64 * L_LD, L_VW = 3 * 64 * L_LD, L_SW = 4 * 64 * L_LD;
constexpr int L_SWLD = 144;
constexpr int L_SC = L_SW + 64 * L_SWLD;
constexpr int S_A = 0, S_MX = 64, S_G = 128, S_WE = 192, S_EMT = 256, S_DS0 = 320, S_DS1 = 384, S_QN = 448  , S_NV = 960  , S_LNS = 1216  , S_GEND = 2240, S_MEND = 2241, S_END = 2248;
static_assert(L_SC + S_END * 4 <= 160 * 1024, "lds");
constexpr int LDS_BYTES = L_SC + S_END * 4;

template <int KIND>
DI void mlstm_item(const Params& p, int l, int b, int hm, char* lds) {
  const int tid0 = otid(), wave = uni(tid0 >> 6);
  const bf16_t* QA = (const bf16_t*)(p.ws + W_AB); const bf16_t* KA = (const bf16_t*)(p.ws + W_KA);
  const bf16_t* Z = (const bf16_t*)(p.ws + W_Z); bf16_t* H = (bf16_t*)(p.ws + W_H);
  const float* GIF = (const float*)(p.ws + W_GIF);
  float* sc = (float*)(lds + L_SC);
  int nchunks = KIND == 0 ? SEQ / 64 : 1; asm volatile("" : "+s"(nchunks));
  const int Lv = KIND == 0 ? 64 : 16;
  f32x16 C[8];
  float nreg = 0.f, m_prev = 0.f;
  { const int tid = tid0, lane = tid & 63, r = lane & 31, h = lane >> 5; (void)r; (void)h;
  if (KIND == 0) {
#pragma unroll
    for (int d = 0; d < 8; ++d)
#pragma unroll
      for (int i = 0; i < 16; ++i) C[d][i] = 0.f;
  } else {
    const float* cp = p.in[5] + ((size_t)(l * 8 + b) * 4 + hm) * 65536 + (size_t)(4 * h) * 256 + wave * 32 + r;
#pragma unroll
    for (int d = 0; d < 8; ++d)
#pragma unroll
      for (int g = 0; g < 4; ++g) {
        C[d][4 * g] = cp[0]; C[d][4 * g + 1] = cp[256]; C[d][4 * g + 2] = cp[512]; C[d][4 * g + 3] = cp[768];
        cp += 2048; asm volatile("" : "+v"(cp));
      }
    if (tid < 256) nreg = p.in[6][((size_t)(l * 8 + b) * 4 + hm) * 256 + tid];
    m_prev = p.in[7][(l * 8 + b) * 4 + hm];
  }
  }
  for (int c = 0; c < nchunks; ++c) {
    int tid = tid0; asm volatile("" : "+v"(tid));
    const int lane = tid & 63, r = lane & 31, h = lane >> 5;
    const int q4 = (lane & 15) >> 2, p4 = lane & 3, blk = (lane >> 4) & 1;
    const float* mhg = p.in[15] + (size_t)l * D + hm * 256;
    const int rowbase = KIND == 0 ? b * SEQ + c * 64 : MP + b * 16;
    const bool tvalid = lane < Lv;
    const float gi = tvalid ? GIF[(size_t)(rowbase + lane) * 8 + hm] : -1e30f;
    const float gf = tvalid ? GIF[(size_t)(rowbase + lane) * 8 + 4 + hm] : 0.f;
    u32x4 qv[4], kv[4], vv[4];
#pragma unroll
    for (int i = 0; i < 4; ++i) {
      const int cidx = tid + 512 * i, t = cidx >> 5, pc = cidx & 31;
      const int row = rowbase + (t < Lv ? t : Lv - 1);
      qv[i] = *(const u32x4*)(QA + (size_t)row * D + hm * 256 + pc * 8);
      kv[i] = *(const u32x4*)(KA + (size_t)row * D + hm * 256 + pc * 8);
      vv[i] = *(const u32x4*)(Z + (size_t)row * NIN + 5120 + hm * 256 + pc * 8);
    }
    if (tid < 256) sc[S_NV + tid] = nreg;
    float g_end, wend_l;
    {
      const float lf = tvalid ? (fminf(gf, 0.f) - log1pf(__expf(-fabsf(gf)))) : 0.f;
      float bc = lf;
#pragma unroll
      for (int o = 1; o < 64; o <<= 1) { const float v = __shfl_up(bc, o); if (lane >= o) bc += v; }
      const float a = gi - bc;
      float cm = a;
#pragma unroll
      for (int o = 1; o < 64; o <<= 1) { const float v = __shfl_up(cm, o); if (lane >= o) cm = fmaxf(cm, v); }
      const float mxv = fmaxf(m_prev, cm);
      const float m_t = bc + mxv;
      const float mx_end = __shfl(mxv, 63), bc_end = __shfl(bc, 63);
      const float m_end = bc_end + mx_end;
      wend_l = __expf(a - mx_end);
      g_end = __expf(m_prev - mx_end);
      if (wave == 0) {
        sc[S_MX + lane] = __expf(mx_end - mxv);
        sc[S_G + lane] = __expf(m_prev - mxv);
        sc[S_EMT + lane] = __expf(-m_t);
      }
      m_prev = m_end;
    }
#pragma unroll
    for (int i = 0; i < 4; ++i) {
      const int cidx = tid + 512 * i, t = cidx >> 5, pc = cidx & 31;
      const float we = __shfl(wend_l, t);
      float f[8]; unpack8(kv[i], f);
      u32x4 o; o[0] = pk2(f[0] * we, f[1] * we); o[1] = pk2(f[2] * we, f[3] * we); o[2] = pk2(f[4] * we, f[5] * we); o[3] = pk2(f[6] * we, f[7] * we);
      *(u32x4*)(lds + L_Q + t * L_LD + pc * 16) = qv[i];
      *(u32x4*)(lds + L_K + t * L_LD + pc * 16) = o;
      *(u32x4*)(lds + L_V + t * L_LD + pc * 16) = vv[i];
    }
    __syncthreads();
    {
      const int t = tid & 63, part = tid >> 6;
      const char* qp = lds + L_Q + t * L_LD + part * 64;
      float s = 0.f;
#pragma unroll
      for (int e = 0; e < 4; ++e) {
        const u32x4 qq = *(const u32x4*)(qp + e * 16); float f[8]; unpack8(qq, f);
#pragma unroll
        for (int z = 0; z < 8; ++z) s += f[z] * sc[S_NV + part * 32 + e * 8 + z];
      }
      sc[S_QN + part * 64 + t] = s;
    }
    if (wave < 3) {
      const int stl = wave == 2 ? 1 : 0, tt = wave == 0 ? 0 : 1;
      f32x16 S, S2;
#pragma unroll
      for (int i = 0; i < 16; ++i) { S[i] = 0.f; S2[i] = 0.f; }
      const char* ka = lds + L_K + (stl * 32 + r) * L_LD + h * 16;
      const char* qa = lds + L_Q + (tt * 32 + r) * L_LD + h * 16;
#pragma unroll 4
      for (int ks = 0; ks < 16; ks += 2) {
        S = MFMA32(*(const bf16x8*)(ka + ks * 32), *(const bf16x8*)(qa + ks * 32), S);
        S2 = MFMA32(*(const bf16x8*)(ka + ks * 32 + 32), *(const bf16x8*)(qa + ks * 32 + 32), S2);
      }
      const int t = tt * 32 + r;
      const float cw = sc[S_MX + t];
      float rs = 0.f;
#pragma unroll
      for (int g = 0; g < 4; ++g) {
        float wv[4];
#pragma unroll
        for (int e = 0; e < 4; ++e) {
          const int s = stl * 32 + 8 * g + 4 * h + e;
          wv[e] = s <= t ? (S[4 * g + e] + S2[4 * g + e]) * cw : 0.f; rs += wv[e];
        }
        u32x2 o; o[0] = pk2(wv[0], wv[1]); o[1] = pk2(wv[2], wv[3]);
        *(u32x2*)(lds + L_SW + t * L_SWLD + (stl * 32 + 8 * g + 4 * h) * 2) = o;
      }
      rs += __shfl_xor(rs, 32);
      if (h == 0) {
        if (wave == 0) { sc[S_DS0 + t] = rs; sc[S_DS1 + t] = 0.f; }
        else if (wave == 1) sc[S_DS0 + t] = rs;
        else sc[S_DS1 + t] = rs;
      }
    } else if (wave == 3) {
      const int t = lane >> 1, hs = lane & 1;
      u32x4 z; z[0] = 0; z[1] = 0; z[2] = 0; z[3] = 0;
      *(u32x4*)(lds + L_SW + t * L_SWLD + 64 + hs * 32) = z; *(u32x4*)(lds + L_SW + t * L_SWLD + 64 + hs * 32 + 16) = z;
    }
    __builtin_amdgcn_sched_barrier(0);
    f32x16 accB[2];
#pragma unroll
    for (int tt = 0; tt < 2; ++tt)
#pragma unroll
      for (int i = 0; i < 16; ++i) accB[tt][i] = 0.f;
#pragma unroll
    for (int d = 0; d < 8; ++d)
#pragma unroll
      for (int s = 0; s < 2; ++s) {
        __builtin_amdgcn_sched_barrier(0);
        const bf16x8 cf = pack8(C[d], s);
#pragma unroll
        for (int tt = 0; tt < 2; ++tt) {
          const char* qp = lds + L_Q + (tt * 32 + r) * L_LD + (d * 32 + 16 * s + 4 * h) * 2;
          const s16x4 lo = *(const s16x4*)qp, hi = *(const s16x4*)(qp + 16);
          const bf16x8 qfr = __builtin_shufflevector(lo, hi, 0, 1, 2, 3, 4, 5, 6, 7);
          accB[tt] = MFMA32(cf, qfr, accB[tt]);
        }
      }
    __builtin_amdgcn_sched_barrier(0);
    bf16x8 vf[4];
    tr_frag4<16 * L_LD, 4 * L_LD>(lds_addr(lds + L_V) + (8 * h + q4) * L_LD + (wave * 32 + 16 * blk + 4 * p4) * 2, vf);
    {
#pragma unroll
      for (int d = 0; d < 8; ++d) {
#pragma unroll
        for (int i = 0; i < 16; ++i) C[d][i] *= g_end;
        bf16x8 kf[4];
        tr_frag4<16 * L_LD, 4 * L_LD>(lds_addr(lds + L_K) + (8 * h + q4) * L_LD + (d * 32 + 16 * blk + 4 * p4) * 2, kf);
#pragma unroll
        for (int ks = 0; ks < 4; ++ks) C[d] = MFMA32(kf[ks], vf[ks], C[d]);
      }
    }
    if (tid < 256) {
      float s0 = 0.f, s1 = 0.f, s2 = 0.f, s3 = 0.f;
      const char* kp = lds + L_K + tid * 2;
#pragma unroll
      for (int t = 0; t < 64; t += 4) {
        s0 += bflo((unsigned)*(const bf16_t*)(kp + t * L_LD)); s1 += bflo((unsigned)*(const bf16_t*)(kp + (t + 1) * L_LD));
        s2 += bflo((unsigned)*(const bf16_t*)(kp + (t + 2) * L_LD)); s3 += bflo((unsigned)*(const bf16_t*)(kp + (t + 3) * L_LD));
      }
      nreg = g_end * nreg + ((s0 + s1) + (s2 + s3));
    }
    __syncthreads();
    {
#pragma unroll
      for (int tt = 0; tt < 2; ++tt) {
        const int t = tt * 32 + r;
        const float g = sc[S_G + t];
#pragma unroll
        for (int i = 0; i < 16; ++i) accB[tt][i] *= g;
        const char* sp = lds + L_SW + (tt * 32 + r) * L_SWLD + h * 16;
#pragma unroll
        for (int ks = 0; ks < 4; ++ks) accB[tt] = MFMA32(vf[ks], *(const bf16x8*)(sp + ks * 32), accB[tt]);
        float qn = 0.f;
#pragma unroll
        for (int pz = 0; pz < 8; ++pz) qn += sc[S_QN + pz * 64 + t];
        float den = sc[S_DS0 + t] + sc[S_DS1 + t] + g * qn;
        den = fmaxf(fabsf(den), sc[S_EMT + t]);
        const float rden = 1.f / den;
        float ps = 0.f, pq = 0.f;
#pragma unroll
        for (int i = 0; i < 16; ++i) { const float hv = accB[tt][i] * rden; accB[tt][i] = hv; ps += hv; pq += hv * hv; }
        ps += __shfl_xor(ps, 32); pq += __shfl_xor(pq, 32);
        if (h == 0) { sc[S_LNS + (wave * 64 + t) * 2] = ps; sc[S_LNS + (wave * 64 + t) * 2 + 1] = pq; }
      }
    }
    __syncthreads();
#pragma unroll
    for (int tt = 0; tt < 2; ++tt) {
      const int t = tt * 32 + r;
      float ps = 0.f, pq = 0.f;
#pragma unroll
      for (int w8 = 0; w8 < 8; ++w8) { ps += sc[S_LNS + (w8 * 64 + t) * 2]; pq += sc[S_LNS + (w8 * 64 + t) * 2 + 1]; }
      const float mean = ps * (1.f / 256.f);
      const float var = fmaxf(pq * (1.f / 256.f) - mean * mean, 0.f);
      const float rstd = rsqrtf(var + LN_EPS);
      if (t < Lv) {
        bf16_t* dst = H + (size_t)(rowbase + t) * D + hm * 256 + wave * 32;
#pragma unroll
        for (int g = 0; g < 4; ++g) {
          const int dv = 8 * g + 4 * h;
          const f32x4 gg = *(const f32x4*)(mhg + wave * 32 + dv);
          u32x2 o; o[0] = pk2((accB[tt][4 * g] - mean) * rstd * gg[0], (accB[tt][4 * g + 1] - mean) * rstd * gg[1]);
          o[1] = pk2((accB[tt][4 * g + 2] - mean) * rstd * gg[2], (accB[tt][4 * g + 3] - mean) * rstd * gg[3]);
          *(u32x2*)(dst + dv) = o;
        }
      }
    }
  }
  __syncthreads();
  {
    const int tid = tid0, lane = tid & 63, r = lane & 31, h = lane >> 5;
    const size_t bh = KIND == 0 ? (size_t)(l * 4 + b) * 4 + hm : (size_t)(l * 8 + b) * 4 + hm;
    float* co = p.out + (KIND == 0 ? O_CP : O_CS) + bh * 65536 + (size_t)(4 * h) * 256 + wave * 32 + r;
#pragma unroll
    for (int d = 0; d < 8; ++d)
#pragma unroll
      for (int g = 0; g < 4; ++g) {
        co[0] = C[d][4 * g]; co[256] = C[d][4 * g + 1]; co[512] = C[d][4 * g + 2]; co[768] = C[d][4 * g + 3];
        co += 2048; asm volatile("" : "+v"(co));
      }
    if (tid < 256) p.out[(KIND == 0 ? O_NP : O_NS) + bh * 256 + tid] = nreg;
    if (tid == 0) p.out[(KIND == 0 ? O_MPP : O_MSS) + bh] = m_prev;
  }
}

DI void mixer_phase(const Params& p, int l, char* lds, int cidx, bool ml_only) {
  unsigned* ctr = (unsigned*)(p.ws + W_MISC) + 16 + cidx;
  int* s_item = (int*)(lds + LDS_BYTES - 16);
  const int total = 16 + 32 + 64 + 2048;
  for (;;) {
    __syncthreads();
    if (threadIdx.x == 0) *s_item = (int)atomicAdd(ctr, 1u);
    __syncthreads();
    const int it = *s_item;
    __syncthreads();
    if (it >= total) break;
    if (ml_only && it >= 48) break;
#ifndef NO_ML0
    if (it < 16) { mlstm_item<0>(p, l, it >> 2, it & 3, lds); continue; }
#endif
#ifndef NO_ML1
    if (it >= 16 && it < 48) { mlstm_item<1>(p, l, (it - 16) >> 2, (it - 16) & 3, lds); continue; }
#endif
#ifndef NO_AT1
    if (it >= 48 && it < 112) { attn_item<1>(p, l, (it - 48) >> 3, (it - 48) & 7, 0, lds); continue; }
#endif
#ifndef NO_AT0
    if (it >= 112) { const int x = it - 112; attn_item<0>(p, l, (x & 31) >> 3, x & 7, 63 - (x >> 5), lds); }
#endif
  }
}

DI void merge_phase(const Params& p) {
  const bf16_t* Z = (const bf16_t*)(p.ws + W_Z); const bf16_t* H = (const bf16_t*)(p.ws + W_H); bf16_t* Y = (bf16_t*)(p.ws + W_AB);
  const size_t total = (size_t)M * 128;
  for (size_t it = (size_t)blockIdx.x * NTH + otid(); it < total; it += (size_t)gridDim.x * NTH) {
    const size_t row = it >> 7; const int col = (int)(it & 127) * 8;
    const bf16_t* z = Z + row * NIN + col;
    float oa[8], om[8], ga[8], gb[8], hn[8];
    unpack8(*(const u32x4*)(z + 3072), oa); unpack8(*(const u32x4*)(z + 6144), om); unpack8(*(const u32x4*)(z + 7168), ga); unpack8(*(const u32x4*)(z + 8192), gb);
    unpack8(*(const u32x4*)(H + row * D + col), hn);
    float y[8];
#pragma unroll
    for (int e = 0; e < 8; ++e) {
      const float hmv = __uint_as_float(f2bf(hn[e]) << 16) * sigmoidf_(om[e]);
      y[e] = sigmoidf_(ga[e]) * oa[e] + sigmoidf_(gb[e]) * hmv;
    }
    u32x4 o; o[0] = pk2(y[0], y[1]); o[1] = pk2(y[2], y[3]); o[2] = pk2(y[4], y[5]); o[3] = pk2(y[6], y[7]);
    *(u32x4*)(Y + row * D + col) = o;
  }
}

DI void ln_phase(const Params& p, const float* g, const float* bta, bool final_out) {
  const int tidq = otid(); const int lane = tidq & 63, gw = blockIdx.x * 8 + (tidq >> 6), ngw = gridDim.x * 8;
  float* R = (float*)(p.ws + W_R); bf16_t* AB = (bf16_t*)(p.ws + W_AB);
  for (int row = gw; row < M; row += ngw) {
    float* xr = R + (size_t)row * D;
    f32x4 v[4]; float s = 0.f;
#pragma unroll
    for (int j = 0; j < 4; ++j) { v[j] = *(const f32x4*)(xr + j * 256 + lane * 4); s += (v[j][0] + v[j][1]) + (v[j][2] + v[j][3]); }
    const float mean = wave_sum(s) * (1.f / D);
    float s2 = 0.f;
#pragma unroll
    for (int j = 0; j < 4; ++j) { v[j] = v[j] - mean; s2 += (v[j][0] * v[j][0] + v[j][1] * v[j][1]) + (v[j][2] * v[j][2] + v[j][3] * v[j][3]); }
    const float rstd = rsqrtf(wave_sum(s2) * (1.f / D) + LN_EPS);
    float* dst = final_out ? (row < MP ? p.out + O_YP + (size_t)row * D : p.out + O_YS + (size_t)(row - MP) * D) : xr;
#pragma unroll
    for (int j = 0; j < 4; ++j) {
      const int c = j * 256 + lane * 4;
      const f32x4 gg = *(const f32x4*)(g + c), bb = *(const f32x4*)(bta + c);
      f32x4 o = v[j] * rstd * gg + bb;
      *(f32x4*)(dst + c) = o;
      if (!final_out) { u32x2 ob; ob[0] = pk2(o[0], o[1]); ob[1] = pk2(o[2], o[3]); *(u32x2*)(AB + (size_t)row * D + c) = ob; }
    }
  }
}

DI void ffnconv_phase(const Params& p, int l) {
  const bf16_t* U = (const bf16_t*)(p.ws + W_Z); bf16_t* HF = (bf16_t*)(p.ws + W_Z + (size_t)M * NUP * 2);
  const float* cw = p.in[20] + (size_t)l * 3 * NUP; const float* cb = p.in[21] + (size_t)l * NUP;
  const size_t total = (size_t)M * 352;
  for (size_t it = (size_t)blockIdx.x * NTH + otid(); it < total; it += (size_t)gridDim.x * NTH) {
    const int row = (int)(it / 352), col = (int)(it % 352) * 8;
    int t; const float* st = nullptr;
    if (row < MP) t = row & (SEQ - 1); else { t = (row - MP) & 15; st = p.in[8] + ((size_t)(l * 8 + ((row - MP) >> 4)) * 2) * NUP; }
    float u[2][8];
#pragma unroll
    for (int hf = 0; hf < 2; ++hf) {
      const int cc = col + hf * DFF;
      f32x4 a = *(const f32x4*)(cb + cc), b = *(const f32x4*)(cb + cc + 4);
      u[hf][0] = a[0]; u[hf][1] = a[1]; u[hf][2] = a[2]; u[hf][3] = a[3]; u[hf][4] = b[0]; u[hf][5] = b[1]; u[hf][6] = b[2]; u[hf][7] = b[3];
#pragma unroll
      for (int j = 0; j < 3; ++j) {
        const int tj = t - 2 + j;
        float x[8];
        if (tj >= 0) unpack8(*(const u32x4*)(U + (size_t)(row - 2 + j) * NUP + cc), x);
        else if (st) { const float* s = st + (size_t)(2 + tj) * NUP + cc; f32x4 a2 = *(const f32x4*)s, b2 = *(const f32x4*)(s + 4);
          x[0] = a2[0]; x[1] = a2[1]; x[2] = a2[2]; x[3] = a2[3]; x[4] = b2[0]; x[5] = b2[1]; x[6] = b2[2]; x[7] = b2[3]; }
        else {
#pragma unroll
          for (int e = 0; e < 8; ++e) x[e] = 0.f; }
        const f32x4 w0 = *(const f32x4*)(cw + j * NUP + cc), w1 = *(const f32x4*)(cw + j * NUP + cc + 4);
        u[hf][0] += w0[0] * x[0]; u[hf][1] += w0[1] * x[1]; u[hf][2] += w0[2] * x[2]; u[hf][3] += w0[3] * x[3];
        u[hf][4] += w1[0] * x[4]; u[hf][5] += w1[1] * x[5]; u[hf][6] += w1[2] * x[6]; u[hf][7] += w1[3] * x[7];
      }
    }
    float o[8];
#pragma unroll
    for (int e = 0; e < 8; ++e) { const float a = u[0][e]; o[e] = 0.5f * a * (1.f + erff(a * 0.70710678118654752f)) * u[1][e]; }
    u32x4 ov; ov[0] = pk2(o[0], o[1]); ov[1] = pk2(o[2], o[3]); ov[2] = pk2(o[4], o[5]); ov[3] = pk2(o[6], o[7]);
    *(u32x4*)(HF + (size_t)row * DFF + col) = ov;
  }
}

constexpr int NPH = 21;
DI void run_phase(const Params& p, int ph, char* lds) {
#ifndef ONLY
  if (ph == 0) { phase0(p, lds); return; }
#else
  if (ph == 0) return;
#endif
  const int l = (ph - 1) / 10, s = (ph - 1) % 10;
#ifdef ONLY
  if (s != ONLY) return;
#endif
  switch (s) {
    case 0: gemm_phase<EPI_IN>(p, l, (const bf16_t*)(p.ws + W_AB), D, (const bf16_t*)(p.ws + W_WIN) + (size_t)l * NIN * D, D, NIN / 256, lds); break;
    case 1: qkconv_phase(p, l); gif_phase(p, l); break;
    case 2: mixer_phase(p, l, lds, l, false); break;
    case 3: merge_phase(p); break;
    case 4: gemm_phase<EPI_OUT>(p, l, (const bf16_t*)(p.ws + W_AB), D, (const bf16_t*)(p.ws + W_WOUT) + (size_t)l * D * D, D, D / 256, lds); break;
    case 5: ln_phase(p, p.in[17] + l * D, p.in[18] + l * D, false); break;
    case 6: gemm_phase<EPI_UP>(p, l, (const bf16_t*)(p.ws + W_AB), D, (const bf16_t*)(p.ws + W_WUP) + (size_t)l * NUP * D, D, NUP / 256, lds); break;
    case 7: ffnconv_phase(p, l); break;
    case 8: gemm_phase<EPI_DOWN>(p, l, (const bf16_t*)(p.ws + W_Z + (size_t)M * NUP * 2), DFF, (const bf16_t*)(p.ws + W_WDN) + (size_t)l * D * DFF, DFF, D / 256, lds); break;
    case 9: ln_phase(p, p.in[23] + l * D, p.in[24] + l * D, l == 1); break;
  }
}

__global__ void __launch_bounds__(NTH) mega(Params p, int ph_lo, int ph_hi) {
  extern __shared__ __attribute__((aligned(16))) char lds[];
#if MULTI_LAUNCH
  for (int ph = ph_lo; ph < ph_hi; ++ph) run_phase(p, ph, lds);
#else
  cg::grid_group grid = cg::this_grid();
  phase0(p, lds);
  grid.sync();
  for (int l = 0; l < 2; ++l) {
    gemm_phase<EPI_IN>(p, l, (const bf16_t*)(p.ws + W_AB), D, (const bf16_t*)(p.ws + W_WIN) + (size_t)l * NIN * D, D, NIN / 256, lds);
    grid.sync();
#ifdef PROBE_GIN2
    gemm_phase<EPI_IN>(p, l, (const bf16_t*)(p.ws + W_AB), D, (const bf16_t*)(p.ws + W_WIN) + (size_t)l * NIN * D, D, NIN / 256, lds);
    grid.sync();
#endif
    qkconv_phase(p, l); gif_phase(p, l);
    grid.sync();
    mixer_phase(p, l, lds, l, false);
    grid.sync();
#ifdef PROBE_ML2
    mixer_phase(p, l, lds, l + 2, true);
    grid.sync();
#endif
#ifdef PROBE_MIX2
    mixer_phase(p, l, lds, l + 2, false);
    grid.sync();
#endif
    merge_phase(p);
    grid.sync();
    gemm_phase<EPI_OUT>(p, l, (const bf16_t*)(p.ws + W_AB), D, (const bf16_t*)(p.ws + W_WOUT) + (size_t)l * D * D, D, D / 256, lds);
    grid.sync();
    ln_phase(p, p.in[17] + l * D, p.in[18] + l * D, false);
    grid.sync();
    gemm_phase<EPI_UP>(p, l, (const bf16_t*)(p.ws + W_AB), D, (const bf16_t*)(p.ws + W_WUP) + (size_t)l * NUP * D, D, NUP / 256, lds);
    grid.sync();
    ffnconv_phase(p, l);
    grid.sync();
    gemm_phase<EPI_DOWN>(p, l, (const bf16_t*)(p.ws + W_Z + (size_t)M * NUP * 2), DFF, (const bf16_t*)(p.ws + W_WDN) + (size_t)l * D * DFF, DFF, D / 256, lds);
    grid.sync();
    ln_phase(p, p.in[23] + l * D, p.in[24] + l * D, l == 1);
    if (l == 0) grid.sync();
  }
#endif
}

extern "C" void kernel_launch(void* const* d_in, const int* in_sizes, int n_in, void* d_out, int out_size, void* d_ws, size_t ws_size, hipStream_t stream) {
  static int grid = 0;
  if (grid == 0) {
    if (n_in != 25 || (size_t)out_size != O_END || ws_size < W_END) { fprintf(stderr, "kernel_launch: unexpected sizes n_in %d out %d (want %zu) ws %zu (want %zu)\n", n_in, out_size, (size_t)O_END, ws_size, (size_t)W_END); grid = -1; return; }
    int dev = 0, cus = 0, per_cu = 0;
    hipGetDevice(&dev);
    hipDeviceGetAttribute(&cus, hipDeviceAttributeMultiprocessorCount, dev);
    if (hipFuncSetAttribute((const void*)mega, hipFuncAttributeMaxDynamicSharedMemorySize, LDS_BYTES) != hipSuccess) { fprintf(stderr, "hipFuncSetAttribute failed\n"); grid = -1; return; }
    hipOccupancyMaxActiveBlocksPerMultiprocessor(&per_cu, (const void*)mega, NTH, LDS_BYTES);
    if (per_cu < 1) per_cu = 1;
    grid = cus * 1;
    (void)hipGetLastError();
  }
  if (grid < 0) return;
  Params p{};
  for (int i = 0; i < 25; ++i) p.in[i] = (const float*)d_in[i];
  p.out = (float*)d_out; p.ws = (unsigned char*)d_ws;
#if MULTI_LAUNCH
  for (int ph = 0; ph < NPH; ++ph) hipLaunchKernelGGL(mega, dim3(grid), dim3(NTH), LDS_BYTES, stream, p, ph, ph + 1);
#else
  int lo = 0, hi = NPH;
  void* args[] = {&p, &lo, &hi};
  hipError_t e = hipLaunchCooperativeKernel((const void*)mega, dim3(grid), dim3(NTH), args, LDS_BYTES, stream);
  if (e != hipSuccess) fprintf(stderr, "cooperative launch failed: %s (grid %d)\n", hipGetErrorString(e), grid);
#endif
}
```

```cpp
#include <hip/hip_runtime.h>
#include <hip/hip_cooperative_groups.h>
#include <cstdio>
namespace cg = cooperative_groups;

#ifndef MULTI_LAUNCH
#define MULTI_LAUNCH 0
#endif

typedef unsigned short bf16_t;
typedef short bf16x8 __attribute__((ext_vector_type(8)));
typedef short s16x4 __attribute__((ext_vector_type(4)));
typedef float f32x16 __attribute__((ext_vector_type(16)));
typedef float f32x4 __attribute__((ext_vector_type(4)));
typedef unsigned u32x4 __attribute__((ext_vector_type(4)));
typedef unsigned u32x2 __attribute__((ext_vector_type(2)));
#define DI __device__ __forceinline__
#define MFMA32(a, b, c) __builtin_amdgcn_mfma_f32_32x32x16_bf16((a), (b), (c), 0, 0, 0)

constexpr int NTH = 512;
constexpr int D = 1024, SEQ = 8192, NB = 4, MP = NB * SEQ, MS = 128, M = MP + MS, NTM = 129;
constexpr int DIN = 9224, NIN = 9216, DFF = 2816, NUP = 5632;
constexpr int PAST = 4096, NKS = PAST + 16;
constexpr float ALPHA = 1.4142135623730951f;
constexpr float LN_EPS = 1e-5f;
constexpr float LOG2E = 1.4426950408889634f;

constexpr size_t O_YP = 0;
constexpr size_t O_YS = O_YP + (size_t)MP * D;
constexpr size_t O_KP = O_YS + (size_t)MS * D;
constexpr size_t O_VP = O_KP + (size_t)2 * MP * 1024;
constexpr size_t O_MCP = O_VP + (size_t)2 * MP * 1024;
constexpr size_t O_CP = O_MCP + (size_t)2 * 4 * 3 * 2048;
constexpr size_t O_NP = O_CP + (size_t)2 * 4 * 4 * 65536;
constexpr size_t O_MPP = O_NP + (size_t)2 * 4 * 4 * 256;
constexpr size_t O_FCP = O_MPP + 32;
constexpr size_t O_KS = O_FCP + (size_t)2 * 4 * 2 * NUP;
constexpr size_t O_VS = O_KS + (size_t)2 * MS * 1024;
constexpr size_t O_MCS = O_VS + (size_t)2 * MS * 1024;
constexpr size_t O_CS = O_MCS + (size_t)2 * 8 * 3 * 2048;
constexpr size_t O_NS = O_CS + (size_t)2 * 8 * 4 * 65536;
constexpr size_t O_MSS = O_NS + (size_t)2 * 8 * 4 * 256;
constexpr size_t O_FCS = O_MSS + 64;
constexpr size_t O_END = O_FCS + (size_t)2 * 8 * 2 * NUP;

constexpr size_t W_Z = 0;
constexpr size_t W_H = W_Z + (size_t)M * NIN * 2;
constexpr size_t W_AB = W_H + (size_t)M * D * 2;
constexpr size_t W_KA = W_AB + (size_t)M * D * 2;
constexpr size_t W_R = W_KA + (size_t)M * D * 2;
constexpr size_t W_WIN = W_R + (size_t)M * D * 4;
constexpr size_t W_WOUT = W_WIN + (size_t)2 * NIN * D * 2;
constexpr size_t W_WUP = W_WOUT + (size_t)2 * D * D * 2;
constexpr size_t W_WDN = W_WUP + (size_t)2 * NUP * D * 2;
constexpr size_t W_GIF = W_WDN + (size_t)2 * D * DFF * 2;
constexpr size_t W_ROPE = W_GIF + (size_t)M * 8 * 4;
constexpr size_t W_MISC = W_ROPE + (size_t)8192 * 32 * 8;
constexpr size_t W_END = W_MISC + 4096;

struct Params {
  const float* in[25];
  float* out;
  unsigned char* ws;
};

DI unsigned f2bf(float x) { unsigned u = __float_as_uint(x); u += 0x7fffu + ((u >> 16) & 1u); return u >> 16; }
typedef __bf16 bf16v2 __attribute__((ext_vector_type(2)));
typedef float f32x2 __attribute__((ext_vector_type(2)));
DI unsigned pk2(float a, float b) { f32x2 v; v[0] = a; v[1] = b; return __builtin_bit_cast(unsigned, __builtin_convertvector(v, bf16v2)); }
DI float bflo(unsigned u) { return __uint_as_float(u << 16); }
DI float bfhi(unsigned u) { return __uint_as_float(u & 0xffff0000u); }
DI float sigmoidf_(float x) { return 1.f / (1.f + __expf(-x)); }
DI float wave_sum(float v) {
#pragma unroll
  for (int o = 1; o < 64; o <<= 1) v += __shfl_xor(v, o);
  return v;
}
DI int crow(int i, int h) { return (i & 3) + 8 * (i >> 2) + 4 * h; }
DI bf16x8 pack8(const f32x16& x, int s) {
  u32x4 p;
  p[0] = pk2(x[8 * s + 0], x[8 * s + 1]); p[1] = pk2(x[8 * s + 2], x[8 * s + 3]);
  p[2] = pk2(x[8 * s + 4], x[8 * s + 5]); p[3] = pk2(x[8 * s + 6], x[8 * s + 7]);
  return __builtin_bit_cast(bf16x8, p);
}
DI void unpack8(u32x4 v, float* f) {
  f[0] = bflo(v[0]); f[1] = bfhi(v[0]); f[2] = bflo(v[1]); f[3] = bfhi(v[1]);
  f[4] = bflo(v[2]); f[5] = bfhi(v[2]); f[6] = bflo(v[3]); f[7] = bfhi(v[3]);
}
DI bf16x8 tr_frag(unsigned a_lo, unsigned a_hi) {
  s16x4 lo, hi;
  asm volatile("ds_read_b64_tr_b16 %0, %2\n\tds_read_b64_tr_b16 %1, %3\n\ts_waitcnt lgkmcnt(0)"
               : "=&v"(lo), "=&v"(hi) : "v"(a_lo), "v"(a_hi) : "memory");
  return __builtin_shufflevector(lo, hi, 0, 1, 2, 3, 4, 5, 6, 7);
}
template <int STEP, int HIOFF>
DI void tr_frag4(unsigned a, bf16x8 (&f)[4]) {
  s16x4 l0, h0, l1, h1, l2, h2, l3, h3;
  asm volatile(
      "ds_read_b64_tr_b16 %0, %8 offset:%9\n\tds_read_b64_tr_b16 %1, %8 offset:%10\n\t"
      "ds_read_b64_tr_b16 %2, %8 offset:%11\n\tds_read_b64_tr_b16 %3, %8 offset:%12\n\t"
      "ds_read_b64_tr_b16 %4, %8 offset:%13\n\tds_read_b64_tr_b16 %5, %8 offset:%14\n\t"
      "ds_read_b64_tr_b16 %6, %8 offset:%15\n\tds_read_b64_tr_b16 %7, %8 offset:%16\n\t"
      "s_waitcnt lgkmcnt(0)"
      : "=&v"(l0), "=&v"(h0), "=&v"(l1), "=&v"(h1), "=&v"(l2), "=&v"(h2), "=&v"(l3), "=&v"(h3)
      : "v"(a), "i"(0), "i"(HIOFF), "i"(STEP), "i"(STEP + HIOFF), "i"(2 * STEP), "i"(2 * STEP + HIOFF), "i"(3 * STEP), "i"(3 * STEP + HIOFF)
      : "memory");
  f[0] = __builtin_shufflevector(l0, h0, 0, 1, 2, 3, 4, 5, 6, 7);
  f[1] = __builtin_shufflevector(l1, h1, 0, 1, 2, 3, 4, 5, 6, 7);
  f[2] = __builtin_shufflevector(l2, h2, 0, 1, 2, 3, 4, 5, 6, 7);
  f[3] = __builtin_shufflevector(l3, h3, 0, 1, 2, 3, 4, 5, 6, 7);
}
DI int otid() { int t = threadIdx.x; asm volatile("" : "+v"(t)); return t; }
DI int uni(int v) { return __builtin_amdgcn_readfirstlane(v); }
DI unsigned lds_addr(const void* p) { return (unsigned)(size_t)p; }

DI const float* xrow_ptr(const Params& p, int l, int row) {
  if (l == 0) return row < MP ? p.in[0] + (size_t)row * D : p.in[1] + (size_t)(row - MP) * D;
  return (const float*)(p.ws + W_R) + (size_t)row * D;
}

DI void transpose_w(const float* W, int K, int N, int src_ld, bf16_t* WT, bool remap, char* lds) {
  float* scr = (float*)lds;
  const int nkb = K / 64, nnb = N / 64, tid = otid();
  for (int it = blockIdx.x; it < nkb * nnb; it += gridDim.x) {
    const int kb = it / nnb, nb = it % nnb, k0 = kb * 64, n0 = nb * 64;
    const int ns = (remap && n0 >= 7168) ? n0 + 8 : n0;
#pragma unroll
    for (int i = 0; i < 8; ++i) {
      const int kk = (tid >> 6) + 8 * i, nn = tid & 63;
      scr[kk * 65 + nn] = W[(size_t)(k0 + kk) * src_ld + ns + nn];
    }
    __syncthreads();
    {
      const int n = tid >> 3, c = tid & 7;
      const float* s = scr + (8 * c) * 65 + n;
      u32x4 o;
      o[0] = pk2(s[0], s[65]); o[1] = pk2(s[2 * 65], s[3 * 65]); o[2] = pk2(s[4 * 65], s[5 * 65]); o[3] = pk2(s[6 * 65], s[7 * 65]);
      const int nd = (remap && n0 < 2048) ? ((n < 32) ? 2 * n : 2 * (n - 32) + 1) : n;
      *(u32x4*)(WT + (size_t)(n0 + nd) * K + k0 + 8 * c) = o;
    }
    __syncthreads();
  }
}

DI void phase0(const Params& p, char* lds) {
  const int tid = otid();
  for (int l = 0; l < 2; ++l) {
    transpose_w(p.in[9] + (size_t)l * D * DIN, D, NIN, DIN, (bf16_t*)(p.ws + W_WIN) + (size_t)l * NIN * D, true, lds);
    transpose_w(p.in[16] + (size_t)l * D * D, D, D, D, (bf16_t*)(p.ws + W_WOUT) + (size_t)l * D * D, false, lds);
    transpose_w(p.in[19] + (size_t)l * D * NUP, D, NUP, NUP, (bf16_t*)(p.ws + W_WUP) + (size_t)l * NUP * D, false, lds);
    transpose_w(p.in[22] + (size_t)l * DFF * D, DFF, D, D, (bf16_t*)(p.ws + W_WDN) + (size_t)l * D * DFF, false, lds);
  }
  bf16_t* ab = (bf16_t*)(p.ws + W_AB);
  for (size_t c = (size_t)blockIdx.x * NTH + tid; c < (size_t)M * 128; c += (size_t)gridDim.x * NTH) {
    const int row = (int)(c >> 7), cc = (int)(c & 127);
    const float* src = xrow_ptr(p, 0, row) + cc * 8;
    f32x4 a = *(const f32x4*)src, b = *(const f32x4*)(src + 4);
    u32x4 o; o[0] = pk2(a[0], a[1]); o[1] = pk2(a[2], a[3]); o[2] = pk2(b[0], b[1]); o[3] = pk2(b[2], b[3]);
    *(u32x4*)(ab + (size_t)row * D + cc * 8) = o;
  }
  float2* rope = (float2*)(p.ws + W_ROPE);
  for (int i = blockIdx.x * NTH + tid; i < 8192 * 32; i += gridDim.x * NTH) {
    const int pos = i >> 5, d = i & 31;
    const double inv = exp2(-(double)d * (13.287712379549449 / 32.0));
    double ang = (double)pos * inv;
    const double twopi = 6.283185307179586476925;
    ang -= twopi * rint(ang / twopi);
    float s, c; sincosf((float)ang, &s, &c);
    rope[i] = make_float2(c, s);
  }
  if (blockIdx.x == 0 && tid < 128) {
    const int l = tid >> 6, ln = tid & 63;
    const float* lp = p.in[13] + (size_t)l * 4 * 64;
    const float s1 = wave_sum(lp[ln] * lp[64 + ln]), s2 = wave_sum(lp[128 + ln] * lp[192 + ln]);
    const float lam_init = (l == 0) ? 0.2f : (0.8f - 0.6f * 0.74081822068171788f);
    if (ln == 0) ((float*)(p.ws + W_MISC))[l] = __expf(s1) - __expf(s2) + lam_init;
  }
  if (blockIdx.x == 0 && tid < 8) ((unsigned*)(p.ws + W_MISC))[16 + tid] = 0u;
}

namespace pg8 {
#define PG8_LAS __attribute__((address_space(3)))
typedef unsigned short bf16_t;
typedef short bf16x8 __attribute__((ext_vector_type(8)));
typedef float f32x4 __attribute__((ext_vector_type(4)));
typedef unsigned u32x4 __attribute__((ext_vector_type(4)));
constexpr int BM = 256, BK = 64, HALF = 128, HTB = HALF * BK * 2  , STAGE_BYTES = 8 * HTB, NXCD = 8, WGM = 8;

__host__ __device__ __forceinline__ int lds_byte(int r, int c) { const int st = (r >> 4) * 2 + (c >> 5), rr = r & 15, cc = c & 31, ob = rr * 64 + cc * 2; return st * 1024 + (ob ^ (((ob >> 9) & 1) << 5)); }
__host__ __device__ __forceinline__ void stage_rc(int b, int& R, int& C) { const int st = b / 1024, sb = b % 1024, swz = sb ^ (((sb >> 9) & 1) << 5); R = (st >> 1) * 16 + swz / 64; C = (st & 1) * 32 + (swz % 64) / 2; }
__host__ __device__ __forceinline__ int perm32(int rho) { const int n = rho >> 4, i = rho & 15; return 8 * (i >> 2) + 4 * n + (i & 3); }

struct Unit { int pm, pn; };
struct Gemm { const bf16_t* A; const bf16_t* Bt; int M, N, K; };

struct StaticOrder {
    int nM, nN, nwg, G, c;
    __host__ __device__ void init(int M, int N, int G_, int c_) { nM = M / BM; nN = N / BM; nwg = nM * nN; G = G_; c = c_; }
    __host__ __device__ bool next(int i, Unit& u) const {
        const long L = (long)i * G + c; if (L >= nwg) return false;
        int wgid = (int)L; { const int q = nwg / NXCD, r = nwg % NXCD, xcd = wgid % NXCD, off = wgid / NXCD; wgid = (xcd < r ? xcd * (q + 1) : r * (q + 1) + (xcd - r) * q) + off; }
        const int nig = WGM * nN, gid = wgid / nig, fm = gid * WGM, gsz = (nM - fm) < WGM ? (nM - fm) : WGM;
        u.pm = fm + ((wgid % nig) % gsz); u.pn = (wgid % nig) / gsz; return true;
    }
    __device__ __forceinline__ void a_ready(const Unit&) const {}
    __device__ __forceinline__ void done(const Unit&) const {}
};
template <class Epi, class Sched, bool STAMP = false>
__device__ __forceinline__ void gemm_phase(PG8_LAS unsigned char* lds, const Gemm g, const Sched& S, const Epi& E, unsigned long long* stamps) {
    const int tid = otid(), wid = __builtin_amdgcn_readfirstlane(tid >> 6), lane = tid & 63, wr = wid >> 2, wc = wid & 3, fr = lane & 15, fq = lane >> 4;
    const int K = g.K, nt = K / BK;
    int ts_lo = 0, ts_hi = 0, nts = 0; const unsigned long long rt_entry = STAMP ? (unsigned long long)wall_clock64() : 0ull;
#define PG8_STAMP() do { if (STAMP && wid == 0 && nts < 64) { const unsigned long long _c = (unsigned long long)clock64(); \
        ts_lo = (lane == nts) ? (int)(unsigned)_c : ts_lo; ts_hi = (lane == nts) ? (int)(unsigned)(_c >> 32) : ts_hi; ++nts; } } while (0)
    PG8_STAMP();
    unsigned voffA[2], voffB[2];
#pragma unroll
    for (int i = 0; i < 2; ++i) { int R, C; stage_rc(tid * 16 + i * 8192, R, C); const int Rb = Epi::PERM ? ((R & ~31) + perm32(R & 31)) : R;
        voffA[i] = (unsigned)(R * K + C) * 2u; voffB[i] = (unsigned)(Rb * K + C) * 2u; }
    const size_t kstep = (size_t)(BK * 2);
    const size_t hstep = (size_t)HALF * K * 2;
    const size_t tstep = 2 * hstep;
    const unsigned ldsw = (unsigned)wid * 1024u;
    const int aoff = lds_byte(wr * 64 + fr, fq * 8), boff = lds_byte(wc * 32 + fr, fq * 8);
#define PG8_SA(b, h) (((b) * 2 + (h)) * HTB)
#define PG8_SB(b, h) ((4 + (b) * 2 + (h)) * HTB)
#define PG8_STAGE(bufoff, gbase, voff) do { _Pragma("unroll") for (int _i = 0; _i < 2; ++_i) \
        __builtin_amdgcn_global_load_lds((const unsigned*)((const char*)(gbase) + (voff)[_i]), (PG8_LAS unsigned*)(lds + (bufoff) + ldsw + _i * 8192), 16, 0, 0); } while (0)
#define PG8_LDA(dst, b, h) do { _Pragma("unroll") for (int m = 0; m < 4; ++m) _Pragma("unroll") for (int k = 0; k < 2; ++k) dst[m][k] = *(const PG8_LAS bf16x8*)(lds + PG8_SA(b, h) + aoff + m * 2048 + k * 1024); } while (0)
#define PG8_LDB(dst, b, h) do { _Pragma("unroll") for (int n = 0; n < 2; ++n) _Pragma("unroll") for (int k = 0; k < 2; ++k) dst[n][k] = *(const PG8_LAS bf16x8*)(lds + PG8_SB(b, h) + boff + n * 2048 + k * 1024); } while (0)
#define PG8_MMA(ai, bj, At, Bt) do { __builtin_amdgcn_s_setprio(1); _Pragma("unroll") for (int m = 0; m < 4; ++m) _Pragma("unroll") for (int n = 0; n < 2; ++n) _Pragma("unroll") for (int k = 0; k < 2; ++k) \
        acc[ai][bj][m][n] = __builtin_amdgcn_mfma_f32_16x16x32_bf16(Bt[n][k], At[m][k], acc[ai][bj][m][n], 0, 0, 0); __builtin_amdgcn_s_setprio(0); } while (0)
#define PG8_WAIT_V(n) asm volatile("s_waitcnt vmcnt(" #n ")" ::: "memory")
#define PG8_WAIT_L(n) asm volatile("s_waitcnt lgkmcnt(" #n ")" ::: "memory")
#define PG8_BAR __builtin_amdgcn_s_barrier()
#define PG8_SCHED __builtin_amdgcn_sched_barrier(0)
    Unit cur, nxt; int ui = 0;
    if (!S.next(0, cur)) return;
    f32x4 acc[2][2][4][2];
#pragma unroll
    for (int a = 0; a < 2; ++a)
#pragma unroll
        for (int b = 0; b < 2; ++b)
#pragma unroll
            for (int m = 0; m < 4; ++m)
#pragma unroll
                for (int n = 0; n < 2; ++n) acc[a][b][m][n] = (f32x4){0.f, 0.f, 0.f, 0.f};
    bf16x8 At[4][2], B0[2][2], B1[2][2];
    const char* cA = (const char*)g.A + (size_t)cur.pm * tstep; const char* cB = (const char*)g.Bt + (size_t)cur.pn * tstep;
    S.a_ready(cur);
    PG8_STAGE(PG8_SB(0, 0), cB, voffB); PG8_STAGE(PG8_SA(0, 0), cA, voffA); PG8_STAGE(PG8_SB(0, 1), cB + hstep, voffB); PG8_STAGE(PG8_SA(0, 1), cA + hstep, voffA);
    if (wr == 1) PG8_BAR;
    PG8_WAIT_V(4); PG8_BAR;
    PG8_STAGE(PG8_SB(1, 0), cB + kstep, voffB); PG8_STAGE(PG8_SA(1, 0), cA + kstep, voffA); PG8_STAGE(PG8_SB(1, 1), cB + hstep + kstep, voffB);
    PG8_WAIT_V(6); PG8_BAR;
    PG8_STAMP();
    for (;;) {
        const bool has_next = S.next(ui + 1, nxt);
        const char* nA = has_next ? (const char*)g.A + (size_t)nxt.pm * tstep : cA; const char* nB = has_next ? (const char*)g.Bt + (size_t)nxt.pn * tstep : cB;
        for (int t = 0; t < nt; t += 2) {
            const bool last = (t == nt - 2);
            const char* a1 = cA + (size_t)(t + 1) * kstep;
            const char* a2 = last ? nA : cA + (size_t)(t + 2) * kstep; const char* b2 = last ? nB : cB + (size_t)(t + 2) * kstep;
            const char* a3 = a2 + kstep; const char* b3 = b2 + kstep;
            if (last && has_next) S.a_ready(nxt);
            PG8_LDB(B0, 0, 0); PG8_SCHED; PG8_LDA(At, 0, 0); PG8_STAGE(PG8_SA(1, 1), a1 + hstep, voffA);
            PG8_WAIT_L(8); PG8_BAR; PG8_WAIT_L(0); PG8_MMA(0, 0, At, B0); PG8_BAR; PG8_SCHED;
            PG8_LDB(B1, 0, 1); PG8_STAGE(PG8_SB(0, 0), b2, voffB);
            PG8_BAR; PG8_WAIT_L(0); PG8_MMA(0, 1, At, B1); PG8_BAR;
            PG8_LDA(At, 0, 1); PG8_STAGE(PG8_SA(0, 0), a2, voffA);
            PG8_BAR; PG8_WAIT_L(0); PG8_MMA(1, 0, At, B0); PG8_BAR; PG8_SCHED;
            PG8_STAGE(PG8_SB(0, 1), b2 + hstep, voffB);
            PG8_WAIT_V(6); PG8_BAR; PG8_MMA(1, 1, At, B1); PG8_BAR;
            PG8_LDB(B0, 1, 0); PG8_SCHED; PG8_LDA(At, 1, 0); PG8_STAGE(PG8_SA(0, 1), a2 + hstep, voffA);
            PG8_WAIT_L(8); PG8_BAR; PG8_WAIT_L(0); PG8_MMA(0, 0, At, B0); PG8_BAR; PG8_SCHED;
            PG8_LDB(B1, 1, 1); PG8_STAGE(PG8_SB(1, 0), b3, voffB);
            PG8_BAR; PG8_WAIT_L(0); PG8_MMA(0, 1, At, B1); PG8_BAR;
            PG8_LDA(At, 1, 1); PG8_STAGE(PG8_SA(1, 0), a3, voffA);
            PG8_BAR; PG8_WAIT_L(0); PG8_MMA(1, 0, At, B0); PG8_BAR; PG8_SCHED;
            PG8_STAGE(PG8_SB(1, 1), b3 + hstep, voffB);
            PG8_WAIT_V(6); PG8_BAR; PG8_MMA(1, 1, At, B1); PG8_BAR;
        }
        PG8_STAMP();
        if constexpr (!Epi::AFTER_DRAIN) { E(acc, cur, wr, wc, fr, fq); S.done(cur); }
        PG8_STAMP();
        if (!has_next) break;
#pragma unroll
        for (int a = 0; a < 2; ++a)
#pragma unroll
            for (int b = 0; b < 2; ++b)
#pragma unroll
                for (int m = 0; m < 4; ++m)
#pragma unroll
                    for (int n = 0; n < 2; ++n) acc[a][b][m][n] = (f32x4){0.f, 0.f, 0.f, 0.f};
        cur = nxt; cA = nA; cB = nB; ++ui;
    }
    PG8_WAIT_V(0);
    if (wr == 0) PG8_BAR;
    PG8_BAR;
    if constexpr (Epi::AFTER_DRAIN) { E.fused(acc, cur, wr, wc, fr, fq, lds, wid, lane); S.done(cur); }
    PG8_STAMP();
    if (STAMP && wid == 0) { stamps[lane] = lane < nts ? (((unsigned long long)(unsigned)ts_hi << 32) | (unsigned)ts_lo) : 0ull;
        if (lane == 62) stamps[62] = rt_entry; if (lane == 63) stamps[63] = (unsigned long long)wall_clock64(); }
#undef PG8_STAMP
#undef PG8_SA
#undef PG8_SB
#undef PG8_STAGE
#undef PG8_LDA
#undef PG8_LDB
#undef PG8_MMA
#undef PG8_WAIT_V
#undef PG8_WAIT_L
#undef PG8_BAR
#undef PG8_SCHED
}
}

enum { EPI_IN = 0, EPI_OUT = 1, EPI_UP = 2, EPI_DOWN = 3 };
template <int MODE>
struct Epi {
  static constexpr bool PERM = true, AFTER_DRAIN = false;
  Params p; int l;
  DI void operator()(const f32x4 (&acc)[2][2][4][2], const pg8::Unit& u, int wr, int wc, int fr, int fq) const {
    const int colb = u.pn * 256 + wc * 32 + 8 * fq;
#pragma unroll
    for (int ai = 0; ai < 2; ++ai)
#pragma unroll
      for (int m = 0; m < 4; ++m) {
        const int row = u.pm * 256 + ai * 128 + wr * 64 + m * 16 + fr;
        if (row < M) {
#pragma unroll
          for (int bj = 0; bj < 2; ++bj) {
            const int col = colb + bj * 128;
            const f32x4 v0 = acc[ai][bj][m][0], v1 = acc[ai][bj][m][1];
            if (MODE == EPI_IN) {
              bf16_t* Z = (bf16_t*)(p.ws + W_Z);
              const int seg = u.pn >> 2;
              if (seg <= 1) {
                const int pos = row < MP ? (row & (SEQ - 1)) : PAST + ((row - MP) & 15);
                const int d0 = (col & 63) >> 1;
                const f32x4* rp = (const f32x4*)((const float2*)(p.ws + W_ROPE) + pos * 32 + d0);
                const f32x4 c01 = rp[0], c23 = rp[1];
                const float a0 = v0[0] * c01[0] - v0[1] * c01[1], b0 = v0[1] * c01[0] + v0[0] * c01[1];
                const float a1 = v0[2] * c01[2] - v0[3] * c01[3], b1 = v0[3] * c01[2] + v0[2] * c01[3];
                const float a2 = v1[0] * c23[0] - v1[1] * c23[1], b2 = v1[1] * c23[0] + v1[0] * c23[1];
                const float a3 = v1[2] * c23[2] - v1[3] * c23[3], b3 = v1[3] * c23[2] + v1[2] * c23[3];
                const float qs = seg == 0 ? 0.125f : 1.f;
                u32x4 o; o[0] = pk2(a0 * qs, b0 * qs); o[1] = pk2(a1 * qs, b1 * qs); o[2] = pk2(a2 * qs, b2 * qs); o[3] = pk2(a3 * qs, b3 * qs);
                *(u32x4*)(Z + (size_t)row * NIN + col) = o;
                if (seg == 1) {
                  float* ob = (row < MP ? p.out + O_KP + ((size_t)l * MP + row) * 1024 : p.out + O_KS + ((size_t)l * MS + row - MP) * 1024) + ((col - 1024) & ~63) + d0;
                  f32x4 o1, o2; o1[0] = a0; o1[1] = a1; o1[2] = a2; o1[3] = a3; o2[0] = b0; o2[1] = b1; o2[2] = b2; o2[3] = b3;
                  *(f32x4*)ob = o1; *(f32x4*)(ob + 32) = o2;
                }
              } else {
                u32x4 o; o[0] = pk2(v0[0], v0[1]); o[1] = pk2(v0[2], v0[3]); o[2] = pk2(v1[0], v1[1]); o[3] = pk2(v1[2], v1[3]);
                *(u32x4*)(Z + (size_t)row * NIN + col) = o;
                if (seg == 2) {
                  float* ob = (row < MP ? p.out + O_VP + ((size_t)l * MP + row) * 1024 : p.out + O_VS + ((size_t)l * MS + row - MP) * 1024) + (col - 2048);
                  *(f32x4*)ob = v0; *(f32x4*)(ob + 4) = v1;
                } else if (seg == 3 || seg == 4) {
                  float* ob = nullptr;
                  if (row < MP) { const int s = row & (SEQ - 1); if (s >= SEQ - 3) ob = p.out + O_MCP + ((size_t)(l * 4 + (row >> 13)) * 3 + (s - (SEQ - 3))) * 2048 + col - 3072; }
                  else { const int t = (row - MP) & 15, b = (row - MP) >> 4; if (t >= 13) ob = p.out + O_MCS + ((size_t)(l * 8 + b) * 3 + (t - 13)) * 2048 + col - 3072; }
                  if (ob) { *(f32x4*)ob = v0; *(f32x4*)(ob + 4) = v1; }
                }
              }
            } else if (MODE == EPI_OUT || MODE == EPI_DOWN) {
              float* R = (float*)(p.ws + W_R) + (size_t)row * D + col;
              const float* rs = MODE == EPI_OUT ? xrow_ptr(p, l, row) + col : R;
              const f32x4 r0 = *(const f32x4*)rs, r1 = *(const f32x4*)(rs + 4);
              *(f32x4*)R = r0 * ALPHA + v0; *(f32x4*)(R + 4) = r1 * ALPHA + v1;
            } else {
              bf16_t* U = (bf16_t*)(p.ws + W_Z);
              u32x4 o; o[0] = pk2(v0[0], v0[1]); o[1] = pk2(v0[2], v0[3]); o[2] = pk2(v1[0], v1[1]); o[3] = pk2(v1[2], v1[3]);
              *(u32x4*)(U + (size_t)row * NUP + col) = o;
              float* ob = nullptr;
              if (row < MP) { const int s = row & (SEQ - 1); if (s >= SEQ - 2) ob = p.out + O_FCP + ((size_t)(l * 4 + (row >> 13)) * 2 + (s - (SEQ - 2))) * NUP + col; }
              else { const int t = (row - MP) & 15, b = (row - MP) >> 4; if (t >= 14) ob = p.out + O_FCS + ((size_t)(l * 8 + b) * 2 + (t - 14)) * NUP + col; }
              if (ob) { *(f32x4*)ob = v0; *(f32x4*)(ob + 4) = v1; }
            }
          }
        }
      }
  }
};

template <int MODE>
DI void gemm_phase(const Params& p, int l, const bf16_t* A, int lda, const bf16_t* Bt, int K, int ntn, char* lds) {
  (void)lda;
  pg8::Gemm g; g.A = A; g.Bt = Bt; g.M = NTM * 256; g.N = ntn * 256; g.K = K;
  pg8::StaticOrder S; S.init(g.M, g.N, (int)gridDim.x, (int)blockIdx.x);
  Epi<MODE> E; E.p = p; E.l = l;
  pg8::gemm_phase<Epi<MODE>, pg8::StaticOrder, false>((PG8_LAS unsigned char*)lds, g, S, E, nullptr);
  __syncthreads();
}

DI void gif_phase(const Params& p, int l) {
  const int tidq = otid(); const int lane = tidq & 63, gw = blockIdx.x * 8 + (tidq >> 6), ngw = gridDim.x * 8;
  const float* w = p.in[9] + (size_t)l * D * DIN + 7168;
  const float* bif = p.in[10] + l * 8;
  float* gif = (float*)(p.ws + W_GIF);
  for (int rg = gw; rg < M / 4; rg += ngw) {
    float acc[4][8];
#pragma unroll
    for (int a = 0; a < 4; ++a)
#pragma unroll
      for (int j = 0; j < 8; ++j) acc[a][j] = 0.f;
    const float* x0 = xrow_ptr(p, l, rg * 4);
#pragma unroll 2
    for (int kk = 0; kk < 16; ++kk) {
      const int k = kk * 64 + lane;
      const f32x4 w0 = *(const f32x4*)(w + (size_t)k * DIN), w1 = *(const f32x4*)(w + (size_t)k * DIN + 4);
#pragma unroll
      for (int a = 0; a < 4; ++a) {
        const float xv = x0[(size_t)a * D + k];
        acc[a][0] += xv * w0[0]; acc[a][1] += xv * w0[1]; acc[a][2] += xv * w0[2]; acc[a][3] += xv * w0[3];
        acc[a][4] += xv * w1[0]; acc[a][5] += xv * w1[1]; acc[a][6] += xv * w1[2]; acc[a][7] += xv * w1[3];
      }
    }
#pragma unroll
    for (int a = 0; a < 4; ++a)
#pragma unroll
      for (int j = 0; j < 8; ++j) {
        const float s = wave_sum(acc[a][j]);
        if (lane == 0) gif[(size_t)(rg * 4 + a) * 8 + j] = s + bif[j];
      }
  }
}

DI void qkconv_phase(const Params& p, int l) {
  const bf16_t* Z = (const bf16_t*)(p.ws + W_Z);
  bf16_t* QA = (bf16_t*)(p.ws + W_AB); bf16_t* KA = (bf16_t*)(p.ws + W_KA);
  const float* cw = p.in[11] + (size_t)l * 4 * 2048; const float* cb = p.in[12] + (size_t)l * 2048;
  const size_t total = (size_t)(M / 4) * 256;
  for (size_t it = (size_t)blockIdx.x * NTH + otid(); it < total; it += (size_t)gridDim.x * NTH) {
    const int cc = (int)(it & 255), rg = (int)(it >> 8), col = cc * 8, row0 = rg * 4;
    int t0, hist_rows;
    const float* st = nullptr;
    if (row0 < MP) { t0 = row0 & (SEQ - 1); }
    else { t0 = (row0 - MP) & 15; st = p.in[4] + ((size_t)(l * 8 + ((row0 - MP) >> 4)) * 3) * 2048 + col; }
    (void)hist_rows;
    float w[4][8], bias[8];
#pragma unroll
    for (int j = 0; j < 4; ++j) { f32x4 a = *(const f32x4*)(cw + j * 2048 + col), b = *(const f32x4*)(cw + j * 2048 + col + 4);
      w[j][0] = a[0]; w[j][1] = a[1]; w[j][2] = a[2]; w[j][3] = a[3]; w[j][4] = b[0]; w[j][5] = b[1]; w[j][6] = b[2]; w[j][7] = b[3]; }
    { f32x4 a = *(const f32x4*)(cb + col), b = *(const f32x4*)(cb + col + 4);
      bias[0] = a[0]; bias[1] = a[1]; bias[2] = a[2]; bias[3] = a[3]; bias[4] = b[0]; bias[5] = b[1]; bias[6] = b[2]; bias[7] = b[3]; }
    float x[7][8];
#pragma unroll
    for (int j = 0; j < 7; ++j) {
      const int t = t0 - 3 + j;
      if (t >= 0) { u32x4 v = *(const u32x4*)(Z + (size_t)(row0 - 3 + j) * NIN + 3072 + col); unpack8(v, x[j]); }
      else if (st) { f32x4 a = *(const f32x4*)(st + (size_t)(3 + t) * 2048), b = *(const f32x4*)(st + (size_t)(3 + t) * 2048 + 4);
        x[j][0] = a[0]; x[j][1] = a[1]; x[j][2] = a[2]; x[j][3] = a[3]; x[j][4] = b[0]; x[j][5] = b[1]; x[j][6] = b[2]; x[j][7] = b[3]; }
      else {
#pragma unroll
        for (int e = 0; e < 8; ++e) x[j][e] = 0.f; }
    }
    const float sc = col >= 1024 ? 0.0625f : 1.f;
    bf16_t* dst = col >= 1024 ? KA + (col - 1024) : QA + col;
#pragma unroll
    for (int a = 0; a < 4; ++a) {
      float o[8];
#pragma unroll
      for (int e = 0; e < 8; ++e) {
        float u = bias[e] + w[0][e] * x[a][e] + w[1][e] * x[a + 1][e] + w[2][e] * x[a + 2][e] + w[3][e] * x[a + 3][e];
        o[e] = u * sigmoidf_(u) * sc;
      }
      u32x4 ov; ov[0] = pk2(o[0], o[1]); ov[1] = pk2(o[2], o[3]); ov[2] = pk2(o[4], o[5]); ov[3] = pk2(o[6], o[7]);
      *(u32x4*)(dst + (size_t)(row0 + a) * D) = ov;
    }
  }
}

constexpr int A_LD = 272;
constexpr int A_TILE = 64 * A_LD;
template <int KIND>
DI void attn_item(const Params& p, int l, int b, int ha, int qb, char* lds) {
  const int tid = otid(), lane = tid & 63, wave = uni(tid >> 6);
  const int map = wave >> 2, qt = wave & 3, r = lane & 31, h = lane >> 5;
  const bf16_t* Z = (const bf16_t*)(p.ws + W_Z);
  const int NT = KIND == 0 ? 2 * (qb + 1) : (NKS + 63) / 64;
  const int ntw = KIND == 0 ? 2 * qb + (qt >> 1) + 1 : NT;
  const bool active = KIND == 0 ? true : (qt == 0);
  int qrow;
  if (KIND == 0) qrow = b * SEQ + qb * 128 + qt * 32 + r; else qrow = MP + b * 16 + (r < 16 ? r : 15);
  bf16x8 qf[4];
#pragma unroll
  for (int ks = 0; ks < 4; ++ks) {
    if (KIND == 0) qf[ks] = *(const bf16x8*)(Z + (size_t)qrow * NIN + ha * 128 + map * 64 + ks * 16 + h * 8);
    else {
      const int dn = ks * 16 + h * 8, par = dn >> 5, dd = dn & 31;
      const bf16_t* src = Z + (size_t)qrow * NIN + ha * 128 + map * 64 + 2 * dd;
      const u32x4 lo = *(const u32x4*)src, hi = *(const u32x4*)(src + 8);
      unsigned e[8];
#pragma unroll
      for (int i = 0; i < 4; ++i) { e[i] = par ? (lo[i] >> 16) : (lo[i] & 0xffffu); e[4 + i] = par ? (hi[i] >> 16) : (hi[i] & 0xffffu); }
      u32x4 o; o[0] = e[0] | (e[1] << 16); o[1] = e[2] | (e[3] << 16); o[2] = e[4] | (e[5] << 16); o[3] = e[6] | (e[7] << 16);
      qf[ks] = __builtin_bit_cast(bf16x8, o);
    }
  }
  const int skey = tid >> 4, part = tid & 15;
  u32x4 rk0, rk1, rv0, rv1;
  auto gload = [&](int j) {
    if (KIND == 0) {
      const bf16_t* base = Z + (size_t)(b * SEQ + j * 64 + skey) * NIN + 1024 + ha * 128 + part * 8;
      rk0 = *(const u32x4*)base; rk1 = *(const u32x4*)(base + (size_t)32 * NIN);
      rv0 = *(const u32x4*)(base + 1024); rv1 = *(const u32x4*)(base + (size_t)32 * NIN + 1024);
    } else {
#pragma unroll
      for (int i = 0; i < 2; ++i) {
        int kk = j * 64 + skey + 32 * i; if (kk > NKS - 1) kk = NKS - 1;
        const float *ks_, *vs_;
        if (kk < PAST) { const size_t o = (((size_t)(l * 8 + b) * PAST + kk) * 8 + ha) * 128 + part * 8; ks_ = p.in[2] + o; vs_ = p.in[3] + o; }
        else { const size_t o = (((size_t)l * MS + b * 16 + (kk - PAST)) * 8 + ha) * 128 + part * 8; ks_ = p.out + O_KS + o; vs_ = p.out + O_VS + o; }
        const f32x4 a0 = *(const f32x4*)ks_, a1 = *(const f32x4*)(ks_ + 4), c0 = *(const f32x4*)vs_, c1 = *(const f32x4*)(vs_ + 4);
        u32x4 ko, vo;
        ko[0] = pk2(a0[0], a0[1]); ko[1] = pk2(a0[2], a0[3]); ko[2] = pk2(a1[0], a1[1]); ko[3] = pk2(a1[2], a1[3]);
        vo[0] = pk2(c0[0], c0[1]); vo[1] = pk2(c0[2], c0[3]); vo[2] = pk2(c1[0], c1[1]); vo[3] = pk2(c1[2], c1[3]);
        if (i == 0) { rk0 = ko; rv0 = vo; } else { rk1 = ko; rv1 = vo; }
      }
    }
  };
  auto lwrite = [&](int buf) {
    char* kb = lds + buf * (2 * A_TILE) + skey * A_LD + part * 16; char* vb = kb + A_TILE;
    *(u32x4*)kb = rk0; *(u32x4*)(kb + 32 * A_LD) = rk1; *(u32x4*)vb = rv0; *(u32x4*)(vb + 32 * A_LD) = rv1;
  };
  f32x16 O[4];
#pragma unroll
  for (int v = 0; v < 4; ++v)
#pragma unroll
    for (int i = 0; i < 16; ++i) O[v][i] = 0.f;
  float m_run = -1e30f, l_run = 0.f;
  gload(0); lwrite(0);
  __syncthreads();
  const int q4 = (lane & 15) >> 2, p4 = lane & 3, blk = (lane >> 4) & 1;
  for (int j = 0; j < NT; ++j) {
    if (j + 1 < NT) gload(j + 1);
    if (active && j < ntw) {
      const char* kb = lds + (j & 1) * (2 * A_TILE);
      const char* vb = kb + A_TILE;
      f32x16 st[2];
#pragma unroll
      for (int kt = 0; kt < 2; ++kt) {
#pragma unroll
        for (int i = 0; i < 16; ++i) st[kt][i] = 0.f;
#pragma unroll
        for (int ks = 0; ks < 4; ++ks) {
          const bf16x8 kf = *(const bf16x8*)(kb + (kt * 32 + r) * A_LD + (map * 64 + ks * 16 + h * 8) * 2);
          st[kt] = MFMA32(kf, qf[ks], st[kt]);
        }
      }
      if (KIND == 1 && j == NT - 1) {
#pragma unroll
        for (int kt = 0; kt < 2; ++kt)
#pragma unroll
          for (int i = 0; i < 16; ++i) if (j * 64 + kt * 32 + crow(i, h) >= NKS) st[kt][i] = -1e30f;
      }
      float mx = st[0][0];
#pragma unroll
      for (int kt = 0; kt < 2; ++kt)
#pragma unroll
        for (int i = 0; i < 16; ++i) mx = fmaxf(mx, st[kt][i]);
      mx = fmaxf(mx, __shfl_xor(mx, 32));
      const float m_new = fmaxf(m_run, mx);
      const float alpha = __builtin_amdgcn_exp2f((m_run - m_new) * LOG2E);
      const float mb = m_new * LOG2E;
      float rs = 0.f;
#pragma unroll
      for (int kt = 0; kt < 2; ++kt)
#pragma unroll
        for (int i = 0; i < 16; ++i) { const float e = __builtin_amdgcn_exp2f(st[kt][i] * LOG2E - mb); st[kt][i] = e; rs += e; }
      rs += __shfl_xor(rs, 32);
      l_run = l_run * alpha + rs; m_run = m_new;
      if (__builtin_amdgcn_ballot_w64(alpha != 1.f) != 0ull) {
#pragma unroll
        for (int v = 0; v < 4; ++v)
#pragma unroll
          for (int i = 0; i < 16; ++i) O[v][i] *= alpha;
      }
      bf16x8 pk[4];
      pk[0] = pack8(st[0], 0); pk[1] = pack8(st[0], 1); pk[2] = pack8(st[1], 0); pk[3] = pack8(st[1], 1);
      const unsigned vaddr = lds_addr(vb) + (4 * h + q4) * A_LD + (16 * blk + 4 * p4) * 2;
#pragma unroll
      for (int vt = 0; vt < 4; ++vt) {
        bf16x8 vf[4];
        tr_frag4<16 * A_LD, 8 * A_LD>(vaddr + vt * 64, vf);
#pragma unroll
        for (int ks = 0; ks < 4; ++ks) O[vt] = MFMA32(vf[ks], pk[ks], O[vt]);
      }
    }
    if (j + 1 < NT) lwrite((j + 1) & 1);
    __syncthreads();
  }
  float* ex = (float*)lds;
  const float inv_l = 1.f / l_run;
  if (map == 1) {
#pragma unroll
    for (int vt = 0; vt < 4; ++vt)
#pragma unroll
      for (int g = 0; g < 4; ++g) {
        f32x4 o; o[0] = O[vt][4 * g] * inv_l; o[1] = O[vt][4 * g + 1] * inv_l; o[2] = O[vt][4 * g + 2] * inv_l; o[3] = O[vt][4 * g + 3] * inv_l;
        *(f32x4*)(ex + (qt * 32 + r) * 132 + vt * 32 + 8 * g + 4 * h) = o;
      }
  }
  __syncthreads();
  if (map == 0) {
    const float lam = ((const float*)(p.ws + W_MISC))[l];
    const float lam_init = (l == 0) ? 0.2f : (0.8f - 0.6f * 0.74081822068171788f);
    float ssq = 0.f;
#pragma unroll
    for (int vt = 0; vt < 4; ++vt)
#pragma unroll
      for (int g = 0; g < 4; ++g) {
        const f32x4 o2 = *(const f32x4*)(ex + (qt * 32 + r) * 132 + vt * 32 + 8 * g + 4 * h);
#pragma unroll
        for (int e = 0; e < 4; ++e) { const float o = O[vt][4 * g + e] * inv_l - lam * o2[e]; O[vt][4 * g + e] = o; ssq += o * o; }
      }
    ssq += __shfl_xor(ssq, 32);
    const float rms = rsqrtf(ssq * (1.f / 128.f) + LN_EPS) * (1.f - lam_init);
    const float* sg = p.in[14] + l * 128;
    const bool valid = KIND == 0 ? true : (qt == 0 && r < 16);
    if (valid) {
      bf16_t* dst = (bf16_t*)(p.ws + W_Z) + (size_t)qrow * NIN + 3072 + ha * 128;
#pragma unroll
      for (int vt = 0; vt < 4; ++vt)
#pragma unroll
        for (int g = 0; g < 4; ++g) {
          const int v0 = vt * 32 + 8 * g + 4 * h;
          const f32x4 gg = *(const f32x4*)(sg + v0);
          u32x2 o; o[0] = pk2(O[vt][4 * g] * rms * gg[0], O[vt][4 * g + 1] * rms * gg[1]); o[1] = pk2(O[vt][4 * g + 2] * rms * gg[2], O[vt][4 * g + 3] * rms * gg[3]);
          *(u32x2*)(dst + v0) = o;
        }
    }
  }
  __syncthreads();
}

constexpr int L_LD = 528;
constexpr int L_VLD = 272;
constexpr int L_Q = 0, L_K = 64 * L_LD, L_V = 2 * 64 * L_LD, L_SW = L_V + 64 * L_VLD;
constexpr int L_SWLD = 144;
constexpr int L_SC = L_SW + 64 * L_SWLD;
constexpr int S_MX = 0, S_G = 64, S_EMT = 128, S_DS0 = 192, S_DS1 = 256, S_QN = 320  , S_NV = 576  , S_GEND = 832, S_PAR = 840;
constexpr int LDS_BYTES = 153376;
static_assert(L_SC + 2 * S_PAR * 4 <= 131072, "lds");
#define WG_BAR() do { __builtin_amdgcn_fence(__ATOMIC_RELEASE, "workgroup"); __builtin_amdgcn_s_barrier(); __builtin_amdgcn_fence(__ATOMIC_ACQUIRE, "workgroup"); } while (0)

template <int KIND>
DI void mlstm_item(const Params& p, int l, int b, int hm, int half, char* lds) {
  const int tid0 = otid(), wave = uni(tid0 >> 6);
  const bf16_t* QA = (const bf16_t*)(p.ws + W_AB); const bf16_t* KA = (const bf16_t*)(p.ws + W_KA);
  const bf16_t* Z = (const bf16_t*)(p.ws + W_Z); bf16_t* H = (bf16_t*)(p.ws + W_H);
  const float* GIF = (const float*)(p.ws + W_GIF);
  float* scb = (float*)(lds + L_SC);
  int nchunks = KIND == 0 ? SEQ / 64 : 1; asm volatile("" : "+s"(nchunks));
  const int Lv = KIND == 0 ? 64 : 16;
  const size_t bh = KIND == 0 ? (size_t)(l * 4 + b) * 4 + hm : (size_t)(l * 8 + b) * 4 + hm;
  if (wave < 4) {
    f32x16 C[8];
    { const int lane = tid0 & 63, r = lane & 31, h = lane >> 5; (void)r; (void)h;
      if (KIND == 0) {
#pragma unroll
        for (int d = 0; d < 8; ++d)
#pragma unroll
          for (int i = 0; i < 16; ++i) C[d][i] = 0.f;
      } else {
        const float* cp = p.in[5] + bh * 65536 + (size_t)(4 * h) * 256 + half * 128 + wave * 32 + r;
#pragma unroll
        for (int d = 0; d < 8; ++d)
#pragma unroll
          for (int g = 0; g < 4; ++g) {
            C[d][4 * g] = cp[0]; C[d][4 * g + 1] = cp[256]; C[d][4 * g + 2] = cp[512]; C[d][4 * g + 3] = cp[768];
            cp += 2048; asm volatile("" : "+v"(cp));
          }
      }
    }
    for (int c = 0; c < nchunks; ++c) {
      int tid = tid0; asm volatile("" : "+v"(tid));
      const int lane = tid & 63, r = lane & 31, h = lane >> 5;
      const int q4 = (lane & 15) >> 2, p4 = lane & 3, blk = (lane >> 4) & 1;
      const float* sc = scb + (c & 1) * S_PAR;
      const int rowbase = KIND == 0 ? b * SEQ + c * 64 : MP + b * 16;
      WG_BAR();
      f32x16 accB[2];
#pragma unroll
      for (int tt = 0; tt < 2; ++tt)
#pragma unroll
        for (int i = 0; i < 16; ++i) accB[tt][i] = 0.f;
#pragma unroll
      for (int d = 0; d < 8; ++d)
#pragma unroll
        for (int s = 0; s < 2; ++s) {
          __builtin_amdgcn_sched_barrier(0);
          const bf16x8 cf = pack8(C[d], s);
#pragma unroll
          for (int tt = 0; tt < 2; ++tt) {
            const char* qp = lds + L_Q + (tt * 32 + r) * L_LD + (d * 32 + 16 * s + 4 * h) * 2;
            const s16x4 lo = *(const s16x4*)qp, hi = *(const s16x4*)(qp + 16);
            const bf16x8 qfr = __builtin_shufflevector(lo, hi, 0, 1, 2, 3, 4, 5, 6, 7);
            accB[tt] = MFMA32(cf, qfr, accB[tt]);
          }
        }
      __builtin_amdgcn_sched_barrier(0);
      bf16x8 vf[4];
      tr_frag4<16 * L_VLD, 4 * L_VLD>(lds_addr(lds + L_V) + (8 * h + q4) * L_VLD + (wave * 32 + 16 * blk + 4 * p4) * 2, vf);
      const float g_end = sc[S_GEND];
#pragma unroll
      for (int d = 0; d < 8; ++d) {
#pragma unroll
        for (int i = 0; i < 16; ++i) C[d][i] *= g_end;
        bf16x8 kf[4];
        tr_frag4<16 * L_LD, 4 * L_LD>(lds_addr(lds + L_K) + (8 * h + q4) * L_LD + (d * 32 + 16 * blk + 4 * p4) * 2, kf);
#pragma unroll
        for (int ks = 0; ks < 4; ++ks) C[d] = MFMA32(kf[ks], vf[ks], C[d]);
      }
      WG_BAR();
#pragma unroll
      for (int tt = 0; tt < 2; ++tt) {
        const int t = tt * 32 + r;
        const float g = sc[S_G + t];
#pragma unroll
        for (int i = 0; i < 16; ++i) accB[tt][i] *= g;
        const char* sp = lds + L_SW + (tt * 32 + r) * L_SWLD + h * 16;
#pragma unroll
        for (int ks = 0; ks < 4; ++ks) accB[tt] = MFMA32(vf[ks], *(const bf16x8*)(sp + ks * 32), accB[tt]);
        const float qn = (sc[S_QN + t] + sc[S_QN + 64 + t]) + (sc[S_QN + 128 + t] + sc[S_QN + 192 + t]);
        float den = sc[S_DS0 + t] + sc[S_DS1 + t] + g * qn;
        den = fmaxf(fabsf(den), sc[S_EMT + t]);
        const float rden = 1.f / den;
        if (t < Lv) {
          bf16_t* dst = H + (size_t)(rowbase + t) * D + hm * 256 + half * 128 + wave * 32;
#pragma unroll
          for (int g4 = 0; g4 < 4; ++g4) {
            u32x2 o; o[0] = pk2(accB[tt][4 * g4] * rden, accB[tt][4 * g4 + 1] * rden); o[1] = pk2(accB[tt][4 * g4 + 2] * rden, accB[tt][4 * g4 + 3] * rden);
            *(u32x2*)(dst + 8 * g4 + 4 * h) = o;
          }
        }
      }
    }
    WG_BAR();
    {
      const int lane = tid0 & 63, r = lane & 31, h = lane >> 5;
      float* co = p.out + (KIND == 0 ? O_CP : O_CS) + bh * 65536 + (size_t)(4 * h) * 256 + half * 128 + wave * 32 + r;
#pragma unroll
      for (int d = 0; d < 8; ++d)
#pragma unroll
        for (int g = 0; g < 4; ++g) {
          co[0] = C[d][4 * g]; co[256] = C[d][4 * g + 1]; co[512] = C[d][4 * g + 2]; co[768] = C[d][4 * g + 3];
          co += 2048; asm volatile("" : "+v"(co));
        }
    }
  } else {
    const int hw = wave - 4;
    float nreg = 0.f, m_prev = 0.f;
    if (KIND == 1) { nreg = p.in[6][bh * 256 + (tid0 - 256)]; m_prev = p.in[7][bh]; }
    u32x4 pq[8], pk[8], pv[4];
    float gi = 0.f, gf = 0.f, g_end_cur = 0.f;
    auto issue_loads = [&](int c, int tid) {
      const int ht = tid - 256, lane = tid & 63;
      const int rowbase = KIND == 0 ? b * SEQ + c * 64 : MP + b * 16;
      const bool tvalid = lane < Lv;
      gi = tvalid ? GIF[(size_t)(rowbase + lane) * 8 + hm] : -1e30f;
      gf = tvalid ? GIF[(size_t)(rowbase + lane) * 8 + 4 + hm] : 0.f;
#pragma unroll
      for (int i = 0; i < 8; ++i) {
        const int cidx = ht + 256 * i, t = cidx >> 5, pc = cidx & 31;
        const int row = rowbase + (t < Lv ? t : Lv - 1);
        pq[i] = *(const u32x4*)(QA + (size_t)row * D + hm * 256 + pc * 8);
        pk[i] = *(const u32x4*)(KA + (size_t)row * D + hm * 256 + pc * 8);
      }
#pragma unroll
      for (int i = 0; i < 4; ++i) {
        const int cidx = ht + 256 * i, t = cidx >> 4, pc = cidx & 15;
        const int row = rowbase + (t < Lv ? t : Lv - 1);
        pv[i] = *(const u32x4*)(Z + (size_t)row * NIN + 5120 + hm * 256 + half * 128 + pc * 8);
      }
    };
    auto scalars = [&](int par, int lane) -> float {
      const bool tvalid = lane < Lv;
      const float lf = tvalid ? (fminf(gf, 0.f) - __logf(1.f + __expf(-fabsf(gf)))) : 0.f;
      float bc = lf;
#pragma unroll
      for (int o = 1; o < 64; o <<= 1) { const float v = __shfl_up(bc, o); if (lane >= o) bc += v; }
      const float a = gi - bc;
      float cm = a;
#pragma unroll
      for (int o = 1; o < 64; o <<= 1) { const float v = __shfl_up(cm, o); if (lane >= o) cm = fmaxf(cm, v); }
      const float mxv = fmaxf(m_prev, cm);
      const float m_t = bc + mxv;
      const float mx_end = __shfl(mxv, 63), bc_end = __shfl(bc, 63);
      const float wend = __expf(a - mx_end);
      g_end_cur = __expf(m_prev - mx_end);
      if (hw == 0) {
        float* sc = scb + par * S_PAR;
        sc[S_MX + lane] = __expf(mx_end - mxv);
        sc[S_G + lane] = __expf(m_prev - mxv);
        sc[S_EMT + lane] = __expf(-m_t);
        if (lane == 0) sc[S_GEND] = g_end_cur;
      }
      m_prev = bc_end + mx_end;
      return wend;
    };
    auto stage_lds = [&](float wend_l, int tid) {
      const int ht = tid - 256;
#pragma unroll
      for (int i = 0; i < 8; ++i) {
        const int cidx = ht + 256 * i, t = cidx >> 5, pc = cidx & 31;
        const float we = __shfl(wend_l, t);
        float f[8]; unpack8(pk[i], f);
        u32x4 o; o[0] = pk2(f[0] * we, f[1] * we); o[1] = pk2(f[2] * we, f[3] * we); o[2] = pk2(f[4] * we, f[5] * we); o[3] = pk2(f[6] * we, f[7] * we);
        *(u32x4*)(lds + L_Q + t * L_LD + pc * 16) = pq[i];
        *(u32x4*)(lds + L_K + t * L_LD + pc * 16) = o;
      }
#pragma unroll
      for (int i = 0; i < 4; ++i) {
        const int cidx = ht + 256 * i, t = cidx >> 4, pc = cidx & 15;
        *(u32x4*)(lds + L_V + t * L_VLD + pc * 16) = pv[i];
      }
    };
    {
      int tid = tid0; asm volatile("" : "+v"(tid));
      issue_loads(0, tid);
      scb[S_NV + (tid - 256)] = nreg;
      const float wend = scalars(0, tid & 63);
      stage_lds(wend, tid);
    }
    for (int c = 0; c < nchunks; ++c) {
      int tid = tid0; asm volatile("" : "+v"(tid));
      const int ht = tid - 256, lane = tid & 63, r = lane & 31, h = lane >> 5;
      float* sc = scb + (c & 1) * S_PAR;
      float* scn = scb + ((c + 1) & 1) * S_PAR;
      const float g_end_c = g_end_cur;
      WG_BAR();
      const bool more = c + 1 < nchunks;
      if (more) issue_loads(c + 1, tid);
      {
        const int t = ht & 63, part = ht >> 6;
        const char* qp = lds + L_Q + t * L_LD + part * 128;
        float s = 0.f;
#pragma unroll
        for (int e = 0; e < 8; ++e) {
          const u32x4 qq = *(const u32x4*)(qp + e * 16); float f[8]; unpack8(qq, f);
#pragma unroll
          for (int z = 0; z < 8; ++z) s += f[z] * sc[S_NV + part * 64 + e * 8 + z];
        }
        sc[S_QN + part * 64 + t] = s;
      }
      if (hw < 3) {
        const int stl = hw == 2 ? 1 : 0, tt = hw == 0 ? 0 : 1;
        f32x16 S, S2;
#pragma unroll
        for (int i = 0; i < 16; ++i) { S[i] = 0.f; S2[i] = 0.f; }
        const char* ka = lds + L_K + (stl * 32 + r) * L_LD + h * 16;
        const char* qa = lds + L_Q + (tt * 32 + r) * L_LD + h * 16;
#pragma unroll 4
        for (int ks = 0; ks < 16; ks += 2) {
          S = MFMA32(*(const bf16x8*)(ka + ks * 32), *(const bf16x8*)(qa + ks * 32), S);
          S2 = MFMA32(*(const bf16x8*)(ka + ks * 32 + 32), *(const bf16x8*)(qa + ks * 32 + 32), S2);
        }
        const int t = tt * 32 + r;
        const float cw = sc[S_MX + t];
        float rs = 0.f;
#pragma unroll
        for (int g = 0; g < 4; ++g) {
          float wv[4];
#pragma unroll
          for (int e = 0; e < 4; ++e) {
            const int s = stl * 32 + 8 * g + 4 * h + e;
            wv[e] = s <= t ? (S[4 * g + e] + S2[4 * g + e]) * cw : 0.f; rs += wv[e];
          }
          u32x2 o; o[0] = pk2(wv[0], wv[1]); o[1] = pk2(wv[2], wv[3]);
          *(u32x2*)(lds + L_SW + t * L_SWLD + (stl * 32 + 8 * g + 4 * h) * 2) = o;
        }
        rs += __shfl_xor(rs, 32);
        if (h == 0) {
          if (hw == 0) { sc[S_DS0 + t] = rs; sc[S_DS1 + t] = 0.f; }
          else if (hw == 1) sc[S_DS0 + t] = rs;
          else sc[S_DS1 + t] = rs;
        }
      } else {
        const int t = lane >> 1, hs = lane & 1;
        u32x4 z; z[0] = 0; z[1] = 0; z[2] = 0; z[3] = 0;
        *(u32x4*)(lds + L_SW + t * L_SWLD + 64 + hs * 32) = z; *(u32x4*)(lds + L_SW + t * L_SWLD + 64 + hs * 32 + 16) = z;
      }
      {
        float s0 = 0.f, s1 = 0.f, s2 = 0.f, s3 = 0.f;
        const char* kp = lds + L_K + ht * 2;
#pragma unroll
        for (int t = 0; t < 64; t += 4) {
          s0 += bflo((unsigned)*(const bf16_t*)(kp + t * L_LD)); s1 += bflo((unsigned)*(const bf16_t*)(kp + (t + 1) * L_LD));
          s2 += bflo((unsigned)*(const bf16_t*)(kp + (t + 2) * L_LD)); s3 += bflo((unsigned)*(const bf16_t*)(kp + (t + 3) * L_LD));
        }
        nreg = g_end_c * nreg + ((s0 + s1) + (s2 + s3));
        scn[S_NV + ht] = nreg;
      }
      float wend = 0.f;
      if (more) wend = scalars((c + 1) & 1, lane);
      WG_BAR();
      if (more) stage_lds(wend, tid);
    }
    WG_BAR();
    if (half == 0) {
      p.out[(KIND == 0 ? O_NP : O_NS) + bh * 256 + (tid0 - 256)] = nreg;
      if (tid0 == 256) p.out[(KIND == 0 ? O_MPP : O_MSS) + bh] = m_prev;
    }
  }
}

DI void mixer_phase(const Params& p, int l, char* lds, int cidx, bool ml_only) {
  unsigned* ctr = (unsigned*)(p.ws + W_MISC) + 16 + cidx;
  int* s_item = (int*)(lds + LDS_BYTES - 16);
  const int total = 32 + 64 + 64 + 2048;
  for (;;) {
    __syncthreads();
    if (threadIdx.x == 0) *s_item = (int)atomicAdd(ctr, 1u);
    __syncthreads();
    const int it = *s_item;
    __syncthreads();
    if (it >= total) break;
    if (ml_only && it >= 96) break;
    if (it < 32) { mlstm_item<0>(p, l, it >> 3, (it >> 1) & 3, it & 1, lds); continue; }
    if (it < 96) { const int x = it - 32; mlstm_item<1>(p, l, x >> 3, (x >> 1) & 3, x & 1, lds); continue; }
    if (it < 160) { attn_item<1>(p, l, (it - 96) >> 3, (it - 96) & 7, 0, lds); continue; }
    { const int x = it - 160; attn_item<0>(p, l, (x & 31) >> 3, x & 7, 63 - (x >> 5), lds); }
  }
}

DI void merge_phase(const Params& p, int l) {
  const bf16_t* Z = (const bf16_t*)(p.ws + W_Z); const bf16_t* H = (const bf16_t*)(p.ws + W_H); bf16_t* Y = (bf16_t*)(p.ws + W_AB);
  const int tidq = otid(); const int lane = tidq & 63, gw = blockIdx.x * 8 + (tidq >> 6), ngw = gridDim.x * 8;
  const float* mhg = p.in[15] + (size_t)l * D;
  for (int row = gw; row < M; row += ngw) {
    const int col = lane * 16;
    const bf16_t* z = Z + (size_t)row * NIN + col;
    float hv[16];
    unpack8(*(const u32x4*)(H + (size_t)row * D + col), hv); unpack8(*(const u32x4*)(H + (size_t)row * D + col + 8), hv + 8);
    float s = 0.f;
#pragma unroll
    for (int e = 0; e < 16; ++e) s += hv[e];
#pragma unroll
    for (int o = 1; o < 16; o <<= 1) s += __shfl_xor(s, o);
    const float mean = s * (1.f / 256.f);
    float s2 = 0.f;
#pragma unroll
    for (int e = 0; e < 16; ++e) { hv[e] -= mean; s2 += hv[e] * hv[e]; }
#pragma unroll
    for (int o = 1; o < 16; o <<= 1) s2 += __shfl_xor(s2, o);
    const float rstd = rsqrtf(s2 * (1.f / 256.f) + LN_EPS);
#pragma unroll
    for (int hh = 0; hh < 2; ++hh) {
      float oa[8], om[8], ga[8], gb[8];
      unpack8(*(const u32x4*)(z + 3072 + hh * 8), oa); unpack8(*(const u32x4*)(z + 6144 + hh * 8), om);
      unpack8(*(const u32x4*)(z + 7168 + hh * 8), ga); unpack8(*(const u32x4*)(z + 8192 + hh * 8), gb);
      const f32x4 g0 = *(const f32x4*)(mhg + col + hh * 8), g1 = *(const f32x4*)(mhg + col + hh * 8 + 4);
      float y[8];
#pragma unroll
      for (int e = 0; e < 8; ++e) {
        const float hn = hv[hh * 8 + e] * rstd * (e < 4 ? g0[e] : g1[e - 4]);
        y[e] = sigmoidf_(ga[e]) * oa[e] + sigmoidf_(gb[e]) * (hn * sigmoidf_(om[e]));
      }
      u32x4 o; o[0] = pk2(y[0], y[1]); o[1] = pk2(y[2], y[3]); o[2] = pk2(y[4], y[5]); o[3] = pk2(y[6], y[7]);
      *(u32x4*)(Y + (size_t)row * D + col + hh * 8) = o;
    }
  }
}

DI void ln_phase(const Params& p, const float* g, const float* bta, bool final_out) {
  const int tidq = otid(); const int lane = tidq & 63, gw = blockIdx.x * 8 + (tidq >> 6), ngw = gridDim.x * 8;
  float* R = (float*)(p.ws + W_R); bf16_t* AB = (bf16_t*)(p.ws + W_AB);
  for (int row = gw; row < M; row += ngw) {
    float* xr = R + (size_t)row * D;
    f32x4 v[4]; float s = 0.f;
#pragma unroll
    for (int j = 0; j < 4; ++j) { v[j] = *(const f32x4*)(xr + j * 256 + lane * 4); s += (v[j][0] + v[j][1]) + (v[j][2] + v[j][3]); }
    const float mean = wave_sum(s) * (1.f / D);
    float s2 = 0.f;
#pragma unroll
    for (int j = 0; j < 4; ++j) { v[j] = v[j] - mean; s2 += (v[j][0] * v[j][0] + v[j][1] * v[j][1]) + (v[j][2] * v[j][2] + v[j][3] * v[j][3]); }
    const float rstd = rsqrtf(wave_sum(s2) * (1.f / D) + LN_EPS);
    float* dst = final_out ? (row < MP ? p.out + O_YP + (size_t)row * D : p.out + O_YS + (size_t)(row - MP) * D) : xr;
#pragma unroll
    for (int j = 0; j < 4; ++j) {
      const int c = j * 256 + lane * 4;
      const f32x4 gg = *(const f32x4*)(g + c), bb = *(const f32x4*)(bta + c);
      f32x4 o = v[j] * rstd * gg + bb;
      *(f32x4*)(dst + c) = o;
      if (!final_out) { u32x2 ob; ob[0] = pk2(o[0], o[1]); ob[1] = pk2(o[2], o[3]); *(u32x2*)(AB + (size_t)row * D + c) = ob; }
    }
  }
}

DI void ffnconv_phase(const Params& p, int l) {
  const bf16_t* U = (const bf16_t*)(p.ws + W_Z); bf16_t* HF = (bf16_t*)(p.ws + W_Z + (size_t)M * NUP * 2);
  const float* cw = p.in[20] + (size_t)l * 3 * NUP; const float* cb = p.in[21] + (size_t)l * NUP;
  const size_t total = (size_t)M * 352;
  for (size_t it = (size_t)blockIdx.x * NTH + otid(); it < total; it += (size_t)gridDim.x * NTH) {
    const int row = (int)(it / 352), col = (int)(it % 352) * 8;
    int t; const float* st = nullptr;
    if (row < MP) t = row & (SEQ - 1); else { t = (row - MP) & 15; st = p.in[8] + ((size_t)(l * 8 + ((row - MP) >> 4)) * 2) * NUP; }
    float u[2][8];
#pragma unroll
    for (int hf = 0; hf < 2; ++hf) {
      const int cc = col + hf * DFF;
      f32x4 a = *(const f32x4*)(cb + cc), b = *(const f32x4*)(cb + cc + 4);
      u[hf][0] = a[0]; u[hf][1] = a[1]; u[hf][2] = a[2]; u[hf][3] = a[3]; u[hf][4] = b[0]; u[hf][5] = b[1]; u[hf][6] = b[2]; u[hf][7] = b[3];
#pragma unroll
      for (int j = 0; j < 3; ++j) {
        const int tj = t - 2 + j;
        float x[8];
        if (tj >= 0) unpack8(*(const u32x4*)(U + (size_t)(row - 2 + j) * NUP + cc), x);
        else if (st) { const float* s = st + (size_t)(2 + tj) * NUP + cc; f32x4 a2 = *(const f32x4*)s, b2 = *(const f32x4*)(s + 4);
          x[0] = a2[0]; x[1] = a2[1]; x[2] = a2[2]; x[3] = a2[3]; x[4] = b2[0]; x[5] = b2[1]; x[6] = b2[2]; x[7] = b2[3]; }
        else {
#pragma unroll
          for (int e = 0; e < 8; ++e) x[e] = 0.f; }
        const f32x4 w0 = *(const f32x4*)(cw + j * NUP + cc), w1 = *(const f32x4*)(cw + j * NUP + cc + 4);
        u[hf][0] += w0[0] * x[0]; u[hf][1] += w0[1] * x[1]; u[hf][2] += w0[2] * x[2]; u[hf][3] += w0[3] * x[3];
        u[hf][4] += w1[0] * x[4]; u[hf][5] += w1[1] * x[5]; u[hf][6] += w1[2] * x[6]; u[hf][7] += w1[3] * x[7];
      }
    }
    float o[8];
#pragma unroll
    for (int e = 0; e < 8; ++e) { const float a = u[0][e]; o[e] = 0.5f * a * (1.f + erff(a * 0.70710678118654752f)) * u[1][e]; }
    u32x4 ov; ov[0] = pk2(o[0], o[1]); ov[1] = pk2(o[2], o[3]); ov[2] = pk2(o[4], o[5]); ov[3] = pk2(o[6], o[7]);
    *(u32x4*)(HF + (size_t)row * DFF + col) = ov;
  }
}

constexpr int NPH = 21;
DI void run_phase(const Params& p, int ph, char* lds) {
#ifndef ONLY
  if (ph == 0) { phase0(p, lds); return; }
#else
  if (ph == 0) return;
#endif
  const int l = (ph - 1) / 10, s = (ph - 1) % 10;
#ifdef ONLY
  if (s != ONLY) return;
#endif
  switch (s) {
    case 0: gemm_phase<EPI_IN>(p, l, (const bf16_t*)(p.ws + W_AB), D, (const bf16_t*)(p.ws + W_WIN) + (size_t)l * NIN * D, D, NIN / 256, lds); break;
    case 1: qkconv_phase(p, l); gif_phase(p, l); break;
    case 2: mixer_phase(p, l, lds, l, false); break;
    case 3: merge_phase(p, l); break;
    case 4: gemm_phase<EPI_OUT>(p, l, (const bf16_t*)(p.ws + W_AB), D, (const bf16_t*)(p.ws + W_WOUT) + (size_t)l * D * D, D, D / 256, lds); break;
    case 5: ln_phase(p, p.in[17] + l * D, p.in[18] + l * D, false); break;
    case 6: gemm_phase<EPI_UP>(p, l, (const bf16_t*)(p.ws + W_AB), D, (const bf16_t*)(p.ws + W_WUP) + (size_t)l * NUP * D, D, NUP / 256, lds); break;
    case 7: ffnconv_phase(p, l); break;
    case 8: gemm_phase<EPI_DOWN>(p, l, (const bf16_t*)(p.ws + W_Z + (size_t)M * NUP * 2), DFF, (const bf16_t*)(p.ws + W_WDN) + (size_t)l * D * DFF, DFF, D / 256, lds); break;
    case 9: ln_phase(p, p.in[23] + l * D, p.in[24] + l * D, l == 1); break;
  }
}

__global__ void __launch_bounds__(NTH) mega(Params p, int ph_lo, int ph_hi) {
  extern __shared__ __attribute__((aligned(16))) char lds[];
#if MULTI_LAUNCH
  for (int ph = ph_lo; ph < ph_hi; ++ph) run_phase(p, ph, lds);
#else
  cg::grid_group grid = cg::this_grid();
  phase0(p, lds);
  grid.sync();
  for (int l = 0; l < 2; ++l) {
    gemm_phase<EPI_IN>(p, l, (const bf16_t*)(p.ws + W_AB), D, (const bf16_t*)(p.ws + W_WIN) + (size_t)l * NIN * D, D, NIN / 256, lds);
    grid.sync();
#ifdef PROBE_GIN2
    gemm_phase<EPI_IN>(p, l, (const bf16_t*)(p.ws + W_AB), D, (const bf16_t*)(p.ws + W_WIN) + (size_t)l * NIN * D, D, NIN / 256, lds);
    grid.sync();
#endif
    qkconv_phase(p, l); gif_phase(p, l);
    grid.sync();
#ifdef PROBE_EW2
    qkconv_phase(p, l); gif_phase(p, l);
    grid.sync();
#endif
    mixer_phase(p, l, lds, l, false);
    grid.sync();
#ifdef PROBE_ML2
    mixer_phase(p, l, lds, l + 2, true);
    grid.sync();
#endif
#ifdef PROBE_MIX2
    mixer_phase(p, l, lds, l + 2, false);
    grid.sync();
#endif
    merge_phase(p, l);
    grid.sync();
#ifdef PROBE_EW2
    merge_phase(p, l);
    grid.sync();
#endif
    gemm_phase<EPI_OUT>(p, l, (const bf16_t*)(p.ws + W_AB), D, (const bf16_t*)(p.ws + W_WOUT) + (size_t)l * D * D, D, D / 256, lds);
    grid.sync();
    ln_phase(p, p.in[17] + l * D, p.in[18] + l * D, false);
    grid.sync();
    gemm_phase<EPI_UP>(p, l, (const bf16_t*)(p.ws + W_AB), D, (const bf16_t*)(p.ws + W_WUP) + (size_t)l * NUP * D, D, NUP / 256, lds);
    grid.sync();
    ffnconv_phase(p, l);
    grid.sync();
#ifdef PROBE_EW2
    ffnconv_phase(p, l);
    grid.sync();
#endif
    gemm_phase<EPI_DOWN>(p, l, (const bf16_t*)(p.ws + W_Z + (size_t)M * NUP * 2), DFF, (const bf16_t*)(p.ws + W_WDN) + (size_t)l * D * DFF, DFF, D / 256, lds);
    grid.sync();
    ln_phase(p, p.in[23] + l * D, p.in[24] + l * D, l == 1);
    if (l == 0) grid.sync();
  }
#endif
}

extern "C" void kernel_launch(void* const* d_in, const int* in_sizes, int n_in, void* d_out, int out_size, void* d_ws, size_t ws_size, hipStream_t stream) {
  static int grid = 0;
  if (grid == 0) {
    if (n_in != 25 || (size_t)out_size != O_END || ws_size < W_END) { fprintf(stderr, "kernel_launch: unexpected sizes n_in %d out %d (want %zu) ws %zu (want %zu)\n", n_in, out_size, (size_t)O_END, ws_size, (size_t)W_END); grid = -1; return; }
    int dev = 0, cus = 0, per_cu = 0;
    hipGetDevice(&dev);
    hipDeviceGetAttribute(&cus, hipDeviceAttributeMultiprocessorCount, dev);
    if (hipFuncSetAttribute((const void*)mega, hipFuncAttributeMaxDynamicSharedMemorySize, LDS_BYTES) != hipSuccess) { fprintf(stderr, "hipFuncSetAttribute failed\n"); grid = -1; return; }
    hipOccupancyMaxActiveBlocksPerMultiprocessor(&per_cu, (const void*)mega, NTH, LDS_BYTES);
    if (per_cu < 1) per_cu = 1;
    grid = cus * 1;
    (void)hipGetLastError();
  }
  if (grid < 0) return;
  Params p{};
  for (int i = 0; i < 25; ++i) p.in[i] = (const float*)d_in[i];
  p.out = (float*)d_out; p.ws = (unsigned char*)d_ws;
#if MULTI_LAUNCH
  for (int ph = 0; ph < NPH; ++ph) hipLaunchKernelGGL(mega, dim3(grid), dim3(NTH), LDS_BYTES, stream, p, ph, ph + 1);
#else
  int lo = 0, hi = NPH;
  void* args[] = {&p, &lo, &hi};
  hipError_t e = hipLaunchCooperativeKernel((const void*)mega, dim3(grid), dim3(NTH), args, LDS_BYTES, stream);
  if (e != hipSuccess) fprintf(stderr, "cooperative launch failed: %s (grid %d)\n", hipGetErrorString(e), grid);
#endif
}
```

```cpp
#include <hip/hip_runtime.h>
#include <hip/hip_cooperative_groups.h>
#include <cstdio>
namespace cg = cooperative_groups;

#ifndef MULTI_LAUNCH
#define MULTI_LAUNCH 0
#endif

typedef unsigned short bf16_t;
typedef short bf16x8 __attribute__((ext_vector_type(8)));
typedef short s16x4 __attribute__((ext_vector_type(4)));
typedef float f32x16 __attribute__((ext_vector_type(16)));
typedef float f32x4 __attribute__((ext_vector_type(4)));
typedef unsigned u32x4 __attribute__((ext_vector_type(4)));
typedef unsigned u32x2 __attribute__((ext_vector_type(2)));
#define DI __device__ __forceinline__
#define MFMA32(a, b, c) __builtin_amdgcn_mfma_f32_32x32x16_bf16((a), (b), (c), 0, 0, 0)

constexpr int NTH = 512;
constexpr int D = 1024, SEQ = 8192, NB = 4, MP = NB * SEQ, MS = 128, M = MP + MS, NTM = 129;
constexpr int DIN = 9224, NIN = 9216, DFF = 2816, NUP = 5632;
constexpr int PAST = 4096, NKS = PAST + 16;
constexpr float ALPHA = 1.4142135623730951f;
constexpr float LN_EPS = 1e-5f;
constexpr float LOG2E = 1.4426950408889634f;

constexpr size_t O_YP = 0;
constexpr size_t O_YS = O_YP + (size_t)MP * D;
constexpr size_t O_KP = O_YS + (size_t)MS * D;
constexpr size_t O_VP = O_KP + (size_t)2 * MP * 1024;
constexpr size_t O_MCP = O_VP + (size_t)2 * MP * 1024;
constexpr size_t O_CP = O_MCP + (size_t)2 * 4 * 3 * 2048;
constexpr size_t O_NP = O_CP + (size_t)2 * 4 * 4 * 65536;
constexpr size_t O_MPP = O_NP + (size_t)2 * 4 * 4 * 256;
constexpr size_t O_FCP = O_MPP + 32;
constexpr size_t O_KS = O_FCP + (size_t)2 * 4 * 2 * NUP;
constexpr size_t O_VS = O_KS + (size_t)2 * MS * 1024;
constexpr size_t O_MCS = O_VS + (size_t)2 * MS * 1024;
constexpr size_t O_CS = O_MCS + (size_t)2 * 8 * 3 * 2048;
constexpr size_t O_NS = O_CS + (size_t)2 * 8 * 4 * 65536;
constexpr size_t O_MSS = O_NS + (size_t)2 * 8 * 4 * 256;
constexpr size_t O_FCS = O_MSS + 64;
constexpr size_t O_END = O_FCS + (size_t)2 * 8 * 2 * NUP;

constexpr size_t W_Z = 0;
constexpr size_t W_H = W_Z + (size_t)M * NIN * 2;
constexpr size_t W_AB = W_H + (size_t)M * D * 2;
constexpr size_t W_KA = W_AB + (size_t)M * D * 2;
constexpr size_t W_R = W_KA + (size_t)M * D * 2;
constexpr size_t W_WIN = W_R + (size_t)M * D * 4;
constexpr size_t W_WOUT = W_WIN + (size_t)2 * NIN * D * 2;
constexpr size_t W_WUP = W_WOUT + (size_t)2 * D * D * 2;
constexpr size_t W_WDN = W_WUP + (size_t)2 * NUP * D * 2;
constexpr size_t W_GIF = W_WDN + (size_t)2 * D * DFF * 2;
constexpr size_t W_ROPE = W_GIF + (size_t)M * 8 * 4;
constexpr size_t W_MISC = W_ROPE + (size_t)8192 * 32 * 8;
constexpr size_t W_END = W_MISC + 4096;

struct Params {
  const float* in[25];
  float* out;
  unsigned char* ws;
};

DI unsigned f2bf(float x) { unsigned u = __float_as_uint(x); u += 0x7fffu + ((u >> 16) & 1u); return u >> 16; }
typedef __bf16 bf16v2 __attribute__((ext_vector_type(2)));
typedef float f32x2 __attribute__((ext_vector_type(2)));
DI unsigned pk2(float a, float b) { f32x2 v; v[0] = a; v[1] = b; return __builtin_bit_cast(unsigned, __builtin_convertvector(v, bf16v2)); }
DI float bflo(unsigned u) { return __uint_as_float(u << 16); }
DI float bfhi(unsigned u) { return __uint_as_float(u & 0xffff0000u); }
DI float sigmoidf_(float x) { return 1.f / (1.f + __expf(-x)); }
DI float wave_sum(float v) {
#pragma unroll
  for (int o = 1; o < 64; o <<= 1) v += __shfl_xor(v, o);
  return v;
}
DI int crow(int i, int h) { return (i & 3) + 8 * (i >> 2) + 4 * h; }
DI bf16x8 pack8(const f32x16& x, int s) {
  u32x4 p;
  p[0] = pk2(x[8 * s + 0], x[8 * s + 1]); p[1] = pk2(x[8 * s + 2], x[8 * s + 3]);
  p[2] = pk2(x[8 * s + 4], x[8 * s + 5]); p[3] = pk2(x[8 * s + 6], x[8 * s + 7]);
  return __builtin_bit_cast(bf16x8, p);
}
DI void unpack8(u32x4 v, float* f) {
  f[0] = bflo(v[0]); f[1] = bfhi(v[0]); f[2] = bflo(v[1]); f[3] = bfhi(v[1]);
  f[4] = bflo(v[2]); f[5] = bfhi(v[2]); f[6] = bflo(v[3]); f[7] = bfhi(v[3]);
}
typedef __attribute__((address_space(3))) s16x4 lds_s16x4;
DI bf16x8 tr_frag(unsigned a_lo, unsigned a_hi) {
  const s16x4 lo = __builtin_amdgcn_ds_read_tr16_b64_v4i16((lds_s16x4*)(size_t)a_lo);
  const s16x4 hi = __builtin_amdgcn_ds_read_tr16_b64_v4i16((lds_s16x4*)(size_t)a_hi);
  return __builtin_shufflevector(lo, hi, 0, 1, 2, 3, 4, 5, 6, 7);
}
template <int STEP, int HIOFF>
DI void tr_frag4(unsigned a, bf16x8 (&f)[4]) {
#pragma unroll
  for (int i = 0; i < 4; ++i) f[i] = tr_frag(a + i * STEP, a + i * STEP + HIOFF);
}
DI int otid() { int t = threadIdx.x; asm volatile("" : "+v"(t)); return t; }
DI int uni(int v) { return __builtin_amdgcn_readfirstlane(v); }
DI unsigned lds_addr(const void* p) { return (unsigned)(size_t)p; }

DI const float* xrow_ptr(const Params& p, int l, int row) {
  if (l == 0) return row < MP ? p.in[0] + (size_t)row * D : p.in[1] + (size_t)(row - MP) * D;
  return (const float*)(p.ws + W_R) + (size_t)row * D;
}

DI void transpose_w(const float* W, int K, int N, int src_ld, bf16_t* WT, bool remap, char* lds) {
  float* scr = (float*)lds;
  const int nkb = K / 64, nnb = N / 64, tid = otid();
  for (int it = blockIdx.x; it < nkb * nnb; it += gridDim.x) {
    const int kb = it / nnb, nb = it % nnb, k0 = kb * 64, n0 = nb * 64;
    const int ns = (remap && n0 >= 7168) ? n0 + 8 : n0;
#pragma unroll
    for (int i = 0; i < 8; ++i) {
      const int kk = (tid >> 6) + 8 * i, nn = tid & 63;
      scr[kk * 65 + nn] = W[(size_t)(k0 + kk) * src_ld + ns + nn];
    }
    __syncthreads();
    {
      const int n = tid >> 3, c = tid & 7;
      const float* s = scr + (8 * c) * 65 + n;
      u32x4 o;
      o[0] = pk2(s[0], s[65]); o[1] = pk2(s[2 * 65], s[3 * 65]); o[2] = pk2(s[4 * 65], s[5 * 65]); o[3] = pk2(s[6 * 65], s[7 * 65]);
      const int nd = (remap && n0 < 2048) ? ((n < 32) ? 2 * n : 2 * (n - 32) + 1) : n;
      *(u32x4*)(WT + (size_t)(n0 + nd) * K + k0 + 8 * c) = o;
    }
    __syncthreads();
  }
}

DI void phase0(const Params& p, char* lds) {
  const int tid = otid();
  for (int l = 0; l < 2; ++l) {
    transpose_w(p.in[9] + (size_t)l * D * DIN, D, NIN, DIN, (bf16_t*)(p.ws + W_WIN) + (size_t)l * NIN * D, true, lds);
    transpose_w(p.in[16] + (size_t)l * D * D, D, D, D, (bf16_t*)(p.ws + W_WOUT) + (size_t)l * D * D, false, lds);
    transpose_w(p.in[19] + (size_t)l * D * NUP, D, NUP, NUP, (bf16_t*)(p.ws + W_WUP) + (size_t)l * NUP * D, false, lds);
    transpose_w(p.in[22] + (size_t)l * DFF * D, DFF, D, D, (bf16_t*)(p.ws + W_WDN) + (size_t)l * D * DFF, false, lds);
  }
  bf16_t* ab = (bf16_t*)(p.ws + W_AB);
  for (size_t c = (size_t)blockIdx.x * NTH + tid; c < (size_t)M * 128; c += (size_t)gridDim.x * NTH) {
    const int row = (int)(c >> 7), cc = (int)(c & 127);
    const float* src = xrow_ptr(p, 0, row) + cc * 8;
    f32x4 a = *(const f32x4*)src, b = *(const f32x4*)(src + 4);
    u32x4 o; o[0] = pk2(a[0], a[1]); o[1] = pk2(a[2], a[3]); o[2] = pk2(b[0], b[1]); o[3] = pk2(b[2], b[3]);
    *(u32x4*)(ab + (size_t)row * D + cc * 8) = o;
  }
  float2* rope = (float2*)(p.ws + W_ROPE);
  for (int i = blockIdx.x * NTH + tid; i < 8192 * 32; i += gridDim.x * NTH) {
    const int pos = i >> 5, d = i & 31;
    const double inv = exp2(-(double)d * (13.287712379549449 / 32.0));
    double ang = (double)pos * inv;
    const double twopi = 6.283185307179586476925;
    ang -= twopi * rint(ang / twopi);
    float s, c; sincosf((float)ang, &s, &c);
    rope[i] = make_float2(c, s);
  }
  if (blockIdx.x == 0 && tid < 128) {
    const int l = tid >> 6, ln = tid & 63;
    const float* lp = p.in[13] + (size_t)l * 4 * 64;
    const float s1 = wave_sum(lp[ln] * lp[64 + ln]), s2 = wave_sum(lp[128 + ln] * lp[192 + ln]);
    const float lam_init = (l == 0) ? 0.2f : (0.8f - 0.6f * 0.74081822068171788f);
    if (ln == 0) ((float*)(p.ws + W_MISC))[l] = __expf(s1) - __expf(s2) + lam_init;
  }
  if (blockIdx.x == 0 && tid < 8) ((unsigned*)(p.ws + W_MISC))[16 + tid] = 0u;
}

namespace pg8 {
#define PG8_LAS __attribute__((address_space(3)))
typedef unsigned short bf16_t;
typedef short bf16x8 __attribute__((ext_vector_type(8)));
typedef float f32x4 __attribute__((ext_vector_type(4)));
typedef unsigned u32x4 __attribute__((ext_vector_type(4)));
constexpr int BM = 256, BK = 64, HALF = 128, HTB = HALF * BK * 2  , STAGE_BYTES = 8 * HTB, NXCD = 8, WGM = 8;

__host__ __device__ __forceinline__ int lds_byte(int r, int c) { const int st = (r >> 4) * 2 + (c >> 5), rr = r & 15, cc = c & 31, ob = rr * 64 + cc * 2; return st * 1024 + (ob ^ (((ob >> 9) & 1) << 5)); }
__host__ __device__ __forceinline__ void stage_rc(int b, int& R, int& C) { const int st = b / 1024, sb = b % 1024, swz = sb ^ (((sb >> 9) & 1) << 5); R = (st >> 1) * 16 + swz / 64; C = (st & 1) * 32 + (swz % 64) / 2; }
__host__ __device__ __forceinline__ int perm32(int rho) { const int n = rho >> 4, i = rho & 15; return 8 * (i >> 2) + 4 * n + (i & 3); }

struct Unit { int pm, pn; };
struct Gemm { const bf16_t* A; const bf16_t* Bt; int M, N, K; };

struct StaticOrder {
    int nM, nN, nwg, G, c;
    __host__ __device__ void init(int M, int N, int G_, int c_) { nM = M / BM; nN = N / BM; nwg = nM * nN; G = G_; c = c_; }
    __host__ __device__ bool next(int i, Unit& u) const {
        const long L = (long)i * G + c; if (L >= nwg) return false;
        int wgid = (int)L; { const int q = nwg / NXCD, r = nwg % NXCD, xcd = wgid % NXCD, off = wgid / NXCD; wgid = (xcd < r ? xcd * (q + 1) : r * (q + 1) + (xcd - r) * q) + off; }
        const int nig = WGM * nN, gid = wgid / nig, fm = gid * WGM, gsz = (nM - fm) < WGM ? (nM - fm) : WGM;
        u.pm = fm + ((wgid % nig) % gsz); u.pn = (wgid % nig) / gsz; return true;
    }
    __device__ __forceinline__ void a_ready(const Unit&) const {}
    __device__ __forceinline__ void done(const Unit&) const {}
};
template <class Epi, class Sched, bool STAMP = false>
__device__ __forceinline__ void gemm_phase(PG8_LAS unsigned char* lds, const Gemm g, const Sched& S, const Epi& E, unsigned long long* stamps) {
    const int tid = otid(), wid = __builtin_amdgcn_readfirstlane(tid >> 6), lane = tid & 63, wr = wid >> 2, wc = wid & 3, fr = lane & 15, fq = lane >> 4;
    const int K = g.K, nt = K / BK;
    int ts_lo = 0, ts_hi = 0, nts = 0; const unsigned long long rt_entry = STAMP ? (unsigned long long)wall_clock64() : 0ull;
#define PG8_STAMP() do { if (STAMP && wid == 0 && nts < 64) { const unsigned long long _c = (unsigned long long)clock64(); \
        ts_lo = (lane == nts) ? (int)(unsigned)_c : ts_lo; ts_hi = (lane == nts) ? (int)(unsigned)(_c >> 32) : ts_hi; ++nts; } } while (0)
    PG8_STAMP();
    unsigned voffA[2], voffB[2];
#pragma unroll
    for (int i = 0; i < 2; ++i) { int R, C; stage_rc(tid * 16 + i * 8192, R, C); const int Rb = Epi::PERM ? ((R & ~31) + perm32(R & 31)) : R;
        voffA[i] = (unsigned)(R * K + C) * 2u; voffB[i] = (unsigned)(Rb * K + C) * 2u; }
    const size_t kstep = (size_t)(BK * 2);
    const size_t hstep = (size_t)HALF * K * 2;
    const size_t tstep = 2 * hstep;
    const unsigned ldsw = (unsigned)wid * 1024u;
    const int aoff = lds_byte(wr * 64 + fr, fq * 8), boff = lds_byte(wc * 32 + fr, fq * 8);
#define PG8_SA(b, h) (((b) * 2 + (h)) * HTB)
#define PG8_SB(b, h) ((4 + (b) * 2 + (h)) * HTB)
#define PG8_STAGE(bufoff, gbase, voff) do { _Pragma("unroll") for (int _i = 0; _i < 2; ++_i) \
        __builtin_amdgcn_global_load_lds((const unsigned*)((const char*)(gbase) + (voff)[_i]), (PG8_LAS unsigned*)(lds + (bufoff) + ldsw + _i * 8192), 16, 0, 0); } while (0)
#define PG8_LDA(dst, b, h) do { _Pragma("unroll") for (int m = 0; m < 4; ++m) _Pragma("unroll") for (int k = 0; k < 2; ++k) dst[m][k] = *(const PG8_LAS bf16x8*)(lds + PG8_SA(b, h) + aoff + m * 2048 + k * 1024); } while (0)
#define PG8_LDB(dst, b, h) do { _Pragma("unroll") for (int n = 0; n < 2; ++n) _Pragma("unroll") for (int k = 0; k < 2; ++k) dst[n][k] = *(const PG8_LAS bf16x8*)(lds + PG8_SB(b, h) + boff + n * 2048 + k * 1024); } while (0)
#define PG8_MMA(ai, bj, At, Bt) do { __builtin_amdgcn_s_setprio(1); _Pragma("unroll") for (int m = 0; m < 4; ++m) _Pragma("unroll") for (int n = 0; n < 2; ++n) _Pragma("unroll") for (int k = 0; k < 2; ++k) \
        acc[ai][bj][m][n] = __builtin_amdgcn_mfma_f32_16x16x32_bf16(Bt[n][k], At[m][k], acc[ai][bj][m][n], 0, 0, 0); __builtin_amdgcn_s_setprio(0); } while (0)
#define PG8_WAIT_V(n) asm volatile("s_waitcnt vmcnt(" #n ")" ::: "memory")
#define PG8_WAIT_L(n) asm volatile("s_waitcnt lgkmcnt(" #n ")" ::: "memory")
#define PG8_BAR __builtin_amdgcn_s_barrier()
#define PG8_SCHED __builtin_amdgcn_sched_barrier(0)
    Unit cur, nxt; int ui = 0;
    if (!S.next(0, cur)) return;
    f32x4 acc[2][2][4][2];
#pragma unroll
    for (int a = 0; a < 2; ++a)
#pragma unroll
        for (int b = 0; b < 2; ++b)
#pragma unroll
            for (int m = 0; m < 4; ++m)
#pragma unroll
                for (int n = 0; n < 2; ++n) acc[a][b][m][n] = (f32x4){0.f, 0.f, 0.f, 0.f};
    bf16x8 At[4][2], B0[2][2], B1[2][2];
    const char* cA = (const char*)g.A + (size_t)cur.pm * tstep; const char* cB = (const char*)g.Bt + (size_t)cur.pn * tstep;
    S.a_ready(cur);
    PG8_STAGE(PG8_SB(0, 0), cB, voffB); PG8_STAGE(PG8_SA(0, 0), cA, voffA); PG8_STAGE(PG8_SB(0, 1), cB + hstep, voffB); PG8_STAGE(PG8_SA(0, 1), cA + hstep, voffA);
    if (wr == 1) PG8_BAR;
    PG8_WAIT_V(4); PG8_BAR;
    PG8_STAGE(PG8_SB(1, 0), cB + kstep, voffB); PG8_STAGE(PG8_SA(1, 0), cA + kstep, voffA); PG8_STAGE(PG8_SB(1, 1), cB + hstep + kstep, voffB);
    PG8_WAIT_V(6); PG8_BAR;
    PG8_STAMP();
    for (;;) {
        const bool has_next = S.next(ui + 1, nxt);
        const char* nA = has_next ? (const char*)g.A + (size_t)nxt.pm * tstep : cA; const char* nB = has_next ? (const char*)g.Bt + (size_t)nxt.pn * tstep : cB;
        for (int t = 0; t < nt; t += 2) {
            const bool last = (t == nt - 2);
            const char* a1 = cA + (size_t)(t + 1) * kstep;
            const char* a2 = last ? nA : cA + (size_t)(t + 2) * kstep; const char* b2 = last ? nB : cB + (size_t)(t + 2) * kstep;
            const char* a3 = a2 + kstep; const char* b3 = b2 + kstep;
            if (last && has_next) S.a_ready(nxt);
            PG8_LDB(B0, 0, 0); PG8_SCHED; PG8_LDA(At, 0, 0); PG8_STAGE(PG8_SA(1, 1), a1 + hstep, voffA);
            PG8_WAIT_L(8); PG8_BAR; PG8_WAIT_L(0); PG8_MMA(0, 0, At, B0); PG8_BAR; PG8_SCHED;
            PG8_LDB(B1, 0, 1); PG8_STAGE(PG8_SB(0, 0), b2, voffB);
            PG8_BAR; PG8_WAIT_L(0); PG8_MMA(0, 1, At, B1); PG8_BAR;
            PG8_LDA(At, 0, 1); PG8_STAGE(PG8_SA(0, 0), a2, voffA);
            PG8_BAR; PG8_WAIT_L(0); PG8_MMA(1, 0, At, B0); PG8_BAR; PG8_SCHED;
            PG8_STAGE(PG8_SB(0, 1), b2 + hstep, voffB);
            PG8_WAIT_V(6); PG8_BAR; PG8_MMA(1, 1, At, B1); PG8_BAR;
            PG8_LDB(B0, 1, 0); PG8_SCHED; PG8_LDA(At, 1, 0); PG8_STAGE(PG8_SA(0, 1), a2 + hstep, voffA);
            PG8_WAIT_L(8); PG8_BAR; PG8_WAIT_L(0); PG8_MMA(0, 0, At, B0); PG8_BAR; PG8_SCHED;
            PG8_LDB(B1, 1, 1); PG8_STAGE(PG8_SB(1, 0), b3, voffB);
            PG8_BAR; PG8_WAIT_L(0); PG8_MMA(0, 1, At, B1); PG8_BAR;
            PG8_LDA(At, 1, 1); PG8_STAGE(PG8_SA(1, 0), a3, voffA);
            PG8_BAR; PG8_WAIT_L(0); PG8_MMA(1, 0, At, B0); PG8_BAR; PG8_SCHED;
            PG8_STAGE(PG8_SB(1, 1), b3 + hstep, voffB);
            PG8_WAIT_V(6); PG8_BAR; PG8_MMA(1, 1, At, B1); PG8_BAR;
        }
        PG8_STAMP();
        if constexpr (!Epi::AFTER_DRAIN) { E(acc, cur, wr, wc, fr, fq); S.done(cur); }
        PG8_STAMP();
        if (!has_next) break;
#pragma unroll
        for (int a = 0; a < 2; ++a)
#pragma unroll
            for (int b = 0; b < 2; ++b)
#pragma unroll
                for (int m = 0; m < 4; ++m)
#pragma unroll
                    for (int n = 0; n < 2; ++n) acc[a][b][m][n] = (f32x4){0.f, 0.f, 0.f, 0.f};
        cur = nxt; cA = nA; cB = nB; ++ui;
    }
    PG8_WAIT_V(0);
    if (wr == 0) PG8_BAR;
    PG8_BAR;
    if constexpr (Epi::AFTER_DRAIN) { E.fused(acc, cur, wr, wc, fr, fq, lds, wid, lane); S.done(cur); }
    PG8_STAMP();
    if (STAMP && wid == 0) { stamps[lane] = lane < nts ? (((unsigned long long)(unsigned)ts_hi << 32) | (unsigned)ts_lo) : 0ull;
        if (lane == 62) stamps[62] = rt_entry; if (lane == 63) stamps[63] = (unsigned long long)wall_clock64(); }
#undef PG8_STAMP
#undef PG8_SA
#undef PG8_SB
#undef PG8_STAGE
#undef PG8_LDA
#undef PG8_LDB
#undef PG8_MMA
#undef PG8_WAIT_V
#undef PG8_WAIT_L
#undef PG8_BAR
#undef PG8_SCHED
}
}

enum { EPI_IN = 0, EPI_OUT = 1, EPI_UP = 2, EPI_DOWN = 3 };
template <int MODE>
struct Epi {
  static constexpr bool PERM = true, AFTER_DRAIN = false;
  Params p; int l;
  DI void operator()(const f32x4 (&acc)[2][2][4][2], const pg8::Unit& u, int wr, int wc, int fr, int fq) const {
    const int colb = u.pn * 256 + wc * 32 + 8 * fq;
#pragma unroll
    for (int ai = 0; ai < 2; ++ai)
#pragma unroll
      for (int m = 0; m < 4; ++m) {
        const int row = u.pm * 256 + ai * 128 + wr * 64 + m * 16 + fr;
        if (row < M) {
#pragma unroll
          for (int bj = 0; bj < 2; ++bj) {
            const int col = colb + bj * 128;
            const f32x4 v0 = acc[ai][bj][m][0], v1 = acc[ai][bj][m][1];
            if (MODE == EPI_IN) {
              bf16_t* Z = (bf16_t*)(p.ws + W_Z);
              const int seg = u.pn >> 2;
              if (seg <= 1) {
                const int pos = row < MP ? (row & (SEQ - 1)) : PAST + ((row - MP) & 15);
                const int d0 = (col & 63) >> 1;
                const f32x4* rp = (const f32x4*)((const float2*)(p.ws + W_ROPE) + pos * 32 + d0);
                const f32x4 c01 = rp[0], c23 = rp[1];
                const float a0 = v0[0] * c01[0] - v0[1] * c01[1], b0 = v0[1] * c01[0] + v0[0] * c01[1];
                const float a1 = v0[2] * c01[2] - v0[3] * c01[3], b1 = v0[3] * c01[2] + v0[2] * c01[3];
                const float a2 = v1[0] * c23[0] - v1[1] * c23[1], b2 = v1[1] * c23[0] + v1[0] * c23[1];
                const float a3 = v1[2] * c23[2] - v1[3] * c23[3], b3 = v1[3] * c23[2] + v1[2] * c23[3];
                const float qs = seg == 0 ? 0.125f : 1.f;
                u32x4 o; o[0] = pk2(a0 * qs, b0 * qs); o[1] = pk2(a1 * qs, b1 * qs); o[2] = pk2(a2 * qs, b2 * qs); o[3] = pk2(a3 * qs, b3 * qs);
                *(u32x4*)(Z + (size_t)row * NIN + col) = o;
                if (seg == 1) {
                  float* ob = (row < MP ? p.out + O_KP + ((size_t)l * MP + row) * 1024 : p.out + O_KS + ((size_t)l * MS + row - MP) * 1024) + ((col - 1024) & ~63) + d0;
                  f32x4 o1, o2; o1[0] = a0; o1[1] = a1; o1[2] = a2; o1[3] = a3; o2[0] = b0; o2[1] = b1; o2[2] = b2; o2[3] = b3;
                  *(f32x4*)ob = o1; *(f32x4*)(ob + 32) = o2;
                }
              } else {
                u32x4 o; o[0] = pk2(v0[0], v0[1]); o[1] = pk2(v0[2], v0[3]); o[2] = pk2(v1[0], v1[1]); o[3] = pk2(v1[2], v1[3]);
                *(u32x4*)(Z + (size_t)row * NIN + col) = o;
                if (seg == 2) {
                  float* ob = (row < MP ? p.out + O_VP + ((size_t)l * MP + row) * 1024 : p.out + O_VS + ((size_t)l * MS + row - MP) * 1024) + (col - 2048);
                  *(f32x4*)ob = v0; *(f32x4*)(ob + 4) = v1;
                } else if (seg == 3 || seg == 4) {
                  float* ob = nullptr;
                  if (row < MP) { const int s = row & (SEQ - 1); if (s >= SEQ - 3) ob = p.out + O_MCP + ((size_t)(l * 4 + (row >> 13)) * 3 + (s - (SEQ - 3))) * 2048 + col - 3072; }
                  else { const int t = (row - MP) & 15, b = (row - MP) >> 4; if (t >= 13) ob = p.out + O_MCS + ((size_t)(l * 8 + b) * 3 + (t - 13)) * 2048 + col - 3072; }
                  if (ob) { *(f32x4*)ob = v0; *(f32x4*)(ob + 4) = v1; }
                }
              }
            } else if (MODE == EPI_OUT || MODE == EPI_DOWN) {
              float* R = (float*)(p.ws + W_R) + (size_t)row * D + col;
              const float* rs = MODE == EPI_OUT ? xrow_ptr(p, l, row) + col : R;
              const f32x4 r0 = *(const f32x4*)rs, r1 = *(const f32x4*)(rs + 4);
              *(f32x4*)R = r0 * ALPHA + v0; *(f32x4*)(R + 4) = r1 * ALPHA + v1;
            } else {
              bf16_t* U = (bf16_t*)(p.ws + W_Z);
              u32x4 o; o[0] = pk2(v0[0], v0[1]); o[1] = pk2(v0[2], v0[3]); o[2] = pk2(v1[0], v1[1]); o[3] = pk2(v1[2], v1[3]);
              *(u32x4*)(U + (size_t)row * NUP + col) = o;
              float* ob = nullptr;
              if (row < MP) { const int s = row & (SEQ - 1); if (s >= SEQ - 2) ob = p.out + O_FCP + ((size_t)(l * 4 + (row >> 13)) * 2 + (s - (SEQ - 2))) * NUP + col; }
              else { const int t = (row - MP) & 15, b = (row - MP) >> 4; if (t >= 14) ob = p.out + O_FCS + ((size_t)(l * 8 + b) * 2 + (t - 14)) * NUP + col; }
              if (ob) { *(f32x4*)ob = v0; *(f32x4*)(ob + 4) = v1; }
            }
          }
        }
      }
  }
};

template <int MODE>
DI void gemm_phase(const Params& p, int l, const bf16_t* A, int lda, const bf16_t* Bt, int K, int ntn, char* lds) {
  (void)lda;
  pg8::Gemm g; g.A = A; g.Bt = Bt; g.M = NTM * 256; g.N = ntn * 256; g.K = K;
  pg8::StaticOrder S; S.init(g.M, g.N, (int)gridDim.x, (int)blockIdx.x);
  Epi<MODE> E; E.p = p; E.l = l;
  pg8::gemm_phase<Epi<MODE>, pg8::StaticOrder, false>((PG8_LAS unsigned char*)lds, g, S, E, nullptr);
  __syncthreads();
}

DI void gif_phase(const Params& p, int l, char* lds) {
  const int tidq = otid(); const int lane = tidq & 63, gw = blockIdx.x * 8 + (tidq >> 6), ngw = gridDim.x * 8;
  const float* w = p.in[9] + (size_t)l * D * DIN + 7168;
  const float* bif = p.in[10] + l * 8;
  float* gif = (float*)(p.ws + W_GIF);
  float* w8 = (float*)lds;
  __syncthreads();
#pragma unroll
  for (int i = 0; i < 2; ++i) {
    const int k = tidq + 512 * i;
    *(f32x4*)(w8 + k * 8) = *(const f32x4*)(w + (size_t)k * DIN); *(f32x4*)(w8 + k * 8 + 4) = *(const f32x4*)(w + (size_t)k * DIN + 4);
  }
  __syncthreads();
  for (int rg = gw; rg < M / 4; rg += ngw) {
    float acc[4][8];
#pragma unroll
    for (int a = 0; a < 4; ++a)
#pragma unroll
      for (int j = 0; j < 8; ++j) acc[a][j] = 0.f;
    const float* x0 = xrow_ptr(p, l, rg * 4);
#pragma unroll 4
    for (int kk = 0; kk < 16; ++kk) {
      const int k = kk * 64 + lane;
      const f32x4 w0 = *(const f32x4*)(w8 + k * 8), w1 = *(const f32x4*)(w8 + k * 8 + 4);
#pragma unroll
      for (int a = 0; a < 4; ++a) {
        const float xv = x0[(size_t)a * D + k];
        acc[a][0] += xv * w0[0]; acc[a][1] += xv * w0[1]; acc[a][2] += xv * w0[2]; acc[a][3] += xv * w0[3];
        acc[a][4] += xv * w1[0]; acc[a][5] += xv * w1[1]; acc[a][6] += xv * w1[2]; acc[a][7] += xv * w1[3];
      }
    }
#pragma unroll
    for (int a = 0; a < 4; ++a)
#pragma unroll
      for (int j = 0; j < 8; ++j) {
        const float s = wave_sum(acc[a][j]);
        if (lane == 0) gif[(size_t)(rg * 4 + a) * 8 + j] = s + bif[j];
      }
  }
  __syncthreads();
}

DI void qkconv_phase(const Params& p, int l) {
  const bf16_t* Z = (const bf16_t*)(p.ws + W_Z);
  bf16_t* QA = (bf16_t*)(p.ws + W_AB); bf16_t* KA = (bf16_t*)(p.ws + W_KA);
  const float* cw = p.in[11] + (size_t)l * 4 * 2048; const float* cb = p.in[12] + (size_t)l * 2048;
  const size_t total = (size_t)(M / 4) * 256;
  for (size_t it = (size_t)blockIdx.x * NTH + otid(); it < total; it += (size_t)gridDim.x * NTH) {
    const int cc = (int)(it & 255), rg = (int)(it >> 8), col = cc * 8, row0 = rg * 4;
    int t0, hist_rows;
    const float* st = nullptr;
    if (row0 < MP) { t0 = row0 & (SEQ - 1); }
    else { t0 = (row0 - MP) & 15; st = p.in[4] + ((size_t)(l * 8 + ((row0 - MP) >> 4)) * 3) * 2048 + col; }
    (void)hist_rows;
    float w[4][8], bias[8];
#pragma unroll
    for (int j = 0; j < 4; ++j) { f32x4 a = *(const f32x4*)(cw + j * 2048 + col), b = *(const f32x4*)(cw + j * 2048 + col + 4);
      w[j][0] = a[0]; w[j][1] = a[1]; w[j][2] = a[2]; w[j][3] = a[3]; w[j][4] = b[0]; w[j][5] = b[1]; w[j][6] = b[2]; w[j][7] = b[3]; }
    { f32x4 a = *(const f32x4*)(cb + col), b = *(const f32x4*)(cb + col + 4);
      bias[0] = a[0]; bias[1] = a[1]; bias[2] = a[2]; bias[3] = a[3]; bias[4] = b[0]; bias[5] = b[1]; bias[6] = b[2]; bias[7] = b[3]; }
    float x[7][8];
#pragma unroll
    for (int j = 0; j < 7; ++j) {
      const int t = t0 - 3 + j;
      if (t >= 0) { u32x4 v = *(const u32x4*)(Z + (size_t)(row0 - 3 + j) * NIN + 3072 + col); unpack8(v, x[j]); }
      else if (st) { f32x4 a = *(const f32x4*)(st + (size_t)(3 + t) * 2048), b = *(const f32x4*)(st + (size_t)(3 + t) * 2048 + 4);
        x[j][0] = a[0]; x[j][1] = a[1]; x[j][2] = a[2]; x[j][3] = a[3]; x[j][4] = b[0]; x[j][5] = b[1]; x[j][6] = b[2]; x[j][7] = b[3]; }
      else {
#pragma unroll
        for (int e = 0; e < 8; ++e) x[j][e] = 0.f; }
    }
    const float sc = col >= 1024 ? 0.0625f : 1.f;
    bf16_t* dst = col >= 1024 ? KA + (col - 1024) : QA + col;
#pragma unroll
    for (int a = 0; a < 4; ++a) {
      float o[8];
#pragma unroll
      for (int e = 0; e < 8; ++e) {
        float u = bias[e] + w[0][e] * x[a][e] + w[1][e] * x[a + 1][e] + w[2][e] * x[a + 2][e] + w[3][e] * x[a + 3][e];
        o[e] = u * sigmoidf_(u) * sc;
      }
      u32x4 ov; ov[0] = pk2(o[0], o[1]); ov[1] = pk2(o[2], o[3]); ov[2] = pk2(o[4], o[5]); ov[3] = pk2(o[6], o[7]);
      *(u32x4*)(dst + (size_t)(row0 + a) * D) = ov;
    }
  }
}

constexpr int A_LD = 272;
constexpr int A_TILE = 64 * A_LD;
template <int KIND>
DI void attn_item(const Params& p, int l, int b, int ha, int qb, char* lds) {
  const int tid = otid(), lane = tid & 63, wave = uni(tid >> 6);
  const int map = wave >> 2, qt = wave & 3, r = lane & 31, h = lane >> 5;
  const bf16_t* Z = (const bf16_t*)(p.ws + W_Z);
  const int NT = KIND == 0 ? 2 * (qb + 1) : (NKS + 63) / 64;
  const int ntw = KIND == 0 ? 2 * qb + (qt >> 1) + 1 : NT;
  const bool active = KIND == 0 ? true : (qt == 0);
  int qrow;
  if (KIND == 0) qrow = b * SEQ + qb * 128 + qt * 32 + r; else qrow = MP + b * 16 + (r < 16 ? r : 15);
  bf16x8 qf[4];
#pragma unroll
  for (int ks = 0; ks < 4; ++ks) {
    if (KIND == 0) qf[ks] = *(const bf16x8*)(Z + (size_t)qrow * NIN + ha * 128 + map * 64 + ks * 16 + h * 8);
    else {
      const int dn = ks * 16 + h * 8, par = dn >> 5, dd = dn & 31;
      const bf16_t* src = Z + (size_t)qrow * NIN + ha * 128 + map * 64 + 2 * dd;
      const u32x4 lo = *(const u32x4*)src, hi = *(const u32x4*)(src + 8);
      unsigned e[8];
#pragma unroll
      for (int i = 0; i < 4; ++i) { e[i] = par ? (lo[i] >> 16) : (lo[i] & 0xffffu); e[4 + i] = par ? (hi[i] >> 16) : (hi[i] & 0xffffu); }
      u32x4 o; o[0] = e[0] | (e[1] << 16); o[1] = e[2] | (e[3] << 16); o[2] = e[4] | (e[5] << 16); o[3] = e[6] | (e[7] << 16);
      qf[ks] = __builtin_bit_cast(bf16x8, o);
    }
  }
  const int skey = tid >> 4, part = tid & 15;
  u32x4 rk0, rk1, rv0, rv1;
  auto gload = [&](int j) {
    if (KIND == 0) {
      const bf16_t* base = Z + (size_t)(b * SEQ + j * 64 + skey) * NIN + 1024 + ha * 128 + part * 8;
      rk0 = *(const u32x4*)base; rk1 = *(const u32x4*)(base + (size_t)32 * NIN);
      rv0 = *(const u32x4*)(base + 1024); rv1 = *(const u32x4*)(base + (size_t)32 * NIN + 1024);
    } else {
#pragma unroll
      for (int i = 0; i < 2; ++i) {
        int kk = j * 64 + skey + 32 * i; if (kk > NKS - 1) kk = NKS - 1;
        const float *ks_, *vs_;
        if (kk < PAST) { const size_t o = (((size_t)(l * 8 + b) * PAST + kk) * 8 + ha) * 128 + part * 8; ks_ = p.in[2] + o; vs_ = p.in[3] + o; }
        else { const size_t o = (((size_t)l * MS + b * 16 + (kk - PAST)) * 8 + ha) * 128 + part * 8; ks_ = p.out + O_KS + o; vs_ = p.out + O_VS + o; }
        const f32x4 a0 = *(const f32x4*)ks_, a1 = *(const f32x4*)(ks_ + 4), c0 = *(const f32x4*)vs_, c1 = *(const f32x4*)(vs_ + 4);
        u32x4 ko, vo;
        ko[0] = pk2(a0[0], a0[1]); ko[1] = pk2(a0[2], a0[3]); ko[2] = pk2(a1[0], a1[1]); ko[3] = pk2(a1[2], a1[3]);
        vo[0] = pk2(c0[0], c0[1]); vo[1] = pk2(c0[2], c0[3]); vo[2] = pk2(c1[0], c1[1]); vo[3] = pk2(c1[2], c1[3]);
        if (i == 0) { rk0 = ko; rv0 = vo; } else { rk1 = ko; rv1 = vo; }
      }
    }
  };
  f32x16 O[4];
#pragma unroll
  for (int v = 0; v < 4; ++v)
#pragma unroll
    for (int i = 0; i < 16; ++i) O[v][i] = 0.f;
  float m_run = -1e30f, l_run = 0.f;
  const int q4 = (lane & 15) >> 2, p4 = lane & 3, blk = (lane >> 4) & 1;
  const unsigned sofs = skey * A_LD + part * 16;
  auto qk = [&](int j, f32x16 (&st)[2]) {
    const char* kb = lds + (j & 1) * A_TILE;
#pragma unroll
    for (int kt = 0; kt < 2; ++kt) {
#pragma unroll
      for (int i = 0; i < 16; ++i) st[kt][i] = 0.f;
#pragma unroll
      for (int ks = 0; ks < 4; ++ks) {
        const bf16x8 kf = *(const bf16x8*)(kb + (kt * 32 + r) * A_LD + (map * 64 + ks * 16 + h * 8) * 2);
        st[kt] = MFMA32(kf, qf[ks], st[kt]);
      }
    }
    if (KIND == 1 && j == NT - 1) {
#pragma unroll
      for (int kt = 0; kt < 2; ++kt)
#pragma unroll
        for (int i = 0; i < 16; ++i) if (j * 64 + kt * 32 + crow(i, h) >= NKS) st[kt][i] = -1e30f;
    }
  };
  bf16x8 pk[4];
  auto smax = [&](int j, f32x16 (&sc)[2], f32x16 (&sn)[2]) {
    if (j + 1 < ntw) qk(j + 1, sn);
    float mx = sc[0][0];
#pragma unroll
    for (int kt = 0; kt < 2; ++kt)
#pragma unroll
      for (int i = 0; i < 16; ++i) mx = fmaxf(mx, sc[kt][i]);
    mx = fmaxf(mx, __shfl_xor(mx, 32));
    const float m_new = fmaxf(m_run, mx);
    const float alpha = __builtin_amdgcn_exp2f((m_run - m_new) * LOG2E);
    const float mb = m_new * LOG2E;
    float rs = 0.f;
#pragma unroll
    for (int kt = 0; kt < 2; ++kt)
#pragma unroll
      for (int i = 0; i < 16; ++i) { const float e = __builtin_amdgcn_exp2f(sc[kt][i] * LOG2E - mb); sc[kt][i] = e; rs += e; }
    rs += __shfl_xor(rs, 32);
    l_run = l_run * alpha + rs; m_run = m_new;
    if (__builtin_amdgcn_ballot_w64(alpha != 1.f) != 0ull) {
#pragma unroll
      for (int v = 0; v < 4; ++v)
#pragma unroll
        for (int i = 0; i < 16; ++i) O[v][i] *= alpha;
    }
    pk[0] = pack8(sc[0], 0); pk[1] = pack8(sc[0], 1); pk[2] = pack8(sc[1], 0); pk[3] = pack8(sc[1], 1);
  };
  auto pv = [&](int j) {
    const unsigned vaddr = lds_addr(lds + (2 + j % 3) * A_TILE) + (4 * h + q4) * A_LD + (16 * blk + 4 * p4) * 2;
#pragma unroll
    for (int vt = 0; vt < 4; ++vt) {
      bf16x8 vf[4];
      tr_frag4<16 * A_LD, 8 * A_LD>(vaddr + vt * 64, vf);
#pragma unroll
      for (int ks = 0; ks < 4; ++ks) O[vt] = MFMA32(vf[ks], pk[ks], O[vt]);
    }
  };
  gload(0);
  { char* kb = lds + sofs; *(u32x4*)kb = rk0; *(u32x4*)(kb + 32 * A_LD) = rk1; char* vb = lds + 2 * A_TILE + sofs; *(u32x4*)vb = rv0; *(u32x4*)(vb + 32 * A_LD) = rv1; }
  gload(1);
  { char* kb = lds + A_TILE + sofs; *(u32x4*)kb = rk0; *(u32x4*)(kb + 32 * A_LD) = rk1; }
  __syncthreads();
  f32x16 sA[2], sB[2];
  if (active && 0 < ntw) qk(0, sA);
  for (int j = 0; j < NT; j += 2) {
#pragma unroll
    for (int u = 0; u < 2; ++u) {
      const int jj = j + u;
      if (jj < NT) {
        if (jj + 1 < NT) { char* vb = lds + (2 + (jj + 1) % 3) * A_TILE + sofs; *(u32x4*)vb = rv0; *(u32x4*)(vb + 32 * A_LD) = rv1; }
        if (jj + 2 < NT) gload(jj + 2);
        if (active) {
          if (map == 1 && jj >= 1 && jj - 1 < ntw) pv(jj - 1);
          if (jj < ntw) { if (u == 0) smax(jj, sA, sB); else smax(jj, sB, sA); }
          if (map == 0 && jj < ntw) pv(jj);
        }
        if (jj + 2 < NT) { char* kb = lds + (jj & 1) * A_TILE + sofs; *(u32x4*)kb = rk0; *(u32x4*)(kb + 32 * A_LD) = rk1; }
        __syncthreads();
      }
    }
  }
  if (active && map == 1 && ntw == NT) pv(NT - 1);
  __syncthreads();
  float* ex = (float*)lds;
  const float inv_l = 1.f / l_run;
  if (map == 1) {
#pragma unroll
    for (int vt = 0; vt < 4; ++vt)
#pragma unroll
      for (int g = 0; g < 4; ++g) {
        f32x4 o; o[0] = O[vt][4 * g] * inv_l; o[1] = O[vt][4 * g + 1] * inv_l; o[2] = O[vt][4 * g + 2] * inv_l; o[3] = O[vt][4 * g + 3] * inv_l;
        *(f32x4*)(ex + (qt * 32 + r) * 132 + vt * 32 + 8 * g + 4 * h) = o;
      }
  }
  __syncthreads();
  if (map == 0) {
    const float lam = ((const float*)(p.ws + W_MISC))[l];
    const float lam_init = (l == 0) ? 0.2f : (0.8f - 0.6f * 0.74081822068171788f);
    float ssq = 0.f;
#pragma unroll
    for (int vt = 0; vt < 4; ++vt)
#pragma unroll
      for (int g = 0; g < 4; ++g) {
        const f32x4 o2 = *(const f32x4*)(ex + (qt * 32 + r) * 132 + vt * 32 + 8 * g + 4 * h);
#pragma unroll
        for (int e = 0; e < 4; ++e) { const float o = O[vt][4 * g + e] * inv_l - lam * o2[e]; O[vt][4 * g + e] = o; ssq += o * o; }
      }
    ssq += __shfl_xor(ssq, 32);
    const float rms = rsqrtf(ssq * (1.f / 128.f) + LN_EPS) * (1.f - lam_init);
    const float* sg = p.in[14] + l * 128;
    const bool valid = KIND == 0 ? true : (qt == 0 && r < 16);
    if (valid) {
      bf16_t* dst = (bf16_t*)(p.ws + W_Z) + (size_t)qrow * NIN + 3072 + ha * 128;
#pragma unroll
      for (int vt = 0; vt < 4; ++vt)
#pragma unroll
        for (int g = 0; g < 4; ++g) {
          const int v0 = vt * 32 + 8 * g + 4 * h;
          const f32x4 gg = *(const f32x4*)(sg + v0);
          u32x2 o; o[0] = pk2(O[vt][4 * g] * rms * gg[0], O[vt][4 * g + 1] * rms * gg[1]); o[1] = pk2(O[vt][4 * g + 2] * rms * gg[2], O[vt][4 * g + 3] * rms * gg[3]);
          *(u32x2*)(dst + v0) = o;
        }
    }
  }
  __syncthreads();
}

constexpr int L_LD = 528;
constexpr int L_VLD = 272;
constexpr int L_Q = 0, L_K = 64 * L_LD, L_V = 2 * 64 * L_LD, L_SW = L_V + 64 * L_VLD;
constexpr int L_SWLD = 144;
constexpr int L_SC = L_SW + 64 * L_SWLD;
constexpr int S_MX = 0, S_G = 64, S_EMT = 128, S_DS0 = 192, S_DS1 = 256, S_QN = 320  , S_NV = 576  , S_GEND = 832, S_PAR = 840;
constexpr int LDS_BYTES = 153376;
static_assert(L_SC + 2 * S_PAR * 4 <= 131072, "lds");
#define WG_BAR() do { __builtin_amdgcn_fence(__ATOMIC_RELEASE, "workgroup"); __builtin_amdgcn_s_barrier(); __builtin_amdgcn_fence(__ATOMIC_ACQUIRE, "workgroup"); } while (0)

template <int KIND>
DI void mlstm_item(const Params& p, int l, int b, int hm, int half, char* lds) {
  const int tid0 = otid(), wave = uni(tid0 >> 6);
  const bf16_t* QA = (const bf16_t*)(p.ws + W_AB); const bf16_t* KA = (const bf16_t*)(p.ws + W_KA);
  const bf16_t* Z = (const bf16_t*)(p.ws + W_Z); bf16_t* H = (bf16_t*)(p.ws + W_H);
  const float* GIF = (const float*)(p.ws + W_GIF);
  float* scb = (float*)(lds + L_SC);
  int nchunks = KIND == 0 ? SEQ / 64 : 1; asm volatile("" : "+s"(nchunks));
  const int Lv = KIND == 0 ? 64 : 16;
  const size_t bh = KIND == 0 ? (size_t)(l * 4 + b) * 4 + hm : (size_t)(l * 8 + b) * 4 + hm;
  if (wave < 4) {
    f32x16 C[8];
    { const int lane = tid0 & 63, r = lane & 31, h = lane >> 5; (void)r; (void)h;
      if (KIND == 0) {
#pragma unroll
        for (int d = 0; d < 8; ++d)
#pragma unroll
          for (int i = 0; i < 16; ++i) C[d][i] = 0.f;
      } else {
        const float* cp = p.in[5] + bh * 65536 + (size_t)(4 * h) * 256 + half * 128 + wave * 32 + r;
#pragma unroll
        for (int d = 0; d < 8; ++d)
#pragma unroll
          for (int g = 0; g < 4; ++g) {
            C[d][4 * g] = cp[0]; C[d][4 * g + 1] = cp[256]; C[d][4 * g + 2] = cp[512]; C[d][4 * g + 3] = cp[768];
            cp += 2048; asm volatile("" : "+v"(cp));
          }
      }
    }
    for (int c = 0; c < nchunks; ++c) {
      int tid = tid0; asm volatile("" : "+v"(tid));
      const int lane = tid & 63, r = lane & 31, h = lane >> 5;
      const int q4 = (lane & 15) >> 2, p4 = lane & 3, blk = (lane >> 4) & 1;
      const float* sc = scb + (c & 1) * S_PAR;
      const int rowbase = KIND == 0 ? b * SEQ + c * 64 : MP + b * 16;
      WG_BAR();
      f32x16 accB[2];
#pragma unroll
      for (int tt = 0; tt < 2; ++tt)
#pragma unroll
        for (int i = 0; i < 16; ++i) accB[tt][i] = 0.f;
#pragma unroll
      for (int d = 0; d < 8; ++d)
#pragma unroll
        for (int s = 0; s < 2; ++s) {
          __builtin_amdgcn_sched_barrier(0);
          const bf16x8 cf = pack8(C[d], s);
#pragma unroll
          for (int tt = 0; tt < 2; ++tt) {
            const char* qp = lds + L_Q + (tt * 32 + r) * L_LD + (d * 32 + 16 * s + 4 * h) * 2;
            const s16x4 lo = *(const s16x4*)qp, hi = *(const s16x4*)(qp + 16);
            const bf16x8 qfr = __builtin_shufflevector(lo, hi, 0, 1, 2, 3, 4, 5, 6, 7);
            accB[tt] = MFMA32(cf, qfr, accB[tt]);
          }
        }
      __builtin_amdgcn_sched_barrier(0);
      bf16x8 vf[4];
      tr_frag4<16 * L_VLD, 4 * L_VLD>(lds_addr(lds + L_V) + (8 * h + q4) * L_VLD + (wave * 32 + 16 * blk + 4 * p4) * 2, vf);
      const float g_end = sc[S_GEND];
#pragma unroll
      for (int d = 0; d < 8; ++d) {
#pragma unroll
        for (int i = 0; i < 16; ++i) C[d][i] *= g_end;
        bf16x8 kf[4];
        tr_frag4<16 * L_LD, 4 * L_LD>(lds_addr(lds + L_K) + (8 * h + q4) * L_LD + (d * 32 + 16 * blk + 4 * p4) * 2, kf);
#pragma unroll
        for (int ks = 0; ks < 4; ++ks) C[d] = MFMA32(kf[ks], vf[ks], C[d]);
      }
      WG_BAR();
#pragma unroll
      for (int tt = 0; tt < 2; ++tt) {
        const int t = tt * 32 + r;
        const float g = sc[S_G + t];
#pragma unroll
        for (int i = 0; i < 16; ++i) accB[tt][i] *= g;
        const char* sp = lds + L_SW + (tt * 32 + r) * L_SWLD + h * 16;
#pragma unroll
        for (int ks = 0; ks < 4; ++ks) accB[tt] = MFMA32(vf[ks], *(const bf16x8*)(sp + ks * 32), accB[tt]);
        const float qn = (sc[S_QN + t] + sc[S_QN + 64 + t]) + (sc[S_QN + 128 + t] + sc[S_QN + 192 + t]);
        float den = sc[S_DS0 + t] + sc[S_DS1 + t] + g * qn;
        den = fmaxf(fabsf(den), sc[S_EMT + t]);
        const float rden = 1.f / den;
        if (t < Lv) {
          bf16_t* dst = H + (size_t)(rowbase + t) * D + hm * 256 + half * 128 + wave * 32;
#pragma unroll
          for (int g4 = 0; g4 < 4; ++g4) {
            u32x2 o; o[0] = pk2(accB[tt][4 * g4] * rden, accB[tt][4 * g4 + 1] * rden); o[1] = pk2(accB[tt][4 * g4 + 2] * rden, accB[tt][4 * g4 + 3] * rden);
            *(u32x2*)(dst + 8 * g4 + 4 * h) = o;
          }
        }
      }
    }
    WG_BAR();
    {
      const int lane = tid0 & 63, r = lane & 31, h = lane >> 5;
      float* co = p.out + (KIND == 0 ? O_CP : O_CS) + bh * 65536 + (size_t)(4 * h) * 256 + half * 128 + wave * 32 + r;
#pragma unroll
      for (int d = 0; d < 8; ++d)
#pragma unroll
        for (int g = 0; g < 4; ++g) {
          co[0] = C[d][4 * g]; co[256] = C[d][4 * g + 1]; co[512] = C[d][4 * g + 2]; co[768] = C[d][4 * g + 3];
          co += 2048; asm volatile("" : "+v"(co));
        }
    }
  } else {
    const int hw = wave - 4;
    float nreg = 0.f, m_prev = 0.f;
    if (KIND == 1) { nreg = p.in[6][bh * 256 + (tid0 - 256)]; m_prev = p.in[7][bh]; }
    u32x4 pq[8], pk[8], pv[4];
    float gi = 0.f, gf = 0.f, g_end_cur = 0.f;
    auto issue_loads = [&](int c, int tid) {
      const int ht = tid - 256, lane = tid & 63;
      const int rowbase = KIND == 0 ? b * SEQ + c * 64 : MP + b * 16;
      const bool tvalid = lane < Lv;
      gi = tvalid ? GIF[(size_t)(rowbase + lane) * 8 + hm] : -1e30f;
      gf = tvalid ? GIF[(size_t)(rowbase + lane) * 8 + 4 + hm] : 0.f;
#pragma unroll
      for (int i = 0; i < 8; ++i) {
        const int cidx = ht + 256 * i, t = cidx >> 5, pc = cidx & 31;
        const int row = rowbase + (t < Lv ? t : Lv - 1);
        pq[i] = *(const u32x4*)(QA + (size_t)row * D + hm * 256 + pc * 8);
        pk[i] = *(const u32x4*)(KA + (size_t)row * D + hm * 256 + pc * 8);
      }
#pragma unroll
      for (int i = 0; i < 4; ++i) {
        const int cidx = ht + 256 * i, t = cidx >> 4, pc = cidx & 15;
        const int row = rowbase + (t < Lv ? t : Lv - 1);
        pv[i] = *(const u32x4*)(Z + (size_t)row * NIN + 5120 + hm * 256 + half * 128 + pc * 8);
      }
    };
    auto scalars = [&](int par, int lane) -> float {
      const bool tvalid = lane < Lv;
      const float lf = tvalid ? (fminf(gf, 0.f) - __logf(1.f + __expf(-fabsf(gf)))) : 0.f;
      float bc = lf;
#pragma unroll
      for (int o = 1; o < 64; o <<= 1) { const float v = __shfl_up(bc, o); if (lane >= o) bc += v; }
      const float a = gi - bc;
      float cm = a;
#pragma unroll
      for (int o = 1; o < 64; o <<= 1) { const float v = __shfl_up(cm, o); if (lane >= o) cm = fmaxf(cm, v); }
      const float mxv = fmaxf(m_prev, cm);
      const float m_t = bc + mxv;
      const float mx_end = __shfl(mxv, 63), bc_end = __shfl(bc, 63);
      const float wend = __expf(a - mx_end);
      g_end_cur = __expf(m_prev - mx_end);
      if (hw == 0) {
        float* sc = scb + par * S_PAR;
        sc[S_MX + lane] = __expf(mx_end - mxv);
        sc[S_G + lane] = __expf(m_prev - mxv);
        sc[S_EMT + lane] = __expf(-m_t);
        if (lane == 0) sc[S_GEND] = g_end_cur;
      }
      m_prev = bc_end + mx_end;
      return wend;
    };
    auto stage_lds = [&](float wend_l, int tid) {
      const int ht = tid - 256;
#pragma unroll
      for (int i = 0; i < 8; ++i) {
        const int cidx = ht + 256 * i, t = cidx >> 5, pc = cidx & 31;
        const float we = __shfl(wend_l, t);
        float f[8]; unpack8(pk[i], f);
        u32x4 o; o[0] = pk2(f[0] * we, f[1] * we); o[1] = pk2(f[2] * we, f[3] * we); o[2] = pk2(f[4] * we, f[5] * we); o[3] = pk2(f[6] * we, f[7] * we);
        *(u32x4*)(lds + L_Q + t * L_LD + pc * 16) = pq[i];
        *(u32x4*)(lds + L_K + t * L_LD + pc * 16) = o;
      }
#pragma unroll
      for (int i = 0; i < 4; ++i) {
        const int cidx = ht + 256 * i, t = cidx >> 4, pc = cidx & 15;
        *(u32x4*)(lds + L_V + t * L_VLD + pc * 16) = pv[i];
      }
    };
    {
      int tid = tid0; asm volatile("" : "+v"(tid));
      issue_loads(0, tid);
      scb[S_NV + (tid - 256)] = nreg;
      const float wend = scalars(0, tid & 63);
      stage_lds(wend, tid);
    }
    for (int c = 0; c < nchunks; ++c) {
      int tid = tid0; asm volatile("" : "+v"(tid));
      const int ht = tid - 256, lane = tid & 63, r = lane & 31, h = lane >> 5;
      float* sc = scb + (c & 1) * S_PAR;
      float* scn = scb + ((c + 1) & 1) * S_PAR;
      const float g_end_c = g_end_cur;
      WG_BAR();
      const bool more = c + 1 < nchunks;
      if (more) issue_loads(c + 1, tid);
      {
        const int t = ht & 63, part = ht >> 6;
        const char* qp = lds + L_Q + t * L_LD + part * 128;
        float s = 0.f;
#pragma unroll
        for (int e = 0; e < 8; ++e) {
          const u32x4 qq = *(const u32x4*)(qp + e * 16); float f[8]; unpack8(qq, f);
#pragma unroll
          for (int z = 0; z < 8; ++z) s += f[z] * sc[S_NV + part * 64 + e * 8 + z];
        }
        sc[S_QN + part * 64 + t] = s;
      }
      if (hw < 3) {
        const int stl = hw == 2 ? 1 : 0, tt = hw == 0 ? 0 : 1;
        f32x16 S, S2;
#pragma unroll
        for (int i = 0; i < 16; ++i) { S[i] = 0.f; S2[i] = 0.f; }
        const char* ka = lds + L_K + (stl * 32 + r) * L_LD + h * 16;
        const char* qa = lds + L_Q + (tt * 32 + r) * L_LD + h * 16;
#pragma unroll 4
        for (int ks = 0; ks < 16; ks += 2) {
          S = MFMA32(*(const bf16x8*)(ka + ks * 32), *(const bf16x8*)(qa + ks * 32), S);
          S2 = MFMA32(*(const bf16x8*)(ka + ks * 32 + 32), *(const bf16x8*)(qa + ks * 32 + 32), S2);
        }
        const int t = tt * 32 + r;
        const float cw = sc[S_MX + t];
        float rs = 0.f;
#pragma unroll
        for (int g = 0; g < 4; ++g) {
          float wv[4];
#pragma unroll
          for (int e = 0; e < 4; ++e) {
            const int s = stl * 32 + 8 * g + 4 * h + e;
            wv[e] = s <= t ? (S[4 * g + e] + S2[4 * g + e]) * cw : 0.f; rs += wv[e];
          }
          u32x2 o; o[0] = pk2(wv[0], wv[1]); o[1] = pk2(wv[2], wv[3]);
          *(u32x2*)(lds + L_SW + t * L_SWLD + (stl * 32 + 8 * g + 4 * h) * 2) = o;
        }
        rs += __shfl_xor(rs, 32);
        if (h == 0) {
          if (hw == 0) { sc[S_DS0 + t] = rs; sc[S_DS1 + t] = 0.f; }
          else if (hw == 1) sc[S_DS0 + t] = rs;
          else sc[S_DS1 + t] = rs;
        }
      } else {
        const int t = lane >> 1, hs = lane & 1;
        u32x4 z; z[0] = 0; z[1] = 0; z[2] = 0; z[3] = 0;
        *(u32x4*)(lds + L_SW + t * L_SWLD + 64 + hs * 32) = z; *(u32x4*)(lds + L_SW + t * L_SWLD + 64 + hs * 32 + 16) = z;
      }
      {
        float s0 = 0.f, s1 = 0.f, s2 = 0.f, s3 = 0.f;
        const char* kp = lds + L_K + ht * 2;
#pragma unroll
        for (int t = 0; t < 64; t += 4) {
          s0 += bflo((unsigned)*(const bf16_t*)(kp + t * L_LD)); s1 += bflo((unsigned)*(const bf16_t*)(kp + (t + 1) * L_LD));
          s2 += bflo((unsigned)*(const bf16_t*)(kp + (t + 2) * L_LD)); s3 += bflo((unsigned)*(const bf16_t*)(kp + (t + 3) * L_LD));
        }
        nreg = g_end_c * nreg + ((s0 + s1) + (s2 + s3));
        scn[S_NV + ht] = nreg;
      }
      float wend = 0.f;
      if (more) wend = scalars((c + 1) & 1, lane);
      WG_BAR();
      if (more) stage_lds(wend, tid);
    }
    WG_BAR();
    if (half == 0) {
      p.out[(KIND == 0 ? O_NP : O_NS) + bh * 256 + (tid0 - 256)] = nreg;
      if (tid0 == 256) p.out[(KIND == 0 ? O_MPP : O_MSS) + bh] = m_prev;
    }
  }
}

DI void mixer_phase(const Params& p, int l, char* lds, int cidx, bool ml_only) {
  unsigned* ctr = (unsigned*)(p.ws + W_MISC) + 16 + cidx;
  int* s_item = (int*)(lds + LDS_BYTES - 16);
  const int total = 32 + 64 + 64 + 2048;
  for (;;) {
    __syncthreads();
    if (threadIdx.x == 0) *s_item = (int)atomicAdd(ctr, 1u);
    __syncthreads();
    const int it = *s_item;
    __syncthreads();
    if (it >= total) break;
    if (ml_only && it >= 96) break;
    if (it < 32) { mlstm_item<0>(p, l, it >> 3, (it >> 1) & 3, it & 1, lds); continue; }
    if (it < 96) { const int x = it - 32; mlstm_item<1>(p, l, x >> 3, (x >> 1) & 3, x & 1, lds); continue; }
    if (it < 160) { attn_item<1>(p, l, (it - 96) >> 3, (it - 96) & 7, 0, lds); continue; }
    { const int x = it - 160; attn_item<0>(p, l, (x & 31) >> 3, x & 7, 63 - (x >> 5), lds); }
  }
}

DI void merge_phase(const Params& p, int l) {
  const bf16_t* Z = (const bf16_t*)(p.ws + W_Z); const bf16_t* H = (const bf16_t*)(p.ws + W_H); bf16_t* Y = (bf16_t*)(p.ws + W_AB);
  const int tidq = otid(); const int lane = tidq & 63, gw = blockIdx.x * 8 + (tidq >> 6), ngw = gridDim.x * 8;
  const float* mhg = p.in[15] + (size_t)l * D;
  for (int row = gw; row < M; row += ngw) {
    const int col = lane * 16;
    const bf16_t* z = Z + (size_t)row * NIN + col;
    float hv[16];
    unpack8(*(const u32x4*)(H + (size_t)row * D + col), hv); unpack8(*(const u32x4*)(H + (size_t)row * D + col + 8), hv + 8);
    float s = 0.f;
#pragma unroll
    for (int e = 0; e < 16; ++e) s += hv[e];
#pragma unroll
    for (int o = 1; o < 16; o <<= 1) s += __shfl_xor(s, o);
    const float mean = s * (1.f / 256.f);
    float s2 = 0.f;
#pragma unroll
    for (int e = 0; e < 16; ++e) { hv[e] -= mean; s2 += hv[e] * hv[e]; }
#pragma unroll
    for (int o = 1; o < 16; o <<= 1) s2 += __shfl_xor(s2, o);
    const float rstd = rsqrtf(s2 * (1.f / 256.f) + LN_EPS);
#pragma unroll
    for (int hh = 0; hh < 2; ++hh) {
      float oa[8], om[8], ga[8], gb[8];
      unpack8(*(const u32x4*)(z + 3072 + hh * 8), oa); unpack8(*(const u32x4*)(z + 6144 + hh * 8), om);
      unpack8(*(const u32x4*)(z + 7168 + hh * 8), ga); unpack8(*(const u32x4*)(z + 8192 + hh * 8), gb);
      const f32x4 g0 = *(const f32x4*)(mhg + col + hh * 8), g1 = *(const f32x4*)(mhg + col + hh * 8 + 4);
      float y[8];
#pragma unroll
      for (int e = 0; e < 8; ++e) {
        const float hn = hv[hh * 8 + e] * rstd * (e < 4 ? g0[e] : g1[e - 4]);
        y[e] = sigmoidf_(ga[e]) * oa[e] + sigmoidf_(gb[e]) * (hn * sigmoidf_(om[e]));
      }
      u32x4 o; o[0] = pk2(y[0], y[1]); o[1] = pk2(y[2], y[3]); o[2] = pk2(y[4], y[5]); o[3] = pk2(y[6], y[7]);
      *(u32x4*)(Y + (size_t)row * D + col + hh * 8) = o;
    }
  }
}

DI void ln_phase(const Params& p, const float* g, const float* bta, bool final_out) {
  const int tidq = otid(); const int lane = tidq & 63, gw = blockIdx.x * 8 + (tidq >> 6), ngw = gridDim.x * 8;
  float* R = (float*)(p.ws + W_R); bf16_t* AB = (bf16_t*)(p.ws + W_AB);
  for (int row = gw; row < M; row += ngw) {
    float* xr = R + (size_t)row * D;
    f32x4 v[4]; float s = 0.f;
#pragma unroll
    for (int j = 0; j < 4; ++j) { v[j] = *(const f32x4*)(xr + j * 256 + lane * 4); s += (v[j][0] + v[j][1]) + (v[j][2] + v[j][3]); }
    const float mean = wave_sum(s) * (1.f / D);
    float s2 = 0.f;
#pragma unroll
    for (int j = 0; j < 4; ++j) { v[j] = v[j] - mean; s2 += (v[j][0] * v[j][0] + v[j][1] * v[j][1]) + (v[j][2] * v[j][2] + v[j][3] * v[j][3]); }
    const float rstd = rsqrtf(wave_sum(s2) * (1.f / D) + LN_EPS);
    float* dst = final_out ? (row < MP ? p.out + O_YP + (size_t)row * D : p.out + O_YS + (size_t)(row - MP) * D) : xr;
#pragma unroll
    for (int j = 0; j < 4; ++j) {
      const int c = j * 256 + lane * 4;
      const f32x4 gg = *(const f32x4*)(g + c), bb = *(const f32x4*)(bta + c);
      f32x4 o = v[j] * rstd * gg + bb;
      *(f32x4*)(dst + c) = o;
      if (!final_out) { u32x2 ob; ob[0] = pk2(o[0], o[1]); ob[1] = pk2(o[2], o[3]); *(u32x2*)(AB + (size_t)row * D + c) = ob; }
    }
  }
}

DI float gelu_f(float v) {
  const float av = fabsf(v), d = av * 0.2316418882f + 1.0f;
  const float t = __builtin_amdgcn_rcpf(d);
  float q = t * 0.5307027145f + (-0.7265760135f); q = q * t + 0.7107068705f; q = q * t + (-0.142248368f); q = q * t + 0.127414796f; q = q * t;
  const float e = __builtin_amdgcn_exp2f((v * v) * (-0.72134752044f));
  const float m = v * (q * e), r = v - m;
  return v < 0.f ? m : r;
}
DI void ffnconv_phase(const Params& p, int l) {
  const bf16_t* U = (const bf16_t*)(p.ws + W_Z); bf16_t* HF = (bf16_t*)(p.ws + W_Z + (size_t)M * NUP * 2);
  const float* cw = p.in[20] + (size_t)l * 3 * NUP; const float* cb = p.in[21] + (size_t)l * NUP;
  const size_t total = (size_t)M * 352;
  for (size_t it = (size_t)blockIdx.x * NTH + otid(); it < total; it += (size_t)gridDim.x * NTH) {
    const int row = (int)(it / 352), col = (int)(it % 352) * 8;
    int t; const float* st = nullptr;
    if (row < MP) t = row & (SEQ - 1); else { t = (row - MP) & 15; st = p.in[8] + ((size_t)(l * 8 + ((row - MP) >> 4)) * 2) * NUP; }
    float u[2][8];
#pragma unroll
    for (int hf = 0; hf < 2; ++hf) {
      const int cc = col + hf * DFF;
      f32x4 a = *(const f32x4*)(cb + cc), b = *(const f32x4*)(cb + cc + 4);
      u[hf][0] = a[0]; u[hf][1] = a[1]; u[hf][2] = a[2]; u[hf][3] = a[3]; u[hf][4] = b[0]; u[hf][5] = b[1]; u[hf][6] = b[2]; u[hf][7] = b[3];
#pragma unroll
      for (int j = 0; j < 3; ++j) {
        const int tj = t - 2 + j;
        float x[8];
        if (tj >= 0) unpack8(*(const u32x4*)(U + (size_t)(row - 2 + j) * NUP + cc), x);
        else if (st) { const float* s = st + (size_t)(2 + tj) * NUP + cc; f32x4 a2 = *(const f32x4*)s, b2 = *(const f32x4*)(s + 4);
          x[0] = a2[0]; x[1] = a2[1]; x[2] = a2[2]; x[3] = a2[3]; x[4] = b2[0]; x[5] = b2[1]; x[6] = b2[2]; x[7] = b2[3]; }
        else {
#pragma unroll
          for (int e = 0; e < 8; ++e) x[e] = 0.f; }
        const f32x4 w0 = *(const f32x4*)(cw + j * NUP + cc), w1 = *(const f32x4*)(cw + j * NUP + cc + 4);
        u[hf][0] += w0[0] * x[0]; u[hf][1] += w0[1] * x[1]; u[hf][2] += w0[2] * x[2]; u[hf][3] += w0[3] * x[3];
        u[hf][4] += w1[0] * x[4]; u[hf][5] += w1[1] * x[5]; u[hf][6] += w1[2] * x[6]; u[hf][7] += w1[3] * x[7];
      }
    }
    float o[8];
#pragma unroll
    for (int e = 0; e < 8; ++e) { const float a = u[0][e]; o[e] = gelu_f(a) * u[1][e]; }
    u32x4 ov; ov[0] = pk2(o[0], o[1]); ov[1] = pk2(o[2], o[3]); ov[2] = pk2(o[4], o[5]); ov[3] = pk2(o[6], o[7]);
    *(u32x4*)(HF + (size_t)row * DFF + col) = ov;
  }
}

constexpr int NPH = 21;
DI void run_phase(const Params& p, int ph, char* lds) {
#ifndef ONLY
  if (ph == 0) { phase0(p, lds); return; }
#else
  if (ph == 0) return;
#endif
  const int l = (ph - 1) / 10, s = (ph - 1) % 10;
#ifdef ONLY
  if (s != ONLY) return;
#endif
  switch (s) {
    case 0: gemm_phase<EPI_IN>(p, l, (const bf16_t*)(p.ws + W_AB), D, (const bf16_t*)(p.ws + W_WIN) + (size_t)l * NIN * D, D, NIN / 256, lds); break;
    case 1: qkconv_phase(p, l); gif_phase(p, l, lds); break;
    case 2: mixer_phase(p, l, lds, l, false); break;
    case 3: merge_phase(p, l); break;
    case 4: gemm_phase<EPI_OUT>(p, l, (const bf16_t*)(p.ws + W_AB), D, (const bf16_t*)(p.ws + W_WOUT) + (size_t)l * D * D, D, D / 256, lds); break;
    case 5: ln_phase(p, p.in[17] + l * D, p.in[18] + l * D, false); break;
    case 6: gemm_phase<EPI_UP>(p, l, (const bf16_t*)(p.ws + W_AB), D, (const bf16_t*)(p.ws + W_WUP) + (size_t)l * NUP * D, D, NUP / 256, lds); break;
    case 7: ffnconv_phase(p, l); break;
    case 8: gemm_phase<EPI_DOWN>(p, l, (const bf16_t*)(p.ws + W_Z + (size_t)M * NUP * 2), DFF, (const bf16_t*)(p.ws + W_WDN) + (size_t)l * D * DFF, DFF, D / 256, lds); break;
    case 9: ln_phase(p, p.in[23] + l * D, p.in[24] + l * D, l == 1); break;
  }
}

__global__ void __launch_bounds__(NTH) mega(Params p, int ph_lo, int ph_hi) {
  extern __shared__ __attribute__((aligned(16))) char lds[];
#if MULTI_LAUNCH
  for (int ph = ph_lo; ph < ph_hi; ++ph) run_phase(p, ph, lds);
#else
  cg::grid_group grid = cg::this_grid();
  phase0(p, lds);
  grid.sync();
  for (int l = 0; l < 2; ++l) {
    gemm_phase<EPI_IN>(p, l, (const bf16_t*)(p.ws + W_AB), D, (const bf16_t*)(p.ws + W_WIN) + (size_t)l * NIN * D, D, NIN / 256, lds);
    grid.sync();
#ifdef PROBE_GIN2
    gemm_phase<EPI_IN>(p, l, (const bf16_t*)(p.ws + W_AB), D, (const bf16_t*)(p.ws + W_WIN) + (size_t)l * NIN * D, D, NIN / 256, lds);
    grid.sync();
#endif
    qkconv_phase(p, l); gif_phase(p, l, lds);
    grid.sync();
#ifdef PROBE_EW2
    qkconv_phase(p, l); gif_phase(p, l, lds);
    grid.sync();
#endif
    mixer_phase(p, l, lds, l, false);
    grid.sync();
#ifdef PROBE_ML2
    mixer_phase(p, l, lds, l + 2, true);
    grid.sync();
#endif
#ifdef PROBE_MIX2
    mixer_phase(p, l, lds, l + 2, false);
    grid.sync();
#endif
    merge_phase(p, l);
    grid.sync();
#ifdef PROBE_EW2
    merge_phase(p, l);
    grid.sync();
#endif
    gemm_phase<EPI_OUT>(p, l, (const bf16_t*)(p.ws + W_AB), D, (const bf16_t*)(p.ws + W_WOUT) + (size_t)l * D * D, D, D / 256, lds);
    grid.sync();
    ln_phase(p, p.in[17] + l * D, p.in[18] + l * D, false);
    grid.sync();
    gemm_phase<EPI_UP>(p, l, (const bf16_t*)(p.ws + W_AB), D, (const bf16_t*)(p.ws + W_WUP) + (size_t)l * NUP * D, D, NUP / 256, lds);
    grid.sync();
    ffnconv_phase(p, l);
    grid.sync();
#ifdef PROBE_EW2
    ffnconv_phase(p, l);
    grid.sync();
#endif
    gemm_phase<EPI_DOWN>(p, l, (const bf16_t*)(p.ws + W_Z + (size_t)M * NUP * 2), DFF, (const bf16_t*)(p.ws + W_WDN) + (size_t)l * D * DFF, DFF, D / 256, lds);
    grid.sync();
    ln_phase(p, p.in[23] + l * D, p.in[24] + l * D, l == 1);
    if (l == 0) grid.sync();
  }
#endif
}

extern "C" void kernel_launch(void* const* d_in, const int* in_sizes, int n_in, void* d_out, int out_size, void* d_ws, size_t ws_size, hipStream_t stream) {
  static int grid = 0;
  if (grid == 0) {
    if (n_in != 25 || (size_t)out_size != O_END || ws_size < W_END) { fprintf(stderr, "kernel_launch: unexpected sizes n_in %d out %d (want %zu) ws %zu (want %zu)\n", n_in, out_size, (size_t)O_END, ws_size, (size_t)W_END); grid = -1; return; }
    int dev = 0, cus = 0, per_cu = 0;
    hipGetDevice(&dev);
    hipDeviceGetAttribute(&cus, hipDeviceAttributeMultiprocessorCount, dev);
    if (hipFuncSetAttribute((const void*)mega, hipFuncAttributeMaxDynamicSharedMemorySize, LDS_BYTES) != hipSuccess) { fprintf(stderr, "hipFuncSetAttribute failed\n"); grid = -1; return; }
    hipOccupancyMaxActiveBlocksPerMultiprocessor(&per_cu, (const void*)mega, NTH, LDS_BYTES);
    if (per_cu < 1) per_cu = 1;
    grid = cus * 1;
    (void)hipGetLastError();
  }
  if (grid < 0) return;
  Params p{};
  for (int i = 0; i < 25; ++i) p.in[i] = (const float*)d_in[i];
  p.out = (float*)d_out; p.ws = (unsigned char*)d_ws;
#if MULTI_LAUNCH
  for (int ph = 0; ph < NPH; ++ph) hipLaunchKernelGGL(mega, dim3(grid), dim3(NTH), LDS_BYTES, stream, p, ph, ph + 1);
#else
  int lo = 0, hi = NPH;
  void* args[] = {&p, &lo, &hi};
  hipError_t e = hipLaunchCooperativeKernel((const void*)mega, dim3(grid), dim3(NTH), args, LDS_BYTES, stream);
  if (e != hipSuccess) fprintf(stderr, "cooperative launch failed: %s (grid %d)\n", hipGetErrorString(e), grid);
#endif
}
```

```cpp
#include <hip/hip_runtime.h>
#include <hip/hip_cooperative_groups.h>
#include <cstdio>
namespace cg = cooperative_groups;

#ifndef MULTI_LAUNCH
#define MULTI_LAUNCH 0
#endif

typedef unsigned short bf16_t;
typedef short bf16x8 __attribute__((ext_vector_type(8)));
typedef short s16x4 __attribute__((ext_vector_type(4)));
typedef float f32x16 __attribute__((ext_vector_type(16)));
typedef float f32x4 __attribute__((ext_vector_type(4)));
typedef unsigned u32x4 __attribute__((ext_vector_type(4)));
typedef unsigned u32x2 __attribute__((ext_vector_type(2)));
#define DI __device__ __forceinline__
#define MFMA32(a, b, c) __builtin_amdgcn_mfma_f32_32x32x16_bf16((a), (b), (c), 0, 0, 0)

constexpr int NTH = 512;
constexpr int D = 1024, SEQ = 8192, NB = 4, MP = NB * SEQ, MS = 128, M = MP + MS, NTM = 129;
constexpr int DIN = 9224, NIN = 9216, DFF = 2816, NUP = 5632;
constexpr int PAST = 4096, NKS = PAST + 16;
constexpr float ALPHA = 1.4142135623730951f;
constexpr float LN_EPS = 1e-5f;
constexpr float LOG2E = 1.4426950408889634f;

constexpr size_t O_YP = 0;
constexpr size_t O_YS = O_YP + (size_t)MP * D;
constexpr size_t O_KP = O_YS + (size_t)MS * D;
constexpr size_t O_VP = O_KP + (size_t)2 * MP * 1024;
constexpr size_t O_MCP = O_VP + (size_t)2 * MP * 1024;
constexpr size_t O_CP = O_MCP + (size_t)2 * 4 * 3 * 2048;
constexpr size_t O_NP = O_CP + (size_t)2 * 4 * 4 * 65536;
constexpr size_t O_MPP = O_NP + (size_t)2 * 4 * 4 * 256;
constexpr size_t O_FCP = O_MPP + 32;
constexpr size_t O_KS = O_FCP + (size_t)2 * 4 * 2 * NUP;
constexpr size_t O_VS = O_KS + (size_t)2 * MS * 1024;
constexpr size_t O_MCS = O_VS + (size_t)2 * MS * 1024;
constexpr size_t O_CS = O_MCS + (size_t)2 * 8 * 3 * 2048;
constexpr size_t O_NS = O_CS + (size_t)2 * 8 * 4 * 65536;
constexpr size_t O_MSS = O_NS + (size_t)2 * 8 * 4 * 256;
constexpr size_t O_FCS = O_MSS + 64;
constexpr size_t O_END = O_FCS + (size_t)2 * 8 * 2 * NUP;

constexpr size_t W_Z = 0;
constexpr size_t W_H = W_Z + (size_t)M * NIN * 2;
constexpr size_t W_AB = W_H + (size_t)M * D * 2;
constexpr size_t W_KA = W_AB + (size_t)M * D * 2;
constexpr size_t W_R = W_KA + (size_t)M * D * 2;
constexpr size_t W_WIN = W_R + (size_t)M * D * 4;
constexpr size_t W_WOUT = W_WIN + (size_t)2 * NIN * D * 2;
constexpr size_t W_WUP = W_WOUT + (size_t)2 * D * D * 2;
constexpr size_t W_WDN = W_WUP + (size_t)2 * NUP * D * 2;
constexpr size_t W_GIF = W_WDN + (size_t)2 * D * DFF * 2;
constexpr size_t W_ROPE = W_GIF + (size_t)M * 8 * 4;
constexpr size_t W_MISC = W_ROPE + (size_t)8192 * 32 * 8;
constexpr size_t W_END = W_MISC + 4096;

struct Params {
  const float* in[25];
  float* out;
  unsigned char* ws;
};

DI unsigned f2bf(float x) { unsigned u = __float_as_uint(x); u += 0x7fffu + ((u >> 16) & 1u); return u >> 16; }
typedef __bf16 bf16v2 __attribute__((ext_vector_type(2)));
typedef float f32x2 __attribute__((ext_vector_type(2)));
DI unsigned pk2(float a, float b) { f32x2 v; v[0] = a; v[1] = b; return __builtin_bit_cast(unsigned, __builtin_convertvector(v, bf16v2)); }
DI float bflo(unsigned u) { return __uint_as_float(u << 16); }
DI float bfhi(unsigned u) { return __uint_as_float(u & 0xffff0000u); }
DI float sigmoidf_(float x) { return 1.f / (1.f + __expf(-x)); }
DI float wave_sum(float v) {
#pragma unroll
  for (int o = 1; o < 64; o <<= 1) v += __shfl_xor(v, o);
  return v;
}
DI int crow(int i, int h) { return (i & 3) + 8 * (i >> 2) + 4 * h; }
DI bf16x8 pack8(const f32x16& x, int s) {
  u32x4 p;
  p[0] = pk2(x[8 * s + 0], x[8 * s + 1]); p[1] = pk2(x[8 * s + 2], x[8 * s + 3]);
  p[2] = pk2(x[8 * s + 4], x[8 * s + 5]); p[3] = pk2(x[8 * s + 6], x[8 * s + 7]);
  return __builtin_bit_cast(bf16x8, p);
}
DI void unpack8(u32x4 v, float* f) {
  f[0] = bflo(v[0]); f[1] = bfhi(v[0]); f[2] = bflo(v[1]); f[3] = bfhi(v[1]);
  f[4] = bflo(v[2]); f[5] = bfhi(v[2]); f[6] = bflo(v[3]); f[7] = bfhi(v[3]);
}
typedef __attribute__((address_space(3))) s16x4 lds_s16x4;
DI bf16x8 tr_frag(unsigned a_lo, unsigned a_hi) {
  const s16x4 lo = __builtin_amdgcn_ds_read_tr16_b64_v4i16((lds_s16x4*)(size_t)a_lo);
  const s16x4 hi = __builtin_amdgcn_ds_read_tr16_b64_v4i16((lds_s16x4*)(size_t)a_hi);
  return __builtin_shufflevector(lo, hi, 0, 1, 2, 3, 4, 5, 6, 7);
}
template <int STEP, int HIOFF>
DI void tr_frag4(unsigned a, bf16x8 (&f)[4]) {
#pragma unroll
  for (int i = 0; i < 4; ++i) f[i] = tr_frag(a + i * STEP, a + i * STEP + HIOFF);
}
DI int otid() { int t = threadIdx.x; asm volatile("" : "+v"(t)); return t; }
DI int uni(int v) { return __builtin_amdgcn_readfirstlane(v); }
DI unsigned lds_addr(const void* p) { return (unsigned)(size_t)p; }

DI const float* xrow_ptr(const Params& p, int l, int row) {
  if (l == 0) return row < MP ? p.in[0] + (size_t)row * D : p.in[1] + (size_t)(row - MP) * D;
  return (const float*)(p.ws + W_R) + (size_t)row * D;
}

DI void transpose_w(const float* W, int K, int N, int src_ld, bf16_t* WT, bool remap, char* lds) {
  float* scr = (float*)lds;
  const int nkb = K / 64, nnb = N / 64, tid = otid();
  for (int it = blockIdx.x; it < nkb * nnb; it += gridDim.x) {
    const int kb = it / nnb, nb = it % nnb, k0 = kb * 64, n0 = nb * 64;
    const int ns = (remap && n0 >= 7168) ? n0 + 8 : n0;
#pragma unroll
    for (int i = 0; i < 8; ++i) {
      const int kk = (tid >> 6) + 8 * i, nn = tid & 63;
      scr[kk * 65 + nn] = W[(size_t)(k0 + kk) * src_ld + ns + nn];
    }
    __syncthreads();
    {
      const int n = tid >> 3, c = tid & 7;
      const float* s = scr + (8 * c) * 65 + n;
      u32x4 o;
      o[0] = pk2(s[0], s[65]); o[1] = pk2(s[2 * 65], s[3 * 65]); o[2] = pk2(s[4 * 65], s[5 * 65]); o[3] = pk2(s[6 * 65], s[7 * 65]);
      const int nd = (remap && n0 < 2048) ? ((n < 32) ? 2 * n : 2 * (n - 32) + 1) : n;
      *(u32x4*)(WT + (size_t)(n0 + nd) * K + k0 + 8 * c) = o;
    }
    __syncthreads();
  }
}

DI void phase0(const Params& p, char* lds) {
  const int tid = otid();
  for (int l = 0; l < 2; ++l) {
    transpose_w(p.in[9] + (size_t)l * D * DIN, D, NIN, DIN, (bf16_t*)(p.ws + W_WIN) + (size_t)l * NIN * D, true, lds);
    transpose_w(p.in[16] + (size_t)l * D * D, D, D, D, (bf16_t*)(p.ws + W_WOUT) + (size_t)l * D * D, false, lds);
    transpose_w(p.in[19] + (size_t)l * D * NUP, D, NUP, NUP, (bf16_t*)(p.ws + W_WUP) + (size_t)l * NUP * D, false, lds);
    transpose_w(p.in[22] + (size_t)l * DFF * D, DFF, D, D, (bf16_t*)(p.ws + W_WDN) + (size_t)l * D * DFF, false, lds);
  }
  bf16_t* ab = (bf16_t*)(p.ws + W_AB);
  for (size_t c = (size_t)blockIdx.x * NTH + tid; c < (size_t)M * 128; c += (size_t)gridDim.x * NTH) {
    const int row = (int)(c >> 7), cc = (int)(c & 127);
    const float* src = xrow_ptr(p, 0, row) + cc * 8;
    f32x4 a = *(const f32x4*)src, b = *(const f32x4*)(src + 4);
    u32x4 o; o[0] = pk2(a[0], a[1]); o[1] = pk2(a[2], a[3]); o[2] = pk2(b[0], b[1]); o[3] = pk2(b[2], b[3]);
    *(u32x4*)(ab + (size_t)row * D + cc * 8) = o;
  }
  float2* rope = (float2*)(p.ws + W_ROPE);
  for (int i = blockIdx.x * NTH + tid; i < 8192 * 32; i += gridDim.x * NTH) {
    const int pos = i >> 5, d = i & 31;
    const double inv = exp2(-(double)d * (13.287712379549449 / 32.0));
    double ang = (double)pos * inv;
    const double twopi = 6.283185307179586476925;
    ang -= twopi * rint(ang / twopi);
    float s, c; sincosf((float)ang, &s, &c);
    rope[i] = make_float2(c, s);
  }
  if (blockIdx.x == 0 && tid < 128) {
    const int l = tid >> 6, ln = tid & 63;
    const float* lp = p.in[13] + (size_t)l * 4 * 64;
    const float s1 = wave_sum(lp[ln] * lp[64 + ln]), s2 = wave_sum(lp[128 + ln] * lp[192 + ln]);
    const float lam_init = (l == 0) ? 0.2f : (0.8f - 0.6f * 0.74081822068171788f);
    if (ln == 0) ((float*)(p.ws + W_MISC))[l] = __expf(s1) - __expf(s2) + lam_init;
  }
  if (blockIdx.x == 0 && tid < 8) ((unsigned*)(p.ws + W_MISC))[16 + tid] = 0u;
}

namespace pg8 {
#define PG8_LAS __attribute__((address_space(3)))
typedef unsigned short bf16_t;
typedef short bf16x8 __attribute__((ext_vector_type(8)));
typedef float f32x4 __attribute__((ext_vector_type(4)));
typedef unsigned u32x4 __attribute__((ext_vector_type(4)));
constexpr int BM = 256, BK = 64, HALF = 128, HTB = HALF * BK * 2  , STAGE_BYTES = 8 * HTB, NXCD = 8, WGM = 8;

__host__ __device__ __forceinline__ int lds_byte(int r, int c) { const int st = (r >> 4) * 2 + (c >> 5), rr = r & 15, cc = c & 31, ob = rr * 64 + cc * 2; return st * 1024 + (ob ^ (((ob >> 9) & 1) << 5)); }
__host__ __device__ __forceinline__ void stage_rc(int b, int& R, int& C) { const int st = b / 1024, sb = b % 1024, swz = sb ^ (((sb >> 9) & 1) << 5); R = (st >> 1) * 16 + swz / 64; C = (st & 1) * 32 + (swz % 64) / 2; }
__host__ __device__ __forceinline__ int perm32(int rho) { const int n = rho >> 4, i = rho & 15; return 8 * (i >> 2) + 4 * n + (i & 3); }

struct Unit { int pm, pn; };
struct Gemm { const bf16_t* A; const bf16_t* Bt; int M, N, K; };

struct StaticOrder {
    int nM, nN, nwg, G, c;
    __host__ __device__ void init(int M, int N, int G_, int c_) { nM = M / BM; nN = N / BM; nwg = nM * nN; G = G_; c = c_; }
    __host__ __device__ bool next(int i, Unit& u) const {
        const long L = (long)i * G + c; if (L >= nwg) return false;
        int wgid = (int)L; { const int q = nwg / NXCD, r = nwg % NXCD, xcd = wgid % NXCD, off = wgid / NXCD; wgid = (xcd < r ? xcd * (q + 1) : r * (q + 1) + (xcd - r) * q) + off; }
        const int nig = WGM * nN, gid = wgid / nig, fm = gid * WGM, gsz = (nM - fm) < WGM ? (nM - fm) : WGM;
        u.pm = fm + ((wgid % nig) % gsz); u.pn = (wgid % nig) / gsz; return true;
    }
    __device__ __forceinline__ void a_ready(const Unit&) const {}
    __device__ __forceinline__ void done(const Unit&) const {}
};
template <class Epi, class Sched, bool STAMP = false>
__device__ __forceinline__ void gemm_phase(PG8_LAS unsigned char* lds, const Gemm g, const Sched& S, const Epi& E, unsigned long long* stamps) {
    const int tid = otid(), wid = __builtin_amdgcn_readfirstlane(tid >> 6), lane = tid & 63, wr = wid >> 2, wc = wid & 3, fr = lane & 15, fq = lane >> 4;
    const int K = g.K, nt = K / BK;
    int ts_lo = 0, ts_hi = 0, nts = 0; const unsigned long long rt_entry = STAMP ? (unsigned long long)wall_clock64() : 0ull;
#define PG8_STAMP() do { if (STAMP && wid == 0 && nts < 64) { const unsigned long long _c = (unsigned long long)clock64(); \
        ts_lo = (lane == nts) ? (int)(unsigned)_c : ts_lo; ts_hi = (lane == nts) ? (int)(unsigned)(_c >> 32) : ts_hi; ++nts; } } while (0)
    PG8_STAMP();
    unsigned voffA[2], voffB[2];
#pragma unroll
    for (int i = 0; i < 2; ++i) { int R, C; stage_rc(tid * 16 + i * 8192, R, C); const int Rb = Epi::PERM ? ((R & ~31) + perm32(R & 31)) : R;
        voffA[i] = (unsigned)(R * K + C) * 2u; voffB[i] = (unsigned)(Rb * K + C) * 2u; }
    const size_t kstep = (size_t)(BK * 2);
    const size_t hstep = (size_t)HALF * K * 2;
    const size_t tstep = 2 * hstep;
    const unsigned ldsw = (unsigned)wid * 1024u;
    const int aoff = lds_byte(wr * 64 + fr, fq * 8), boff = lds_byte(wc * 32 + fr, fq * 8);
#define PG8_SA(b, h) (((b) * 2 + (h)) * HTB)
#define PG8_SB(b, h) ((4 + (b) * 2 + (h)) * HTB)
#define PG8_STAGE(bufoff, gbase, voff) do { _Pragma("unroll") for (int _i = 0; _i < 2; ++_i) \
        __builtin_amdgcn_global_load_lds((const unsigned*)((const char*)(gbase) + (voff)[_i]), (PG8_LAS unsigned*)(lds + (bufoff) + ldsw + _i * 8192), 16, 0, 0); } while (0)
#define PG8_LDA(dst, b, h) do { _Pragma("unroll") for (int m = 0; m < 4; ++m) _Pragma("unroll") for (int k = 0; k < 2; ++k) dst[m][k] = *(const PG8_LAS bf16x8*)(lds + PG8_SA(b, h) + aoff + m * 2048 + k * 1024); } while (0)
#define PG8_LDB(dst, b, h) do { _Pragma("unroll") for (int n = 0; n < 2; ++n) _Pragma("unroll") for (int k = 0; k < 2; ++k) dst[n][k] = *(const PG8_LAS bf16x8*)(lds + PG8_SB(b, h) + boff + n * 2048 + k * 1024); } while (0)
#define PG8_MMA(ai, bj, At, Bt) do { __builtin_amdgcn_s_setprio(1); _Pragma("unroll") for (int m = 0; m < 4; ++m) _Pragma("unroll") for (int n = 0; n < 2; ++n) _Pragma("unroll") for (int k = 0; k < 2; ++k) \
        acc[ai][bj][m][n] = __builtin_amdgcn_mfma_f32_16x16x32_bf16(Bt[n][k], At[m][k], acc[ai][bj][m][n], 0, 0, 0); __builtin_amdgcn_s_setprio(0); } while (0)
#define PG8_WAIT_V(n) asm volatile("s_waitcnt vmcnt(" #n ")" ::: "memory")
#define PG8_WAIT_L(n) asm volatile("s_waitcnt lgkmcnt(" #n ")" ::: "memory")
#define PG8_BAR __builtin_amdgcn_s_barrier()
#define PG8_SCHED __builtin_amdgcn_sched_barrier(0)
    Unit cur, nxt; int ui = 0;
    if (!S.next(0, cur)) return;
    f32x4 acc[2][2][4][2];
#pragma unroll
    for (int a = 0; a < 2; ++a)
#pragma unroll
        for (int b = 0; b < 2; ++b)
#pragma unroll
            for (int m = 0; m < 4; ++m)
#pragma unroll
                for (int n = 0; n < 2; ++n) acc[a][b][m][n] = (f32x4){0.f, 0.f, 0.f, 0.f};
    bf16x8 At[4][2], B0[2][2], B1[2][2];
    const char* cA = (const char*)g.A + (size_t)cur.pm * tstep; const char* cB = (const char*)g.Bt + (size_t)cur.pn * tstep;
    S.a_ready(cur);
    PG8_STAGE(PG8_SB(0, 0), cB, voffB); PG8_STAGE(PG8_SA(0, 0), cA, voffA); PG8_STAGE(PG8_SB(0, 1), cB + hstep, voffB); PG8_STAGE(PG8_SA(0, 1), cA + hstep, voffA);
    if (wr == 1) PG8_BAR;
    PG8_WAIT_V(4); PG8_BAR;
    PG8_STAGE(PG8_SB(1, 0), cB + kstep, voffB); PG8_STAGE(PG8_SA(1, 0), cA + kstep, voffA); PG8_STAGE(PG8_SB(1, 1), cB + hstep + kstep, voffB);
    PG8_WAIT_V(6); PG8_BAR;
    PG8_STAMP();
    for (;;) {
        const bool has_next = S.next(ui + 1, nxt);
        const char* nA = has_next ? (const char*)g.A + (size_t)nxt.pm * tstep : cA; const char* nB = has_next ? (const char*)g.Bt + (size_t)nxt.pn * tstep : cB;
        for (int t = 0; t < nt; t += 2) {
            const bool last = (t == nt - 2);
            const char* a1 = cA + (size_t)(t + 1) * kstep;
            const char* a2 = last ? nA : cA + (size_t)(t + 2) * kstep; const char* b2 = last ? nB : cB + (size_t)(t + 2) * kstep;
            const char* a3 = a2 + kstep; const char* b3 = b2 + kstep;
            if (last && has_next) S.a_ready(nxt);
            PG8_LDB(B0, 0, 0); PG8_SCHED; PG8_LDA(At, 0, 0); PG8_STAGE(PG8_SA(1, 1), a1 + hstep, voffA);
            PG8_WAIT_L(8); PG8_BAR; PG8_WAIT_L(0); PG8_MMA(0, 0, At, B0); PG8_BAR; PG8_SCHED;
            PG8_LDB(B1, 0, 1); PG8_STAGE(PG8_SB(0, 0), b2, voffB);
            PG8_BAR; PG8_WAIT_L(0); PG8_MMA(0, 1, At, B1); PG8_BAR;
            PG8_LDA(At, 0, 1); PG8_STAGE(PG8_SA(0, 0), a2, voffA);
            PG8_BAR; PG8_WAIT_L(0); PG8_MMA(1, 0, At, B0); PG8_BAR; PG8_SCHED;
            PG8_STAGE(PG8_SB(0, 1), b2 + hstep, voffB);
            PG8_WAIT_V(6); PG8_BAR; PG8_MMA(1, 1, At, B1); PG8_BAR;
            PG8_LDB(B0, 1, 0); PG8_SCHED; PG8_LDA(At, 1, 0); PG8_STAGE(PG8_SA(0, 1), a2 + hstep, voffA);
            PG8_WAIT_L(8); PG8_BAR; PG8_WAIT_L(0); PG8_MMA(0, 0, At, B0); PG8_BAR; PG8_SCHED;
            PG8_LDB(B1, 1, 1); PG8_STAGE(PG8_SB(1, 0), b3, voffB);
            PG8_BAR; PG8_WAIT_L(0); PG8_MMA(0, 1, At, B1); PG8_BAR;
            PG8_LDA(At, 1, 1); PG8_STAGE(PG8_SA(1, 0), a3, voffA);
            PG8_BAR; PG8_WAIT_L(0); PG8_MMA(1, 0, At, B0); PG8_BAR; PG8_SCHED;
            PG8_STAGE(PG8_SB(1, 1), b3 + hstep, voffB);
            PG8_WAIT_V(6); PG8_BAR; PG8_MMA(1, 1, At, B1); PG8_BAR;
        }
        PG8_STAMP();
        if constexpr (!Epi::AFTER_DRAIN) { E(acc, cur, wr, wc, fr, fq); S.done(cur); }
        PG8_STAMP();
        if (!has_next) break;
#pragma unroll
        for (int a = 0; a < 2; ++a)
#pragma unroll
            for (int b = 0; b < 2; ++b)
#pragma unroll
                for (int m = 0; m < 4; ++m)
#pragma unroll
                    for (int n = 0; n < 2; ++n) acc[a][b][m][n] = (f32x4){0.f, 0.f, 0.f, 0.f};
        cur = nxt; cA = nA; cB = nB; ++ui;
    }
    PG8_WAIT_V(0);
    if (wr == 0) PG8_BAR;
    PG8_BAR;
    if constexpr (Epi::AFTER_DRAIN) { E.fused(acc, cur, wr, wc, fr, fq, lds, wid, lane); S.done(cur); }
    PG8_STAMP();
    if (STAMP && wid == 0) { stamps[lane] = lane < nts ? (((unsigned long long)(unsigned)ts_hi << 32) | (unsigned)ts_lo) : 0ull;
        if (lane == 62) stamps[62] = rt_entry; if (lane == 63) stamps[63] = (unsigned long long)wall_clock64(); }
#undef PG8_STAMP
#undef PG8_SA
#undef PG8_SB
#undef PG8_STAGE
#undef PG8_LDA
#undef PG8_LDB
#undef PG8_MMA
#undef PG8_WAIT_V
#undef PG8_WAIT_L
#undef PG8_BAR
#undef PG8_SCHED
}
}

enum { EPI_IN = 0, EPI_OUT = 1, EPI_UP = 2, EPI_DOWN = 3 };
template <int MODE>
struct Epi {
  static constexpr bool PERM = true, AFTER_DRAIN = false;
  Params p; int l;
  DI void operator()(const f32x4 (&acc)[2][2][4][2], const pg8::Unit& u, int wr, int wc, int fr, int fq) const {
    const int colb = u.pn * 256 + wc * 32 + 8 * fq;
#pragma unroll
    for (int ai = 0; ai < 2; ++ai)
#pragma unroll
      for (int m = 0; m < 4; ++m) {
        const int row = u.pm * 256 + ai * 128 + wr * 64 + m * 16 + fr;
        if (row < M) {
#pragma unroll
          for (int bj = 0; bj < 2; ++bj) {
            const int col = colb + bj * 128;
            const f32x4 v0 = acc[ai][bj][m][0], v1 = acc[ai][bj][m][1];
            if (MODE == EPI_IN) {
              bf16_t* Z = (bf16_t*)(p.ws + W_Z);
              const int seg = u.pn >> 2;
              if (seg <= 1) {
                const int pos = row < MP ? (row & (SEQ - 1)) : PAST + ((row - MP) & 15);
                const int d0 = (col & 63) >> 1;
                const f32x4* rp = (const f32x4*)((const float2*)(p.ws + W_ROPE) + pos * 32 + d0);
                const f32x4 c01 = rp[0], c23 = rp[1];
                const float a0 = v0[0] * c01[0] - v0[1] * c01[1], b0 = v0[1] * c01[0] + v0[0] * c01[1];
                const float a1 = v0[2] * c01[2] - v0[3] * c01[3], b1 = v0[3] * c01[2] + v0[2] * c01[3];
                const float a2 = v1[0] * c23[0] - v1[1] * c23[1], b2 = v1[1] * c23[0] + v1[0] * c23[1];
                const float a3 = v1[2] * c23[2] - v1[3] * c23[3], b3 = v1[3] * c23[2] + v1[2] * c23[3];
                const float qs = seg == 0 ? 0.125f : 1.f;
                u32x4 o; o[0] = pk2(a0 * qs, b0 * qs); o[1] = pk2(a1 * qs, b1 * qs); o[2] = pk2(a2 * qs, b2 * qs); o[3] = pk2(a3 * qs, b3 * qs);
                *(u32x4*)(Z + (size_t)row * NIN + col) = o;
                if (seg == 1) {
                  float* ob = (row < MP ? p.out + O_KP + ((size_t)l * MP + row) * 1024 : p.out + O_KS + ((size_t)l * MS + row - MP) * 1024) + ((col - 1024) & ~63) + d0;
                  f32x4 o1, o2; o1[0] = a0; o1[1] = a1; o1[2] = a2; o1[3] = a3; o2[0] = b0; o2[1] = b1; o2[2] = b2; o2[3] = b3;
                  *(f32x4*)ob = o1; *(f32x4*)(ob + 32) = o2;
                }
              } else {
                u32x4 o; o[0] = pk2(v0[0], v0[1]); o[1] = pk2(v0[2], v0[3]); o[2] = pk2(v1[0], v1[1]); o[3] = pk2(v1[2], v1[3]);
                *(u32x4*)(Z + (size_t)row * NIN + col) = o;
                if (seg == 2) {
                  float* ob = (row < MP ? p.out + O_VP + ((size_t)l * MP + row) * 1024 : p.out + O_VS + ((size_t)l * MS + row - MP) * 1024) + (col - 2048);
                  *(f32x4*)ob = v0; *(f32x4*)(ob + 4) = v1;
                } else if (seg == 3 || seg == 4) {
                  float* ob = nullptr;
                  if (row < MP) { const int s = row & (SEQ - 1); if (s >= SEQ - 3) ob = p.out + O_MCP + ((size_t)(l * 4 + (row >> 13)) * 3 + (s - (SEQ - 3))) * 2048 + col - 3072; }
                  else { const int t = (row - MP) & 15, b = (row - MP) >> 4; if (t >= 13) ob = p.out + O_MCS + ((size_t)(l * 8 + b) * 3 + (t - 13)) * 2048 + col - 3072; }
                  if (ob) { *(f32x4*)ob = v0; *(f32x4*)(ob + 4) = v1; }
                }
              }
            } else if (MODE == EPI_OUT || MODE == EPI_DOWN) {
              float* R = (float*)(p.ws + W_R) + (size_t)row * D + col;
              const float* rs = MODE == EPI_OUT ? xrow_ptr(p, l, row) + col : R;
              const f32x4 r0 = *(const f32x4*)rs, r1 = *(const f32x4*)(rs + 4);
              *(f32x4*)R = r0 * ALPHA + v0; *(f32x4*)(R + 4) = r1 * ALPHA + v1;
            } else {
              bf16_t* U = (bf16_t*)(p.ws + W_Z);
              u32x4 o; o[0] = pk2(v0[0], v0[1]); o[1] = pk2(v0[2], v0[3]); o[2] = pk2(v1[0], v1[1]); o[3] = pk2(v1[2], v1[3]);
              *(u32x4*)(U + (size_t)row * NUP + col) = o;
              float* ob = nullptr;
              if (row < MP) { const int s = row & (SEQ - 1); if (s >= SEQ - 2) ob = p.out + O_FCP + ((size_t)(l * 4 + (row >> 13)) * 2 + (s - (SEQ - 2))) * NUP + col; }
              else { const int t = (row - MP) & 15, b = (row - MP) >> 4; if (t >= 14) ob = p.out + O_FCS + ((size_t)(l * 8 + b) * 2 + (t - 14)) * NUP + col; }
              if (ob) { *(f32x4*)ob = v0; *(f32x4*)(ob + 4) = v1; }
            }
          }
        }
      }
  }
};

template <int MODE>
DI void gemm_phase(const Params& p, int l, const bf16_t* A, int lda, const bf16_t* Bt, int K, int ntn, char* lds) {
  (void)lda;
  pg8::Gemm g; g.A = A; g.Bt = Bt; g.M = ((MODE == EPI_OUT || MODE == EPI_DOWN) ? NTM - 1 : NTM) * 256; g.N = ntn * 256; g.K = K;
  if (MODE == EPI_OUT || MODE == EPI_DOWN) sample_gemm<MODE>(p, l, A, Bt, K);
  pg8::StaticOrder S; S.init(g.M, g.N, (int)gridDim.x, (int)blockIdx.x);
  Epi<MODE> E; E.p = p; E.l = l;
  pg8::gemm_phase<Epi<MODE>, pg8::StaticOrder, false>((PG8_LAS unsigned char*)lds, g, S, E, nullptr);
  __syncthreads();
}

typedef float f32x4v __attribute__((ext_vector_type(4)));
template <int MODE>
DI void sample_gemm(const Params& p, int l, const bf16_t* A, const bf16_t* Bt, int K) {
  if (blockIdx.x >= 64) return;
  const int tid = otid(), lane = tid & 63, wave = uni(tid >> 6), fr = lane & 15, fq = lane >> 4;
  const bf16_t* ap = A + (size_t)(MP + wave * 16 + fr) * K + fq * 8;
  const bf16_t* bp = Bt + (size_t)(blockIdx.x * 16 + fr) * K + fq * 8;
  f32x4v acc0 = {0.f, 0.f, 0.f, 0.f}, acc1 = {0.f, 0.f, 0.f, 0.f};
  for (int k0 = 0; k0 < K; k0 += 256) {
    bf16x8 a[8], bb[8];
#pragma unroll
    for (int i = 0; i < 8; ++i) { a[i] = *(const bf16x8*)(ap + k0 + i * 32); bb[i] = *(const bf16x8*)(bp + k0 + i * 32); }
#pragma unroll
    for (int i = 0; i < 8; i += 2) {
      acc0 = __builtin_amdgcn_mfma_f32_16x16x32_bf16(a[i], bb[i], acc0, 0, 0, 0);
      acc1 = __builtin_amdgcn_mfma_f32_16x16x32_bf16(a[i + 1], bb[i + 1], acc1, 0, 0, 0);
    }
  }
  const int col = blockIdx.x * 16 + fr;
  float* R = (float*)(p.ws + W_R);
#pragma unroll
  for (int j = 0; j < 4; ++j) {
    const int row = MP + wave * 16 + fq * 4 + j;
    const float res = MODE == EPI_OUT ? xrow_ptr(p, l, row)[col] : R[(size_t)row * D + col];
    R[(size_t)row * D + col] = ALPHA * res + (acc0[j] + acc1[j]);
  }
}

DI void gif_phase(const Params& p, int l, char* lds) {
  const int tidq = otid(); const int lane = tidq & 63, gw = blockIdx.x * 8 + (tidq >> 6), ngw = gridDim.x * 8;
  const float* w = p.in[9] + (size_t)l * D * DIN + 7168;
  const float* bif = p.in[10] + l * 8;
  float* gif = (float*)(p.ws + W_GIF);
  float* w8 = (float*)lds;
  __syncthreads();
#pragma unroll
  for (int i = 0; i < 2; ++i) {
    const int k = tidq + 512 * i;
    *(f32x4*)(w8 + k * 8) = *(const f32x4*)(w + (size_t)k * DIN); *(f32x4*)(w8 + k * 8 + 4) = *(const f32x4*)(w + (size_t)k * DIN + 4);
  }
  __syncthreads();
  for (int rg = gw; rg < M / 4; rg += ngw) {
    float acc[4][8];
#pragma unroll
    for (int a = 0; a < 4; ++a)
#pragma unroll
      for (int j = 0; j < 8; ++j) acc[a][j] = 0.f;
    const float* x0 = xrow_ptr(p, l, rg * 4);
#pragma unroll 4
    for (int kk = 0; kk < 16; ++kk) {
      const int k = kk * 64 + lane;
      const f32x4 w0 = *(const f32x4*)(w8 + k * 8), w1 = *(const f32x4*)(w8 + k * 8 + 4);
#pragma unroll
      for (int a = 0; a < 4; ++a) {
        const float xv = x0[(size_t)a * D + k];
        acc[a][0] += xv * w0[0]; acc[a][1] += xv * w0[1]; acc[a][2] += xv * w0[2]; acc[a][3] += xv * w0[3];
        acc[a][4] += xv * w1[0]; acc[a][5] += xv * w1[1]; acc[a][6] += xv * w1[2]; acc[a][7] += xv * w1[3];
      }
    }
#pragma unroll
    for (int a = 0; a < 4; ++a)
#pragma unroll
      for (int j = 0; j < 8; ++j) {
        const float s = wave_sum(acc[a][j]);
        if (lane == 0) gif[(size_t)(rg * 4 + a) * 8 + j] = s + bif[j];
      }
  }
  __syncthreads();
}

DI void qkconv_phase(const Params& p, int l) {
  const bf16_t* Z = (const bf16_t*)(p.ws + W_Z);
  bf16_t* QA = (bf16_t*)(p.ws + W_AB); bf16_t* KA = (bf16_t*)(p.ws + W_KA);
  const float* cw = p.in[11] + (size_t)l * 4 * 2048; const float* cb = p.in[12] + (size_t)l * 2048;
  const size_t total = (size_t)(M / 4) * 256;
  for (size_t it = (size_t)blockIdx.x * NTH + otid(); it < total; it += (size_t)gridDim.x * NTH) {
    const int cc = (int)(it & 255), rg = (int)(it >> 8), col = cc * 8, row0 = rg * 4;
    int t0, hist_rows;
    const float* st = nullptr;
    if (row0 < MP) { t0 = row0 & (SEQ - 1); }
    else { t0 = (row0 - MP) & 15; st = p.in[4] + ((size_t)(l * 8 + ((row0 - MP) >> 4)) * 3) * 2048 + col; }
    (void)hist_rows;
    float w[4][8], bias[8];
#pragma unroll
    for (int j = 0; j < 4; ++j) { f32x4 a = *(const f32x4*)(cw + j * 2048 + col), b = *(const f32x4*)(cw + j * 2048 + col + 4);
      w[j][0] = a[0]; w[j][1] = a[1]; w[j][2] = a[2]; w[j][3] = a[3]; w[j][4] = b[0]; w[j][5] = b[1]; w[j][6] = b[2]; w[j][7] = b[3]; }
    { f32x4 a = *(const f32x4*)(cb + col), b = *(const f32x4*)(cb + col + 4);
      bias[0] = a[0]; bias[1] = a[1]; bias[2] = a[2]; bias[3] = a[3]; bias[4] = b[0]; bias[5] = b[1]; bias[6] = b[2]; bias[7] = b[3]; }
    float x[7][8];
#pragma unroll
    for (int j = 0; j < 7; ++j) {
      const int t = t0 - 3 + j;
      if (t >= 0) { u32x4 v = *(const u32x4*)(Z + (size_t)(row0 - 3 + j) * NIN + 3072 + col); unpack8(v, x[j]); }
      else if (st) { f32x4 a = *(const f32x4*)(st + (size_t)(3 + t) * 2048), b = *(const f32x4*)(st + (size_t)(3 + t) * 2048 + 4);
        x[j][0] = a[0]; x[j][1] = a[1]; x[j][2] = a[2]; x[j][3] = a[3]; x[j][4] = b[0]; x[j][5] = b[1]; x[j][6] = b[2]; x[j][7] = b[3]; }
      else {
#pragma unroll
        for (int e = 0; e < 8; ++e) x[j][e] = 0.f; }
    }
    const float sc = col >= 1024 ? 0.0625f : 1.f;
    bf16_t* dst = col >= 1024 ? KA + (col - 1024) : QA + col;
#pragma unroll
    for (int a = 0; a < 4; ++a) {
      float o[8];
#pragma unroll
      for (int e = 0; e < 8; ++e) {
        float u = bias[e] + w[0][e] * x[a][e] + w[1][e] * x[a + 1][e] + w[2][e] * x[a + 2][e] + w[3][e] * x[a + 3][e];
        o[e] = u * sigmoidf_(u) * sc;
      }
      u32x4 ov; ov[0] = pk2(o[0], o[1]); ov[1] = pk2(o[2], o[3]); ov[2] = pk2(o[4], o[5]); ov[3] = pk2(o[6], o[7]);
      *(u32x4*)(dst + (size_t)(row0 + a) * D) = ov;
    }
  }
}

constexpr int A_LD = 272;
constexpr int A_TILE = 64 * A_LD;
template <int KIND>
DI void attn_item(const Params& p, int l, int b, int ha, int qb, char* lds) {
  const int tid = otid(), lane = tid & 63, wave = uni(tid >> 6);
  const int map = wave >> 2, qt = wave & 3, r = lane & 31, h = lane >> 5;
  const bf16_t* Z = (const bf16_t*)(p.ws + W_Z);
  const int NT = KIND == 0 ? 2 * (qb + 1) : (NKS + 63) / 64;
  const int ntw = KIND == 0 ? 2 * qb + (qt >> 1) + 1 : NT;
  const bool active = KIND == 0 ? true : (qt == 0);
  int qrow;
  if (KIND == 0) qrow = b * SEQ + qb * 128 + qt * 32 + r; else qrow = MP + b * 16 + (r < 16 ? r : 15);
  bf16x8 qf[4];
#pragma unroll
  for (int ks = 0; ks < 4; ++ks) {
    if (KIND == 0) qf[ks] = *(const bf16x8*)(Z + (size_t)qrow * NIN + ha * 128 + map * 64 + ks * 16 + h * 8);
    else {
      const int dn = ks * 16 + h * 8, par = dn >> 5, dd = dn & 31;
      const bf16_t* src = Z + (size_t)qrow * NIN + ha * 128 + map * 64 + 2 * dd;
      const u32x4 lo = *(const u32x4*)src, hi = *(const u32x4*)(src + 8);
      unsigned e[8];
#pragma unroll
      for (int i = 0; i < 4; ++i) { e[i] = par ? (lo[i] >> 16) : (lo[i] & 0xffffu); e[4 + i] = par ? (hi[i] >> 16) : (hi[i] & 0xffffu); }
      u32x4 o; o[0] = e[0] | (e[1] << 16); o[1] = e[2] | (e[3] << 16); o[2] = e[4] | (e[5] << 16); o[3] = e[6] | (e[7] << 16);
      qf[ks] = __builtin_bit_cast(bf16x8, o);
    }
  }
  const int skey = tid >> 4, part = tid & 15;
  u32x4 rk0, rk1, rv0, rv1;
  auto gload = [&](int j) {
    if (KIND == 0) {
      const bf16_t* base = Z + (size_t)(b * SEQ + j * 64 + skey) * NIN + 1024 + ha * 128 + part * 8;
      rk0 = *(const u32x4*)base; rk1 = *(const u32x4*)(base + (size_t)32 * NIN);
      rv0 = *(const u32x4*)(base + 1024); rv1 = *(const u32x4*)(base + (size_t)32 * NIN + 1024);
    } else {
#pragma unroll
      for (int i = 0; i < 2; ++i) {
        int kk = j * 64 + skey + 32 * i; if (kk > NKS - 1) kk = NKS - 1;
        const float *ks_, *vs_;
        if (kk < PAST) { const size_t o = (((size_t)(l * 8 + b) * PAST + kk) * 8 + ha) * 128 + part * 8; ks_ = p.in[2] + o; vs_ = p.in[3] + o; }
        else { const size_t o = (((size_t)l * MS + b * 16 + (kk - PAST)) * 8 + ha) * 128 + part * 8; ks_ = p.out + O_KS + o; vs_ = p.out + O_VS + o; }
        const f32x4 a0 = *(const f32x4*)ks_, a1 = *(const f32x4*)(ks_ + 4), c0 = *(const f32x4*)vs_, c1 = *(const f32x4*)(vs_ + 4);
        u32x4 ko, vo;
        ko[0] = pk2(a0[0], a0[1]); ko[1] = pk2(a0[2], a0[3]); ko[2] = pk2(a1[0], a1[1]); ko[3] = pk2(a1[2], a1[3]);
        vo[0] = pk2(c0[0], c0[1]); vo[1] = pk2(c0[2], c0[3]); vo[2] = pk2(c1[0], c1[1]); vo[3] = pk2(c1[2], c1[3]);
        if (i == 0) { rk0 = ko; rv0 = vo; } else { rk1 = ko; rv1 = vo; }
      }
    }
  };
  f32x16 O[4];
#pragma unroll
  for (int v = 0; v < 4; ++v)
#pragma unroll
    for (int i = 0; i < 16; ++i) O[v][i] = 0.f;
  float m_run = -1e30f, l_run = 0.f;
  const int q4 = (lane & 15) >> 2, p4 = lane & 3, blk = (lane >> 4) & 1;
  const unsigned sofs = skey * A_LD + part * 16;
  auto qk = [&](int j, f32x16 (&st)[2]) {
    const char* kb = lds + (j & 1) * A_TILE;
#pragma unroll
    for (int kt = 0; kt < 2; ++kt) {
#pragma unroll
      for (int i = 0; i < 16; ++i) st[kt][i] = 0.f;
#pragma unroll
      for (int ks = 0; ks < 4; ++ks) {
        const bf16x8 kf = *(const bf16x8*)(kb + (kt * 32 + r) * A_LD + (map * 64 + ks * 16 + h * 8) * 2);
        st[kt] = MFMA32(kf, qf[ks], st[kt]);
      }
    }
    if (KIND == 1 && j == NT - 1) {
#pragma unroll
      for (int kt = 0; kt < 2; ++kt)
#pragma unroll
        for (int i = 0; i < 16; ++i) if (j * 64 + kt * 32 + crow(i, h) >= NKS) st[kt][i] = -1e30f;
    }
  };
  bf16x8 pk[4];
  auto smax = [&](int j, f32x16 (&sc)[2], f32x16 (&sn)[2]) {
    if (j + 1 < ntw) qk(j + 1, sn);
    float mx = sc[0][0];
#pragma unroll
    for (int kt = 0; kt < 2; ++kt)
#pragma unroll
      for (int i = 0; i < 16; ++i) mx = fmaxf(mx, sc[kt][i]);
    mx = fmaxf(mx, __shfl_xor(mx, 32));
    const float m_new = fmaxf(m_run, mx);
    const float alpha = __builtin_amdgcn_exp2f((m_run - m_new) * LOG2E);
    const float mb = m_new * LOG2E;
    float rs = 0.f;
#pragma unroll
    for (int kt = 0; kt < 2; ++kt)
#pragma unroll
      for (int i = 0; i < 16; ++i) { const float e = __builtin_amdgcn_exp2f(sc[kt][i] * LOG2E - mb); sc[kt][i] = e; rs += e; }
    rs += __shfl_xor(rs, 32);
    l_run = l_run * alpha + rs; m_run = m_new;
    if (__builtin_amdgcn_ballot_w64(alpha != 1.f) != 0ull) {
#pragma unroll
      for (int v = 0; v < 4; ++v)
#pragma unroll
        for (int i = 0; i < 16; ++i) O[v][i] *= alpha;
    }
    pk[0] = pack8(sc[0], 0); pk[1] = pack8(sc[0], 1); pk[2] = pack8(sc[1], 0); pk[3] = pack8(sc[1], 1);
  };
  auto pv = [&](int j) {
    const unsigned vaddr = lds_addr(lds + (2 + j % 3) * A_TILE) + (4 * h + q4) * A_LD + (16 * blk + 4 * p4) * 2;
#pragma unroll
    for (int vt = 0; vt < 4; ++vt) {
      bf16x8 vf[4];
      tr_frag4<16 * A_LD, 8 * A_LD>(vaddr + vt * 64, vf);
#pragma unroll
      for (int ks = 0; ks < 4; ++ks) O[vt] = MFMA32(vf[ks], pk[ks], O[vt]);
    }
  };
  gload(0);
  { char* kb = lds + sofs; *(u32x4*)kb = rk0; *(u32x4*)(kb + 32 * A_LD) = rk1; char* vb = lds + 2 * A_TILE + sofs; *(u32x4*)vb = rv0; *(u32x4*)(vb + 32 * A_LD) = rv1; }
  gload(1);
  { char* kb = lds + A_TILE + sofs; *(u32x4*)kb = rk0; *(u32x4*)(kb + 32 * A_LD) = rk1; }
  __syncthreads();
  f32x16 sA[2], sB[2];
  if (active && 0 < ntw) qk(0, sA);
  for (int j = 0; j < NT; j += 2) {
#pragma unroll
    for (int u = 0; u < 2; ++u) {
      const int jj = j + u;
      if (jj < NT) {
        if (jj + 1 < NT) { char* vb = lds + (2 + (jj + 1) % 3) * A_TILE + sofs; *(u32x4*)vb = rv0; *(u32x4*)(vb + 32 * A_LD) = rv1; }
        if (jj + 2 < NT) gload(jj + 2);
        if (active) {
          if (map == 1 && jj >= 1 && jj - 1 < ntw) pv(jj - 1);
          if (jj < ntw) { if (u == 0) smax(jj, sA, sB); else smax(jj, sB, sA); }
          if (map == 0 && jj < ntw) pv(jj);
        }
        if (jj + 2 < NT) { char* kb = lds + (jj & 1) * A_TILE + sofs; *(u32x4*)kb = rk0; *(u32x4*)(kb + 32 * A_LD) = rk1; }
        __syncthreads();
      }
    }
  }
  if (active && map == 1 && ntw == NT) pv(NT - 1);
  __syncthreads();
  float* ex = (float*)lds;
  const float inv_l = 1.f / l_run;
  if (map == 1) {
#pragma unroll
    for (int vt = 0; vt < 4; ++vt)
#pragma unroll
      for (int g = 0; g < 4; ++g) {
        f32x4 o; o[0] = O[vt][4 * g] * inv_l; o[1] = O[vt][4 * g + 1] * inv_l; o[2] = O[vt][4 * g + 2] * inv_l; o[3] = O[vt][4 * g + 3] * inv_l;
        *(f32x4*)(ex + (qt * 32 + r) * 132 + vt * 32 + 8 * g + 4 * h) = o;
      }
  }
  __syncthreads();
  if (map == 0) {
    const float lam = ((const float*)(p.ws + W_MISC))[l];
    const float lam_init = (l == 0) ? 0.2f : (0.8f - 0.6f * 0.74081822068171788f);
    float ssq = 0.f;
#pragma unroll
    for (int vt = 0; vt < 4; ++vt)
#pragma unroll
      for (int g = 0; g < 4; ++g) {
        const f32x4 o2 = *(const f32x4*)(ex + (qt * 32 + r) * 132 + vt * 32 + 8 * g + 4 * h);
#pragma unroll
        for (int e = 0; e < 4; ++e) { const float o = O[vt][4 * g + e] * inv_l - lam * o2[e]; O[vt][4 * g + e] = o; ssq += o * o; }
      }
    ssq += __shfl_xor(ssq, 32);
    const float rms = rsqrtf(ssq * (1.f / 128.f) + LN_EPS) * (1.f - lam_init);
    const float* sg = p.in[14] + l * 128;
    const bool valid = KIND == 0 ? true : (qt == 0 && r < 16);
    if (valid) {
      bf16_t* dst = (bf16_t*)(p.ws + W_Z) + (size_t)qrow * NIN + 3072 + ha * 128;
#pragma unroll
      for (int vt = 0; vt < 4; ++vt)
#pragma unroll
        for (int g = 0; g < 4; ++g) {
          const int v0 = vt * 32 + 8 * g + 4 * h;
          const f32x4 gg = *(const f32x4*)(sg + v0);
          u32x2 o; o[0] = pk2(O[vt][4 * g] * rms * gg[0], O[vt][4 * g + 1] * rms * gg[1]); o[1] = pk2(O[vt][4 * g + 2] * rms * gg[2], O[vt][4 * g + 3] * rms * gg[3]);
          *(u32x2*)(dst + v0) = o;
        }
    }
  }
  __syncthreads();
}

constexpr int L_LD = 528;
constexpr int L_VLD = 272;
constexpr int L_Q = 0, L_K = 64 * L_LD, L_V = 2 * 64 * L_LD, L_SW = L_V + 64 * L_VLD;
constexpr int L_SWLD = 144;
constexpr int L_SC = L_SW + 64 * L_SWLD;
constexpr int S_MX = 0, S_G = 64, S_EMT = 128, S_DS0 = 192, S_DS1 = 256, S_QN = 320  , S_NV = 576  , S_GEND = 832, S_PAR = 840;
constexpr int LDS_BYTES = 153376;
static_assert(L_SC + 2 * S_PAR * 4 <= 131072, "lds");
#define WG_BAR() do { __builtin_amdgcn_fence(__ATOMIC_RELEASE, "workgroup"); __builtin_amdgcn_s_barrier(); __builtin_amdgcn_fence(__ATOMIC_ACQUIRE, "workgroup"); } while (0)

template <int KIND>
DI void mlstm_item(const Params& p, int l, int b, int hm, int half, char* lds) {
  const int tid0 = otid(), wave = uni(tid0 >> 6);
  const bf16_t* QA = (const bf16_t*)(p.ws + W_AB); const bf16_t* KA = (const bf16_t*)(p.ws + W_KA);
  const bf16_t* Z = (const bf16_t*)(p.ws + W_Z); bf16_t* H = (bf16_t*)(p.ws + W_H);
  const float* GIF = (const float*)(p.ws + W_GIF);
  float* scb = (float*)(lds + L_SC);
  int nchunks = KIND == 0 ? SEQ / 64 : 1; asm volatile("" : "+s"(nchunks));
  const int Lv = KIND == 0 ? 64 : 16;
  const size_t bh = KIND == 0 ? (size_t)(l * 4 + b) * 4 + hm : (size_t)(l * 8 + b) * 4 + hm;
  if (wave < 4) {
    f32x16 C[8];
    { const int lane = tid0 & 63, r = lane & 31, h = lane >> 5; (void)r; (void)h;
      if (KIND == 0) {
#pragma unroll
        for (int d = 0; d < 8; ++d)
#pragma unroll
          for (int i = 0; i < 16; ++i) C[d][i] = 0.f;
      } else {
        const float* cp = p.in[5] + bh * 65536 + (size_t)(4 * h) * 256 + half * 128 + wave * 32 + r;
#pragma unroll
        for (int d = 0; d < 8; ++d)
#pragma unroll
          for (int g = 0; g < 4; ++g) {
            C[d][4 * g] = cp[0]; C[d][4 * g + 1] = cp[256]; C[d][4 * g + 2] = cp[512]; C[d][4 * g + 3] = cp[768];
            cp += 2048; asm volatile("" : "+v"(cp));
          }
      }
    }
    for (int c = 0; c < nchunks; ++c) {
      int tid = tid0; asm volatile("" : "+v"(tid));
      const int lane = tid & 63, r = lane & 31, h = lane >> 5;
      const int q4 = (lane & 15) >> 2, p4 = lane & 3, blk = (lane >> 4) & 1;
      const float* sc = scb + (c & 1) * S_PAR;
      const int rowbase = KIND == 0 ? b * SEQ + c * 64 : MP + b * 16;
      WG_BAR();
      f32x16 accB[2];
#pragma unroll
      for (int tt = 0; tt < 2; ++tt)
#pragma unroll
        for (int i = 0; i < 16; ++i) accB[tt][i] = 0.f;
#pragma unroll
      for (int d = 0; d < 8; ++d)
#pragma unroll
        for (int s = 0; s < 2; ++s) {
          __builtin_amdgcn_sched_barrier(0);
          const bf16x8 cf = pack8(C[d], s);
#pragma unroll
          for (int tt = 0; tt < 2; ++tt) {
            const char* qp = lds + L_Q + (tt * 32 + r) * L_LD + (d * 32 + 16 * s + 4 * h) * 2;
            const s16x4 lo = *(const s16x4*)qp, hi = *(const s16x4*)(qp + 16);
            const bf16x8 qfr = __builtin_shufflevector(lo, hi, 0, 1, 2, 3, 4, 5, 6, 7);
            accB[tt] = MFMA32(cf, qfr, accB[tt]);
          }
        }
      __builtin_amdgcn_sched_barrier(0);
      bf16x8 vf[4];
      tr_frag4<16 * L_VLD, 4 * L_VLD>(lds_addr(lds + L_V) + (8 * h + q4) * L_VLD + (wave * 32 + 16 * blk + 4 * p4) * 2, vf);
      const float g_end = sc[S_GEND];
#pragma unroll
      for (int d = 0; d < 8; ++d) {
#pragma unroll
        for (int i = 0; i < 16; ++i) C[d][i] *= g_end;
        bf16x8 kf[4];
        tr_frag4<16 * L_LD, 4 * L_LD>(lds_addr(lds + L_K) + (8 * h + q4) * L_LD + (d * 32 + 16 * blk + 4 * p4) * 2, kf);
#pragma unroll
        for (int ks = 0; ks < 4; ++ks) C[d] = MFMA32(kf[ks], vf[ks], C[d]);
      }
      WG_BAR();
#pragma unroll
      for (int tt = 0; tt < 2; ++tt) {
        const int t = tt * 32 + r;
        const float g = sc[S_G + t];
#pragma unroll
        for (int i = 0; i < 16; ++i) accB[tt][i] *= g;
        const char* sp = lds + L_SW + (tt * 32 + r) * L_SWLD + h * 16;
#pragma unroll
        for (int ks = 0; ks < 4; ++ks) accB[tt] = MFMA32(vf[ks], *(const bf16x8*)(sp + ks * 32), accB[tt]);
        const float qn = (sc[S_QN + t] + sc[S_QN + 64 + t]) + (sc[S_QN + 128 + t] + sc[S_QN + 192 + t]);
        float den = sc[S_DS0 + t] + sc[S_DS1 + t] + g * qn;
        den = fmaxf(fabsf(den), sc[S_EMT + t]);
        const float rden = 1.f / den;
        if (t < Lv) {
          bf16_t* dst = H + (size_t)(rowbase + t) * D + hm * 256 + half * 128 + wave * 32;
#pragma unroll
          for (int g4 = 0; g4 < 4; ++g4) {
            u32x2 o; o[0] = pk2(accB[tt][4 * g4] * rden, accB[tt][4 * g4 + 1] * rden); o[1] = pk2(accB[tt][4 * g4 + 2] * rden, accB[tt][4 * g4 + 3] * rden);
            *(u32x2*)(dst + 8 * g4 + 4 * h) = o;
          }
        }
      }
    }
    WG_BAR();
    {
      const int lane = tid0 & 63, r = lane & 31, h = lane >> 5;
      float* co = p.out + (KIND == 0 ? O_CP : O_CS) + bh * 65536 + (size_t)(4 * h) * 256 + half * 128 + wave * 32 + r;
#pragma unroll
      for (int d = 0; d < 8; ++d)
#pragma unroll
        for (int g = 0; g < 4; ++g) {
          co[0] = C[d][4 * g]; co[256] = C[d][4 * g + 1]; co[512] = C[d][4 * g + 2]; co[768] = C[d][4 * g + 3];
          co += 2048; asm volatile("" : "+v"(co));
        }
    }
  } else {
    const int hw = wave - 4;
    float nreg = 0.f, m_prev = 0.f;
    if (KIND == 1) { nreg = p.in[6][bh * 256 + (tid0 - 256)]; m_prev = p.in[7][bh]; }
    u32x4 pq[8], pk[8], pv[4];
    float gi = 0.f, gf = 0.f, g_end_cur = 0.f;
    auto issue_loads = [&](int c, int tid) {
      const int ht = tid - 256, lane = tid & 63;
      const int rowbase = KIND == 0 ? b * SEQ + c * 64 : MP + b * 16;
      const bool tvalid = lane < Lv;
      gi = tvalid ? GIF[(size_t)(rowbase + lane) * 8 + hm] : -1e30f;
      gf = tvalid ? GIF[(size_t)(rowbase + lane) * 8 + 4 + hm] : 0.f;
#pragma unroll
      for (int i = 0; i < 8; ++i) {
        const int cidx = ht + 256 * i, t = cidx >> 5, pc = cidx & 31;
        const int row = rowbase + (t < Lv ? t : Lv - 1);
        pq[i] = *(const u32x4*)(QA + (size_t)row * D + hm * 256 + pc * 8);
        pk[i] = *(const u32x4*)(KA + (size_t)row * D + hm * 256 + pc * 8);
      }
#pragma unroll
      for (int i = 0; i < 4; ++i) {
        const int cidx = ht + 256 * i, t = cidx >> 4, pc = cidx & 15;
        const int row = rowbase + (t < Lv ? t : Lv - 1);
        pv[i] = *(const u32x4*)(Z + (size_t)row * NIN + 5120 + hm * 256 + half * 128 + pc * 8);
      }
    };
    auto scalars = [&](int par, int lane) -> float {
      const bool tvalid = lane < Lv;
      const float lf = tvalid ? (fminf(gf, 0.f) - __logf(1.f + __expf(-fabsf(gf)))) : 0.f;
      float bc = lf;
#pragma unroll
      for (int o = 1; o < 64; o <<= 1) { const float v = __shfl_up(bc, o); if (lane >= o) bc += v; }
      const float a = gi - bc;
      float cm = a;
#pragma unroll
      for (int o = 1; o < 64; o <<= 1) { const float v = __shfl_up(cm, o); if (lane >= o) cm = fmaxf(cm, v); }
      const float mxv = fmaxf(m_prev, cm);
      const float m_t = bc + mxv;
      const float mx_end = __shfl(mxv, 63), bc_end = __shfl(bc, 63);
      const float wend = __expf(a - mx_end);
      g_end_cur = __expf(m_prev - mx_end);
      if (hw == 0) {
        float* sc = scb + par * S_PAR;
        sc[S_MX + lane] = __expf(mx_end - mxv);
        sc[S_G + lane] = __expf(m_prev - mxv);
        sc[S_EMT + lane] = __expf(-m_t);
        if (lane == 0) sc[S_GEND] = g_end_cur;
      }
      m_prev = bc_end + mx_end;
      return wend;
    };
    auto stage_lds = [&](float wend_l, int tid) {
      const int ht = tid - 256;
#pragma unroll
      for (int i = 0; i < 8; ++i) {
        const int cidx = ht + 256 * i, t = cidx >> 5, pc = cidx & 31;
        const float we = __shfl(wend_l, t);
        float f[8]; unpack8(pk[i], f);
        u32x4 o; o[0] = pk2(f[0] * we, f[1] * we); o[1] = pk2(f[2] * we, f[3] * we); o[2] = pk2(f[4] * we, f[5] * we); o[3] = pk2(f[6] * we, f[7] * we);
        *(u32x4*)(lds + L_Q + t * L_LD + pc * 16) = pq[i];
        *(u32x4*)(lds + L_K + t * L_LD + pc * 16) = o;
      }
#pragma unroll
      for (int i = 0; i < 4; ++i) {
        const int cidx = ht + 256 * i, t = cidx >> 4, pc = cidx & 15;
        *(u32x4*)(lds + L_V + t * L_VLD + pc * 16) = pv[i];
      }
    };
    {
      int tid = tid0; asm volatile("" : "+v"(tid));
      issue_loads(0, tid);
      scb[S_NV + (tid - 256)] = nreg;
      const float wend = scalars(0, tid & 63);
      stage_lds(wend, tid);
    }
    for (int c = 0; c < nchunks; ++c) {
      int tid = tid0; asm volatile("" : "+v"(tid));
      const int ht = tid - 256, lane = tid & 63, r = lane & 31, h = lane >> 5;
      float* sc = scb + (c & 1) * S_PAR;
      float* scn = scb + ((c + 1) & 1) * S_PAR;
      const float g_end_c = g_end_cur;
      WG_BAR();
      const bool more = c + 1 < nchunks;
      if (more) issue_loads(c + 1, tid);
      {
        const int t = ht & 63, part = ht >> 6;
        const char* qp = lds + L_Q + t * L_LD + part * 128;
        float s = 0.f;
#pragma unroll
        for (int e = 0; e < 8; ++e) {
          const u32x4 qq = *(const u32x4*)(qp + e * 16); float f[8]; unpack8(qq, f);
#pragma unroll
          for (int z = 0; z < 8; ++z) s += f[z] * sc[S_NV + part * 64 + e * 8 + z];
        }
        sc[S_QN + part * 64 + t] = s;
      }
      if (hw < 3) {
        const int stl = hw == 2 ? 1 : 0, tt = hw == 0 ? 0 : 1;
        f32x16 S, S2;
#pragma unroll
        for (int i = 0; i < 16; ++i) { S[i] = 0.f; S2[i] = 0.f; }
        const char* ka = lds + L_K + (stl * 32 + r) * L_LD + h * 16;
        const char* qa = lds + L_Q + (tt * 32 + r) * L_LD + h * 16;
#pragma unroll 4
        for (int ks = 0; ks < 16; ks += 2) {
          S = MFMA32(*(const bf16x8*)(ka + ks * 32), *(const bf16x8*)(qa + ks * 32), S);
          S2 = MFMA32(*(const bf16x8*)(ka + ks * 32 + 32), *(const bf16x8*)(qa + ks * 32 + 32), S2);
        }
        const int t = tt * 32 + r;
        const float cw = sc[S_MX + t];
        float rs = 0.f;
#pragma unroll
        for (int g = 0; g < 4; ++g) {
          float wv[4];
#pragma unroll
          for (int e = 0; e < 4; ++e) {
            const int s = stl * 32 + 8 * g + 4 * h + e;
            wv[e] = s <= t ? (S[4 * g + e] + S2[4 * g + e]) * cw : 0.f; rs += wv[e];
          }
          u32x2 o; o[0] = pk2(wv[0], wv[1]); o[1] = pk2(wv[2], wv[3]);
          *(u32x2*)(lds + L_SW + t * L_SWLD + (stl * 32 + 8 * g + 4 * h) * 2) = o;
        }
        rs += __shfl_xor(rs, 32);
        if (h == 0) {
          if (hw == 0) { sc[S_DS0 + t] = rs; sc[S_DS1 + t] = 0.f; }
          else if (hw == 1) sc[S_DS0 + t] = rs;
          else sc[S_DS1 + t] = rs;
        }
      } else {
        const int t = lane >> 1, hs = lane & 1;
        u32x4 z; z[0] = 0; z[1] = 0; z[2] = 0; z[3] = 0;
        *(u32x4*)(lds + L_SW + t * L_SWLD + 64 + hs * 32) = z; *(u32x4*)(lds + L_SW + t * L_SWLD + 64 + hs * 32 + 16) = z;
      }
      {
        float s0 = 0.f, s1 = 0.f, s2 = 0.f, s3 = 0.f;
        const char* kp = lds + L_K + ht * 2;
#pragma unroll
        for (int t = 0; t < 64; t += 4) {
          s0 += bflo((unsigned)*(const bf16_t*)(kp + t * L_LD)); s1 += bflo((unsigned)*(const bf16_t*)(kp + (t + 1) * L_LD));
          s2 += bflo((unsigned)*(const bf16_t*)(kp + (t + 2) * L_LD)); s3 += bflo((unsigned)*(const bf16_t*)(kp + (t + 3) * L_LD));
        }
        nreg = g_end_c * nreg + ((s0 + s1) + (s2 + s3));
        scn[S_NV + ht] = nreg;
      }
      float wend = 0.f;
      if (more) wend = scalars((c + 1) & 1, lane);
      WG_BAR();
      if (more) stage_lds(wend, tid);
    }
    WG_BAR();
    if (half == 0) {
      p.out[(KIND == 0 ? O_NP : O_NS) + bh * 256 + (tid0 - 256)] = nreg;
      if (tid0 == 256) p.out[(KIND == 0 ? O_MPP : O_MSS) + bh] = m_prev;
    }
  }
}

DI void mixer_phase(const Params& p, int l, char* lds, int cidx, bool ml_only) {
  unsigned* ctr = (unsigned*)(p.ws + W_MISC) + 16 + cidx;
  int* s_item = (int*)(lds + LDS_BYTES - 16);
  const int total = 32 + 64 + 64 + 2048;
  for (;;) {
    __syncthreads();
    if (threadIdx.x == 0) *s_item = (int)atomicAdd(ctr, 1u);
    __syncthreads();
    const int it = *s_item;
    __syncthreads();
    if (it >= total) break;
    if (ml_only && it >= 96) break;
    if (it < 32) { mlstm_item<0>(p, l, it >> 3, (it >> 1) & 3, it & 1, lds); continue; }
    if (it < 96) { const int x = it - 32; mlstm_item<1>(p, l, x >> 3, (x >> 1) & 3, x & 1, lds); continue; }
    if (it < 160) { attn_item<1>(p, l, (it - 96) >> 3, (it - 96) & 7, 0, lds); continue; }
    { const int x = it - 160; attn_item<0>(p, l, (x & 31) >> 3, x & 7, 63 - (x >> 5), lds); }
  }
}

DI void merge_phase(const Params& p, int l) {
  const bf16_t* Z = (const bf16_t*)(p.ws + W_Z); const bf16_t* H = (const bf16_t*)(p.ws + W_H); bf16_t* Y = (bf16_t*)(p.ws + W_AB);
  const int tidq = otid(); const int lane = tidq & 63, gw = blockIdx.x * 8 + (tidq >> 6), ngw = gridDim.x * 8;
  const float* mhg = p.in[15] + (size_t)l * D;
  for (int row = gw; row < M; row += ngw) {
    const int col = lane * 16;
    const bf16_t* z = Z + (size_t)row * NIN + col;
    float hv[16];
    unpack8(*(const u32x4*)(H + (size_t)row * D + col), hv); unpack8(*(const u32x4*)(H + (size_t)row * D + col + 8), hv + 8);
    float s = 0.f;
#pragma unroll
    for (int e = 0; e < 16; ++e) s += hv[e];
#pragma unroll
    for (int o = 1; o < 16; o <<= 1) s += __shfl_xor(s, o);
    const float mean = s * (1.f / 256.f);
    float s2 = 0.f;
#pragma unroll
    for (int e = 0; e < 16; ++e) { hv[e] -= mean; s2 += hv[e] * hv[e]; }
#pragma unroll
    for (int o = 1; o < 16; o <<= 1) s2 += __shfl_xor(s2, o);
    const float rstd = rsqrtf(s2 * (1.f / 256.f) + LN_EPS);
#pragma unroll
    for (int hh = 0; hh < 2; ++hh) {
      float oa[8], om[8], ga[8], gb[8];
      unpack8(*(const u32x4*)(z + 3072 + hh * 8), oa); unpack8(*(const u32x4*)(z + 6144 + hh * 8), om);
      unpack8(*(const u32x4*)(z + 7168 + hh * 8), ga); unpack8(*(const u32x4*)(z + 8192 + hh * 8), gb);
      const f32x4 g0 = *(const f32x4*)(mhg + col + hh * 8), g1 = *(const f32x4*)(mhg + col + hh * 8 + 4);
      float y[8];
#pragma unroll
      for (int e = 0; e < 8; ++e) {
        const float hn = hv[hh * 8 + e] * rstd * (e < 4 ? g0[e] : g1[e - 4]);
        y[e] = sigmoidf_(ga[e]) * oa[e] + sigmoidf_(gb[e]) * (hn * sigmoidf_(om[e]));
      }
      u32x4 o; o[0] = pk2(y[0], y[1]); o[1] = pk2(y[2], y[3]); o[2] = pk2(y[4], y[5]); o[3] = pk2(y[6], y[7]);
      *(u32x4*)(Y + (size_t)row * D + col + hh * 8) = o;
    }
  }
}

DI void ln_phase(const Params& p, const float* g, const float* bta, bool final_out) {
  const int tidq = otid(); const int lane = tidq & 63, gw = blockIdx.x * 8 + (tidq >> 6), ngw = gridDim.x * 8;
  float* R = (float*)(p.ws + W_R); bf16_t* AB = (bf16_t*)(p.ws + W_AB);
  for (int row = gw; row < M; row += ngw) {
    float* xr = R + (size_t)row * D;
    f32x4 v[4]; float s = 0.f;
#pragma unroll
    for (int j = 0; j < 4; ++j) { v[j] = *(const f32x4*)(xr + j * 256 + lane * 4); s += (v[j][0] + v[j][1]) + (v[j][2] + v[j][3]); }
    const float mean = wave_sum(s) * (1.f / D);
    float s2 = 0.f;
#pragma unroll
    for (int j = 0; j < 4; ++j) { v[j] = v[j] - mean; s2 += (v[j][0] * v[j][0] + v[j][1] * v[j][1]) + (v[j][2] * v[j][2] + v[j][3] * v[j][3]); }
    const float rstd = rsqrtf(wave_sum(s2) * (1.f / D) + LN_EPS);
    float* dst = final_out ? (row < MP ? p.out + O_YP + (size_t)row * D : p.out + O_YS + (size_t)(row - MP) * D) : xr;
#pragma unroll
    for (int j = 0; j < 4; ++j) {
      const int c = j * 256 + lane * 4;
      const f32x4 gg = *(const f32x4*)(g + c), bb = *(const f32x4*)(bta + c);
      f32x4 o = v[j] * rstd * gg + bb;
      *(f32x4*)(dst + c) = o;
      if (!final_out) { u32x2 ob; ob[0] = pk2(o[0], o[1]); ob[1] = pk2(o[2], o[3]); *(u32x2*)(AB + (size_t)row * D + c) = ob; }
    }
  }
}

DI float gelu_f(float v) {
  const float av = fabsf(v), d = av * 0.2316418882f + 1.0f;
  const float t = __builtin_amdgcn_rcpf(d);
  float q = t * 0.5307027145f + (-0.7265760135f); q = q * t + 0.7107068705f; q = q * t + (-0.142248368f); q = q * t + 0.127414796f; q = q * t;
  const float e = __builtin_amdgcn_exp2f((v * v) * (-0.72134752044f));
  const float m = v * (q * e), r = v - m;
  return v < 0.f ? m : r;
}
DI void ffnconv_phase(const Params& p, int l) {
  const bf16_t* U = (const bf16_t*)(p.ws + W_Z); bf16_t* HF = (bf16_t*)(p.ws + W_Z + (size_t)M * NUP * 2);
  const float* cw = p.in[20] + (size_t)l * 3 * NUP; const float* cb = p.in[21] + (size_t)l * NUP;
  const size_t total = (size_t)M * 352;
  for (size_t it = (size_t)blockIdx.x * NTH + otid(); it < total; it += (size_t)gridDim.x * NTH) {
    const int row = (int)(it / 352), col = (int)(it % 352) * 8;
    int t; const float* st = nullptr;
    if (row < MP) t = row & (SEQ - 1); else { t = (row - MP) & 15; st = p.in[8] + ((size_t)(l * 8 + ((row - MP) >> 4)) * 2) * NUP; }
    float u[2][8];
#pragma unroll
    for (int hf = 0; hf < 2; ++hf) {
      const int cc = col + hf * DFF;
      f32x4 a = *(const f32x4*)(cb + cc), b = *(const f32x4*)(cb + cc + 4);
      u[hf][0] = a[0]; u[hf][1] = a[1]; u[hf][2] = a[2]; u[hf][3] = a[3]; u[hf][4] = b[0]; u[hf][5] = b[1]; u[hf][6] = b[2]; u[hf][7] = b[3];
#pragma unroll
      for (int j = 0; j < 3; ++j) {
        const int tj = t - 2 + j;
        float x[8];
        if (tj >= 0) unpack8(*(const u32x4*)(U + (size_t)(row - 2 + j) * NUP + cc), x);
        else if (st) { const float* s = st + (size_t)(2 + tj) * NUP + cc; f32x4 a2 = *(const f32x4*)s, b2 = *(const f32x4*)(s + 4);
          x[0] = a2[0]; x[1] = a2[1]; x[2] = a2[2]; x[3] = a2[3]; x[4] = b2[0]; x[5] = b2[1]; x[6] = b2[2]; x[7] = b2[3]; }
        else {
#pragma unroll
          for (int e = 0; e < 8; ++e) x[e] = 0.f; }
        const f32x4 w0 = *(const f32x4*)(cw + j * NUP + cc), w1 = *(const f32x4*)(cw + j * NUP + cc + 4);
        u[hf][0] += w0[0] * x[0]; u[hf][1] += w0[1] * x[1]; u[hf][2] += w0[2] * x[2]; u[hf][3] += w0[3] * x[3];
        u[hf][4] += w1[0] * x[4]; u[hf][5] += w1[1] * x[5]; u[hf][6] += w1[2] * x[6]; u[hf][7] += w1[3] * x[7];
      }
    }
    float o[8];
#pragma unroll
    for (int e = 0; e < 8; ++e) { const float a = u[0][e]; o[e] = gelu_f(a) * u[1][e]; }
    u32x4 ov; ov[0] = pk2(o[0], o[1]); ov[1] = pk2(o[2], o[3]); ov[2] = pk2(o[4], o[5]); ov[3] = pk2(o[6], o[7]);
    *(u32x4*)(HF + (size_t)row * DFF + col) = ov;
  }
}

constexpr int NPH = 21;
DI void run_phase(const Params& p, int ph, char* lds) {
#ifndef ONLY
  if (ph == 0) { phase0(p, lds); return; }
#else
  if (ph == 0) return;
#endif
  const int l = (ph - 1) / 10, s = (ph - 1) % 10;
#ifdef ONLY
  if (s != ONLY) return;
#endif
  switch (s) {
    case 0: gemm_phase<EPI_IN>(p, l, (const bf16_t*)(p.ws + W_AB), D, (const bf16_t*)(p.ws + W_WIN) + (size_t)l * NIN * D, D, NIN / 256, lds); break;
    case 1: qkconv_phase(p, l); gif_phase(p, l, lds); break;
    case 2: mixer_phase(p, l, lds, l, false); break;
    case 3: merge_phase(p, l); break;
    case 4: gemm_phase<EPI_OUT>(p, l, (const bf16_t*)(p.ws + W_AB), D, (const bf16_t*)(p.ws + W_WOUT) + (size_t)l * D * D, D, D / 256, lds); break;
    case 5: ln_phase(p, p.in[17] + l * D, p.in[18] + l * D, false); break;
    case 6: gemm_phase<EPI_UP>(p, l, (const bf16_t*)(p.ws + W_AB), D, (const bf16_t*)(p.ws + W_WUP) + (size_t)l * NUP * D, D, NUP / 256, lds); break;
    case 7: ffnconv_phase(p, l); break;
    case 8: gemm_phase<EPI_DOWN>(p, l, (const bf16_t*)(p.ws + W_Z + (size_t)M * NUP * 2), DFF, (const bf16_t*)(p.ws + W_WDN) + (size_t)l * D * DFF, DFF, D / 256, lds); break;
    case 9: ln_phase(p, p.in[23] + l * D, p.in[24] + l * D, l == 1); break;
  }
}

__global__ void __launch_bounds__(NTH) mega(Params p, int ph_lo, int ph_hi) {
  extern __shared__ __attribute__((aligned(16))) char lds[];
#if MULTI_LAUNCH
  for (int ph = ph_lo; ph < ph_hi; ++ph) run_phase(p, ph, lds);
#else
  cg::grid_group grid = cg::this_grid();
  phase0(p, lds);
  grid.sync();
  for (int l = 0; l < 2; ++l) {
    gemm_phase<EPI_IN>(p, l, (const bf16_t*)(p.ws + W_AB), D, (const bf16_t*)(p.ws + W_WIN) + (size_t)l * NIN * D, D, NIN / 256, lds);
    grid.sync();
#ifdef PROBE_GIN2
    gemm_phase<EPI_IN>(p, l, (const bf16_t*)(p.ws + W_AB), D, (const bf16_t*)(p.ws + W_WIN) + (size_t)l * NIN * D, D, NIN / 256, lds);
    grid.sync();
#endif
    qkconv_phase(p, l); gif_phase(p, l, lds);
    grid.sync();
#ifdef PROBE_EW2
    qkconv_phase(p, l); gif_phase(p, l, lds);
    grid.sync();
#endif
    mixer_phase(p, l, lds, l, false);
    grid.sync();
#ifdef PROBE_ML2
    mixer_phase(p, l, lds, l + 2, true);
    grid.sync();
#endif
#ifdef PROBE_MIX2
    mixer_phase(p, l, lds, l + 2, false);
    grid.sync();
#endif
    merge_phase(p, l);
    grid.sync();
#ifdef PROBE_EW2
    merge_phase(p, l);
    grid.sync();
#endif
    gemm_phase<EPI_OUT>(p, l, (const bf16_t*)(p.ws + W_AB), D, (const bf16_t*)(p.ws + W_WOUT) + (size_t)l * D * D, D, D / 256, lds);
    grid.sync();
    ln_phase(p, p.in[17] + l * D, p.in[18] + l * D, false);
    grid.sync();
    gemm_phase<EPI_UP>(p, l, (const bf16_t*)(p.ws + W_AB), D, (const bf16_t*)(p.ws + W_WUP) + (size_t)l * NUP * D, D, NUP / 256, lds);
    grid.sync();
    ffnconv_phase(p, l);
    grid.sync();
#ifdef PROBE_EW2
    ffnconv_phase(p, l);
    grid.sync();
#endif
    gemm_phase<EPI_DOWN>(p, l, (const bf16_t*)(p.ws + W_Z + (size_t)M * NUP * 2), DFF, (const bf16_t*)(p.ws + W_WDN) + (size_t)l * D * DFF, DFF, D / 256, lds);
    grid.sync();
    ln_phase(p, p.in[23] + l * D, p.in[24] + l * D, l == 1);
    if (l == 0) grid.sync();
  }
#endif
}

extern "C" void kernel_launch(void* const* d_in, const int* in_sizes, int n_in, void* d_out, int out_size, void* d_ws, size_t ws_size, hipStream_t stream) {
  static int grid = 0;
  if (grid == 0) {
    if (n_in != 25 || (size_t)out_size != O_END || ws_size < W_END) { fprintf(stderr, "kernel_launch: unexpected sizes n_in %d out %d (want %zu) ws %zu (want %zu)\n", n_in, out_size, (size_t)O_END, ws_size, (size_t)W_END); grid = -1; return; }
    int dev = 0, cus = 0, per_cu = 0;
    hipGetDevice(&dev);
    hipDeviceGetAttribute(&cus, hipDeviceAttributeMultiprocessorCount, dev);
    if (hipFuncSetAttribute((const void*)mega, hipFuncAttributeMaxDynamicSharedMemorySize, LDS_BYTES) != hipSuccess) { fprintf(stderr, "hipFuncSetAttribute failed\n"); grid = -1; return; }
    hipOccupancyMaxActiveBlocksPerMultiprocessor(&per_cu, (const void*)mega, NTH, LDS_BYTES);
    if (per_cu < 1) per_cu = 1;
    grid = cus * 1;
    (void)hipGetLastError();
  }
  if (grid < 0) return;
  Params p{};
  for (int i = 0; i < 25; ++i) p.in[i] = (const float*)d_in[i];
  p.out = (float*)d_out; p.ws = (unsigned char*)d_ws;
#if MULTI_LAUNCH
  for (int ph = 0; ph < NPH; ++ph) hipLaunchKernelGGL(mega, dim3(grid), dim3(NTH), LDS_BYTES, stream, p, ph, ph + 1);
#else
  int lo = 0, hi = NPH;
  void* args[] = {&p, &lo, &hi};
  hipError_t e = hipLaunchCooperativeKernel((const void*)mega, dim3(grid), dim3(NTH), args, LDS_BYTES, stream);
  if (e != hipSuccess) fprintf(stderr, "cooperative launch failed: %s (grid %d)\n", hipGetErrorString(e), grid);
#endif
}
```

```cpp
#include <hip/hip_runtime.h>
#include <hip/hip_cooperative_groups.h>
#include <cstdio>
namespace cg = cooperative_groups;

#ifndef MULTI_LAUNCH
#define MULTI_LAUNCH 0
#endif

typedef unsigned short bf16_t;
typedef short bf16x8 __attribute__((ext_vector_type(8)));
typedef short s16x4 __attribute__((ext_vector_type(4)));
typedef float f32x16 __attribute__((ext_vector_type(16)));
typedef float f32x4 __attribute__((ext_vector_type(4)));
typedef unsigned u32x4 __attribute__((ext_vector_type(4)));
typedef unsigned u32x2 __attribute__((ext_vector_type(2)));
#define DI __device__ __forceinline__
#define MFMA32(a, b, c) __builtin_amdgcn_mfma_f32_32x32x16_bf16((a), (b), (c), 0, 0, 0)

constexpr int NTH = 512;
constexpr int D = 1024, SEQ = 8192, NB = 4, MP = NB * SEQ, MS = 128, M = MP + MS, NTM = 129;
constexpr int DIN = 9224, NIN = 9216, DFF = 2816, NUP = 5632;
constexpr int PAST = 4096, NKS = PAST + 16;
constexpr float ALPHA = 1.4142135623730951f;
constexpr float LN_EPS = 1e-5f;
constexpr float LOG2E = 1.4426950408889634f;

constexpr size_t O_YP = 0;
constexpr size_t O_YS = O_YP + (size_t)MP * D;
constexpr size_t O_KP = O_YS + (size_t)MS * D;
constexpr size_t O_VP = O_KP + (size_t)2 * MP * 1024;
constexpr size_t O_MCP = O_VP + (size_t)2 * MP * 1024;
constexpr size_t O_CP = O_MCP + (size_t)2 * 4 * 3 * 2048;
constexpr size_t O_NP = O_CP + (size_t)2 * 4 * 4 * 65536;
constexpr size_t O_MPP = O_NP + (size_t)2 * 4 * 4 * 256;
constexpr size_t O_FCP = O_MPP + 32;
constexpr size_t O_KS = O_FCP + (size_t)2 * 4 * 2 * NUP;
constexpr size_t O_VS = O_KS + (size_t)2 * MS * 1024;
constexpr size_t O_MCS = O_VS + (size_t)2 * MS * 1024;
constexpr size_t O_CS = O_MCS + (size_t)2 * 8 * 3 * 2048;
constexpr size_t O_NS = O_CS + (size_t)2 * 8 * 4 * 65536;
constexpr size_t O_MSS = O_NS + (size_t)2 * 8 * 4 * 256;
constexpr size_t O_FCS = O_MSS + 64;
constexpr size_t O_END = O_FCS + (size_t)2 * 8 * 2 * NUP;

constexpr size_t W_Z = 0;
constexpr size_t W_H = W_Z + (size_t)M * NIN * 2;
constexpr size_t W_AB = W_H + (size_t)M * D * 2;
constexpr size_t W_KA = W_AB + (size_t)M * D * 2;
constexpr size_t W_R = W_KA + (size_t)M * D * 2;
constexpr size_t W_WIN = W_R + (size_t)M * D * 4;
constexpr size_t W_WOUT = W_WIN + (size_t)2 * NIN * D * 2;
constexpr size_t W_WUP = W_WOUT + (size_t)2 * D * D * 2;
constexpr size_t W_WDN = W_WUP + (size_t)2 * NUP * D * 2;
constexpr size_t W_GIF = W_WDN + (size_t)2 * D * DFF * 2;
constexpr size_t W_ROPE = W_GIF + (size_t)M * 8 * 4;
constexpr size_t W_MISC = W_ROPE + (size_t)8192 * 32 * 8;
constexpr size_t W_BAR = W_MISC + 4096;
constexpr size_t W_END = W_BAR + 16384;

struct Params {
  const float* in[25];
  float* out;
  unsigned char* ws;
};

DI unsigned f2bf(float x) { unsigned u = __float_as_uint(x); u += 0x7fffu + ((u >> 16) & 1u); return u >> 16; }
typedef __bf16 bf16v2 __attribute__((ext_vector_type(2)));
typedef float f32x2 __attribute__((ext_vector_type(2)));
DI unsigned pk2(float a, float b) { f32x2 v; v[0] = a; v[1] = b; return __builtin_bit_cast(unsigned, __builtin_convertvector(v, bf16v2)); }
DI float bflo(unsigned u) { return __uint_as_float(u << 16); }
DI float bfhi(unsigned u) { return __uint_as_float(u & 0xffff0000u); }
DI float sigmoidf_(float x) { return 1.f / (1.f + __expf(-x)); }
DI float wave_sum(float v) {
#pragma unroll
  for (int o = 1; o < 64; o <<= 1) v += __shfl_xor(v, o);
  return v;
}
DI int crow(int i, int h) { return (i & 3) + 8 * (i >> 2) + 4 * h; }
DI bf16x8 pack8(const f32x16& x, int s) {
  u32x4 p;
  p[0] = pk2(x[8 * s + 0], x[8 * s + 1]); p[1] = pk2(x[8 * s + 2], x[8 * s + 3]);
  p[2] = pk2(x[8 * s + 4], x[8 * s + 5]); p[3] = pk2(x[8 * s + 6], x[8 * s + 7]);
  return __builtin_bit_cast(bf16x8, p);
}
DI void unpack8(u32x4 v, float* f) {
  f[0] = bflo(v[0]); f[1] = bfhi(v[0]); f[2] = bflo(v[1]); f[3] = bfhi(v[1]);
  f[4] = bflo(v[2]); f[5] = bfhi(v[2]); f[6] = bflo(v[3]); f[7] = bfhi(v[3]);
}
typedef __attribute__((address_space(3))) s16x4 lds_s16x4;
DI bf16x8 tr_frag(unsigned a_lo, unsigned a_hi) {
  const s16x4 lo = __builtin_amdgcn_ds_read_tr16_b64_v4i16((lds_s16x4*)(size_t)a_lo);
  const s16x4 hi = __builtin_amdgcn_ds_read_tr16_b64_v4i16((lds_s16x4*)(size_t)a_hi);
  return __builtin_shufflevector(lo, hi, 0, 1, 2, 3, 4, 5, 6, 7);
}
template <int STEP, int HIOFF>
DI void tr_frag4(unsigned a, bf16x8 (&f)[4]) {
#pragma unroll
  for (int i = 0; i < 4; ++i) f[i] = tr_frag(a + i * STEP, a + i * STEP + HIOFF);
}
DI int otid() { int t = threadIdx.x; asm volatile("" : "+v"(t)); return t; }
DI int uni(int v) { return __builtin_amdgcn_readfirstlane(v); }
DI unsigned lds_addr(const void* p) { return (unsigned)(size_t)p; }

DI const float* xrow_ptr(const Params& p, int l, int row) {
  if (l == 0) return row < MP ? p.in[0] + (size_t)row * D : p.in[1] + (size_t)(row - MP) * D;
  return (const float*)(p.ws + W_R) + (size_t)row * D;
}

DI void transpose_w(const float* W, int K, int N, int src_ld, bf16_t* WT, bool remap, char* lds) {
  float* scr = (float*)lds;
  const int nkb = K / 64, nnb = N / 64, tid = otid();
  for (int it = blockIdx.x; it < nkb * nnb; it += gridDim.x) {
    const int kb = it / nnb, nb = it % nnb, k0 = kb * 64, n0 = nb * 64;
    const int ns = (remap && n0 >= 7168) ? n0 + 8 : n0;
#pragma unroll
    for (int i = 0; i < 8; ++i) {
      const int kk = (tid >> 6) + 8 * i, nn = tid & 63;
      scr[kk * 65 + nn] = W[(size_t)(k0 + kk) * src_ld + ns + nn];
    }
    __syncthreads();
    {
      const int n = tid >> 3, c = tid & 7;
      const float* s = scr + (8 * c) * 65 + n;
      u32x4 o;
      o[0] = pk2(s[0], s[65]); o[1] = pk2(s[2 * 65], s[3 * 65]); o[2] = pk2(s[4 * 65], s[5 * 65]); o[3] = pk2(s[6 * 65], s[7 * 65]);
      const int nd = (remap && n0 < 2048) ? ((n < 32) ? 2 * n : 2 * (n - 32) + 1) : n;
      *(u32x4*)(WT + (size_t)(n0 + nd) * K + k0 + 8 * c) = o;
    }
    __syncthreads();
  }
}

DI void phase0(const Params& p, char* lds) {
  const int tid = otid();
  for (int l = 0; l < 2; ++l) {
    transpose_w(p.in[9] + (size_t)l * D * DIN, D, NIN, DIN, (bf16_t*)(p.ws + W_WIN) + (size_t)l * NIN * D, true, lds);
    transpose_w(p.in[16] + (size_t)l * D * D, D, D, D, (bf16_t*)(p.ws + W_WOUT) + (size_t)l * D * D, false, lds);
    transpose_w(p.in[19] + (size_t)l * D * NUP, D, NUP, NUP, (bf16_t*)(p.ws + W_WUP) + (size_t)l * NUP * D, false, lds);
    transpose_w(p.in[22] + (size_t)l * DFF * D, DFF, D, D, (bf16_t*)(p.ws + W_WDN) + (size_t)l * D * DFF, false, lds);
  }
  bf16_t* ab = (bf16_t*)(p.ws + W_AB);
  for (size_t c = (size_t)blockIdx.x * NTH + tid; c < (size_t)M * 128; c += (size_t)gridDim.x * NTH) {
    const int row = (int)(c >> 7), cc = (int)(c & 127);
    const float* src = xrow_ptr(p, 0, row) + cc * 8;
    f32x4 a = *(const f32x4*)src, b = *(const f32x4*)(src + 4);
    u32x4 o; o[0] = pk2(a[0], a[1]); o[1] = pk2(a[2], a[3]); o[2] = pk2(b[0], b[1]); o[3] = pk2(b[2], b[3]);
    *(u32x4*)(ab + (size_t)row * D + cc * 8) = o;
  }
  float2* rope = (float2*)(p.ws + W_ROPE);
  for (int i = blockIdx.x * NTH + tid; i < 8192 * 32; i += gridDim.x * NTH) {
    const int pos = i >> 5, d = i & 31;
    const double inv = exp2(-(double)d * (13.287712379549449 / 32.0));
    double ang = (double)pos * inv;
    const double twopi = 6.283185307179586476925;
    ang -= twopi * rint(ang / twopi);
    float s, c; sincosf((float)ang, &s, &c);
    rope[i] = make_float2(c, s);
  }
  if (blockIdx.x == 0 && tid < 128) {
    const int l = tid >> 6, ln = tid & 63;
    const float* lp = p.in[13] + (size_t)l * 4 * 64;
    const float s1 = wave_sum(lp[ln] * lp[64 + ln]), s2 = wave_sum(lp[128 + ln] * lp[192 + ln]);
    const float lam_init = (l == 0) ? 0.2f : (0.8f - 0.6f * 0.74081822068171788f);
    if (ln == 0) ((float*)(p.ws + W_MISC))[l] = __expf(s1) - __expf(s2) + lam_init;
  }
  if (blockIdx.x == 0 && tid < 8) ((unsigned*)(p.ws + W_MISC))[16 + tid] = 0u;
  if (blockIdx.x == 0) for (int i = tid; i < 3456; i += NTH) ((unsigned*)(p.ws + W_BAR))[i] = 0u;
}

namespace pg8 {
#define PG8_LAS __attribute__((address_space(3)))
typedef unsigned short bf16_t;
typedef short bf16x8 __attribute__((ext_vector_type(8)));
typedef float f32x4 __attribute__((ext_vector_type(4)));
typedef unsigned u32x4 __attribute__((ext_vector_type(4)));
constexpr int BM = 256, BK = 64, HALF = 128, HTB = HALF * BK * 2  , STAGE_BYTES = 8 * HTB, NXCD = 8, WGM = 8;

__host__ __device__ __forceinline__ int lds_byte(int r, int c) { const int st = (r >> 4) * 2 + (c >> 5), rr = r & 15, cc = c & 31, ob = rr * 64 + cc * 2; return st * 1024 + (ob ^ (((ob >> 9) & 1) << 5)); }
__host__ __device__ __forceinline__ void stage_rc(int b, int& R, int& C) { const int st = b / 1024, sb = b % 1024, swz = sb ^ (((sb >> 9) & 1) << 5); R = (st >> 1) * 16 + swz / 64; C = (st & 1) * 32 + (swz % 64) / 2; }
__host__ __device__ __forceinline__ int perm32(int rho) { const int n = rho >> 4, i = rho & 15; return 8 * (i >> 2) + 4 * n + (i & 3); }

struct Unit { int pm, pn; };
struct Gemm { const bf16_t* A; const bf16_t* Bt; int M, N, K; };

struct StaticOrder {
    int nM, nN, nwg, G, c;
    __host__ __device__ void init(int M, int N, int G_, int c_) { nM = M / BM; nN = N / BM; nwg = nM * nN; G = G_; c = c_; }
    __host__ __device__ bool next(int i, Unit& u) const {
        const long L = (long)i * G + c; if (L >= nwg) return false;
        int wgid = (int)L; { const int q = nwg / NXCD, r = nwg % NXCD, xcd = wgid % NXCD, off = wgid / NXCD; wgid = (xcd < r ? xcd * (q + 1) : r * (q + 1) + (xcd - r) * q) + off; }
        const int nig = WGM * nN, gid = wgid / nig, fm = gid * WGM, gsz = (nM - fm) < WGM ? (nM - fm) : WGM;
        u.pm = fm + ((wgid % nig) % gsz); u.pn = (wgid % nig) / gsz; return true;
    }
    __device__ __forceinline__ void a_ready(const Unit&) const {}
    __device__ __forceinline__ void done(const Unit&) const {}
};
template <class Epi, class Sched, bool STAMP = false>
__device__ __forceinline__ void gemm_phase(PG8_LAS unsigned char* lds, const Gemm g, const Sched& S, const Epi& E, unsigned long long* stamps) {
    const int tid = otid(), wid = __builtin_amdgcn_readfirstlane(tid >> 6), lane = tid & 63, wr = wid >> 2, wc = wid & 3, fr = lane & 15, fq = lane >> 4;
    const int K = g.K, nt = K / BK;
    int ts_lo = 0, ts_hi = 0, nts = 0; const unsigned long long rt_entry = STAMP ? (unsigned long long)wall_clock64() : 0ull;
#define PG8_STAMP() do { if (STAMP && wid == 0 && nts < 64) { const unsigned long long _c = (unsigned long long)clock64(); \
        ts_lo = (lane == nts) ? (int)(unsigned)_c : ts_lo; ts_hi = (lane == nts) ? (int)(unsigned)(_c >> 32) : ts_hi; ++nts; } } while (0)
    PG8_STAMP();
    unsigned voffA[2], voffB[2];
#pragma unroll
    for (int i = 0; i < 2; ++i) { int R, C; stage_rc(tid * 16 + i * 8192, R, C); const int Rb = Epi::PERM ? ((R & ~31) + perm32(R & 31)) : R;
        voffA[i] = (unsigned)(R * K + C) * 2u; voffB[i] = (unsigned)(Rb * K + C) * 2u; }
    const size_t kstep = (size_t)(BK * 2);
    const size_t hstep = (size_t)HALF * K * 2;
    const size_t tstep = 2 * hstep;
    const unsigned ldsw = (unsigned)wid * 1024u;
    const int aoff = lds_byte(wr * 64 + fr, fq * 8), boff = lds_byte(wc * 32 + fr, fq * 8);
#define PG8_SA(b, h) (((b) * 2 + (h)) * HTB)
#define PG8_SB(b, h) ((4 + (b) * 2 + (h)) * HTB)
#define PG8_STAGE(bufoff, gbase, voff) do { _Pragma("unroll") for (int _i = 0; _i < 2; ++_i) \
        __builtin_amdgcn_global_load_lds((const unsigned*)((const char*)(gbase) + (voff)[_i]), (PG8_LAS unsigned*)(lds + (bufoff) + ldsw + _i * 8192), 16, 0, 0); } while (0)
#define PG8_LDA(dst, b, h) do { _Pragma("unroll") for (int m = 0; m < 4; ++m) _Pragma("unroll") for (int k = 0; k < 2; ++k) dst[m][k] = *(const PG8_LAS bf16x8*)(lds + PG8_SA(b, h) + aoff + m * 2048 + k * 1024); } while (0)
#define PG8_LDB(dst, b, h) do { _Pragma("unroll") for (int n = 0; n < 2; ++n) _Pragma("unroll") for (int k = 0; k < 2; ++k) dst[n][k] = *(const PG8_LAS bf16x8*)(lds + PG8_SB(b, h) + boff + n * 2048 + k * 1024); } while (0)
#define PG8_MMA(ai, bj, At, Bt) do { __builtin_amdgcn_s_setprio(1); _Pragma("unroll") for (int m = 0; m < 4; ++m) _Pragma("unroll") for (int n = 0; n < 2; ++n) _Pragma("unroll") for (int k = 0; k < 2; ++k) \
        acc[ai][bj][m][n] = __builtin_amdgcn_mfma_f32_16x16x32_bf16(Bt[n][k], At[m][k], acc[ai][bj][m][n], 0, 0, 0); __builtin_amdgcn_s_setprio(0); } while (0)
#define PG8_WAIT_V(n) asm volatile("s_waitcnt vmcnt(" #n ")" ::: "memory")
#define PG8_WAIT_L(n) asm volatile("s_waitcnt lgkmcnt(" #n ")" ::: "memory")
#define PG8_BAR __builtin_amdgcn_s_barrier()
#define PG8_SCHED __builtin_amdgcn_sched_barrier(0)
    Unit cur, nxt; int ui = 0;
    if (!S.next(0, cur)) return;
    f32x4 acc[2][2][4][2];
#pragma unroll
    for (int a = 0; a < 2; ++a)
#pragma unroll
        for (int b = 0; b < 2; ++b)
#pragma unroll
            for (int m = 0; m < 4; ++m)
#pragma unroll
                for (int n = 0; n < 2; ++n) acc[a][b][m][n] = (f32x4){0.f, 0.f, 0.f, 0.f};
    bf16x8 At[4][2], B0[2][2], B1[2][2];
    const char* cA = (const char*)g.A + (size_t)cur.pm * tstep; const char* cB = (const char*)g.Bt + (size_t)cur.pn * tstep;
    S.a_ready(cur);
    PG8_STAGE(PG8_SB(0, 0), cB, voffB); PG8_STAGE(PG8_SA(0, 0), cA, voffA); PG8_STAGE(PG8_SB(0, 1), cB + hstep, voffB); PG8_STAGE(PG8_SA(0, 1), cA + hstep, voffA);
    if (wr == 1) PG8_BAR;
    PG8_WAIT_V(4); PG8_BAR;
    PG8_STAGE(PG8_SB(1, 0), cB + kstep, voffB); PG8_STAGE(PG8_SA(1, 0), cA + kstep, voffA); PG8_STAGE(PG8_SB(1, 1), cB + hstep + kstep, voffB);
    PG8_WAIT_V(6); PG8_BAR;
    PG8_STAMP();
    for (;;) {
        const bool has_next = S.next(ui + 1, nxt);
        const char* nA = has_next ? (const char*)g.A + (size_t)nxt.pm * tstep : cA; const char* nB = has_next ? (const char*)g.Bt + (size_t)nxt.pn * tstep : cB;
        for (int t = 0; t < nt; t += 2) {
            const bool last = (t == nt - 2);
            const char* a1 = cA + (size_t)(t + 1) * kstep;
            const char* a2 = last ? nA : cA + (size_t)(t + 2) * kstep; const char* b2 = last ? nB : cB + (size_t)(t + 2) * kstep;
            const char* a3 = a2 + kstep; const char* b3 = b2 + kstep;
            if (last && has_next) S.a_ready(nxt);
            PG8_LDB(B0, 0, 0); PG8_SCHED; PG8_LDA(At, 0, 0); PG8_STAGE(PG8_SA(1, 1), a1 + hstep, voffA);
            PG8_WAIT_L(8); PG8_BAR; PG8_WAIT_L(0); PG8_MMA(0, 0, At, B0); PG8_BAR; PG8_SCHED;
            PG8_LDB(B1, 0, 1); PG8_STAGE(PG8_SB(0, 0), b2, voffB);
            PG8_BAR; PG8_WAIT_L(0); PG8_MMA(0, 1, At, B1); PG8_BAR;
            PG8_LDA(At, 0, 1); PG8_STAGE(PG8_SA(0, 0), a2, voffA);
            PG8_BAR; PG8_WAIT_L(0); PG8_MMA(1, 0, At, B0); PG8_BAR; PG8_SCHED;
            PG8_STAGE(PG8_SB(0, 1), b2 + hstep, voffB);
            PG8_WAIT_V(6); PG8_BAR; PG8_MMA(1, 1, At, B1); PG8_BAR;
            PG8_LDB(B0, 1, 0); PG8_SCHED; PG8_LDA(At, 1, 0); PG8_STAGE(PG8_SA(0, 1), a2 + hstep, voffA);
            PG8_WAIT_L(8); PG8_BAR; PG8_WAIT_L(0); PG8_MMA(0, 0, At, B0); PG8_BAR; PG8_SCHED;
            PG8_LDB(B1, 1, 1); PG8_STAGE(PG8_SB(1, 0), b3, voffB);
            PG8_BAR; PG8_WAIT_L(0); PG8_MMA(0, 1, At, B1); PG8_BAR;
            PG8_LDA(At, 1, 1); PG8_STAGE(PG8_SA(1, 0), a3, voffA);
            PG8_BAR; PG8_WAIT_L(0); PG8_MMA(1, 0, At, B0); PG8_BAR; PG8_SCHED;
            PG8_STAGE(PG8_SB(1, 1), b3 + hstep, voffB);
            PG8_WAIT_V(6); PG8_BAR; PG8_MMA(1, 1, At, B1); PG8_BAR;
        }
        PG8_STAMP();
        if constexpr (!Epi::AFTER_DRAIN) { E(acc, cur, wr, wc, fr, fq); S.done(cur); }
        PG8_STAMP();
        if (!has_next) break;
#pragma unroll
        for (int a = 0; a < 2; ++a)
#pragma unroll
            for (int b = 0; b < 2; ++b)
#pragma unroll
                for (int m = 0; m < 4; ++m)
#pragma unroll
                    for (int n = 0; n < 2; ++n) acc[a][b][m][n] = (f32x4){0.f, 0.f, 0.f, 0.f};
        cur = nxt; cA = nA; cB = nB; ++ui;
    }
    PG8_WAIT_V(0);
    if (wr == 0) PG8_BAR;
    PG8_BAR;
    if constexpr (Epi::AFTER_DRAIN) { E.fused(acc, cur, wr, wc, fr, fq, lds, wid, lane); S.done(cur); }
    PG8_STAMP();
    if (STAMP && wid == 0) { stamps[lane] = lane < nts ? (((unsigned long long)(unsigned)ts_hi << 32) | (unsigned)ts_lo) : 0ull;
        if (lane == 62) stamps[62] = rt_entry; if (lane == 63) stamps[63] = (unsigned long long)wall_clock64(); }
#undef PG8_STAMP
#undef PG8_SA
#undef PG8_SB
#undef PG8_STAGE
#undef PG8_LDA
#undef PG8_LDB
#undef PG8_MMA
#undef PG8_WAIT_V
#undef PG8_WAIT_L
#undef PG8_BAR
#undef PG8_SCHED
}
}

enum { EPI_IN = 0, EPI_OUT = 1, EPI_UP = 2, EPI_DOWN = 3 };
template <int MODE>
struct Epi {
  static constexpr bool PERM = true, AFTER_DRAIN = false;
  Params p; int l;
  DI void operator()(const f32x4 (&acc)[2][2][4][2], const pg8::Unit& u, int wr, int wc, int fr, int fq) const {
    const int colb = u.pn * 256 + wc * 32 + 8 * fq;
#pragma unroll
    for (int ai = 0; ai < 2; ++ai)
#pragma unroll
      for (int m = 0; m < 4; ++m) {
        const int row = u.pm * 256 + ai * 128 + wr * 64 + m * 16 + fr;
        if (row < M) {
#pragma unroll
          for (int bj = 0; bj < 2; ++bj) {
            const int col = colb + bj * 128;
            const f32x4 v0 = acc[ai][bj][m][0], v1 = acc[ai][bj][m][1];
            if (MODE == EPI_IN) {
              bf16_t* Z = (bf16_t*)(p.ws + W_Z);
              const int seg = u.pn >> 2;
              if (seg <= 1) {
                const int pos = row < MP ? (row & (SEQ - 1)) : PAST + ((row - MP) & 15);
                const int d0 = (col & 63) >> 1;
                const f32x4* rp = (const f32x4*)((const float2*)(p.ws + W_ROPE) + pos * 32 + d0);
                const f32x4 c01 = rp[0], c23 = rp[1];
                const float a0 = v0[0] * c01[0] - v0[1] * c01[1], b0 = v0[1] * c01[0] + v0[0] * c01[1];
                const float a1 = v0[2] * c01[2] - v0[3] * c01[3], b1 = v0[3] * c01[2] + v0[2] * c01[3];
                const float a2 = v1[0] * c23[0] - v1[1] * c23[1], b2 = v1[1] * c23[0] + v1[0] * c23[1];
                const float a3 = v1[2] * c23[2] - v1[3] * c23[3], b3 = v1[3] * c23[2] + v1[2] * c23[3];
                const float qs = seg == 0 ? 0.125f : 1.f;
                u32x4 o; o[0] = pk2(a0 * qs, b0 * qs); o[1] = pk2(a1 * qs, b1 * qs); o[2] = pk2(a2 * qs, b2 * qs); o[3] = pk2(a3 * qs, b3 * qs);
                *(u32x4*)(Z + (size_t)row * NIN + col) = o;
                if (seg == 1) {
                  float* ob = (row < MP ? p.out + O_KP + ((size_t)l * MP + row) * 1024 : p.out + O_KS + ((size_t)l * MS + row - MP) * 1024) + ((col - 1024) & ~63) + d0;
                  f32x4 o1, o2; o1[0] = a0; o1[1] = a1; o1[2] = a2; o1[3] = a3; o2[0] = b0; o2[1] = b1; o2[2] = b2; o2[3] = b3;
                  *(f32x4*)ob = o1; *(f32x4*)(ob + 32) = o2;
                }
              } else {
                u32x4 o; o[0] = pk2(v0[0], v0[1]); o[1] = pk2(v0[2], v0[3]); o[2] = pk2(v1[0], v1[1]); o[3] = pk2(v1[2], v1[3]);
                *(u32x4*)(Z + (size_t)row * NIN + col) = o;
                if (seg == 2) {
                  float* ob = (row < MP ? p.out + O_VP + ((size_t)l * MP + row) * 1024 : p.out + O_VS + ((size_t)l * MS + row - MP) * 1024) + (col - 2048);
                  *(f32x4*)ob = v0; *(f32x4*)(ob + 4) = v1;
                } else if (seg == 3 || seg == 4) {
                  float* ob = nullptr;
                  if (row < MP) { const int s = row & (SEQ - 1); if (s >= SEQ - 3) ob = p.out + O_MCP + ((size_t)(l * 4 + (row >> 13)) * 3 + (s - (SEQ - 3))) * 2048 + col - 3072; }
                  else { const int t = (row - MP) & 15, b = (row - MP) >> 4; if (t >= 13) ob = p.out + O_MCS + ((size_t)(l * 8 + b) * 3 + (t - 13)) * 2048 + col - 3072; }
                  if (ob) { *(f32x4*)ob = v0; *(f32x4*)(ob + 4) = v1; }
                }
              }
            } else if (MODE == EPI_OUT || MODE == EPI_DOWN) {
              float* R = (float*)(p.ws + W_R) + (size_t)row * D + col;
              const float* rs = MODE == EPI_OUT ? xrow_ptr(p, l, row) + col : R;
              const f32x4 r0 = *(const f32x4*)rs, r1 = *(const f32x4*)(rs + 4);
              *(f32x4*)R = r0 * ALPHA + v0; *(f32x4*)(R + 4) = r1 * ALPHA + v1;
            } else {
              bf16_t* U = (bf16_t*)(p.ws + W_Z);
              u32x4 o; o[0] = pk2(v0[0], v0[1]); o[1] = pk2(v0[2], v0[3]); o[2] = pk2(v1[0], v1[1]); o[3] = pk2(v1[2], v1[3]);
              *(u32x4*)(U + (size_t)row * NUP + col) = o;
              float* ob = nullptr;
              if (row < MP) { const int s = row & (SEQ - 1); if (s >= SEQ - 2) ob = p.out + O_FCP + ((size_t)(l * 4 + (row >> 13)) * 2 + (s - (SEQ - 2))) * NUP + col; }
              else { const int t = (row - MP) & 15, b = (row - MP) >> 4; if (t >= 14) ob = p.out + O_FCS + ((size_t)(l * 8 + b) * 2 + (t - 14)) * NUP + col; }
              if (ob) { *(f32x4*)ob = v0; *(f32x4*)(ob + 4) = v1; }
            }
          }
        }
      }
  }
};

template <int MODE>
DI void gemm_phase(const Params& p, int l, const bf16_t* A, int lda, const bf16_t* Bt, int K, int ntn, char* lds) {
  (void)lda;
  pg8::Gemm g; g.A = A; g.Bt = Bt; g.M = ((MODE == EPI_OUT || MODE == EPI_DOWN) ? NTM - 1 : NTM) * 256; g.N = ntn * 256; g.K = K;
  if (MODE == EPI_OUT || MODE == EPI_DOWN) sample_gemm<MODE>(p, l, A, Bt, K);
  pg8::StaticOrder S; S.init(g.M, g.N, (int)gridDim.x, (int)blockIdx.x);
  Epi<MODE> E; E.p = p; E.l = l;
  pg8::gemm_phase<Epi<MODE>, pg8::StaticOrder, false>((PG8_LAS unsigned char*)lds, g, S, E, nullptr);
  __syncthreads();
}

typedef float f32x4v __attribute__((ext_vector_type(4)));
template <int MODE>
DI void sample_gemm(const Params& p, int l, const bf16_t* A, const bf16_t* Bt, int K) {
  if (blockIdx.x >= 64) return;
  const int tid = otid(), lane = tid & 63, wave = uni(tid >> 6), fr = lane & 15, fq = lane >> 4;
  const bf16_t* ap = A + (size_t)(MP + wave * 16 + fr) * K + fq * 8;
  const bf16_t* bp = Bt + (size_t)(blockIdx.x * 16 + fr) * K + fq * 8;
  f32x4v acc0 = {0.f, 0.f, 0.f, 0.f}, acc1 = {0.f, 0.f, 0.f, 0.f};
  for (int k0 = 0; k0 < K; k0 += 256) {
    bf16x8 a[8], bb[8];
#pragma unroll
    for (int i = 0; i < 8; ++i) { a[i] = *(const bf16x8*)(ap + k0 + i * 32); bb[i] = *(const bf16x8*)(bp + k0 + i * 32); }
#pragma unroll
    for (int i = 0; i < 8; i += 2) {
      acc0 = __builtin_amdgcn_mfma_f32_16x16x32_bf16(a[i], bb[i], acc0, 0, 0, 0);
      acc1 = __builtin_amdgcn_mfma_f32_16x16x32_bf16(a[i + 1], bb[i + 1], acc1, 0, 0, 0);
    }
  }
  const int col = blockIdx.x * 16 + fr;
  float* R = (float*)(p.ws + W_R);
#pragma unroll
  for (int j = 0; j < 4; ++j) {
    const int row = MP + wave * 16 + fq * 4 + j;
    const float res = MODE == EPI_OUT ? xrow_ptr(p, l, row)[col] : R[(size_t)row * D + col];
    R[(size_t)row * D + col] = ALPHA * res + (acc0[j] + acc1[j]);
  }
}

DI void gif_phase(const Params& p, int l, char* lds) {
  const int tidq = otid(); const int lane = tidq & 63, gw = blockIdx.x * 8 + (tidq >> 6), ngw = gridDim.x * 8;
  const float* w = p.in[9] + (size_t)l * D * DIN + 7168;
  const float* bif = p.in[10] + l * 8;
  float* gif = (float*)(p.ws + W_GIF);
  float* w8 = (float*)lds;
  __syncthreads();
#pragma unroll
  for (int i = 0; i < 2; ++i) {
    const int k = tidq + 512 * i;
    *(f32x4*)(w8 + k * 8) = *(const f32x4*)(w + (size_t)k * DIN); *(f32x4*)(w8 + k * 8 + 4) = *(const f32x4*)(w + (size_t)k * DIN + 4);
  }
  __syncthreads();
  for (int rg = gw; rg < M / 4; rg += ngw) {
    float acc[4][8];
#pragma unroll
    for (int a = 0; a < 4; ++a)
#pragma unroll
      for (int j = 0; j < 8; ++j) acc[a][j] = 0.f;
    const float* x0 = xrow_ptr(p, l, rg * 4);
#pragma unroll 4
    for (int kk = 0; kk < 16; ++kk) {
      const int k = kk * 64 + lane;
      const f32x4 w0 = *(const f32x4*)(w8 + k * 8), w1 = *(const f32x4*)(w8 + k * 8 + 4);
#pragma unroll
      for (int a = 0; a < 4; ++a) {
        const float xv = x0[(size_t)a * D + k];
        acc[a][0] += xv * w0[0]; acc[a][1] += xv * w0[1]; acc[a][2] += xv * w0[2]; acc[a][3] += xv * w0[3];
        acc[a][4] += xv * w1[0]; acc[a][5] += xv * w1[1]; acc[a][6] += xv * w1[2]; acc[a][7] += xv * w1[3];
      }
    }
#pragma unroll
    for (int a = 0; a < 4; ++a)
#pragma unroll
      for (int j = 0; j < 8; ++j) {
        const float s = wave_sum(acc[a][j]);
        if (lane == 0) gif[(size_t)(rg * 4 + a) * 8 + j] = s + bif[j];
      }
  }
  __syncthreads();
}

DI void qkconv_phase(const Params& p, int l) {
  const bf16_t* Z = (const bf16_t*)(p.ws + W_Z);
  bf16_t* QA = (bf16_t*)(p.ws + W_AB); bf16_t* KA = (bf16_t*)(p.ws + W_KA);
  const float* cw = p.in[11] + (size_t)l * 4 * 2048; const float* cb = p.in[12] + (size_t)l * 2048;
  const size_t total = (size_t)(M / 4) * 256;
  for (size_t it = (size_t)blockIdx.x * NTH + otid(); it < total; it += (size_t)gridDim.x * NTH) {
    const int cc = (int)(it & 255), rg = (int)(it >> 8), col = cc * 8, row0 = rg * 4;
    int t0, hist_rows;
    const float* st = nullptr;
    if (row0 < MP) { t0 = row0 & (SEQ - 1); }
    else { t0 = (row0 - MP) & 15; st = p.in[4] + ((size_t)(l * 8 + ((row0 - MP) >> 4)) * 3) * 2048 + col; }
    (void)hist_rows;
    float w[4][8], bias[8];
#pragma unroll
    for (int j = 0; j < 4; ++j) { f32x4 a = *(const f32x4*)(cw + j * 2048 + col), b = *(const f32x4*)(cw + j * 2048 + col + 4);
      w[j][0] = a[0]; w[j][1] = a[1]; w[j][2] = a[2]; w[j][3] = a[3]; w[j][4] = b[0]; w[j][5] = b[1]; w[j][6] = b[2]; w[j][7] = b[3]; }
    { f32x4 a = *(const f32x4*)(cb + col), b = *(const f32x4*)(cb + col + 4);
      bias[0] = a[0]; bias[1] = a[1]; bias[2] = a[2]; bias[3] = a[3]; bias[4] = b[0]; bias[5] = b[1]; bias[6] = b[2]; bias[7] = b[3]; }
    float x[7][8];
#pragma unroll
    for (int j = 0; j < 7; ++j) {
      const int t = t0 - 3 + j;
      if (t >= 0) { u32x4 v = *(const u32x4*)(Z + (size_t)(row0 - 3 + j) * NIN + 3072 + col); unpack8(v, x[j]); }
      else if (st) { f32x4 a = *(const f32x4*)(st + (size_t)(3 + t) * 2048), b = *(const f32x4*)(st + (size_t)(3 + t) * 2048 + 4);
        x[j][0] = a[0]; x[j][1] = a[1]; x[j][2] = a[2]; x[j][3] = a[3]; x[j][4] = b[0]; x[j][5] = b[1]; x[j][6] = b[2]; x[j][7] = b[3]; }
      else {
#pragma unroll
        for (int e = 0; e < 8; ++e) x[j][e] = 0.f; }
    }
    const float sc = col >= 1024 ? 0.0625f : 1.f;
    bf16_t* dst = col >= 1024 ? KA + (col - 1024) : QA + col;
#pragma unroll
    for (int a = 0; a < 4; ++a) {
      float o[8];
#pragma unroll
      for (int e = 0; e < 8; ++e) {
        float u = bias[e] + w[0][e] * x[a][e] + w[1][e] * x[a + 1][e] + w[2][e] * x[a + 2][e] + w[3][e] * x[a + 3][e];
        o[e] = u * sigmoidf_(u) * sc;
      }
      u32x4 ov; ov[0] = pk2(o[0], o[1]); ov[1] = pk2(o[2], o[3]); ov[2] = pk2(o[4], o[5]); ov[3] = pk2(o[6], o[7]);
      *(u32x4*)(dst + (size_t)(row0 + a) * D) = ov;
    }
  }
}

constexpr int A_LD = 272;
constexpr int A_TILE = 64 * A_LD;
template <int KIND>
DI void attn_item(const Params& p, int l, int b, int ha, int qb, char* lds) {
  const int tid = otid(), lane = tid & 63, wave = uni(tid >> 6);
  const int map = wave >> 2, qt = wave & 3, r = lane & 31, h = lane >> 5;
  const bf16_t* Z = (const bf16_t*)(p.ws + W_Z);
  const int NT = KIND == 0 ? 2 * (qb + 1) : (NKS + 63) / 64;
  const int ntw = KIND == 0 ? 2 * qb + (qt >> 1) + 1 : NT;
  const bool active = KIND == 0 ? true : (qt == 0);
  int qrow;
  if (KIND == 0) qrow = b * SEQ + qb * 128 + qt * 32 + r; else qrow = MP + b * 16 + (r < 16 ? r : 15);
  bf16x8 qf[4];
#pragma unroll
  for (int ks = 0; ks < 4; ++ks) {
    if (KIND == 0) qf[ks] = *(const bf16x8*)(Z + (size_t)qrow * NIN + ha * 128 + map * 64 + ks * 16 + h * 8);
    else {
      const int dn = ks * 16 + h * 8, par = dn >> 5, dd = dn & 31;
      const bf16_t* src = Z + (size_t)qrow * NIN + ha * 128 + map * 64 + 2 * dd;
      const u32x4 lo = *(const u32x4*)src, hi = *(const u32x4*)(src + 8);
      unsigned e[8];
#pragma unroll
      for (int i = 0; i < 4; ++i) { e[i] = par ? (lo[i] >> 16) : (lo[i] & 0xffffu); e[4 + i] = par ? (hi[i] >> 16) : (hi[i] & 0xffffu); }
      u32x4 o; o[0] = e[0] | (e[1] << 16); o[1] = e[2] | (e[3] << 16); o[2] = e[4] | (e[5] << 16); o[3] = e[6] | (e[7] << 16);
      qf[ks] = __builtin_bit_cast(bf16x8, o);
    }
  }
  const int skey = tid >> 4, part = tid & 15;
  u32x4 rk0, rk1, rv0, rv1;
  auto gload = [&](int j) {
    if (KIND == 0) {
      const bf16_t* base = Z + (size_t)(b * SEQ + j * 64 + skey) * NIN + 1024 + ha * 128 + part * 8;
      rk0 = *(const u32x4*)base; rk1 = *(const u32x4*)(base + (size_t)32 * NIN);
      rv0 = *(const u32x4*)(base + 1024); rv1 = *(const u32x4*)(base + (size_t)32 * NIN + 1024);
    } else {
#pragma unroll
      for (int i = 0; i < 2; ++i) {
        int kk = j * 64 + skey + 32 * i; if (kk > NKS - 1) kk = NKS - 1;
        const float *ks_, *vs_;
        if (kk < PAST) { const size_t o = (((size_t)(l * 8 + b) * PAST + kk) * 8 + ha) * 128 + part * 8; ks_ = p.in[2] + o; vs_ = p.in[3] + o; }
        else { const size_t o = (((size_t)l * MS + b * 16 + (kk - PAST)) * 8 + ha) * 128 + part * 8; ks_ = p.out + O_KS + o; vs_ = p.out + O_VS + o; }
        const f32x4 a0 = *(const f32x4*)ks_, a1 = *(const f32x4*)(ks_ + 4), c0 = *(const f32x4*)vs_, c1 = *(const f32x4*)(vs_ + 4);
        u32x4 ko, vo;
        ko[0] = pk2(a0[0], a0[1]); ko[1] = pk2(a0[2], a0[3]); ko[2] = pk2(a1[0], a1[1]); ko[3] = pk2(a1[2], a1[3]);
        vo[0] = pk2(c0[0], c0[1]); vo[1] = pk2(c0[2], c0[3]); vo[2] = pk2(c1[0], c1[1]); vo[3] = pk2(c1[2], c1[3]);
        if (i == 0) { rk0 = ko; rv0 = vo; } else { rk1 = ko; rv1 = vo; }
      }
    }
  };
  f32x16 O[4];
#pragma unroll
  for (int v = 0; v < 4; ++v)
#pragma unroll
    for (int i = 0; i < 16; ++i) O[v][i] = 0.f;
  float m_run = -1e30f, l_run = 0.f;
  const int q4 = (lane & 15) >> 2, p4 = lane & 3, blk = (lane >> 4) & 1;
  const unsigned sofs = skey * A_LD + part * 16;
  auto qk = [&](int j, f32x16 (&st)[2]) {
    const char* kb = lds + (j & 1) * A_TILE;
#pragma unroll
    for (int kt = 0; kt < 2; ++kt) {
#pragma unroll
      for (int i = 0; i < 16; ++i) st[kt][i] = 0.f;
#pragma unroll
      for (int ks = 0; ks < 4; ++ks) {
        const bf16x8 kf = *(const bf16x8*)(kb + (kt * 32 + r) * A_LD + (map * 64 + ks * 16 + h * 8) * 2);
        st[kt] = MFMA32(kf, qf[ks], st[kt]);
      }
    }
    if (KIND == 1 && j == NT - 1) {
#pragma unroll
      for (int kt = 0; kt < 2; ++kt)
#pragma unroll
        for (int i = 0; i < 16; ++i) if (j * 64 + kt * 32 + crow(i, h) >= NKS) st[kt][i] = -1e30f;
    }
  };
  bf16x8 pk[4];
  auto smax = [&](int j, f32x16 (&sc)[2], f32x16 (&sn)[2]) {
    if (j + 1 < ntw) qk(j + 1, sn);
    float mx = sc[0][0];
#pragma unroll
    for (int kt = 0; kt < 2; ++kt)
#pragma unroll
      for (int i = 0; i < 16; ++i) mx = fmaxf(mx, sc[kt][i]);
    mx = fmaxf(mx, __shfl_xor(mx, 32));
    const float m_new = fmaxf(m_run, mx);
    const float alpha = __builtin_amdgcn_exp2f((m_run - m_new) * LOG2E);
    const float mb = m_new * LOG2E;
    float rs = 0.f;
#pragma unroll
    for (int kt = 0; kt < 2; ++kt)
#pragma unroll
      for (int i = 0; i < 16; ++i) { const float e = __builtin_amdgcn_exp2f(sc[kt][i] * LOG2E - mb); sc[kt][i] = e; rs += e; }
    rs += __shfl_xor(rs, 32);
    l_run = l_run * alpha + rs; m_run = m_new;
    if (__builtin_amdgcn_ballot_w64(alpha != 1.f) != 0ull) {
#pragma unroll
      for (int v = 0; v < 4; ++v)
#pragma unroll
        for (int i = 0; i < 16; ++i) O[v][i] *= alpha;
    }
    pk[0] = pack8(sc[0], 0); pk[1] = pack8(sc[0], 1); pk[2] = pack8(sc[1], 0); pk[3] = pack8(sc[1], 1);
  };
  auto pv = [&](int j) {
    const unsigned vaddr = lds_addr(lds + (2 + j % 3) * A_TILE) + (4 * h + q4) * A_LD + (16 * blk + 4 * p4) * 2;
#pragma unroll
    for (int vt = 0; vt < 4; ++vt) {
      bf16x8 vf[4];
      tr_frag4<16 * A_LD, 8 * A_LD>(vaddr + vt * 64, vf);
#pragma unroll
      for (int ks = 0; ks < 4; ++ks) O[vt] = MFMA32(vf[ks], pk[ks], O[vt]);
    }
  };
  gload(0);
  { char* kb = lds + sofs; *(u32x4*)kb = rk0; *(u32x4*)(kb + 32 * A_LD) = rk1; char* vb = lds + 2 * A_TILE + sofs; *(u32x4*)vb = rv0; *(u32x4*)(vb + 32 * A_LD) = rv1; }
  gload(1);
  { char* kb = lds + A_TILE + sofs; *(u32x4*)kb = rk0; *(u32x4*)(kb + 32 * A_LD) = rk1; }
  __syncthreads();
  f32x16 sA[2], sB[2];
  if (active && 0 < ntw) qk(0, sA);
  for (int j = 0; j < NT; j += 2) {
#pragma unroll
    for (int u = 0; u < 2; ++u) {
      const int jj = j + u;
      if (jj < NT) {
        if (jj + 1 < NT) { char* vb = lds + (2 + (jj + 1) % 3) * A_TILE + sofs; *(u32x4*)vb = rv0; *(u32x4*)(vb + 32 * A_LD) = rv1; }
        if (jj + 2 < NT) gload(jj + 2);
        if (active) {
          if (map == 1 && jj >= 1 && jj - 1 < ntw) pv(jj - 1);
          if (jj < ntw) { if (u == 0) smax(jj, sA, sB); else smax(jj, sB, sA); }
          if (map == 0 && jj < ntw) pv(jj);
        }
        if (jj + 2 < NT) { char* kb = lds + (jj & 1) * A_TILE + sofs; *(u32x4*)kb = rk0; *(u32x4*)(kb + 32 * A_LD) = rk1; }
        __syncthreads();
      }
    }
  }
  if (active && map == 1 && ntw == NT) pv(NT - 1);
  __syncthreads();
  float* ex = (float*)lds;
  const float inv_l = 1.f / l_run;
  if (map == 1) {
#pragma unroll
    for (int vt = 0; vt < 4; ++vt)
#pragma unroll
      for (int g = 0; g < 4; ++g) {
        f32x4 o; o[0] = O[vt][4 * g] * inv_l; o[1] = O[vt][4 * g + 1] * inv_l; o[2] = O[vt][4 * g + 2] * inv_l; o[3] = O[vt][4 * g + 3] * inv_l;
        *(f32x4*)(ex + (qt * 32 + r) * 132 + vt * 32 + 8 * g + 4 * h) = o;
      }
  }
  __syncthreads();
  if (map == 0) {
    const float lam = ((const float*)(p.ws + W_MISC))[l];
    const float lam_init = (l == 0) ? 0.2f : (0.8f - 0.6f * 0.74081822068171788f);
    float ssq = 0.f;
#pragma unroll
    for (int vt = 0; vt < 4; ++vt)
#pragma unroll
      for (int g = 0; g < 4; ++g) {
        const f32x4 o2 = *(const f32x4*)(ex + (qt * 32 + r) * 132 + vt * 32 + 8 * g + 4 * h);
#pragma unroll
        for (int e = 0; e < 4; ++e) { const float o = O[vt][4 * g + e] * inv_l - lam * o2[e]; O[vt][4 * g + e] = o; ssq += o * o; }
      }
    ssq += __shfl_xor(ssq, 32);
    const float rms = rsqrtf(ssq * (1.f / 128.f) + LN_EPS) * (1.f - lam_init);
    const float* sg = p.in[14] + l * 128;
    const bool valid = KIND == 0 ? true : (qt == 0 && r < 16);
    if (valid) {
      bf16_t* dst = (bf16_t*)(p.ws + W_Z) + (size_t)qrow * NIN + 3072 + ha * 128;
#pragma unroll
      for (int vt = 0; vt < 4; ++vt)
#pragma unroll
        for (int g = 0; g < 4; ++g) {
          const int v0 = vt * 32 + 8 * g + 4 * h;
          const f32x4 gg = *(const f32x4*)(sg + v0);
          u32x2 o; o[0] = pk2(O[vt][4 * g] * rms * gg[0], O[vt][4 * g + 1] * rms * gg[1]); o[1] = pk2(O[vt][4 * g + 2] * rms * gg[2], O[vt][4 * g + 3] * rms * gg[3]);
          *(u32x2*)(dst + v0) = o;
        }
    }
  }
  __syncthreads();
}

constexpr int L_LD = 528;
constexpr int L_VLD = 272;
constexpr int L_Q = 0, L_K = 64 * L_LD, L_V = 2 * 64 * L_LD, L_SW = L_V + 64 * L_VLD;
constexpr int L_SWLD = 144;
constexpr int L_SC = L_SW + 64 * L_SWLD;
constexpr int S_MX = 0, S_G = 64, S_EMT = 128, S_DS0 = 192, S_DS1 = 256, S_QN = 320  , S_NV = 576  , S_GEND = 832, S_PAR = 840;
constexpr int LDS_BYTES = 153376;
static_assert(L_SC + 2 * S_PAR * 4 <= 131072, "lds");
#define WG_BAR() do { __builtin_amdgcn_fence(__ATOMIC_RELEASE, "workgroup"); __builtin_amdgcn_s_barrier(); __builtin_amdgcn_fence(__ATOMIC_ACQUIRE, "workgroup"); } while (0)

template <int KIND>
DI void mlstm_item(const Params& p, int l, int b, int hm, int half, char* lds) {
  const int tid0 = otid(), wave = uni(tid0 >> 6);
  const bf16_t* QA = (const bf16_t*)(p.ws + W_AB); const bf16_t* KA = (const bf16_t*)(p.ws + W_KA);
  const bf16_t* Z = (const bf16_t*)(p.ws + W_Z); bf16_t* H = (bf16_t*)(p.ws + W_H);
  const float* GIF = (const float*)(p.ws + W_GIF);
  float* scb = (float*)(lds + L_SC);
  int nchunks = KIND == 0 ? SEQ / 64 : 1; asm volatile("" : "+s"(nchunks));
  const int Lv = KIND == 0 ? 64 : 16;
  const size_t bh = KIND == 0 ? (size_t)(l * 4 + b) * 4 + hm : (size_t)(l * 8 + b) * 4 + hm;
  if (wave < 4) {
    f32x16 C[8];
    { const int lane = tid0 & 63, r = lane & 31, h = lane >> 5; (void)r; (void)h;
      if (KIND == 0) {
#pragma unroll
        for (int d = 0; d < 8; ++d)
#pragma unroll
          for (int i = 0; i < 16; ++i) C[d][i] = 0.f;
      } else {
        const float* cp = p.in[5] + bh * 65536 + (size_t)(4 * h) * 256 + half * 128 + wave * 32 + r;
#pragma unroll
        for (int d = 0; d < 8; ++d)
#pragma unroll
          for (int g = 0; g < 4; ++g) {
            C[d][4 * g] = cp[0]; C[d][4 * g + 1] = cp[256]; C[d][4 * g + 2] = cp[512]; C[d][4 * g + 3] = cp[768];
            cp += 2048; asm volatile("" : "+v"(cp));
          }
      }
    }
    for (int c = 0; c < nchunks; ++c) {
      int tid = tid0; asm volatile("" : "+v"(tid));
      const int lane = tid & 63, r = lane & 31, h = lane >> 5;
      const int q4 = (lane & 15) >> 2, p4 = lane & 3, blk = (lane >> 4) & 1;
      const float* sc = scb + (c & 1) * S_PAR;
      const int rowbase = KIND == 0 ? b * SEQ + c * 64 : MP + b * 16;
      WG_BAR();
      f32x16 accB[2];
#pragma unroll
      for (int tt = 0; tt < 2; ++tt)
#pragma unroll
        for (int i = 0; i < 16; ++i) accB[tt][i] = 0.f;
#pragma unroll
      for (int d = 0; d < 8; ++d)
#pragma unroll
        for (int s = 0; s < 2; ++s) {
          __builtin_amdgcn_sched_barrier(0);
          const bf16x8 cf = pack8(C[d], s);
#pragma unroll
          for (int tt = 0; tt < 2; ++tt) {
            const char* qp = lds + L_Q + (tt * 32 + r) * L_LD + (d * 32 + 16 * s + 4 * h) * 2;
            const s16x4 lo = *(const s16x4*)qp, hi = *(const s16x4*)(qp + 16);
            const bf16x8 qfr = __builtin_shufflevector(lo, hi, 0, 1, 2, 3, 4, 5, 6, 7);
            accB[tt] = MFMA32(cf, qfr, accB[tt]);
          }
        }
      __builtin_amdgcn_sched_barrier(0);
      bf16x8 vf[4];
      tr_frag4<16 * L_VLD, 4 * L_VLD>(lds_addr(lds + L_V) + (8 * h + q4) * L_VLD + (wave * 32 + 16 * blk + 4 * p4) * 2, vf);
      const float g_end = sc[S_GEND];
#pragma unroll
      for (int d = 0; d < 8; ++d) {
#pragma unroll
        for (int i = 0; i < 16; ++i) C[d][i] *= g_end;
        bf16x8 kf[4];
        tr_frag4<16 * L_LD, 4 * L_LD>(lds_addr(lds + L_K) + (8 * h + q4) * L_LD + (d * 32 + 16 * blk + 4 * p4) * 2, kf);
#pragma unroll
        for (int ks = 0; ks < 4; ++ks) C[d] = MFMA32(kf[ks], vf[ks], C[d]);
      }
      WG_BAR();
#pragma unroll
      for (int tt = 0; tt < 2; ++tt) {
        const int t = tt * 32 + r;
        const float g = sc[S_G + t];
#pragma unroll
        for (int i = 0; i < 16; ++i) accB[tt][i] *= g;
        const char* sp = lds + L_SW + (tt * 32 + r) * L_SWLD + h * 16;
#pragma unroll
        for (int ks = 0; ks < 4; ++ks) accB[tt] = MFMA32(vf[ks], *(const bf16x8*)(sp + ks * 32), accB[tt]);
        const float qn = (sc[S_QN + t] + sc[S_QN + 64 + t]) + (sc[S_QN + 128 + t] + sc[S_QN + 192 + t]);
        float den = sc[S_DS0 + t] + sc[S_DS1 + t] + g * qn;
        den = fmaxf(fabsf(den), sc[S_EMT + t]);
        const float rden = 1.f / den;
        if (t < Lv) {
          bf16_t* dst = H + (size_t)(rowbase + t) * D + hm * 256 + half * 128 + wave * 32;
#pragma unroll
          for (int g4 = 0; g4 < 4; ++g4) {
            u32x2 o; o[0] = pk2(accB[tt][4 * g4] * rden, accB[tt][4 * g4 + 1] * rden); o[1] = pk2(accB[tt][4 * g4 + 2] * rden, accB[tt][4 * g4 + 3] * rden);
            *(u32x2*)(dst + 8 * g4 + 4 * h) = o;
          }
        }
      }
    }
    WG_BAR();
    {
      const int lane = tid0 & 63, r = lane & 31, h = lane >> 5;
      float* co = p.out + (KIND == 0 ? O_CP : O_CS) + bh * 65536 + (size_t)(4 * h) * 256 + half * 128 + wave * 32 + r;
#pragma unroll
      for (int d = 0; d < 8; ++d)
#pragma unroll
        for (int g = 0; g < 4; ++g) {
          co[0] = C[d][4 * g]; co[256] = C[d][4 * g + 1]; co[512] = C[d][4 * g + 2]; co[768] = C[d][4 * g + 3];
          co += 2048; asm volatile("" : "+v"(co));
        }
    }
  } else {
    const int hw = wave - 4;
    float nreg = 0.f, m_prev = 0.f;
    if (KIND == 1) { nreg = p.in[6][bh * 256 + (tid0 - 256)]; m_prev = p.in[7][bh]; }
    u32x4 pq[8], pk[8], pv[4];
    float gi = 0.f, gf = 0.f, g_end_cur = 0.f;
    auto issue_loads = [&](int c, int tid) {
      const int ht = tid - 256, lane = tid & 63;
      const int rowbase = KIND == 0 ? b * SEQ + c * 64 : MP + b * 16;
      const bool tvalid = lane < Lv;
      gi = tvalid ? GIF[(size_t)(rowbase + lane) * 8 + hm] : -1e30f;
      gf = tvalid ? GIF[(size_t)(rowbase + lane) * 8 + 4 + hm] : 0.f;
#pragma unroll
      for (int i = 0; i < 8; ++i) {
        const int cidx = ht + 256 * i, t = cidx >> 5, pc = cidx & 31;
        const int row = rowbase + (t < Lv ? t : Lv - 1);
        pq[i] = *(const u32x4*)(QA + (size_t)row * D + hm * 256 + pc * 8);
        pk[i] = *(const u32x4*)(KA + (size_t)row * D + hm * 256 + pc * 8);
      }
#pragma unroll
      for (int i = 0; i < 4; ++i) {
        const int cidx = ht + 256 * i, t = cidx >> 4, pc = cidx & 15;
        const int row = rowbase + (t < Lv ? t : Lv - 1);
        pv[i] = *(const u32x4*)(Z + (size_t)row * NIN + 5120 + hm * 256 + half * 128 + pc * 8);
      }
    };
    auto scalars = [&](int par, int lane) -> float {
      const bool tvalid = lane < Lv;
      const float lf = tvalid ? (fminf(gf, 0.f) - __logf(1.f + __expf(-fabsf(gf)))) : 0.f;
      float bc = lf;
#pragma unroll
      for (int o = 1; o < 64; o <<= 1) { const float v = __shfl_up(bc, o); if (lane >= o) bc += v; }
      const float a = gi - bc;
      float cm = a;
#pragma unroll
      for (int o = 1; o < 64; o <<= 1) { const float v = __shfl_up(cm, o); if (lane >= o) cm = fmaxf(cm, v); }
      const float mxv = fmaxf(m_prev, cm);
      const float m_t = bc + mxv;
      const float mx_end = __shfl(mxv, 63), bc_end = __shfl(bc, 63);
      const float wend = __expf(a - mx_end);
      g_end_cur = __expf(m_prev - mx_end);
      if (hw == 0) {
        float* sc = scb + par * S_PAR;
        sc[S_MX + lane] = __expf(mx_end - mxv);
        sc[S_G + lane] = __expf(m_prev - mxv);
        sc[S_EMT + lane] = __expf(-m_t);
        if (lane == 0) sc[S_GEND] = g_end_cur;
      }
      m_prev = bc_end + mx_end;
      return wend;
    };
    auto stage_lds = [&](float wend_l, int tid) {
      const int ht = tid - 256;
#pragma unroll
      for (int i = 0; i < 8; ++i) {
        const int cidx = ht + 256 * i, t = cidx >> 5, pc = cidx & 31;
        const float we = __shfl(wend_l, t);
        float f[8]; unpack8(pk[i], f);
        u32x4 o; o[0] = pk2(f[0] * we, f[1] * we); o[1] = pk2(f[2] * we, f[3] * we); o[2] = pk2(f[4] * we, f[5] * we); o[3] = pk2(f[6] * we, f[7] * we);
        *(u32x4*)(lds + L_Q + t * L_LD + pc * 16) = pq[i];
        *(u32x4*)(lds + L_K + t * L_LD + pc * 16) = o;
      }
#pragma unroll
      for (int i = 0; i < 4; ++i) {
        const int cidx = ht + 256 * i, t = cidx >> 4, pc = cidx & 15;
        *(u32x4*)(lds + L_V + t * L_VLD + pc * 16) = pv[i];
      }
    };
    {
      int tid = tid0; asm volatile("" : "+v"(tid));
      issue_loads(0, tid);
      scb[S_NV + (tid - 256)] = nreg;
      const float wend = scalars(0, tid & 63);
      stage_lds(wend, tid);
    }
    for (int c = 0; c < nchunks; ++c) {
      int tid = tid0; asm volatile("" : "+v"(tid));
      const int ht = tid - 256, lane = tid & 63, r = lane & 31, h = lane >> 5;
      float* sc = scb + (c & 1) * S_PAR;
      float* scn = scb + ((c + 1) & 1) * S_PAR;
      const float g_end_c = g_end_cur;
      WG_BAR();
      const bool more = c + 1 < nchunks;
      if (more) issue_loads(c + 1, tid);
      {
        const int t = ht & 63, part = ht >> 6;
        const char* qp = lds + L_Q + t * L_LD + part * 128;
        float s = 0.f;
#pragma unroll
        for (int e = 0; e < 8; ++e) {
          const u32x4 qq = *(const u32x4*)(qp + e * 16); float f[8]; unpack8(qq, f);
#pragma unroll
          for (int z = 0; z < 8; ++z) s += f[z] * sc[S_NV + part * 64 + e * 8 + z];
        }
        sc[S_QN + part * 64 + t] = s;
      }
      if (hw < 3) {
        const int stl = hw == 2 ? 1 : 0, tt = hw == 0 ? 0 : 1;
        f32x16 S, S2;
#pragma unroll
        for (int i = 0; i < 16; ++i) { S[i] = 0.f; S2[i] = 0.f; }
        const char* ka = lds + L_K + (stl * 32 + r) * L_LD + h * 16;
        const char* qa = lds + L_Q + (tt * 32 + r) * L_LD + h * 16;
#pragma unroll 4
        for (int ks = 0; ks < 16; ks += 2) {
          S = MFMA32(*(const bf16x8*)(ka + ks * 32), *(const bf16x8*)(qa + ks * 32), S);
          S2 = MFMA32(*(const bf16x8*)(ka + ks * 32 + 32), *(const bf16x8*)(qa + ks * 32 + 32), S2);
        }
        const int t = tt * 32 + r;
        const float cw = sc[S_MX + t];
        float rs = 0.f;
#pragma unroll
        for (int g = 0; g < 4; ++g) {
          float wv[4];
#pragma unroll
          for (int e = 0; e < 4; ++e) {
            const int s = stl * 32 + 8 * g + 4 * h + e;
            wv[e] = s <= t ? (S[4 * g + e] + S2[4 * g + e]) * cw : 0.f; rs += wv[e];
          }
          u32x2 o; o[0] = pk2(wv[0], wv[1]); o[1] = pk2(wv[2], wv[3]);
          *(u32x2*)(lds + L_SW + t * L_SWLD + (stl * 32 + 8 * g + 4 * h) * 2) = o;
        }
        rs += __shfl_xor(rs, 32);
        if (h == 0) {
          if (hw == 0) { sc[S_DS0 + t] = rs; sc[S_DS1 + t] = 0.f; }
          else if (hw == 1) sc[S_DS0 + t] = rs;
          else sc[S_DS1 + t] = rs;
        }
      } else {
        const int t = lane >> 1, hs = lane & 1;
        u32x4 z; z[0] = 0; z[1] = 0; z[2] = 0; z[3] = 0;
        *(u32x4*)(lds + L_SW + t * L_SWLD + 64 + hs * 32) = z; *(u32x4*)(lds + L_SW + t * L_SWLD + 64 + hs * 32 + 16) = z;
      }
      {
        float s0 = 0.f, s1 = 0.f, s2 = 0.f, s3 = 0.f;
        const char* kp = lds + L_K + ht * 2;
#pragma unroll
        for (int t = 0; t < 64; t += 4) {
          s0 += bflo((unsigned)*(const bf16_t*)(kp + t * L_LD)); s1 += bflo((unsigned)*(const bf16_t*)(kp + (t + 1) * L_LD));
          s2 += bflo((unsigned)*(const bf16_t*)(kp + (t + 2) * L_LD)); s3 += bflo((unsigned)*(const bf16_t*)(kp + (t + 3) * L_LD));
        }
        nreg = g_end_c * nreg + ((s0 + s1) + (s2 + s3));
        scn[S_NV + ht] = nreg;
      }
      float wend = 0.f;
      if (more) wend = scalars((c + 1) & 1, lane);
      WG_BAR();
      if (more) stage_lds(wend, tid);
    }
    WG_BAR();
    if (half == 0) {
      p.out[(KIND == 0 ? O_NP : O_NS) + bh * 256 + (tid0 - 256)] = nreg;
      if (tid0 == 256) p.out[(KIND == 0 ? O_MPP : O_MSS) + bh] = m_prev;
    }
  }
}

DI void mixer_phase(const Params& p, int l, char* lds, int cidx, bool ml_only) {
  unsigned* ctr = (unsigned*)(p.ws + W_MISC) + 16 + cidx;
  int* s_item = (int*)(lds + LDS_BYTES - 16);
  const int total = 32 + 64 + 64 + 2048;
  for (;;) {
    __syncthreads();
    if (threadIdx.x == 0) *s_item = (int)atomicAdd(ctr, 1u);
    __syncthreads();
    const int it = *s_item;
    __syncthreads();
    if (it >= total) break;
    if (ml_only && it >= 96) break;
    if (it < 32) { mlstm_item<0>(p, l, it >> 3, (it >> 1) & 3, it & 1, lds); continue; }
    if (it < 96) { const int x = it - 32; mlstm_item<1>(p, l, x >> 3, (x >> 1) & 3, x & 1, lds); continue; }
    if (it < 160) { attn_item<1>(p, l, (it - 96) >> 3, (it - 96) & 7, 0, lds); continue; }
    { const int x = it - 160; attn_item<0>(p, l, (x & 31) >> 3, x & 7, 63 - (x >> 5), lds); }
  }
}

DI void merge_phase(const Params& p, int l) {
  const bf16_t* Z = (const bf16_t*)(p.ws + W_Z); const bf16_t* H = (const bf16_t*)(p.ws + W_H); bf16_t* Y = (bf16_t*)(p.ws + W_AB);
  const int tidq = otid(); const int lane = tidq & 63, gw = blockIdx.x * 8 + (tidq >> 6), ngw = gridDim.x * 8;
  const float* mhg = p.in[15] + (size_t)l * D;
  for (int row = gw; row < M; row += ngw) {
    const int col = lane * 16;
    const bf16_t* z = Z + (size_t)row * NIN + col;
    float hv[16];
    unpack8(*(const u32x4*)(H + (size_t)row * D + col), hv); unpack8(*(const u32x4*)(H + (size_t)row * D + col + 8), hv + 8);
    float s = 0.f;
#pragma unroll
    for (int e = 0; e < 16; ++e) s += hv[e];
#pragma unroll
    for (int o = 1; o < 16; o <<= 1) s += __shfl_xor(s, o);
    const float mean = s * (1.f / 256.f);
    float s2 = 0.f;
#pragma unroll
    for (int e = 0; e < 16; ++e) { hv[e] -= mean; s2 += hv[e] * hv[e]; }
#pragma unroll
    for (int o = 1; o < 16; o <<= 1) s2 += __shfl_xor(s2, o);
    const float rstd = rsqrtf(s2 * (1.f / 256.f) + LN_EPS);
#pragma unroll
    for (int hh = 0; hh < 2; ++hh) {
      float oa[8], om[8], ga[8], gb[8];
      unpack8(*(const u32x4*)(z + 3072 + hh * 8), oa); unpack8(*(const u32x4*)(z + 6144 + hh * 8), om);
      unpack8(*(const u32x4*)(z + 7168 + hh * 8), ga); unpack8(*(const u32x4*)(z + 8192 + hh * 8), gb);
      const f32x4 g0 = *(const f32x4*)(mhg + col + hh * 8), g1 = *(const f32x4*)(mhg + col + hh * 8 + 4);
      float y[8];
#pragma unroll
      for (int e = 0; e < 8; ++e) {
        const float hn = hv[hh * 8 + e] * rstd * (e < 4 ? g0[e] : g1[e - 4]);
        y[e] = sigmoidf_(ga[e]) * oa[e] + sigmoidf_(gb[e]) * (hn * sigmoidf_(om[e]));
      }
      u32x4 o; o[0] = pk2(y[0], y[1]); o[1] = pk2(y[2], y[3]); o[2] = pk2(y[4], y[5]); o[3] = pk2(y[6], y[7]);
      *(u32x4*)(Y + (size_t)row * D + col + hh * 8) = o;
    }
  }
}

DI void ln_phase(const Params& p, const float* g, const float* bta, bool final_out) {
  const int tidq = otid(); const int lane = tidq & 63, gw = blockIdx.x * 8 + (tidq >> 6), ngw = gridDim.x * 8;
  float* R = (float*)(p.ws + W_R); bf16_t* AB = (bf16_t*)(p.ws + W_AB);
  for (int row = gw; row < M; row += ngw) {
    float* xr = R + (size_t)row * D;
    f32x4 v[4]; float s = 0.f;
#pragma unroll
    for (int j = 0; j < 4; ++j) { v[j] = *(const f32x4*)(xr + j * 256 + lane * 4); s += (v[j][0] + v[j][1]) + (v[j][2] + v[j][3]); }
    const float mean = wave_sum(s) * (1.f / D);
    float s2 = 0.f;
#pragma unroll
    for (int j = 0; j < 4; ++j) { v[j] = v[j] - mean; s2 += (v[j][0] * v[j][0] + v[j][1] * v[j][1]) + (v[j][2] * v[j][2] + v[j][3] * v[j][3]); }
    const float rstd = rsqrtf(wave_sum(s2) * (1.f / D) + LN_EPS);
    float* dst = final_out ? (row < MP ? p.out + O_YP + (size_t)row * D : p.out + O_YS + (size_t)(row - MP) * D) : xr;
#pragma unroll
    for (int j = 0; j < 4; ++j) {
      const int c = j * 256 + lane * 4;
      const f32x4 gg = *(const f32x4*)(g + c), bb = *(const f32x4*)(bta + c);
      f32x4 o = v[j] * rstd * gg + bb;
      *(f32x4*)(dst + c) = o;
      if (!final_out) { u32x2 ob; ob[0] = pk2(o[0], o[1]); ob[1] = pk2(o[2], o[3]); *(u32x2*)(AB + (size_t)row * D + c) = ob; }
    }
  }
}

DI float gelu_f(float v) {
  const float av = fabsf(v), d = av * 0.2316418882f + 1.0f;
  const float t = __builtin_amdgcn_rcpf(d);
  float q = t * 0.5307027145f + (-0.7265760135f); q = q * t + 0.7107068705f; q = q * t + (-0.142248368f); q = q * t + 0.127414796f; q = q * t;
  const float e = __builtin_amdgcn_exp2f((v * v) * (-0.72134752044f));
  const float m = v * (q * e), r = v - m;
  return v < 0.f ? m : r;
}
DI void ffnconv_phase(const Params& p, int l) {
  const bf16_t* U = (const bf16_t*)(p.ws + W_Z); bf16_t* HF = (bf16_t*)(p.ws + W_Z + (size_t)M * NUP * 2);
  const float* cw = p.in[20] + (size_t)l * 3 * NUP; const float* cb = p.in[21] + (size_t)l * NUP;
  const size_t total = (size_t)M * 352;
  for (size_t it = (size_t)blockIdx.x * NTH + otid(); it < total; it += (size_t)gridDim.x * NTH) {
    const int row = (int)(it / 352), col = (int)(it % 352) * 8;
    int t; const float* st = nullptr;
    if (row < MP) t = row & (SEQ - 1); else { t = (row - MP) & 15; st = p.in[8] + ((size_t)(l * 8 + ((row - MP) >> 4)) * 2) * NUP; }
    float u[2][8];
#pragma unroll
    for (int hf = 0; hf < 2; ++hf) {
      const int cc = col + hf * DFF;
      f32x4 a = *(const f32x4*)(cb + cc), b = *(const f32x4*)(cb + cc + 4);
      u[hf][0] = a[0]; u[hf][1] = a[1]; u[hf][2] = a[2]; u[hf][3] = a[3]; u[hf][4] = b[0]; u[hf][5] = b[1]; u[hf][6] = b[2]; u[hf][7] = b[3];
#pragma unroll
      for (int j = 0; j < 3; ++j) {
        const int tj = t - 2 + j;
        float x[8];
        if (tj >= 0) unpack8(*(const u32x4*)(U + (size_t)(row - 2 + j) * NUP + cc), x);
        else if (st) { const float* s = st + (size_t)(2 + tj) * NUP + cc; f32x4 a2 = *(const f32x4*)s, b2 = *(const f32x4*)(s + 4);
          x[0] = a2[0]; x[1] = a2[1]; x[2] = a2[2]; x[3] = a2[3]; x[4] = b2[0]; x[5] = b2[1]; x[6] = b2[2]; x[7] = b2[3]; }
        else {
#pragma unroll
          for (int e = 0; e < 8; ++e) x[e] = 0.f; }
        const f32x4 w0 = *(const f32x4*)(cw + j * NUP + cc), w1 = *(const f32x4*)(cw + j * NUP + cc + 4);
        u[hf][0] += w0[0] * x[0]; u[hf][1] += w0[1] * x[1]; u[hf][2] += w0[2] * x[2]; u[hf][3] += w0[3] * x[3];
        u[hf][4] += w1[0] * x[4]; u[hf][5] += w1[1] * x[5]; u[hf][6] += w1[2] * x[6]; u[hf][7] += w1[3] * x[7];
      }
    }
    float o[8];
#pragma unroll
    for (int e = 0; e < 8; ++e) { const float a = u[0][e]; o[e] = gelu_f(a) * u[1][e]; }
    u32x4 ov; ov[0] = pk2(o[0], o[1]); ov[1] = pk2(o[2], o[3]); ov[2] = pk2(o[4], o[5]); ov[3] = pk2(o[6], o[7]);
    *(u32x4*)(HF + (size_t)row * DFF + col) = ov;
  }
}

#define XB_TMO      128
#define XB_XCNT(j)  (256  + 64 * (j))
#define XB_XSUB(j)  (1280 + 64 * (j))
#define XB_XGEN(j)  (2304 + 64 * (j))
#define XB_TOP      3328
#define XB_TOPGEN   3392
#define XCD_BAR_WORDS 3456
#define XB_SPIN_CAP (1u << 18)
#define XLAS __attribute__((address_space(3)))
DI unsigned xb_ld(unsigned* p)              { return __hip_atomic_load(p, __ATOMIC_RELAXED, __HIP_MEMORY_SCOPE_AGENT); }
DI unsigned xb_add(unsigned* p, unsigned v) { return __hip_atomic_fetch_add(p, v, __ATOMIC_RELAXED, __HIP_MEMORY_SCOPE_AGENT); }
DI unsigned xb_xcc_id() { return (unsigned)__builtin_amdgcn_s_getreg((3 << 11) | 20) & 0xFu; }
#define XB_SPIN(cond, bar) do { unsigned _sp = 0; while (cond) { __builtin_amdgcn_s_sleep(1); \
    if ((++_sp & 255u) == 0u) { if (xb_ld(&(bar)[XB_TMO])) break; if (_sp > XB_SPIN_CAP) { atomicAdd(&(bar)[XB_TMO], 1u); break; } } } } while (0)
struct XcdBarrier { unsigned* bar; unsigned x; volatile XLAS unsigned* st; };
DI XcdBarrier xcd_barrier_post(unsigned* bar, volatile XLAS unsigned* st) {
  XcdBarrier b; b.bar = bar; b.x = xb_xcc_id(); b.st = st;
  if (threadIdx.x == 0) (void)xb_add(&bar[XB_XCNT(b.x)], 1u);
  return b;
}
DI void xcd_barrier_complete(unsigned* bar, unsigned x, unsigned& nloc, unsigned& nx) {
  const unsigned G = gridDim.x * gridDim.y * gridDim.z;
  unsigned sum, cnt, mine, sp = 0u;
  for (;;) {
    sum = 0u; cnt = 0u; mine = 0u;
#pragma unroll
    for (unsigned j = 0; j < 16; ++j) { const unsigned c = xb_ld(&bar[XB_XCNT(j)]); sum += c; cnt += (c > 0u) ? 1u : 0u; mine = (j == x) ? c : mine; }
    if (sum == G) break;
    __builtin_amdgcn_s_sleep(1);
    if ((++sp & 255u) == 0u) { if (xb_ld(&bar[XB_TMO])) break; if (sp > XB_SPIN_CAP) { atomicAdd(&bar[XB_TMO], 1u); break; } }
  }
  nloc = mine > 0u ? mine : 1u; nx = cnt > 0u ? cnt : 1u;
}
DI void xcd_barrier(const XcdBarrier& b) {
  asm volatile("s_waitcnt vmcnt(0)" ::: "memory");
  __syncthreads();
  if (threadIdx.x == 0) {
    unsigned* bar = b.bar;
    __builtin_amdgcn_s_waitcnt(0);
    unsigned nloc = b.st[0], nx = b.st[1];
    if (nloc == 0u) { xcd_barrier_complete(bar, b.x, nloc, nx); b.st[0] = nloc; b.st[1] = nx; }
    const unsigned old = xb_add(&bar[XB_XSUB(b.x)], 1u);
    const unsigned gen = old / nloc;
    if (old + 1u == (gen + 1u) * nloc) {
      __builtin_amdgcn_fence(__ATOMIC_RELEASE, "agent");
      asm volatile("s_waitcnt vmcnt(0)" ::: "memory");
      const unsigned og = xb_add(&bar[XB_TOP], 1u);
      const unsigned tg = og / nx;
      if (og + 1u == (tg + 1u) * nx) xb_add(&bar[XB_TOPGEN], 1u);
      else XB_SPIN(xb_ld(&bar[XB_TOPGEN]) == tg, bar);
      __builtin_amdgcn_fence(__ATOMIC_ACQUIRE, "agent");
      xb_add(&bar[XB_XGEN(b.x)], 1u);
      asm volatile("s_waitcnt vmcnt(0)" ::: "memory");
    } else {
      XB_SPIN(xb_ld(&bar[XB_XGEN(b.x)]) == gen, bar);
      __builtin_amdgcn_fence(__ATOMIC_ACQUIRE, "agent");
      asm volatile("s_waitcnt vmcnt(0)" ::: "memory");
    }
  }
  __syncthreads();
}

constexpr int NPH = 21;
DI void run_phase(const Params& p, int ph, char* lds) {
#ifndef ONLY
  if (ph == 0) { phase0(p, lds); return; }
#else
  if (ph == 0) return;
#endif
  const int l = (ph - 1) / 10, s = (ph - 1) % 10;
#ifdef ONLY
  if (s != ONLY) return;
#endif
  switch (s) {
    case 0: gemm_phase<EPI_IN>(p, l, (const bf16_t*)(p.ws + W_AB), D, (const bf16_t*)(p.ws + W_WIN) + (size_t)l * NIN * D, D, NIN / 256, lds); break;
    case 1: qkconv_phase(p, l); gif_phase(p, l, lds); break;
    case 2: mixer_phase(p, l, lds, l, false); break;
    case 3: merge_phase(p, l); break;
    case 4: gemm_phase<EPI_OUT>(p, l, (const bf16_t*)(p.ws + W_AB), D, (const bf16_t*)(p.ws + W_WOUT) + (size_t)l * D * D, D, D / 256, lds); break;
    case 5: ln_phase(p, p.in[17] + l * D, p.in[18] + l * D, false); break;
    case 6: gemm_phase<EPI_UP>(p, l, (const bf16_t*)(p.ws + W_AB), D, (const bf16_t*)(p.ws + W_WUP) + (size_t)l * NUP * D, D, NUP / 256, lds); break;
    case 7: ffnconv_phase(p, l); break;
    case 8: gemm_phase<EPI_DOWN>(p, l, (const bf16_t*)(p.ws + W_Z + (size_t)M * NUP * 2), DFF, (const bf16_t*)(p.ws + W_WDN) + (size_t)l * D * DFF, DFF, D / 256, lds); break;
    case 9: ln_phase(p, p.in[23] + l * D, p.in[24] + l * D, l == 1); break;
  }
}

__global__ void __launch_bounds__(NTH) mega(Params p, int ph_lo, int ph_hi) {
  extern __shared__ __attribute__((aligned(16))) char lds[];
#if MULTI_LAUNCH
  for (int ph = ph_lo; ph < ph_hi; ++ph) run_phase(p, ph, lds);
#else
  cg::grid_group grid = cg::this_grid();
  phase0(p, lds);
  grid.sync();
  volatile XLAS unsigned* xst = (volatile XLAS unsigned*)((XLAS char*)lds + (LDS_BYTES - 32));
  if (threadIdx.x == 0) { xst[0] = 0u; xst[1] = 0u; }
  __syncthreads();
  const XcdBarrier xb = xcd_barrier_post((unsigned*)(p.ws + W_BAR), xst);
#define GSYNC() xcd_barrier(xb)
  for (int l = 0; l < 2; ++l) {
    gemm_phase<EPI_IN>(p, l, (const bf16_t*)(p.ws + W_AB), D, (const bf16_t*)(p.ws + W_WIN) + (size_t)l * NIN * D, D, NIN / 256, lds);
    GSYNC();
#ifdef PROBE_GIN2
    gemm_phase<EPI_IN>(p, l, (const bf16_t*)(p.ws + W_AB), D, (const bf16_t*)(p.ws + W_WIN) + (size_t)l * NIN * D, D, NIN / 256, lds);
    GSYNC();
#endif
    qkconv_phase(p, l); gif_phase(p, l, lds);
    GSYNC();
#ifdef PROBE_EW2
    qkconv_phase(p, l); gif_phase(p, l, lds);
    GSYNC();
#endif
    mixer_phase(p, l, lds, l, false);
    GSYNC();
#ifdef PROBE_ML2
    mixer_phase(p, l, lds, l + 2, true);
    GSYNC();
#endif
#ifdef PROBE_MIX2
    mixer_phase(p, l, lds, l + 2, false);
    GSYNC();
#endif
    merge_phase(p, l);
    GSYNC();
#ifdef PROBE_SYNC
    for (int q = 0; q < 20; ++q) GSYNC();
#endif
#ifdef PROBE_EW2
    merge_phase(p, l);
    GSYNC();
#endif
    gemm_phase<EPI_OUT>(p, l, (const bf16_t*)(p.ws + W_AB), D, (const bf16_t*)(p.ws + W_WOUT) + (size_t)l * D * D, D, D / 256, lds);
    GSYNC();
    ln_phase(p, p.in[17] + l * D, p.in[18] + l * D, false);
    GSYNC();
    gemm_phase<EPI_UP>(p, l, (const bf16_t*)(p.ws + W_AB), D, (const bf16_t*)(p.ws + W_WUP) + (size_t)l * NUP * D, D, NUP / 256, lds);
    GSYNC();
    ffnconv_phase(p, l);
    GSYNC();
#ifdef PROBE_EW2
    ffnconv_phase(p, l);
    GSYNC();
#endif
    gemm_phase<EPI_DOWN>(p, l, (const bf16_t*)(p.ws + W_Z + (size_t)M * NUP * 2), DFF, (const bf16_t*)(p.ws + W_WDN) + (size_t)l * D * DFF, DFF, D / 256, lds);
    GSYNC();
    ln_phase(p, p.in[23] + l * D, p.in[24] + l * D, l == 1);
    if (l == 0) GSYNC();
  }
#endif
}

extern "C" void kernel_launch(void* const* d_in, const int* in_sizes, int n_in, void* d_out, int out_size, void* d_ws, size_t ws_size, hipStream_t stream) {
  static int grid = 0;
  if (grid == 0) {
    if (n_in != 25 || (size_t)out_size != O_END || ws_size < W_END) { fprintf(stderr, "kernel_launch: unexpected sizes n_in %d out %d (want %zu) ws %zu (want %zu)\n", n_in, out_size, (size_t)O_END, ws_size, (size_t)W_END); grid = -1; return; }
    int dev = 0, cus = 0, per_cu = 0;
    hipGetDevice(&dev);
    hipDeviceGetAttribute(&cus, hipDeviceAttributeMultiprocessorCount, dev);
    if (hipFuncSetAttribute((const void*)mega, hipFuncAttributeMaxDynamicSharedMemorySize, LDS_BYTES) != hipSuccess) { fprintf(stderr, "hipFuncSetAttribute failed\n"); grid = -1; return; }
    hipOccupancyMaxActiveBlocksPerMultiprocessor(&per_cu, (const void*)mega, NTH, LDS_BYTES);
    if (per_cu < 1) per_cu = 1;
    grid = cus * 1;
    (void)hipGetLastError();
  }
  if (grid < 0) return;
  Params p{};
  for (int i = 0; i < 25; ++i) p.in[i] = (const float*)d_in[i];
  p.out = (float*)d_out; p.ws = (unsigned char*)d_ws;
#if MULTI_LAUNCH
  for (int ph = 0; ph < NPH; ++ph) hipLaunchKernelGGL(mega, dim3(grid), dim3(NTH), LDS_BYTES, stream, p, ph, ph + 1);
#else
  int lo = 0, hi = NPH;
  void* args[] = {&p, &lo, &hi};
  hipError_t e = hipLaunchCooperativeKernel((const void*)mega, dim3(grid), dim3(NTH), args, LDS_BYTES, stream);
  if (e != hipSuccess) fprintf(stderr, "cooperative launch failed: %s (grid %d)\n", hipGetErrorString(e), grid);
#endif
}
```

```cpp
#include <hip/hip_runtime.h>
#include <hip/hip_cooperative_groups.h>
#include <cstdio>
namespace cg = cooperative_groups;

#ifndef MULTI_LAUNCH
#define MULTI_LAUNCH 0
#endif

typedef unsigned short bf16_t;
typedef short bf16x8 __attribute__((ext_vector_type(8)));
typedef short s16x4 __attribute__((ext_vector_type(4)));
typedef float f32x16 __attribute__((ext_vector_type(16)));
typedef float f32x4 __attribute__((ext_vector_type(4)));
typedef unsigned u32x4 __attribute__((ext_vector_type(4)));
typedef unsigned u32x2 __attribute__((ext_vector_type(2)));
#define DI __device__ __forceinline__
#define MFMA32(a, b, c) __builtin_amdgcn_mfma_f32_32x32x16_bf16((a), (b), (c), 0, 0, 0)

constexpr int NTH = 512;
constexpr int D = 1024, SEQ = 8192, NB = 4, MP = NB * SEQ, MS = 128, M = MP + MS, NTM = 129;
constexpr int DIN = 9224, NIN = 9216, DFF = 2816, NUP = 5632;
constexpr int PAST = 4096, NKS = PAST + 16;
constexpr float ALPHA = 1.4142135623730951f;
constexpr float LN_EPS = 1e-5f;
constexpr float LOG2E = 1.4426950408889634f;

constexpr size_t O_YP = 0;
constexpr size_t O_YS = O_YP + (size_t)MP * D;
constexpr size_t O_KP = O_YS + (size_t)MS * D;
constexpr size_t O_VP = O_KP + (size_t)2 * MP * 1024;
constexpr size_t O_MCP = O_VP + (size_t)2 * MP * 1024;
constexpr size_t O_CP = O_MCP + (size_t)2 * 4 * 3 * 2048;
constexpr size_t O_NP = O_CP + (size_t)2 * 4 * 4 * 65536;
constexpr size_t O_MPP = O_NP + (size_t)2 * 4 * 4 * 256;
constexpr size_t O_FCP = O_MPP + 32;
constexpr size_t O_KS = O_FCP + (size_t)2 * 4 * 2 * NUP;
constexpr size_t O_VS = O_KS + (size_t)2 * MS * 1024;
constexpr size_t O_MCS = O_VS + (size_t)2 * MS * 1024;
constexpr size_t O_CS = O_MCS + (size_t)2 * 8 * 3 * 2048;
constexpr size_t O_NS = O_CS + (size_t)2 * 8 * 4 * 65536;
constexpr size_t O_MSS = O_NS + (size_t)2 * 8 * 4 * 256;
constexpr size_t O_FCS = O_MSS + 64;
constexpr size_t O_END = O_FCS + (size_t)2 * 8 * 2 * NUP;

constexpr size_t W_Z = 0;
constexpr size_t W_H = W_Z + (size_t)M * NIN * 2;
constexpr size_t W_AB = W_H + (size_t)M * D * 2;
constexpr size_t W_KA = W_AB + (size_t)M * D * 2;
constexpr size_t W_R = W_KA + (size_t)M * D * 2;
constexpr size_t W_WIN = W_R + (size_t)M * D * 4;
constexpr size_t W_WOUT = W_WIN + (size_t)2 * NIN * D * 2;
constexpr size_t W_WUP = W_WOUT + (size_t)2 * D * D * 2;
constexpr size_t W_WDN = W_WUP + (size_t)2 * NUP * D * 2;
constexpr size_t W_GIF = W_WDN + (size_t)2 * D * DFF * 2;
constexpr size_t W_ROPE = W_GIF + (size_t)M * 8 * 4;
constexpr size_t W_MISC = W_ROPE + (size_t)8192 * 32 * 8;
constexpr size_t W_BAR = W_MISC + 4096;
constexpr size_t W_END = W_BAR + 16384;

struct Params {
  const float* in[25];
  float* out;
  unsigned char* ws;
};

DI unsigned f2bf(float x) { unsigned u = __float_as_uint(x); u += 0x7fffu + ((u >> 16) & 1u); return u >> 16; }
typedef __bf16 bf16v2 __attribute__((ext_vector_type(2)));
typedef float f32x2 __attribute__((ext_vector_type(2)));
DI unsigned pk2(float a, float b) { f32x2 v; v[0] = a; v[1] = b; return __builtin_bit_cast(unsigned, __builtin_convertvector(v, bf16v2)); }
DI float bflo(unsigned u) { return __uint_as_float(u << 16); }
DI float bfhi(unsigned u) { return __uint_as_float(u & 0xffff0000u); }
DI float sigmoidf_(float x) { return 1.f / (1.f + __expf(-x)); }
DI float wave_sum(float v) {
#pragma unroll
  for (int o = 1; o < 64; o <<= 1) v += __shfl_xor(v, o);
  return v;
}
DI int crow(int i, int h) { return (i & 3) + 8 * (i >> 2) + 4 * h; }
DI bf16x8 pack8(const f32x16& x, int s) {
  u32x4 p;
  p[0] = pk2(x[8 * s + 0], x[8 * s + 1]); p[1] = pk2(x[8 * s + 2], x[8 * s + 3]);
  p[2] = pk2(x[8 * s + 4], x[8 * s + 5]); p[3] = pk2(x[8 * s + 6], x[8 * s + 7]);
  return __builtin_bit_cast(bf16x8, p);
}
DI void unpack8(u32x4 v, float* f) {
  f[0] = bflo(v[0]); f[1] = bfhi(v[0]); f[2] = bflo(v[1]); f[3] = bfhi(v[1]);
  f[4] = bflo(v[2]); f[5] = bfhi(v[2]); f[6] = bflo(v[3]); f[7] = bfhi(v[3]);
}
typedef __attribute__((address_space(3))) s16x4 lds_s16x4;
DI bf16x8 tr_frag(unsigned a_lo, unsigned a_hi) {
  const s16x4 lo = __builtin_amdgcn_ds_read_tr16_b64_v4i16((lds_s16x4*)(size_t)a_lo);
  const s16x4 hi = __builtin_amdgcn_ds_read_tr16_b64_v4i16((lds_s16x4*)(size_t)a_hi);
  return __builtin_shufflevector(lo, hi, 0, 1, 2, 3, 4, 5, 6, 7);
}
template <int STEP, int HIOFF>
DI void tr_frag4(unsigned a, bf16x8 (&f)[4]) {
#pragma unroll
  for (int i = 0; i < 4; ++i) f[i] = tr_frag(a + i * STEP, a + i * STEP + HIOFF);
}
DI int otid() { int t = threadIdx.x; asm volatile("" : "+v"(t)); return t; }
DI int uni(int v) { return __builtin_amdgcn_readfirstlane(v); }
DI unsigned lds_addr(const void* p) { return (unsigned)(size_t)p; }

DI const float* xrow_ptr(const Params& p, int l, int row) {
  if (l == 0) return row < MP ? p.in[0] + (size_t)row * D : p.in[1] + (size_t)(row - MP) * D;
  return (const float*)(p.ws + W_R) + (size_t)row * D;
}

DI void transpose_w(const float* W, int K, int N, int src_ld, bf16_t* WT, bool remap, char* lds) {
  float* scr = (float*)lds;
  const int nkb = K / 64, nnb = N / 64, tid = otid();
  for (int it = blockIdx.x; it < nkb * nnb; it += gridDim.x) {
    const int kb = it / nnb, nb = it % nnb, k0 = kb * 64, n0 = nb * 64;
    const int ns = (remap && n0 >= 7168) ? n0 + 8 : n0;
#pragma unroll
    for (int i = 0; i < 8; ++i) {
      const int kk = (tid >> 6) + 8 * i, nn = tid & 63;
      scr[kk * 65 + nn] = W[(size_t)(k0 + kk) * src_ld + ns + nn];
    }
    __syncthreads();
    {
      const int n = tid >> 3, c = tid & 7;
      const float* s = scr + (8 * c) * 65 + n;
      u32x4 o;
      o[0] = pk2(s[0], s[65]); o[1] = pk2(s[2 * 65], s[3 * 65]); o[2] = pk2(s[4 * 65], s[5 * 65]); o[3] = pk2(s[6 * 65], s[7 * 65]);
      const int nd = (remap && n0 < 2048) ? ((n < 32) ? 2 * n : 2 * (n - 32) + 1) : n;
      *(u32x4*)(WT + (size_t)(n0 + nd) * K + k0 + 8 * c) = o;
    }
    __syncthreads();
  }
}

DI void phase0(const Params& p, char* lds) {
  const int tid = otid();
  for (int l = 0; l < 2; ++l) {
    transpose_w(p.in[9] + (size_t)l * D * DIN, D, NIN, DIN, (bf16_t*)(p.ws + W_WIN) + (size_t)l * NIN * D, true, lds);
    transpose_w(p.in[16] + (size_t)l * D * D, D, D, D, (bf16_t*)(p.ws + W_WOUT) + (size_t)l * D * D, false, lds);
    transpose_w(p.in[19] + (size_t)l * D * NUP, D, NUP, NUP, (bf16_t*)(p.ws + W_WUP) + (size_t)l * NUP * D, false, lds);
    transpose_w(p.in[22] + (size_t)l * DFF * D, DFF, D, D, (bf16_t*)(p.ws + W_WDN) + (size_t)l * D * DFF, false, lds);
  }
  bf16_t* ab = (bf16_t*)(p.ws + W_AB);
  for (size_t c = (size_t)blockIdx.x * NTH + tid; c < (size_t)M * 128; c += (size_t)gridDim.x * NTH) {
    const int row = (int)(c >> 7), cc = (int)(c & 127);
    const float* src = xrow_ptr(p, 0, row) + cc * 8;
    f32x4 a = *(const f32x4*)src, b = *(const f32x4*)(src + 4);
    u32x4 o; o[0] = pk2(a[0], a[1]); o[1] = pk2(a[2], a[3]); o[2] = pk2(b[0], b[1]); o[3] = pk2(b[2], b[3]);
    *(u32x4*)(ab + (size_t)row * D + cc * 8) = o;
  }
  float2* rope = (float2*)(p.ws + W_ROPE);
  for (int i = blockIdx.x * NTH + tid; i < 8192 * 32; i += gridDim.x * NTH) {
    const int pos = i >> 5, d = i & 31;
    const double inv = exp2(-(double)d * (13.287712379549449 / 32.0));
    double ang = (double)pos * inv;
    const double twopi = 6.283185307179586476925;
    ang -= twopi * rint(ang / twopi);
    float s, c; sincosf((float)ang, &s, &c);
    rope[i] = make_float2(c, s);
  }
  if (blockIdx.x == 0 && tid < 128) {
    const int l = tid >> 6, ln = tid & 63;
    const float* lp = p.in[13] + (size_t)l * 4 * 64;
    const float s1 = wave_sum(lp[ln] * lp[64 + ln]), s2 = wave_sum(lp[128 + ln] * lp[192 + ln]);
    const float lam_init = (l == 0) ? 0.2f : (0.8f - 0.6f * 0.74081822068171788f);
    if (ln == 0) ((float*)(p.ws + W_MISC))[l] = __expf(s1) - __expf(s2) + lam_init;
  }
  if (blockIdx.x == 0 && tid < 8) ((unsigned*)(p.ws + W_MISC))[16 + tid] = 0u;
  if (blockIdx.x == 0) for (int i = tid; i < 3456; i += NTH) ((unsigned*)(p.ws + W_BAR))[i] = 0u;
}

namespace pg8 {
#define PG8_LAS __attribute__((address_space(3)))
typedef unsigned short bf16_t;
typedef short bf16x8 __attribute__((ext_vector_type(8)));
typedef float f32x4 __attribute__((ext_vector_type(4)));
typedef unsigned u32x4 __attribute__((ext_vector_type(4)));
constexpr int BM = 256, BK = 64, HALF = 128, HTB = HALF * BK * 2  , STAGE_BYTES = 8 * HTB, NXCD = 8, WGM = 8;

__host__ __device__ __forceinline__ int lds_byte(int r, int c) { const int st = (r >> 4) * 2 + (c >> 5), rr = r & 15, cc = c & 31, ob = rr * 64 + cc * 2; return st * 1024 + (ob ^ (((ob >> 9) & 1) << 5)); }
__host__ __device__ __forceinline__ void stage_rc(int b, int& R, int& C) { const int st = b / 1024, sb = b % 1024, swz = sb ^ (((sb >> 9) & 1) << 5); R = (st >> 1) * 16 + swz / 64; C = (st & 1) * 32 + (swz % 64) / 2; }
__host__ __device__ __forceinline__ int perm32(int rho) { const int n = rho >> 4, i = rho & 15; return 8 * (i >> 2) + 4 * n + (i & 3); }

struct Unit { int pm, pn; };
struct Gemm { const bf16_t* A; const bf16_t* Bt; int M, N, K; };

struct StaticOrder {
    int nM, nN, nwg, G, c;
    __host__ __device__ void init(int M, int N, int G_, int c_) { nM = M / BM; nN = N / BM; nwg = nM * nN; G = G_; c = c_; }
    __host__ __device__ bool next(int i, Unit& u) const {
        const long L = (long)i * G + c; if (L >= nwg) return false;
        int wgid = (int)L; { const int q = nwg / NXCD, r = nwg % NXCD, xcd = wgid % NXCD, off = wgid / NXCD; wgid = (xcd < r ? xcd * (q + 1) : r * (q + 1) + (xcd - r) * q) + off; }
        const int nig = WGM * nN, gid = wgid / nig, fm = gid * WGM, gsz = (nM - fm) < WGM ? (nM - fm) : WGM;
        u.pm = fm + ((wgid % nig) % gsz); u.pn = (wgid % nig) / gsz; return true;
    }
    __device__ __forceinline__ void a_ready(const Unit&) const {}
    __device__ __forceinline__ void done(const Unit&) const {}
};
template <class Epi, class Sched, bool STAMP = false>
__device__ __forceinline__ void gemm_phase(PG8_LAS unsigned char* lds, const Gemm g, const Sched& S, const Epi& E, unsigned long long* stamps) {
    const int tid = otid(), wid = __builtin_amdgcn_readfirstlane(tid >> 6), lane = tid & 63, wr = wid >> 2, wc = wid & 3, fr = lane & 15, fq = lane >> 4;
    const int K = g.K, nt = K / BK;
    int ts_lo = 0, ts_hi = 0, nts = 0; const unsigned long long rt_entry = STAMP ? (unsigned long long)wall_clock64() : 0ull;
#define PG8_STAMP() do { if (STAMP && wid == 0 && nts < 64) { const unsigned long long _c = (unsigned long long)clock64(); \
        ts_lo = (lane == nts) ? (int)(unsigned)_c : ts_lo; ts_hi = (lane == nts) ? (int)(unsigned)(_c >> 32) : ts_hi; ++nts; } } while (0)
    PG8_STAMP();
    unsigned voffA[2], voffB[2];
#pragma unroll
    for (int i = 0; i < 2; ++i) { int R, C; stage_rc(tid * 16 + i * 8192, R, C); const int Rb = Epi::PERM ? ((R & ~31) + perm32(R & 31)) : R;
        voffA[i] = (unsigned)(R * K + C) * 2u; voffB[i] = (unsigned)(Rb * K + C) * 2u; }
    const size_t kstep = (size_t)(BK * 2);
    const size_t hstep = (size_t)HALF * K * 2;
    const size_t tstep = 2 * hstep;
    const unsigned ldsw = (unsigned)wid * 1024u;
    const int aoff = lds_byte(wr * 64 + fr, fq * 8), boff = lds_byte(wc * 32 + fr, fq * 8);
#define PG8_SA(b, h) (((b) * 2 + (h)) * HTB)
#define PG8_SB(b, h) ((4 + (b) * 2 + (h)) * HTB)
#define PG8_STAGE(bufoff, gbase, voff) do { _Pragma("unroll") for (int _i = 0; _i < 2; ++_i) \
        __builtin_amdgcn_global_load_lds((const unsigned*)((const char*)(gbase) + (voff)[_i]), (PG8_LAS unsigned*)(lds + (bufoff) + ldsw + _i * 8192), 16, 0, 0); } while (0)
#define PG8_LDA(dst, b, h) do { _Pragma("unroll") for (int m = 0; m < 4; ++m) _Pragma("unroll") for (int k = 0; k < 2; ++k) dst[m][k] = *(const PG8_LAS bf16x8*)(lds + PG8_SA(b, h) + aoff + m * 2048 + k * 1024); } while (0)
#define PG8_LDB(dst, b, h) do { _Pragma("unroll") for (int n = 0; n < 2; ++n) _Pragma("unroll") for (int k = 0; k < 2; ++k) dst[n][k] = *(const PG8_LAS bf16x8*)(lds + PG8_SB(b, h) + boff + n * 2048 + k * 1024); } while (0)
#define PG8_MMA(ai, bj, At, Bt) do { __builtin_amdgcn_s_setprio(1); _Pragma("unroll") for (int m = 0; m < 4; ++m) _Pragma("unroll") for (int n = 0; n < 2; ++n) _Pragma("unroll") for (int k = 0; k < 2; ++k) \
        acc[ai][bj][m][n] = __builtin_amdgcn_mfma_f32_16x16x32_bf16(Bt[n][k], At[m][k], acc[ai][bj][m][n], 0, 0, 0); __builtin_amdgcn_s_setprio(0); } while (0)
#define PG8_WAIT_V(n) asm volatile("s_waitcnt vmcnt(" #n ")" ::: "memory")
#define PG8_WAIT_L(n) asm volatile("s_waitcnt lgkmcnt(" #n ")" ::: "memory")
#define PG8_BAR __builtin_amdgcn_s_barrier()
#define PG8_SCHED __builtin_amdgcn_sched_barrier(0)
    Unit cur, nxt; int ui = 0;
    if (!S.next(0, cur)) return;
    f32x4 acc[2][2][4][2];
#pragma unroll
    for (int a = 0; a < 2; ++a)
#pragma unroll
        for (int b = 0; b < 2; ++b)
#pragma unroll
            for (int m = 0; m < 4; ++m)
#pragma unroll
                for (int n = 0; n < 2; ++n) acc[a][b][m][n] = (f32x4){0.f, 0.f, 0.f, 0.f};
    bf16x8 At[4][2], B0[2][2], B1[2][2];
    const char* cA = (const char*)g.A + (size_t)cur.pm * tstep; const char* cB = (const char*)g.Bt + (size_t)cur.pn * tstep;
    S.a_ready(cur);
    PG8_STAGE(PG8_SB(0, 0), cB, voffB); PG8_STAGE(PG8_SA(0, 0), cA, voffA); PG8_STAGE(PG8_SB(0, 1), cB + hstep, voffB); PG8_STAGE(PG8_SA(0, 1), cA + hstep, voffA);
    if (wr == 1) PG8_BAR;
    PG8_WAIT_V(4); PG8_BAR;
    PG8_STAGE(PG8_SB(1, 0), cB + kstep, voffB); PG8_STAGE(PG8_SA(1, 0), cA + kstep, voffA); PG8_STAGE(PG8_SB(1, 1), cB + hstep + kstep, voffB);
    PG8_WAIT_V(6); PG8_BAR;
    PG8_STAMP();
    for (;;) {
        const bool has_next = S.next(ui + 1, nxt);
        const char* nA = has_next ? (const char*)g.A + (size_t)nxt.pm * tstep : cA; const char* nB = has_next ? (const char*)g.Bt + (size_t)nxt.pn * tstep : cB;
        for (int t = 0; t < nt; t += 2) {
            const bool last = (t == nt - 2);
            const char* a1 = cA + (size_t)(t + 1) * kstep;
            const char* a2 = last ? nA : cA + (size_t)(t + 2) * kstep; const char* b2 = last ? nB : cB + (size_t)(t + 2) * kstep;
            const char* a3 = a2 + kstep; const char* b3 = b2 + kstep;
            if (last && has_next) S.a_ready(nxt);
            PG8_LDB(B0, 0, 0); PG8_SCHED; PG8_LDA(At, 0, 0); PG8_STAGE(PG8_SA(1, 1), a1 + hstep, voffA);
            PG8_WAIT_L(8); PG8_BAR; PG8_WAIT_L(0); PG8_MMA(0, 0, At, B0); PG8_BAR; PG8_SCHED;
            PG8_LDB(B1, 0, 1); PG8_STAGE(PG8_SB(0, 0), b2, voffB);
            PG8_BAR; PG8_WAIT_L(0); PG8_MMA(0, 1, At, B1); PG8_BAR;
            PG8_LDA(At, 0, 1); PG8_STAGE(PG8_SA(0, 0), a2, voffA);
            PG8_BAR; PG8_WAIT_L(0); PG8_MMA(1, 0, At, B0); PG8_BAR; PG8_SCHED;
            PG8_STAGE(PG8_SB(0, 1), b2 + hstep, voffB);
            PG8_WAIT_V(6); PG8_BAR; PG8_MMA(1, 1, At, B1); PG8_BAR;
            PG8_LDB(B0, 1, 0); PG8_SCHED; PG8_LDA(At, 1, 0); PG8_STAGE(PG8_SA(0, 1), a2 + hstep, voffA);
            PG8_WAIT_L(8); PG8_BAR; PG8_WAIT_L(0); PG8_MMA(0, 0, At, B0); PG8_BAR; PG8_SCHED;
            PG8_LDB(B1, 1, 1); PG8_STAGE(PG8_SB(1, 0), b3, voffB);
            PG8_BAR; PG8_WAIT_L(0); PG8_MMA(0, 1, At, B1); PG8_BAR;
            PG8_LDA(At, 1, 1); PG8_STAGE(PG8_SA(1, 0), a3, voffA);
            PG8_BAR; PG8_WAIT_L(0); PG8_MMA(1, 0, At, B0); PG8_BAR; PG8_SCHED;
            PG8_STAGE(PG8_SB(1, 1), b3 + hstep, voffB);
            PG8_WAIT_V(6); PG8_BAR; PG8_MMA(1, 1, At, B1); PG8_BAR;
        }
        PG8_STAMP();
        if constexpr (!Epi::AFTER_DRAIN) { E(acc, cur, wr, wc, fr, fq); S.done(cur); }
        PG8_STAMP();
        if (!has_next) break;
#pragma unroll
        for (int a = 0; a < 2; ++a)
#pragma unroll
            for (int b = 0; b < 2; ++b)
#pragma unroll
                for (int m = 0; m < 4; ++m)
#pragma unroll
                    for (int n = 0; n < 2; ++n) acc[a][b][m][n] = (f32x4){0.f, 0.f, 0.f, 0.f};
        cur = nxt; cA = nA; cB = nB; ++ui;
    }
    PG8_WAIT_V(0);
    if (wr == 0) PG8_BAR;
    PG8_BAR;
    if constexpr (Epi::AFTER_DRAIN) { E.fused(acc, cur, wr, wc, fr, fq, lds, wid, lane); S.done(cur); }
    PG8_STAMP();
    if (STAMP && wid == 0) { stamps[lane] = lane < nts ? (((unsigned long long)(unsigned)ts_hi << 32) | (unsigned)ts_lo) : 0ull;
        if (lane == 62) stamps[62] = rt_entry; if (lane == 63) stamps[63] = (unsigned long long)wall_clock64(); }
#undef PG8_STAMP
#undef PG8_SA
#undef PG8_SB
#undef PG8_STAGE
#undef PG8_LDA
#undef PG8_LDB
#undef PG8_MMA
#undef PG8_WAIT_V
#undef PG8_WAIT_L
#undef PG8_BAR
#undef PG8_SCHED
}
}

enum { EPI_IN = 0, EPI_OUT = 1, EPI_UP = 2, EPI_DOWN = 3 };
template <int MODE>
struct Epi {
  static constexpr bool PERM = true, AFTER_DRAIN = false;
  Params p; int l;
  DI void operator()(const f32x4 (&acc)[2][2][4][2], const pg8::Unit& u, int wr, int wc, int fr, int fq) const {
    const int colb = u.pn * 256 + wc * 32 + 8 * fq;
#pragma unroll
    for (int ai = 0; ai < 2; ++ai)
#pragma unroll
      for (int m = 0; m < 4; ++m) {
        const int row = u.pm * 256 + ai * 128 + wr * 64 + m * 16 + fr;
        if (row < M) {
#pragma unroll
          for (int bj = 0; bj < 2; ++bj) {
            const int col = colb + bj * 128;
            const f32x4 v0 = acc[ai][bj][m][0], v1 = acc[ai][bj][m][1];
            if (MODE == EPI_IN) {
              bf16_t* Z = (bf16_t*)(p.ws + W_Z);
              const int seg = u.pn >> 2;
              if (seg <= 1) {
                const int pos = row < MP ? (row & (SEQ - 1)) : PAST + ((row - MP) & 15);
                const int d0 = (col & 63) >> 1;
                const f32x4* rp = (const f32x4*)((const float2*)(p.ws + W_ROPE) + pos * 32 + d0);
                const f32x4 c01 = rp[0], c23 = rp[1];
                const float a0 = v0[0] * c01[0] - v0[1] * c01[1], b0 = v0[1] * c01[0] + v0[0] * c01[1];
                const float a1 = v0[2] * c01[2] - v0[3] * c01[3], b1 = v0[3] * c01[2] + v0[2] * c01[3];
                const float a2 = v1[0] * c23[0] - v1[1] * c23[1], b2 = v1[1] * c23[0] + v1[0] * c23[1];
                const float a3 = v1[2] * c23[2] - v1[3] * c23[3], b3 = v1[3] * c23[2] + v1[2] * c23[3];
                const float qs = seg == 0 ? 0.125f : 1.f;
                u32x4 o; o[0] = pk2(a0 * qs, b0 * qs); o[1] = pk2(a1 * qs, b1 * qs); o[2] = pk2(a2 * qs, b2 * qs); o[3] = pk2(a3 * qs, b3 * qs);
                *(u32x4*)(Z + (size_t)row * NIN + col) = o;
                if (seg == 1) {
                  float* ob = (row < MP ? p.out + O_KP + ((size_t)l * MP + row) * 1024 : p.out + O_KS + ((size_t)l * MS + row - MP) * 1024) + ((col - 1024) & ~63) + d0;
                  f32x4 o1, o2; o1[0] = a0; o1[1] = a1; o1[2] = a2; o1[3] = a3; o2[0] = b0; o2[1] = b1; o2[2] = b2; o2[3] = b3;
                  *(f32x4*)ob = o1; *(f32x4*)(ob + 32) = o2;
                }
              } else {
                u32x4 o; o[0] = pk2(v0[0], v0[1]); o[1] = pk2(v0[2], v0[3]); o[2] = pk2(v1[0], v1[1]); o[3] = pk2(v1[2], v1[3]);
                *(u32x4*)(Z + (size_t)row * NIN + col) = o;
                if (seg == 2) {
                  float* ob = (row < MP ? p.out + O_VP + ((size_t)l * MP + row) * 1024 : p.out + O_VS + ((size_t)l * MS + row - MP) * 1024) + (col - 2048);
                  *(f32x4*)ob = v0; *(f32x4*)(ob + 4) = v1;
                } else if (seg == 3 || seg == 4) {
                  float* ob = nullptr;
                  if (row < MP) { const int s = row & (SEQ - 1); if (s >= SEQ - 3) ob = p.out + O_MCP + ((size_t)(l * 4 + (row >> 13)) * 3 + (s - (SEQ - 3))) * 2048 + col - 3072; }
                  else { const int t = (row - MP) & 15, b = (row - MP) >> 4; if (t >= 13) ob = p.out + O_MCS + ((size_t)(l * 8 + b) * 3 + (t - 13)) * 2048 + col - 3072; }
                  if (ob) { *(f32x4*)ob = v0; *(f32x4*)(ob + 4) = v1; }
                }
              }
            } else if (MODE == EPI_OUT || MODE == EPI_DOWN) {
              float* R = (float*)(p.ws + W_R) + (size_t)row * D + col;
              const float* rs = MODE == EPI_OUT ? xrow_ptr(p, l, row) + col : R;
              const f32x4 r0 = *(const f32x4*)rs, r1 = *(const f32x4*)(rs + 4);
              *(f32x4*)R = r0 * ALPHA + v0; *(f32x4*)(R + 4) = r1 * ALPHA + v1;
            } else {
              bf16_t* U = (bf16_t*)(p.ws + W_Z);
              u32x4 o; o[0] = pk2(v0[0], v0[1]); o[1] = pk2(v0[2], v0[3]); o[2] = pk2(v1[0], v1[1]); o[3] = pk2(v1[2], v1[3]);
              *(u32x4*)(U + (size_t)row * NUP + col) = o;
              float* ob = nullptr;
              if (row < MP) { const int s = row & (SEQ - 1); if (s >= SEQ - 2) ob = p.out + O_FCP + ((size_t)(l * 4 + (row >> 13)) * 2 + (s - (SEQ - 2))) * NUP + col; }
              else { const int t = (row - MP) & 15, b = (row - MP) >> 4; if (t >= 14) ob = p.out + O_FCS + ((size_t)(l * 8 + b) * 2 + (t - 14)) * NUP + col; }
              if (ob) { *(f32x4*)ob = v0; *(f32x4*)(ob + 4) = v1; }
            }
          }
        }
      }
  }
};

template <int MODE>
DI void gemm_phase(const Params& p, int l, const bf16_t* A, int lda, const bf16_t* Bt, int K, int ntn, char* lds) {
  (void)lda;
  pg8::Gemm g; g.A = A; g.Bt = Bt; g.M = ((MODE == EPI_OUT || MODE == EPI_DOWN) ? NTM - 1 : NTM) * 256; g.N = ntn * 256; g.K = K;
  if (MODE == EPI_OUT || MODE == EPI_DOWN) sample_gemm<MODE>(p, l, A, Bt, K);
  pg8::StaticOrder S; S.init(g.M, g.N, (int)gridDim.x, (int)blockIdx.x);
  Epi<MODE> E; E.p = p; E.l = l;
  pg8::gemm_phase<Epi<MODE>, pg8::StaticOrder, false>((PG8_LAS unsigned char*)lds, g, S, E, nullptr);
  __syncthreads();
}

typedef float f32x4v __attribute__((ext_vector_type(4)));
template <int MODE>
DI void sample_gemm(const Params& p, int l, const bf16_t* A, const bf16_t* Bt, int K) {
  if (blockIdx.x >= 64) return;
  const int tid = otid(), lane = tid & 63, wave = uni(tid >> 6), fr = lane & 15, fq = lane >> 4;
  const bf16_t* ap = A + (size_t)(MP + wave * 16 + fr) * K + fq * 8;
  const bf16_t* bp = Bt + (size_t)(blockIdx.x * 16 + fr) * K + fq * 8;
  f32x4v acc0 = {0.f, 0.f, 0.f, 0.f}, acc1 = {0.f, 0.f, 0.f, 0.f};
  for (int k0 = 0; k0 < K; k0 += 256) {
    bf16x8 a[8], bb[8];
#pragma unroll
    for (int i = 0; i < 8; ++i) { a[i] = *(const bf16x8*)(ap + k0 + i * 32); bb[i] = *(const bf16x8*)(bp + k0 + i * 32); }
#pragma unroll
    for (int i = 0; i < 8; i += 2) {
      acc0 = __builtin_amdgcn_mfma_f32_16x16x32_bf16(a[i], bb[i], acc0, 0, 0, 0);
      acc1 = __builtin_amdgcn_mfma_f32_16x16x32_bf16(a[i + 1], bb[i + 1], acc1, 0, 0, 0);
    }
  }
  const int col = blockIdx.x * 16 + fr;
  float* R = (float*)(p.ws + W_R);
#pragma unroll
  for (int j = 0; j < 4; ++j) {
    const int row = MP + wave * 16 + fq * 4 + j;
    const float res = MODE == EPI_OUT ? xrow_ptr(p, l, row)[col] : R[(size_t)row * D + col];
    R[(size_t)row * D + col] = ALPHA * res + (acc0[j] + acc1[j]);
  }
}

DI void gif_phase(const Params& p, int l, char* lds) {
  const int tidq = otid(); const int lane = tidq & 63, gw = blockIdx.x * 8 + (tidq >> 6), ngw = gridDim.x * 8;
  const float* w = p.in[9] + (size_t)l * D * DIN + 7168;
  const float* bif = p.in[10] + l * 8;
  float* gif = (float*)(p.ws + W_GIF);
  float* w8 = (float*)lds;
  __syncthreads();
#pragma unroll
  for (int i = 0; i < 2; ++i) {
    const int k = tidq + 512 * i;
    *(f32x4*)(w8 + k * 8) = *(const f32x4*)(w + (size_t)k * DIN); *(f32x4*)(w8 + k * 8 + 4) = *(const f32x4*)(w + (size_t)k * DIN + 4);
  }
  __syncthreads();
  for (int rg = gw; rg < M / 4; rg += ngw) {
    float acc[4][8];
#pragma unroll
    for (int a = 0; a < 4; ++a)
#pragma unroll
      for (int j = 0; j < 8; ++j) acc[a][j] = 0.f;
    const float* x0 = xrow_ptr(p, l, rg * 4);
#pragma unroll 4
    for (int kk = 0; kk < 16; ++kk) {
      const int k = kk * 64 + lane;
      const f32x4 w0 = *(const f32x4*)(w8 + k * 8), w1 = *(const f32x4*)(w8 + k * 8 + 4);
#pragma unroll
      for (int a = 0; a < 4; ++a) {
        const float xv = x0[(size_t)a * D + k];
        acc[a][0] += xv * w0[0]; acc[a][1] += xv * w0[1]; acc[a][2] += xv * w0[2]; acc[a][3] += xv * w0[3];
        acc[a][4] += xv * w1[0]; acc[a][5] += xv * w1[1]; acc[a][6] += xv * w1[2]; acc[a][7] += xv * w1[3];
      }
    }
#pragma unroll
    for (int a = 0; a < 4; ++a)
#pragma unroll
      for (int j = 0; j < 8; ++j) {
        const float s = wave_sum(acc[a][j]);
        if (lane == 0) gif[(size_t)(rg * 4 + a) * 8 + j] = s + bif[j];
      }
  }
  __syncthreads();
}

DI void qkconv_phase(const Params& p, int l) {
  const bf16_t* Z = (const bf16_t*)(p.ws + W_Z);
  bf16_t* QA = (bf16_t*)(p.ws + W_AB); bf16_t* KA = (bf16_t*)(p.ws + W_KA);
  const float* cw = p.in[11] + (size_t)l * 4 * 2048; const float* cb = p.in[12] + (size_t)l * 2048;
  const size_t total = (size_t)(M / 4) * 256;
  for (size_t it = (size_t)blockIdx.x * NTH + otid(); it < total; it += (size_t)gridDim.x * NTH) {
    const int cc = (int)(it & 255), rg = (int)(it >> 8), col = cc * 8, row0 = rg * 4;
    int t0, hist_rows;
    const float* st = nullptr;
    if (row0 < MP) { t0 = row0 & (SEQ - 1); }
    else { t0 = (row0 - MP) & 15; st = p.in[4] + ((size_t)(l * 8 + ((row0 - MP) >> 4)) * 3) * 2048 + col; }
    (void)hist_rows;
    float w[4][8], bias[8];
#pragma unroll
    for (int j = 0; j < 4; ++j) { f32x4 a = *(const f32x4*)(cw + j * 2048 + col), b = *(const f32x4*)(cw + j * 2048 + col + 4);
      w[j][0] = a[0]; w[j][1] = a[1]; w[j][2] = a[2]; w[j][3] = a[3]; w[j][4] = b[0]; w[j][5] = b[1]; w[j][6] = b[2]; w[j][7] = b[3]; }
    { f32x4 a = *(const f32x4*)(cb + col), b = *(const f32x4*)(cb + col + 4);
      bias[0] = a[0]; bias[1] = a[1]; bias[2] = a[2]; bias[3] = a[3]; bias[4] = b[0]; bias[5] = b[1]; bias[6] = b[2]; bias[7] = b[3]; }
    float x[7][8];
#pragma unroll
    for (int j = 0; j < 7; ++j) {
      const int t = t0 - 3 + j;
      if (t >= 0) { u32x4 v = *(const u32x4*)(Z + (size_t)(row0 - 3 + j) * NIN + 3072 + col); unpack8(v, x[j]); }
      else if (st) { f32x4 a = *(const f32x4*)(st + (size_t)(3 + t) * 2048), b = *(const f32x4*)(st + (size_t)(3 + t) * 2048 + 4);
        x[j][0] = a[0]; x[j][1] = a[1]; x[j][2] = a[2]; x[j][3] = a[3]; x[j][4] = b[0]; x[j][5] = b[1]; x[j][6] = b[2]; x[j][7] = b[3]; }
      else {
#pragma unroll
        for (int e = 0; e < 8; ++e) x[j][e] = 0.f; }
    }
    const float sc = col >= 1024 ? 0.0625f : 1.f;
    bf16_t* dst = col >= 1024 ? KA + (col - 1024) : QA + col;
#pragma unroll
    for (int a = 0; a < 4; ++a) {
      float o[8];
#pragma unroll
      for (int e = 0; e < 8; ++e) {
        float u = bias[e] + w[0][e] * x[a][e] + w[1][e] * x[a + 1][e] + w[2][e] * x[a + 2][e] + w[3][e] * x[a + 3][e];
        o[e] = u * sigmoidf_(u) * sc;
      }
      u32x4 ov; ov[0] = pk2(o[0], o[1]); ov[1] = pk2(o[2], o[3]); ov[2] = pk2(o[4], o[5]); ov[3] = pk2(o[6], o[7]);
      *(u32x4*)(dst + (size_t)(row0 + a) * D) = ov;
    }
  }
}

constexpr int A_LD = 272;
constexpr int A_TILE = 64 * A_LD;
template <int KIND>
DI void attn_item(const Params& p, int l, int b, int ha, int qb, char* lds) {
  const int tid = otid(), lane = tid & 63, wave = uni(tid >> 6);
  const int map = wave >> 2, qt = wave & 3, r = lane & 31, h = lane >> 5;
  const bf16_t* Z = (const bf16_t*)(p.ws + W_Z);
  const int NT = KIND == 0 ? 2 * (qb + 1) : (NKS + 63) / 64;
  const int ntw = KIND == 0 ? 2 * qb + (qt >> 1) + 1 : NT;
  const bool active = KIND == 0 ? true : (qt == 0);
  int qrow;
  if (KIND == 0) qrow = b * SEQ + qb * 128 + qt * 32 + r; else qrow = MP + b * 16 + (r < 16 ? r : 15);
  bf16x8 qf[4];
#pragma unroll
  for (int ks = 0; ks < 4; ++ks) {
    if (KIND == 0) qf[ks] = *(const bf16x8*)(Z + (size_t)qrow * NIN + ha * 128 + map * 64 + ks * 16 + h * 8);
    else {
      const int dn = ks * 16 + h * 8, par = dn >> 5, dd = dn & 31;
      const bf16_t* src = Z + (size_t)qrow * NIN + ha * 128 + map * 64 + 2 * dd;
      const u32x4 lo = *(const u32x4*)src, hi = *(const u32x4*)(src + 8);
      unsigned e[8];
#pragma unroll
      for (int i = 0; i < 4; ++i) { e[i] = par ? (lo[i] >> 16) : (lo[i] & 0xffffu); e[4 + i] = par ? (hi[i] >> 16) : (hi[i] & 0xffffu); }
      u32x4 o; o[0] = e[0] | (e[1] << 16); o[1] = e[2] | (e[3] << 16); o[2] = e[4] | (e[5] << 16); o[3] = e[6] | (e[7] << 16);
      qf[ks] = __builtin_bit_cast(bf16x8, o);
    }
  }
  const int skey = tid >> 4, part = tid & 15;
  u32x4 rk0, rk1, rv0, rv1;
  auto gload = [&](int j) {
    if (KIND == 0) {
      const bf16_t* base = Z + (size_t)(b * SEQ + j * 64 + skey) * NIN + 1024 + ha * 128 + part * 8;
      rk0 = *(const u32x4*)base; rk1 = *(const u32x4*)(base + (size_t)32 * NIN);
      rv0 = *(const u32x4*)(base + 1024); rv1 = *(const u32x4*)(base + (size_t)32 * NIN + 1024);
    } else {
#pragma unroll
      for (int i = 0; i < 2; ++i) {
        int kk = j * 64 + skey + 32 * i; if (kk > NKS - 1) kk = NKS - 1;
        const float *ks_, *vs_;
        if (kk < PAST) { const size_t o = (((size_t)(l * 8 + b) * PAST + kk) * 8 + ha) * 128 + part * 8; ks_ = p.in[2] + o; vs_ = p.in[3] + o; }
        else { const size_t o = (((size_t)l * MS + b * 16 + (kk - PAST)) * 8 + ha) * 128 + part * 8; ks_ = p.out + O_KS + o; vs_ = p.out + O_VS + o; }
        const f32x4 a0 = *(const f32x4*)ks_, a1 = *(const f32x4*)(ks_ + 4), c0 = *(const f32x4*)vs_, c1 = *(const f32x4*)(vs_ + 4);
        u32x4 ko, vo;
        ko[0] = pk2(a0[0], a0[1]); ko[1] = pk2(a0[2], a0[3]); ko[2] = pk2(a1[0], a1[1]); ko[3] = pk2(a1[2], a1[3]);
        vo[0] = pk2(c0[0], c0[1]); vo[1] = pk2(c0[2], c0[3]); vo[2] = pk2(c1[0], c1[1]); vo[3] = pk2(c1[2], c1[3]);
        if (i == 0) { rk0 = ko; rv0 = vo; } else { rk1 = ko; rv1 = vo; }
      }
    }
  };
  f32x16 O[4];
#pragma unroll
  for (int v = 0; v < 4; ++v)
#pragma unroll
    for (int i = 0; i < 16; ++i) O[v][i] = 0.f;
  float m_run = -1e30f, l_run = 0.f;
  const int q4 = (lane & 15) >> 2, p4 = lane & 3, blk = (lane >> 4) & 1;
  const unsigned sofs = skey * A_LD + part * 16;
  auto qk = [&](int j, f32x16 (&st)[2]) {
    const char* kb = lds + (j & 1) * A_TILE;
#pragma unroll
    for (int kt = 0; kt < 2; ++kt) {
#pragma unroll
      for (int i = 0; i < 16; ++i) st[kt][i] = 0.f;
#pragma unroll
      for (int ks = 0; ks < 4; ++ks) {
        const bf16x8 kf = *(const bf16x8*)(kb + (kt * 32 + r) * A_LD + (map * 64 + ks * 16 + h * 8) * 2);
        st[kt] = MFMA32(kf, qf[ks], st[kt]);
      }
    }
    if (KIND == 1 && j == NT - 1) {
#pragma unroll
      for (int kt = 0; kt < 2; ++kt)
#pragma unroll
        for (int i = 0; i < 16; ++i) if (j * 64 + kt * 32 + crow(i, h) >= NKS) st[kt][i] = -1e30f;
    }
  };
  bf16x8 pk[4];
  auto smax = [&](int j, f32x16 (&sc)[2], f32x16 (&sn)[2]) {
    if (j + 1 < ntw) qk(j + 1, sn);
    float mx = sc[0][0];
#pragma unroll
    for (int kt = 0; kt < 2; ++kt)
#pragma unroll
      for (int i = 0; i < 16; ++i) mx = fmaxf(mx, sc[kt][i]);
    mx = fmaxf(mx, __shfl_xor(mx, 32));
    const float m_new = fmaxf(m_run, mx);
    const float alpha = __builtin_amdgcn_exp2f((m_run - m_new) * LOG2E);
    const float mb = m_new * LOG2E;
    float rs = 0.f;
#pragma unroll
    for (int kt = 0; kt < 2; ++kt)
#pragma unroll
      for (int i = 0; i < 16; ++i) { const float e = __builtin_amdgcn_exp2f(sc[kt][i] * LOG2E - mb); sc[kt][i] = e; rs += e; }
    rs += __shfl_xor(rs, 32);
    l_run = l_run * alpha + rs; m_run = m_new;
    if (__builtin_amdgcn_ballot_w64(alpha != 1.f) != 0ull) {
#pragma unroll
      for (int v = 0; v < 4; ++v)
#pragma unroll
        for (int i = 0; i < 16; ++i) O[v][i] *= alpha;
    }
    pk[0] = pack8(sc[0], 0); pk[1] = pack8(sc[0], 1); pk[2] = pack8(sc[1], 0); pk[3] = pack8(sc[1], 1);
  };
  auto pv = [&](int j) {
    const unsigned vaddr = lds_addr(lds + (2 + j % 3) * A_TILE) + (4 * h + q4) * A_LD + (16 * blk + 4 * p4) * 2;
#pragma unroll
    for (int vt = 0; vt < 4; ++vt) {
      bf16x8 vf[4];
      tr_frag4<16 * A_LD, 8 * A_LD>(vaddr + vt * 64, vf);
#pragma unroll
      for (int ks = 0; ks < 4; ++ks) O[vt] = MFMA32(vf[ks], pk[ks], O[vt]);
    }
  };
  gload(0);
  { char* kb = lds + sofs; *(u32x4*)kb = rk0; *(u32x4*)(kb + 32 * A_LD) = rk1; char* vb = lds + 2 * A_TILE + sofs; *(u32x4*)vb = rv0; *(u32x4*)(vb + 32 * A_LD) = rv1; }
  gload(1);
  { char* kb = lds + A_TILE + sofs; *(u32x4*)kb = rk0; *(u32x4*)(kb + 32 * A_LD) = rk1; }
  __syncthreads();
  f32x16 sA[2], sB[2];
  if (active && 0 < ntw) qk(0, sA);
  for (int j = 0; j < NT; j += 2) {
#pragma unroll
    for (int u = 0; u < 2; ++u) {
      const int jj = j + u;
      if (jj < NT) {
        if (jj + 1 < NT) { char* vb = lds + (2 + (jj + 1) % 3) * A_TILE + sofs; *(u32x4*)vb = rv0; *(u32x4*)(vb + 32 * A_LD) = rv1; }
        if (jj + 2 < NT) gload(jj + 2);
        if (active) {
          if (map == 1 && jj >= 1 && jj - 1 < ntw) pv(jj - 1);
          if (jj < ntw) { if (u == 0) smax(jj, sA, sB); else smax(jj, sB, sA); }
          if (map == 0 && jj < ntw) pv(jj);
        }
        if (jj + 2 < NT) { char* kb = lds + (jj & 1) * A_TILE + sofs; *(u32x4*)kb = rk0; *(u32x4*)(kb + 32 * A_LD) = rk1; }
        __syncthreads();
      }
    }
  }
  if (active && map == 1 && ntw == NT) pv(NT - 1);
  __syncthreads();
  float* ex = (float*)lds;
  const float inv_l = 1.f / l_run;
  if (map == 1) {
#pragma unroll
    for (int vt = 0; vt < 4; ++vt)
#pragma unroll
      for (int g = 0; g < 4; ++g) {
        f32x4 o; o[0] = O[vt][4 * g] * inv_l; o[1] = O[vt][4 * g + 1] * inv_l; o[2] = O[vt][4 * g + 2] * inv_l; o[3] = O[vt][4 * g + 3] * inv_l;
        *(f32x4*)(ex + (qt * 32 + r) * 132 + vt * 32 + 8 * g + 4 * h) = o;
      }
  }
  __syncthreads();
  if (map == 0) {
    const float lam = ((const float*)(p.ws + W_MISC))[l];
    const float lam_init = (l == 0) ? 0.2f : (0.8f - 0.6f * 0.74081822068171788f);
    float ssq = 0.f;
#pragma unroll
    for (int vt = 0; vt < 4; ++vt)
#pragma unroll
      for (int g = 0; g < 4; ++g) {
        const f32x4 o2 = *(const f32x4*)(ex + (qt * 32 + r) * 132 + vt * 32 + 8 * g + 4 * h);
#pragma unroll
        for (int e = 0; e < 4; ++e) { const float o = O[vt][4 * g + e] * inv_l - lam * o2[e]; O[vt][4 * g + e] = o; ssq += o * o; }
      }
    ssq += __shfl_xor(ssq, 32);
    const float rms = rsqrtf(ssq * (1.f / 128.f) + LN_EPS) * (1.f - lam_init);
    const float* sg = p.in[14] + l * 128;
    const bool valid = KIND == 0 ? true : (qt == 0 && r < 16);
    if (valid) {
      bf16_t* dst = (bf16_t*)(p.ws + W_Z) + (size_t)qrow * NIN + 3072 + ha * 128;
#pragma unroll
      for (int vt = 0; vt < 4; ++vt)
#pragma unroll
        for (int g = 0; g < 4; ++g) {
          const int v0 = vt * 32 + 8 * g + 4 * h;
          const f32x4 gg = *(const f32x4*)(sg + v0);
          u32x2 o; o[0] = pk2(O[vt][4 * g] * rms * gg[0], O[vt][4 * g + 1] * rms * gg[1]); o[1] = pk2(O[vt][4 * g + 2] * rms * gg[2], O[vt][4 * g + 3] * rms * gg[3]);
          *(u32x2*)(dst + v0) = o;
        }
    }
  }
  __syncthreads();
}

constexpr int L_LD = 528;
constexpr int L_VLD = 272;
constexpr int L_Q = 0, L_K = 64 * L_LD, L_V = 2 * 64 * L_LD, L_SW = L_V + 64 * L_VLD;
constexpr int L_SWLD = 144;
constexpr int L_SC = L_SW + 64 * L_SWLD;
constexpr int S_MX = 0, S_G = 64, S_EMT = 128, S_DS0 = 192, S_DS1 = 256, S_QN = 320  , S_NV = 576  , S_GEND = 832, S_PAR = 840;
constexpr int LDS_BYTES = 153376;
static_assert(L_SC + 2 * S_PAR * 4 <= 131072, "lds");
#define WG_BAR() do { __builtin_amdgcn_fence(__ATOMIC_RELEASE, "workgroup"); __builtin_amdgcn_s_barrier(); __builtin_amdgcn_fence(__ATOMIC_ACQUIRE, "workgroup"); } while (0)

template <int KIND>
DI void mlstm_item(const Params& p, int l, int b, int hm, int half, char* lds) {
  const int tid0 = otid(), wave = uni(tid0 >> 6);
  const bf16_t* QA = (const bf16_t*)(p.ws + W_AB); const bf16_t* KA = (const bf16_t*)(p.ws + W_KA);
  const bf16_t* Z = (const bf16_t*)(p.ws + W_Z); bf16_t* H = (bf16_t*)(p.ws + W_H);
  const float* GIF = (const float*)(p.ws + W_GIF);
  float* scb = (float*)(lds + L_SC);
  int nchunks = KIND == 0 ? SEQ / 64 : 1; asm volatile("" : "+s"(nchunks));
  const int Lv = KIND == 0 ? 64 : 16;
  const size_t bh = KIND == 0 ? (size_t)(l * 4 + b) * 4 + hm : (size_t)(l * 8 + b) * 4 + hm;
  if (wave < 4) {
    f32x16 C[8];
    { const int lane = tid0 & 63, r = lane & 31, h = lane >> 5; (void)r; (void)h;
      if (KIND == 0) {
#pragma unroll
        for (int d = 0; d < 8; ++d)
#pragma unroll
          for (int i = 0; i < 16; ++i) C[d][i] = 0.f;
      } else {
        const float* cp = p.in[5] + bh * 65536 + (size_t)(4 * h) * 256 + half * 128 + wave * 32 + r;
#pragma unroll
        for (int d = 0; d < 8; ++d)
#pragma unroll
          for (int g = 0; g < 4; ++g) {
            C[d][4 * g] = cp[0]; C[d][4 * g + 1] = cp[256]; C[d][4 * g + 2] = cp[512]; C[d][4 * g + 3] = cp[768];
            cp += 2048; asm volatile("" : "+v"(cp));
          }
      }
    }
    for (int c = 0; c < nchunks; ++c) {
      int tid = tid0; asm volatile("" : "+v"(tid));
      const int lane = tid & 63, r = lane & 31, h = lane >> 5;
      const int q4 = (lane & 15) >> 2, p4 = lane & 3, blk = (lane >> 4) & 1;
      const float* sc = scb + (c & 1) * S_PAR;
      const int rowbase = KIND == 0 ? b * SEQ + c * 64 : MP + b * 16;
      WG_BAR();
      f32x16 accB[2];
#pragma unroll
      for (int tt = 0; tt < 2; ++tt)
#pragma unroll
        for (int i = 0; i < 16; ++i) accB[tt][i] = 0.f;
#pragma unroll
      for (int d = 0; d < 8; ++d)
#pragma unroll
        for (int s = 0; s < 2; ++s) {
          __builtin_amdgcn_sched_barrier(0);
          const bf16x8 cf = pack8(C[d], s);
#pragma unroll
          for (int tt = 0; tt < 2; ++tt) {
            const char* qp = lds + L_Q + (tt * 32 + r) * L_LD + (d * 32 + 16 * s + 4 * h) * 2;
            const s16x4 lo = *(const s16x4*)qp, hi = *(const s16x4*)(qp + 16);
            const bf16x8 qfr = __builtin_shufflevector(lo, hi, 0, 1, 2, 3, 4, 5, 6, 7);
            accB[tt] = MFMA32(cf, qfr, accB[tt]);
          }
        }
      __builtin_amdgcn_sched_barrier(0);
      bf16x8 vf[4];
      tr_frag4<16 * L_VLD, 4 * L_VLD>(lds_addr(lds + L_V) + (8 * h + q4) * L_VLD + (wave * 32 + 16 * blk + 4 * p4) * 2, vf);
      const float g_end = sc[S_GEND];
#pragma unroll
      for (int d = 0; d < 8; ++d) {
#pragma unroll
        for (int i = 0; i < 16; ++i) C[d][i] *= g_end;
        bf16x8 kf[4];
        tr_frag4<16 * L_LD, 4 * L_LD>(lds_addr(lds + L_K) + (8 * h + q4) * L_LD + (d * 32 + 16 * blk + 4 * p4) * 2, kf);
#pragma unroll
        for (int ks = 0; ks < 4; ++ks) C[d] = MFMA32(kf[ks], vf[ks], C[d]);
      }
      WG_BAR();
#pragma unroll
      for (int tt = 0; tt < 2; ++tt) {
        const int t = tt * 32 + r;
        const float g = sc[S_G + t];
#pragma unroll
        for (int i = 0; i < 16; ++i) accB[tt][i] *= g;
        const char* sp = lds + L_SW + (tt * 32 + r) * L_SWLD + h * 16;
#pragma unroll
        for (int ks = 0; ks < 4; ++ks) accB[tt] = MFMA32(vf[ks], *(const bf16x8*)(sp + ks * 32), accB[tt]);
        const float qn = (sc[S_QN + t] + sc[S_QN + 64 + t]) + (sc[S_QN + 128 + t] + sc[S_QN + 192 + t]);
        float den = sc[S_DS0 + t] + sc[S_DS1 + t] + g * qn;
        den = fmaxf(fabsf(den), sc[S_EMT + t]);
        const float rden = 1.f / den;
        if (t < Lv) {
          bf16_t* dst = H + (size_t)(rowbase + t) * D + hm * 256 + half * 128 + wave * 32;
#pragma unroll
          for (int g4 = 0; g4 < 4; ++g4) {
            u32x2 o; o[0] = pk2(accB[tt][4 * g4] * rden, accB[tt][4 * g4 + 1] * rden); o[1] = pk2(accB[tt][4 * g4 + 2] * rden, accB[tt][4 * g4 + 3] * rden);
            *(u32x2*)(dst + 8 * g4 + 4 * h) = o;
          }
        }
      }
    }
    WG_BAR();
    {
      const int lane = tid0 & 63, r = lane & 31, h = lane >> 5;
      float* co = p.out + (KIND == 0 ? O_CP : O_CS) + bh * 65536 + (size_t)(4 * h) * 256 + half * 128 + wave * 32 + r;
#pragma unroll
      for (int d = 0; d < 8; ++d)
#pragma unroll
        for (int g = 0; g < 4; ++g) {
          co[0] = C[d][4 * g]; co[256] = C[d][4 * g + 1]; co[512] = C[d][4 * g + 2]; co[768] = C[d][4 * g + 3];
          co += 2048; asm volatile("" : "+v"(co));
        }
    }
  } else {
    const int hw = wave - 4;
    float nreg = 0.f, m_prev = 0.f;
    if (KIND == 1) { nreg = p.in[6][bh * 256 + (tid0 - 256)]; m_prev = p.in[7][bh]; }
    u32x4 pq[8], pk[8], pv[4];
    float gi = 0.f, gf = 0.f, g_end_cur = 0.f;
    auto issue_loads = [&](int c, int tid) {
      const int ht = tid - 256, lane = tid & 63;
      const int rowbase = KIND == 0 ? b * SEQ + c * 64 : MP + b * 16;
      const bool tvalid = lane < Lv;
      gi = tvalid ? GIF[(size_t)(rowbase + lane) * 8 + hm] : -1e30f;
      gf = tvalid ? GIF[(size_t)(rowbase + lane) * 8 + 4 + hm] : 0.f;
#pragma unroll
      for (int i = 0; i < 8; ++i) {
        const int cidx = ht + 256 * i, t = cidx >> 5, pc = cidx & 31;
        const int row = rowbase + (t < Lv ? t : Lv - 1);
        pq[i] = *(const u32x4*)(QA + (size_t)row * D + hm * 256 + pc * 8);
        pk[i] = *(const u32x4*)(KA + (size_t)row * D + hm * 256 + pc * 8);
      }
#pragma unroll
      for (int i = 0; i < 4; ++i) {
        const int cidx = ht + 256 * i, t = cidx >> 4, pc = cidx & 15;
        const int row = rowbase + (t < Lv ? t : Lv - 1);
        pv[i] = *(const u32x4*)(Z + (size_t)row * NIN + 5120 + hm * 256 + half * 128 + pc * 8);
      }
    };
    auto scalars = [&](int par, int lane) -> float {
      const bool tvalid = lane < Lv;
      const float lf = tvalid ? (fminf(gf, 0.f) - __logf(1.f + __expf(-fabsf(gf)))) : 0.f;
      float bc = lf;
#pragma unroll
      for (int o = 1; o < 64; o <<= 1) { const float v = __shfl_up(bc, o); if (lane >= o) bc += v; }
      const float a = gi - bc;
      float cm = a;
#pragma unroll
      for (int o = 1; o < 64; o <<= 1) { const float v = __shfl_up(cm, o); if (lane >= o) cm = fmaxf(cm, v); }
      const float mxv = fmaxf(m_prev, cm);
      const float m_t = bc + mxv;
      const float mx_end = __shfl(mxv, 63), bc_end = __shfl(bc, 63);
      const float wend = __expf(a - mx_end);
      g_end_cur = __expf(m_prev - mx_end);
      if (hw == 0) {
        float* sc = scb + par * S_PAR;
        sc[S_MX + lane] = __expf(mx_end - mxv);
        sc[S_G + lane] = __expf(m_prev - mxv);
        sc[S_EMT + lane] = __expf(-m_t);
        if (lane == 0) sc[S_GEND] = g_end_cur;
      }
      m_prev = bc_end + mx_end;
      return wend;
    };
    auto stage_lds = [&](float wend_l, int tid) {
      const int ht = tid - 256;
#pragma unroll
      for (int i = 0; i < 8; ++i) {
        const int cidx = ht + 256 * i, t = cidx >> 5, pc = cidx & 31;
        const float we = __shfl(wend_l, t);
        float f[8]; unpack8(pk[i], f);
        u32x4 o; o[0] = pk2(f[0] * we, f[1] * we); o[1] = pk2(f[2] * we, f[3] * we); o[2] = pk2(f[4] * we, f[5] * we); o[3] = pk2(f[6] * we, f[7] * we);
        *(u32x4*)(lds + L_Q + t * L_LD + pc * 16) = pq[i];
        *(u32x4*)(lds + L_K + t * L_LD + pc * 16) = o;
      }
#pragma unroll
      for (int i = 0; i < 4; ++i) {
        const int cidx = ht + 256 * i, t = cidx >> 4, pc = cidx & 15;
        *(u32x4*)(lds + L_V + t * L_VLD + pc * 16) = pv[i];
      }
    };
    {
      int tid = tid0; asm volatile("" : "+v"(tid));
      issue_loads(0, tid);
      scb[S_NV + (tid - 256)] = nreg;
      const float wend = scalars(0, tid & 63);
      stage_lds(wend, tid);
    }
    for (int c = 0; c < nchunks; ++c) {
      int tid = tid0; asm volatile("" : "+v"(tid));
      const int ht = tid - 256, lane = tid & 63, r = lane & 31, h = lane >> 5;
      float* sc = scb + (c & 1) * S_PAR;
      float* scn = scb + ((c + 1) & 1) * S_PAR;
      const float g_end_c = g_end_cur;
      WG_BAR();
      const bool more = c + 1 < nchunks;
      if (more) issue_loads(c + 1, tid);
      {
        const int t = ht & 63, part = ht >> 6;
        const char* qp = lds + L_Q + t * L_LD + part * 128;
        float s = 0.f;
#pragma unroll
        for (int e = 0; e < 8; ++e) {
          const u32x4 qq = *(const u32x4*)(qp + e * 16); float f[8]; unpack8(qq, f);
#pragma unroll
          for (int z = 0; z < 8; ++z) s += f[z] * sc[S_NV + part * 64 + e * 8 + z];
        }
        sc[S_QN + part * 64 + t] = s;
      }
      if (hw < 3) {
        const int stl = hw == 2 ? 1 : 0, tt = hw == 0 ? 0 : 1;
        f32x16 S, S2;
#pragma unroll
        for (int i = 0; i < 16; ++i) { S[i] = 0.f; S2[i] = 0.f; }
        const char* ka = lds + L_K + (stl * 32 + r) * L_LD + h * 16;
        const char* qa = lds + L_Q + (tt * 32 + r) * L_LD + h * 16;
#pragma unroll 4
        for (int ks = 0; ks < 16; ks += 2) {
          S = MFMA32(*(const bf16x8*)(ka + ks * 32), *(const bf16x8*)(qa + ks * 32), S);
          S2 = MFMA32(*(const bf16x8*)(ka + ks * 32 + 32), *(const bf16x8*)(qa + ks * 32 + 32), S2);
        }
        const int t = tt * 32 + r;
        const float cw = sc[S_MX + t];
        float rs = 0.f;
#pragma unroll
        for (int g = 0; g < 4; ++g) {
          float wv[4];
#pragma unroll
          for (int e = 0; e < 4; ++e) {
            const int s = stl * 32 + 8 * g + 4 * h + e;
            wv[e] = s <= t ? (S[4 * g + e] + S2[4 * g + e]) * cw : 0.f; rs += wv[e];
          }
          u32x2 o; o[0] = pk2(wv[0], wv[1]); o[1] = pk2(wv[2], wv[3]);
          *(u32x2*)(lds + L_SW + t * L_SWLD + (stl * 32 + 8 * g + 4 * h) * 2) = o;
        }
        rs += __shfl_xor(rs, 32);
        if (h == 0) {
          if (hw == 0) { sc[S_DS0 + t] = rs; sc[S_DS1 + t] = 0.f; }
          else if (hw == 1) sc[S_DS0 + t] = rs;
          else sc[S_DS1 + t] = rs;
        }
      } else {
        const int t = lane >> 1, hs = lane & 1;
        u32x4 z; z[0] = 0; z[1] = 0; z[2] = 0; z[3] = 0;
        *(u32x4*)(lds + L_SW + t * L_SWLD + 64 + hs * 32) = z; *(u32x4*)(lds + L_SW + t * L_SWLD + 64 + hs * 32 + 16) = z;
      }
      {
        float s0 = 0.f, s1 = 0.f, s2 = 0.f, s3 = 0.f;
        const char* kp = lds + L_K + ht * 2;
#pragma unroll
        for (int t = 0; t < 64; t += 4) {
          s0 += bflo((unsigned)*(const bf16_t*)(kp + t * L_LD)); s1 += bflo((unsigned)*(const bf16_t*)(kp + (t + 1) * L_LD));
          s2 += bflo((unsigned)*(const bf16_t*)(kp + (t + 2) * L_LD)); s3 += bflo((unsigned)*(const bf16_t*)(kp + (t + 3) * L_LD));
        }
        nreg = g_end_c * nreg + ((s0 + s1) + (s2 + s3));
        scn[S_NV + ht] = nreg;
      }
      float wend = 0.f;
      if (more) wend = scalars((c + 1) & 1, lane);
      WG_BAR();
      if (more) stage_lds(wend, tid);
    }
    WG_BAR();
    if (half == 0) {
      p.out[(KIND == 0 ? O_NP : O_NS) + bh * 256 + (tid0 - 256)] = nreg;
      if (tid0 == 256) p.out[(KIND == 0 ? O_MPP : O_MSS) + bh] = m_prev;
    }
  }
}

DI void mixer_phase(const Params& p, int l, char* lds, int cidx, bool ml_only) {
  unsigned* ctr = (unsigned*)(p.ws + W_MISC) + 16 + cidx;
  int* s_item = (int*)(lds + LDS_BYTES - 16);
  const int total = 32 + 64 + 64 + 2048;
  for (;;) {
    __syncthreads();
    if (threadIdx.x == 0) *s_item = (int)atomicAdd(ctr, 1u);
    __syncthreads();
    const int it = *s_item;
    __syncthreads();
    if (it >= total) break;
    if (ml_only && it >= 96) break;
    if (it < 32) { mlstm_item<0>(p, l, it >> 3, (it >> 1) & 3, it & 1, lds); continue; }
    if (it < 96) { const int x = it - 32; mlstm_item<1>(p, l, x >> 3, (x >> 1) & 3, x & 1, lds); continue; }
    if (it < 160) { attn_item<1>(p, l, (it - 96) >> 3, (it - 96) & 7, 0, lds); continue; }
    { const int x = it - 160; attn_item<0>(p, l, (x & 31) >> 3, x & 7, 63 - (x >> 5), lds); }
  }
}

DI void merge_phase(const Params& p, int l) {
  const bf16_t* Z = (const bf16_t*)(p.ws + W_Z); const bf16_t* H = (const bf16_t*)(p.ws + W_H); bf16_t* Y = (bf16_t*)(p.ws + W_AB);
  const int tidq = otid(); const int lane = tidq & 63, gw = blockIdx.x * 8 + (tidq >> 6), ngw = gridDim.x * 8;
  const float* mhg = p.in[15] + (size_t)l * D;
  for (int row = gw; row < M; row += ngw) {
    const int col = lane * 16;
    const bf16_t* z = Z + (size_t)row * NIN + col;
    float hv[16];
    unpack8(*(const u32x4*)(H + (size_t)row * D + col), hv); unpack8(*(const u32x4*)(H + (size_t)row * D + col + 8), hv + 8);
    float s = 0.f;
#pragma unroll
    for (int e = 0; e < 16; ++e) s += hv[e];
#pragma unroll
    for (int o = 1; o < 16; o <<= 1) s += __shfl_xor(s, o);
    const float mean = s * (1.f / 256.f);
    float s2 = 0.f;
#pragma unroll
    for (int e = 0; e < 16; ++e) { hv[e] -= mean; s2 += hv[e] * hv[e]; }
#pragma unroll
    for (int o = 1; o < 16; o <<= 1) s2 += __shfl_xor(s2, o);
    const float rstd = rsqrtf(s2 * (1.f / 256.f) + LN_EPS);
#pragma unroll
    for (int hh = 0; hh < 2; ++hh) {
      float oa[8], om[8], ga[8], gb[8];
      unpack8(*(const u32x4*)(z + 3072 + hh * 8), oa); unpack8(*(const u32x4*)(z + 6144 + hh * 8), om);
      unpack8(*(const u32x4*)(z + 7168 + hh * 8), ga); unpack8(*(const u32x4*)(z + 8192 + hh * 8), gb);
      const f32x4 g0 = *(const f32x4*)(mhg + col + hh * 8), g1 = *(const f32x4*)(mhg + col + hh * 8 + 4);
      float y[8];
#pragma unroll
      for (int e = 0; e < 8; ++e) {
        const float hn = hv[hh * 8 + e] * rstd * (e < 4 ? g0[e] : g1[e - 4]);
        y[e] = sigmoidf_(ga[e]) * oa[e] + sigmoidf_(gb[e]) * (hn * sigmoidf_(om[e]));
      }
      u32x4 o; o[0] = pk2(y[0], y[1]); o[1] = pk2(y[2], y[3]); o[2] = pk2(y[4], y[5]); o[3] = pk2(y[6], y[7]);
      *(u32x4*)(Y + (size_t)row * D + col + hh * 8) = o;
    }
  }
}

DI void ln_phase(const Params& p, const float* g, const float* bta, bool final_out) {
  const int tidq = otid(); const int lane = tidq & 63, gw = blockIdx.x * 8 + (tidq >> 6), ngw = gridDim.x * 8;
  float* R = (float*)(p.ws + W_R); bf16_t* AB = (bf16_t*)(p.ws + W_AB);
  for (int row = gw; row < M; row += ngw) {
    float* xr = R + (size_t)row * D;
    f32x4 v[4]; float s = 0.f;
#pragma unroll
    for (int j = 0; j < 4; ++j) { v[j] = *(const f32x4*)(xr + j * 256 + lane * 4); s += (v[j][0] + v[j][1]) + (v[j][2] + v[j][3]); }
    const float mean = wave_sum(s) * (1.f / D);
    float s2 = 0.f;
#pragma unroll
    for (int j = 0; j < 4; ++j) { v[j] = v[j] - mean; s2 += (v[j][0] * v[j][0] + v[j][1] * v[j][1]) + (v[j][2] * v[j][2] + v[j][3] * v[j][3]); }
    const float rstd = rsqrtf(wave_sum(s2) * (1.f / D) + LN_EPS);
    float* dst = final_out ? (row < MP ? p.out + O_YP + (size_t)row * D : p.out + O_YS + (size_t)(row - MP) * D) : xr;
#pragma unroll
    for (int j = 0; j < 4; ++j) {
      const int c = j * 256 + lane * 4;
      const f32x4 gg = *(const f32x4*)(g + c), bb = *(const f32x4*)(bta + c);
      f32x4 o = v[j] * rstd * gg + bb;
      *(f32x4*)(dst + c) = o;
      if (!final_out) { u32x2 ob; ob[0] = pk2(o[0], o[1]); ob[1] = pk2(o[2], o[3]); *(u32x2*)(AB + (size_t)row * D + c) = ob; }
    }
  }
}

DI float gelu_f(float v) {
  const float av = fabsf(v), d = av * 0.2316418882f + 1.0f;
  const float t = __builtin_amdgcn_rcpf(d);
  float q = t * 0.5307027145f + (-0.7265760135f); q = q * t + 0.7107068705f; q = q * t + (-0.142248368f); q = q * t + 0.127414796f; q = q * t;
  const float e = __builtin_amdgcn_exp2f((v * v) * (-0.72134752044f));
  const float m = v * (q * e), r = v - m;
  return v < 0.f ? m : r;
}
DI void ffnconv_phase(const Params& p, int l) {
  const bf16_t* U = (const bf16_t*)(p.ws + W_Z); bf16_t* HF = (bf16_t*)(p.ws + W_Z + (size_t)M * NUP * 2);
  const float* cw = p.in[20] + (size_t)l * 3 * NUP; const float* cb = p.in[21] + (size_t)l * NUP;
  const unsigned total = (unsigned)(M / 4) * 352u;
  for (unsigned it = blockIdx.x * NTH + (unsigned)otid(); it < total; it += gridDim.x * NTH) {
    const unsigned rg = it / 352u, cc = it - rg * 352u;
    const int col = (int)cc * 8, row0 = (int)rg * 4;
    int t0; const float* st = nullptr;
    if (row0 < MP) t0 = row0 & (SEQ - 1); else { t0 = (row0 - MP) & 15; st = p.in[8] + ((size_t)(l * 8 + ((row0 - MP) >> 4)) * 2) * NUP; }
    float gl[4][8];
#pragma unroll
    for (int hf = 0; hf < 2; ++hf) {
      const int c2 = col + hf * DFF;
      float w[3][8], bias[8], x[6][8];
#pragma unroll
      for (int j = 0; j < 3; ++j) { const f32x4 a = *(const f32x4*)(cw + j * NUP + c2), b2 = *(const f32x4*)(cw + j * NUP + c2 + 4);
        w[j][0] = a[0]; w[j][1] = a[1]; w[j][2] = a[2]; w[j][3] = a[3]; w[j][4] = b2[0]; w[j][5] = b2[1]; w[j][6] = b2[2]; w[j][7] = b2[3]; }
      { const f32x4 a = *(const f32x4*)(cb + c2), b2 = *(const f32x4*)(cb + c2 + 4);
        bias[0] = a[0]; bias[1] = a[1]; bias[2] = a[2]; bias[3] = a[3]; bias[4] = b2[0]; bias[5] = b2[1]; bias[6] = b2[2]; bias[7] = b2[3]; }
#pragma unroll
      for (int j = 0; j < 6; ++j) {
        const int t = t0 - 2 + j;
        if (t >= 0) unpack8(*(const u32x4*)(U + (size_t)(row0 - 2 + j) * NUP + c2), x[j]);
        else if (st) { const float* sp = st + (size_t)(2 + t) * NUP + c2; const f32x4 a = *(const f32x4*)sp, b2 = *(const f32x4*)(sp + 4);
          x[j][0] = a[0]; x[j][1] = a[1]; x[j][2] = a[2]; x[j][3] = a[3]; x[j][4] = b2[0]; x[j][5] = b2[1]; x[j][6] = b2[2]; x[j][7] = b2[3]; }
        else {
#pragma unroll
          for (int e = 0; e < 8; ++e) x[j][e] = 0.f; }
      }
#pragma unroll
      for (int a = 0; a < 4; ++a) {
        float o[8];
#pragma unroll
        for (int e = 0; e < 8; ++e) {
          const float u = bias[e] + w[0][e] * x[a][e] + w[1][e] * x[a + 1][e] + w[2][e] * x[a + 2][e];
          if (hf == 0) gl[a][e] = gelu_f(u); else o[e] = gl[a][e] * u;
        }
        if (hf == 1) {
          u32x4 ov; ov[0] = pk2(o[0], o[1]); ov[1] = pk2(o[2], o[3]); ov[2] = pk2(o[4], o[5]); ov[3] = pk2(o[6], o[7]);
          *(u32x4*)(HF + (size_t)(row0 + a) * DFF + col) = ov;
        }
      }
    }
  }
}

#define XB_TMO      128
#define XB_XCNT(j)  (256  + 64 * (j))
#define XB_XSUB(j)  (1280 + 64 * (j))
#define XB_XGEN(j)  (2304 + 64 * (j))
#define XB_TOP      3328
#define XB_TOPGEN   3392
#define XCD_BAR_WORDS 3456
#define XB_SPIN_CAP (1u << 18)
#define XLAS __attribute__((address_space(3)))
DI unsigned xb_ld(unsigned* p)              { return __hip_atomic_load(p, __ATOMIC_RELAXED, __HIP_MEMORY_SCOPE_AGENT); }
DI unsigned xb_add(unsigned* p, unsigned v) { return __hip_atomic_fetch_add(p, v, __ATOMIC_RELAXED, __HIP_MEMORY_SCOPE_AGENT); }
DI unsigned xb_xcc_id() { return (unsigned)__builtin_amdgcn_s_getreg((3 << 11) | 20) & 0xFu; }
#define XB_SPIN(cond, bar) do { unsigned _sp = 0; while (cond) { __builtin_amdgcn_s_sleep(1); \
    if ((++_sp & 255u) == 0u) { if (xb_ld(&(bar)[XB_TMO])) break; if (_sp > XB_SPIN_CAP) { atomicAdd(&(bar)[XB_TMO], 1u); break; } } } } while (0)
struct XcdBarrier { unsigned* bar; unsigned x; volatile XLAS unsigned* st; };
DI XcdBarrier xcd_barrier_post(unsigned* bar, volatile XLAS unsigned* st) {
  XcdBarrier b; b.bar = bar; b.x = xb_xcc_id(); b.st = st;
  if (threadIdx.x == 0) (void)xb_add(&bar[XB_XCNT(b.x)], 1u);
  return b;
}
DI void xcd_barrier_complete(unsigned* bar, unsigned x, unsigned& nloc, unsigned& nx) {
  const unsigned G = gridDim.x * gridDim.y * gridDim.z;
  unsigned sum, cnt, mine, sp = 0u;
  for (;;) {
    sum = 0u; cnt = 0u; mine = 0u;
#pragma unroll
    for (unsigned j = 0; j < 16; ++j) { const unsigned c = xb_ld(&bar[XB_XCNT(j)]); sum += c; cnt += (c > 0u) ? 1u : 0u; mine = (j == x) ? c : mine; }
    if (sum == G) break;
    __builtin_amdgcn_s_sleep(1);
    if ((++sp & 255u) == 0u) { if (xb_ld(&bar[XB_TMO])) break; if (sp > XB_SPIN_CAP) { atomicAdd(&bar[XB_TMO], 1u); break; } }
  }
  nloc = mine > 0u ? mine : 1u; nx = cnt > 0u ? cnt : 1u;
}
DI void xcd_barrier(const XcdBarrier& b) {
  asm volatile("s_waitcnt vmcnt(0)" ::: "memory");
  __syncthreads();
  if (threadIdx.x == 0) {
    unsigned* bar = b.bar;
    __builtin_amdgcn_s_waitcnt(0);
    unsigned nloc = b.st[0], nx = b.st[1];
    if (nloc == 0u) { xcd_barrier_complete(bar, b.x, nloc, nx); b.st[0] = nloc; b.st[1] = nx; }
    const unsigned old = xb_add(&bar[XB_XSUB(b.x)], 1u);
    const unsigned gen = old / nloc;
    if (old + 1u == (gen + 1u) * nloc) {
      __builtin_amdgcn_fence(__ATOMIC_RELEASE, "agent");
      asm volatile("s_waitcnt vmcnt(0)" ::: "memory");
      const unsigned og = xb_add(&bar[XB_TOP], 1u);
      const unsigned tg = og / nx;
      if (og + 1u == (tg + 1u) * nx) xb_add(&bar[XB_TOPGEN], 1u);
      else XB_SPIN(xb_ld(&bar[XB_TOPGEN]) == tg, bar);
      __builtin_amdgcn_fence(__ATOMIC_ACQUIRE, "agent");
      xb_add(&bar[XB_XGEN(b.x)], 1u);
      asm volatile("s_waitcnt vmcnt(0)" ::: "memory");
    } else {
      XB_SPIN(xb_ld(&bar[XB_XGEN(b.x)]) == gen, bar);
      __builtin_amdgcn_fence(__ATOMIC_ACQUIRE, "agent");
      asm volatile("s_waitcnt vmcnt(0)" ::: "memory");
    }
  }
  __syncthreads();
}

constexpr int NPH = 21;
DI void run_phase(const Params& p, int ph, char* lds) {
#ifndef ONLY
  if (ph == 0) { phase0(p, lds); return; }
#else
  if (ph == 0) return;
#endif
  const int l = (ph - 1) / 10, s = (ph - 1) % 10;
#ifdef ONLY
  if (s != ONLY) return;
#endif
  switch (s) {
    case 0: gemm_phase<EPI_IN>(p, l, (const bf16_t*)(p.ws + W_AB), D, (const bf16_t*)(p.ws + W_WIN) + (size_t)l * NIN * D, D, NIN / 256, lds); break;
    case 1: qkconv_phase(p, l); gif_phase(p, l, lds); break;
    case 2: mixer_phase(p, l, lds, l, false); break;
    case 3: merge_phase(p, l); break;
    case 4: gemm_phase<EPI_OUT>(p, l, (const bf16_t*)(p.ws + W_AB), D, (const bf16_t*)(p.ws + W_WOUT) + (size_t)l * D * D, D, D / 256, lds); break;
    case 5: ln_phase(p, p.in[17] + l * D, p.in[18] + l * D, false); break;
    case 6: gemm_phase<EPI_UP>(p, l, (const bf16_t*)(p.ws + W_AB), D, (const bf16_t*)(p.ws + W_WUP) + (size_t)l * NUP * D, D, NUP / 256, lds); break;
    case 7: ffnconv_phase(p, l); break;
    case 8: gemm_phase<EPI_DOWN>(p, l, (const bf16_t*)(p.ws + W_Z + (size_t)M * NUP * 2), DFF, (const bf16_t*)(p.ws + W_WDN) + (size_t)l * D * DFF, DFF, D / 256, lds); break;
    case 9: ln_phase(p, p.in[23] + l * D, p.in[24] + l * D, l == 1); break;
  }
}

__global__ void __launch_bounds__(NTH) mega(Params p, int ph_lo, int ph_hi) {
  extern __shared__ __attribute__((aligned(16))) char lds[];
#if MULTI_LAUNCH
  for (int ph = ph_lo; ph < ph_hi; ++ph) run_phase(p, ph, lds);
#else
  cg::grid_group grid = cg::this_grid();
  phase0(p, lds);
  grid.sync();
  volatile XLAS unsigned* xst = (volatile XLAS unsigned*)((XLAS char*)lds + (LDS_BYTES - 32));
  if (threadIdx.x == 0) { xst[0] = 0u; xst[1] = 0u; }
  __syncthreads();
  const XcdBarrier xb = xcd_barrier_post((unsigned*)(p.ws + W_BAR), xst);
#define GSYNC() xcd_barrier(xb)
  for (int l = 0; l < 2; ++l) {
    gemm_phase<EPI_IN>(p, l, (const bf16_t*)(p.ws + W_AB), D, (const bf16_t*)(p.ws + W_WIN) + (size_t)l * NIN * D, D, NIN / 256, lds);
    GSYNC();
#ifdef PROBE_GIN2
    gemm_phase<EPI_IN>(p, l, (const bf16_t*)(p.ws + W_AB), D, (const bf16_t*)(p.ws + W_WIN) + (size_t)l * NIN * D, D, NIN / 256, lds);
    GSYNC();
#endif
    qkconv_phase(p, l); gif_phase(p, l, lds);
    GSYNC();
#if defined(PROBE_EW2) || defined(PROBE_QKC2)
    qkconv_phase(p, l); gif_phase(p, l, lds);
    GSYNC();
#endif
    mixer_phase(p, l, lds, l, false);
    GSYNC();
#ifdef PROBE_ML2
    mixer_phase(p, l, lds, l + 2, true);
    GSYNC();
#endif
#ifdef PROBE_MIX2
    mixer_phase(p, l, lds, l + 2, false);
    GSYNC();
#endif
    merge_phase(p, l);
    GSYNC();
#ifdef PROBE_SYNC
    for (int q = 0; q < 20; ++q) GSYNC();
#endif
#if defined(PROBE_EW2) || defined(PROBE_MRG2)
    merge_phase(p, l);
    GSYNC();
#endif
    gemm_phase<EPI_OUT>(p, l, (const bf16_t*)(p.ws + W_AB), D, (const bf16_t*)(p.ws + W_WOUT) + (size_t)l * D * D, D, D / 256, lds);
    GSYNC();
    ln_phase(p, p.in[17] + l * D, p.in[18] + l * D, false);
    GSYNC();
    gemm_phase<EPI_UP>(p, l, (const bf16_t*)(p.ws + W_AB), D, (const bf16_t*)(p.ws + W_WUP) + (size_t)l * NUP * D, D, NUP / 256, lds);
    GSYNC();
    ffnconv_phase(p, l);
    GSYNC();
#if defined(PROBE_EW2) || defined(PROBE_FFC2)
    ffnconv_phase(p, l);
    GSYNC();
#endif
    gemm_phase<EPI_DOWN>(p, l, (const bf16_t*)(p.ws + W_Z + (size_t)M * NUP * 2), DFF, (const bf16_t*)(p.ws + W_WDN) + (size_t)l * D * DFF, DFF, D / 256, lds);
    GSYNC();
    ln_phase(p, p.in[23] + l * D, p.in[24] + l * D, l == 1);
    if (l == 0) GSYNC();
  }
#endif
}

extern "C" void kernel_launch(void* const* d_in, const int* in_sizes, int n_in, void* d_out, int out_size, void* d_ws, size_t ws_size, hipStream_t stream) {
  static int grid = 0;
  if (grid == 0) {
    if (n_in != 25 || (size_t)out_size != O_END || ws_size < W_END) { fprintf(stderr, "kernel_launch: unexpected sizes n_in %d out %d (want %zu) ws %zu (want %zu)\n", n_in, out_size, (size_t)O_END, ws_size, (size_t)W_END); grid = -1; return; }
    int dev = 0, cus = 0, per_cu = 0;
    hipGetDevice(&dev);
    hipDeviceGetAttribute(&cus, hipDeviceAttributeMultiprocessorCount, dev);
    if (hipFuncSetAttribute((const void*)mega, hipFuncAttributeMaxDynamicSharedMemorySize, LDS_BYTES) != hipSuccess) { fprintf(stderr, "hipFuncSetAttribute failed\n"); grid = -1; return; }
    hipOccupancyMaxActiveBlocksPerMultiprocessor(&per_cu, (const void*)mega, NTH, LDS_BYTES);
    if (per_cu < 1) per_cu = 1;
    grid = cus * 1;
    (void)hipGetLastError();
  }
  if (grid < 0) return;
  Params p{};
  for (int i = 0; i < 25; ++i) p.in[i] = (const float*)d_in[i];
  p.out = (float*)d_out; p.ws = (unsigned char*)d_ws;
#if MULTI_LAUNCH
  for (int ph = 0; ph < NPH; ++ph) hipLaunchKernelGGL(mega, dim3(grid), dim3(NTH), LDS_BYTES, stream, p, ph, ph + 1);
#else
  int lo = 0, hi = NPH;
  void* args[] = {&p, &lo, &hi};
  hipError_t e = hipLaunchCooperativeKernel((const void*)mega, dim3(grid), dim3(NTH), args, LDS_BYTES, stream);
  if (e != hipSuccess) fprintf(stderr, "cooperative launch failed: %s (grid %d)\n", hipGetErrorString(e), grid);
#endif
}
```

```cpp
#include <hip/hip_runtime.h>
#include <hip/hip_cooperative_groups.h>
#include <cstdio>
namespace cg = cooperative_groups;

#ifndef MULTI_LAUNCH
#define MULTI_LAUNCH 0
#endif

typedef unsigned short bf16_t;
typedef short bf16x8 __attribute__((ext_vector_type(8)));
typedef short s16x4 __attribute__((ext_vector_type(4)));
typedef float f32x16 __attribute__((ext_vector_type(16)));
typedef float f32x4 __attribute__((ext_vector_type(4)));
typedef unsigned u32x4 __attribute__((ext_vector_type(4)));
typedef unsigned u32x2 __attribute__((ext_vector_type(2)));
#define DI __device__ __forceinline__
#define MFMA32(a, b, c) __builtin_amdgcn_mfma_f32_32x32x16_bf16((a), (b), (c), 0, 0, 0)

constexpr int NTH = 512;
constexpr int D = 1024, SEQ = 8192, NB = 4, MP = NB * SEQ, MS = 128, M = MP + MS, NTM = 129;
constexpr int DIN = 9224, NIN = 9216, DFF = 2816, NUP = 5632;
constexpr int PAST = 4096, NKS = PAST + 16;
constexpr float ALPHA = 1.4142135623730951f;
constexpr float LN_EPS = 1e-5f;
constexpr float LOG2E = 1.4426950408889634f;

constexpr size_t O_YP = 0;
constexpr size_t O_YS = O_YP + (size_t)MP * D;
constexpr size_t O_KP = O_YS + (size_t)MS * D;
constexpr size_t O_VP = O_KP + (size_t)2 * MP * 1024;
constexpr size_t O_MCP = O_VP + (size_t)2 * MP * 1024;
constexpr size_t O_CP = O_MCP + (size_t)2 * 4 * 3 * 2048;
constexpr size_t O_NP = O_CP + (size_t)2 * 4 * 4 * 65536;
constexpr size_t O_MPP = O_NP + (size_t)2 * 4 * 4 * 256;
constexpr size_t O_FCP = O_MPP + 32;
constexpr size_t O_KS = O_FCP + (size_t)2 * 4 * 2 * NUP;
constexpr size_t O_VS = O_KS + (size_t)2 * MS * 1024;
constexpr size_t O_MCS = O_VS + (size_t)2 * MS * 1024;
constexpr size_t O_CS = O_MCS + (size_t)2 * 8 * 3 * 2048;
constexpr size_t O_NS = O_CS + (size_t)2 * 8 * 4 * 65536;
constexpr size_t O_MSS = O_NS + (size_t)2 * 8 * 4 * 256;
constexpr size_t O_FCS = O_MSS + 64;
constexpr size_t O_END = O_FCS + (size_t)2 * 8 * 2 * NUP;

constexpr size_t W_Z = 0;
constexpr size_t W_H = W_Z + (size_t)M * NIN * 2;
constexpr size_t W_AB = W_H + (size_t)M * D * 2;
constexpr size_t W_KA = W_AB + (size_t)M * D * 2;
constexpr size_t W_R = W_KA + (size_t)M * D * 2;
constexpr size_t W_WIN = W_R + (size_t)M * D * 4;
constexpr size_t W_WOUT = W_WIN + (size_t)2 * NIN * D * 2;
constexpr size_t W_WUP = W_WOUT + (size_t)2 * D * D * 2;
constexpr size_t W_WDN = W_WUP + (size_t)2 * NUP * D * 2;
constexpr size_t W_GIF = W_WDN + (size_t)2 * D * DFF * 2;
constexpr size_t W_ROPE = W_GIF + (size_t)M * 8 * 4;
constexpr size_t W_MISC = W_ROPE + (size_t)8192 * 32 * 8;
constexpr size_t W_BAR = W_MISC + 4096;
constexpr size_t W_END = W_BAR + 16384;

struct Params {
  const float* in[25];
  float* out;
  unsigned char* ws;
};

DI unsigned f2bf(float x) { unsigned u = __float_as_uint(x); u += 0x7fffu + ((u >> 16) & 1u); return u >> 16; }
typedef __bf16 bf16v2 __attribute__((ext_vector_type(2)));
typedef float f32x2 __attribute__((ext_vector_type(2)));
DI unsigned pk2(float a, float b) { f32x2 v; v[0] = a; v[1] = b; return __builtin_bit_cast(unsigned, __builtin_convertvector(v, bf16v2)); }
DI float bflo(unsigned u) { return __uint_as_float(u << 16); }
DI float bfhi(unsigned u) { return __uint_as_float(u & 0xffff0000u); }
DI float sigmoidf_(float x) { return __builtin_amdgcn_rcpf(1.f + __builtin_amdgcn_exp2f(-1.4426950408889634f * x)); }
DI float wave_sum(float v) {
#pragma unroll
  for (int o = 1; o < 64; o <<= 1) v += __shfl_xor(v, o);
  return v;
}
DI int crow(int i, int h) { return (i & 3) + 8 * (i >> 2) + 4 * h; }
DI bf16x8 pack8(const f32x16& x, int s) {
  u32x4 p;
  p[0] = pk2(x[8 * s + 0], x[8 * s + 1]); p[1] = pk2(x[8 * s + 2], x[8 * s + 3]);
  p[2] = pk2(x[8 * s + 4], x[8 * s + 5]); p[3] = pk2(x[8 * s + 6], x[8 * s + 7]);
  return __builtin_bit_cast(bf16x8, p);
}
DI void unpack8(u32x4 v, float* f) {
  f[0] = bflo(v[0]); f[1] = bfhi(v[0]); f[2] = bflo(v[1]); f[3] = bfhi(v[1]);
  f[4] = bflo(v[2]); f[5] = bfhi(v[2]); f[6] = bflo(v[3]); f[7] = bfhi(v[3]);
}
typedef __attribute__((address_space(3))) s16x4 lds_s16x4;
DI bf16x8 tr_frag(unsigned a_lo, unsigned a_hi) {
  const s16x4 lo = __builtin_amdgcn_ds_read_tr16_b64_v4i16((lds_s16x4*)(size_t)a_lo);
  const s16x4 hi = __builtin_amdgcn_ds_read_tr16_b64_v4i16((lds_s16x4*)(size_t)a_hi);
  return __builtin_shufflevector(lo, hi, 0, 1, 2, 3, 4, 5, 6, 7);
}
template <int STEP, int HIOFF>
DI void tr_frag4(unsigned a, bf16x8 (&f)[4]) {
#pragma unroll
  for (int i = 0; i < 4; ++i) f[i] = tr_frag(a + i * STEP, a + i * STEP + HIOFF);
}
DI int otid() { int t = threadIdx.x; asm volatile("" : "+v"(t)); return t; }
DI int uni(int v) { return __builtin_amdgcn_readfirstlane(v); }
DI unsigned lds_addr(const void* p) { return (unsigned)(size_t)p; }

DI const float* xrow_ptr(const Params& p, int l, int row) {
  if (l == 0) return row < MP ? p.in[0] + (size_t)row * D : p.in[1] + (size_t)(row - MP) * D;
  return (const float*)(p.ws + W_R) + (size_t)row * D;
}

DI void transpose_w(const float* W, int K, int N, int src_ld, bf16_t* WT, bool remap, char* lds) {
  float* scr = (float*)lds;
  const int nkb = K / 64, nnb = N / 64, tid = otid();
  for (int it = blockIdx.x; it < nkb * nnb; it += gridDim.x) {
    const int kb = it / nnb, nb = it % nnb, k0 = kb * 64, n0 = nb * 64;
    const int ns = (remap && n0 >= 7168) ? n0 + 8 : n0;
#pragma unroll
    for (int i = 0; i < 8; ++i) {
      const int kk = (tid >> 6) + 8 * i, nn = tid & 63;
      scr[kk * 65 + nn] = W[(size_t)(k0 + kk) * src_ld + ns + nn];
    }
    __syncthreads();
    {
      const int n = tid >> 3, c = tid & 7;
      const float* s = scr + (8 * c) * 65 + n;
      u32x4 o;
      o[0] = pk2(s[0], s[65]); o[1] = pk2(s[2 * 65], s[3 * 65]); o[2] = pk2(s[4 * 65], s[5 * 65]); o[3] = pk2(s[6 * 65], s[7 * 65]);
      const int nd = (remap && n0 < 2048) ? ((n < 32) ? 2 * n : 2 * (n - 32) + 1) : n;
      *(u32x4*)(WT + (size_t)(n0 + nd) * K + k0 + 8 * c) = o;
    }
    __syncthreads();
  }
}

DI void phase0(const Params& p, char* lds) {
  const int tid = otid();
  for (int l = 0; l < 2; ++l) {
    transpose_w(p.in[9] + (size_t)l * D * DIN, D, NIN, DIN, (bf16_t*)(p.ws + W_WIN) + (size_t)l * NIN * D, true, lds);
    transpose_w(p.in[16] + (size_t)l * D * D, D, D, D, (bf16_t*)(p.ws + W_WOUT) + (size_t)l * D * D, false, lds);
    transpose_w(p.in[19] + (size_t)l * D * NUP, D, NUP, NUP, (bf16_t*)(p.ws + W_WUP) + (size_t)l * NUP * D, false, lds);
    transpose_w(p.in[22] + (size_t)l * DFF * D, DFF, D, D, (bf16_t*)(p.ws + W_WDN) + (size_t)l * D * DFF, false, lds);
  }
  bf16_t* ab = (bf16_t*)(p.ws + W_AB);
  for (size_t c = (size_t)blockIdx.x * NTH + tid; c < (size_t)M * 128; c += (size_t)gridDim.x * NTH) {
    const int row = (int)(c >> 7), cc = (int)(c & 127);
    const float* src = xrow_ptr(p, 0, row) + cc * 8;
    f32x4 a = *(const f32x4*)src, b = *(const f32x4*)(src + 4);
    u32x4 o; o[0] = pk2(a[0], a[1]); o[1] = pk2(a[2], a[3]); o[2] = pk2(b[0], b[1]); o[3] = pk2(b[2], b[3]);
    *(u32x4*)(ab + (size_t)row * D + cc * 8) = o;
  }
  float2* rope = (float2*)(p.ws + W_ROPE);
  for (int i = blockIdx.x * NTH + tid; i < 8192 * 32; i += gridDim.x * NTH) {
    const int pos = i >> 5, d = i & 31;
    const double inv = exp2(-(double)d * (13.287712379549449 / 32.0));
    double ang = (double)pos * inv;
    const double twopi = 6.283185307179586476925;
    ang -= twopi * rint(ang / twopi);
    float s, c; sincosf((float)ang, &s, &c);
    rope[i] = make_float2(c, s);
  }
  if (blockIdx.x == 0 && tid < 128) {
    const int l = tid >> 6, ln = tid & 63;
    const float* lp = p.in[13] + (size_t)l * 4 * 64;
    const float s1 = wave_sum(lp[ln] * lp[64 + ln]), s2 = wave_sum(lp[128 + ln] * lp[192 + ln]);
    const float lam_init = (l == 0) ? 0.2f : (0.8f - 0.6f * 0.74081822068171788f);
    if (ln == 0) ((float*)(p.ws + W_MISC))[l] = __expf(s1) - __expf(s2) + lam_init;
  }
  if (blockIdx.x == 0 && tid < 8) ((unsigned*)(p.ws + W_MISC))[16 + tid] = 0u;
  if (blockIdx.x == 0) for (int i = tid; i < 3456; i += NTH) ((unsigned*)(p.ws + W_BAR))[i] = 0u;
}

namespace pg8 {
#define PG8_LAS __attribute__((address_space(3)))
typedef unsigned short bf16_t;
typedef short bf16x8 __attribute__((ext_vector_type(8)));
typedef float f32x4 __attribute__((ext_vector_type(4)));
typedef unsigned u32x4 __attribute__((ext_vector_type(4)));
constexpr int BM = 256, BK = 64, HALF = 128, HTB = HALF * BK * 2  , STAGE_BYTES = 8 * HTB, NXCD = 8, WGM = 8;

__host__ __device__ __forceinline__ int lds_byte(int r, int c) { const int st = (r >> 4) * 2 + (c >> 5), rr = r & 15, cc = c & 31, ob = rr * 64 + cc * 2; return st * 1024 + (ob ^ (((ob >> 9) & 1) << 5)); }
__host__ __device__ __forceinline__ void stage_rc(int b, int& R, int& C) { const int st = b / 1024, sb = b % 1024, swz = sb ^ (((sb >> 9) & 1) << 5); R = (st >> 1) * 16 + swz / 64; C = (st & 1) * 32 + (swz % 64) / 2; }
__host__ __device__ __forceinline__ int perm32(int rho) { const int n = rho >> 4, i = rho & 15; return 8 * (i >> 2) + 4 * n + (i & 3); }

struct Unit { int pm, pn; };
struct Gemm { const bf16_t* A; const bf16_t* Bt; int M, N, K; };

struct StaticOrder {
    int nM, nN, nwg, G, c;
    __host__ __device__ void init(int M, int N, int G_, int c_) { nM = M / BM; nN = N / BM; nwg = nM * nN; G = G_; c = c_; }
    __host__ __device__ bool next(int i, Unit& u) const {
        const long L = (long)i * G + c; if (L >= nwg) return false;
        int wgid = (int)L; { const int q = nwg / NXCD, r = nwg % NXCD, xcd = wgid % NXCD, off = wgid / NXCD; wgid = (xcd < r ? xcd * (q + 1) : r * (q + 1) + (xcd - r) * q) + off; }
        const int nig = WGM * nN, gid = wgid / nig, fm = gid * WGM, gsz = (nM - fm) < WGM ? (nM - fm) : WGM;
        u.pm = fm + ((wgid % nig) % gsz); u.pn = (wgid % nig) / gsz; return true;
    }
    __device__ __forceinline__ void a_ready(const Unit&) const {}
    __device__ __forceinline__ void done(const Unit&) const {}
};
template <class Epi, class Sched, bool STAMP = false>
__device__ __forceinline__ void gemm_phase(PG8_LAS unsigned char* lds, const Gemm g, const Sched& S, const Epi& E, unsigned long long* stamps) {
    const int tid = otid(), wid = __builtin_amdgcn_readfirstlane(tid >> 6), lane = tid & 63, wr = wid >> 2, wc = wid & 3, fr = lane & 15, fq = lane >> 4;
    const int K = g.K, nt = K / BK;
    int ts_lo = 0, ts_hi = 0, nts = 0; const unsigned long long rt_entry = STAMP ? (unsigned long long)wall_clock64() : 0ull;
#define PG8_STAMP() do { if (STAMP && wid == 0 && nts < 64) { const unsigned long long _c = (unsigned long long)clock64(); \
        ts_lo = (lane == nts) ? (int)(unsigned)_c : ts_lo; ts_hi = (lane == nts) ? (int)(unsigned)(_c >> 32) : ts_hi; ++nts; } } while (0)
    PG8_STAMP();
    unsigned voffA[2], voffB[2];
#pragma unroll
    for (int i = 0; i < 2; ++i) { int R, C; stage_rc(tid * 16 + i * 8192, R, C); const int Rb = Epi::PERM ? ((R & ~31) + perm32(R & 31)) : R;
        voffA[i] = (unsigned)(R * K + C) * 2u; voffB[i] = (unsigned)(Rb * K + C) * 2u; }
    const size_t kstep = (size_t)(BK * 2);
    const size_t hstep = (size_t)HALF * K * 2;
    const size_t tstep = 2 * hstep;
    const unsigned ldsw = (unsigned)wid * 1024u;
    const int aoff = lds_byte(wr * 64 + fr, fq * 8), boff = lds_byte(wc * 32 + fr, fq * 8);
#define PG8_SA(b, h) (((b) * 2 + (h)) * HTB)
#define PG8_SB(b, h) ((4 + (b) * 2 + (h)) * HTB)
#define PG8_STAGE(bufoff, gbase, voff) do { _Pragma("unroll") for (int _i = 0; _i < 2; ++_i) \
        __builtin_amdgcn_global_load_lds((const unsigned*)((const char*)(gbase) + (voff)[_i]), (PG8_LAS unsigned*)(lds + (bufoff) + ldsw + _i * 8192), 16, 0, 0); } while (0)
#define PG8_LDA(dst, b, h) do { _Pragma("unroll") for (int m = 0; m < 4; ++m) _Pragma("unroll") for (int k = 0; k < 2; ++k) dst[m][k] = *(const PG8_LAS bf16x8*)(lds + PG8_SA(b, h) + aoff + m * 2048 + k * 1024); } while (0)
#define PG8_LDB(dst, b, h) do { _Pragma("unroll") for (int n = 0; n < 2; ++n) _Pragma("unroll") for (int k = 0; k < 2; ++k) dst[n][k] = *(const PG8_LAS bf16x8*)(lds + PG8_SB(b, h) + boff + n * 2048 + k * 1024); } while (0)
#define PG8_MMA(ai, bj, At, Bt) do { __builtin_amdgcn_s_setprio(1); _Pragma("unroll") for (int m = 0; m < 4; ++m) _Pragma("unroll") for (int n = 0; n < 2; ++n) _Pragma("unroll") for (int k = 0; k < 2; ++k) \
        acc[ai][bj][m][n] = __builtin_amdgcn_mfma_f32_16x16x32_bf16(Bt[n][k], At[m][k], acc[ai][bj][m][n], 0, 0, 0); __builtin_amdgcn_s_setprio(0); } while (0)
#define PG8_WAIT_V(n) asm volatile("s_waitcnt vmcnt(" #n ")" ::: "memory")
#define PG8_WAIT_L(n) asm volatile("s_waitcnt lgkmcnt(" #n ")" ::: "memory")
#define PG8_BAR __builtin_amdgcn_s_barrier()
#define PG8_SCHED __builtin_amdgcn_sched_barrier(0)
    Unit cur, nxt; int ui = 0;
    if (!S.next(0, cur)) return;
    f32x4 acc[2][2][4][2];
#pragma unroll
    for (int a = 0; a < 2; ++a)
#pragma unroll
        for (int b = 0; b < 2; ++b)
#pragma unroll
            for (int m = 0; m < 4; ++m)
#pragma unroll
                for (int n = 0; n < 2; ++n) acc[a][b][m][n] = (f32x4){0.f, 0.f, 0.f, 0.f};
    bf16x8 At[4][2], B0[2][2], B1[2][2];
    const char* cA = (const char*)g.A + (size_t)cur.pm * tstep; const char* cB = (const char*)g.Bt + (size_t)cur.pn * tstep;
    S.a_ready(cur);
    PG8_STAGE(PG8_SB(0, 0), cB, voffB); PG8_STAGE(PG8_SA(0, 0), cA, voffA); PG8_STAGE(PG8_SB(0, 1), cB + hstep, voffB); PG8_STAGE(PG8_SA(0, 1), cA + hstep, voffA);
    if (wr == 1) PG8_BAR;
    PG8_WAIT_V(4); PG8_BAR;
    PG8_STAGE(PG8_SB(1, 0), cB + kstep, voffB); PG8_STAGE(PG8_SA(1, 0), cA + kstep, voffA); PG8_STAGE(PG8_SB(1, 1), cB + hstep + kstep, voffB);
    PG8_WAIT_V(6); PG8_BAR;
    PG8_STAMP();
    for (;;) {
        const bool has_next = S.next(ui + 1, nxt);
        const char* nA = has_next ? (const char*)g.A + (size_t)nxt.pm * tstep : cA; const char* nB = has_next ? (const char*)g.Bt + (size_t)nxt.pn * tstep : cB;
        for (int t = 0; t < nt; t += 2) {
            const bool last = (t == nt - 2);
            const char* a1 = cA + (size_t)(t + 1) * kstep;
            const char* a2 = last ? nA : cA + (size_t)(t + 2) * kstep; const char* b2 = last ? nB : cB + (size_t)(t + 2) * kstep;
            const char* a3 = a2 + kstep; const char* b3 = b2 + kstep;
            if (last && has_next) S.a_ready(nxt);
            PG8_LDB(B0, 0, 0); PG8_SCHED; PG8_LDA(At, 0, 0); PG8_STAGE(PG8_SA(1, 1), a1 + hstep, voffA);
            PG8_WAIT_L(8); PG8_BAR; PG8_WAIT_L(0); PG8_MMA(0, 0, At, B0); PG8_BAR; PG8_SCHED;
            PG8_LDB(B1, 0, 1); PG8_STAGE(PG8_SB(0, 0), b2, voffB);
            PG8_BAR; PG8_WAIT_L(0); PG8_MMA(0, 1, At, B1); PG8_BAR;
            PG8_LDA(At, 0, 1); PG8_STAGE(PG8_SA(0, 0), a2, voffA);
            PG8_BAR; PG8_WAIT_L(0); PG8_MMA(1, 0, At, B0); PG8_BAR; PG8_SCHED;
            PG8_STAGE(PG8_SB(0, 1), b2 + hstep, voffB);
            PG8_WAIT_V(6); PG8_BAR; PG8_MMA(1, 1, At, B1); PG8_BAR;
            PG8_LDB(B0, 1, 0); PG8_SCHED; PG8_LDA(At, 1, 0); PG8_STAGE(PG8_SA(0, 1), a2 + hstep, voffA);
            PG8_WAIT_L(8); PG8_BAR; PG8_WAIT_L(0); PG8_MMA(0, 0, At, B0); PG8_BAR; PG8_SCHED;
            PG8_LDB(B1, 1, 1); PG8_STAGE(PG8_SB(1, 0), b3, voffB);
            PG8_BAR; PG8_WAIT_L(0); PG8_MMA(0, 1, At, B1); PG8_BAR;
            PG8_LDA(At, 1, 1); PG8_STAGE(PG8_SA(1, 0), a3, voffA);
            PG8_BAR; PG8_WAIT_L(0); PG8_MMA(1, 0, At, B0); PG8_BAR; PG8_SCHED;
            PG8_STAGE(PG8_SB(1, 1), b3 + hstep, voffB);
            PG8_WAIT_V(6); PG8_BAR; PG8_MMA(1, 1, At, B1); PG8_BAR;
        }
        PG8_STAMP();
        if constexpr (!Epi::AFTER_DRAIN) { E(acc, cur, wr, wc, fr, fq); S.done(cur); }
        PG8_STAMP();
        if (!has_next) break;
#pragma unroll
        for (int a = 0; a < 2; ++a)
#pragma unroll
            for (int b = 0; b < 2; ++b)
#pragma unroll
                for (int m = 0; m < 4; ++m)
#pragma unroll
                    for (int n = 0; n < 2; ++n) acc[a][b][m][n] = (f32x4){0.f, 0.f, 0.f, 0.f};
        cur = nxt; cA = nA; cB = nB; ++ui;
    }
    PG8_WAIT_V(0);
    if (wr == 0) PG8_BAR;
    PG8_BAR;
    if constexpr (Epi::AFTER_DRAIN) { E.fused(acc, cur, wr, wc, fr, fq, lds, wid, lane); S.done(cur); }
    PG8_STAMP();
    if (STAMP && wid == 0) { stamps[lane] = lane < nts ? (((unsigned long long)(unsigned)ts_hi << 32) | (unsigned)ts_lo) : 0ull;
        if (lane == 62) stamps[62] = rt_entry; if (lane == 63) stamps[63] = (unsigned long long)wall_clock64(); }
#undef PG8_STAMP
#undef PG8_SA
#undef PG8_SB
#undef PG8_STAGE
#undef PG8_LDA
#undef PG8_LDB
#undef PG8_MMA
#undef PG8_WAIT_V
#undef PG8_WAIT_L
#undef PG8_BAR
#undef PG8_SCHED
}
}

enum { EPI_IN = 0, EPI_OUT = 1, EPI_UP = 2, EPI_DOWN = 3 };
template <int MODE>
struct Epi {
  static constexpr bool PERM = true, AFTER_DRAIN = false;
  Params p; int l;
  DI void operator()(const f32x4 (&acc)[2][2][4][2], const pg8::Unit& u, int wr, int wc, int fr, int fq) const {
    const int colb = u.pn * 256 + wc * 32 + 8 * fq;
#pragma unroll
    for (int ai = 0; ai < 2; ++ai)
#pragma unroll
      for (int m = 0; m < 4; ++m) {
        const int row = u.pm * 256 + ai * 128 + wr * 64 + m * 16 + fr;
        if (row < M) {
#pragma unroll
          for (int bj = 0; bj < 2; ++bj) {
            const int col = colb + bj * 128;
            const f32x4 v0 = acc[ai][bj][m][0], v1 = acc[ai][bj][m][1];
            if (MODE == EPI_IN) {
              bf16_t* Z = (bf16_t*)(p.ws + W_Z);
              const int seg = u.pn >> 2;
              if (seg <= 1) {
                const int pos = row < MP ? (row & (SEQ - 1)) : PAST + ((row - MP) & 15);
                const int d0 = (col & 63) >> 1;
                const f32x4* rp = (const f32x4*)((const float2*)(p.ws + W_ROPE) + pos * 32 + d0);
                const f32x4 c01 = rp[0], c23 = rp[1];
                const float a0 = v0[0] * c01[0] - v0[1] * c01[1], b0 = v0[1] * c01[0] + v0[0] * c01[1];
                const float a1 = v0[2] * c01[2] - v0[3] * c01[3], b1 = v0[3] * c01[2] + v0[2] * c01[3];
                const float a2 = v1[0] * c23[0] - v1[1] * c23[1], b2 = v1[1] * c23[0] + v1[0] * c23[1];
                const float a3 = v1[2] * c23[2] - v1[3] * c23[3], b3 = v1[3] * c23[2] + v1[2] * c23[3];
                const float qs = seg == 0 ? 0.125f : 1.f;
                u32x4 o; o[0] = pk2(a0 * qs, b0 * qs); o[1] = pk2(a1 * qs, b1 * qs); o[2] = pk2(a2 * qs, b2 * qs); o[3] = pk2(a3 * qs, b3 * qs);
                *(u32x4*)(Z + (size_t)row * NIN + col) = o;
                if (seg == 1) {
                  float* ob = (row < MP ? p.out + O_KP + ((size_t)l * MP + row) * 1024 : p.out + O_KS + ((size_t)l * MS + row - MP) * 1024) + ((col - 1024) & ~63) + d0;
                  f32x4 o1, o2; o1[0] = a0; o1[1] = a1; o1[2] = a2; o1[3] = a3; o2[0] = b0; o2[1] = b1; o2[2] = b2; o2[3] = b3;
                  *(f32x4*)ob = o1; *(f32x4*)(ob + 32) = o2;
                }
              } else {
                u32x4 o; o[0] = pk2(v0[0], v0[1]); o[1] = pk2(v0[2], v0[3]); o[2] = pk2(v1[0], v1[1]); o[3] = pk2(v1[2], v1[3]);
                *(u32x4*)(Z + (size_t)row * NIN + col) = o;
                if (seg == 2) {
                  float* ob = (row < MP ? p.out + O_VP + ((size_t)l * MP + row) * 1024 : p.out + O_VS + ((size_t)l * MS + row - MP) * 1024) + (col - 2048);
                  *(f32x4*)ob = v0; *(f32x4*)(ob + 4) = v1;
                } else if (seg == 3 || seg == 4) {
                  float* ob = nullptr;
                  if (row < MP) { const int s = row & (SEQ - 1); if (s >= SEQ - 3) ob = p.out + O_MCP + ((size_t)(l * 4 + (row >> 13)) * 3 + (s - (SEQ - 3))) * 2048 + col - 3072; }
                  else { const int t = (row - MP) & 15, b = (row - MP) >> 4; if (t >= 13) ob = p.out + O_MCS + ((size_t)(l * 8 + b) * 3 + (t - 13)) * 2048 + col - 3072; }
                  if (ob) { *(f32x4*)ob = v0; *(f32x4*)(ob + 4) = v1; }
                }
              }
            } else if (MODE == EPI_OUT || MODE == EPI_DOWN) {
              float* R = (float*)(p.ws + W_R) + (size_t)row * D + col;
              const float* rs = MODE == EPI_OUT ? xrow_ptr(p, l, row) + col : R;
              const f32x4 r0 = *(const f32x4*)rs, r1 = *(const f32x4*)(rs + 4);
              *(f32x4*)R = r0 * ALPHA + v0; *(f32x4*)(R + 4) = r1 * ALPHA + v1;
            } else {
              bf16_t* U = (bf16_t*)(p.ws + W_Z);
              u32x4 o; o[0] = pk2(v0[0], v0[1]); o[1] = pk2(v0[2], v0[3]); o[2] = pk2(v1[0], v1[1]); o[3] = pk2(v1[2], v1[3]);
              *(u32x4*)(U + (size_t)row * NUP + col) = o;
              float* ob = nullptr;
              if (row < MP) { const int s = row & (SEQ - 1); if (s >= SEQ - 2) ob = p.out + O_FCP + ((size_t)(l * 4 + (row >> 13)) * 2 + (s - (SEQ - 2))) * NUP + col; }
              else { const int t = (row - MP) & 15, b = (row - MP) >> 4; if (t >= 14) ob = p.out + O_FCS + ((size_t)(l * 8 + b) * 2 + (t - 14)) * NUP + col; }
              if (ob) { *(f32x4*)ob = v0; *(f32x4*)(ob + 4) = v1; }
            }
          }
        }
      }
  }
};

template <int MODE>
DI void gemm_phase(const Params& p, int l, const bf16_t* A, int lda, const bf16_t* Bt, int K, int ntn, char* lds) {
  (void)lda;
  pg8::Gemm g; g.A = A; g.Bt = Bt; g.M = ((MODE == EPI_OUT || MODE == EPI_DOWN) ? NTM - 1 : NTM) * 256; g.N = ntn * 256; g.K = K;
  if (MODE == EPI_OUT || MODE == EPI_DOWN) sample_gemm<MODE>(p, l, A, Bt, K);
  pg8::StaticOrder S; S.init(g.M, g.N, (int)gridDim.x, (int)blockIdx.x);
  Epi<MODE> E; E.p = p; E.l = l;
  pg8::gemm_phase<Epi<MODE>, pg8::StaticOrder, false>((PG8_LAS unsigned char*)lds, g, S, E, nullptr);
  __syncthreads();
}

typedef float f32x4v __attribute__((ext_vector_type(4)));
template <int MODE>
DI void sample_gemm(const Params& p, int l, const bf16_t* A, const bf16_t* Bt, int K) {
  if (blockIdx.x >= 64) return;
  const int tid = otid(), lane = tid & 63, wave = uni(tid >> 6), fr = lane & 15, fq = lane >> 4;
  const bf16_t* ap = A + (size_t)(MP + wave * 16 + fr) * K + fq * 8;
  const bf16_t* bp = Bt + (size_t)(blockIdx.x * 16 + fr) * K + fq * 8;
  f32x4v acc0 = {0.f, 0.f, 0.f, 0.f}, acc1 = {0.f, 0.f, 0.f, 0.f};
  for (int k0 = 0; k0 < K; k0 += 256) {
    bf16x8 a[8], bb[8];
#pragma unroll
    for (int i = 0; i < 8; ++i) { a[i] = *(const bf16x8*)(ap + k0 + i * 32); bb[i] = *(const bf16x8*)(bp + k0 + i * 32); }
#pragma unroll
    for (int i = 0; i < 8; i += 2) {
      acc0 = __builtin_amdgcn_mfma_f32_16x16x32_bf16(a[i], bb[i], acc0, 0, 0, 0);
      acc1 = __builtin_amdgcn_mfma_f32_16x16x32_bf16(a[i + 1], bb[i + 1], acc1, 0, 0, 0);
    }
  }
  const int col = blockIdx.x * 16 + fr;
  float* R = (float*)(p.ws + W_R);
#pragma unroll
  for (int j = 0; j < 4; ++j) {
    const int row = MP + wave * 16 + fq * 4 + j;
    const float res = MODE == EPI_OUT ? xrow_ptr(p, l, row)[col] : R[(size_t)row * D + col];
    R[(size_t)row * D + col] = ALPHA * res + (acc0[j] + acc1[j]);
  }
}

DI void gif_phase(const Params& p, int l, char* lds) {
  const int tidq = otid(); const int lane = tidq & 63, gw = blockIdx.x * 8 + (tidq >> 6), ngw = gridDim.x * 8;
  const float* w = p.in[9] + (size_t)l * D * DIN + 7168;
  const float* bif = p.in[10] + l * 8;
  float* gif = (float*)(p.ws + W_GIF);
  float* w8 = (float*)lds;
  __syncthreads();
#pragma unroll
  for (int i = 0; i < 2; ++i) {
    const int k = tidq + 512 * i;
    *(f32x4*)(w8 + k * 8) = *(const f32x4*)(w + (size_t)k * DIN); *(f32x4*)(w8 + k * 8 + 4) = *(const f32x4*)(w + (size_t)k * DIN + 4);
  }
  __syncthreads();
  for (int rg = gw; rg < M / 4; rg += ngw) {
    float acc[4][8];
#pragma unroll
    for (int a = 0; a < 4; ++a)
#pragma unroll
      for (int j = 0; j < 8; ++j) acc[a][j] = 0.f;
    const float* x0 = xrow_ptr(p, l, rg * 4);
#pragma unroll 4
    for (int kk = 0; kk < 16; ++kk) {
      const int k = kk * 64 + lane;
      const f32x4 w0 = *(const f32x4*)(w8 + k * 8), w1 = *(const f32x4*)(w8 + k * 8 + 4);
#pragma unroll
      for (int a = 0; a < 4; ++a) {
        const float xv = x0[(size_t)a * D + k];
        acc[a][0] += xv * w0[0]; acc[a][1] += xv * w0[1]; acc[a][2] += xv * w0[2]; acc[a][3] += xv * w0[3];
        acc[a][4] += xv * w1[0]; acc[a][5] += xv * w1[1]; acc[a][6] += xv * w1[2]; acc[a][7] += xv * w1[3];
      }
    }
#pragma unroll
    for (int a = 0; a < 4; ++a)
#pragma unroll
      for (int j = 0; j < 8; ++j) {
        const float s = wave_sum(acc[a][j]);
        if (lane == 0) gif[(size_t)(rg * 4 + a) * 8 + j] = s + bif[j];
      }
  }
  __syncthreads();
}

DI void qkconv_phase(const Params& p, int l) {
  const bf16_t* Z = (const bf16_t*)(p.ws + W_Z);
  bf16_t* QA = (bf16_t*)(p.ws + W_AB); bf16_t* KA = (bf16_t*)(p.ws + W_KA);
  const float* cw = p.in[11] + (size_t)l * 4 * 2048; const float* cb = p.in[12] + (size_t)l * 2048;
  const size_t total = (size_t)(M / 4) * 256;
  for (size_t it = (size_t)blockIdx.x * NTH + otid(); it < total; it += (size_t)gridDim.x * NTH) {
    const int cc = (int)(it & 255), rg = (int)(it >> 8), col = cc * 8, row0 = rg * 4;
    int t0, hist_rows;
    const float* st = nullptr;
    if (row0 < MP) { t0 = row0 & (SEQ - 1); }
    else { t0 = (row0 - MP) & 15; st = p.in[4] + ((size_t)(l * 8 + ((row0 - MP) >> 4)) * 3) * 2048 + col; }
    (void)hist_rows;
    float w[4][8], bias[8];
#pragma unroll
    for (int j = 0; j < 4; ++j) { f32x4 a = *(const f32x4*)(cw + j * 2048 + col), b = *(const f32x4*)(cw + j * 2048 + col + 4);
      w[j][0] = a[0]; w[j][1] = a[1]; w[j][2] = a[2]; w[j][3] = a[3]; w[j][4] = b[0]; w[j][5] = b[1]; w[j][6] = b[2]; w[j][7] = b[3]; }
    { f32x4 a = *(const f32x4*)(cb + col), b = *(const f32x4*)(cb + col + 4);
      bias[0] = a[0]; bias[1] = a[1]; bias[2] = a[2]; bias[3] = a[3]; bias[4] = b[0]; bias[5] = b[1]; bias[6] = b[2]; bias[7] = b[3]; }
    float x[7][8];
#pragma unroll
    for (int j = 0; j < 7; ++j) {
      const int t = t0 - 3 + j;
      if (t >= 0) { u32x4 v = *(const u32x4*)(Z + (size_t)(row0 - 3 + j) * NIN + 3072 + col); unpack8(v, x[j]); }
      else if (st) { f32x4 a = *(const f32x4*)(st + (size_t)(3 + t) * 2048), b = *(const f32x4*)(st + (size_t)(3 + t) * 2048 + 4);
        x[j][0] = a[0]; x[j][1] = a[1]; x[j][2] = a[2]; x[j][3] = a[3]; x[j][4] = b[0]; x[j][5] = b[1]; x[j][6] = b[2]; x[j][7] = b[3]; }
      else {
#pragma unroll
        for (int e = 0; e < 8; ++e) x[j][e] = 0.f; }
    }
    const float sc = col >= 1024 ? 0.0625f : 1.f;
    bf16_t* dst = col >= 1024 ? KA + (col - 1024) : QA + col;
#pragma unroll
    for (int a = 0; a < 4; ++a) {
      float o[8];
#pragma unroll
      for (int e = 0; e < 8; ++e) {
        float u = bias[e] + w[0][e] * x[a][e] + w[1][e] * x[a + 1][e] + w[2][e] * x[a + 2][e] + w[3][e] * x[a + 3][e];
        o[e] = u * sigmoidf_(u) * sc;
      }
      u32x4 ov; ov[0] = pk2(o[0], o[1]); ov[1] = pk2(o[2], o[3]); ov[2] = pk2(o[4], o[5]); ov[3] = pk2(o[6], o[7]);
      *(u32x4*)(dst + (size_t)(row0 + a) * D) = ov;
    }
  }
}

constexpr int A_LD = 272;
constexpr int A_TILE = 64 * A_LD;
constexpr int A_VLD = 320;
constexpr int A_VTILE = 64 * A_VLD;
template <int KIND>
DI void attn_item(const Params& p, int l, int b, int ha, int qb, char* lds) {
  const int tid = otid(), lane = tid & 63, wave = uni(tid >> 6);
  const int map = wave >> 2, qt = wave & 3, r = lane & 31, h = lane >> 5;
  const bf16_t* Z = (const bf16_t*)(p.ws + W_Z);
  const int NT = KIND == 0 ? 2 * (qb + 1) : (NKS + 63) / 64;
  const int ntw = KIND == 0 ? 2 * qb + (qt >> 1) + 1 : NT;
  const bool active = KIND == 0 ? true : (qt == 0);
  int qrow;
  if (KIND == 0) qrow = b * SEQ + qb * 128 + qt * 32 + r; else qrow = MP + b * 16 + (r < 16 ? r : 15);
  bf16x8 qf[4];
#pragma unroll
  for (int ks = 0; ks < 4; ++ks) {
    if (KIND == 0) qf[ks] = *(const bf16x8*)(Z + (size_t)qrow * NIN + ha * 128 + map * 64 + ks * 16 + h * 8);
    else {
      const int dn = ks * 16 + h * 8, par = dn >> 5, dd = dn & 31;
      const bf16_t* src = Z + (size_t)qrow * NIN + ha * 128 + map * 64 + 2 * dd;
      const u32x4 lo = *(const u32x4*)src, hi = *(const u32x4*)(src + 8);
      unsigned e[8];
#pragma unroll
      for (int i = 0; i < 4; ++i) { e[i] = par ? (lo[i] >> 16) : (lo[i] & 0xffffu); e[4 + i] = par ? (hi[i] >> 16) : (hi[i] & 0xffffu); }
      u32x4 o; o[0] = e[0] | (e[1] << 16); o[1] = e[2] | (e[3] << 16); o[2] = e[4] | (e[5] << 16); o[3] = e[6] | (e[7] << 16);
      qf[ks] = __builtin_bit_cast(bf16x8, o);
    }
  }
  const int skey = tid >> 4, part = tid & 15;
  u32x4 rk0, rk1, rv0, rv1;
  auto gload = [&](int j) {
    if (KIND == 0) {
      const bf16_t* base = Z + (size_t)(b * SEQ + j * 64 + skey) * NIN + 1024 + ha * 128 + part * 8;
      rk0 = *(const u32x4*)base; rk1 = *(const u32x4*)(base + (size_t)32 * NIN);
      rv0 = *(const u32x4*)(base + 1024); rv1 = *(const u32x4*)(base + (size_t)32 * NIN + 1024);
    } else {
#pragma unroll
      for (int i = 0; i < 2; ++i) {
        int kk = j * 64 + skey + 32 * i; if (kk > NKS - 1) kk = NKS - 1;
        const float *ks_, *vs_;
        if (kk < PAST) { const size_t o = (((size_t)(l * 8 + b) * PAST + kk) * 8 + ha) * 128 + part * 8; ks_ = p.in[2] + o; vs_ = p.in[3] + o; }
        else { const size_t o = (((size_t)l * MS + b * 16 + (kk - PAST)) * 8 + ha) * 128 + part * 8; ks_ = p.out + O_KS + o; vs_ = p.out + O_VS + o; }
        const f32x4 a0 = *(const f32x4*)ks_, a1 = *(const f32x4*)(ks_ + 4), c0 = *(const f32x4*)vs_, c1 = *(const f32x4*)(vs_ + 4);
        u32x4 ko, vo;
        ko[0] = pk2(a0[0], a0[1]); ko[1] = pk2(a0[2], a0[3]); ko[2] = pk2(a1[0], a1[1]); ko[3] = pk2(a1[2], a1[3]);
        vo[0] = pk2(c0[0], c0[1]); vo[1] = pk2(c0[2], c0[3]); vo[2] = pk2(c1[0], c1[1]); vo[3] = pk2(c1[2], c1[3]);
        if (i == 0) { rk0 = ko; rv0 = vo; } else { rk1 = ko; rv1 = vo; }
      }
    }
  };
  f32x16 O[4];
#pragma unroll
  for (int v = 0; v < 4; ++v)
#pragma unroll
    for (int i = 0; i < 16; ++i) O[v][i] = 0.f;
  float m_run = -1e30f, l_run = 0.f;
  const int q4 = (lane & 15) >> 2, p4 = lane & 3, blk = (lane >> 4) & 1;
  const unsigned sofs = skey * A_LD + part * 16, vofs = skey * A_VLD + part * 16;
  auto qk = [&](int j, f32x16 (&st)[2]) {
    const char* kb = lds + (j & 1) * A_TILE;
#pragma unroll
    for (int kt = 0; kt < 2; ++kt) {
#pragma unroll
      for (int i = 0; i < 16; ++i) st[kt][i] = 0.f;
#pragma unroll
      for (int ks = 0; ks < 4; ++ks) {
        const bf16x8 kf = *(const bf16x8*)(kb + (kt * 32 + r) * A_LD + (map * 64 + ks * 16 + h * 8) * 2);
        st[kt] = MFMA32(kf, qf[ks], st[kt]);
      }
    }
    if (KIND == 1 && j == NT - 1) {
#pragma unroll
      for (int kt = 0; kt < 2; ++kt)
#pragma unroll
        for (int i = 0; i < 16; ++i) if (j * 64 + kt * 32 + crow(i, h) >= NKS) st[kt][i] = -1e30f;
    }
  };
  bf16x8 pk[4];
  auto smax = [&](int j, f32x16 (&sc)[2], f32x16 (&sn)[2]) {
    if (j + 1 < ntw) qk(j + 1, sn);
    float mx = sc[0][0];
#pragma unroll
    for (int kt = 0; kt < 2; ++kt)
#pragma unroll
      for (int i = 0; i < 16; ++i) mx = fmaxf(mx, sc[kt][i]);
    mx = fmaxf(mx, __shfl_xor(mx, 32));
    const float m_new = fmaxf(m_run, mx);
    const float alpha = __builtin_amdgcn_exp2f((m_run - m_new) * LOG2E);
    const float mb = m_new * LOG2E;
    float rs = 0.f;
#pragma unroll
    for (int kt = 0; kt < 2; ++kt)
#pragma unroll
      for (int i = 0; i < 16; ++i) { const float e = __builtin_amdgcn_exp2f(sc[kt][i] * LOG2E - mb); sc[kt][i] = e; rs += e; }
    rs += __shfl_xor(rs, 32);
    l_run = l_run * alpha + rs; m_run = m_new;
    if (__builtin_amdgcn_ballot_w64(alpha != 1.f) != 0ull) {
#pragma unroll
      for (int v = 0; v < 4; ++v)
#pragma unroll
        for (int i = 0; i < 16; ++i) O[v][i] *= alpha;
    }
    pk[0] = pack8(sc[0], 0); pk[1] = pack8(sc[0], 1); pk[2] = pack8(sc[1], 0); pk[3] = pack8(sc[1], 1);
  };
  auto pv = [&](int j) {
    const unsigned vaddr = lds_addr(lds + 2 * A_TILE + (j % 3) * A_VTILE) + (4 * h + q4) * A_VLD + (16 * blk + 4 * p4) * 2;
#pragma unroll
    for (int vt = 0; vt < 4; ++vt) {
      bf16x8 vf[4];
      tr_frag4<16 * A_VLD, 8 * A_VLD>(vaddr + vt * 64, vf);
#pragma unroll
      for (int ks = 0; ks < 4; ++ks) O[vt] = MFMA32(vf[ks], pk[ks], O[vt]);
    }
  };
  gload(0);
  { char* kb = lds + sofs; *(u32x4*)kb = rk0; *(u32x4*)(kb + 32 * A_LD) = rk1; char* vb = lds + 2 * A_TILE + vofs; *(u32x4*)vb = rv0; *(u32x4*)(vb + 32 * A_VLD) = rv1; }
  gload(1);
  { char* kb = lds + A_TILE + sofs; *(u32x4*)kb = rk0; *(u32x4*)(kb + 32 * A_LD) = rk1; }
  __syncthreads();
  f32x16 sA[2], sB[2];
  if (active && 0 < ntw) qk(0, sA);
  for (int j = 0; j < NT; j += 2) {
#pragma unroll
    for (int u = 0; u < 2; ++u) {
      const int jj = j + u;
      if (jj < NT) {
        if (jj + 1 < NT) { char* vb = lds + 2 * A_TILE + ((jj + 1) % 3) * A_VTILE + vofs; *(u32x4*)vb = rv0; *(u32x4*)(vb + 32 * A_VLD) = rv1; }
        if (jj + 2 < NT) gload(jj + 2);
        if (active) {
          if (map == 1 && jj >= 1 && jj - 1 < ntw) pv(jj - 1);
          if (jj < ntw) { if (u == 0) smax(jj, sA, sB); else smax(jj, sB, sA); }
          if (map == 0 && jj < ntw) pv(jj);
        }
        if (jj + 2 < NT) { char* kb = lds + (jj & 1) * A_TILE + sofs; *(u32x4*)kb = rk0; *(u32x4*)(kb + 32 * A_LD) = rk1; }
        __syncthreads();
      }
    }
  }
  if (active && map == 1 && ntw == NT) pv(NT - 1);
  __syncthreads();
  float* ex = (float*)lds;
  const float inv_l = 1.f / l_run;
  if (map == 1) {
#pragma unroll
    for (int vt = 0; vt < 4; ++vt)
#pragma unroll
      for (int g = 0; g < 4; ++g) {
        f32x4 o; o[0] = O[vt][4 * g] * inv_l; o[1] = O[vt][4 * g + 1] * inv_l; o[2] = O[vt][4 * g + 2] * inv_l; o[3] = O[vt][4 * g + 3] * inv_l;
        *(f32x4*)(ex + (qt * 32 + r) * 132 + vt * 32 + 8 * g + 4 * h) = o;
      }
  }
  __syncthreads();
  if (map == 0) {
    const float lam = ((const float*)(p.ws + W_MISC))[l];
    const float lam_init = (l == 0) ? 0.2f : (0.8f - 0.6f * 0.74081822068171788f);
    float ssq = 0.f;
#pragma unroll
    for (int vt = 0; vt < 4; ++vt)
#pragma unroll
      for (int g = 0; g < 4; ++g) {
        const f32x4 o2 = *(const f32x4*)(ex + (qt * 32 + r) * 132 + vt * 32 + 8 * g + 4 * h);
#pragma unroll
        for (int e = 0; e < 4; ++e) { const float o = O[vt][4 * g + e] * inv_l - lam * o2[e]; O[vt][4 * g + e] = o; ssq += o * o; }
      }
    ssq += __shfl_xor(ssq, 32);
    const float rms = rsqrtf(ssq * (1.f / 128.f) + LN_EPS) * (1.f - lam_init);
    const float* sg = p.in[14] + l * 128;
    const bool valid = KIND == 0 ? true : (qt == 0 && r < 16);
    if (valid) {
      bf16_t* dst = (bf16_t*)(p.ws + W_Z) + (size_t)qrow * NIN + 3072 + ha * 128;
#pragma unroll
      for (int vt = 0; vt < 4; ++vt)
#pragma unroll
        for (int g = 0; g < 4; ++g) {
          const int v0 = vt * 32 + 8 * g + 4 * h;
          const f32x4 gg = *(const f32x4*)(sg + v0);
          u32x2 o; o[0] = pk2(O[vt][4 * g] * rms * gg[0], O[vt][4 * g + 1] * rms * gg[1]); o[1] = pk2(O[vt][4 * g + 2] * rms * gg[2], O[vt][4 * g + 3] * rms * gg[3]);
          *(u32x2*)(dst + v0) = o;
        }
    }
  }
  __syncthreads();
}

constexpr int L_LD = 528;
constexpr int L_VLD = 320;
constexpr int L_Q = 0, L_K = 64 * L_LD, L_V = 2 * 64 * L_LD, L_SW = L_V + 64 * L_VLD;
constexpr int L_SWLD = 144;
constexpr int L_SC = L_SW + 64 * L_SWLD;
constexpr int S_MX = 0, S_G = 64, S_EMT = 128, S_DS0 = 192, S_DS1 = 256, S_QN = 320  , S_NV = 576  , S_GEND = 832, S_PAR = 840;
constexpr int LDS_BYTES = 153376;
static_assert(L_SC + 2 * S_PAR * 4 <= 131072, "lds");
#define WG_BAR() do { __builtin_amdgcn_fence(__ATOMIC_RELEASE, "workgroup"); __builtin_amdgcn_s_barrier(); __builtin_amdgcn_fence(__ATOMIC_ACQUIRE, "workgroup"); } while (0)

template <int KIND>
DI void mlstm_item(const Params& p, int l, int b, int hm, int half, char* lds) {
  const int tid0 = otid(), wave = uni(tid0 >> 6);
  const bf16_t* QA = (const bf16_t*)(p.ws + W_AB); const bf16_t* KA = (const bf16_t*)(p.ws + W_KA);
  const bf16_t* Z = (const bf16_t*)(p.ws + W_Z); bf16_t* H = (bf16_t*)(p.ws + W_H);
  const float* GIF = (const float*)(p.ws + W_GIF);
  float* scb = (float*)(lds + L_SC);
  int nchunks = KIND == 0 ? SEQ / 64 : 1; asm volatile("" : "+s"(nchunks));
  const int Lv = KIND == 0 ? 64 : 16;
  const size_t bh = KIND == 0 ? (size_t)(l * 4 + b) * 4 + hm : (size_t)(l * 8 + b) * 4 + hm;
  if (wave < 4) {
    f32x16 C[8];
    { const int lane = tid0 & 63, r = lane & 31, h = lane >> 5; (void)r; (void)h;
      if (KIND == 0) {
#pragma unroll
        for (int d = 0; d < 8; ++d)
#pragma unroll
          for (int i = 0; i < 16; ++i) C[d][i] = 0.f;
      } else {
        const float* cp = p.in[5] + bh * 65536 + (size_t)(4 * h) * 256 + half * 128 + wave * 32 + r;
#pragma unroll
        for (int d = 0; d < 8; ++d)
#pragma unroll
          for (int g = 0; g < 4; ++g) {
            C[d][4 * g] = cp[0]; C[d][4 * g + 1] = cp[256]; C[d][4 * g + 2] = cp[512]; C[d][4 * g + 3] = cp[768];
            cp += 2048; asm volatile("" : "+v"(cp));
          }
      }
    }
    for (int c = 0; c < nchunks; ++c) {
      int tid = tid0; asm volatile("" : "+v"(tid));
      const int lane = tid & 63, r = lane & 31, h = lane >> 5;
      const int q4 = (lane & 15) >> 2, p4 = lane & 3, blk = (lane >> 4) & 1;
      const float* sc = scb + (c & 1) * S_PAR;
      const int rowbase = KIND == 0 ? b * SEQ + c * 64 : MP + b * 16;
      WG_BAR();
      f32x16 accB[2];
#pragma unroll
      for (int tt = 0; tt < 2; ++tt)
#pragma unroll
        for (int i = 0; i < 16; ++i) accB[tt][i] = 0.f;
#pragma unroll
      for (int d = 0; d < 8; ++d)
#pragma unroll
        for (int s = 0; s < 2; ++s) {
          __builtin_amdgcn_sched_barrier(0);
          const bf16x8 cf = pack8(C[d], s);
#pragma unroll
          for (int tt = 0; tt < 2; ++tt) {
            const char* qp = lds + L_Q + (tt * 32 + r) * L_LD + (d * 32 + 16 * s + 4 * h) * 2;
            const s16x4 lo = *(const s16x4*)qp, hi = *(const s16x4*)(qp + 16);
            const bf16x8 qfr = __builtin_shufflevector(lo, hi, 0, 1, 2, 3, 4, 5, 6, 7);
            accB[tt] = MFMA32(cf, qfr, accB[tt]);
          }
        }
      __builtin_amdgcn_sched_barrier(0);
      bf16x8 vf[4];
      tr_frag4<16 * L_VLD, 4 * L_VLD>(lds_addr(lds + L_V) + (8 * h + q4) * L_VLD + (wave * 32 + 16 * blk + 4 * p4) * 2, vf);
      const float g_end = sc[S_GEND];
#pragma unroll
      for (int d = 0; d < 8; ++d) {
#pragma unroll
        for (int i = 0; i < 16; ++i) C[d][i] *= g_end;
        bf16x8 kf[4];
        tr_frag4<16 * L_LD, 4 * L_LD>(lds_addr(lds + L_K) + (8 * h + q4) * L_LD + (d * 32 + 16 * blk + 4 * p4) * 2, kf);
#pragma unroll
        for (int ks = 0; ks < 4; ++ks) C[d] = MFMA32(kf[ks], vf[ks], C[d]);
      }
      WG_BAR();
#pragma unroll
      for (int tt = 0; tt < 2; ++tt) {
        const int t = tt * 32 + r;
        const float g = sc[S_G + t];
#pragma unroll
        for (int i = 0; i < 16; ++i) accB[tt][i] *= g;
        const char* sp = lds + L_SW + (tt * 32 + r) * L_SWLD + h * 16;
#pragma unroll
        for (int ks = 0; ks < 4; ++ks) accB[tt] = MFMA32(vf[ks], *(const bf16x8*)(sp + ks * 32), accB[tt]);
        const float qn = (sc[S_QN + t] + sc[S_QN + 64 + t]) + (sc[S_QN + 128 + t] + sc[S_QN + 192 + t]);
        float den = sc[S_DS0 + t] + sc[S_DS1 + t] + g * qn;
        den = fmaxf(fabsf(den), sc[S_EMT + t]);
        const float rden = 1.f / den;
        if (t < Lv) {
          bf16_t* dst = H + (size_t)(rowbase + t) * D + hm * 256 + half * 128 + wave * 32;
#pragma unroll
          for (int g4 = 0; g4 < 4; ++g4) {
            u32x2 o; o[0] = pk2(accB[tt][4 * g4] * rden, accB[tt][4 * g4 + 1] * rden); o[1] = pk2(accB[tt][4 * g4 + 2] * rden, accB[tt][4 * g4 + 3] * rden);
            *(u32x2*)(dst + 8 * g4 + 4 * h) = o;
          }
        }
      }
    }
    WG_BAR();
    {
      const int lane = tid0 & 63, r = lane & 31, h = lane >> 5;
      float* co = p.out + (KIND == 0 ? O_CP : O_CS) + bh * 65536 + (size_t)(4 * h) * 256 + half * 128 + wave * 32 + r;
#pragma unroll
      for (int d = 0; d < 8; ++d)
#pragma unroll
        for (int g = 0; g < 4; ++g) {
          co[0] = C[d][4 * g]; co[256] = C[d][4 * g + 1]; co[512] = C[d][4 * g + 2]; co[768] = C[d][4 * g + 3];
          co += 2048; asm volatile("" : "+v"(co));
        }
    }
  } else {
    const int hw = wave - 4;
    float nreg = 0.f, m_prev = 0.f;
    if (KIND == 1) { nreg = p.in[6][bh * 256 + (tid0 - 256)]; m_prev = p.in[7][bh]; }
    u32x4 pq[8], pk[8], pv[4];
    float gi = 0.f, gf = 0.f, g_end_cur = 0.f;
    auto issue_loads = [&](int c, int tid) {
      const int ht = tid - 256, lane = tid & 63;
      const int rowbase = KIND == 0 ? b * SEQ + c * 64 : MP + b * 16;
      const bool tvalid = lane < Lv;
      gi = tvalid ? GIF[(size_t)(rowbase + lane) * 8 + hm] : -1e30f;
      gf = tvalid ? GIF[(size_t)(rowbase + lane) * 8 + 4 + hm] : 0.f;
#pragma unroll
      for (int i = 0; i < 8; ++i) {
        const int cidx = ht + 256 * i, t = cidx >> 5, pc = cidx & 31;
        const int row = rowbase + (t < Lv ? t : Lv - 1);
        pq[i] = *(const u32x4*)(QA + (size_t)row * D + hm * 256 + pc * 8);
        pk[i] = *(const u32x4*)(KA + (size_t)row * D + hm * 256 + pc * 8);
      }
#pragma unroll
      for (int i = 0; i < 4; ++i) {
        const int cidx = ht + 256 * i, t = cidx >> 4, pc = cidx & 15;
        const int row = rowbase + (t < Lv ? t : Lv - 1);
        pv[i] = *(const u32x4*)(Z + (size_t)row * NIN + 5120 + hm * 256 + half * 128 + pc * 8);
      }
    };
    auto scalars = [&](int par, int lane) -> float {
      const bool tvalid = lane < Lv;
      const float lf = tvalid ? (fminf(gf, 0.f) - __logf(1.f + __expf(-fabsf(gf)))) : 0.f;
      float bc = lf;
#pragma unroll
      for (int o = 1; o < 64; o <<= 1) { const float v = __shfl_up(bc, o); if (lane >= o) bc += v; }
      const float a = gi - bc;
      float cm = a;
#pragma unroll
      for (int o = 1; o < 64; o <<= 1) { const float v = __shfl_up(cm, o); if (lane >= o) cm = fmaxf(cm, v); }
      const float mxv = fmaxf(m_prev, cm);
      const float m_t = bc + mxv;
      const float mx_end = __shfl(mxv, 63), bc_end = __shfl(bc, 63);
      const float wend = __expf(a - mx_end);
      g_end_cur = __expf(m_prev - mx_end);
      if (hw == 0) {
        float* sc = scb + par * S_PAR;
        sc[S_MX + lane] = __expf(mx_end - mxv);
        sc[S_G + lane] = __expf(m_prev - mxv);
        sc[S_EMT + lane] = __expf(-m_t);
        if (lane == 0) sc[S_GEND] = g_end_cur;
      }
      m_prev = bc_end + mx_end;
      return wend;
    };
    auto stage_lds = [&](float wend_l, int tid) {
      const int ht = tid - 256;
#pragma unroll
      for (int i = 0; i < 8; ++i) {
        const int cidx = ht + 256 * i, t = cidx >> 5, pc = cidx & 31;
        const float we = __shfl(wend_l, t);
        float f[8]; unpack8(pk[i], f);
        u32x4 o; o[0] = pk2(f[0] * we, f[1] * we); o[1] = pk2(f[2] * we, f[3] * we); o[2] = pk2(f[4] * we, f[5] * we); o[3] = pk2(f[6] * we, f[7] * we);
        *(u32x4*)(lds + L_Q + t * L_LD + pc * 16) = pq[i];
        *(u32x4*)(lds + L_K + t * L_LD + pc * 16) = o;
      }
#pragma unroll
      for (int i = 0; i < 4; ++i) {
        const int cidx = ht + 256 * i, t = cidx >> 4, pc = cidx & 15;
        *(u32x4*)(lds + L_V + t * L_VLD + pc * 16) = pv[i];
      }
    };
    {
      int tid = tid0; asm volatile("" : "+v"(tid));
      issue_loads(0, tid);
      scb[S_NV + (tid - 256)] = nreg;
      const float wend = scalars(0, tid & 63);
      stage_lds(wend, tid);
    }
    for (int c = 0; c < nchunks; ++c) {
      int tid = tid0; asm volatile("" : "+v"(tid));
      const int ht = tid - 256, lane = tid & 63, r = lane & 31, h = lane >> 5;
      float* sc = scb + (c & 1) * S_PAR;
      float* scn = scb + ((c + 1) & 1) * S_PAR;
      const float g_end_c = g_end_cur;
      WG_BAR();
      const bool more = c + 1 < nchunks;
      if (more) issue_loads(c + 1, tid);
      {
        const int t = ht & 63, part = ht >> 6;
        const char* qp = lds + L_Q + t * L_LD + part * 128;
        float s = 0.f;
#pragma unroll
        for (int e = 0; e < 8; ++e) {
          const u32x4 qq = *(const u32x4*)(qp + e * 16); float f[8]; unpack8(qq, f);
#pragma unroll
          for (int z = 0; z < 8; ++z) s += f[z] * sc[S_NV + part * 64 + e * 8 + z];
        }
        sc[S_QN + part * 64 + t] = s;
      }
      if (hw < 3) {
        const int stl = hw == 2 ? 1 : 0, tt = hw == 0 ? 0 : 1;
        f32x16 S, S2;
#pragma unroll
        for (int i = 0; i < 16; ++i) { S[i] = 0.f; S2[i] = 0.f; }
        const char* ka = lds + L_K + (stl * 32 + r) * L_LD + h * 16;
        const char* qa = lds + L_Q + (tt * 32 + r) * L_LD + h * 16;
#pragma unroll 4
        for (int ks = 0; ks < 16; ks += 2) {
          S = MFMA32(*(const bf16x8*)(ka + ks * 32), *(const bf16x8*)(qa + ks * 32), S);
          S2 = MFMA32(*(const bf16x8*)(ka + ks * 32 + 32), *(const bf16x8*)(qa + ks * 32 + 32), S2);
        }
        const int t = tt * 32 + r;
        const float cw = sc[S_MX + t];
        float rs = 0.f;
#pragma unroll
        for (int g = 0; g < 4; ++g) {
          float wv[4];
#pragma unroll
          for (int e = 0; e < 4; ++e) {
            const int s = stl * 32 + 8 * g + 4 * h + e;
            wv[e] = s <= t ? (S[4 * g + e] + S2[4 * g + e]) * cw : 0.f; rs += wv[e];
          }
          u32x2 o; o[0] = pk2(wv[0], wv[1]); o[1] = pk2(wv[2], wv[3]);
          *(u32x2*)(lds + L_SW + t * L_SWLD + (stl * 32 + 8 * g + 4 * h) * 2) = o;
        }
        rs += __shfl_xor(rs, 32);
        if (h == 0) {
          if (hw == 0) { sc[S_DS0 + t] = rs; sc[S_DS1 + t] = 0.f; }
          else if (hw == 1) sc[S_DS0 + t] = rs;
          else sc[S_DS1 + t] = rs;
        }
      } else {
        const int t = lane >> 1, hs = lane & 1;
        u32x4 z; z[0] = 0; z[1] = 0; z[2] = 0; z[3] = 0;
        *(u32x4*)(lds + L_SW + t * L_SWLD + 64 + hs * 32) = z; *(u32x4*)(lds + L_SW + t * L_SWLD + 64 + hs * 32 + 16) = z;
      }
      {
        float s0 = 0.f, s1 = 0.f, s2 = 0.f, s3 = 0.f;
        const char* kp = lds + L_K + ht * 2;
#pragma unroll
        for (int t = 0; t < 64; t += 4) {
          s0 += bflo((unsigned)*(const bf16_t*)(kp + t * L_LD)); s1 += bflo((unsigned)*(const bf16_t*)(kp + (t + 1) * L_LD));
          s2 += bflo((unsigned)*(const bf16_t*)(kp + (t + 2) * L_LD)); s3 += bflo((unsigned)*(const bf16_t*)(kp + (t + 3) * L_LD));
        }
        nreg = g_end_c * nreg + ((s0 + s1) + (s2 + s3));
        scn[S_NV + ht] = nreg;
      }
      float wend = 0.f;
      if (more) wend = scalars((c + 1) & 1, lane);
      WG_BAR();
      if (more) stage_lds(wend, tid);
    }
    WG_BAR();
    if (half == 0) {
      p.out[(KIND == 0 ? O_NP : O_NS) + bh * 256 + (tid0 - 256)] = nreg;
      if (tid0 == 256) p.out[(KIND == 0 ? O_MPP : O_MSS) + bh] = m_prev;
    }
  }
}

DI void mixer_phase(const Params& p, int l, char* lds, int cidx, bool ml_only) {
  unsigned* ctr = (unsigned*)(p.ws + W_MISC) + 16 + cidx;
  int* s_item = (int*)(lds + LDS_BYTES - 16);
  const int total = 32 + 64 + 64 + 2048;
  for (;;) {
    __syncthreads();
    if (threadIdx.x == 0) *s_item = (int)atomicAdd(ctr, 1u);
    __syncthreads();
    const int it = *s_item;
    __syncthreads();
    if (it >= total) break;
    if (ml_only && it >= 96) break;
    if (it < 32) { mlstm_item<0>(p, l, it >> 3, (it >> 1) & 3, it & 1, lds); continue; }
    if (it < 96) { const int x = it - 32; mlstm_item<1>(p, l, x >> 3, (x >> 1) & 3, x & 1, lds); continue; }
    if (it < 160) { attn_item<1>(p, l, (it - 96) >> 3, (it - 96) & 7, 0, lds); continue; }
    { const int x = it - 160; attn_item<0>(p, l, (x & 31) >> 3, x & 7, 63 - (x >> 5), lds); }
  }
}

DI void merge_phase(const Params& p, int l) {
  const bf16_t* Z = (const bf16_t*)(p.ws + W_Z); const bf16_t* H = (const bf16_t*)(p.ws + W_H); bf16_t* Y = (bf16_t*)(p.ws + W_AB);
  const int tidq = otid(); const int lane = tidq & 63, gw = blockIdx.x * 8 + (tidq >> 6), ngw = gridDim.x * 8;
  const float* mhg = p.in[15] + (size_t)l * D;
  for (int row = gw; row < M; row += ngw) {
    const int col = lane * 16;
    const bf16_t* z = Z + (size_t)row * NIN + col;
    float hv[16];
    unpack8(*(const u32x4*)(H + (size_t)row * D + col), hv); unpack8(*(const u32x4*)(H + (size_t)row * D + col + 8), hv + 8);
    float s = 0.f;
#pragma unroll
    for (int e = 0; e < 16; ++e) s += hv[e];
#pragma unroll
    for (int o = 1; o < 16; o <<= 1) s += __shfl_xor(s, o);
    const float mean = s * (1.f / 256.f);
    float s2 = 0.f;
#pragma unroll
    for (int e = 0; e < 16; ++e) { hv[e] -= mean; s2 += hv[e] * hv[e]; }
#pragma unroll
    for (int o = 1; o < 16; o <<= 1) s2 += __shfl_xor(s2, o);
    const float rstd = rsqrtf(s2 * (1.f / 256.f) + LN_EPS);
#pragma unroll
    for (int hh = 0; hh < 2; ++hh) {
      float oa[8], om[8], ga[8], gb[8];
      unpack8(*(const u32x4*)(z + 3072 + hh * 8), oa); unpack8(*(const u32x4*)(z + 6144 + hh * 8), om);
      unpack8(*(const u32x4*)(z + 7168 + hh * 8), ga); unpack8(*(const u32x4*)(z + 8192 + hh * 8), gb);
      const f32x4 g0 = *(const f32x4*)(mhg + col + hh * 8), g1 = *(const f32x4*)(mhg + col + hh * 8 + 4);
      float y[8];
#pragma unroll
      for (int e = 0; e < 8; ++e) {
        const float hn = hv[hh * 8 + e] * rstd * (e < 4 ? g0[e] : g1[e - 4]);
        y[e] = sigmoidf_(ga[e]) * oa[e] + sigmoidf_(gb[e]) * (hn * sigmoidf_(om[e]));
      }
      u32x4 o; o[0] = pk2(y[0], y[1]); o[1] = pk2(y[2], y[3]); o[2] = pk2(y[4], y[5]); o[3] = pk2(y[6], y[7]);
      *(u32x4*)(Y + (size_t)row * D + col + hh * 8) = o;
    }
  }
}

DI void ln_phase(const Params& p, const float* g, const float* bta, bool final_out) {
  const int tidq = otid(); const int lane = tidq & 63, gw = blockIdx.x * 8 + (tidq >> 6), ngw = gridDim.x * 8;
  float* R = (float*)(p.ws + W_R); bf16_t* AB = (bf16_t*)(p.ws + W_AB);
  for (int row = gw; row < M; row += ngw) {
    float* xr = R + (size_t)row * D;
    f32x4 v[4]; float s = 0.f;
#pragma unroll
    for (int j = 0; j < 4; ++j) { v[j] = *(const f32x4*)(xr + j * 256 + lane * 4); s += (v[j][0] + v[j][1]) + (v[j][2] + v[j][3]); }
    const float mean = wave_sum(s) * (1.f / D);
    float s2 = 0.f;
#pragma unroll
    for (int j = 0; j < 4; ++j) { v[j] = v[j] - mean; s2 += (v[j][0] * v[j][0] + v[j][1] * v[j][1]) + (v[j][2] * v[j][2] + v[j][3] * v[j][3]); }
    const float rstd = rsqrtf(wave_sum(s2) * (1.f / D) + LN_EPS);
    float* dst = final_out ? (row < MP ? p.out + O_YP + (size_t)row * D : p.out + O_YS + (size_t)(row - MP) * D) : xr;
#pragma unroll
    for (int j = 0; j < 4; ++j) {
      const int c = j * 256 + lane * 4;
      const f32x4 gg = *(const f32x4*)(g + c), bb = *(const f32x4*)(bta + c);
      f32x4 o = v[j] * rstd * gg + bb;
      *(f32x4*)(dst + c) = o;
      if (!final_out) { u32x2 ob; ob[0] = pk2(o[0], o[1]); ob[1] = pk2(o[2], o[3]); *(u32x2*)(AB + (size_t)row * D + c) = ob; }
    }
  }
}

DI float gelu_f(float v) {
  const float av = fabsf(v), d = av * 0.2316418882f + 1.0f;
  const float t = __builtin_amdgcn_rcpf(d);
  float q = t * 0.5307027145f + (-0.7265760135f); q = q * t + 0.7107068705f; q = q * t + (-0.142248368f); q = q * t + 0.127414796f; q = q * t;
  const float e = __builtin_amdgcn_exp2f((v * v) * (-0.72134752044f));
  const float m = v * (q * e), r = v - m;
  return v < 0.f ? m : r;
}
DI void ffnconv_phase(const Params& p, int l) {
  const bf16_t* U = (const bf16_t*)(p.ws + W_Z); bf16_t* HF = (bf16_t*)(p.ws + W_Z + (size_t)M * NUP * 2);
  const float* cw = p.in[20] + (size_t)l * 3 * NUP; const float* cb = p.in[21] + (size_t)l * NUP;
  const unsigned total = (unsigned)(M / 4) * 352u;
  for (unsigned it = blockIdx.x * NTH + (unsigned)otid(); it < total; it += gridDim.x * NTH) {
    const unsigned rg = it / 352u, cc = it - rg * 352u;
    const int col = (int)cc * 8, row0 = (int)rg * 4;
    int t0; const float* st = nullptr;
    if (row0 < MP) t0 = row0 & (SEQ - 1); else { t0 = (row0 - MP) & 15; st = p.in[8] + ((size_t)(l * 8 + ((row0 - MP) >> 4)) * 2) * NUP; }
    float gl[4][8];
#pragma unroll
    for (int hf = 0; hf < 2; ++hf) {
      const int c2 = col + hf * DFF;
      float w[3][8], bias[8], x[6][8];
#pragma unroll
      for (int j = 0; j < 3; ++j) { const f32x4 a = *(const f32x4*)(cw + j * NUP + c2), b2 = *(const f32x4*)(cw + j * NUP + c2 + 4);
        w[j][0] = a[0]; w[j][1] = a[1]; w[j][2] = a[2]; w[j][3] = a[3]; w[j][4] = b2[0]; w[j][5] = b2[1]; w[j][6] = b2[2]; w[j][7] = b2[3]; }
      { const f32x4 a = *(const f32x4*)(cb + c2), b2 = *(const f32x4*)(cb + c2 + 4);
        bias[0] = a[0]; bias[1] = a[1]; bias[2] = a[2]; bias[3] = a[3]; bias[4] = b2[0]; bias[5] = b2[1]; bias[6] = b2[2]; bias[7] = b2[3]; }
#pragma unroll
      for (int j = 0; j < 6; ++j) {
        const int t = t0 - 2 + j;
        if (t >= 0) unpack8(*(const u32x4*)(U + (size_t)(row0 - 2 + j) * NUP + c2), x[j]);
        else if (st) { const float* sp = st + (size_t)(2 + t) * NUP + c2; const f32x4 a = *(const f32x4*)sp, b2 = *(const f32x4*)(sp + 4);
          x[j][0] = a[0]; x[j][1] = a[1]; x[j][2] = a[2]; x[j][3] = a[3]; x[j][4] = b2[0]; x[j][5] = b2[1]; x[j][6] = b2[2]; x[j][7] = b2[3]; }
        else {
#pragma unroll
          for (int e = 0; e < 8; ++e) x[j][e] = 0.f; }
      }
#pragma unroll
      for (int a = 0; a < 4; ++a) {
        float o[8];
#pragma unroll
        for (int e = 0; e < 8; ++e) {
          const float u = bias[e] + w[0][e] * x[a][e] + w[1][e] * x[a + 1][e] + w[2][e] * x[a + 2][e];
          if (hf == 0) gl[a][e] = gelu_f(u); else o[e] = gl[a][e] * u;
        }
        if (hf == 1) {
          u32x4 ov; ov[0] = pk2(o[0], o[1]); ov[1] = pk2(o[2], o[3]); ov[2] = pk2(o[4], o[5]); ov[3] = pk2(o[6], o[7]);
          *(u32x4*)(HF + (size_t)(row0 + a) * DFF + col) = ov;
        }
      }
    }
  }
}

#define XB_TMO      128
#define XB_XCNT(j)  (256  + 64 * (j))
#define XB_XSUB(j)  (1280 + 64 * (j))
#define XB_XGEN(j)  (2304 + 64 * (j))
#define XB_TOP      3328
#define XB_TOPGEN   3392
#define XCD_BAR_WORDS 3456
#define XB_SPIN_CAP (1u << 18)
#define XLAS __attribute__((address_space(3)))
DI unsigned xb_ld(unsigned* p)              { return __hip_atomic_load(p, __ATOMIC_RELAXED, __HIP_MEMORY_SCOPE_AGENT); }
DI unsigned xb_add(unsigned* p, unsigned v) { return __hip_atomic_fetch_add(p, v, __ATOMIC_RELAXED, __HIP_MEMORY_SCOPE_AGENT); }
DI unsigned xb_xcc_id() { return (unsigned)__builtin_amdgcn_s_getreg((3 << 11) | 20) & 0xFu; }
#define XB_SPIN(cond, bar) do { unsigned _sp = 0; while (cond) { __builtin_amdgcn_s_sleep(1); \
    if ((++_sp & 255u) == 0u) { if (xb_ld(&(bar)[XB_TMO])) break; if (_sp > XB_SPIN_CAP) { atomicAdd(&(bar)[XB_TMO], 1u); break; } } } } while (0)
struct XcdBarrier { unsigned* bar; unsigned x; volatile XLAS unsigned* st; };
DI XcdBarrier xcd_barrier_post(unsigned* bar, volatile XLAS unsigned* st) {
  XcdBarrier b; b.bar = bar; b.x = xb_xcc_id(); b.st = st;
  if (threadIdx.x == 0) (void)xb_add(&bar[XB_XCNT(b.x)], 1u);
  return b;
}
DI void xcd_barrier_complete(unsigned* bar, unsigned x, unsigned& nloc, unsigned& nx) {
  const unsigned G = gridDim.x * gridDim.y * gridDim.z;
  unsigned sum, cnt, mine, sp = 0u;
  for (;;) {
    sum = 0u; cnt = 0u; mine = 0u;
#pragma unroll
    for (unsigned j = 0; j < 16; ++j) { const unsigned c = xb_ld(&bar[XB_XCNT(j)]); sum += c; cnt += (c > 0u) ? 1u : 0u; mine = (j == x) ? c : mine; }
    if (sum == G) break;
    __builtin_amdgcn_s_sleep(1);
    if ((++sp & 255u) == 0u) { if (xb_ld(&bar[XB_TMO])) break; if (sp > XB_SPIN_CAP) { atomicAdd(&bar[XB_TMO], 1u); break; } }
  }
  nloc = mine > 0u ? mine : 1u; nx = cnt > 0u ? cnt : 1u;
}
DI void xcd_barrier(const XcdBarrier& b) {
  asm volatile("s_waitcnt vmcnt(0)" ::: "memory");
  __syncthreads();
  if (threadIdx.x == 0) {
    unsigned* bar = b.bar;
    __builtin_amdgcn_s_waitcnt(0);
    unsigned nloc = b.st[0], nx = b.st[1];
    if (nloc == 0u) { xcd_barrier_complete(bar, b.x, nloc, nx); b.st[0] = nloc; b.st[1] = nx; }
    const unsigned old = xb_add(&bar[XB_XSUB(b.x)], 1u);
    const unsigned gen = old / nloc;
    if (old + 1u == (gen + 1u) * nloc) {
      __builtin_amdgcn_fence(__ATOMIC_RELEASE, "agent");
      asm volatile("s_waitcnt vmcnt(0)" ::: "memory");
      const unsigned og = xb_add(&bar[XB_TOP], 1u);
      const unsigned tg = og / nx;
      if (og + 1u == (tg + 1u) * nx) xb_add(&bar[XB_TOPGEN], 1u);
      else XB_SPIN(xb_ld(&bar[XB_TOPGEN]) == tg, bar);
      __builtin_amdgcn_fence(__ATOMIC_ACQUIRE, "agent");
      xb_add(&bar[XB_XGEN(b.x)], 1u);
      asm volatile("s_waitcnt vmcnt(0)" ::: "memory");
    } else {
      XB_SPIN(xb_ld(&bar[XB_XGEN(b.x)]) == gen, bar);
      __builtin_amdgcn_fence(__ATOMIC_ACQUIRE, "agent");
      asm volatile("s_waitcnt vmcnt(0)" ::: "memory");
    }
  }
  __syncthreads();
}

constexpr int NPH = 21;
DI void run_phase(const Params& p, int ph, char* lds) {
#ifndef ONLY
  if (ph == 0) { phase0(p, lds); return; }
#else
  if (ph == 0) return;
#endif
  const int l = (ph - 1) / 10, s = (ph - 1) % 10;
#ifdef ONLY
  if (s != ONLY) return;
#endif
  switch (s) {
    case 0: gemm_phase<EPI_IN>(p, l, (const bf16_t*)(p.ws + W_AB), D, (const bf16_t*)(p.ws + W_WIN) + (size_t)l * NIN * D, D, NIN / 256, lds); break;
    case 1: qkconv_phase(p, l); gif_phase(p, l, lds); break;
    case 2: mixer_phase(p, l, lds, l, false); break;
    case 3: merge_phase(p, l); break;
    case 4: gemm_phase<EPI_OUT>(p, l, (const bf16_t*)(p.ws + W_AB), D, (const bf16_t*)(p.ws + W_WOUT) + (size_t)l * D * D, D, D / 256, lds); break;
    case 5: ln_phase(p, p.in[17] + l * D, p.in[18] + l * D, false); break;
    case 6: gemm_phase<EPI_UP>(p, l, (const bf16_t*)(p.ws + W_AB), D, (const bf16_t*)(p.ws + W_WUP) + (size_t)l * NUP * D, D, NUP / 256, lds); break;
    case 7: ffnconv_phase(p, l); break;
    case 8: gemm_phase<EPI_DOWN>(p, l, (const bf16_t*)(p.ws + W_Z + (size_t)M * NUP * 2), DFF, (const bf16_t*)(p.ws + W_WDN) + (size_t)l * D * DFF, DFF, D / 256, lds); break;
    case 9: ln_phase(p, p.in[23] + l * D, p.in[24] + l * D, l == 1); break;
  }
}

__global__ void __launch_bounds__(NTH) mega(Params p, int ph_lo, int ph_hi) {
  extern __shared__ __attribute__((aligned(16))) char lds[];
#if MULTI_LAUNCH
  for (int ph = ph_lo; ph < ph_hi; ++ph) run_phase(p, ph, lds);
#else
  cg::grid_group grid = cg::this_grid();
  phase0(p, lds);
  grid.sync();
  volatile XLAS unsigned* xst = (volatile XLAS unsigned*)((XLAS char*)lds + (LDS_BYTES - 32));
  if (threadIdx.x == 0) { xst[0] = 0u; xst[1] = 0u; }
  __syncthreads();
  const XcdBarrier xb = xcd_barrier_post((unsigned*)(p.ws + W_BAR), xst);
#define GSYNC() xcd_barrier(xb)
  for (int l = 0; l < 2; ++l) {
    gemm_phase<EPI_IN>(p, l, (const bf16_t*)(p.ws + W_AB), D, (const bf16_t*)(p.ws + W_WIN) + (size_t)l * NIN * D, D, NIN / 256, lds);
    GSYNC();
#ifdef PROBE_GIN2
    gemm_phase<EPI_IN>(p, l, (const bf16_t*)(p.ws + W_AB), D, (const bf16_t*)(p.ws + W_WIN) + (size_t)l * NIN * D, D, NIN / 256, lds);
    GSYNC();
#endif
    qkconv_phase(p, l); gif_phase(p, l, lds);
    GSYNC();
#if defined(PROBE_EW2) || defined(PROBE_QKC2)
    qkconv_phase(p, l); gif_phase(p, l, lds);
    GSYNC();
#endif
    mixer_phase(p, l, lds, l, false);
    GSYNC();
#ifdef PROBE_ML2
    mixer_phase(p, l, lds, l + 2, true);
    GSYNC();
#endif
#ifdef PROBE_MIX2
    mixer_phase(p, l, lds, l + 2, false);
    GSYNC();
#endif
    merge_phase(p, l);
    GSYNC();
#ifdef PROBE_SYNC
    for (int q = 0; q < 20; ++q) GSYNC();
#endif
#if defined(PROBE_EW2) || defined(PROBE_MRG2)
    merge_phase(p, l);
    GSYNC();
#endif
    gemm_phase<EPI_OUT>(p, l, (const bf16_t*)(p.ws + W_AB), D, (const bf16_t*)(p.ws + W_WOUT) + (size_t)l * D * D, D, D / 256, lds);
    GSYNC();
    ln_phase(p, p.in[17] + l * D, p.in[18] + l * D, false);
    GSYNC();
    gemm_phase<EPI_UP>(p, l, (const bf16_t*)(p.ws + W_AB), D, (const bf16_t*)(p.ws + W_WUP) + (size_t)l * NUP * D, D, NUP / 256, lds);
    GSYNC();
    ffnconv_phase(p, l);
    GSYNC();
#if defined(PROBE_EW2) || defined(PROBE_FFC2)
    ffnconv_phase(p, l);
    GSYNC();
#endif
    gemm_phase<EPI_DOWN>(p, l, (const bf16_t*)(p.ws + W_Z + (size_t)M * NUP * 2), DFF, (const bf16_t*)(p.ws + W_WDN) + (size_t)l * D * DFF, DFF, D / 256, lds);
    GSYNC();
    ln_phase(p, p.in[23] + l * D, p.in[24] + l * D, l == 1);
    if (l == 0) GSYNC();
  }
#endif
}

extern "C" void kernel_launch(void* const* d_in, const int* in_sizes, int n_in, void* d_out, int out_size, void* d_ws, size_t ws_size, hipStream_t stream) {
  static int grid = 0;
  if (grid == 0) {
    if (n_in != 25 || (size_t)out_size != O_END || ws_size < W_END) { fprintf(stderr, "kernel_launch: unexpected sizes n_in %d out %d (want %zu) ws %zu (want %zu)\n", n_in, out_size, (size_t)O_END, ws_size, (size_t)W_END); grid = -1; return; }
    int dev = 0, cus = 0, per_cu = 0;
    hipGetDevice(&dev);
    hipDeviceGetAttribute(&cus, hipDeviceAttributeMultiprocessorCount, dev);
    if (hipFuncSetAttribute((const void*)mega, hipFuncAttributeMaxDynamicSharedMemorySize, LDS_BYTES) != hipSuccess) { fprintf(stderr, "hipFuncSetAttribute failed\n"); grid = -1; return; }
    hipOccupancyMaxActiveBlocksPerMultiprocessor(&per_cu, (const void*)mega, NTH, LDS_BYTES);
    if (per_cu < 1) per_cu = 1;
    grid = cus * 1;
    (void)hipGetLastError();
  }
  if (grid < 0) return;
  Params p{};
  for (int i = 0; i < 25; ++i) p.in[i] = (const float*)d_in[i];
  p.out = (float*)d_out; p.ws = (unsigned char*)d_ws;
#if MULTI_LAUNCH
  for (int ph = 0; ph < NPH; ++ph) hipLaunchKernelGGL(mega, dim3(grid), dim3(NTH), LDS_BYTES, stream, p, ph, ph + 1);
#else
  int lo = 0, hi = NPH;
  void* args[] = {&p, &lo, &hi};
  hipError_t e = hipLaunchCooperativeKernel((const void*)mega, dim3(grid), dim3(NTH), args, LDS_BYTES, stream);
  if (e != hipSuccess) fprintf(stderr, "cooperative launch failed: %s (grid %d)\n", hipGetErrorString(e), grid);
#endif
}
```

```cpp
#include <hip/hip_runtime.h>
#include <hip/hip_cooperative_groups.h>
#include <cstdio>
namespace cg = cooperative_groups;

#ifndef MULTI_LAUNCH
#define MULTI_LAUNCH 0
#endif

typedef unsigned short bf16_t;
typedef short bf16x8 __attribute__((ext_vector_type(8)));
typedef short s16x4 __attribute__((ext_vector_type(4)));
typedef float f32x16 __attribute__((ext_vector_type(16)));
typedef float f32x4 __attribute__((ext_vector_type(4)));
typedef unsigned u32x4 __attribute__((ext_vector_type(4)));
typedef unsigned u32x2 __attribute__((ext_vector_type(2)));
#define DI __device__ __forceinline__
#define MFMA32(a, b, c) __builtin_amdgcn_mfma_f32_32x32x16_bf16((a), (b), (c), 0, 0, 0)

constexpr int NTH = 512;
constexpr int D = 1024, SEQ = 8192, NB = 4, MP = NB * SEQ, MS = 128, M = MP + MS, NTM = 129;
constexpr int DIN = 9224, NIN = 9216, DFF = 2816, NUP = 5632;
constexpr int PAST = 4096, NKS = PAST + 16;
constexpr float ALPHA = 1.4142135623730951f;
constexpr float LN_EPS = 1e-5f;
constexpr float LOG2E = 1.4426950408889634f;

constexpr size_t O_YP = 0;
constexpr size_t O_YS = O_YP + (size_t)MP * D;
constexpr size_t O_KP = O_YS + (size_t)MS * D;
constexpr size_t O_VP = O_KP + (size_t)2 * MP * 1024;
constexpr size_t O_MCP = O_VP + (size_t)2 * MP * 1024;
constexpr size_t O_CP = O_MCP + (size_t)2 * 4 * 3 * 2048;
constexpr size_t O_NP = O_CP + (size_t)2 * 4 * 4 * 65536;
constexpr size_t O_MPP = O_NP + (size_t)2 * 4 * 4 * 256;
constexpr size_t O_FCP = O_MPP + 32;
constexpr size_t O_KS = O_FCP + (size_t)2 * 4 * 2 * NUP;
constexpr size_t O_VS = O_KS + (size_t)2 * MS * 1024;
constexpr size_t O_MCS = O_VS + (size_t)2 * MS * 1024;
constexpr size_t O_CS = O_MCS + (size_t)2 * 8 * 3 * 2048;
constexpr size_t O_NS = O_CS + (size_t)2 * 8 * 4 * 65536;
constexpr size_t O_MSS = O_NS + (size_t)2 * 8 * 4 * 256;
constexpr size_t O_FCS = O_MSS + 64;
constexpr size_t O_END = O_FCS + (size_t)2 * 8 * 2 * NUP;

constexpr size_t W_Z = 0;
constexpr size_t W_H = W_Z + (size_t)M * NIN * 2;
constexpr size_t W_AB = W_H + (size_t)M * D * 2;
constexpr size_t W_KA = W_AB + (size_t)M * D * 2;
constexpr size_t W_R = W_KA + (size_t)M * D * 2;
constexpr size_t W_WIN = W_R + (size_t)M * D * 4;
constexpr size_t W_WOUT = W_WIN + (size_t)2 * NIN * D * 2;
constexpr size_t W_WUP = W_WOUT + (size_t)2 * D * D * 2;
constexpr size_t W_WDN = W_WUP + (size_t)2 * NUP * D * 2;
constexpr size_t W_GIF = W_WDN + (size_t)2 * D * DFF * 2;
constexpr size_t W_ROPE = W_GIF + (size_t)M * 8 * 4;
constexpr size_t W_MISC = W_ROPE + (size_t)8192 * 32 * 8;
constexpr size_t W_BAR = W_MISC + 4096;
constexpr size_t W_END = W_BAR + 16384;

struct Params {
  const float* in[25];
  float* out;
  unsigned char* ws;
};

DI unsigned f2bf(float x) { unsigned u = __float_as_uint(x); u += 0x7fffu + ((u >> 16) & 1u); return u >> 16; }
typedef __bf16 bf16v2 __attribute__((ext_vector_type(2)));
typedef float f32x2 __attribute__((ext_vector_type(2)));
DI unsigned pk2(float a, float b) { f32x2 v; v[0] = a; v[1] = b; return __builtin_bit_cast(unsigned, __builtin_convertvector(v, bf16v2)); }
DI float bflo(unsigned u) { return __uint_as_float(u << 16); }
DI float bfhi(unsigned u) { return __uint_as_float(u & 0xffff0000u); }
DI float sigmoidf_(float x) { return __builtin_amdgcn_rcpf(1.f + __builtin_amdgcn_exp2f(-1.4426950408889634f * x)); }
DI float wave_sum(float v) {
#pragma unroll
  for (int o = 1; o < 64; o <<= 1) v += __shfl_xor(v, o);
  return v;
}
DI int crow(int i, int h) { return (i & 3) + 8 * (i >> 2) + 4 * h; }
DI bf16x8 pack8(const f32x16& x, int s) {
  u32x4 p;
  p[0] = pk2(x[8 * s + 0], x[8 * s + 1]); p[1] = pk2(x[8 * s + 2], x[8 * s + 3]);
  p[2] = pk2(x[8 * s + 4], x[8 * s + 5]); p[3] = pk2(x[8 * s + 6], x[8 * s + 7]);
  return __builtin_bit_cast(bf16x8, p);
}
DI void unpack8(u32x4 v, float* f) {
  f[0] = bflo(v[0]); f[1] = bfhi(v[0]); f[2] = bflo(v[1]); f[3] = bfhi(v[1]);
  f[4] = bflo(v[2]); f[5] = bfhi(v[2]); f[6] = bflo(v[3]); f[7] = bfhi(v[3]);
}
typedef __attribute__((address_space(3))) s16x4 lds_s16x4;
DI bf16x8 tr_frag(unsigned a_lo, unsigned a_hi) {
  const s16x4 lo = __builtin_amdgcn_ds_read_tr16_b64_v4i16((lds_s16x4*)(size_t)a_lo);
  const s16x4 hi = __builtin_amdgcn_ds_read_tr16_b64_v4i16((lds_s16x4*)(size_t)a_hi);
  return __builtin_shufflevector(lo, hi, 0, 1, 2, 3, 4, 5, 6, 7);
}
template <int STEP, int HIOFF>
DI void tr_frag4(unsigned a, bf16x8 (&f)[4]) {
#pragma unroll
  for (int i = 0; i < 4; ++i) f[i] = tr_frag(a + i * STEP, a + i * STEP + HIOFF);
}
DI int otid() { int t = threadIdx.x; asm volatile("" : "+v"(t)); return t; }
DI int uni(int v) { return __builtin_amdgcn_readfirstlane(v); }
DI unsigned lds_addr(const void* p) { return (unsigned)(size_t)p; }

DI const float* xrow_ptr(const Params& p, int l, int row) {
  if (l == 0) return row < MP ? p.in[0] + (size_t)row * D : p.in[1] + (size_t)(row - MP) * D;
  return (const float*)(p.ws + W_R) + (size_t)row * D;
}

DI void transpose_w(const float* W, int K, int N, int src_ld, bf16_t* WT, bool remap, char* lds) {
  float* scr = (float*)lds;
  const int nkb = K / 64, nnb = N / 64, tid = otid();
  for (int it = blockIdx.x; it < nkb * nnb; it += gridDim.x) {
    const int kb = it / nnb, nb = it % nnb, k0 = kb * 64, n0 = nb * 64;
    const int ns = (remap && n0 >= 7168) ? n0 + 8 : n0;
#pragma unroll
    for (int i = 0; i < 8; ++i) {
      const int kk = (tid >> 6) + 8 * i, nn = tid & 63;
      scr[kk * 65 + nn] = W[(size_t)(k0 + kk) * src_ld + ns + nn];
    }
    __syncthreads();
    {
      const int n = tid >> 3, c = tid & 7;
      const float* s = scr + (8 * c) * 65 + n;
      u32x4 o;
      o[0] = pk2(s[0], s[65]); o[1] = pk2(s[2 * 65], s[3 * 65]); o[2] = pk2(s[4 * 65], s[5 * 65]); o[3] = pk2(s[6 * 65], s[7 * 65]);
      const int nd = (remap && n0 < 2048) ? ((n < 32) ? 2 * n : 2 * (n - 32) + 1) : n;
      *(u32x4*)(WT + (size_t)(n0 + nd) * K + k0 + 8 * c) = o;
    }
    __syncthreads();
  }
}

DI void phase0(const Params& p, char* lds) {
  const int tid = otid();
  for (int l = 0; l < 2; ++l) {
    transpose_w(p.in[9] + (size_t)l * D * DIN, D, NIN, DIN, (bf16_t*)(p.ws + W_WIN) + (size_t)l * NIN * D, true, lds);
    transpose_w(p.in[16] + (size_t)l * D * D, D, D, D, (bf16_t*)(p.ws + W_WOUT) + (size_t)l * D * D, false, lds);
    transpose_w(p.in[19] + (size_t)l * D * NUP, D, NUP, NUP, (bf16_t*)(p.ws + W_WUP) + (size_t)l * NUP * D, false, lds);
    transpose_w(p.in[22] + (size_t)l * DFF * D, DFF, D, D, (bf16_t*)(p.ws + W_WDN) + (size_t)l * D * DFF, false, lds);
  }
  bf16_t* ab = (bf16_t*)(p.ws + W_AB);
  {
    const unsigned total = (unsigned)M * 128u, S = gridDim.x * NTH;
    for (unsigned c0 = blockIdx.x * NTH + (unsigned)tid; c0 < total; c0 += 4u * S) {
      f32x4 a[4], b4[4];
#pragma unroll
      for (int u = 0; u < 4; ++u) {
        const unsigned c = c0 + (unsigned)u * S;
        if (c < total) { const float* src = xrow_ptr(p, 0, (int)(c >> 7)) + (c & 127u) * 8; a[u] = *(const f32x4*)src; b4[u] = *(const f32x4*)(src + 4); }
      }
#pragma unroll
      for (int u = 0; u < 4; ++u) {
        const unsigned c = c0 + (unsigned)u * S;
        if (c < total) {
          u32x4 o; o[0] = pk2(a[u][0], a[u][1]); o[1] = pk2(a[u][2], a[u][3]); o[2] = pk2(b4[u][0], b4[u][1]); o[3] = pk2(b4[u][2], b4[u][3]);
          *(u32x4*)(ab + (size_t)(c >> 7) * D + (c & 127u) * 8) = o;
        }
      }
    }
  }
  float2* rope = (float2*)(p.ws + W_ROPE);
  for (int i = blockIdx.x * NTH + tid; i < 8192 * 32; i += gridDim.x * NTH) {
    const int pos = i >> 5, d = i & 31;
    const double inv = exp2(-(double)d * (13.287712379549449 / 32.0));
    double ang = (double)pos * inv;
    const double twopi = 6.283185307179586476925;
    ang -= twopi * rint(ang / twopi);
    float s, c; sincosf((float)ang, &s, &c);
    rope[i] = make_float2(c, s);
  }
  if (blockIdx.x == 0 && tid < 128) {
    const int l = tid >> 6, ln = tid & 63;
    const float* lp = p.in[13] + (size_t)l * 4 * 64;
    const float s1 = wave_sum(lp[ln] * lp[64 + ln]), s2 = wave_sum(lp[128 + ln] * lp[192 + ln]);
    const float lam_init = (l == 0) ? 0.2f : (0.8f - 0.6f * 0.74081822068171788f);
    if (ln == 0) ((float*)(p.ws + W_MISC))[l] = __expf(s1) - __expf(s2) + lam_init;
  }
  if (blockIdx.x == 0 && tid < 8) ((unsigned*)(p.ws + W_MISC))[16 + tid] = 0u;
  if (blockIdx.x == 0) for (int i = tid; i < 3456; i += NTH) ((unsigned*)(p.ws + W_BAR))[i] = 0u;
}

namespace pg8 {
#define PG8_LAS __attribute__((address_space(3)))
typedef unsigned short bf16_t;
typedef short bf16x8 __attribute__((ext_vector_type(8)));
typedef float f32x4 __attribute__((ext_vector_type(4)));
typedef unsigned u32x4 __attribute__((ext_vector_type(4)));
constexpr int BM = 256, BK = 64, HALF = 128, HTB = HALF * BK * 2  , STAGE_BYTES = 8 * HTB, NXCD = 8, WGM = 8;

__host__ __device__ __forceinline__ int lds_byte(int r, int c) { const int st = (r >> 4) * 2 + (c >> 5), rr = r & 15, cc = c & 31, ob = rr * 64 + cc * 2; return st * 1024 + (ob ^ (((ob >> 9) & 1) << 5)); }
__host__ __device__ __forceinline__ void stage_rc(int b, int& R, int& C) { const int st = b / 1024, sb = b % 1024, swz = sb ^ (((sb >> 9) & 1) << 5); R = (st >> 1) * 16 + swz / 64; C = (st & 1) * 32 + (swz % 64) / 2; }
__host__ __device__ __forceinline__ int perm32(int rho) { const int n = rho >> 4, i = rho & 15; return 8 * (i >> 2) + 4 * n + (i & 3); }

struct Unit { int pm, pn; };
struct Gemm { const bf16_t* A; const bf16_t* Bt; int M, N, K; };

struct StaticOrder {
    int nM, nN, nwg, G, c;
    __host__ __device__ void init(int M, int N, int G_, int c_) { nM = M / BM; nN = N / BM; nwg = nM * nN; G = G_; c = c_; }
    __host__ __device__ bool next(int i, Unit& u) const {
        const long L = (long)i * G + c; if (L >= nwg) return false;
        int wgid = (int)L; { const int q = nwg / NXCD, r = nwg % NXCD, xcd = wgid % NXCD, off = wgid / NXCD; wgid = (xcd < r ? xcd * (q + 1) : r * (q + 1) + (xcd - r) * q) + off; }
        const int nig = WGM * nN, gid = wgid / nig, fm = gid * WGM, gsz = (nM - fm) < WGM ? (nM - fm) : WGM;
        u.pm = fm + ((wgid % nig) % gsz); u.pn = (wgid % nig) / gsz; return true;
    }
    __device__ __forceinline__ void a_ready(const Unit&) const {}
    __device__ __forceinline__ void done(const Unit&) const {}
};
template <class Epi, class Sched, bool STAMP = false>
__device__ __forceinline__ void gemm_phase(PG8_LAS unsigned char* lds, const Gemm g, const Sched& S, const Epi& E, unsigned long long* stamps) {
    const int tid = otid(), wid = __builtin_amdgcn_readfirstlane(tid >> 6), lane = tid & 63, wr = wid >> 2, wc = wid & 3, fr = lane & 15, fq = lane >> 4;
    const int K = g.K, nt = K / BK;
    int ts_lo = 0, ts_hi = 0, nts = 0; const unsigned long long rt_entry = STAMP ? (unsigned long long)wall_clock64() : 0ull;
#define PG8_STAMP() do { if (STAMP && wid == 0 && nts < 64) { const unsigned long long _c = (unsigned long long)clock64(); \
        ts_lo = (lane == nts) ? (int)(unsigned)_c : ts_lo; ts_hi = (lane == nts) ? (int)(unsigned)(_c >> 32) : ts_hi; ++nts; } } while (0)
    PG8_STAMP();
    unsigned voffA[2], voffB[2];
#pragma unroll
    for (int i = 0; i < 2; ++i) { int R, C; stage_rc(tid * 16 + i * 8192, R, C); const int Rb = Epi::PERM ? ((R & ~31) + perm32(R & 31)) : R;
        voffA[i] = (unsigned)(R * K + C) * 2u; voffB[i] = (unsigned)(Rb * K + C) * 2u; }
    const size_t kstep = (size_t)(BK * 2);
    const size_t hstep = (size_t)HALF * K * 2;
    const size_t tstep = 2 * hstep;
    const unsigned ldsw = (unsigned)wid * 1024u;
    const int aoff = lds_byte(wr * 64 + fr, fq * 8), boff = lds_byte(wc * 32 + fr, fq * 8);
#define PG8_SA(b, h) (((b) * 2 + (h)) * HTB)
#define PG8_SB(b, h) ((4 + (b) * 2 + (h)) * HTB)
#define PG8_STAGE(bufoff, gbase, voff) do { _Pragma("unroll") for (int _i = 0; _i < 2; ++_i) \
        __builtin_amdgcn_global_load_lds((const unsigned*)((const char*)(gbase) + (voff)[_i]), (PG8_LAS unsigned*)(lds + (bufoff) + ldsw + _i * 8192), 16, 0, 0); } while (0)
#define PG8_LDA(dst, b, h) do { _Pragma("unroll") for (int m = 0; m < 4; ++m) _Pragma("unroll") for (int k = 0; k < 2; ++k) dst[m][k] = *(const PG8_LAS bf16x8*)(lds + PG8_SA(b, h) + aoff + m * 2048 + k * 1024); } while (0)
#define PG8_LDB(dst, b, h) do { _Pragma("unroll") for (int n = 0; n < 2; ++n) _Pragma("unroll") for (int k = 0; k < 2; ++k) dst[n][k] = *(const PG8_LAS bf16x8*)(lds + PG8_SB(b, h) + boff + n * 2048 + k * 1024); } while (0)
#define PG8_MMA(ai, bj, At, Bt) do { __builtin_amdgcn_s_setprio(1); _Pragma("unroll") for (int m = 0; m < 4; ++m) _Pragma("unroll") for (int n = 0; n < 2; ++n) _Pragma("unroll") for (int k = 0; k < 2; ++k) \
        acc[ai][bj][m][n] = __builtin_amdgcn_mfma_f32_16x16x32_bf16(Bt[n][k], At[m][k], acc[ai][bj][m][n], 0, 0, 0); __builtin_amdgcn_s_setprio(0); } while (0)
#define PG8_WAIT_V(n) asm volatile("s_waitcnt vmcnt(" #n ")" ::: "memory")
#define PG8_WAIT_L(n) asm volatile("s_waitcnt lgkmcnt(" #n ")" ::: "memory")
#define PG8_BAR __builtin_amdgcn_s_barrier()
#define PG8_SCHED __builtin_amdgcn_sched_barrier(0)
    Unit cur, nxt; int ui = 0;
    if (!S.next(0, cur)) return;
    f32x4 acc[2][2][4][2];
#pragma unroll
    for (int a = 0; a < 2; ++a)
#pragma unroll
        for (int b = 0; b < 2; ++b)
#pragma unroll
            for (int m = 0; m < 4; ++m)
#pragma unroll
                for (int n = 0; n < 2; ++n) acc[a][b][m][n] = (f32x4){0.f, 0.f, 0.f, 0.f};
    bf16x8 At[4][2], B0[2][2], B1[2][2];
    const char* cA = (const char*)g.A + (size_t)cur.pm * tstep; const char* cB = (const char*)g.Bt + (size_t)cur.pn * tstep;
    S.a_ready(cur);
    PG8_STAGE(PG8_SB(0, 0), cB, voffB); PG8_STAGE(PG8_SA(0, 0), cA, voffA); PG8_STAGE(PG8_SB(0, 1), cB + hstep, voffB); PG8_STAGE(PG8_SA(0, 1), cA + hstep, voffA);
    if (wr == 1) PG8_BAR;
    PG8_WAIT_V(4); PG8_BAR;
    PG8_STAGE(PG8_SB(1, 0), cB + kstep, voffB); PG8_STAGE(PG8_SA(1, 0), cA + kstep, voffA); PG8_STAGE(PG8_SB(1, 1), cB + hstep + kstep, voffB);
    PG8_WAIT_V(6); PG8_BAR;
    PG8_STAMP();
    for (;;) {
        const bool has_next = S.next(ui + 1, nxt);
        const char* nA = has_next ? (const char*)g.A + (size_t)nxt.pm * tstep : cA; const char* nB = has_next ? (const char*)g.Bt + (size_t)nxt.pn * tstep : cB;
        for (int t = 0; t < nt; t += 2) {
            const bool last = (t == nt - 2);
            const char* a1 = cA + (size_t)(t + 1) * kstep;
            const char* a2 = last ? nA : cA + (size_t)(t + 2) * kstep; const char* b2 = last ? nB : cB + (size_t)(t + 2) * kstep;
            const char* a3 = a2 + kstep; const char* b3 = b2 + kstep;
            if (last && has_next) S.a_ready(nxt);
            PG8_LDB(B0, 0, 0); PG8_SCHED; PG8_LDA(At, 0, 0); PG8_STAGE(PG8_SA(1, 1), a1 + hstep, voffA);
            PG8_WAIT_L(8); PG8_BAR; PG8_WAIT_L(0); PG8_MMA(0, 0, At, B0); PG8_BAR; PG8_SCHED;
            PG8_LDB(B1, 0, 1); PG8_STAGE(PG8_SB(0, 0), b2, voffB);
            PG8_BAR; PG8_WAIT_L(0); PG8_MMA(0, 1, At, B1); PG8_BAR;
            PG8_LDA(At, 0, 1); PG8_STAGE(PG8_SA(0, 0), a2, voffA);
            PG8_BAR; PG8_WAIT_L(0); PG8_MMA(1, 0, At, B0); PG8_BAR; PG8_SCHED;
            PG8_STAGE(PG8_SB(0, 1), b2 + hstep, voffB);
            PG8_WAIT_V(6); PG8_BAR; PG8_MMA(1, 1, At, B1); PG8_BAR;
            PG8_LDB(B0, 1, 0); PG8_SCHED; PG8_LDA(At, 1, 0); PG8_STAGE(PG8_SA(0, 1), a2 + hstep, voffA);
            PG8_WAIT_L(8); PG8_BAR; PG8_WAIT_L(0); PG8_MMA(0, 0, At, B0); PG8_BAR; PG8_SCHED;
            PG8_LDB(B1, 1, 1); PG8_STAGE(PG8_SB(1, 0), b3, voffB);
            PG8_BAR; PG8_WAIT_L(0); PG8_MMA(0, 1, At, B1); PG8_BAR;
            PG8_LDA(At, 1, 1); PG8_STAGE(PG8_SA(1, 0), a3, voffA);
            PG8_BAR; PG8_WAIT_L(0); PG8_MMA(1, 0, At, B0); PG8_BAR; PG8_SCHED;
            PG8_STAGE(PG8_SB(1, 1), b3 + hstep, voffB);
            PG8_WAIT_V(6); PG8_BAR; PG8_MMA(1, 1, At, B1); PG8_BAR;
        }
        PG8_STAMP();
        if constexpr (!Epi::AFTER_DRAIN) { E(acc, cur, wr, wc, fr, fq); S.done(cur); }
        PG8_STAMP();
        if (!has_next) break;
#pragma unroll
        for (int a = 0; a < 2; ++a)
#pragma unroll
            for (int b = 0; b < 2; ++b)
#pragma unroll
                for (int m = 0; m < 4; ++m)
#pragma unroll
                    for (int n = 0; n < 2; ++n) acc[a][b][m][n] = (f32x4){0.f, 0.f, 0.f, 0.f};
        cur = nxt; cA = nA; cB = nB; ++ui;
    }
    PG8_WAIT_V(0);
    if (wr == 0) PG8_BAR;
    PG8_BAR;
    if constexpr (Epi::AFTER_DRAIN) { E.fused(acc, cur, wr, wc, fr, fq, lds, wid, lane); S.done(cur); }
    PG8_STAMP();
    if (STAMP && wid == 0) { stamps[lane] = lane < nts ? (((unsigned long long)(unsigned)ts_hi << 32) | (unsigned)ts_lo) : 0ull;
        if (lane == 62) stamps[62] = rt_entry; if (lane == 63) stamps[63] = (unsigned long long)wall_clock64(); }
#undef PG8_STAMP
#undef PG8_SA
#undef PG8_SB
#undef PG8_STAGE
#undef PG8_LDA
#undef PG8_LDB
#undef PG8_MMA
#undef PG8_WAIT_V
#undef PG8_WAIT_L
#undef PG8_BAR
#undef PG8_SCHED
}
}

enum { EPI_IN = 0, EPI_OUT = 1, EPI_UP = 2, EPI_DOWN = 3 };
template <int MODE>
struct Epi {
  static constexpr bool PERM = true, AFTER_DRAIN = false;
  Params p; int l;
  DI void operator()(const f32x4 (&acc)[2][2][4][2], const pg8::Unit& u, int wr, int wc, int fr, int fq) const {
    const int colb = u.pn * 256 + wc * 32 + 8 * fq;
#pragma unroll
    for (int ai = 0; ai < 2; ++ai)
#pragma unroll
      for (int m = 0; m < 4; ++m) {
        const int row = u.pm * 256 + ai * 128 + wr * 64 + m * 16 + fr;
        if (row < M) {
#pragma unroll
          for (int bj = 0; bj < 2; ++bj) {
            const int col = colb + bj * 128;
            const f32x4 v0 = acc[ai][bj][m][0], v1 = acc[ai][bj][m][1];
            if (MODE == EPI_IN) {
              bf16_t* Z = (bf16_t*)(p.ws + W_Z);
              const int seg = u.pn >> 2;
              if (seg <= 1) {
                const int pos = row < MP ? (row & (SEQ - 1)) : PAST + ((row - MP) & 15);
                const int d0 = (col & 63) >> 1;
                const f32x4* rp = (const f32x4*)((const float2*)(p.ws + W_ROPE) + pos * 32 + d0);
                const f32x4 c01 = rp[0], c23 = rp[1];
                const float a0 = v0[0] * c01[0] - v0[1] * c01[1], b0 = v0[1] * c01[0] + v0[0] * c01[1];
                const float a1 = v0[2] * c01[2] - v0[3] * c01[3], b1 = v0[3] * c01[2] + v0[2] * c01[3];
                const float a2 = v1[0] * c23[0] - v1[1] * c23[1], b2 = v1[1] * c23[0] + v1[0] * c23[1];
                const float a3 = v1[2] * c23[2] - v1[3] * c23[3], b3 = v1[3] * c23[2] + v1[2] * c23[3];
                const float qs = seg == 0 ? 0.125f : 1.f;
                u32x4 o; o[0] = pk2(a0 * qs, b0 * qs); o[1] = pk2(a1 * qs, b1 * qs); o[2] = pk2(a2 * qs, b2 * qs); o[3] = pk2(a3 * qs, b3 * qs);
                *(u32x4*)(Z + (size_t)row * NIN + col) = o;
                if (seg == 1) {
                  float* ob = (row < MP ? p.out + O_KP + ((size_t)l * MP + row) * 1024 : p.out + O_KS + ((size_t)l * MS + row - MP) * 1024) + ((col - 1024) & ~63) + d0;
                  f32x4 o1, o2; o1[0] = a0; o1[1] = a1; o1[2] = a2; o1[3] = a3; o2[0] = b0; o2[1] = b1; o2[2] = b2; o2[3] = b3;
                  *(f32x4*)ob = o1; *(f32x4*)(ob + 32) = o2;
                }
              } else {
                u32x4 o; o[0] = pk2(v0[0], v0[1]); o[1] = pk2(v0[2], v0[3]); o[2] = pk2(v1[0], v1[1]); o[3] = pk2(v1[2], v1[3]);
                *(u32x4*)(Z + (size_t)row * NIN + col) = o;
                if (seg == 2) {
                  float* ob = (row < MP ? p.out + O_VP + ((size_t)l * MP + row) * 1024 : p.out + O_VS + ((size_t)l * MS + row - MP) * 1024) + (col - 2048);
                  *(f32x4*)ob = v0; *(f32x4*)(ob + 4) = v1;
                } else if (seg == 3 || seg == 4) {
                  float* ob = nullptr;
                  if (row < MP) { const int s = row & (SEQ - 1); if (s >= SEQ - 3) ob = p.out + O_MCP + ((size_t)(l * 4 + (row >> 13)) * 3 + (s - (SEQ - 3))) * 2048 + col - 3072; }
                  else { const int t = (row - MP) & 15, b = (row - MP) >> 4; if (t >= 13) ob = p.out + O_MCS + ((size_t)(l * 8 + b) * 3 + (t - 13)) * 2048 + col - 3072; }
                  if (ob) { *(f32x4*)ob = v0; *(f32x4*)(ob + 4) = v1; }
                }
              }
            } else if (MODE == EPI_OUT || MODE == EPI_DOWN) {
              float* R = (float*)(p.ws + W_R) + (size_t)row * D + col;
              const float* rs = MODE == EPI_OUT ? xrow_ptr(p, l, row) + col : R;
              const f32x4 r0 = *(const f32x4*)rs, r1 = *(const f32x4*)(rs + 4);
              *(f32x4*)R = r0 * ALPHA + v0; *(f32x4*)(R + 4) = r1 * ALPHA + v1;
            } else {
              bf16_t* U = (bf16_t*)(p.ws + W_Z);
              u32x4 o; o[0] = pk2(v0[0], v0[1]); o[1] = pk2(v0[2], v0[3]); o[2] = pk2(v1[0], v1[1]); o[3] = pk2(v1[2], v1[3]);
              *(u32x4*)(U + (size_t)row * NUP + col) = o;
              float* ob = nullptr;
              if (row < MP) { const int s = row & (SEQ - 1); if (s >= SEQ - 2) ob = p.out + O_FCP + ((size_t)(l * 4 + (row >> 13)) * 2 + (s - (SEQ - 2))) * NUP + col; }
              else { const int t = (row - MP) & 15, b = (row - MP) >> 4; if (t >= 14) ob = p.out + O_FCS + ((size_t)(l * 8 + b) * 2 + (t - 14)) * NUP + col; }
              if (ob) { *(f32x4*)ob = v0; *(f32x4*)(ob + 4) = v1; }
            }
          }
        }
      }
  }
};

template <int MODE>
DI void gemm_phase(const Params& p, int l, const bf16_t* A, int lda, const bf16_t* Bt, int K, int ntn, char* lds) {
  (void)lda;
  pg8::Gemm g; g.A = A; g.Bt = Bt; g.M = ((MODE == EPI_OUT || MODE == EPI_DOWN) ? NTM - 1 : NTM) * 256; g.N = ntn * 256; g.K = K;
  if (MODE == EPI_OUT || MODE == EPI_DOWN) sample_gemm<MODE>(p, l, A, Bt, K);
  pg8::StaticOrder S; S.init(g.M, g.N, (int)gridDim.x, (int)blockIdx.x);
  Epi<MODE> E; E.p = p; E.l = l;
  pg8::gemm_phase<Epi<MODE>, pg8::StaticOrder, false>((PG8_LAS unsigned char*)lds, g, S, E, nullptr);
  __syncthreads();
}

typedef float f32x4v __attribute__((ext_vector_type(4)));
template <int MODE>
DI void sample_gemm(const Params& p, int l, const bf16_t* A, const bf16_t* Bt, int K) {
  if (blockIdx.x >= 64) return;
  const int tid = otid(), lane = tid & 63, wave = uni(tid >> 6), fr = lane & 15, fq = lane >> 4;
  const bf16_t* ap = A + (size_t)(MP + wave * 16 + fr) * K + fq * 8;
  const bf16_t* bp = Bt + (size_t)(blockIdx.x * 16 + fr) * K + fq * 8;
  f32x4v acc0 = {0.f, 0.f, 0.f, 0.f}, acc1 = {0.f, 0.f, 0.f, 0.f};
  for (int k0 = 0; k0 < K; k0 += 256) {
    bf16x8 a[8], bb[8];
#pragma unroll
    for (int i = 0; i < 8; ++i) { a[i] = *(const bf16x8*)(ap + k0 + i * 32); bb[i] = *(const bf16x8*)(bp + k0 + i * 32); }
#pragma unroll
    for (int i = 0; i < 8; i += 2) {
      acc0 = __builtin_amdgcn_mfma_f32_16x16x32_bf16(a[i], bb[i], acc0, 0, 0, 0);
      acc1 = __builtin_amdgcn_mfma_f32_16x16x32_bf16(a[i + 1], bb[i + 1], acc1, 0, 0, 0);
    }
  }
  const int col = blockIdx.x * 16 + fr;
  float* R = (float*)(p.ws + W_R);
#pragma unroll
  for (int j = 0; j < 4; ++j) {
    const int row = MP + wave * 16 + fq * 4 + j;
    const float res = MODE == EPI_OUT ? xrow_ptr(p, l, row)[col] : R[(size_t)row * D + col];
    R[(size_t)row * D + col] = ALPHA * res + (acc0[j] + acc1[j]);
  }
}

DI void gif_phase(const Params& p, int l, char* lds, int first_blk) {
  if ((int)blockIdx.x < first_blk) return;
  const int tidq = otid(); const int lane = tidq & 63, gw = ((int)blockIdx.x - first_blk) * 8 + (tidq >> 6), ngw = ((int)gridDim.x - first_blk) * 8;
  const float* w = p.in[9] + (size_t)l * D * DIN + 7168;
  const float* bif = p.in[10] + l * 8;
  float* gif = (float*)(p.ws + W_GIF);
  float* w8 = (float*)lds;
  __syncthreads();
#pragma unroll
  for (int i = 0; i < 2; ++i) {
    const int k = tidq + 512 * i;
    *(f32x4*)(w8 + k * 8) = *(const f32x4*)(w + (size_t)k * DIN); *(f32x4*)(w8 + k * 8 + 4) = *(const f32x4*)(w + (size_t)k * DIN + 4);
  }
  __syncthreads();
  for (int rg = gw; rg < M / 4; rg += ngw) {
    float acc[4][8];
#pragma unroll
    for (int a = 0; a < 4; ++a)
#pragma unroll
      for (int j = 0; j < 8; ++j) acc[a][j] = 0.f;
    const float* x0 = xrow_ptr(p, l, rg * 4);
#pragma unroll 4
    for (int kk = 0; kk < 16; ++kk) {
      const int k = kk * 64 + lane;
      const f32x4 w0 = *(const f32x4*)(w8 + k * 8), w1 = *(const f32x4*)(w8 + k * 8 + 4);
#pragma unroll
      for (int a = 0; a < 4; ++a) {
        const float xv = x0[(size_t)a * D + k];
        acc[a][0] += xv * w0[0]; acc[a][1] += xv * w0[1]; acc[a][2] += xv * w0[2]; acc[a][3] += xv * w0[3];
        acc[a][4] += xv * w1[0]; acc[a][5] += xv * w1[1]; acc[a][6] += xv * w1[2]; acc[a][7] += xv * w1[3];
      }
    }
#pragma unroll
    for (int a = 0; a < 4; ++a)
#pragma unroll
      for (int j = 0; j < 8; ++j) {
        const float s = wave_sum(acc[a][j]);
        if (lane == 0) gif[(size_t)(rg * 4 + a) * 8 + j] = s + bif[j];
      }
  }
  __syncthreads();
}

DI void qkconv_phase(const Params& p, int l) {
  const bf16_t* Z = (const bf16_t*)(p.ws + W_Z);
  bf16_t* QA = (bf16_t*)(p.ws + W_AB); bf16_t* KA = (bf16_t*)(p.ws + W_KA);
  const float* cw = p.in[11] + (size_t)l * 4 * 2048; const float* cb = p.in[12] + (size_t)l * 2048;
  const size_t total = (size_t)(M / 4) * 256;
  for (size_t it = (size_t)blockIdx.x * NTH + otid(); it < total; it += (size_t)gridDim.x * NTH) {
    const int cc = (int)(it & 255), rg = (int)(it >> 8), col = cc * 8, row0 = rg * 4;
    int t0, hist_rows;
    const float* st = nullptr;
    if (row0 < MP) { t0 = row0 & (SEQ - 1); }
    else { t0 = (row0 - MP) & 15; st = p.in[4] + ((size_t)(l * 8 + ((row0 - MP) >> 4)) * 3) * 2048 + col; }
    (void)hist_rows;
    float w[4][8], bias[8];
#pragma unroll
    for (int j = 0; j < 4; ++j) { f32x4 a = *(const f32x4*)(cw + j * 2048 + col), b = *(const f32x4*)(cw + j * 2048 + col + 4);
      w[j][0] = a[0]; w[j][1] = a[1]; w[j][2] = a[2]; w[j][3] = a[3]; w[j][4] = b[0]; w[j][5] = b[1]; w[j][6] = b[2]; w[j][7] = b[3]; }
    { f32x4 a = *(const f32x4*)(cb + col), b = *(const f32x4*)(cb + col + 4);
      bias[0] = a[0]; bias[1] = a[1]; bias[2] = a[2]; bias[3] = a[3]; bias[4] = b[0]; bias[5] = b[1]; bias[6] = b[2]; bias[7] = b[3]; }
    float x[7][8];
#pragma unroll
    for (int j = 0; j < 7; ++j) {
      const int t = t0 - 3 + j;
      if (t >= 0) { u32x4 v = *(const u32x4*)(Z + (size_t)(row0 - 3 + j) * NIN + 3072 + col); unpack8(v, x[j]); }
      else if (st) { f32x4 a = *(const f32x4*)(st + (size_t)(3 + t) * 2048), b = *(const f32x4*)(st + (size_t)(3 + t) * 2048 + 4);
        x[j][0] = a[0]; x[j][1] = a[1]; x[j][2] = a[2]; x[j][3] = a[3]; x[j][4] = b[0]; x[j][5] = b[1]; x[j][6] = b[2]; x[j][7] = b[3]; }
      else {
#pragma unroll
        for (int e = 0; e < 8; ++e) x[j][e] = 0.f; }
    }
    const float sc = col >= 1024 ? 0.0625f : 1.f;
    bf16_t* dst = col >= 1024 ? KA + (col - 1024) : QA + col;
#pragma unroll
    for (int a = 0; a < 4; ++a) {
      float o[8];
#pragma unroll
      for (int e = 0; e < 8; ++e) {
        float u = bias[e] + w[0][e] * x[a][e] + w[1][e] * x[a + 1][e] + w[2][e] * x[a + 2][e] + w[3][e] * x[a + 3][e];
        o[e] = u * sigmoidf_(u) * sc;
      }
      u32x4 ov; ov[0] = pk2(o[0], o[1]); ov[1] = pk2(o[2], o[3]); ov[2] = pk2(o[4], o[5]); ov[3] = pk2(o[6], o[7]);
      *(u32x4*)(dst + (size_t)(row0 + a) * D) = ov;
    }
  }
}

constexpr int A_LD = 272;
constexpr int A_TILE = 64 * A_LD;
constexpr int A_VLD = 320;
constexpr int A_VTILE = 64 * A_VLD;
template <int KIND>
DI void attn_item(const Params& p, int l, int b, int ha, int qb, char* lds) {
  const int tid = otid(), lane = tid & 63, wave = uni(tid >> 6);
  const int map = wave >> 2, qt = wave & 3, r = lane & 31, h = lane >> 5;
  const bf16_t* Z = (const bf16_t*)(p.ws + W_Z);
  const int NT = KIND == 0 ? 2 * (qb + 1) : (NKS + 63) / 64;
  const int ntw = KIND == 0 ? 2 * qb + (qt >> 1) + 1 : NT;
  const bool active = KIND == 0 ? true : (qt == 0);
  int qrow;
  if (KIND == 0) qrow = b * SEQ + qb * 128 + qt * 32 + r; else qrow = MP + b * 16 + (r < 16 ? r : 15);
  bf16x8 qf[4];
#pragma unroll
  for (int ks = 0; ks < 4; ++ks) {
    if (KIND == 0) qf[ks] = *(const bf16x8*)(Z + (size_t)qrow * NIN + ha * 128 + map * 64 + ks * 16 + h * 8);
    else {
      const int dn = ks * 16 + h * 8, par = dn >> 5, dd = dn & 31;
      const bf16_t* src = Z + (size_t)qrow * NIN + ha * 128 + map * 64 + 2 * dd;
      const u32x4 lo = *(const u32x4*)src, hi = *(const u32x4*)(src + 8);
      unsigned e[8];
#pragma unroll
      for (int i = 0; i < 4; ++i) { e[i] = par ? (lo[i] >> 16) : (lo[i] & 0xffffu); e[4 + i] = par ? (hi[i] >> 16) : (hi[i] & 0xffffu); }
      u32x4 o; o[0] = e[0] | (e[1] << 16); o[1] = e[2] | (e[3] << 16); o[2] = e[4] | (e[5] << 16); o[3] = e[6] | (e[7] << 16);
      qf[ks] = __builtin_bit_cast(bf16x8, o);
    }
  }
  const int skey = tid >> 4, part = tid & 15;
  u32x4 rk0, rk1, rv0, rv1;
  auto gload = [&](int j) {
    if (KIND == 0) {
      const bf16_t* base = Z + (size_t)(b * SEQ + j * 64 + skey) * NIN + 1024 + ha * 128 + part * 8;
      rk0 = *(const u32x4*)base; rk1 = *(const u32x4*)(base + (size_t)32 * NIN);
      rv0 = *(const u32x4*)(base + 1024); rv1 = *(const u32x4*)(base + (size_t)32 * NIN + 1024);
    } else {
#pragma unroll
      for (int i = 0; i < 2; ++i) {
        int kk = j * 64 + skey + 32 * i; if (kk > NKS - 1) kk = NKS - 1;
        const float *ks_, *vs_;
        if (kk < PAST) { const size_t o = (((size_t)(l * 8 + b) * PAST + kk) * 8 + ha) * 128 + part * 8; ks_ = p.in[2] + o; vs_ = p.in[3] + o; }
        else { const size_t o = (((size_t)l * MS + b * 16 + (kk - PAST)) * 8 + ha) * 128 + part * 8; ks_ = p.out + O_KS + o; vs_ = p.out + O_VS + o; }
        const f32x4 a0 = *(const f32x4*)ks_, a1 = *(const f32x4*)(ks_ + 4), c0 = *(const f32x4*)vs_, c1 = *(const f32x4*)(vs_ + 4);
        u32x4 ko, vo;
        ko[0] = pk2(a0[0], a0[1]); ko[1] = pk2(a0[2], a0[3]); ko[2] = pk2(a1[0], a1[1]); ko[3] = pk2(a1[2], a1[3]);
        vo[0] = pk2(c0[0], c0[1]); vo[1] = pk2(c0[2], c0[3]); vo[2] = pk2(c1[0], c1[1]); vo[3] = pk2(c1[2], c1[3]);
        if (i == 0) { rk0 = ko; rv0 = vo; } else { rk1 = ko; rv1 = vo; }
      }
    }
  };
  f32x16 O[4];
#pragma unroll
  for (int v = 0; v < 4; ++v)
#pragma unroll
    for (int i = 0; i < 16; ++i) O[v][i] = 0.f;
  float m_run = -1e30f, l_run = 0.f;
  const int q4 = (lane & 15) >> 2, p4 = lane & 3, blk = (lane >> 4) & 1;
  const unsigned sofs = skey * A_LD + part * 16, vofs = skey * A_VLD + part * 16;
  auto qk = [&](int j, f32x16 (&st)[2]) {
    const char* kb = lds + (j & 1) * A_TILE;
#pragma unroll
    for (int kt = 0; kt < 2; ++kt) {
#pragma unroll
      for (int i = 0; i < 16; ++i) st[kt][i] = 0.f;
#pragma unroll
      for (int ks = 0; ks < 4; ++ks) {
        const bf16x8 kf = *(const bf16x8*)(kb + (kt * 32 + r) * A_LD + (map * 64 + ks * 16 + h * 8) * 2);
        st[kt] = MFMA32(kf, qf[ks], st[kt]);
      }
    }
    if (KIND == 1 && j == NT - 1) {
#pragma unroll
      for (int kt = 0; kt < 2; ++kt)
#pragma unroll
        for (int i = 0; i < 16; ++i) if (j * 64 + kt * 32 + crow(i, h) >= NKS) st[kt][i] = -1e30f;
    }
  };
  bf16x8 pk[4];
  auto smax = [&](int j, f32x16 (&sc)[2], f32x16 (&sn)[2]) {
    if (j + 1 < ntw) qk(j + 1, sn);
    float mx = sc[0][0];
#pragma unroll
    for (int kt = 0; kt < 2; ++kt)
#pragma unroll
      for (int i = 0; i < 16; ++i) mx = fmaxf(mx, sc[kt][i]);
    mx = fmaxf(mx, __shfl_xor(mx, 32));
    const float m_new = fmaxf(m_run, mx);
    const float alpha = __builtin_amdgcn_exp2f((m_run - m_new) * LOG2E);
    const float mb = m_new * LOG2E;
    float rs = 0.f;
#pragma unroll
    for (int kt = 0; kt < 2; ++kt)
#pragma unroll
      for (int i = 0; i < 16; ++i) { const float e = __builtin_amdgcn_exp2f(sc[kt][i] * LOG2E - mb); sc[kt][i] = e; rs += e; }
    rs += __shfl_xor(rs, 32);
    l_run = l_run * alpha + rs; m_run = m_new;
    if (__builtin_amdgcn_ballot_w64(alpha != 1.f) != 0ull) {
#pragma unroll
      for (int v = 0; v < 4; ++v)
#pragma unroll
        for (int i = 0; i < 16; ++i) O[v][i] *= alpha;
    }
    pk[0] = pack8(sc[0], 0); pk[1] = pack8(sc[0], 1); pk[2] = pack8(sc[1], 0); pk[3] = pack8(sc[1], 1);
  };
  auto pv = [&](int j) {
    const unsigned vaddr = lds_addr(lds + 2 * A_TILE + (j % 3) * A_VTILE) + (4 * h + q4) * A_VLD + (16 * blk + 4 * p4) * 2;
#pragma unroll
    for (int vt = 0; vt < 4; ++vt) {
      bf16x8 vf[4];
      tr_frag4<16 * A_VLD, 8 * A_VLD>(vaddr + vt * 64, vf);
#pragma unroll
      for (int ks = 0; ks < 4; ++ks) O[vt] = MFMA32(vf[ks], pk[ks], O[vt]);
    }
  };
  gload(0);
  { char* kb = lds + sofs; *(u32x4*)kb = rk0; *(u32x4*)(kb + 32 * A_LD) = rk1; char* vb = lds + 2 * A_TILE + vofs; *(u32x4*)vb = rv0; *(u32x4*)(vb + 32 * A_VLD) = rv1; }
  gload(1);
  { char* kb = lds + A_TILE + sofs; *(u32x4*)kb = rk0; *(u32x4*)(kb + 32 * A_LD) = rk1; }
  __syncthreads();
  f32x16 sA[2], sB[2];
  if (active && 0 < ntw) qk(0, sA);
  for (int j = 0; j < NT; j += 2) {
#pragma unroll
    for (int u = 0; u < 2; ++u) {
      const int jj = j + u;
      if (jj < NT) {
        if (jj + 1 < NT) { char* vb = lds + 2 * A_TILE + ((jj + 1) % 3) * A_VTILE + vofs; *(u32x4*)vb = rv0; *(u32x4*)(vb + 32 * A_VLD) = rv1; }
        if (jj + 2 < NT) gload(jj + 2);
        if (active) {
          if (map == 1 && jj >= 1 && jj - 1 < ntw) pv(jj - 1);
          if (jj < ntw) { if (u == 0) smax(jj, sA, sB); else smax(jj, sB, sA); }
          if (map == 0 && jj < ntw) pv(jj);
        }
        if (jj + 2 < NT) { char* kb = lds + (jj & 1) * A_TILE + sofs; *(u32x4*)kb = rk0; *(u32x4*)(kb + 32 * A_LD) = rk1; }
        __syncthreads();
      }
    }
  }
  if (active && map == 1 && ntw == NT) pv(NT - 1);
  __syncthreads();
  float* ex = (float*)lds;
  const float inv_l = 1.f / l_run;
  if (map == 1) {
#pragma unroll
    for (int vt = 0; vt < 4; ++vt)
#pragma unroll
      for (int g = 0; g < 4; ++g) {
        f32x4 o; o[0] = O[vt][4 * g] * inv_l; o[1] = O[vt][4 * g + 1] * inv_l; o[2] = O[vt][4 * g + 2] * inv_l; o[3] = O[vt][4 * g + 3] * inv_l;
        *(f32x4*)(ex + (qt * 32 + r) * 132 + vt * 32 + 8 * g + 4 * h) = o;
      }
  }
  __syncthreads();
  if (map == 0) {
    const float lam = ((const float*)(p.ws + W_MISC))[l];
    const float lam_init = (l == 0) ? 0.2f : (0.8f - 0.6f * 0.74081822068171788f);
    float ssq = 0.f;
#pragma unroll
    for (int vt = 0; vt < 4; ++vt)
#pragma unroll
      for (int g = 0; g < 4; ++g) {
        const f32x4 o2 = *(const f32x4*)(ex + (qt * 32 + r) * 132 + vt * 32 + 8 * g + 4 * h);
#pragma unroll
        for (int e = 0; e < 4; ++e) { const float o = O[vt][4 * g + e] * inv_l - lam * o2[e]; O[vt][4 * g + e] = o; ssq += o * o; }
      }
    ssq += __shfl_xor(ssq, 32);
    const float rms = rsqrtf(ssq * (1.f / 128.f) + LN_EPS) * (1.f - lam_init);
    const float* sg = p.in[14] + l * 128;
    const bool valid = KIND == 0 ? true : (qt == 0 && r < 16);
    if (valid) {
      bf16_t* dst = (bf16_t*)(p.ws + W_Z) + (size_t)qrow * NIN + 3072 + ha * 128;
#pragma unroll
      for (int vt = 0; vt < 4; ++vt)
#pragma unroll
        for (int g = 0; g < 4; ++g) {
          const int v0 = vt * 32 + 8 * g + 4 * h;
          const f32x4 gg = *(const f32x4*)(sg + v0);
          u32x2 o; o[0] = pk2(O[vt][4 * g] * rms * gg[0], O[vt][4 * g + 1] * rms * gg[1]); o[1] = pk2(O[vt][4 * g + 2] * rms * gg[2], O[vt][4 * g + 3] * rms * gg[3]);
          *(u32x2*)(dst + v0) = o;
        }
    }
  }
  __syncthreads();
}

constexpr int L_LD = 528;
constexpr int L_VLD = 320;
constexpr int L_Q = 0, L_K = 64 * L_LD, L_V = 2 * 64 * L_LD, L_SW = L_V + 64 * L_VLD;
constexpr int L_SWLD = 144;
constexpr int L_SC = L_SW + 64 * L_SWLD;
constexpr int S_MX = 0, S_G = 64, S_EMT = 128, S_DS0 = 192, S_DS1 = 256, S_QN = 320  , S_NV = 576  , S_GEND = 832, S_PAR = 840;
constexpr int LDS_BYTES = 153376;
static_assert(L_SC + 2 * S_PAR * 4 <= 131072, "lds");
#define WG_BAR() do { __builtin_amdgcn_fence(__ATOMIC_RELEASE, "workgroup"); __builtin_amdgcn_s_barrier(); __builtin_amdgcn_fence(__ATOMIC_ACQUIRE, "workgroup"); } while (0)

template <int KIND>
DI void mlstm_item(const Params& p, int l, int b, int hm, int half, char* lds) {
  const int tid0 = otid(), wave = uni(tid0 >> 6);
  const bf16_t* QA = (const bf16_t*)(p.ws + W_AB); const bf16_t* KA = (const bf16_t*)(p.ws + W_KA);
  const bf16_t* Z = (const bf16_t*)(p.ws + W_Z); bf16_t* H = (bf16_t*)(p.ws + W_H);
  const float* GIF = (const float*)(p.ws + W_GIF);
  float* scb = (float*)(lds + L_SC);
  int nchunks = KIND == 0 ? SEQ / 64 : 1; asm volatile("" : "+s"(nchunks));
  const int Lv = KIND == 0 ? 64 : 16;
  const size_t bh = KIND == 0 ? (size_t)(l * 4 + b) * 4 + hm : (size_t)(l * 8 + b) * 4 + hm;
  if (wave < 4) {
    f32x16 C[8];
    { const int lane = tid0 & 63, r = lane & 31, h = lane >> 5; (void)r; (void)h;
      if (KIND == 0) {
#pragma unroll
        for (int d = 0; d < 8; ++d)
#pragma unroll
          for (int i = 0; i < 16; ++i) C[d][i] = 0.f;
      } else {
        const float* cp = p.in[5] + bh * 65536 + (size_t)(4 * h) * 256 + half * 128 + wave * 32 + r;
#pragma unroll
        for (int d = 0; d < 8; ++d)
#pragma unroll
          for (int g = 0; g < 4; ++g) {
            C[d][4 * g] = cp[0]; C[d][4 * g + 1] = cp[256]; C[d][4 * g + 2] = cp[512]; C[d][4 * g + 3] = cp[768];
            cp += 2048; asm volatile("" : "+v"(cp));
          }
      }
    }
    for (int c = 0; c < nchunks; ++c) {
      int tid = tid0; asm volatile("" : "+v"(tid));
      const int lane = tid & 63, r = lane & 31, h = lane >> 5;
      const int q4 = (lane & 15) >> 2, p4 = lane & 3, blk = (lane >> 4) & 1;
      const float* sc = scb + (c & 1) * S_PAR;
      const int rowbase = KIND == 0 ? b * SEQ + c * 64 : MP + b * 16;
      WG_BAR();
      f32x16 accB[2];
#pragma unroll
      for (int tt = 0; tt < 2; ++tt)
#pragma unroll
        for (int i = 0; i < 16; ++i) accB[tt][i] = 0.f;
#pragma unroll
      for (int d = 0; d < 8; ++d)
#pragma unroll
        for (int s = 0; s < 2; ++s) {
          __builtin_amdgcn_sched_barrier(0);
          const bf16x8 cf = pack8(C[d], s);
#pragma unroll
          for (int tt = 0; tt < 2; ++tt) {
            const char* qp = lds + L_Q + (tt * 32 + r) * L_LD + (d * 32 + 16 * s + 4 * h) * 2;
            const s16x4 lo = *(const s16x4*)qp, hi = *(const s16x4*)(qp + 16);
            const bf16x8 qfr = __builtin_shufflevector(lo, hi, 0, 1, 2, 3, 4, 5, 6, 7);
            accB[tt] = MFMA32(cf, qfr, accB[tt]);
          }
        }
      __builtin_amdgcn_sched_barrier(0);
      bf16x8 vf[4];
      tr_frag4<16 * L_VLD, 4 * L_VLD>(lds_addr(lds + L_V) + (8 * h + q4) * L_VLD + (wave * 32 + 16 * blk + 4 * p4) * 2, vf);
      const float g_end = sc[S_GEND];
#pragma unroll
      for (int d = 0; d < 8; ++d) {
#pragma unroll
        for (int i = 0; i < 16; ++i) C[d][i] *= g_end;
        bf16x8 kf[4];
        tr_frag4<16 * L_LD, 4 * L_LD>(lds_addr(lds + L_K) + (8 * h + q4) * L_LD + (d * 32 + 16 * blk + 4 * p4) * 2, kf);
#pragma unroll
        for (int ks = 0; ks < 4; ++ks) C[d] = MFMA32(kf[ks], vf[ks], C[d]);
      }
      WG_BAR();
#pragma unroll
      for (int tt = 0; tt < 2; ++tt) {
        const int t = tt * 32 + r;
        const float g = sc[S_G + t];
#pragma unroll
        for (int i = 0; i < 16; ++i) accB[tt][i] *= g;
        const char* sp = lds + L_SW + (tt * 32 + r) * L_SWLD + h * 16;
#pragma unroll
        for (int ks = 0; ks < 4; ++ks) accB[tt] = MFMA32(vf[ks], *(const bf16x8*)(sp + ks * 32), accB[tt]);
        const float qn = (sc[S_QN + t] + sc[S_QN + 64 + t]) + (sc[S_QN + 128 + t] + sc[S_QN + 192 + t]);
        float den = sc[S_DS0 + t] + sc[S_DS1 + t] + g * qn;
        den = fmaxf(fabsf(den), sc[S_EMT + t]);
        const float rden = 1.f / den;
        if (t < Lv) {
          bf16_t* dst = H + (size_t)(rowbase + t) * D + hm * 256 + half * 128 + wave * 32;
#pragma unroll
          for (int g4 = 0; g4 < 4; ++g4) {
            u32x2 o; o[0] = pk2(accB[tt][4 * g4] * rden, accB[tt][4 * g4 + 1] * rden); o[1] = pk2(accB[tt][4 * g4 + 2] * rden, accB[tt][4 * g4 + 3] * rden);
            *(u32x2*)(dst + 8 * g4 + 4 * h) = o;
          }
        }
      }
    }
    WG_BAR();
    {
      const int lane = tid0 & 63, r = lane & 31, h = lane >> 5;
      float* co = p.out + (KIND == 0 ? O_CP : O_CS) + bh * 65536 + (size_t)(4 * h) * 256 + half * 128 + wave * 32 + r;
#pragma unroll
      for (int d = 0; d < 8; ++d)
#pragma unroll
        for (int g = 0; g < 4; ++g) {
          co[0] = C[d][4 * g]; co[256] = C[d][4 * g + 1]; co[512] = C[d][4 * g + 2]; co[768] = C[d][4 * g + 3];
          co += 2048; asm volatile("" : "+v"(co));
        }
    }
  } else {
    const int hw = wave - 4;
    float nreg = 0.f, m_prev = 0.f;
    if (KIND == 1) { nreg = p.in[6][bh * 256 + (tid0 - 256)]; m_prev = p.in[7][bh]; }
    u32x4 pq[8], pk[8], pv[4];
    float gi = 0.f, gf = 0.f, g_end_cur = 0.f;
    auto issue_loads = [&](int c, int tid) {
      const int ht = tid - 256, lane = tid & 63;
      const int rowbase = KIND == 0 ? b * SEQ + c * 64 : MP + b * 16;
      const bool tvalid = lane < Lv;
      gi = tvalid ? GIF[(size_t)(rowbase + lane) * 8 + hm] : -1e30f;
      gf = tvalid ? GIF[(size_t)(rowbase + lane) * 8 + 4 + hm] : 0.f;
#pragma unroll
      for (int i = 0; i < 8; ++i) {
        const int cidx = ht + 256 * i, t = cidx >> 5, pc = cidx & 31;
        const int row = rowbase + (t < Lv ? t : Lv - 1);
        pq[i] = *(const u32x4*)(QA + (size_t)row * D + hm * 256 + pc * 8);
        pk[i] = *(const u32x4*)(KA + (size_t)row * D + hm * 256 + pc * 8);
      }
#pragma unroll
      for (int i = 0; i < 4; ++i) {
        const int cidx = ht + 256 * i, t = cidx >> 4, pc = cidx & 15;
        const int row = rowbase + (t < Lv ? t : Lv - 1);
        pv[i] = *(const u32x4*)(Z + (size_t)row * NIN + 5120 + hm * 256 + half * 128 + pc * 8);
      }
    };
    auto scalars = [&](int par, int lane) -> float {
      const bool tvalid = lane < Lv;
      const float lf = tvalid ? (fminf(gf, 0.f) - __logf(1.f + __expf(-fabsf(gf)))) : 0.f;
      float bc = lf;
#pragma unroll
      for (int o = 1; o < 64; o <<= 1) { const float v = __shfl_up(bc, o); if (lane >= o) bc += v; }
      const float a = gi - bc;
      float cm = a;
#pragma unroll
      for (int o = 1; o < 64; o <<= 1) { const float v = __shfl_up(cm, o); if (lane >= o) cm = fmaxf(cm, v); }
      const float mxv = fmaxf(m_prev, cm);
      const float m_t = bc + mxv;
      const float mx_end = __shfl(mxv, 63), bc_end = __shfl(bc, 63);
      const float wend = __expf(a - mx_end);
      g_end_cur = __expf(m_prev - mx_end);
      if (hw == 0) {
        float* sc = scb + par * S_PAR;
        sc[S_MX + lane] = __expf(mx_end - mxv);
        sc[S_G + lane] = __expf(m_prev - mxv);
        sc[S_EMT + lane] = __expf(-m_t);
        if (lane == 0) sc[S_GEND] = g_end_cur;
      }
      m_prev = bc_end + mx_end;
      return wend;
    };
    auto stage_lds = [&](float wend_l, int tid) {
      const int ht = tid - 256;
#pragma unroll
      for (int i = 0; i < 8; ++i) {
        const int cidx = ht + 256 * i, t = cidx >> 5, pc = cidx & 31;
        const float we = __shfl(wend_l, t);
        float f[8]; unpack8(pk[i], f);
        u32x4 o; o[0] = pk2(f[0] * we, f[1] * we); o[1] = pk2(f[2] * we, f[3] * we); o[2] = pk2(f[4] * we, f[5] * we); o[3] = pk2(f[6] * we, f[7] * we);
        *(u32x4*)(lds + L_Q + t * L_LD + pc * 16) = pq[i];
        *(u32x4*)(lds + L_K + t * L_LD + pc * 16) = o;
      }
#pragma unroll
      for (int i = 0; i < 4; ++i) {
        const int cidx = ht + 256 * i, t = cidx >> 4, pc = cidx & 15;
        *(u32x4*)(lds + L_V + t * L_VLD + pc * 16) = pv[i];
      }
    };
    {
      int tid = tid0; asm volatile("" : "+v"(tid));
      issue_loads(0, tid);
      scb[S_NV + (tid - 256)] = nreg;
      const float wend = scalars(0, tid & 63);
      stage_lds(wend, tid);
    }
    for (int c = 0; c < nchunks; ++c) {
      int tid = tid0; asm volatile("" : "+v"(tid));
      const int ht = tid - 256, lane = tid & 63, r = lane & 31, h = lane >> 5;
      float* sc = scb + (c & 1) * S_PAR;
      float* scn = scb + ((c + 1) & 1) * S_PAR;
      const float g_end_c = g_end_cur;
      WG_BAR();
      const bool more = c + 1 < nchunks;
      if (more) issue_loads(c + 1, tid);
      {
        const int t = ht & 63, part = ht >> 6;
        const char* qp = lds + L_Q + t * L_LD + part * 128;
        float s = 0.f;
#pragma unroll
        for (int e = 0; e < 8; ++e) {
          const u32x4 qq = *(const u32x4*)(qp + e * 16); float f[8]; unpack8(qq, f);
#pragma unroll
          for (int z = 0; z < 8; ++z) s += f[z] * sc[S_NV + part * 64 + e * 8 + z];
        }
        sc[S_QN + part * 64 + t] = s;
      }
      if (hw < 3) {
        const int stl = hw == 2 ? 1 : 0, tt = hw == 0 ? 0 : 1;
        f32x16 S, S2;
#pragma unroll
        for (int i = 0; i < 16; ++i) { S[i] = 0.f; S2[i] = 0.f; }
        const char* ka = lds + L_K + (stl * 32 + r) * L_LD + h * 16;
        const char* qa = lds + L_Q + (tt * 32 + r) * L_LD + h * 16;
#pragma unroll 4
        for (int ks = 0; ks < 16; ks += 2) {
          S = MFMA32(*(const bf16x8*)(ka + ks * 32), *(const bf16x8*)(qa + ks * 32), S);
          S2 = MFMA32(*(const bf16x8*)(ka + ks * 32 + 32), *(const bf16x8*)(qa + ks * 32 + 32), S2);
        }
        const int t = tt * 32 + r;
        const float cw = sc[S_MX + t];
        float rs = 0.f;
#pragma unroll
        for (int g = 0; g < 4; ++g) {
          float wv[4];
#pragma unroll
          for (int e = 0; e < 4; ++e) {
            const int s = stl * 32 + 8 * g + 4 * h + e;
            wv[e] = s <= t ? (S[4 * g + e] + S2[4 * g + e]) * cw : 0.f; rs += wv[e];
          }
          u32x2 o; o[0] = pk2(wv[0], wv[1]); o[1] = pk2(wv[2], wv[3]);
          *(u32x2*)(lds + L_SW + t * L_SWLD + (stl * 32 + 8 * g + 4 * h) * 2) = o;
        }
        rs += __shfl_xor(rs, 32);
        if (h == 0) {
          if (hw == 0) { sc[S_DS0 + t] = rs; sc[S_DS1 + t] = 0.f; }
          else if (hw == 1) sc[S_DS0 + t] = rs;
          else sc[S_DS1 + t] = rs;
        }
      } else {
        const int t = lane >> 1, hs = lane & 1;
        u32x4 z; z[0] = 0; z[1] = 0; z[2] = 0; z[3] = 0;
        *(u32x4*)(lds + L_SW + t * L_SWLD + 64 + hs * 32) = z; *(u32x4*)(lds + L_SW + t * L_SWLD + 64 + hs * 32 + 16) = z;
      }
      {
        float s0 = 0.f, s1 = 0.f, s2 = 0.f, s3 = 0.f;
        const char* kp = lds + L_K + ht * 2;
#pragma unroll
        for (int t = 0; t < 64; t += 4) {
          s0 += bflo((unsigned)*(const bf16_t*)(kp + t * L_LD)); s1 += bflo((unsigned)*(const bf16_t*)(kp + (t + 1) * L_LD));
          s2 += bflo((unsigned)*(const bf16_t*)(kp + (t + 2) * L_LD)); s3 += bflo((unsigned)*(const bf16_t*)(kp + (t + 3) * L_LD));
        }
        nreg = g_end_c * nreg + ((s0 + s1) + (s2 + s3));
        scn[S_NV + ht] = nreg;
      }
      float wend = 0.f;
      if (more) wend = scalars((c + 1) & 1, lane);
      WG_BAR();
      if (more) stage_lds(wend, tid);
    }
    WG_BAR();
    if (half == 0) {
      p.out[(KIND == 0 ? O_NP : O_NS) + bh * 256 + (tid0 - 256)] = nreg;
      if (tid0 == 256) p.out[(KIND == 0 ? O_MPP : O_MSS) + bh] = m_prev;
    }
  }
}

DI void mixer_phase(const Params& p, int l, char* lds, int cidx, bool ml_only) {
  unsigned* ctr = (unsigned*)(p.ws + W_MISC) + 16 + cidx;
  int* s_item = (int*)(lds + LDS_BYTES - 16);
  const int total = 32 + 64 + 64 + 2048;
  for (;;) {
    __syncthreads();
    if (threadIdx.x == 0) *s_item = (int)atomicAdd(ctr, 1u);
    __syncthreads();
    const int it = *s_item;
    __syncthreads();
    if (it >= total) break;
    if (ml_only && it >= 96) break;
    if (it < 32) { mlstm_item<0>(p, l, it >> 3, (it >> 1) & 3, it & 1, lds); continue; }
    if (it < 96) { const int x = it - 32; mlstm_item<1>(p, l, x >> 3, (x >> 1) & 3, x & 1, lds); continue; }
    if (it < 160) { attn_item<1>(p, l, (it - 96) >> 3, (it - 96) & 7, 0, lds); continue; }
    { const int x = it - 160; attn_item<0>(p, l, (x & 31) >> 3, x & 7, 63 - (x >> 5), lds); }
  }
}

DI void merge_phase(const Params& p, int l) {
  const bf16_t* Z = (const bf16_t*)(p.ws + W_Z); const bf16_t* H = (const bf16_t*)(p.ws + W_H); bf16_t* Y = (bf16_t*)(p.ws + W_AB);
  const int tidq = otid(); const int lane = tidq & 63, gw = blockIdx.x * 8 + (tidq >> 6), ngw = gridDim.x * 8;
  const float* mhg = p.in[15] + (size_t)l * D;
  for (int row = gw; row < M; row += ngw) {
    const int col = lane * 16;
    const bf16_t* z = Z + (size_t)row * NIN + col;
    float hv[16];
    unpack8(*(const u32x4*)(H + (size_t)row * D + col), hv); unpack8(*(const u32x4*)(H + (size_t)row * D + col + 8), hv + 8);
    float s = 0.f;
#pragma unroll
    for (int e = 0; e < 16; ++e) s += hv[e];
#pragma unroll
    for (int o = 1; o < 16; o <<= 1) s += __shfl_xor(s, o);
    const float mean = s * (1.f / 256.f);
    float s2 = 0.f;
#pragma unroll
    for (int e = 0; e < 16; ++e) { hv[e] -= mean; s2 += hv[e] * hv[e]; }
#pragma unroll
    for (int o = 1; o < 16; o <<= 1) s2 += __shfl_xor(s2, o);
    const float rstd = rsqrtf(s2 * (1.f / 256.f) + LN_EPS);
#pragma unroll
    for (int hh = 0; hh < 2; ++hh) {
      float oa[8], om[8], ga[8], gb[8];
      unpack8(*(const u32x4*)(z + 3072 + hh * 8), oa); unpack8(*(const u32x4*)(z + 6144 + hh * 8), om);
      unpack8(*(const u32x4*)(z + 7168 + hh * 8), ga); unpack8(*(const u32x4*)(z + 8192 + hh * 8), gb);
      const f32x4 g0 = *(const f32x4*)(mhg + col + hh * 8), g1 = *(const f32x4*)(mhg + col + hh * 8 + 4);
      float y[8];
#pragma unroll
      for (int e = 0; e < 8; ++e) {
        const float hn = hv[hh * 8 + e] * rstd * (e < 4 ? g0[e] : g1[e - 4]);
        y[e] = sigmoidf_(ga[e]) * oa[e] + sigmoidf_(gb[e]) * (hn * sigmoidf_(om[e]));
      }
      u32x4 o; o[0] = pk2(y[0], y[1]); o[1] = pk2(y[2], y[3]); o[2] = pk2(y[4], y[5]); o[3] = pk2(y[6], y[7]);
      *(u32x4*)(Y + (size_t)row * D + col + hh * 8) = o;
    }
  }
}

DI void ln_phase(const Params& p, const float* g, const float* bta, bool final_out) {
  const int tidq = otid(); const int lane = tidq & 63, gw = blockIdx.x * 8 + (tidq >> 6), ngw = gridDim.x * 8;
  float* R = (float*)(p.ws + W_R); bf16_t* AB = (bf16_t*)(p.ws + W_AB);
  for (int row0 = gw; row0 < M; row0 += 2 * ngw) {
    f32x4 v[2][4]; float s[2] = {0.f, 0.f};
    const int row1 = row0 + ngw; const bool has1 = row1 < M;
#pragma unroll
    for (int q = 0; q < 2; ++q) {
      const float* xr = R + (size_t)(q == 0 ? row0 : (has1 ? row1 : row0)) * D;
#pragma unroll
      for (int j = 0; j < 4; ++j) { v[q][j] = *(const f32x4*)(xr + j * 256 + lane * 4); s[q] += (v[q][j][0] + v[q][j][1]) + (v[q][j][2] + v[q][j][3]); }
    }
#pragma unroll
    for (int q = 0; q < 2; ++q) {
      if (q == 1 && !has1) break;
      const int row = q == 0 ? row0 : row1;
      const float mean = wave_sum(s[q]) * (1.f / D);
      float s2 = 0.f;
#pragma unroll
      for (int j = 0; j < 4; ++j) { v[q][j] = v[q][j] - mean; s2 += (v[q][j][0] * v[q][j][0] + v[q][j][1] * v[q][j][1]) + (v[q][j][2] * v[q][j][2] + v[q][j][3] * v[q][j][3]); }
      const float rstd = rsqrtf(wave_sum(s2) * (1.f / D) + LN_EPS);
      float* dst = final_out ? (row < MP ? p.out + O_YP + (size_t)row * D : p.out + O_YS + (size_t)(row - MP) * D) : R + (size_t)row * D;
#pragma unroll
      for (int j = 0; j < 4; ++j) {
        const int c = j * 256 + lane * 4;
        const f32x4 gg = *(const f32x4*)(g + c), bb = *(const f32x4*)(bta + c);
        const f32x4 o = v[q][j] * rstd * gg + bb;
        *(f32x4*)(dst + c) = o;
        if (!final_out) { u32x2 ob; ob[0] = pk2(o[0], o[1]); ob[1] = pk2(o[2], o[3]); *(u32x2*)(AB + (size_t)row * D + c) = ob; }
      }
    }
  }
}

DI float gelu_f(float v) {
  const float av = fabsf(v), d = av * 0.2316418882f + 1.0f;
  const float t = __builtin_amdgcn_rcpf(d);
  float q = t * 0.5307027145f + (-0.7265760135f); q = q * t + 0.7107068705f; q = q * t + (-0.142248368f); q = q * t + 0.127414796f; q = q * t;
  const float e = __builtin_amdgcn_exp2f((v * v) * (-0.72134752044f));
  const float m = v * (q * e), r = v - m;
  return v < 0.f ? m : r;
}
DI void ffnconv_phase(const Params& p, int l) {
  const bf16_t* U = (const bf16_t*)(p.ws + W_Z); bf16_t* HF = (bf16_t*)(p.ws + W_Z + (size_t)M * NUP * 2);
  const float* cw = p.in[20] + (size_t)l * 3 * NUP; const float* cb = p.in[21] + (size_t)l * NUP;
  const unsigned total = (unsigned)(M / 4) * 352u;
  for (unsigned it = blockIdx.x * NTH + (unsigned)otid(); it < total; it += gridDim.x * NTH) {
    const unsigned rg = it / 352u, cc = it - rg * 352u;
    const int col = (int)cc * 8, row0 = (int)rg * 4;
    int t0; const float* st = nullptr;
    if (row0 < MP) t0 = row0 & (SEQ - 1); else { t0 = (row0 - MP) & 15; st = p.in[8] + ((size_t)(l * 8 + ((row0 - MP) >> 4)) * 2) * NUP; }
    float gl[4][8];
#pragma unroll
    for (int hf = 0; hf < 2; ++hf) {
      const int c2 = col + hf * DFF;
      float w[3][8], bias[8], x[6][8];
#pragma unroll
      for (int j = 0; j < 3; ++j) { const f32x4 a = *(const f32x4*)(cw + j * NUP + c2), b2 = *(const f32x4*)(cw + j * NUP + c2 + 4);
        w[j][0] = a[0]; w[j][1] = a[1]; w[j][2] = a[2]; w[j][3] = a[3]; w[j][4] = b2[0]; w[j][5] = b2[1]; w[j][6] = b2[2]; w[j][7] = b2[3]; }
      { const f32x4 a = *(const f32x4*)(cb + c2), b2 = *(const f32x4*)(cb + c2 + 4);
        bias[0] = a[0]; bias[1] = a[1]; bias[2] = a[2]; bias[3] = a[3]; bias[4] = b2[0]; bias[5] = b2[1]; bias[6] = b2[2]; bias[7] = b2[3]; }
#pragma unroll
      for (int j = 0; j < 6; ++j) {
        const int t = t0 - 2 + j;
        if (t >= 0) unpack8(*(const u32x4*)(U + (size_t)(row0 - 2 + j) * NUP + c2), x[j]);
        else if (st) { const float* sp = st + (size_t)(2 + t) * NUP + c2; const f32x4 a = *(const f32x4*)sp, b2 = *(const f32x4*)(sp + 4);
          x[j][0] = a[0]; x[j][1] = a[1]; x[j][2] = a[2]; x[j][3] = a[3]; x[j][4] = b2[0]; x[j][5] = b2[1]; x[j][6] = b2[2]; x[j][7] = b2[3]; }
        else {
#pragma unroll
          for (int e = 0; e < 8; ++e) x[j][e] = 0.f; }
      }
#pragma unroll
      for (int a = 0; a < 4; ++a) {
        float o[8];
#pragma unroll
        for (int e = 0; e < 8; ++e) {
          const float u = bias[e] + w[0][e] * x[a][e] + w[1][e] * x[a + 1][e] + w[2][e] * x[a + 2][e];
          if (hf == 0) gl[a][e] = gelu_f(u); else o[e] = gl[a][e] * u;
        }
        if (hf == 1) {
          u32x4 ov; ov[0] = pk2(o[0], o[1]); ov[1] = pk2(o[2], o[3]); ov[2] = pk2(o[4], o[5]); ov[3] = pk2(o[6], o[7]);
          *(u32x4*)(HF + (size_t)(row0 + a) * DFF + col) = ov;
        }
      }
    }
  }
}

#define XB_TMO      128
#define XB_XCNT(j)  (256  + 64 * (j))
#define XB_XSUB(j)  (1280 + 64 * (j))
#define XB_XGEN(j)  (2304 + 64 * (j))
#define XB_TOP      3328
#define XB_TOPGEN   3392
#define XCD_BAR_WORDS 3456
#define XB_SPIN_CAP (1u << 18)
#define XLAS __attribute__((address_space(3)))
DI unsigned xb_ld(unsigned* p)              { return __hip_atomic_load(p, __ATOMIC_RELAXED, __HIP_MEMORY_SCOPE_AGENT); }
DI unsigned xb_add(unsigned* p, unsigned v) { return __hip_atomic_fetch_add(p, v, __ATOMIC_RELAXED, __HIP_MEMORY_SCOPE_AGENT); }
DI unsigned xb_xcc_id() { return (unsigned)__builtin_amdgcn_s_getreg((3 << 11) | 20) & 0xFu; }
#define XB_SPIN(cond, bar) do { unsigned _sp = 0; while (cond) { __builtin_amdgcn_s_sleep(1); \
    if ((++_sp & 255u) == 0u) { if (xb_ld(&(bar)[XB_TMO])) break; if (_sp > XB_SPIN_CAP) { atomicAdd(&(bar)[XB_TMO], 1u); break; } } } } while (0)
struct XcdBarrier { unsigned* bar; unsigned x; volatile XLAS unsigned* st; };
DI XcdBarrier xcd_barrier_post(unsigned* bar, volatile XLAS unsigned* st) {
  XcdBarrier b; b.bar = bar; b.x = xb_xcc_id(); b.st = st;
  if (threadIdx.x == 0) (void)xb_add(&bar[XB_XCNT(b.x)], 1u);
  return b;
}
DI void xcd_barrier_complete(unsigned* bar, unsigned x, unsigned& nloc, unsigned& nx) {
  const unsigned G = gridDim.x * gridDim.y * gridDim.z;
  unsigned sum, cnt, mine, sp = 0u;
  for (;;) {
    sum = 0u; cnt = 0u; mine = 0u;
#pragma unroll
    for (unsigned j = 0; j < 16; ++j) { const unsigned c = xb_ld(&bar[XB_XCNT(j)]); sum += c; cnt += (c > 0u) ? 1u : 0u; mine = (j == x) ? c : mine; }
    if (sum == G) break;
    __builtin_amdgcn_s_sleep(1);
    if ((++sp & 255u) == 0u) { if (xb_ld(&bar[XB_TMO])) break; if (sp > XB_SPIN_CAP) { atomicAdd(&bar[XB_TMO], 1u); break; } }
  }
  nloc = mine > 0u ? mine : 1u; nx = cnt > 0u ? cnt : 1u;
}
DI void xcd_barrier(const XcdBarrier& b) {
  asm volatile("s_waitcnt vmcnt(0)" ::: "memory");
  __syncthreads();
  if (threadIdx.x == 0) {
    unsigned* bar = b.bar;
    __builtin_amdgcn_s_waitcnt(0);
    unsigned nloc = b.st[0], nx = b.st[1];
    if (nloc == 0u) { xcd_barrier_complete(bar, b.x, nloc, nx); b.st[0] = nloc; b.st[1] = nx; }
    const unsigned old = xb_add(&bar[XB_XSUB(b.x)], 1u);
    const unsigned gen = old / nloc;
    if (old + 1u == (gen + 1u) * nloc) {
      __builtin_amdgcn_fence(__ATOMIC_RELEASE, "agent");
      asm volatile("s_waitcnt vmcnt(0)" ::: "memory");
      const unsigned og = xb_add(&bar[XB_TOP], 1u);
      const unsigned tg = og / nx;
      if (og + 1u == (tg + 1u) * nx) xb_add(&bar[XB_TOPGEN], 1u);
      else XB_SPIN(xb_ld(&bar[XB_TOPGEN]) == tg, bar);
      __builtin_amdgcn_fence(__ATOMIC_ACQUIRE, "agent");
      xb_add(&bar[XB_XGEN(b.x)], 1u);
      asm volatile("s_waitcnt vmcnt(0)" ::: "memory");
    } else {
      XB_SPIN(xb_ld(&bar[XB_XGEN(b.x)]) == gen, bar);
      __builtin_amdgcn_fence(__ATOMIC_ACQUIRE, "agent");
      asm volatile("s_waitcnt vmcnt(0)" ::: "memory");
    }
  }
  __syncthreads();
}

constexpr int NPH = 21;
DI void run_phase(const Params& p, int ph, char* lds) {
#ifndef ONLY
  if (ph == 0) { phase0(p, lds); return; }
#else
  if (ph == 0) return;
#endif
  const int l = (ph - 1) / 10, s = (ph - 1) % 10;
#ifdef ONLY
  if (s != ONLY) return;
#endif
  switch (s) {
    case 0: gemm_phase<EPI_IN>(p, l, (const bf16_t*)(p.ws + W_AB), D, (const bf16_t*)(p.ws + W_WIN) + (size_t)l * NIN * D, D, NIN / 256, lds); break;
    case 1: qkconv_phase(p, l); gif_phase(p, l, lds, 0); break;
    case 2: mixer_phase(p, l, lds, l, false); break;
    case 3: merge_phase(p, l); break;
    case 4: gemm_phase<EPI_OUT>(p, l, (const bf16_t*)(p.ws + W_AB), D, (const bf16_t*)(p.ws + W_WOUT) + (size_t)l * D * D, D, D / 256, lds); break;
    case 5: ln_phase(p, p.in[17] + l * D, p.in[18] + l * D, false); break;
    case 6: gemm_phase<EPI_UP>(p, l, (const bf16_t*)(p.ws + W_AB), D, (const bf16_t*)(p.ws + W_WUP) + (size_t)l * NUP * D, D, NUP / 256, lds); break;
    case 7: ffnconv_phase(p, l); break;
    case 8: gemm_phase<EPI_DOWN>(p, l, (const bf16_t*)(p.ws + W_Z + (size_t)M * NUP * 2), DFF, (const bf16_t*)(p.ws + W_WDN) + (size_t)l * D * DFF, DFF, D / 256, lds); break;
    case 9: ln_phase(p, p.in[23] + l * D, p.in[24] + l * D, l == 1); break;
  }
}

__global__ void __launch_bounds__(NTH) mega(Params p, int ph_lo, int ph_hi) {
  extern __shared__ __attribute__((aligned(16))) char lds[];
#if MULTI_LAUNCH
  for (int ph = ph_lo; ph < ph_hi; ++ph) run_phase(p, ph, lds);
#else
  cg::grid_group grid = cg::this_grid();
  phase0(p, lds);
  grid.sync();
  volatile XLAS unsigned* xst = (volatile XLAS unsigned*)((XLAS char*)lds + (LDS_BYTES - 32));
  if (threadIdx.x == 0) { xst[0] = 0u; xst[1] = 0u; }
  __syncthreads();
  const XcdBarrier xb = xcd_barrier_post((unsigned*)(p.ws + W_BAR), xst);
#define GSYNC() xcd_barrier(xb)
  for (int l = 0; l < 2; ++l) {
    gemm_phase<EPI_IN>(p, l, (const bf16_t*)(p.ws + W_AB), D, (const bf16_t*)(p.ws + W_WIN) + (size_t)l * NIN * D, D, NIN / 256, lds);
    {
      const int nun = NTM * (NIN / 256), G = (int)gridDim.x;
      const int busy = nun % G;
      gif_phase(p, l, lds, (busy > 0 && busy * 2 < G) ? busy : 0);
    }
    GSYNC();
#ifdef PROBE_GIN2
    gemm_phase<EPI_IN>(p, l, (const bf16_t*)(p.ws + W_AB), D, (const bf16_t*)(p.ws + W_WIN) + (size_t)l * NIN * D, D, NIN / 256, lds);
    GSYNC();
#endif
    qkconv_phase(p, l);
    GSYNC();
#if defined(PROBE_EW2) || defined(PROBE_QKC2)
    qkconv_phase(p, l);
    GSYNC();
#endif
    mixer_phase(p, l, lds, l, false);
    GSYNC();
#ifdef PROBE_ML2
    mixer_phase(p, l, lds, l + 2, true);
    GSYNC();
#endif
#ifdef PROBE_MIX2
    mixer_phase(p, l, lds, l + 2, false);
    GSYNC();
#endif
    merge_phase(p, l);
    GSYNC();
#ifdef PROBE_SYNC
    for (int q = 0; q < 20; ++q) GSYNC();
#endif
#if defined(PROBE_EW2) || defined(PROBE_MRG2)
    merge_phase(p, l);
    GSYNC();
#endif
    gemm_phase<EPI_OUT>(p, l, (const bf16_t*)(p.ws + W_AB), D, (const bf16_t*)(p.ws + W_WOUT) + (size_t)l * D * D, D, D / 256, lds);
    GSYNC();
    ln_phase(p, p.in[17] + l * D, p.in[18] + l * D, false);
    GSYNC();
    gemm_phase<EPI_UP>(p, l, (const bf16_t*)(p.ws + W_AB), D, (const bf16_t*)(p.ws + W_WUP) + (size_t)l * NUP * D, D, NUP / 256, lds);
    GSYNC();
    ffnconv_phase(p, l);
    GSYNC();
#if defined(PROBE_EW2) || defined(PROBE_FFC2)
    ffnconv_phase(p, l);
    GSYNC();
#endif
    gemm_phase<EPI_DOWN>(p, l, (const bf16_t*)(p.ws + W_Z + (size_t)M * NUP * 2), DFF, (const bf16_t*)(p.ws + W_WDN) + (size_t)l * D * DFF, DFF, D / 256, lds);
    GSYNC();
    ln_phase(p, p.in[23] + l * D, p.in[24] + l * D, l == 1);
    if (l == 0) GSYNC();
  }
#endif
}

extern "C" void kernel_launch(void* const* d_in, const int* in_sizes, int n_in, void* d_out, int out_size, void* d_ws, size_t ws_size, hipStream_t stream) {
  static int grid = 0;
  if (grid == 0) {
    if (n_in != 25 || (size_t)out_size != O_END || ws_size < W_END) { fprintf(stderr, "kernel_launch: unexpected sizes n_in %d out %d (want %zu) ws %zu (want %zu)\n", n_in, out_size, (size_t)O_END, ws_size, (size_t)W_END); grid = -1; return; }
    int dev = 0, cus = 0, per_cu = 0;
    hipGetDevice(&dev);
    hipDeviceGetAttribute(&cus, hipDeviceAttributeMultiprocessorCount, dev);
    if (hipFuncSetAttribute((const void*)mega, hipFuncAttributeMaxDynamicSharedMemorySize, LDS_BYTES) != hipSuccess) { fprintf(stderr, "hipFuncSetAttribute failed\n"); grid = -1; return; }
    hipOccupancyMaxActiveBlocksPerMultiprocessor(&per_cu, (const void*)mega, NTH, LDS_BYTES);
    if (per_cu < 1) per_cu = 1;
    grid = cus * 1;
    (void)hipGetLastError();
  }
  if (grid < 0) return;
  Params p{};
  for (int i = 0; i < 25; ++i) p.in[i] = (const float*)d_in[i];
  p.out = (float*)d_out; p.ws = (unsigned char*)d_ws;
#if MULTI_LAUNCH
  for (int ph = 0; ph < NPH; ++ph) hipLaunchKernelGGL(mega, dim3(grid), dim3(NTH), LDS_BYTES, stream, p, ph, ph + 1);
#else
  int lo = 0, hi = NPH;
  void* args[] = {&p, &lo, &hi};
  hipError_t e = hipLaunchCooperativeKernel((const void*)mega, dim3(grid), dim3(NTH), args, LDS_BYTES, stream);
  if (e != hipSuccess) fprintf(stderr, "cooperative launch failed: %s (grid %d)\n", hipGetErrorString(e), grid);
#endif
}
```

```cpp
#include <hip/hip_runtime.h>
#include <hip/hip_cooperative_groups.h>
#include <cstdio>
namespace cg = cooperative_groups;

#ifndef MULTI_LAUNCH
#define MULTI_LAUNCH 0
#endif

typedef unsigned short bf16_t;
typedef short bf16x8 __attribute__((ext_vector_type(8)));
typedef short s16x4 __attribute__((ext_vector_type(4)));
typedef float f32x16 __attribute__((ext_vector_type(16)));
typedef float f32x4 __attribute__((ext_vector_type(4)));
typedef unsigned u32x4 __attribute__((ext_vector_type(4)));
typedef unsigned u32x2 __attribute__((ext_vector_type(2)));
#define DI __device__ __forceinline__
#define MFMA32(a, b, c) __builtin_amdgcn_mfma_f32_32x32x16_bf16((a), (b), (c), 0, 0, 0)

constexpr int NTH = 512;
constexpr int D = 1024, SEQ = 8192, NB = 4, MP = NB * SEQ, MS = 128, M = MP + MS, NTM = 129;
constexpr int DIN = 9224, NIN = 9216, DFF = 2816, NUP = 5632;
constexpr int PAST = 4096, NKS = PAST + 16;
constexpr float ALPHA = 1.4142135623730951f;
constexpr float LN_EPS = 1e-5f;
constexpr float LOG2E = 1.4426950408889634f;

constexpr size_t O_YP = 0;
constexpr size_t O_YS = O_YP + (size_t)MP * D;
constexpr size_t O_KP = O_YS + (size_t)MS * D;
constexpr size_t O_VP = O_KP + (size_t)2 * MP * 1024;
constexpr size_t O_MCP = O_VP + (size_t)2 * MP * 1024;
constexpr size_t O_CP = O_MCP + (size_t)2 * 4 * 3 * 2048;
constexpr size_t O_NP = O_CP + (size_t)2 * 4 * 4 * 65536;
constexpr size_t O_MPP = O_NP + (size_t)2 * 4 * 4 * 256;
constexpr size_t O_FCP = O_MPP + 32;
constexpr size_t O_KS = O_FCP + (size_t)2 * 4 * 2 * NUP;
constexpr size_t O_VS = O_KS + (size_t)2 * MS * 1024;
constexpr size_t O_MCS = O_VS + (size_t)2 * MS * 1024;
constexpr size_t O_CS = O_MCS + (size_t)2 * 8 * 3 * 2048;
constexpr size_t O_NS = O_CS + (size_t)2 * 8 * 4 * 65536;
constexpr size_t O_MSS = O_NS + (size_t)2 * 8 * 4 * 256;
constexpr size_t O_FCS = O_MSS + 64;
constexpr size_t O_END = O_FCS + (size_t)2 * 8 * 2 * NUP;

constexpr size_t W_Z = 0;
constexpr size_t W_H = W_Z + (size_t)M * NIN * 2;
constexpr size_t W_AB = W_H + (size_t)M * D * 2;
constexpr size_t W_KA = W_AB + (size_t)M * D * 2;
constexpr size_t W_R = W_KA + (size_t)M * D * 2;
constexpr size_t W_WIN = W_R + (size_t)M * D * 4;
constexpr size_t W_WOUT = W_WIN + (size_t)2 * NIN * D * 2;
constexpr size_t W_WUP = W_WOUT + (size_t)2 * D * D * 2;
constexpr size_t W_WDN = W_WUP + (size_t)2 * NUP * D * 2;
constexpr size_t W_GIF = W_WDN + (size_t)2 * D * DFF * 2;
constexpr size_t W_ROPE = W_GIF + (size_t)M * 8 * 4;
constexpr size_t W_MISC = W_ROPE + (size_t)8192 * 32 * 8;
constexpr size_t W_BAR = W_MISC + 4096;
constexpr size_t W_END = W_BAR + 16384;

struct Params {
  const float* in[25];
  float* out;
  unsigned char* ws;
};

DI unsigned f2bf(float x) { unsigned u = __float_as_uint(x); u += 0x7fffu + ((u >> 16) & 1u); return u >> 16; }
typedef __bf16 bf16v2 __attribute__((ext_vector_type(2)));
typedef float f32x2 __attribute__((ext_vector_type(2)));
DI unsigned pk2(float a, float b) { f32x2 v; v[0] = a; v[1] = b; return __builtin_bit_cast(unsigned, __builtin_convertvector(v, bf16v2)); }
DI float bflo(unsigned u) { return __uint_as_float(u << 16); }
DI float bfhi(unsigned u) { return __uint_as_float(u & 0xffff0000u); }
DI float sigmoidf_(float x) { return __builtin_amdgcn_rcpf(1.f + __builtin_amdgcn_exp2f(-1.4426950408889634f * x)); }
DI float wave_sum(float v) {
#pragma unroll
  for (int o = 1; o < 64; o <<= 1) v += __shfl_xor(v, o);
  return v;
}
DI int crow(int i, int h) { return (i & 3) + 8 * (i >> 2) + 4 * h; }
DI bf16x8 pack8(const f32x16& x, int s) {
  u32x4 p;
  p[0] = pk2(x[8 * s + 0], x[8 * s + 1]); p[1] = pk2(x[8 * s + 2], x[8 * s + 3]);
  p[2] = pk2(x[8 * s + 4], x[8 * s + 5]); p[3] = pk2(x[8 * s + 6], x[8 * s + 7]);
  return __builtin_bit_cast(bf16x8, p);
}
DI void unpack8(u32x4 v, float* f) {
  f[0] = bflo(v[0]); f[1] = bfhi(v[0]); f[2] = bflo(v[1]); f[3] = bfhi(v[1]);
  f[4] = bflo(v[2]); f[5] = bfhi(v[2]); f[6] = bflo(v[3]); f[7] = bfhi(v[3]);
}
typedef __attribute__((address_space(3))) s16x4 lds_s16x4;
DI bf16x8 tr_frag(unsigned a_lo, unsigned a_hi) {
  const s16x4 lo = __builtin_amdgcn_ds_read_tr16_b64_v4i16((lds_s16x4*)(size_t)a_lo);
  const s16x4 hi = __builtin_amdgcn_ds_read_tr16_b64_v4i16((lds_s16x4*)(size_t)a_hi);
  return __builtin_shufflevector(lo, hi, 0, 1, 2, 3, 4, 5, 6, 7);
}
template <int STEP, int HIOFF>
DI void tr_frag4(unsigned a, bf16x8 (&f)[4]) {
#pragma unroll
  for (int i = 0; i < 4; ++i) f[i] = tr_frag(a + i * STEP, a + i * STEP + HIOFF);
}
DI int otid() { int t = threadIdx.x; asm volatile("" : "+v"(t)); return t; }
DI int uni(int v) { return __builtin_amdgcn_readfirstlane(v); }
DI unsigned lds_addr(const void* p) { return (unsigned)(size_t)p; }

DI const float* xrow_ptr(const Params& p, int l, int row) {
  if (l == 0) return row < MP ? p.in[0] + (size_t)row * D : p.in[1] + (size_t)(row - MP) * D;
  return (const float*)(p.ws + W_R) + (size_t)row * D;
}

DI void transpose_w(const float* W, int K, int N, int src_ld, bf16_t* WT, bool remap, char* lds) {
  float* scr = (float*)lds;
  const int nkb = K / 64, nnb = N / 64, tid = otid();
  for (int it = blockIdx.x; it < nkb * nnb; it += gridDim.x) {
    const int kb = it / nnb, nb = it % nnb, k0 = kb * 64, n0 = nb * 64;
    const int ns = (remap && n0 >= 7168) ? n0 + 8 : n0;
#pragma unroll
    for (int i = 0; i < 8; ++i) {
      const int kk = (tid >> 6) + 8 * i, nn = tid & 63;
      scr[kk * 65 + nn] = W[(size_t)(k0 + kk) * src_ld + ns + nn];
    }
    __syncthreads();
    {
      const int n = tid >> 3, c = tid & 7;
      const float* s = scr + (8 * c) * 65 + n;
      u32x4 o;
      o[0] = pk2(s[0], s[65]); o[1] = pk2(s[2 * 65], s[3 * 65]); o[2] = pk2(s[4 * 65], s[5 * 65]); o[3] = pk2(s[6 * 65], s[7 * 65]);
      const int nd = (remap && n0 < 2048) ? ((n < 32) ? 2 * n : 2 * (n - 32) + 1) : n;
      *(u32x4*)(WT + (size_t)(n0 + nd) * K + k0 + 8 * c) = o;
    }
    __syncthreads();
  }
}

DI void phase0(const Params& p, char* lds) {
  const int tid = otid();
  for (int l = 0; l < 2; ++l) {
    transpose_w(p.in[9] + (size_t)l * D * DIN, D, NIN, DIN, (bf16_t*)(p.ws + W_WIN) + (size_t)l * NIN * D, true, lds);
    transpose_w(p.in[16] + (size_t)l * D * D, D, D, D, (bf16_t*)(p.ws + W_WOUT) + (size_t)l * D * D, false, lds);
    transpose_w(p.in[19] + (size_t)l * D * NUP, D, NUP, NUP, (bf16_t*)(p.ws + W_WUP) + (size_t)l * NUP * D, false, lds);
    transpose_w(p.in[22] + (size_t)l * DFF * D, DFF, D, D, (bf16_t*)(p.ws + W_WDN) + (size_t)l * D * DFF, false, lds);
  }
  bf16_t* ab = (bf16_t*)(p.ws + W_AB);
  {
    const unsigned total = (unsigned)M * 128u, S = gridDim.x * NTH;
    for (unsigned c0 = blockIdx.x * NTH + (unsigned)tid; c0 < total; c0 += 4u * S) {
      f32x4 a[4], b4[4];
#pragma unroll
      for (int u = 0; u < 4; ++u) {
        const unsigned c = c0 + (unsigned)u * S;
        if (c < total) { const float* src = xrow_ptr(p, 0, (int)(c >> 7)) + (c & 127u) * 8; a[u] = *(const f32x4*)src; b4[u] = *(const f32x4*)(src + 4); }
      }
#pragma unroll
      for (int u = 0; u < 4; ++u) {
        const unsigned c = c0 + (unsigned)u * S;
        if (c < total) {
          u32x4 o; o[0] = pk2(a[u][0], a[u][1]); o[1] = pk2(a[u][2], a[u][3]); o[2] = pk2(b4[u][0], b4[u][1]); o[3] = pk2(b4[u][2], b4[u][3]);
          *(u32x4*)(ab + (size_t)(c >> 7) * D + (c & 127u) * 8) = o;
        }
      }
    }
  }
  float2* rope = (float2*)(p.ws + W_ROPE);
  for (int i = blockIdx.x * NTH + tid; i < 8192 * 32; i += gridDim.x * NTH) {
    const int pos = i >> 5, d = i & 31;
    const double inv = exp2(-(double)d * (13.287712379549449 / 32.0));
    double ang = (double)pos * inv;
    const double twopi = 6.283185307179586476925;
    ang -= twopi * rint(ang / twopi);
    float s, c; sincosf((float)ang, &s, &c);
    rope[i] = make_float2(c, s);
  }
  if (blockIdx.x == 0 && tid < 128) {
    const int l = tid >> 6, ln = tid & 63;
    const float* lp = p.in[13] + (size_t)l * 4 * 64;
    const float s1 = wave_sum(lp[ln] * lp[64 + ln]), s2 = wave_sum(lp[128 + ln] * lp[192 + ln]);
    const float lam_init = (l == 0) ? 0.2f : (0.8f - 0.6f * 0.74081822068171788f);
    if (ln == 0) ((float*)(p.ws + W_MISC))[l] = __expf(s1) - __expf(s2) + lam_init;
  }
  if (blockIdx.x == 0 && tid < 8) ((unsigned*)(p.ws + W_MISC))[16 + tid] = 0u;
  if (blockIdx.x == 0) for (int i = tid; i < 3456; i += NTH) ((unsigned*)(p.ws + W_BAR))[i] = 0u;
}

namespace pg8 {
#define PG8_LAS __attribute__((address_space(3)))
typedef unsigned short bf16_t;
typedef short bf16x8 __attribute__((ext_vector_type(8)));
typedef float f32x4 __attribute__((ext_vector_type(4)));
typedef unsigned u32x4 __attribute__((ext_vector_type(4)));
constexpr int BM = 256, BK = 64, HALF = 128, HTB = HALF * BK * 2  , STAGE_BYTES = 8 * HTB, NXCD = 8, WGM = 8;

__host__ __device__ __forceinline__ int lds_byte(int r, int c) { const int st = (r >> 4) * 2 + (c >> 5), rr = r & 15, cc = c & 31, ob = rr * 64 + cc * 2; return st * 1024 + (ob ^ (((ob >> 9) & 1) << 5)); }
__host__ __device__ __forceinline__ void stage_rc(int b, int& R, int& C) { const int st = b / 1024, sb = b % 1024, swz = sb ^ (((sb >> 9) & 1) << 5); R = (st >> 1) * 16 + swz / 64; C = (st & 1) * 32 + (swz % 64) / 2; }
__host__ __device__ __forceinline__ int perm32(int rho) { const int n = rho >> 4, i = rho & 15; return 8 * (i >> 2) + 4 * n + (i & 3); }

struct Unit { int pm, pn; };
struct Gemm { const bf16_t* A; const bf16_t* Bt; int M, N, K; };

struct StaticOrder {
    int nM, nN, nwg, G, c;
    __host__ __device__ void init(int M, int N, int G_, int c_) { nM = M / BM; nN = N / BM; nwg = nM * nN; G = G_; c = c_; }
    __host__ __device__ bool next(int i, Unit& u) const {
        const long L = (long)i * G + c; if (L >= nwg) return false;
        int wgid = (int)L; { const int q = nwg / NXCD, r = nwg % NXCD, xcd = wgid % NXCD, off = wgid / NXCD; wgid = (xcd < r ? xcd * (q + 1) : r * (q + 1) + (xcd - r) * q) + off; }
        const int nig = WGM * nN, gid = wgid / nig, fm = gid * WGM, gsz = (nM - fm) < WGM ? (nM - fm) : WGM;
        u.pm = fm + ((wgid % nig) % gsz); u.pn = (wgid % nig) / gsz; return true;
    }
    __device__ __forceinline__ void a_ready(const Unit&) const {}
    __device__ __forceinline__ void done(const Unit&) const {}
};
template <class Epi, class Sched, bool STAMP = false>
__device__ __forceinline__ void gemm_phase(PG8_LAS unsigned char* lds, const Gemm g, const Sched& S, const Epi& E, unsigned long long* stamps) {
    const int tid = otid(), wid = __builtin_amdgcn_readfirstlane(tid >> 6), lane = tid & 63, wr = wid >> 2, wc = wid & 3, fr = lane & 15, fq = lane >> 4;
    const int K = g.K, nt = K / BK;
    int ts_lo = 0, ts_hi = 0, nts = 0; const unsigned long long rt_entry = STAMP ? (unsigned long long)wall_clock64() : 0ull;
#define PG8_STAMP() do { if (STAMP && wid == 0 && nts < 64) { const unsigned long long _c = (unsigned long long)clock64(); \
        ts_lo = (lane == nts) ? (int)(unsigned)_c : ts_lo; ts_hi = (lane == nts) ? (int)(unsigned)(_c >> 32) : ts_hi; ++nts; } } while (0)
    PG8_STAMP();
    unsigned voffA[2], voffB[2];
#pragma unroll
    for (int i = 0; i < 2; ++i) { int R, C; stage_rc(tid * 16 + i * 8192, R, C); const int Rb = Epi::PERM ? ((R & ~31) + perm32(R & 31)) : R;
        voffA[i] = (unsigned)(R * K + C) * 2u; voffB[i] = (unsigned)(Rb * K + C) * 2u; }
    const size_t kstep = (size_t)(BK * 2);
    const size_t hstep = (size_t)HALF * K * 2;
    const size_t tstep = 2 * hstep;
    const unsigned ldsw = (unsigned)wid * 1024u;
    const int aoff = lds_byte(wr * 64 + fr, fq * 8), boff = lds_byte(wc * 32 + fr, fq * 8);
#define PG8_SA(b, h) (((b) * 2 + (h)) * HTB)
#define PG8_SB(b, h) ((4 + (b) * 2 + (h)) * HTB)
#define PG8_STAGE(bufoff, gbase, voff) do { _Pragma("unroll") for (int _i = 0; _i < 2; ++_i) \
        __builtin_amdgcn_global_load_lds((const unsigned*)((const char*)(gbase) + (voff)[_i]), (PG8_LAS unsigned*)(lds + (bufoff) + ldsw + _i * 8192), 16, 0, 0); } while (0)
#define PG8_LDA(dst, b, h) do { _Pragma("unroll") for (int m = 0; m < 4; ++m) _Pragma("unroll") for (int k = 0; k < 2; ++k) dst[m][k] = *(const PG8_LAS bf16x8*)(lds + PG8_SA(b, h) + aoff + m * 2048 + k * 1024); } while (0)
#define PG8_LDB(dst, b, h) do { _Pragma("unroll") for (int n = 0; n < 2; ++n) _Pragma("unroll") for (int k = 0; k < 2; ++k) dst[n][k] = *(const PG8_LAS bf16x8*)(lds + PG8_SB(b, h) + boff + n * 2048 + k * 1024); } while (0)
#define PG8_MMA(ai, bj, At, Bt) do { __builtin_amdgcn_s_setprio(1); _Pragma("unroll") for (int m = 0; m < 4; ++m) _Pragma("unroll") for (int n = 0; n < 2; ++n) _Pragma("unroll") for (int k = 0; k < 2; ++k) \
        acc[ai][bj][m][n] = __builtin_amdgcn_mfma_f32_16x16x32_bf16(Bt[n][k], At[m][k], acc[ai][bj][m][n], 0, 0, 0); __builtin_amdgcn_s_setprio(0); } while (0)
#define PG8_WAIT_V(n) asm volatile("s_waitcnt vmcnt(" #n ")" ::: "memory")
#define PG8_WAIT_L(n) asm volatile("s_waitcnt lgkmcnt(" #n ")" ::: "memory")
#define PG8_BAR __builtin_amdgcn_s_barrier()
#define PG8_SCHED __builtin_amdgcn_sched_barrier(0)
    Unit cur, nxt; int ui = 0;
    if (!S.next(0, cur)) return;
    f32x4 acc[2][2][4][2];
#pragma unroll
    for (int a = 0; a < 2; ++a)
#pragma unroll
        for (int b = 0; b < 2; ++b)
#pragma unroll
            for (int m = 0; m < 4; ++m)
#pragma unroll
                for (int n = 0; n < 2; ++n) acc[a][b][m][n] = (f32x4){0.f, 0.f, 0.f, 0.f};
    bf16x8 At[4][2], B0[2][2], B1[2][2];
    const char* cA = (const char*)g.A + (size_t)cur.pm * tstep; const char* cB = (const char*)g.Bt + (size_t)cur.pn * tstep;
    S.a_ready(cur);
    PG8_STAGE(PG8_SB(0, 0), cB, voffB); PG8_STAGE(PG8_SA(0, 0), cA, voffA); PG8_STAGE(PG8_SB(0, 1), cB + hstep, voffB); PG8_STAGE(PG8_SA(0, 1), cA + hstep, voffA);
    if (wr == 1) PG8_BAR;
    PG8_WAIT_V(4); PG8_BAR;
    PG8_STAGE(PG8_SB(1, 0), cB + kstep, voffB); PG8_STAGE(PG8_SA(1, 0), cA + kstep, voffA); PG8_STAGE(PG8_SB(1, 1), cB + hstep + kstep, voffB);
    PG8_WAIT_V(6); PG8_BAR;
    PG8_STAMP();
    for (;;) {
        const bool has_next = S.next(ui + 1, nxt);
        const char* nA = has_next ? (const char*)g.A + (size_t)nxt.pm * tstep : cA; const char* nB = has_next ? (const char*)g.Bt + (size_t)nxt.pn * tstep : cB;
        for (int t = 0; t < nt; t += 2) {
            const bool last = (t == nt - 2);
            const char* a1 = cA + (size_t)(t + 1) * kstep;
            const char* a2 = last ? nA : cA + (size_t)(t + 2) * kstep; const char* b2 = last ? nB : cB + (size_t)(t + 2) * kstep;
            const char* a3 = a2 + kstep; const char* b3 = b2 + kstep;
            if (last && has_next) S.a_ready(nxt);
            PG8_LDB(B0, 0, 0); PG8_SCHED; PG8_LDA(At, 0, 0); PG8_STAGE(PG8_SA(1, 1), a1 + hstep, voffA);
            PG8_WAIT_L(8); PG8_BAR; PG8_WAIT_L(0); PG8_MMA(0, 0, At, B0); PG8_BAR; PG8_SCHED;
            PG8_LDB(B1, 0, 1); PG8_STAGE(PG8_SB(0, 0), b2, voffB);
            PG8_BAR; PG8_WAIT_L(0); PG8_MMA(0, 1, At, B1); PG8_BAR;
            PG8_LDA(At, 0, 1); PG8_STAGE(PG8_SA(0, 0), a2, voffA);
            PG8_BAR; PG8_WAIT_L(0); PG8_MMA(1, 0, At, B0); PG8_BAR; PG8_SCHED;
            PG8_STAGE(PG8_SB(0, 1), b2 + hstep, voffB);
            PG8_WAIT_V(6); PG8_BAR; PG8_MMA(1, 1, At, B1); PG8_BAR;
            PG8_LDB(B0, 1, 0); PG8_SCHED; PG8_LDA(At, 1, 0); PG8_STAGE(PG8_SA(0, 1), a2 + hstep, voffA);
            PG8_WAIT_L(8); PG8_BAR; PG8_WAIT_L(0); PG8_MMA(0, 0, At, B0); PG8_BAR; PG8_SCHED;
            PG8_LDB(B1, 1, 1); PG8_STAGE(PG8_SB(1, 0), b3, voffB);
            PG8_BAR; PG8_WAIT_L(0); PG8_MMA(0, 1, At, B1); PG8_BAR;
            PG8_LDA(At, 1, 1); PG8_STAGE(PG8_SA(1, 0), a3, voffA);
            PG8_BAR; PG8_WAIT_L(0); PG8_MMA(1, 0, At, B0); PG8_BAR; PG8_SCHED;
            PG8_STAGE(PG8_SB(1, 1), b3 + hstep, voffB);
            PG8_WAIT_V(6); PG8_BAR; PG8_MMA(1, 1, At, B1); PG8_BAR;
        }
        PG8_STAMP();
        if constexpr (!Epi::AFTER_DRAIN) { E(acc, cur, wr, wc, fr, fq); S.done(cur); }
        PG8_STAMP();
        if (!has_next) break;
#pragma unroll
        for (int a = 0; a < 2; ++a)
#pragma unroll
            for (int b = 0; b < 2; ++b)
#pragma unroll
                for (int m = 0; m < 4; ++m)
#pragma unroll
                    for (int n = 0; n < 2; ++n) acc[a][b][m][n] = (f32x4){0.f, 0.f, 0.f, 0.f};
        cur = nxt; cA = nA; cB = nB; ++ui;
    }
    PG8_WAIT_V(0);
    if (wr == 0) PG8_BAR;
    PG8_BAR;
    if constexpr (Epi::AFTER_DRAIN) { E.fused(acc, cur, wr, wc, fr, fq, lds, wid, lane); S.done(cur); }
    PG8_STAMP();
    if (STAMP && wid == 0) { stamps[lane] = lane < nts ? (((unsigned long long)(unsigned)ts_hi << 32) | (unsigned)ts_lo) : 0ull;
        if (lane == 62) stamps[62] = rt_entry; if (lane == 63) stamps[63] = (unsigned long long)wall_clock64(); }
#undef PG8_STAMP
#undef PG8_SA
#undef PG8_SB
#undef PG8_STAGE
#undef PG8_LDA
#undef PG8_LDB
#undef PG8_MMA
#undef PG8_WAIT_V
#undef PG8_WAIT_L
#undef PG8_BAR
#undef PG8_SCHED
}
}

enum { EPI_IN = 0, EPI_OUT = 1, EPI_UP = 2, EPI_DOWN = 3 };
template <int MODE>
struct Epi {
  static constexpr bool PERM = true, AFTER_DRAIN = false;
  Params p; int l;
  DI void operator()(const f32x4 (&acc)[2][2][4][2], const pg8::Unit& u, int wr, int wc, int fr, int fq) const {
    const int colb = u.pn * 256 + wc * 32 + 8 * fq;
    if (MODE == EPI_OUT || MODE == EPI_DOWN) {
      float* Rb = (float*)(p.ws + W_R);
#pragma unroll
      for (int ai = 0; ai < 2; ++ai) {
        f32x4 res[4][2][2];
#pragma unroll
        for (int m = 0; m < 4; ++m) {
          const int row = u.pm * 256 + ai * 128 + wr * 64 + m * 16 + fr;
          const float* rs = (MODE == EPI_OUT ? xrow_ptr(p, l, row < M ? row : M - 1) : Rb + (size_t)(row < M ? row : M - 1) * D) + colb;
#pragma unroll
          for (int bj = 0; bj < 2; ++bj) { res[m][bj][0] = *(const f32x4*)(rs + bj * 128); res[m][bj][1] = *(const f32x4*)(rs + bj * 128 + 4); }
        }
#pragma unroll
        for (int m = 0; m < 4; ++m) {
          const int row = u.pm * 256 + ai * 128 + wr * 64 + m * 16 + fr;
          if (row < M) {
            float* R = Rb + (size_t)row * D + colb;
#pragma unroll
            for (int bj = 0; bj < 2; ++bj) {
              *(f32x4*)(R + bj * 128) = res[m][bj][0] * ALPHA + acc[ai][bj][m][0];
              *(f32x4*)(R + bj * 128 + 4) = res[m][bj][1] * ALPHA + acc[ai][bj][m][1];
            }
          }
        }
      }
      return;
    }
    f32x4 rc0[8], rc1[8];
    if (MODE == EPI_IN && (u.pn >> 2) <= 1) {
      const int d0 = (colb & 63) >> 1;
#pragma unroll
      for (int i = 0; i < 8; ++i) {
        int row = u.pm * 256 + (i >> 2) * 128 + wr * 64 + (i & 3) * 16 + fr; row = row < M ? row : M - 1;
        const int pos = row < MP ? (row & (SEQ - 1)) : PAST + ((row - MP) & 15);
        const f32x4* rp = (const f32x4*)((const float2*)(p.ws + W_ROPE) + pos * 32 + d0);
        rc0[i] = rp[0]; rc1[i] = rp[1];
      }
    }
#pragma unroll
    for (int ai = 0; ai < 2; ++ai)
#pragma unroll
      for (int m = 0; m < 4; ++m) {
        const int row = u.pm * 256 + ai * 128 + wr * 64 + m * 16 + fr;
        if (row < M) {
#pragma unroll
          for (int bj = 0; bj < 2; ++bj) {
            const int col = colb + bj * 128;
            const f32x4 v0 = acc[ai][bj][m][0], v1 = acc[ai][bj][m][1];
            if (MODE == EPI_IN) {
              bf16_t* Z = (bf16_t*)(p.ws + W_Z);
              const int seg = u.pn >> 2;
              if (seg <= 1) {
                const int d0 = (col & 63) >> 1;
                const f32x4 c01 = rc0[ai * 4 + m], c23 = rc1[ai * 4 + m];
                const float a0 = v0[0] * c01[0] - v0[1] * c01[1], b0 = v0[1] * c01[0] + v0[0] * c01[1];
                const float a1 = v0[2] * c01[2] - v0[3] * c01[3], b1 = v0[3] * c01[2] + v0[2] * c01[3];
                const float a2 = v1[0] * c23[0] - v1[1] * c23[1], b2 = v1[1] * c23[0] + v1[0] * c23[1];
                const float a3 = v1[2] * c23[2] - v1[3] * c23[3], b3 = v1[3] * c23[2] + v1[2] * c23[3];
                const float qs = seg == 0 ? 0.125f : 1.f;
                u32x4 o; o[0] = pk2(a0 * qs, b0 * qs); o[1] = pk2(a1 * qs, b1 * qs); o[2] = pk2(a2 * qs, b2 * qs); o[3] = pk2(a3 * qs, b3 * qs);
                *(u32x4*)(Z + (size_t)row * NIN + col) = o;
                if (seg == 1) {
                  float* ob = (row < MP ? p.out + O_KP + ((size_t)l * MP + row) * 1024 : p.out + O_KS + ((size_t)l * MS + row - MP) * 1024) + ((col - 1024) & ~63) + d0;
                  f32x4 o1, o2; o1[0] = a0; o1[1] = a1; o1[2] = a2; o1[3] = a3; o2[0] = b0; o2[1] = b1; o2[2] = b2; o2[3] = b3;
                  *(f32x4*)ob = o1; *(f32x4*)(ob + 32) = o2;
                }
              } else {
                u32x4 o; o[0] = pk2(v0[0], v0[1]); o[1] = pk2(v0[2], v0[3]); o[2] = pk2(v1[0], v1[1]); o[3] = pk2(v1[2], v1[3]);
                *(u32x4*)(Z + (size_t)row * NIN + col) = o;
                if (seg == 2) {
                  float* ob = (row < MP ? p.out + O_VP + ((size_t)l * MP + row) * 1024 : p.out + O_VS + ((size_t)l * MS + row - MP) * 1024) + (col - 2048);
                  *(f32x4*)ob = v0; *(f32x4*)(ob + 4) = v1;
                } else if (seg == 3 || seg == 4) {
                  float* ob = nullptr;
                  if (row < MP) { const int s = row & (SEQ - 1); if (s >= SEQ - 3) ob = p.out + O_MCP + ((size_t)(l * 4 + (row >> 13)) * 3 + (s - (SEQ - 3))) * 2048 + col - 3072; }
                  else { const int t = (row - MP) & 15, b = (row - MP) >> 4; if (t >= 13) ob = p.out + O_MCS + ((size_t)(l * 8 + b) * 3 + (t - 13)) * 2048 + col - 3072; }
                  if (ob) { *(f32x4*)ob = v0; *(f32x4*)(ob + 4) = v1; }
                }
              }
            } else if (MODE == EPI_OUT || MODE == EPI_DOWN) {
              float* R = (float*)(p.ws + W_R) + (size_t)row * D + col;
              const float* rs = MODE == EPI_OUT ? xrow_ptr(p, l, row) + col : R;
              const f32x4 r0 = *(const f32x4*)rs, r1 = *(const f32x4*)(rs + 4);
              *(f32x4*)R = r0 * ALPHA + v0; *(f32x4*)(R + 4) = r1 * ALPHA + v1;
            } else {
              bf16_t* U = (bf16_t*)(p.ws + W_Z);
              u32x4 o; o[0] = pk2(v0[0], v0[1]); o[1] = pk2(v0[2], v0[3]); o[2] = pk2(v1[0], v1[1]); o[3] = pk2(v1[2], v1[3]);
              *(u32x4*)(U + (size_t)row * NUP + col) = o;
              float* ob = nullptr;
              if (row < MP) { const int s = row & (SEQ - 1); if (s >= SEQ - 2) ob = p.out + O_FCP + ((size_t)(l * 4 + (row >> 13)) * 2 + (s - (SEQ - 2))) * NUP + col; }
              else { const int t = (row - MP) & 15, b = (row - MP) >> 4; if (t >= 14) ob = p.out + O_FCS + ((size_t)(l * 8 + b) * 2 + (t - 14)) * NUP + col; }
              if (ob) { *(f32x4*)ob = v0; *(f32x4*)(ob + 4) = v1; }
            }
          }
        }
      }
  }
};

template <int MODE>
DI void gemm_phase(const Params& p, int l, const bf16_t* A, int lda, const bf16_t* Bt, int K, int ntn, char* lds) {
  (void)lda;
  pg8::Gemm g; g.A = A; g.Bt = Bt; g.M = ((MODE == EPI_OUT || MODE == EPI_DOWN) ? NTM - 1 : NTM) * 256; g.N = ntn * 256; g.K = K;
  if (MODE == EPI_OUT || MODE == EPI_DOWN) sample_gemm<MODE>(p, l, A, Bt, K);
  pg8::StaticOrder S; S.init(g.M, g.N, (int)gridDim.x, (int)blockIdx.x);
  Epi<MODE> E; E.p = p; E.l = l;
  pg8::gemm_phase<Epi<MODE>, pg8::StaticOrder, false>((PG8_LAS unsigned char*)lds, g, S, E, nullptr);
  __syncthreads();
}

typedef float f32x4v __attribute__((ext_vector_type(4)));
template <int MODE>
DI void sample_gemm(const Params& p, int l, const bf16_t* A, const bf16_t* Bt, int K) {
  if (blockIdx.x >= 64) return;
  const int tid = otid(), lane = tid & 63, wave = uni(tid >> 6), fr = lane & 15, fq = lane >> 4;
  const bf16_t* ap = A + (size_t)(MP + wave * 16 + fr) * K + fq * 8;
  const bf16_t* bp = Bt + (size_t)(blockIdx.x * 16 + fr) * K + fq * 8;
  f32x4v acc0 = {0.f, 0.f, 0.f, 0.f}, acc1 = {0.f, 0.f, 0.f, 0.f};
  for (int k0 = 0; k0 < K; k0 += 256) {
    bf16x8 a[8], bb[8];
#pragma unroll
    for (int i = 0; i < 8; ++i) { a[i] = *(const bf16x8*)(ap + k0 + i * 32); bb[i] = *(const bf16x8*)(bp + k0 + i * 32); }
#pragma unroll
    for (int i = 0; i < 8; i += 2) {
      acc0 = __builtin_amdgcn_mfma_f32_16x16x32_bf16(a[i], bb[i], acc0, 0, 0, 0);
      acc1 = __builtin_amdgcn_mfma_f32_16x16x32_bf16(a[i + 1], bb[i + 1], acc1, 0, 0, 0);
    }
  }
  const int col = blockIdx.x * 16 + fr;
  float* R = (float*)(p.ws + W_R);
#pragma unroll
  for (int j = 0; j < 4; ++j) {
    const int row = MP + wave * 16 + fq * 4 + j;
    const float res = MODE == EPI_OUT ? xrow_ptr(p, l, row)[col] : R[(size_t)row * D + col];
    R[(size_t)row * D + col] = ALPHA * res + (acc0[j] + acc1[j]);
  }
}

DI void gif_phase(const Params& p, int l, char* lds, int first_blk) {
  if ((int)blockIdx.x < first_blk) return;
  const int tidq = otid(); const int lane = tidq & 63, gw = ((int)blockIdx.x - first_blk) * 8 + (tidq >> 6), ngw = ((int)gridDim.x - first_blk) * 8;
  const float* w = p.in[9] + (size_t)l * D * DIN + 7168;
  const float* bif = p.in[10] + l * 8;
  float* gif = (float*)(p.ws + W_GIF);
  float* w8 = (float*)lds;
  __syncthreads();
#pragma unroll
  for (int i = 0; i < 2; ++i) {
    const int k = tidq + 512 * i;
    *(f32x4*)(w8 + k * 8) = *(const f32x4*)(w + (size_t)k * DIN); *(f32x4*)(w8 + k * 8 + 4) = *(const f32x4*)(w + (size_t)k * DIN + 4);
  }
  __syncthreads();
  for (int rg = gw; rg < M / 4; rg += ngw) {
    float acc[4][8];
#pragma unroll
    for (int a = 0; a < 4; ++a)
#pragma unroll
      for (int j = 0; j < 8; ++j) acc[a][j] = 0.f;
    const float* x0 = xrow_ptr(p, l, rg * 4);
#pragma unroll 4
    for (int kk = 0; kk < 16; ++kk) {
      const int k = kk * 64 + lane;
      const f32x4 w0 = *(const f32x4*)(w8 + k * 8), w1 = *(const f32x4*)(w8 + k * 8 + 4);
#pragma unroll
      for (int a = 0; a < 4; ++a) {
        const float xv = x0[(size_t)a * D + k];
        acc[a][0] += xv * w0[0]; acc[a][1] += xv * w0[1]; acc[a][2] += xv * w0[2]; acc[a][3] += xv * w0[3];
        acc[a][4] += xv * w1[0]; acc[a][5] += xv * w1[1]; acc[a][6] += xv * w1[2]; acc[a][7] += xv * w1[3];
      }
    }
#pragma unroll
    for (int a = 0; a < 4; ++a)
#pragma unroll
      for (int j = 0; j < 8; ++j) {
        const float s = wave_sum(acc[a][j]);
        if (lane == 0) gif[(size_t)(rg * 4 + a) * 8 + j] = s + bif[j];
      }
  }
  __syncthreads();
}

DI void qkconv_phase(const Params& p, int l) {
  const bf16_t* Z = (const bf16_t*)(p.ws + W_Z);
  bf16_t* QA = (bf16_t*)(p.ws + W_AB); bf16_t* KA = (bf16_t*)(p.ws + W_KA);
  const float* cw = p.in[11] + (size_t)l * 4 * 2048; const float* cb = p.in[12] + (size_t)l * 2048;
  const size_t total = (size_t)(M / 4) * 256;
  for (size_t it = (size_t)blockIdx.x * NTH + otid(); it < total; it += (size_t)gridDim.x * NTH) {
    const int cc = (int)(it & 255), rg = (int)(it >> 8), col = cc * 8, row0 = rg * 4;
    int t0, hist_rows;
    const float* st = nullptr;
    if (row0 < MP) { t0 = row0 & (SEQ - 1); }
    else { t0 = (row0 - MP) & 15; st = p.in[4] + ((size_t)(l * 8 + ((row0 - MP) >> 4)) * 3) * 2048 + col; }
    (void)hist_rows;
    float w[4][8], bias[8];
#pragma unroll
    for (int j = 0; j < 4; ++j) { f32x4 a = *(const f32x4*)(cw + j * 2048 + col), b = *(const f32x4*)(cw + j * 2048 + col + 4);
      w[j][0] = a[0]; w[j][1] = a[1]; w[j][2] = a[2]; w[j][3] = a[3]; w[j][4] = b[0]; w[j][5] = b[1]; w[j][6] = b[2]; w[j][7] = b[3]; }
    { f32x4 a = *(const f32x4*)(cb + col), b = *(const f32x4*)(cb + col + 4);
      bias[0] = a[0]; bias[1] = a[1]; bias[2] = a[2]; bias[3] = a[3]; bias[4] = b[0]; bias[5] = b[1]; bias[6] = b[2]; bias[7] = b[3]; }
    float x[7][8];
#pragma unroll
    for (int j = 0; j < 7; ++j) {
      const int t = t0 - 3 + j;
      if (t >= 0) { u32x4 v = *(const u32x4*)(Z + (size_t)(row0 - 3 + j) * NIN + 3072 + col); unpack8(v, x[j]); }
      else if (st) { f32x4 a = *(const f32x4*)(st + (size_t)(3 + t) * 2048), b = *(const f32x4*)(st + (size_t)(3 + t) * 2048 + 4);
        x[j][0] = a[0]; x[j][1] = a[1]; x[j][2] = a[2]; x[j][3] = a[3]; x[j][4] = b[0]; x[j][5] = b[1]; x[j][6] = b[2]; x[j][7] = b[3]; }
      else {
#pragma unroll
        for (int e = 0; e < 8; ++e) x[j][e] = 0.f; }
    }
    const float sc = col >= 1024 ? 0.0625f : 1.f;
    bf16_t* dst = col >= 1024 ? KA + (col - 1024) : QA + col;
#pragma unroll
    for (int a = 0; a < 4; ++a) {
      float o[8];
#pragma unroll
      for (int e = 0; e < 8; ++e) {
        float u = bias[e] + w[0][e] * x[a][e] + w[1][e] * x[a + 1][e] + w[2][e] * x[a + 2][e] + w[3][e] * x[a + 3][e];
        o[e] = u * sigmoidf_(u) * sc;
      }
      u32x4 ov; ov[0] = pk2(o[0], o[1]); ov[1] = pk2(o[2], o[3]); ov[2] = pk2(o[4], o[5]); ov[3] = pk2(o[6], o[7]);
      *(u32x4*)(dst + (size_t)(row0 + a) * D) = ov;
    }
  }
}

constexpr int A_LD = 272;
constexpr int A_TILE = 64 * A_LD;
constexpr int A_VLD = 320;
constexpr int A_VTILE = 64 * A_VLD;
template <int KIND>
DI void attn_item(const Params& p, int l, int b, int ha, int qb, char* lds) {
  const int tid = otid(), lane = tid & 63, wave = uni(tid >> 6);
  const int map = wave >> 2, qt = wave & 3, r = lane & 31, h = lane >> 5;
  const bf16_t* Z = (const bf16_t*)(p.ws + W_Z);
  const int NT = KIND == 0 ? 2 * (qb + 1) : (NKS + 63) / 64;
  const int ntw = KIND == 0 ? 2 * qb + (qt >> 1) + 1 : NT;
  const bool active = KIND == 0 ? true : (qt == 0);
  int qrow;
  if (KIND == 0) qrow = b * SEQ + qb * 128 + qt * 32 + r; else qrow = MP + b * 16 + (r < 16 ? r : 15);
  bf16x8 qf[4];
#pragma unroll
  for (int ks = 0; ks < 4; ++ks) {
    if (KIND == 0) qf[ks] = *(const bf16x8*)(Z + (size_t)qrow * NIN + ha * 128 + map * 64 + ks * 16 + h * 8);
    else {
      const int dn = ks * 16 + h * 8, par = dn >> 5, dd = dn & 31;
      const bf16_t* src = Z + (size_t)qrow * NIN + ha * 128 + map * 64 + 2 * dd;
      const u32x4 lo = *(const u32x4*)src, hi = *(const u32x4*)(src + 8);
      unsigned e[8];
#pragma unroll
      for (int i = 0; i < 4; ++i) { e[i] = par ? (lo[i] >> 16) : (lo[i] & 0xffffu); e[4 + i] = par ? (hi[i] >> 16) : (hi[i] & 0xffffu); }
      u32x4 o; o[0] = e[0] | (e[1] << 16); o[1] = e[2] | (e[3] << 16); o[2] = e[4] | (e[5] << 16); o[3] = e[6] | (e[7] << 16);
      qf[ks] = __builtin_bit_cast(bf16x8, o);
    }
  }
  const int skey = tid >> 4, part = tid & 15;
  u32x4 rk0, rk1, rv0, rv1;
  auto gload = [&](int j) {
    if (KIND == 0) {
      const bf16_t* base = Z + (size_t)(b * SEQ + j * 64 + skey) * NIN + 1024 + ha * 128 + part * 8;
      rk0 = *(const u32x4*)base; rk1 = *(const u32x4*)(base + (size_t)32 * NIN);
      rv0 = *(const u32x4*)(base + 1024); rv1 = *(const u32x4*)(base + (size_t)32 * NIN + 1024);
    } else {
#pragma unroll
      for (int i = 0; i < 2; ++i) {
        int kk = j * 64 + skey + 32 * i; if (kk > NKS - 1) kk = NKS - 1;
        const float *ks_, *vs_;
        if (kk < PAST) { const size_t o = (((size_t)(l * 8 + b) * PAST + kk) * 8 + ha) * 128 + part * 8; ks_ = p.in[2] + o; vs_ = p.in[3] + o; }
        else { const size_t o = (((size_t)l * MS + b * 16 + (kk - PAST)) * 8 + ha) * 128 + part * 8; ks_ = p.out + O_KS + o; vs_ = p.out + O_VS + o; }
        const f32x4 a0 = *(const f32x4*)ks_, a1 = *(const f32x4*)(ks_ + 4), c0 = *(const f32x4*)vs_, c1 = *(const f32x4*)(vs_ + 4);
        u32x4 ko, vo;
        ko[0] = pk2(a0[0], a0[1]); ko[1] = pk2(a0[2], a0[3]); ko[2] = pk2(a1[0], a1[1]); ko[3] = pk2(a1[2], a1[3]);
        vo[0] = pk2(c0[0], c0[1]); vo[1] = pk2(c0[2], c0[3]); vo[2] = pk2(c1[0], c1[1]); vo[3] = pk2(c1[2], c1[3]);
        if (i == 0) { rk0 = ko; rv0 = vo; } else { rk1 = ko; rv1 = vo; }
      }
    }
  };
  f32x16 O[4];
#pragma unroll
  for (int v = 0; v < 4; ++v)
#pragma unroll
    for (int i = 0; i < 16; ++i) O[v][i] = 0.f;
  float m_run = -1e30f, l_run = 0.f;
  const int q4 = (lane & 15) >> 2, p4 = lane & 3, blk = (lane >> 4) & 1;
  const unsigned sofs = skey * A_LD + part * 16, vofs = skey * A_VLD + part * 16;
  auto qk = [&](int j, f32x16 (&st)[2]) {
    const char* kb = lds + (j & 1) * A_TILE;
#pragma unroll
    for (int kt = 0; kt < 2; ++kt) {
#pragma unroll
      for (int i = 0; i < 16; ++i) st[kt][i] = 0.f;
#pragma unroll
      for (int ks = 0; ks < 4; ++ks) {
        const bf16x8 kf = *(const bf16x8*)(kb + (kt * 32 + r) * A_LD + (map * 64 + ks * 16 + h * 8) * 2);
        st[kt] = MFMA32(kf, qf[ks], st[kt]);
      }
    }
    if (KIND == 1 && j == NT - 1) {
#pragma unroll
      for (int kt = 0; kt < 2; ++kt)
#pragma unroll
        for (int i = 0; i < 16; ++i) if (j * 64 + kt * 32 + crow(i, h) >= NKS) st[kt][i] = -1e30f;
    }
  };
  bf16x8 pk[4];
  auto smax = [&](int j, f32x16 (&sc)[2], f32x16 (&sn)[2]) {
    if (j + 1 < ntw) qk(j + 1, sn);
    float mx = sc[0][0];
#pragma unroll
    for (int kt = 0; kt < 2; ++kt)
#pragma unroll
      for (int i = 0; i < 16; ++i) mx = fmaxf(mx, sc[kt][i]);
    mx = fmaxf(mx, __shfl_xor(mx, 32));
    const float m_new = fmaxf(m_run, mx);
    const float alpha = __builtin_amdgcn_exp2f((m_run - m_new) * LOG2E);
    const float mb = m_new * LOG2E;
    float rs = 0.f;
#pragma unroll
    for (int kt = 0; kt < 2; ++kt)
#pragma unroll
      for (int i = 0; i < 16; ++i) { const float e = __builtin_amdgcn_exp2f(sc[kt][i] * LOG2E - mb); sc[kt][i] = e; rs += e; }
    rs += __shfl_xor(rs, 32);
    l_run = l_run * alpha + rs; m_run = m_new;
    if (__builtin_amdgcn_ballot_w64(alpha != 1.f) != 0ull) {
#pragma unroll
      for (int v = 0; v < 4; ++v)
#pragma unroll
        for (int i = 0; i < 16; ++i) O[v][i] *= alpha;
    }
    pk[0] = pack8(sc[0], 0); pk[1] = pack8(sc[0], 1); pk[2] = pack8(sc[1], 0); pk[3] = pack8(sc[1], 1);
  };
  auto pv = [&](int j) {
    const unsigned vaddr = lds_addr(lds + 2 * A_TILE + (j % 3) * A_VTILE) + (4 * h + q4) * A_VLD + (16 * blk + 4 * p4) * 2;
#pragma unroll
    for (int vt = 0; vt < 4; ++vt) {
      bf16x8 vf[4];
      tr_frag4<16 * A_VLD, 8 * A_VLD>(vaddr + vt * 64, vf);
#pragma unroll
      for (int ks = 0; ks < 4; ++ks) O[vt] = MFMA32(vf[ks], pk[ks], O[vt]);
    }
  };
  gload(0);
  { char* kb = lds + sofs; *(u32x4*)kb = rk0; *(u32x4*)(kb + 32 * A_LD) = rk1; char* vb = lds + 2 * A_TILE + vofs; *(u32x4*)vb = rv0; *(u32x4*)(vb + 32 * A_VLD) = rv1; }
  gload(1);
  { char* kb = lds + A_TILE + sofs; *(u32x4*)kb = rk0; *(u32x4*)(kb + 32 * A_LD) = rk1; }
  __syncthreads();
  f32x16 sA[2], sB[2];
  if (active && 0 < ntw) qk(0, sA);
  for (int j = 0; j < NT; j += 2) {
#pragma unroll
    for (int u = 0; u < 2; ++u) {
      const int jj = j + u;
      if (jj < NT) {
        if (jj + 1 < NT) { char* vb = lds + 2 * A_TILE + ((jj + 1) % 3) * A_VTILE + vofs; *(u32x4*)vb = rv0; *(u32x4*)(vb + 32 * A_VLD) = rv1; }
        if (jj + 2 < NT) gload(jj + 2);
        if (active) {
          if (map == 1 && jj >= 1 && jj - 1 < ntw) pv(jj - 1);
          if (jj < ntw) { if (u == 0) smax(jj, sA, sB); else smax(jj, sB, sA); }
          if (map == 0 && jj < ntw) pv(jj);
        }
        if (jj + 2 < NT) { char* kb = lds + (jj & 1) * A_TILE + sofs; *(u32x4*)kb = rk0; *(u32x4*)(kb + 32 * A_LD) = rk1; }
        __syncthreads();
      }
    }
  }
  if (active && map == 1 && ntw == NT) pv(NT - 1);
  __syncthreads();
  float* ex = (float*)lds;
  const float inv_l = 1.f / l_run;
  if (map == 1) {
#pragma unroll
    for (int vt = 0; vt < 4; ++vt)
#pragma unroll
      for (int g = 0; g < 4; ++g) {
        f32x4 o; o[0] = O[vt][4 * g] * inv_l; o[1] = O[vt][4 * g + 1] * inv_l; o[2] = O[vt][4 * g + 2] * inv_l; o[3] = O[vt][4 * g + 3] * inv_l;
        *(f32x4*)(ex + (qt * 32 + r) * 132 + vt * 32 + 8 * g + 4 * h) = o;
      }
  }
  __syncthreads();
  if (map == 0) {
    const float lam = ((const float*)(p.ws + W_MISC))[l];
    const float lam_init = (l == 0) ? 0.2f : (0.8f - 0.6f * 0.74081822068171788f);
    float ssq = 0.f;
#pragma unroll
    for (int vt = 0; vt < 4; ++vt)
#pragma unroll
      for (int g = 0; g < 4; ++g) {
        const f32x4 o2 = *(const f32x4*)(ex + (qt * 32 + r) * 132 + vt * 32 + 8 * g + 4 * h);
#pragma unroll
        for (int e = 0; e < 4; ++e) { const float o = O[vt][4 * g + e] * inv_l - lam * o2[e]; O[vt][4 * g + e] = o; ssq += o * o; }
      }
    ssq += __shfl_xor(ssq, 32);
    const float rms = rsqrtf(ssq * (1.f / 128.f) + LN_EPS) * (1.f - lam_init);
    const float* sg = p.in[14] + l * 128;
    const bool valid = KIND == 0 ? true : (qt == 0 && r < 16);
    if (valid) {
      bf16_t* dst = (bf16_t*)(p.ws + W_Z) + (size_t)qrow * NIN + 3072 + ha * 128;
#pragma unroll
      for (int vt = 0; vt < 4; ++vt)
#pragma unroll
        for (int g = 0; g < 4; ++g) {
          const int v0 = vt * 32 + 8 * g + 4 * h;
          const f32x4 gg = *(const f32x4*)(sg + v0);
          u32x2 o; o[0] = pk2(O[vt][4 * g] * rms * gg[0], O[vt][4 * g + 1] * rms * gg[1]); o[1] = pk2(O[vt][4 * g + 2] * rms * gg[2], O[vt][4 * g + 3] * rms * gg[3]);
          *(u32x2*)(dst + v0) = o;
        }
    }
  }
  __syncthreads();
}

constexpr int L_LD = 528;
constexpr int L_VLD = 320;
constexpr int L_Q = 0, L_K = 64 * L_LD, L_V = 2 * 64 * L_LD, L_SW = L_V + 64 * L_VLD;
constexpr int L_SWLD = 144;
constexpr int L_SC = L_SW + 64 * L_SWLD;
constexpr int S_MX = 0, S_G = 64, S_EMT = 128, S_DS0 = 192, S_DS1 = 256, S_QN = 320  , S_NV = 576  , S_GEND = 832, S_PAR = 840;
constexpr int LDS_BYTES = 153376;
static_assert(L_SC + 2 * S_PAR * 4 <= 131072, "lds");
#define WG_BAR() do { __builtin_amdgcn_fence(__ATOMIC_RELEASE, "workgroup"); __builtin_amdgcn_s_barrier(); __builtin_amdgcn_fence(__ATOMIC_ACQUIRE, "workgroup"); } while (0)

template <int KIND>
DI void mlstm_item(const Params& p, int l, int b, int hm, int half, char* lds) {
  const int tid0 = otid(), wave = uni(tid0 >> 6);
  const bf16_t* QA = (const bf16_t*)(p.ws + W_AB); const bf16_t* KA = (const bf16_t*)(p.ws + W_KA);
  const bf16_t* Z = (const bf16_t*)(p.ws + W_Z); bf16_t* H = (bf16_t*)(p.ws + W_H);
  const float* GIF = (const float*)(p.ws + W_GIF);
  float* scb = (float*)(lds + L_SC);
  int nchunks = KIND == 0 ? SEQ / 64 : 1; asm volatile("" : "+s"(nchunks));
  const int Lv = KIND == 0 ? 64 : 16;
  const size_t bh = KIND == 0 ? (size_t)(l * 4 + b) * 4 + hm : (size_t)(l * 8 + b) * 4 + hm;
  if (wave < 4) {
    f32x16 C[8];
    { const int lane = tid0 & 63, r = lane & 31, h = lane >> 5; (void)r; (void)h;
      if (KIND == 0) {
#pragma unroll
        for (int d = 0; d < 8; ++d)
#pragma unroll
          for (int i = 0; i < 16; ++i) C[d][i] = 0.f;
      } else {
        const float* cp = p.in[5] + bh * 65536 + (size_t)(4 * h) * 256 + half * 128 + wave * 32 + r;
#pragma unroll
        for (int d = 0; d < 8; ++d)
#pragma unroll
          for (int g = 0; g < 4; ++g) {
            C[d][4 * g] = cp[0]; C[d][4 * g + 1] = cp[256]; C[d][4 * g + 2] = cp[512]; C[d][4 * g + 3] = cp[768];
            cp += 2048; asm volatile("" : "+v"(cp));
          }
      }
    }
    for (int c = 0; c < nchunks; ++c) {
      int tid = tid0; asm volatile("" : "+v"(tid));
      const int lane = tid & 63, r = lane & 31, h = lane >> 5;
      const int q4 = (lane & 15) >> 2, p4 = lane & 3, blk = (lane >> 4) & 1;
      const float* sc = scb + (c & 1) * S_PAR;
      const int rowbase = KIND == 0 ? b * SEQ + c * 64 : MP + b * 16;
      WG_BAR();
      f32x16 accB[2];
#pragma unroll
      for (int tt = 0; tt < 2; ++tt)
#pragma unroll
        for (int i = 0; i < 16; ++i) accB[tt][i] = 0.f;
#pragma unroll
      for (int d = 0; d < 8; ++d)
#pragma unroll
        for (int s = 0; s < 2; ++s) {
          __builtin_amdgcn_sched_barrier(0);
          const bf16x8 cf = pack8(C[d], s);
#pragma unroll
          for (int tt = 0; tt < 2; ++tt) {
            const char* qp = lds + L_Q + (tt * 32 + r) * L_LD + (d * 32 + 16 * s + 4 * h) * 2;
            const s16x4 lo = *(const s16x4*)qp, hi = *(const s16x4*)(qp + 16);
            const bf16x8 qfr = __builtin_shufflevector(lo, hi, 0, 1, 2, 3, 4, 5, 6, 7);
            accB[tt] = MFMA32(cf, qfr, accB[tt]);
          }
        }
      __builtin_amdgcn_sched_barrier(0);
      bf16x8 vf[4];
      tr_frag4<16 * L_VLD, 4 * L_VLD>(lds_addr(lds + L_V) + (8 * h + q4) * L_VLD + (wave * 32 + 16 * blk + 4 * p4) * 2, vf);
      const float g_end = sc[S_GEND];
#pragma unroll
      for (int d = 0; d < 8; ++d) {
#pragma unroll
        for (int i = 0; i < 16; ++i) C[d][i] *= g_end;
        bf16x8 kf[4];
        tr_frag4<16 * L_LD, 4 * L_LD>(lds_addr(lds + L_K) + (8 * h + q4) * L_LD + (d * 32 + 16 * blk + 4 * p4) * 2, kf);
#pragma unroll
        for (int ks = 0; ks < 4; ++ks) C[d] = MFMA32(kf[ks], vf[ks], C[d]);
      }
      WG_BAR();
#pragma unroll
      for (int tt = 0; tt < 2; ++tt) {
        const int t = tt * 32 + r;
        const float g = sc[S_G + t];
#pragma unroll
        for (int i = 0; i < 16; ++i) accB[tt][i] *= g;
        const char* sp = lds + L_SW + (tt * 32 + r) * L_SWLD + h * 16;
#pragma unroll
        for (int ks = 0; ks < 4; ++ks) accB[tt] = MFMA32(vf[ks], *(const bf16x8*)(sp + ks * 32), accB[tt]);
        const float qn = (sc[S_QN + t] + sc[S_QN + 64 + t]) + (sc[S_QN + 128 + t] + sc[S_QN + 192 + t]);
        float den = sc[S_DS0 + t] + sc[S_DS1 + t] + g * qn;
        den = fmaxf(fabsf(den), sc[S_EMT + t]);
        const float rden = 1.f / den;
        if (t < Lv) {
          bf16_t* dst = H + (size_t)(rowbase + t) * D + hm * 256 + half * 128 + wave * 32;
#pragma unroll
          for (int g4 = 0; g4 < 4; ++g4) {
            u32x2 o; o[0] = pk2(accB[tt][4 * g4] * rden, accB[tt][4 * g4 + 1] * rden); o[1] = pk2(accB[tt][4 * g4 + 2] * rden, accB[tt][4 * g4 + 3] * rden);
            *(u32x2*)(dst + 8 * g4 + 4 * h) = o;
          }
        }
      }
    }
    WG_BAR();
    {
      const int lane = tid0 & 63, r = lane & 31, h = lane >> 5;
      float* co = p.out + (KIND == 0 ? O_CP : O_CS) + bh * 65536 + (size_t)(4 * h) * 256 + half * 128 + wave * 32 + r;
#pragma unroll
      for (int d = 0; d < 8; ++d)
#pragma unroll
        for (int g = 0; g < 4; ++g) {
          co[0] = C[d][4 * g]; co[256] = C[d][4 * g + 1]; co[512] = C[d][4 * g + 2]; co[768] = C[d][4 * g + 3];
          co += 2048; asm volatile("" : "+v"(co));
        }
    }
  } else {
    const int hw = wave - 4;
    float nreg = 0.f, m_prev = 0.f;
    if (KIND == 1) { nreg = p.in[6][bh * 256 + (tid0 - 256)]; m_prev = p.in[7][bh]; }
    u32x4 pq[8], pk[8], pv[4];
    float gi = 0.f, gf = 0.f, g_end_cur = 0.f;
    auto issue_loads = [&](int c, int tid) {
      const int ht = tid - 256, lane = tid & 63;
      const int rowbase = KIND == 0 ? b * SEQ + c * 64 : MP + b * 16;
      const bool tvalid = lane < Lv;
      gi = tvalid ? GIF[(size_t)(rowbase + lane) * 8 + hm] : -1e30f;
      gf = tvalid ? GIF[(size_t)(rowbase + lane) * 8 + 4 + hm] : 0.f;
#pragma unroll
      for (int i = 0; i < 8; ++i) {
        const int cidx = ht + 256 * i, t = cidx >> 5, pc = cidx & 31;
        const int row = rowbase + (t < Lv ? t : Lv - 1);
        pq[i] = *(const u32x4*)(QA + (size_t)row * D + hm * 256 + pc * 8);
        pk[i] = *(const u32x4*)(KA + (size_t)row * D + hm * 256 + pc * 8);
      }
#pragma unroll
      for (int i = 0; i < 4; ++i) {
        const int cidx = ht + 256 * i, t = cidx >> 4, pc = cidx & 15;
        const int row = rowbase + (t < Lv ? t : Lv - 1);
        pv[i] = *(const u32x4*)(Z + (size_t)row * NIN + 5120 + hm * 256 + half * 128 + pc * 8);
      }
    };
    auto scalars = [&](int par, int lane) -> float {
      const bool tvalid = lane < Lv;
      const float lf = tvalid ? (fminf(gf, 0.f) - __logf(1.f + __expf(-fabsf(gf)))) : 0.f;
      float bc = lf;
#pragma unroll
      for (int o = 1; o < 64; o <<= 1) { const float v = __shfl_up(bc, o); if (lane >= o) bc += v; }
      const float a = gi - bc;
      float cm = a;
#pragma unroll
      for (int o = 1; o < 64; o <<= 1) { const float v = __shfl_up(cm, o); if (lane >= o) cm = fmaxf(cm, v); }
      const float mxv = fmaxf(m_prev, cm);
      const float m_t = bc + mxv;
      const float mx_end = __shfl(mxv, 63), bc_end = __shfl(bc, 63);
      const float wend = __expf(a - mx_end);
      g_end_cur = __expf(m_prev - mx_end);
      if (hw == 0) {
        float* sc = scb + par * S_PAR;
        sc[S_MX + lane] = __expf(mx_end - mxv);
        sc[S_G + lane] = __expf(m_prev - mxv);
        sc[S_EMT + lane] = __expf(-m_t);
        if (lane == 0) sc[S_GEND] = g_end_cur;
      }
      m_prev = bc_end + mx_end;
      return wend;
    };
    auto stage_lds = [&](float wend_l, int tid) {
      const int ht = tid - 256;
#pragma unroll
      for (int i = 0; i < 8; ++i) {
        const int cidx = ht + 256 * i, t = cidx >> 5, pc = cidx & 31;
        const float we = __shfl(wend_l, t);
        float f[8]; unpack8(pk[i], f);
        u32x4 o; o[0] = pk2(f[0] * we, f[1] * we); o[1] = pk2(f[2] * we, f[3] * we); o[2] = pk2(f[4] * we, f[5] * we); o[3] = pk2(f[6] * we, f[7] * we);
        *(u32x4*)(lds + L_Q + t * L_LD + pc * 16) = pq[i];
        *(u32x4*)(lds + L_K + t * L_LD + pc * 16) = o;
      }
#pragma unroll
      for (int i = 0; i < 4; ++i) {
        const int cidx = ht + 256 * i, t = cidx >> 4, pc = cidx & 15;
        *(u32x4*)(lds + L_V + t * L_VLD + pc * 16) = pv[i];
      }
    };
    {
      int tid = tid0; asm volatile("" : "+v"(tid));
      issue_loads(0, tid);
      scb[S_NV + (tid - 256)] = nreg;
      const float wend = scalars(0, tid & 63);
      stage_lds(wend, tid);
    }
    for (int c = 0; c < nchunks; ++c) {
      int tid = tid0; asm volatile("" : "+v"(tid));
      const int ht = tid - 256, lane = tid & 63, r = lane & 31, h = lane >> 5;
      float* sc = scb + (c & 1) * S_PAR;
      float* scn = scb + ((c + 1) & 1) * S_PAR;
      const float g_end_c = g_end_cur;
      WG_BAR();
      const bool more = c + 1 < nchunks;
      if (more) issue_loads(c + 1, tid);
      {
        const int t = ht & 63, part = ht >> 6;
        const char* qp = lds + L_Q + t * L_LD + part * 128;
        float s = 0.f;
#pragma unroll
        for (int e = 0; e < 8; ++e) {
          const u32x4 qq = *(const u32x4*)(qp + e * 16); float f[8]; unpack8(qq, f);
#pragma unroll
          for (int z = 0; z < 8; ++z) s += f[z] * sc[S_NV + part * 64 + e * 8 + z];
        }
        sc[S_QN + part * 64 + t] = s;
      }
      if (hw < 3) {
        const int stl = hw == 2 ? 1 : 0, tt = hw == 0 ? 0 : 1;
        f32x16 S, S2;
#pragma unroll
        for (int i = 0; i < 16; ++i) { S[i] = 0.f; S2[i] = 0.f; }
        const char* ka = lds + L_K + (stl * 32 + r) * L_LD + h * 16;
        const char* qa = lds + L_Q + (tt * 32 + r) * L_LD + h * 16;
#pragma unroll 4
        for (int ks = 0; ks < 16; ks += 2) {
          S = MFMA32(*(const bf16x8*)(ka + ks * 32), *(const bf16x8*)(qa + ks * 32), S);
          S2 = MFMA32(*(const bf16x8*)(ka + ks * 32 + 32), *(const bf16x8*)(qa + ks * 32 + 32), S2);
        }
        const int t = tt * 32 + r;
        const float cw = sc[S_MX + t];
        float rs = 0.f;
#pragma unroll
        for (int g = 0; g < 4; ++g) {
          float wv[4];
#pragma unroll
          for (int e = 0; e < 4; ++e) {
            const int s = stl * 32 + 8 * g + 4 * h + e;
            wv[e] = s <= t ? (S[4 * g + e] + S2[4 * g + e]) * cw : 0.f; rs += wv[e];
          }
          u32x2 o; o[0] = pk2(wv[0], wv[1]); o[1] = pk2(wv[2], wv[3]);
          *(u32x2*)(lds + L_SW + t * L_SWLD + (stl * 32 + 8 * g + 4 * h) * 2) = o;
        }
        rs += __shfl_xor(rs, 32);
        if (h == 0) {
          if (hw == 0) { sc[S_DS0 + t] = rs; sc[S_DS1 + t] = 0.f; }
          else if (hw == 1) sc[S_DS0 + t] = rs;
          else sc[S_DS1 + t] = rs;
        }
      } else {
        const int t = lane >> 1, hs = lane & 1;
        u32x4 z; z[0] = 0; z[1] = 0; z[2] = 0; z[3] = 0;
        *(u32x4*)(lds + L_SW + t * L_SWLD + 64 + hs * 32) = z; *(u32x4*)(lds + L_SW + t * L_SWLD + 64 + hs * 32 + 16) = z;
      }
      {
        float s0 = 0.f, s1 = 0.f, s2 = 0.f, s3 = 0.f;
        const char* kp = lds + L_K + ht * 2;
#pragma unroll
        for (int t = 0; t < 64; t += 4) {
          s0 += bflo((unsigned)*(const bf16_t*)(kp + t * L_LD)); s1 += bflo((unsigned)*(const bf16_t*)(kp + (t + 1) * L_LD));
          s2 += bflo((unsigned)*(const bf16_t*)(kp + (t + 2) * L_LD)); s3 += bflo((unsigned)*(const bf16_t*)(kp + (t + 3) * L_LD));
        }
        nreg = g_end_c * nreg + ((s0 + s1) + (s2 + s3));
        scn[S_NV + ht] = nreg;
      }
      float wend = 0.f;
      if (more) wend = scalars((c + 1) & 1, lane);
      WG_BAR();
      if (more) stage_lds(wend, tid);
    }
    WG_BAR();
    if (half == 0) {
      p.out[(KIND == 0 ? O_NP : O_NS) + bh * 256 + (tid0 - 256)] = nreg;
      if (tid0 == 256) p.out[(KIND == 0 ? O_MPP : O_MSS) + bh] = m_prev;
    }
  }
}

DI void mixer_phase(const Params& p, int l, char* lds, int cidx, bool ml_only) {
  unsigned* ctr = (unsigned*)(p.ws + W_MISC) + 16 + cidx;
  int* s_item = (int*)(lds + LDS_BYTES - 16);
  const int total = 32 + 64 + 64 + 2048;
  for (;;) {
    __syncthreads();
    if (threadIdx.x == 0) *s_item = (int)atomicAdd(ctr, 1u);
    __syncthreads();
    const int it = *s_item;
    __syncthreads();
    if (it >= total) break;
    if (ml_only && it >= 96) break;
    if (it < 32) { mlstm_item<0>(p, l, it >> 3, (it >> 1) & 3, it & 1, lds); continue; }
    if (it < 96) { const int x = it - 32; mlstm_item<1>(p, l, x >> 3, (x >> 1) & 3, x & 1, lds); continue; }
    if (it < 160) { attn_item<1>(p, l, (it - 96) >> 3, (it - 96) & 7, 0, lds); continue; }
    { const int x = it - 160; attn_item<0>(p, l, (x & 31) >> 3, x & 7, 63 - (x >> 5), lds); }
  }
}

DI void merge_phase(const Params& p, int l) {
  const bf16_t* Z = (const bf16_t*)(p.ws + W_Z); const bf16_t* H = (const bf16_t*)(p.ws + W_H); bf16_t* Y = (bf16_t*)(p.ws + W_AB);
  const int tidq = otid(); const int lane = tidq & 63, gw = blockIdx.x * 8 + (tidq >> 6), ngw = gridDim.x * 8;
  const float* mhg = p.in[15] + (size_t)l * D;
  for (int row = gw; row < M; row += ngw) {
    const int col = lane * 16;
    const bf16_t* z = Z + (size_t)row * NIN + col;
    float hv[16];
    unpack8(*(const u32x4*)(H + (size_t)row * D + col), hv); unpack8(*(const u32x4*)(H + (size_t)row * D + col + 8), hv + 8);
    float s = 0.f;
#pragma unroll
    for (int e = 0; e < 16; ++e) s += hv[e];
#pragma unroll
    for (int o = 1; o < 16; o <<= 1) s += __shfl_xor(s, o);
    const float mean = s * (1.f / 256.f);
    float s2 = 0.f;
#pragma unroll
    for (int e = 0; e < 16; ++e) { hv[e] -= mean; s2 += hv[e] * hv[e]; }
#pragma unroll
    for (int o = 1; o < 16; o <<= 1) s2 += __shfl_xor(s2, o);
    const float rstd = rsqrtf(s2 * (1.f / 256.f) + LN_EPS);
#pragma unroll
    for (int hh = 0; hh < 2; ++hh) {
      float oa[8], om[8], ga[8], gb[8];
      unpack8(*(const u32x4*)(z + 3072 + hh * 8), oa); unpack8(*(const u32x4*)(z + 6144 + hh * 8), om);
      unpack8(*(const u32x4*)(z + 7168 + hh * 8), ga); unpack8(*(const u32x4*)(z + 8192 + hh * 8), gb);
      const f32x4 g0 = *(const f32x4*)(mhg + col + hh * 8), g1 = *(const f32x4*)(mhg + col + hh * 8 + 4);
      float y[8];
#pragma unroll
      for (int e = 0; e < 8; ++e) {
        const float hn = hv[hh * 8 + e] * rstd * (e < 4 ? g0[e] : g1[e - 4]);
        y[e] = sigmoidf_(ga[e]) * oa[e] + sigmoidf_(gb[e]) * (hn * sigmoidf_(om[e]));
      }
      u32x4 o; o[0] = pk2(y[0], y[1]); o[1] = pk2(y[2], y[3]); o[2] = pk2(y[4], y[5]); o[3] = pk2(y[6], y[7]);
      *(u32x4*)(Y + (size_t)row * D + col + hh * 8) = o;
    }
  }
}

DI void ln_phase(const Params& p, const float* g, const float* bta, bool final_out) {
  const int tidq = otid(); const int lane = tidq & 63, gw = blockIdx.x * 8 + (tidq >> 6), ngw = gridDim.x * 8;
  float* R = (float*)(p.ws + W_R); bf16_t* AB = (bf16_t*)(p.ws + W_AB);
  for (int row0 = gw; row0 < M; row0 += 2 * ngw) {
    f32x4 v[2][4]; float s[2] = {0.f, 0.f};
    const int row1 = row0 + ngw; const bool has1 = row1 < M;
#pragma unroll
    for (int q = 0; q < 2; ++q) {
      const float* xr = R + (size_t)(q == 0 ? row0 : (has1 ? row1 : row0)) * D;
#pragma unroll
      for (int j = 0; j < 4; ++j) { v[q][j] = *(const f32x4*)(xr + j * 256 + lane * 4); s[q] += (v[q][j][0] + v[q][j][1]) + (v[q][j][2] + v[q][j][3]); }
    }
#pragma unroll
    for (int q = 0; q < 2; ++q) {
      if (q == 1 && !has1) break;
      const int row = q == 0 ? row0 : row1;
      const float mean = wave_sum(s[q]) * (1.f / D);
      float s2 = 0.f;
#pragma unroll
      for (int j = 0; j < 4; ++j) { v[q][j] = v[q][j] - mean; s2 += (v[q][j][0] * v[q][j][0] + v[q][j][1] * v[q][j][1]) + (v[q][j][2] * v[q][j][2] + v[q][j][3] * v[q][j][3]); }
      const float rstd = rsqrtf(wave_sum(s2) * (1.f / D) + LN_EPS);
      float* dst = final_out ? (row < MP ? p.out + O_YP + (size_t)row * D : p.out + O_YS + (size_t)(row - MP) * D) : R + (size_t)row * D;
#pragma unroll
      for (int j = 0; j < 4; ++j) {
        const int c = j * 256 + lane * 4;
        const f32x4 gg = *(const f32x4*)(g + c), bb = *(const f32x4*)(bta + c);
        const f32x4 o = v[q][j] * rstd * gg + bb;
        *(f32x4*)(dst + c) = o;
        if (!final_out) { u32x2 ob; ob[0] = pk2(o[0], o[1]); ob[1] = pk2(o[2], o[3]); *(u32x2*)(AB + (size_t)row * D + c) = ob; }
      }
    }
  }
}

DI float gelu_f(float v) {
  const float av = fabsf(v), d = av * 0.2316418882f + 1.0f;
  const float t = __builtin_amdgcn_rcpf(d);
  float q = t * 0.5307027145f + (-0.7265760135f); q = q * t + 0.7107068705f; q = q * t + (-0.142248368f); q = q * t + 0.127414796f; q = q * t;
  const float e = __builtin_amdgcn_exp2f((v * v) * (-0.72134752044f));
  const float m = v * (q * e), r = v - m;
  return v < 0.f ? m : r;
}
DI void ffnconv_phase(const Params& p, int l) {
  const bf16_t* U = (const bf16_t*)(p.ws + W_Z); bf16_t* HF = (bf16_t*)(p.ws + W_Z + (size_t)M * NUP * 2);
  const float* cw = p.in[20] + (size_t)l * 3 * NUP; const float* cb = p.in[21] + (size_t)l * NUP;
  const unsigned total = (unsigned)(M / 4) * 352u;
  for (unsigned it = blockIdx.x * NTH + (unsigned)otid(); it < total; it += gridDim.x * NTH) {
    const unsigned rg = it / 352u, cc = it - rg * 352u;
    const int col = (int)cc * 8, row0 = (int)rg * 4;
    int t0; const float* st = nullptr;
    if (row0 < MP) t0 = row0 & (SEQ - 1); else { t0 = (row0 - MP) & 15; st = p.in[8] + ((size_t)(l * 8 + ((row0 - MP) >> 4)) * 2) * NUP; }
    float gl[4][8];
#pragma unroll
    for (int hf = 0; hf < 2; ++hf) {
      const int c2 = col + hf * DFF;
      float w[3][8], bias[8], x[6][8];
#pragma unroll
      for (int j = 0; j < 3; ++j) { const f32x4 a = *(const f32x4*)(cw + j * NUP + c2), b2 = *(const f32x4*)(cw + j * NUP + c2 + 4);
        w[j][0] = a[0]; w[j][1] = a[1]; w[j][2] = a[2]; w[j][3] = a[3]; w[j][4] = b2[0]; w[j][5] = b2[1]; w[j][6] = b2[2]; w[j][7] = b2[3]; }
      { const f32x4 a = *(const f32x4*)(cb + c2), b2 = *(const f32x4*)(cb + c2 + 4);
        bias[0] = a[0]; bias[1] = a[1]; bias[2] = a[2]; bias[3] = a[3]; bias[4] = b2[0]; bias[5] = b2[1]; bias[6] = b2[2]; bias[7] = b2[3]; }
#pragma unroll
      for (int j = 0; j < 6; ++j) {
        const int t = t0 - 2 + j;
        if (t >= 0) unpack8(*(const u32x4*)(U + (size_t)(row0 - 2 + j) * NUP + c2), x[j]);
        else if (st) { const float* sp = st + (size_t)(2 + t) * NUP + c2; const f32x4 a = *(const f32x4*)sp, b2 = *(const f32x4*)(sp + 4);
          x[j][0] = a[0]; x[j][1] = a[1]; x[j][2] = a[2]; x[j][3] = a[3]; x[j][4] = b2[0]; x[j][5] = b2[1]; x[j][6] = b2[2]; x[j][7] = b2[3]; }
        else {
#pragma unroll
          for (int e = 0; e < 8; ++e) x[j][e] = 0.f; }
      }
#pragma unroll
      for (int a = 0; a < 4; ++a) {
        float o[8];
#pragma unroll
        for (int e = 0; e < 8; ++e) {
          const float u = bias[e] + w[0][e] * x[a][e] + w[1][e] * x[a + 1][e] + w[2][e] * x[a + 2][e];
          if (hf == 0) gl[a][e] = gelu_f(u); else o[e] = gl[a][e] * u;
        }
        if (hf == 1) {
          u32x4 ov; ov[0] = pk2(o[0], o[1]); ov[1] = pk2(o[2], o[3]); ov[2] = pk2(o[4], o[5]); ov[3] = pk2(o[6], o[7]);
          *(u32x4*)(HF + (size_t)(row0 + a) * DFF + col) = ov;
        }
      }
    }
  }
}

#define XB_TMO      128
#define XB_XCNT(j)  (256  + 64 * (j))
#define XB_XSUB(j)  (1280 + 64 * (j))
#define XB_XGEN(j)  (2304 + 64 * (j))
#define XB_TOP      3328
#define XB_TOPGEN   3392
#define XCD_BAR_WORDS 3456
#define XB_SPIN_CAP (1u << 18)
#define XLAS __attribute__((address_space(3)))
DI unsigned xb_ld(unsigned* p)              { return __hip_atomic_load(p, __ATOMIC_RELAXED, __HIP_MEMORY_SCOPE_AGENT); }
DI unsigned xb_add(unsigned* p, unsigned v) { return __hip_atomic_fetch_add(p, v, __ATOMIC_RELAXED, __HIP_MEMORY_SCOPE_AGENT); }
DI unsigned xb_xcc_id() { return (unsigned)__builtin_amdgcn_s_getreg((3 << 11) | 20) & 0xFu; }
#define XB_SPIN(cond, bar) do { unsigned _sp = 0; while (cond) { __builtin_amdgcn_s_sleep(1); \
    if ((++_sp & 255u) == 0u) { if (xb_ld(&(bar)[XB_TMO])) break; if (_sp > XB_SPIN_CAP) { atomicAdd(&(bar)[XB_TMO], 1u); break; } } } } while (0)
struct XcdBarrier { unsigned* bar; unsigned x; volatile XLAS unsigned* st; };
DI XcdBarrier xcd_barrier_post(unsigned* bar, volatile XLAS unsigned* st) {
  XcdBarrier b; b.bar = bar; b.x = xb_xcc_id(); b.st = st;
  if (threadIdx.x == 0) (void)xb_add(&bar[XB_XCNT(b.x)], 1u);
  return b;
}
DI void xcd_barrier_complete(unsigned* bar, unsigned x, unsigned& nloc, unsigned& nx) {
  const unsigned G = gridDim.x * gridDim.y * gridDim.z;
  unsigned sum, cnt, mine, sp = 0u;
  for (;;) {
    sum = 0u; cnt = 0u; mine = 0u;
#pragma unroll
    for (unsigned j = 0; j < 16; ++j) { const unsigned c = xb_ld(&bar[XB_XCNT(j)]); sum += c; cnt += (c > 0u) ? 1u : 0u; mine = (j == x) ? c : mine; }
    if (sum == G) break;
    __builtin_amdgcn_s_sleep(1);
    if ((++sp & 255u) == 0u) { if (xb_ld(&bar[XB_TMO])) break; if (sp > XB_SPIN_CAP) { atomicAdd(&bar[XB_TMO], 1u); break; } }
  }
  nloc = mine > 0u ? mine : 1u; nx = cnt > 0u ? cnt : 1u;
}
DI void xcd_barrier(const XcdBarrier& b) {
  asm volatile("s_waitcnt vmcnt(0)" ::: "memory");
  __syncthreads();
  if (threadIdx.x == 0) {
    unsigned* bar = b.bar;
    __builtin_amdgcn_s_waitcnt(0);
    unsigned nloc = b.st[0], nx = b.st[1];
    if (nloc == 0u) { xcd_barrier_complete(bar, b.x, nloc, nx); b.st[0] = nloc; b.st[1] = nx; }
    const unsigned old = xb_add(&bar[XB_XSUB(b.x)], 1u);
    const unsigned gen = old / nloc;
    if (old + 1u == (gen + 1u) * nloc) {
      __builtin_amdgcn_fence(__ATOMIC_RELEASE, "agent");
      asm volatile("s_waitcnt vmcnt(0)" ::: "memory");
      const unsigned og = xb_add(&bar[XB_TOP], 1u);
      const unsigned tg = og / nx;
      if (og + 1u == (tg + 1u) * nx) xb_add(&bar[XB_TOPGEN], 1u);
      else XB_SPIN(xb_ld(&bar[XB_TOPGEN]) == tg, bar);
      __builtin_amdgcn_fence(__ATOMIC_ACQUIRE, "agent");
      xb_add(&bar[XB_XGEN(b.x)], 1u);
      asm volatile("s_waitcnt vmcnt(0)" ::: "memory");
    } else {
      XB_SPIN(xb_ld(&bar[XB_XGEN(b.x)]) == gen, bar);
      __builtin_amdgcn_fence(__ATOMIC_ACQUIRE, "agent");
      asm volatile("s_waitcnt vmcnt(0)" ::: "memory");
    }
  }
  __syncthreads();
}

constexpr int NPH = 21;
DI void run_phase(const Params& p, int ph, char* lds) {
#ifndef ONLY
  if (ph == 0) { phase0(p, lds); return; }
#else
  if (ph == 0) return;
#endif
  const int l = (ph - 1) / 10, s = (ph - 1) % 10;
#ifdef ONLY
  if (s != ONLY) return;
#endif
  switch (s) {
    case 0: gemm_phase<EPI_IN>(p, l, (const bf16_t*)(p.ws + W_AB), D, (const bf16_t*)(p.ws + W_WIN) + (size_t)l * NIN * D, D, NIN / 256, lds); break;
    case 1: qkconv_phase(p, l); gif_phase(p, l, lds, 0); break;
    case 2: mixer_phase(p, l, lds, l, false); break;
    case 3: merge_phase(p, l); break;
    case 4: gemm_phase<EPI_OUT>(p, l, (const bf16_t*)(p.ws + W_AB), D, (const bf16_t*)(p.ws + W_WOUT) + (size_t)l * D * D, D, D / 256, lds); break;
    case 5: ln_phase(p, p.in[17] + l * D, p.in[18] + l * D, false); break;
    case 6: gemm_phase<EPI_UP>(p, l, (const bf16_t*)(p.ws + W_AB), D, (const bf16_t*)(p.ws + W_WUP) + (size_t)l * NUP * D, D, NUP / 256, lds); break;
    case 7: ffnconv_phase(p, l); break;
    case 8: gemm_phase<EPI_DOWN>(p, l, (const bf16_t*)(p.ws + W_Z + (size_t)M * NUP * 2), DFF, (const bf16_t*)(p.ws + W_WDN) + (size_t)l * D * DFF, DFF, D / 256, lds); break;
    case 9: ln_phase(p, p.in[23] + l * D, p.in[24] + l * D, l == 1); break;
  }
}

__global__ void __launch_bounds__(NTH) mega(Params p, int ph_lo, int ph_hi) {
  extern __shared__ __attribute__((aligned(16))) char lds[];
#if MULTI_LAUNCH
  for (int ph = ph_lo; ph < ph_hi; ++ph) run_phase(p, ph, lds);
#else
  cg::grid_group grid = cg::this_grid();
  phase0(p, lds);
  grid.sync();
  volatile XLAS unsigned* xst = (volatile XLAS unsigned*)((XLAS char*)lds + (LDS_BYTES - 32));
  if (threadIdx.x == 0) { xst[0] = 0u; xst[1] = 0u; }
  __syncthreads();
  const XcdBarrier xb = xcd_barrier_post((unsigned*)(p.ws + W_BAR), xst);
#define GSYNC() xcd_barrier(xb)
  for (int l = 0; l < 2; ++l) {
    gemm_phase<EPI_IN>(p, l, (const bf16_t*)(p.ws + W_AB), D, (const bf16_t*)(p.ws + W_WIN) + (size_t)l * NIN * D, D, NIN / 256, lds);
    {
      const int nun = NTM * (NIN / 256), G = (int)gridDim.x;
      const int busy = nun % G;
      gif_phase(p, l, lds, (busy > 0 && busy * 2 < G) ? busy : 0);
    }
    GSYNC();
#ifdef PROBE_GIN2
    gemm_phase<EPI_IN>(p, l, (const bf16_t*)(p.ws + W_AB), D, (const bf16_t*)(p.ws + W_WIN) + (size_t)l * NIN * D, D, NIN / 256, lds);
    GSYNC();
#endif
    qkconv_phase(p, l);
    GSYNC();
#if defined(PROBE_EW2) || defined(PROBE_QKC2)
    qkconv_phase(p, l);
    GSYNC();
#endif
    mixer_phase(p, l, lds, l, false);
    GSYNC();
#ifdef PROBE_ML2
    mixer_phase(p, l, lds, l + 2, true);
    GSYNC();
#endif
#ifdef PROBE_MIX2
    mixer_phase(p, l, lds, l + 2, false);
    GSYNC();
#endif
    merge_phase(p, l);
    GSYNC();
#ifdef PROBE_SYNC
    for (int q = 0; q < 20; ++q) GSYNC();
#endif
#if defined(PROBE_EW2) || defined(PROBE_MRG2)
    merge_phase(p, l);
    GSYNC();
#endif
    gemm_phase<EPI_OUT>(p, l, (const bf16_t*)(p.ws + W_AB), D, (const bf16_t*)(p.ws + W_WOUT) + (size_t)l * D * D, D, D / 256, lds);
    GSYNC();
    ln_phase(p, p.in[17] + l * D, p.in[18] + l * D, false);
    GSYNC();
    gemm_phase<EPI_UP>(p, l, (const bf16_t*)(p.ws + W_AB), D, (const bf16_t*)(p.ws + W_WUP) + (size_t)l * NUP * D, D, NUP / 256, lds);
    GSYNC();
    ffnconv_phase(p, l);
    GSYNC();
#if defined(PROBE_EW2) || defined(PROBE_FFC2)
    ffnconv_phase(p, l);
    GSYNC();
#endif
    gemm_phase<EPI_DOWN>(p, l, (const bf16_t*)(p.ws + W_Z + (size_t)M * NUP * 2), DFF, (const bf16_t*)(p.ws + W_WDN) + (size_t)l * D * DFF, DFF, D / 256, lds);
    GSYNC();
    ln_phase(p, p.in[23] + l * D, p.in[24] + l * D, l == 1);
    if (l == 0) GSYNC();
  }
#endif
}

extern "C" void kernel_launch(void* const* d_in, const int* in_sizes, int n_in, void* d_out, int out_size, void* d_ws, size_t ws_size, hipStream_t stream) {
  static int grid = 0;
  if (grid == 0) {
    if (n_in != 25 || (size_t)out_size != O_END || ws_size < W_END) { fprintf(stderr, "kernel_launch: unexpected sizes n_in %d out %d (want %zu) ws %zu (want %zu)\n", n_in, out_size, (size_t)O_END, ws_size, (size_t)W_END); grid = -1; return; }
    int dev = 0, cus = 0, per_cu = 0;
    hipGetDevice(&dev);
    hipDeviceGetAttribute(&cus, hipDeviceAttributeMultiprocessorCount, dev);
    if (hipFuncSetAttribute((const void*)mega, hipFuncAttributeMaxDynamicSharedMemorySize, LDS_BYTES) != hipSuccess) { fprintf(stderr, "hipFuncSetAttribute failed\n"); grid = -1; return; }
    hipOccupancyMaxActiveBlocksPerMultiprocessor(&per_cu, (const void*)mega, NTH, LDS_BYTES);
    if (per_cu < 1) per_cu = 1;
    grid = cus * 1;
    (void)hipGetLastError();
  }
  if (grid < 0) return;
  Params p{};
  for (int i = 0; i < 25; ++i) p.in[i] = (const float*)d_in[i];
  p.out = (float*)d_out; p.ws = (unsigned char*)d_ws;
#if MULTI_LAUNCH
  for (int ph = 0; ph < NPH; ++ph) hipLaunchKernelGGL(mega, dim3(grid), dim3(NTH), LDS_BYTES, stream, p, ph, ph + 1);
#else
  int lo = 0, hi = NPH;
  void* args[] = {&p, &lo, &hi};
  hipError_t e = hipLaunchCooperativeKernel((const void*)mega, dim3(grid), dim3(NTH), args, LDS_BYTES, stream);
  if (e != hipSuccess) fprintf(stderr, "cooperative launch failed: %s (grid %d)\n", hipGetErrorString(e), grid);
#endif
}
```

```cpp
#include <hip/hip_runtime.h>
#include <hip/hip_cooperative_groups.h>
#include <cstdio>
namespace cg = cooperative_groups;

#ifndef MULTI_LAUNCH
#define MULTI_LAUNCH 0
#endif

typedef unsigned short bf16_t;
typedef short bf16x8 __attribute__((ext_vector_type(8)));
typedef short s16x4 __attribute__((ext_vector_type(4)));
typedef float f32x16 __attribute__((ext_vector_type(16)));
typedef float f32x4 __attribute__((ext_vector_type(4)));
typedef unsigned u32x4 __attribute__((ext_vector_type(4)));
typedef unsigned u32x2 __attribute__((ext_vector_type(2)));
#define DI __device__ __forceinline__
#define MFMA32(a, b, c) __builtin_amdgcn_mfma_f32_32x32x16_bf16((a), (b), (c), 0, 0, 0)

constexpr int NTH = 512;
constexpr int D = 1024, SEQ = 8192, NB = 4, MP = NB * SEQ, MS = 128, M = MP + MS, NTM = 129;
constexpr int DIN = 9224, NIN = 9216, DFF = 2816, NUP = 5632;
constexpr int PAST = 4096, NKS = PAST + 16;
constexpr float ALPHA = 1.4142135623730951f;
constexpr float LN_EPS = 1e-5f;
constexpr float LOG2E = 1.4426950408889634f;

constexpr size_t O_YP = 0;
constexpr size_t O_YS = O_YP + (size_t)MP * D;
constexpr size_t O_KP = O_YS + (size_t)MS * D;
constexpr size_t O_VP = O_KP + (size_t)2 * MP * 1024;
constexpr size_t O_MCP = O_VP + (size_t)2 * MP * 1024;
constexpr size_t O_CP = O_MCP + (size_t)2 * 4 * 3 * 2048;
constexpr size_t O_NP = O_CP + (size_t)2 * 4 * 4 * 65536;
constexpr size_t O_MPP = O_NP + (size_t)2 * 4 * 4 * 256;
constexpr size_t O_FCP = O_MPP + 32;
constexpr size_t O_KS = O_FCP + (size_t)2 * 4 * 2 * NUP;
constexpr size_t O_VS = O_KS + (size_t)2 * MS * 1024;
constexpr size_t O_MCS = O_VS + (size_t)2 * MS * 1024;
constexpr size_t O_CS = O_MCS + (size_t)2 * 8 * 3 * 2048;
constexpr size_t O_NS = O_CS + (size_t)2 * 8 * 4 * 65536;
constexpr size_t O_MSS = O_NS + (size_t)2 * 8 * 4 * 256;
constexpr size_t O_FCS = O_MSS + 64;
constexpr size_t O_END = O_FCS + (size_t)2 * 8 * 2 * NUP;

constexpr size_t W_Z = 0;
constexpr size_t W_H = W_Z + (size_t)M * NIN * 2;
constexpr size_t W_AB = W_H + (size_t)M * D * 2;
constexpr size_t W_KA = W_AB + (size_t)M * D * 2;
constexpr size_t W_R = W_KA + (size_t)M * D * 2;
constexpr size_t W_WIN = W_R + (size_t)M * D * 4;
constexpr size_t W_WOUT = W_WIN + (size_t)2 * NIN * D * 2;
constexpr size_t W_WUP = W_WOUT + (size_t)2 * D * D * 2;
constexpr size_t W_WDN = W_WUP + (size_t)2 * NUP * D * 2;
constexpr size_t W_GIF = W_WDN + (size_t)2 * D * DFF * 2;
constexpr size_t W_ROPE = W_GIF + (size_t)M * 8 * 4;
constexpr size_t W_MISC = W_ROPE + (size_t)8192 * 32 * 8;
constexpr size_t W_BAR = W_MISC + 4096;
constexpr size_t W_END = W_BAR + 16384;

struct Params {
  const float* in[25];
  float* out;
  unsigned char* ws;
};

DI unsigned f2bf(float x) { unsigned u = __float_as_uint(x); u += 0x7fffu + ((u >> 16) & 1u); return u >> 16; }
typedef __bf16 bf16v2 __attribute__((ext_vector_type(2)));
typedef float f32x2 __attribute__((ext_vector_type(2)));
DI unsigned pk2(float a, float b) { f32x2 v; v[0] = a; v[1] = b; return __builtin_bit_cast(unsigned, __builtin_convertvector(v, bf16v2)); }
DI float bflo(unsigned u) { return __uint_as_float(u << 16); }
DI float bfhi(unsigned u) { return __uint_as_float(u & 0xffff0000u); }
DI float sigmoidf_(float x) { return __builtin_amdgcn_rcpf(1.f + __builtin_amdgcn_exp2f(-1.4426950408889634f * x)); }
DI float wave_sum(float v) {
#pragma unroll
  for (int o = 1; o < 64; o <<= 1) v += __shfl_xor(v, o);
  return v;
}
DI int crow(int i, int h) { return (i & 3) + 8 * (i >> 2) + 4 * h; }
DI bf16x8 pack8(const f32x16& x, int s) {
  u32x4 p;
  p[0] = pk2(x[8 * s + 0], x[8 * s + 1]); p[1] = pk2(x[8 * s + 2], x[8 * s + 3]);
  p[2] = pk2(x[8 * s + 4], x[8 * s + 5]); p[3] = pk2(x[8 * s + 6], x[8 * s + 7]);
  return __builtin_bit_cast(bf16x8, p);
}
DI void unpack8(u32x4 v, float* f) {
  f[0] = bflo(v[0]); f[1] = bfhi(v[0]); f[2] = bflo(v[1]); f[3] = bfhi(v[1]);
  f[4] = bflo(v[2]); f[5] = bfhi(v[2]); f[6] = bflo(v[3]); f[7] = bfhi(v[3]);
}
typedef __attribute__((address_space(3))) s16x4 lds_s16x4;
DI bf16x8 tr_frag(unsigned a_lo, unsigned a_hi) {
  const s16x4 lo = __builtin_amdgcn_ds_read_tr16_b64_v4i16((lds_s16x4*)(size_t)a_lo);
  const s16x4 hi = __builtin_amdgcn_ds_read_tr16_b64_v4i16((lds_s16x4*)(size_t)a_hi);
  return __builtin_shufflevector(lo, hi, 0, 1, 2, 3, 4, 5, 6, 7);
}
template <int STEP, int HIOFF>
DI void tr_frag4(unsigned a, bf16x8 (&f)[4]) {
#pragma unroll
  for (int i = 0; i < 4; ++i) f[i] = tr_frag(a + i * STEP, a + i * STEP + HIOFF);
}
DI int otid() { int t = threadIdx.x; asm volatile("" : "+v"(t)); return t; }
DI int uni(int v) { return __builtin_amdgcn_readfirstlane(v); }
DI unsigned lds_addr(const void* p) { return (unsigned)(size_t)p; }

DI const float* xrow_ptr(const Params& p, int l, int row) {
  if (l == 0) return row < MP ? p.in[0] + (size_t)row * D : p.in[1] + (size_t)(row - MP) * D;
  return (const float*)(p.ws + W_R) + (size_t)row * D;
}

DI void transpose_w(const float* W, int K, int N, int src_ld, bf16_t* WT, bool remap, char* lds) {
  float* scr = (float*)lds;
  const int nkb = K / 64, nnb = N / 64, tid = otid();
  for (int it = blockIdx.x; it < nkb * nnb; it += gridDim.x) {
    const int kb = it / nnb, nb = it % nnb, k0 = kb * 64, n0 = nb * 64;
    const int ns = (remap && n0 >= 7168) ? n0 + 8 : n0;
#pragma unroll
    for (int i = 0; i < 8; ++i) {
      const int kk = (tid >> 6) + 8 * i, nn = tid & 63;
      scr[kk * 65 + nn] = W[(size_t)(k0 + kk) * src_ld + ns + nn];
    }
    __syncthreads();
    {
      const int n = tid >> 3, c = tid & 7;
      const float* s = scr + (8 * c) * 65 + n;
      u32x4 o;
      o[0] = pk2(s[0], s[65]); o[1] = pk2(s[2 * 65], s[3 * 65]); o[2] = pk2(s[4 * 65], s[5 * 65]); o[3] = pk2(s[6 * 65], s[7 * 65]);
      const int nd = (remap && n0 < 2048) ? ((n < 32) ? 2 * n : 2 * (n - 32) + 1) : n;
      *(u32x4*)(WT + (size_t)(n0 + nd) * K + k0 + 8 * c) = o;
    }
    __syncthreads();
  }
}

DI void phase0(const Params& p, char* lds) {
  const int tid = otid();
  for (int l = 0; l < 2; ++l) {
    transpose_w(p.in[9] + (size_t)l * D * DIN, D, NIN, DIN, (bf16_t*)(p.ws + W_WIN) + (size_t)l * NIN * D, true, lds);
    transpose_w(p.in[16] + (size_t)l * D * D, D, D, D, (bf16_t*)(p.ws + W_WOUT) + (size_t)l * D * D, false, lds);
    transpose_w(p.in[19] + (size_t)l * D * NUP, D, NUP, NUP, (bf16_t*)(p.ws + W_WUP) + (size_t)l * NUP * D, false, lds);
    transpose_w(p.in[22] + (size_t)l * DFF * D, DFF, D, D, (bf16_t*)(p.ws + W_WDN) + (size_t)l * D * DFF, false, lds);
  }
  bf16_t* ab = (bf16_t*)(p.ws + W_AB);
  {
    const unsigned total = (unsigned)M * 128u, S = gridDim.x * NTH;
    for (unsigned c0 = blockIdx.x * NTH + (unsigned)tid; c0 < total; c0 += 4u * S) {
      f32x4 a[4], b4[4];
#pragma unroll
      for (int u = 0; u < 4; ++u) {
        const unsigned c = c0 + (unsigned)u * S;
        if (c < total) { const float* src = xrow_ptr(p, 0, (int)(c >> 7)) + (c & 127u) * 8; a[u] = *(const f32x4*)src; b4[u] = *(const f32x4*)(src + 4); }
      }
#pragma unroll
      for (int u = 0; u < 4; ++u) {
        const unsigned c = c0 + (unsigned)u * S;
        if (c < total) {
          u32x4 o; o[0] = pk2(a[u][0], a[u][1]); o[1] = pk2(a[u][2], a[u][3]); o[2] = pk2(b4[u][0], b4[u][1]); o[3] = pk2(b4[u][2], b4[u][3]);
          *(u32x4*)(ab + (size_t)(c >> 7) * D + (c & 127u) * 8) = o;
        }
      }
    }
  }
  float2* rope = (float2*)(p.ws + W_ROPE);
  for (int i = blockIdx.x * NTH + tid; i < 8192 * 32; i += gridDim.x * NTH) {
    const int pos = i >> 5, d = i & 31;
    const double inv = exp2(-(double)d * (13.287712379549449 / 32.0));
    double ang = (double)pos * inv;
    const double twopi = 6.283185307179586476925;
    ang -= twopi * rint(ang / twopi);
    float s, c; sincosf((float)ang, &s, &c);
    rope[i] = make_float2(c, s);
  }
  if (blockIdx.x == 0 && tid < 128) {
    const int l = tid >> 6, ln = tid & 63;
    const float* lp = p.in[13] + (size_t)l * 4 * 64;
    const float s1 = wave_sum(lp[ln] * lp[64 + ln]), s2 = wave_sum(lp[128 + ln] * lp[192 + ln]);
    const float lam_init = (l == 0) ? 0.2f : (0.8f - 0.6f * 0.74081822068171788f);
    if (ln == 0) ((float*)(p.ws + W_MISC))[l] = __expf(s1) - __expf(s2) + lam_init;
  }
  if (blockIdx.x == 0 && tid < 8) ((unsigned*)(p.ws + W_MISC))[16 + tid] = 0u;
  if (blockIdx.x == 0) for (int i = tid; i < 3456; i += NTH) ((unsigned*)(p.ws + W_BAR))[i] = 0u;
}

namespace pg8 {
#define PG8_LAS __attribute__((address_space(3)))
typedef unsigned short bf16_t;
typedef short bf16x8 __attribute__((ext_vector_type(8)));
typedef float f32x4 __attribute__((ext_vector_type(4)));
typedef unsigned u32x4 __attribute__((ext_vector_type(4)));
constexpr int BM = 256, BK = 64, HALF = 128, HTB = HALF * BK * 2  , STAGE_BYTES = 8 * HTB, NXCD = 8, WGM = 8;

__host__ __device__ __forceinline__ int lds_byte(int r, int c) { const int st = (r >> 4) * 2 + (c >> 5), rr = r & 15, cc = c & 31, ob = rr * 64 + cc * 2; return st * 1024 + (ob ^ (((ob >> 9) & 1) << 5)); }
__host__ __device__ __forceinline__ void stage_rc(int b, int& R, int& C) { const int st = b / 1024, sb = b % 1024, swz = sb ^ (((sb >> 9) & 1) << 5); R = (st >> 1) * 16 + swz / 64; C = (st & 1) * 32 + (swz % 64) / 2; }
__host__ __device__ __forceinline__ int perm32(int rho) { const int n = rho >> 4, i = rho & 15; return 8 * (i >> 2) + 4 * n + (i & 3); }

struct Unit { int pm, pn; };
struct Gemm { const bf16_t* A; const bf16_t* Bt; int M, N, K; };

struct StaticOrder {
    int nM, nN, nwg, G, c;
    __host__ __device__ void init(int M, int N, int G_, int c_) { nM = M / BM; nN = N / BM; nwg = nM * nN; G = G_; c = c_; }
    __host__ __device__ bool next(int i, Unit& u) const {
        const long L = (long)i * G + c; if (L >= nwg) return false;
        int wgid = (int)L; { const int q = nwg / NXCD, r = nwg % NXCD, xcd = wgid % NXCD, off = wgid / NXCD; wgid = (xcd < r ? xcd * (q + 1) : r * (q + 1) + (xcd - r) * q) + off; }
        const int nig = WGM * nN, gid = wgid / nig, fm = gid * WGM, gsz = (nM - fm) < WGM ? (nM - fm) : WGM;
        u.pm = fm + ((wgid % nig) % gsz); u.pn = (wgid % nig) / gsz; return true;
    }
    __device__ __forceinline__ void a_ready(const Unit&) const {}
    __device__ __forceinline__ void done(const Unit&) const {}
};
template <class Epi, class Sched, bool STAMP = false>
__device__ __forceinline__ void gemm_phase(PG8_LAS unsigned char* lds, const Gemm g, const Sched& S, const Epi& E, unsigned long long* stamps) {
    const int tid = otid(), wid = __builtin_amdgcn_readfirstlane(tid >> 6), lane = tid & 63, wr = wid >> 2, wc = wid & 3, fr = lane & 15, fq = lane >> 4;
    const int K = g.K, nt = K / BK;
    int ts_lo = 0, ts_hi = 0, nts = 0; const unsigned long long rt_entry = STAMP ? (unsigned long long)wall_clock64() : 0ull;
#define PG8_STAMP() do { if (STAMP && wid == 0 && nts < 64) { const unsigned long long _c = (unsigned long long)clock64(); \
        ts_lo = (lane == nts) ? (int)(unsigned)_c : ts_lo; ts_hi = (lane == nts) ? (int)(unsigned)(_c >> 32) : ts_hi; ++nts; } } while (0)
    PG8_STAMP();
    unsigned voffA[2], voffB[2];
#pragma unroll
    for (int i = 0; i < 2; ++i) { int R, C; stage_rc(tid * 16 + i * 8192, R, C); const int Rb = Epi::PERM ? ((R & ~31) + perm32(R & 31)) : R;
        voffA[i] = (unsigned)(R * K + C) * 2u; voffB[i] = (unsigned)(Rb * K + C) * 2u; }
    const size_t kstep = (size_t)(BK * 2);
    const size_t hstep = (size_t)HALF * K * 2;
    const size_t tstep = 2 * hstep;
    const unsigned ldsw = (unsigned)wid * 1024u;
    const int aoff = lds_byte(wr * 64 + fr, fq * 8), boff = lds_byte(wc * 32 + fr, fq * 8);
#define PG8_SA(b, h) (((b) * 2 + (h)) * HTB)
#define PG8_SB(b, h) ((4 + (b) * 2 + (h)) * HTB)
#define PG8_STAGE(bufoff, gbase, voff) do { _Pragma("unroll") for (int _i = 0; _i < 2; ++_i) \
        __builtin_amdgcn_global_load_lds((const unsigned*)((const char*)(gbase) + (voff)[_i]), (PG8_LAS unsigned*)(lds + (bufoff) + ldsw + _i * 8192), 16, 0, 0); } while (0)
#define PG8_LDA(dst, b, h) do { _Pragma("unroll") for (int m = 0; m < 4; ++m) _Pragma("unroll") for (int k = 0; k < 2; ++k) dst[m][k] = *(const PG8_LAS bf16x8*)(lds + PG8_SA(b, h) + aoff + m * 2048 + k * 1024); } while (0)
#define PG8_LDB(dst, b, h) do { _Pragma("unroll") for (int n = 0; n < 2; ++n) _Pragma("unroll") for (int k = 0; k < 2; ++k) dst[n][k] = *(const PG8_LAS bf16x8*)(lds + PG8_SB(b, h) + boff + n * 2048 + k * 1024); } while (0)
#define PG8_MMA(ai, bj, At, Bt) do { __builtin_amdgcn_s_setprio(1); _Pragma("unroll") for (int m = 0; m < 4; ++m) _Pragma("unroll") for (int n = 0; n < 2; ++n) _Pragma("unroll") for (int k = 0; k < 2; ++k) \
        acc[ai][bj][m][n] = __builtin_amdgcn_mfma_f32_16x16x32_bf16(Bt[n][k], At[m][k], acc[ai][bj][m][n], 0, 0, 0); __builtin_amdgcn_s_setprio(0); } while (0)
#define PG8_WAIT_V(n) asm volatile("s_waitcnt vmcnt(" #n ")" ::: "memory")
#define PG8_WAIT_L(n) asm volatile("s_waitcnt lgkmcnt(" #n ")" ::: "memory")
#define PG8_BAR __builtin_amdgcn_s_barrier()
#define PG8_SCHED __builtin_amdgcn_sched_barrier(0)
    Unit cur, nxt; int ui = 0;
    if (!S.next(0, cur)) return;
    f32x4 acc[2][2][4][2];
#pragma unroll
    for (int a = 0; a < 2; ++a)
#pragma unroll
        for (int b = 0; b < 2; ++b)
#pragma unroll
            for (int m = 0; m < 4; ++m)
#pragma unroll
                for (int n = 0; n < 2; ++n) acc[a][b][m][n] = (f32x4){0.f, 0.f, 0.f, 0.f};
    bf16x8 At[4][2], B0[2][2], B1[2][2];
    const char* cA = (const char*)g.A + (size_t)cur.pm * tstep; const char* cB = (const char*)g.Bt + (size_t)cur.pn * tstep;
    S.a_ready(cur);
    PG8_STAGE(PG8_SB(0, 0), cB, voffB); PG8_STAGE(PG8_SA(0, 0), cA, voffA); PG8_STAGE(PG8_SB(0, 1), cB + hstep, voffB); PG8_STAGE(PG8_SA(0, 1), cA + hstep, voffA);
    if (wr == 1) PG8_BAR;
    PG8_WAIT_V(4); PG8_BAR;
    PG8_STAGE(PG8_SB(1, 0), cB + kstep, voffB); PG8_STAGE(PG8_SA(1, 0), cA + kstep, voffA); PG8_STAGE(PG8_SB(1, 1), cB + hstep + kstep, voffB);
    PG8_WAIT_V(6); PG8_BAR;
    PG8_STAMP();
    for (;;) {
        const bool has_next = S.next(ui + 1, nxt);
        const char* nA = has_next ? (const char*)g.A + (size_t)nxt.pm * tstep : cA; const char* nB = has_next ? (const char*)g.Bt + (size_t)nxt.pn * tstep : cB;
        for (int t = 0; t < nt; t += 2) {
            const bool last = (t == nt - 2);
            const char* a1 = cA + (size_t)(t + 1) * kstep;
            const char* a2 = last ? nA : cA + (size_t)(t + 2) * kstep; const char* b2 = last ? nB : cB + (size_t)(t + 2) * kstep;
            const char* a3 = a2 + kstep; const char* b3 = b2 + kstep;
            if (last && has_next) S.a_ready(nxt);
            PG8_LDB(B0, 0, 0); PG8_SCHED; PG8_LDA(At, 0, 0); PG8_STAGE(PG8_SA(1, 1), a1 + hstep, voffA);
            PG8_WAIT_L(8); PG8_BAR; PG8_WAIT_L(0); PG8_MMA(0, 0, At, B0); PG8_BAR; PG8_SCHED;
            PG8_LDB(B1, 0, 1); PG8_STAGE(PG8_SB(0, 0), b2, voffB);
            PG8_BAR; PG8_WAIT_L(0); PG8_MMA(0, 1, At, B1); PG8_BAR;
            PG8_LDA(At, 0, 1); PG8_STAGE(PG8_SA(0, 0), a2, voffA);
            PG8_BAR; PG8_WAIT_L(0); PG8_MMA(1, 0, At, B0); PG8_BAR; PG8_SCHED;
            PG8_STAGE(PG8_SB(0, 1), b2 + hstep, voffB);
            PG8_WAIT_V(6); PG8_BAR; PG8_MMA(1, 1, At, B1); PG8_BAR;
            PG8_LDB(B0, 1, 0); PG8_SCHED; PG8_LDA(At, 1, 0); PG8_STAGE(PG8_SA(0, 1), a2 + hstep, voffA);
            PG8_WAIT_L(8); PG8_BAR; PG8_WAIT_L(0); PG8_MMA(0, 0, At, B0); PG8_BAR; PG8_SCHED;
            PG8_LDB(B1, 1, 1); PG8_STAGE(PG8_SB(1, 0), b3, voffB);
            PG8_BAR; PG8_WAIT_L(0); PG8_MMA(0, 1, At, B1); PG8_BAR;
            PG8_LDA(At, 1, 1); PG8_STAGE(PG8_SA(1, 0), a3, voffA);
            PG8_BAR; PG8_WAIT_L(0); PG8_MMA(1, 0, At, B0); PG8_BAR; PG8_SCHED;
            PG8_STAGE(PG8_SB(1, 1), b3 + hstep, voffB);
            PG8_WAIT_V(6); PG8_BAR; PG8_MMA(1, 1, At, B1); PG8_BAR;
        }
        PG8_STAMP();
        if constexpr (!Epi::AFTER_DRAIN) { E(acc, cur, wr, wc, fr, fq); S.done(cur); }
        PG8_STAMP();
        if (!has_next) break;
#pragma unroll
        for (int a = 0; a < 2; ++a)
#pragma unroll
            for (int b = 0; b < 2; ++b)
#pragma unroll
                for (int m = 0; m < 4; ++m)
#pragma unroll
                    for (int n = 0; n < 2; ++n) acc[a][b][m][n] = (f32x4){0.f, 0.f, 0.f, 0.f};
        cur = nxt; cA = nA; cB = nB; ++ui;
    }
    PG8_WAIT_V(0);
    if (wr == 0) PG8_BAR;
    PG8_BAR;
    if constexpr (Epi::AFTER_DRAIN) { E.fused(acc, cur, wr, wc, fr, fq, lds, wid, lane); S.done(cur); }
    PG8_STAMP();
    if (STAMP && wid == 0) { stamps[lane] = lane < nts ? (((unsigned long long)(unsigned)ts_hi << 32) | (unsigned)ts_lo) : 0ull;
        if (lane == 62) stamps[62] = rt_entry; if (lane == 63) stamps[63] = (unsigned long long)wall_clock64(); }
#undef PG8_STAMP
#undef PG8_SA
#undef PG8_SB
#undef PG8_STAGE
#undef PG8_LDA
#undef PG8_LDB
#undef PG8_MMA
#undef PG8_WAIT_V
#undef PG8_WAIT_L
#undef PG8_BAR
#undef PG8_SCHED
}
}

enum { EPI_IN = 0, EPI_OUT = 1, EPI_UP = 2, EPI_DOWN = 3 };
template <int MODE>
struct Epi {
  static constexpr bool PERM = true, AFTER_DRAIN = false;
  Params p; int l;
  DI void operator()(const f32x4 (&acc)[2][2][4][2], const pg8::Unit& u, int wr, int wc, int fr, int fq) const {
    const int colb = u.pn * 256 + wc * 32 + 8 * fq;
    if (MODE == EPI_OUT || MODE == EPI_DOWN) {
      float* Rb = (float*)(p.ws + W_R);
#pragma unroll
      for (int ai = 0; ai < 2; ++ai) {
        f32x4 res[4][2][2];
#pragma unroll
        for (int m = 0; m < 4; ++m) {
          const int row = u.pm * 256 + ai * 128 + wr * 64 + m * 16 + fr;
          const float* rs = (MODE == EPI_OUT ? xrow_ptr(p, l, row < M ? row : M - 1) : Rb + (size_t)(row < M ? row : M - 1) * D) + colb;
#pragma unroll
          for (int bj = 0; bj < 2; ++bj) { res[m][bj][0] = *(const f32x4*)(rs + bj * 128); res[m][bj][1] = *(const f32x4*)(rs + bj * 128 + 4); }
        }
#pragma unroll
        for (int m = 0; m < 4; ++m) {
          const int row = u.pm * 256 + ai * 128 + wr * 64 + m * 16 + fr;
          if (row < M) {
            float* R = Rb + (size_t)row * D + colb;
#pragma unroll
            for (int bj = 0; bj < 2; ++bj) {
              *(f32x4*)(R + bj * 128) = res[m][bj][0] * ALPHA + acc[ai][bj][m][0];
              *(f32x4*)(R + bj * 128 + 4) = res[m][bj][1] * ALPHA + acc[ai][bj][m][1];
            }
          }
        }
      }
      return;
    }
    f32x4 rc0[8], rc1[8];
    if (MODE == EPI_IN && (u.pn >> 2) <= 1) {
      const int d0 = (colb & 63) >> 1;
#pragma unroll
      for (int i = 0; i < 8; ++i) {
        int row = u.pm * 256 + (i >> 2) * 128 + wr * 64 + (i & 3) * 16 + fr; row = row < M ? row : M - 1;
        const int pos = row < MP ? (row & (SEQ - 1)) : PAST + ((row - MP) & 15);
        const f32x4* rp = (const f32x4*)((const float2*)(p.ws + W_ROPE) + pos * 32 + d0);
        rc0[i] = rp[0]; rc1[i] = rp[1];
      }
    }
#pragma unroll
    for (int ai = 0; ai < 2; ++ai)
#pragma unroll
      for (int m = 0; m < 4; ++m) {
        const int row = u.pm * 256 + ai * 128 + wr * 64 + m * 16 + fr;
        if (row < M) {
#pragma unroll
          for (int bj = 0; bj < 2; ++bj) {
            const int col = colb + bj * 128;
            const f32x4 v0 = acc[ai][bj][m][0], v1 = acc[ai][bj][m][1];
            if (MODE == EPI_IN) {
              bf16_t* Z = (bf16_t*)(p.ws + W_Z);
              const int seg = u.pn >> 2;
              if (seg <= 1) {
                const int d0 = (col & 63) >> 1;
                const f32x4 c01 = rc0[ai * 4 + m], c23 = rc1[ai * 4 + m];
                const float a0 = v0[0] * c01[0] - v0[1] * c01[1], b0 = v0[1] * c01[0] + v0[0] * c01[1];
                const float a1 = v0[2] * c01[2] - v0[3] * c01[3], b1 = v0[3] * c01[2] + v0[2] * c01[3];
                const float a2 = v1[0] * c23[0] - v1[1] * c23[1], b2 = v1[1] * c23[0] + v1[0] * c23[1];
                const float a3 = v1[2] * c23[2] - v1[3] * c23[3], b3 = v1[3] * c23[2] + v1[2] * c23[3];
                const float qs = seg == 0 ? 0.125f : 1.f;
                u32x4 o; o[0] = pk2(a0 * qs, b0 * qs); o[1] = pk2(a1 * qs, b1 * qs); o[2] = pk2(a2 * qs, b2 * qs); o[3] = pk2(a3 * qs, b3 * qs);
                *(u32x4*)(Z + (size_t)row * NIN + col) = o;
                if (seg == 1) {
                  float* ob = (row < MP ? p.out + O_KP + ((size_t)l * MP + row) * 1024 : p.out + O_KS + ((size_t)l * MS + row - MP) * 1024) + ((col - 1024) & ~63) + d0;
                  f32x4 o1, o2; o1[0] = a0; o1[1] = a1; o1[2] = a2; o1[3] = a3; o2[0] = b0; o2[1] = b1; o2[2] = b2; o2[3] = b3;
                  *(f32x4*)ob = o1; *(f32x4*)(ob + 32) = o2;
                }
              } else {
                u32x4 o; o[0] = pk2(v0[0], v0[1]); o[1] = pk2(v0[2], v0[3]); o[2] = pk2(v1[0], v1[1]); o[3] = pk2(v1[2], v1[3]);
                *(u32x4*)(Z + (size_t)row * NIN + col) = o;
                if (seg == 2) {
                  float* ob = (row < MP ? p.out + O_VP + ((size_t)l * MP + row) * 1024 : p.out + O_VS + ((size_t)l * MS + row - MP) * 1024) + (col - 2048);
                  *(f32x4*)ob = v0; *(f32x4*)(ob + 4) = v1;
                } else if (seg == 3 || seg == 4) {
                  float* ob = nullptr;
                  if (row < MP) { const int s = row & (SEQ - 1); if (s >= SEQ - 3) ob = p.out + O_MCP + ((size_t)(l * 4 + (row >> 13)) * 3 + (s - (SEQ - 3))) * 2048 + col - 3072; }
                  else { const int t = (row - MP) & 15, b = (row - MP) >> 4; if (t >= 13) ob = p.out + O_MCS + ((size_t)(l * 8 + b) * 3 + (t - 13)) * 2048 + col - 3072; }
                  if (ob) { *(f32x4*)ob = v0; *(f32x4*)(ob + 4) = v1; }
                }
              }
            } else if (MODE == EPI_OUT || MODE == EPI_DOWN) {
              float* R = (float*)(p.ws + W_R) + (size_t)row * D + col;
              const float* rs = MODE == EPI_OUT ? xrow_ptr(p, l, row) + col : R;
              const f32x4 r0 = *(const f32x4*)rs, r1 = *(const f32x4*)(rs + 4);
              *(f32x4*)R = r0 * ALPHA + v0; *(f32x4*)(R + 4) = r1 * ALPHA + v1;
            } else {
              bf16_t* U = (bf16_t*)(p.ws + W_Z);
              u32x4 o; o[0] = pk2(v0[0], v0[1]); o[1] = pk2(v0[2], v0[3]); o[2] = pk2(v1[0], v1[1]); o[3] = pk2(v1[2], v1[3]);
              *(u32x4*)(U + (size_t)row * NUP + col) = o;
              float* ob = nullptr;
              if (row < MP) { const int s = row & (SEQ - 1); if (s >= SEQ - 2) ob = p.out + O_FCP + ((size_t)(l * 4 + (row >> 13)) * 2 + (s - (SEQ - 2))) * NUP + col; }
              else { const int t = (row - MP) & 15, b = (row - MP) >> 4; if (t >= 14) ob = p.out + O_FCS + ((size_t)(l * 8 + b) * 2 + (t - 14)) * NUP + col; }
              if (ob) { *(f32x4*)ob = v0; *(f32x4*)(ob + 4) = v1; }
            }
          }
        }
      }
  }
};

template <int MODE>
DI void gemm_phase(const Params& p, int l, const bf16_t* A, int lda, const bf16_t* Bt, int K, int ntn, char* lds) {
  (void)lda;
  pg8::Gemm g; g.A = A; g.Bt = Bt; g.M = ((MODE == EPI_OUT || MODE == EPI_DOWN) ? NTM - 1 : NTM) * 256; g.N = ntn * 256; g.K = K;
  if (MODE == EPI_OUT || MODE == EPI_DOWN) sample_gemm<MODE>(p, l, A, Bt, K);
  pg8::StaticOrder S; S.init(g.M, g.N, (int)gridDim.x, (int)blockIdx.x);
  Epi<MODE> E; E.p = p; E.l = l;
  pg8::gemm_phase<Epi<MODE>, pg8::StaticOrder, false>((PG8_LAS unsigned char*)lds, g, S, E, nullptr);
  __syncthreads();
}

typedef float f32x4v __attribute__((ext_vector_type(4)));
template <int MODE>
DI void sample_gemm(const Params& p, int l, const bf16_t* A, const bf16_t* Bt, int K) {
  if (blockIdx.x >= 64) return;
  const int tid = otid(), lane = tid & 63, wave = uni(tid >> 6), fr = lane & 15, fq = lane >> 4;
  const bf16_t* ap = A + (size_t)(MP + wave * 16 + fr) * K + fq * 8;
  const bf16_t* bp = Bt + (size_t)(blockIdx.x * 16 + fr) * K + fq * 8;
  f32x4v acc0 = {0.f, 0.f, 0.f, 0.f}, acc1 = {0.f, 0.f, 0.f, 0.f};
  for (int k0 = 0; k0 < K; k0 += 256) {
    bf16x8 a[8], bb[8];
#pragma unroll
    for (int i = 0; i < 8; ++i) { a[i] = *(const bf16x8*)(ap + k0 + i * 32); bb[i] = *(const bf16x8*)(bp + k0 + i * 32); }
#pragma unroll
    for (int i = 0; i < 8; i += 2) {
      acc0 = __builtin_amdgcn_mfma_f32_16x16x32_bf16(a[i], bb[i], acc0, 0, 0, 0);
      acc1 = __builtin_amdgcn_mfma_f32_16x16x32_bf16(a[i + 1], bb[i + 1], acc1, 0, 0, 0);
    }
  }
  const int col = blockIdx.x * 16 + fr;
  float* R = (float*)(p.ws + W_R);
#pragma unroll
  for (int j = 0; j < 4; ++j) {
    const int row = MP + wave * 16 + fq * 4 + j;
    const float res = MODE == EPI_OUT ? xrow_ptr(p, l, row)[col] : R[(size_t)row * D + col];
    R[(size_t)row * D + col] = ALPHA * res + (acc0[j] + acc1[j]);
  }
}

DI void gif_phase(const Params& p, int l, char* lds, int first_blk) {
  if ((int)blockIdx.x < first_blk) return;
  const int tidq = otid(); const int lane = tidq & 63, gw = ((int)blockIdx.x - first_blk) * 8 + (tidq >> 6), ngw = ((int)gridDim.x - first_blk) * 8;
  const float* w = p.in[9] + (size_t)l * D * DIN + 7168;
  const float* bif = p.in[10] + l * 8;
  float* gif = (float*)(p.ws + W_GIF);
  float* w8 = (float*)lds;
  __syncthreads();
#pragma unroll
  for (int i = 0; i < 2; ++i) {
    const int k = tidq + 512 * i;
    *(f32x4*)(w8 + k * 8) = *(const f32x4*)(w + (size_t)k * DIN); *(f32x4*)(w8 + k * 8 + 4) = *(const f32x4*)(w + (size_t)k * DIN + 4);
  }
  __syncthreads();
  for (int rg = gw; rg < M / 4; rg += ngw) {
    float acc[4][8];
#pragma unroll
    for (int a = 0; a < 4; ++a)
#pragma unroll
      for (int j = 0; j < 8; ++j) acc[a][j] = 0.f;
    const float* x0 = xrow_ptr(p, l, rg * 4);
#pragma unroll 4
    for (int kk = 0; kk < 16; ++kk) {
      const int k = kk * 64 + lane;
      const f32x4 w0 = *(const f32x4*)(w8 + k * 8), w1 = *(const f32x4*)(w8 + k * 8 + 4);
#pragma unroll
      for (int a = 0; a < 4; ++a) {
        const float xv = x0[(size_t)a * D + k];
        acc[a][0] += xv * w0[0]; acc[a][1] += xv * w0[1]; acc[a][2] += xv * w0[2]; acc[a][3] += xv * w0[3];
        acc[a][4] += xv * w1[0]; acc[a][5] += xv * w1[1]; acc[a][6] += xv * w1[2]; acc[a][7] += xv * w1[3];
      }
    }
#pragma unroll
    for (int a = 0; a < 4; ++a)
#pragma unroll
      for (int j = 0; j < 8; ++j) {
        const float s = wave_sum(acc[a][j]);
        if (lane == 0) gif[(size_t)(rg * 4 + a) * 8 + j] = s + bif[j];
      }
  }
  __syncthreads();
}

DI void qkconv_phase(const Params& p, int l) {
  const bf16_t* Z = (const bf16_t*)(p.ws + W_Z);
  bf16_t* QA = (bf16_t*)(p.ws + W_AB); bf16_t* KA = (bf16_t*)(p.ws + W_KA);
  const float* cw = p.in[11] + (size_t)l * 4 * 2048; const float* cb = p.in[12] + (size_t)l * 2048;
  constexpr int RG = 8;
  const size_t total = (size_t)(M / RG) * 256;
  for (size_t it = (size_t)blockIdx.x * NTH + otid(); it < total; it += (size_t)gridDim.x * NTH) {
    const int cc = (int)(it & 255), rg = (int)(it >> 8), col = cc * 8, row0 = rg * RG;
    int t0, hist_rows;
    const float* st = nullptr;
    if (row0 < MP) { t0 = row0 & (SEQ - 1); }
    else { t0 = (row0 - MP) & 15; st = p.in[4] + ((size_t)(l * 8 + ((row0 - MP) >> 4)) * 3) * 2048 + col; }
    (void)hist_rows;
    float w[4][8], bias[8];
#pragma unroll
    for (int j = 0; j < 4; ++j) { f32x4 a = *(const f32x4*)(cw + j * 2048 + col), b = *(const f32x4*)(cw + j * 2048 + col + 4);
      w[j][0] = a[0]; w[j][1] = a[1]; w[j][2] = a[2]; w[j][3] = a[3]; w[j][4] = b[0]; w[j][5] = b[1]; w[j][6] = b[2]; w[j][7] = b[3]; }
    { f32x4 a = *(const f32x4*)(cb + col), b = *(const f32x4*)(cb + col + 4);
      bias[0] = a[0]; bias[1] = a[1]; bias[2] = a[2]; bias[3] = a[3]; bias[4] = b[0]; bias[5] = b[1]; bias[6] = b[2]; bias[7] = b[3]; }
    float x[RG + 3][8];
#pragma unroll
    for (int j = 0; j < RG + 3; ++j) {
      const int t = t0 - 3 + j;
      if (t >= 0) { u32x4 v = *(const u32x4*)(Z + (size_t)(row0 - 3 + j) * NIN + 3072 + col); unpack8(v, x[j]); }
      else if (st) { f32x4 a = *(const f32x4*)(st + (size_t)(3 + t) * 2048), b = *(const f32x4*)(st + (size_t)(3 + t) * 2048 + 4);
        x[j][0] = a[0]; x[j][1] = a[1]; x[j][2] = a[2]; x[j][3] = a[3]; x[j][4] = b[0]; x[j][5] = b[1]; x[j][6] = b[2]; x[j][7] = b[3]; }
      else {
#pragma unroll
        for (int e = 0; e < 8; ++e) x[j][e] = 0.f; }
    }
    const float sc = col >= 1024 ? 0.0625f : 1.f;
    bf16_t* dst = col >= 1024 ? KA + (col - 1024) : QA + col;
#pragma unroll
    for (int a = 0; a < RG; ++a) {
      float o[8];
#pragma unroll
      for (int e = 0; e < 8; ++e) {
        float u = bias[e] + w[0][e] * x[a][e] + w[1][e] * x[a + 1][e] + w[2][e] * x[a + 2][e] + w[3][e] * x[a + 3][e];
        o[e] = u * sigmoidf_(u) * sc;
      }
      u32x4 ov; ov[0] = pk2(o[0], o[1]); ov[1] = pk2(o[2], o[3]); ov[2] = pk2(o[4], o[5]); ov[3] = pk2(o[6], o[7]);
      *(u32x4*)(dst + (size_t)(row0 + a) * D) = ov;
    }
  }
}

constexpr int A_LD = 272;
constexpr int A_TILE = 64 * A_LD;
constexpr int A_VLD = 320;
constexpr int A_VTILE = 64 * A_VLD;
template <int KIND>
DI void attn_item(const Params& p, int l, int b, int ha, int qb, char* lds) {
  const int tid = otid(), lane = tid & 63, wave = uni(tid >> 6);
  const int map = wave >> 2, qt = wave & 3, r = lane & 31, h = lane >> 5;
  const bf16_t* Z = (const bf16_t*)(p.ws + W_Z);
  const int NT = KIND == 0 ? 2 * (qb + 1) : (NKS + 63) / 64;
  const int ntw = KIND == 0 ? 2 * qb + (qt >> 1) + 1 : NT;
  const bool active = KIND == 0 ? true : (qt == 0);
  int qrow;
  if (KIND == 0) qrow = b * SEQ + qb * 128 + qt * 32 + r; else qrow = MP + b * 16 + (r < 16 ? r : 15);
  bf16x8 qf[4];
#pragma unroll
  for (int ks = 0; ks < 4; ++ks) {
    if (KIND == 0) qf[ks] = *(const bf16x8*)(Z + (size_t)qrow * NIN + ha * 128 + map * 64 + ks * 16 + h * 8);
    else {
      const int dn = ks * 16 + h * 8, par = dn >> 5, dd = dn & 31;
      const bf16_t* src = Z + (size_t)qrow * NIN + ha * 128 + map * 64 + 2 * dd;
      const u32x4 lo = *(const u32x4*)src, hi = *(const u32x4*)(src + 8);
      unsigned e[8];
#pragma unroll
      for (int i = 0; i < 4; ++i) { e[i] = par ? (lo[i] >> 16) : (lo[i] & 0xffffu); e[4 + i] = par ? (hi[i] >> 16) : (hi[i] & 0xffffu); }
      u32x4 o; o[0] = e[0] | (e[1] << 16); o[1] = e[2] | (e[3] << 16); o[2] = e[4] | (e[5] << 16); o[3] = e[6] | (e[7] << 16);
      qf[ks] = __builtin_bit_cast(bf16x8, o);
    }
  }
  const int skey = tid >> 4, part = tid & 15;
  u32x4 rk0, rk1, rv0, rv1;
  auto gload = [&](int j) {
    if (KIND == 0) {
      const bf16_t* base = Z + (size_t)(b * SEQ + j * 64 + skey) * NIN + 1024 + ha * 128 + part * 8;
      rk0 = *(const u32x4*)base; rk1 = *(const u32x4*)(base + (size_t)32 * NIN);
      rv0 = *(const u32x4*)(base + 1024); rv1 = *(const u32x4*)(base + (size_t)32 * NIN + 1024);
    } else {
#pragma unroll
      for (int i = 0; i < 2; ++i) {
        int kk = j * 64 + skey + 32 * i; if (kk > NKS - 1) kk = NKS - 1;
        const float *ks_, *vs_;
        if (kk < PAST) { const size_t o = (((size_t)(l * 8 + b) * PAST + kk) * 8 + ha) * 128 + part * 8; ks_ = p.in[2] + o; vs_ = p.in[3] + o; }
        else { const size_t o = (((size_t)l * MS + b * 16 + (kk - PAST)) * 8 + ha) * 128 + part * 8; ks_ = p.out + O_KS + o; vs_ = p.out + O_VS + o; }
        const f32x4 a0 = *(const f32x4*)ks_, a1 = *(const f32x4*)(ks_ + 4), c0 = *(const f32x4*)vs_, c1 = *(const f32x4*)(vs_ + 4);
        u32x4 ko, vo;
        ko[0] = pk2(a0[0], a0[1]); ko[1] = pk2(a0[2], a0[3]); ko[2] = pk2(a1[0], a1[1]); ko[3] = pk2(a1[2], a1[3]);
        vo[0] = pk2(c0[0], c0[1]); vo[1] = pk2(c0[2], c0[3]); vo[2] = pk2(c1[0], c1[1]); vo[3] = pk2(c1[2], c1[3]);
        if (i == 0) { rk0 = ko; rv0 = vo; } else { rk1 = ko; rv1 = vo; }
      }
    }
  };
  f32x16 O[4];
#pragma unroll
  for (int v = 0; v < 4; ++v)
#pragma unroll
    for (int i = 0; i < 16; ++i) O[v][i] = 0.f;
  float m_run = -1e30f, l_run = 0.f;
  const int q4 = (lane & 15) >> 2, p4 = lane & 3, blk = (lane >> 4) & 1;
  const unsigned sofs = skey * A_LD + part * 16, vofs = skey * A_VLD + part * 16;
  auto qk = [&](int j, f32x16 (&st)[2]) {
    const char* kb = lds + (j & 1) * A_TILE;
#pragma unroll
    for (int kt = 0; kt < 2; ++kt) {
#pragma unroll
      for (int i = 0; i < 16; ++i) st[kt][i] = 0.f;
#pragma unroll
      for (int ks = 0; ks < 4; ++ks) {
        const bf16x8 kf = *(const bf16x8*)(kb + (kt * 32 + r) * A_LD + (map * 64 + ks * 16 + h * 8) * 2);
        st[kt] = MFMA32(kf, qf[ks], st[kt]);
      }
    }
    if (KIND == 1 && j == NT - 1) {
#pragma unroll
      for (int kt = 0; kt < 2; ++kt)
#pragma unroll
        for (int i = 0; i < 16; ++i) if (j * 64 + kt * 32 + crow(i, h) >= NKS) st[kt][i] = -1e30f;
    }
  };
  bf16x8 pk[4];
  auto smax = [&](int j, f32x16 (&sc)[2], f32x16 (&sn)[2]) {
    if (j + 1 < ntw) qk(j + 1, sn);
    float mx = sc[0][0];
#pragma unroll
    for (int kt = 0; kt < 2; ++kt)
#pragma unroll
      for (int i = 0; i < 16; ++i) mx = fmaxf(mx, sc[kt][i]);
    mx = fmaxf(mx, __shfl_xor(mx, 32));
    const float m_new = fmaxf(m_run, mx);
    const float alpha = __builtin_amdgcn_exp2f((m_run - m_new) * LOG2E);
    const float mb = m_new * LOG2E;
    float rs = 0.f;
#pragma unroll
    for (int kt = 0; kt < 2; ++kt)
#pragma unroll
      for (int i = 0; i < 16; ++i) { const float e = __builtin_amdgcn_exp2f(sc[kt][i] * LOG2E - mb); sc[kt][i] = e; rs += e; }
    rs += __shfl_xor(rs, 32);
    l_run = l_run * alpha + rs; m_run = m_new;
    if (__builtin_amdgcn_ballot_w64(alpha != 1.f) != 0ull) {
#pragma unroll
      for (int v = 0; v < 4; ++v)
#pragma unroll
        for (int i = 0; i < 16; ++i) O[v][i] *= alpha;
    }
    pk[0] = pack8(sc[0], 0); pk[1] = pack8(sc[0], 1); pk[2] = pack8(sc[1], 0); pk[3] = pack8(sc[1], 1);
  };
  auto pv = [&](int j) {
    const unsigned vaddr = lds_addr(lds + 2 * A_TILE + (j % 3) * A_VTILE) + (4 * h + q4) * A_VLD + (16 * blk + 4 * p4) * 2;
#pragma unroll
    for (int vt = 0; vt < 4; ++vt) {
      bf16x8 vf[4];
      tr_frag4<16 * A_VLD, 8 * A_VLD>(vaddr + vt * 64, vf);
#pragma unroll
      for (int ks = 0; ks < 4; ++ks) O[vt] = MFMA32(vf[ks], pk[ks], O[vt]);
    }
  };
  gload(0);
  { char* kb = lds + sofs; *(u32x4*)kb = rk0; *(u32x4*)(kb + 32 * A_LD) = rk1; char* vb = lds + 2 * A_TILE + vofs; *(u32x4*)vb = rv0; *(u32x4*)(vb + 32 * A_VLD) = rv1; }
  gload(1);
  { char* kb = lds + A_TILE + sofs; *(u32x4*)kb = rk0; *(u32x4*)(kb + 32 * A_LD) = rk1; }
  __syncthreads();
  f32x16 sA[2], sB[2];
  if (active && 0 < ntw) qk(0, sA);
  for (int j = 0; j < NT; j += 2) {
#pragma unroll
    for (int u = 0; u < 2; ++u) {
      const int jj = j + u;
      if (jj < NT) {
        if (jj + 1 < NT) { char* vb = lds + 2 * A_TILE + ((jj + 1) % 3) * A_VTILE + vofs; *(u32x4*)vb = rv0; *(u32x4*)(vb + 32 * A_VLD) = rv1; }
        if (jj + 2 < NT) gload(jj + 2);
        if (active) {
          if (map == 1 && jj >= 1 && jj - 1 < ntw) pv(jj - 1);
          if (jj < ntw) { if (u == 0) smax(jj, sA, sB); else smax(jj, sB, sA); }
          if (map == 0 && jj < ntw) pv(jj);
        }
        if (jj + 2 < NT) { char* kb = lds + (jj & 1) * A_TILE + sofs; *(u32x4*)kb = rk0; *(u32x4*)(kb + 32 * A_LD) = rk1; }
        __syncthreads();
      }
    }
  }
  if (active && map == 1 && ntw == NT) pv(NT - 1);
  __syncthreads();
  float* ex = (float*)lds;
  const float inv_l = 1.f / l_run;
  if (map == 1) {
#pragma unroll
    for (int vt = 0; vt < 4; ++vt)
#pragma unroll
      for (int g = 0; g < 4; ++g) {
        f32x4 o; o[0] = O[vt][4 * g] * inv_l; o[1] = O[vt][4 * g + 1] * inv_l; o[2] = O[vt][4 * g + 2] * inv_l; o[3] = O[vt][4 * g + 3] * inv_l;
        *(f32x4*)(ex + (qt * 32 + r) * 132 + vt * 32 + 8 * g + 4 * h) = o;
      }
  }
  __syncthreads();
  if (map == 0) {
    const float lam = ((const float*)(p.ws + W_MISC))[l];
    const float lam_init = (l == 0) ? 0.2f : (0.8f - 0.6f * 0.74081822068171788f);
    float ssq = 0.f;
#pragma unroll
    for (int vt = 0; vt < 4; ++vt)
#pragma unroll
      for (int g = 0; g < 4; ++g) {
        const f32x4 o2 = *(const f32x4*)(ex + (qt * 32 + r) * 132 + vt * 32 + 8 * g + 4 * h);
#pragma unroll
        for (int e = 0; e < 4; ++e) { const float o = O[vt][4 * g + e] * inv_l - lam * o2[e]; O[vt][4 * g + e] = o; ssq += o * o; }
      }
    ssq += __shfl_xor(ssq, 32);
    const float rms = rsqrtf(ssq * (1.f / 128.f) + LN_EPS) * (1.f - lam_init);
    const float* sg = p.in[14] + l * 128;
    const bool valid = KIND == 0 ? true : (qt == 0 && r < 16);
    if (valid) {
      bf16_t* dst = (bf16_t*)(p.ws + W_Z) + (size_t)qrow * NIN + 3072 + ha * 128;
#pragma unroll
      for (int vt = 0; vt < 4; ++vt)
#pragma unroll
        for (int g = 0; g < 4; ++g) {
          const int v0 = vt * 32 + 8 * g + 4 * h;
          const f32x4 gg = *(const f32x4*)(sg + v0);
          u32x2 o; o[0] = pk2(O[vt][4 * g] * rms * gg[0], O[vt][4 * g + 1] * rms * gg[1]); o[1] = pk2(O[vt][4 * g + 2] * rms * gg[2], O[vt][4 * g + 3] * rms * gg[3]);
          *(u32x2*)(dst + v0) = o;
        }
    }
  }
  __syncthreads();
}

constexpr int L_LD = 528;
constexpr int L_VLD = 320;
constexpr int L_Q = 0, L_K = 64 * L_LD, L_V = 2 * 64 * L_LD, L_SW = L_V + 64 * L_VLD;
constexpr int L_SWLD = 144;
constexpr int L_SC = L_SW + 64 * L_SWLD;
constexpr int S_MX = 0, S_G = 64, S_EMT = 128, S_DS0 = 192, S_DS1 = 256, S_QN = 320  , S_NV = 576  , S_GEND = 832, S_PAR = 840;
constexpr int LDS_BYTES = 153376;
static_assert(L_SC + 2 * S_PAR * 4 <= 131072, "lds");
#define WG_BAR() do { __builtin_amdgcn_fence(__ATOMIC_RELEASE, "workgroup"); __builtin_amdgcn_s_barrier(); __builtin_amdgcn_fence(__ATOMIC_ACQUIRE, "workgroup"); } while (0)

template <int KIND>
DI void mlstm_item(const Params& p, int l, int b, int hm, int half, char* lds) {
  const int tid0 = otid(), wave = uni(tid0 >> 6);
  const bf16_t* QA = (const bf16_t*)(p.ws + W_AB); const bf16_t* KA = (const bf16_t*)(p.ws + W_KA);
  const bf16_t* Z = (const bf16_t*)(p.ws + W_Z); bf16_t* H = (bf16_t*)(p.ws + W_H);
  const float* GIF = (const float*)(p.ws + W_GIF);
  float* scb = (float*)(lds + L_SC);
  int nchunks = KIND == 0 ? SEQ / 64 : 1; asm volatile("" : "+s"(nchunks));
  const int Lv = KIND == 0 ? 64 : 16;
  const size_t bh = KIND == 0 ? (size_t)(l * 4 + b) * 4 + hm : (size_t)(l * 8 + b) * 4 + hm;
  if (wave < 4) {
    f32x16 C[8];
    { const int lane = tid0 & 63, r = lane & 31, h = lane >> 5; (void)r; (void)h;
      if (KIND == 0) {
#pragma unroll
        for (int d = 0; d < 8; ++d)
#pragma unroll
          for (int i = 0; i < 16; ++i) C[d][i] = 0.f;
      } else {
        const float* cp = p.in[5] + bh * 65536 + (size_t)(4 * h) * 256 + half * 128 + wave * 32 + r;
#pragma unroll
        for (int d = 0; d < 8; ++d)
#pragma unroll
          for (int g = 0; g < 4; ++g) {
            C[d][4 * g] = cp[0]; C[d][4 * g + 1] = cp[256]; C[d][4 * g + 2] = cp[512]; C[d][4 * g + 3] = cp[768];
            cp += 2048; asm volatile("" : "+v"(cp));
          }
      }
    }
    for (int c = 0; c < nchunks; ++c) {
      int tid = tid0; asm volatile("" : "+v"(tid));
      const int lane = tid & 63, r = lane & 31, h = lane >> 5;
      const int q4 = (lane & 15) >> 2, p4 = lane & 3, blk = (lane >> 4) & 1;
      const float* sc = scb + (c & 1) * S_PAR;
      const int rowbase = KIND == 0 ? b * SEQ + c * 64 : MP + b * 16;
      WG_BAR();
      f32x16 accB[2];
#pragma unroll
      for (int tt = 0; tt < 2; ++tt)
#pragma unroll
        for (int i = 0; i < 16; ++i) accB[tt][i] = 0.f;
#pragma unroll
      for (int d = 0; d < 8; ++d)
#pragma unroll
        for (int s = 0; s < 2; ++s) {
          __builtin_amdgcn_sched_barrier(0);
          const bf16x8 cf = pack8(C[d], s);
#pragma unroll
          for (int tt = 0; tt < 2; ++tt) {
            const char* qp = lds + L_Q + (tt * 32 + r) * L_LD + (d * 32 + 16 * s + 4 * h) * 2;
            const s16x4 lo = *(const s16x4*)qp, hi = *(const s16x4*)(qp + 16);
            const bf16x8 qfr = __builtin_shufflevector(lo, hi, 0, 1, 2, 3, 4, 5, 6, 7);
            accB[tt] = MFMA32(cf, qfr, accB[tt]);
          }
        }
      __builtin_amdgcn_sched_barrier(0);
      bf16x8 vf[4];
      tr_frag4<16 * L_VLD, 4 * L_VLD>(lds_addr(lds + L_V) + (8 * h + q4) * L_VLD + (wave * 32 + 16 * blk + 4 * p4) * 2, vf);
      const float g_end = sc[S_GEND];
#pragma unroll
      for (int d = 0; d < 8; ++d) {
#pragma unroll
        for (int i = 0; i < 16; ++i) C[d][i] *= g_end;
        bf16x8 kf[4];
        tr_frag4<16 * L_LD, 4 * L_LD>(lds_addr(lds + L_K) + (8 * h + q4) * L_LD + (d * 32 + 16 * blk + 4 * p4) * 2, kf);
#pragma unroll
        for (int ks = 0; ks < 4; ++ks) C[d] = MFMA32(kf[ks], vf[ks], C[d]);
      }
      WG_BAR();
#pragma unroll
      for (int tt = 0; tt < 2; ++tt) {
        const int t = tt * 32 + r;
        const float g = sc[S_G + t];
#pragma unroll
        for (int i = 0; i < 16; ++i) accB[tt][i] *= g;
        const char* sp = lds + L_SW + (tt * 32 + r) * L_SWLD + h * 16;
#pragma unroll
        for (int ks = 0; ks < 4; ++ks) accB[tt] = MFMA32(vf[ks], *(const bf16x8*)(sp + ks * 32), accB[tt]);
        const float qn = (sc[S_QN + t] + sc[S_QN + 64 + t]) + (sc[S_QN + 128 + t] + sc[S_QN + 192 + t]);
        float den = sc[S_DS0 + t] + sc[S_DS1 + t] + g * qn;
        den = fmaxf(fabsf(den), sc[S_EMT + t]);
        const float rden = 1.f / den;
        if (t < Lv) {
          bf16_t* dst = H + (size_t)(rowbase + t) * D + hm * 256 + half * 128 + wave * 32;
#pragma unroll
          for (int g4 = 0; g4 < 4; ++g4) {
            u32x2 o; o[0] = pk2(accB[tt][4 * g4] * rden, accB[tt][4 * g4 + 1] * rden); o[1] = pk2(accB[tt][4 * g4 + 2] * rden, accB[tt][4 * g4 + 3] * rden);
            *(u32x2*)(dst + 8 * g4 + 4 * h) = o;
          }
        }
      }
    }
    WG_BAR();
    {
      const int lane = tid0 & 63, r = lane & 31, h = lane >> 5;
      float* co = p.out + (KIND == 0 ? O_CP : O_CS) + bh * 65536 + (size_t)(4 * h) * 256 + half * 128 + wave * 32 + r;
#pragma unroll
      for (int d = 0; d < 8; ++d)
#pragma unroll
        for (int g = 0; g < 4; ++g) {
          co[0] = C[d][4 * g]; co[256] = C[d][4 * g + 1]; co[512] = C[d][4 * g + 2]; co[768] = C[d][4 * g + 3];
          co += 2048; asm volatile("" : "+v"(co));
        }
    }
  } else {
    const int hw = wave - 4;
    float nreg = 0.f, m_prev = 0.f;
    if (KIND == 1) { nreg = p.in[6][bh * 256 + (tid0 - 256)]; m_prev = p.in[7][bh]; }
    u32x4 pq[8], pk[8], pv[4];
    float gi = 0.f, gf = 0.f, g_end_cur = 0.f;
    auto issue_loads = [&](int c, int tid) {
      const int ht = tid - 256, lane = tid & 63;
      const int rowbase = KIND == 0 ? b * SEQ + c * 64 : MP + b * 16;
      const bool tvalid = lane < Lv;
      gi = tvalid ? GIF[(size_t)(rowbase + lane) * 8 + hm] : -1e30f;
      gf = tvalid ? GIF[(size_t)(rowbase + lane) * 8 + 4 + hm] : 0.f;
#pragma unroll
      for (int i = 0; i < 8; ++i) {
        const int cidx = ht + 256 * i, t = cidx >> 5, pc = cidx & 31;
        const int row = rowbase + (t < Lv ? t : Lv - 1);
        pq[i] = *(const u32x4*)(QA + (size_t)row * D + hm * 256 + pc * 8);
        pk[i] = *(const u32x4*)(KA + (size_t)row * D + hm * 256 + pc * 8);
      }
#pragma unroll
      for (int i = 0; i < 4; ++i) {
        const int cidx = ht + 256 * i, t = cidx >> 4, pc = cidx & 15;
        const int row = rowbase + (t < Lv ? t : Lv - 1);
        pv[i] = *(const u32x4*)(Z + (size_t)row * NIN + 5120 + hm * 256 + half * 128 + pc * 8);
      }
    };
    auto scalars = [&](int par, int lane) -> float {
      const bool tvalid = lane < Lv;
      const float lf = tvalid ? (fminf(gf, 0.f) - __logf(1.f + __expf(-fabsf(gf)))) : 0.f;
      float bc = lf;
#pragma unroll
      for (int o = 1; o < 64; o <<= 1) { const float v = __shfl_up(bc, o); if (lane >= o) bc += v; }
      const float a = gi - bc;
      float cm = a;
#pragma unroll
      for (int o = 1; o < 64; o <<= 1) { const float v = __shfl_up(cm, o); if (lane >= o) cm = fmaxf(cm, v); }
      const float mxv = fmaxf(m_prev, cm);
      const float m_t = bc + mxv;
      const float mx_end = __shfl(mxv, 63), bc_end = __shfl(bc, 63);
      const float wend = __expf(a - mx_end);
      g_end_cur = __expf(m_prev - mx_end);
      if (hw == 0) {
        float* sc = scb + par * S_PAR;
        sc[S_MX + lane] = __expf(mx_end - mxv);
        sc[S_G + lane] = __expf(m_prev - mxv);
        sc[S_EMT + lane] = __expf(-m_t);
        if (lane == 0) sc[S_GEND] = g_end_cur;
      }
      m_prev = bc_end + mx_end;
      return wend;
    };
    auto stage_lds = [&](float wend_l, int tid) {
      const int ht = tid - 256;
#pragma unroll
      for (int i = 0; i < 8; ++i) {
        const int cidx = ht + 256 * i, t = cidx >> 5, pc = cidx & 31;
        const float we = __shfl(wend_l, t);
        float f[8]; unpack8(pk[i], f);
        u32x4 o; o[0] = pk2(f[0] * we, f[1] * we); o[1] = pk2(f[2] * we, f[3] * we); o[2] = pk2(f[4] * we, f[5] * we); o[3] = pk2(f[6] * we, f[7] * we);
        *(u32x4*)(lds + L_Q + t * L_LD + pc * 16) = pq[i];
        *(u32x4*)(lds + L_K + t * L_LD + pc * 16) = o;
      }
#pragma unroll
      for (int i = 0; i < 4; ++i) {
        const int cidx = ht + 256 * i, t = cidx >> 4, pc = cidx & 15;
        *(u32x4*)(lds + L_V + t * L_VLD + pc * 16) = pv[i];
      }
    };
    {
      int tid = tid0; asm volatile("" : "+v"(tid));
      issue_loads(0, tid);
      scb[S_NV + (tid - 256)] = nreg;
      const float wend = scalars(0, tid & 63);
      stage_lds(wend, tid);
    }
    for (int c = 0; c < nchunks; ++c) {
      int tid = tid0; asm volatile("" : "+v"(tid));
      const int ht = tid - 256, lane = tid & 63, r = lane & 31, h = lane >> 5;
      float* sc = scb + (c & 1) * S_PAR;
      float* scn = scb + ((c + 1) & 1) * S_PAR;
      const float g_end_c = g_end_cur;
      WG_BAR();
      const bool more = c + 1 < nchunks;
      if (more) issue_loads(c + 1, tid);
      {
        const int t = ht & 63, part = ht >> 6;
        const char* qp = lds + L_Q + t * L_LD + part * 128;
        float s = 0.f;
#pragma unroll
        for (int e = 0; e < 8; ++e) {
          const u32x4 qq = *(const u32x4*)(qp + e * 16); float f[8]; unpack8(qq, f);
#pragma unroll
          for (int z = 0; z < 8; ++z) s += f[z] * sc[S_NV + part * 64 + e * 8 + z];
        }
        sc[S_QN + part * 64 + t] = s;
      }
      if (hw < 3) {
        const int stl = hw == 2 ? 1 : 0, tt = hw == 0 ? 0 : 1;
        f32x16 S, S2;
#pragma unroll
        for (int i = 0; i < 16; ++i) { S[i] = 0.f; S2[i] = 0.f; }
        const char* ka = lds + L_K + (stl * 32 + r) * L_LD + h * 16;
        const char* qa = lds + L_Q + (tt * 32 + r) * L_LD + h * 16;
#pragma unroll 4
        for (int ks = 0; ks < 16; ks += 2) {
          S = MFMA32(*(const bf16x8*)(ka + ks * 32), *(const bf16x8*)(qa + ks * 32), S);
          S2 = MFMA32(*(const bf16x8*)(ka + ks * 32 + 32), *(const bf16x8*)(qa + ks * 32 + 32), S2);
        }
        const int t = tt * 32 + r;
        const float cw = sc[S_MX + t];
        float rs = 0.f;
#pragma unroll
        for (int g = 0; g < 4; ++g) {
          float wv[4];
#pragma unroll
          for (int e = 0; e < 4; ++e) {
            const int s = stl * 32 + 8 * g + 4 * h + e;
            wv[e] = s <= t ? (S[4 * g + e] + S2[4 * g + e]) * cw : 0.f; rs += wv[e];
          }
          u32x2 o; o[0] = pk2(wv[0], wv[1]); o[1] = pk2(wv[2], wv[3]);
          *(u32x2*)(lds + L_SW + t * L_SWLD + (stl * 32 + 8 * g + 4 * h) * 2) = o;
        }
        rs += __shfl_xor(rs, 32);
        if (h == 0) {
          if (hw == 0) { sc[S_DS0 + t] = rs; sc[S_DS1 + t] = 0.f; }
          else if (hw == 1) sc[S_DS0 + t] = rs;
          else sc[S_DS1 + t] = rs;
        }
      } else {
        const int t = lane >> 1, hs = lane & 1;
        u32x4 z; z[0] = 0; z[1] = 0; z[2] = 0; z[3] = 0;
        *(u32x4*)(lds + L_SW + t * L_SWLD + 64 + hs * 32) = z; *(u32x4*)(lds + L_SW + t * L_SWLD + 64 + hs * 32 + 16) = z;
      }
      {
        float s0 = 0.f, s1 = 0.f, s2 = 0.f, s3 = 0.f;
        const char* kp = lds + L_K + ht * 2;
#pragma unroll
        for (int t = 0; t < 64; t += 4) {
          s0 += bflo((unsigned)*(const bf16_t*)(kp + t * L_LD)); s1 += bflo((unsigned)*(const bf16_t*)(kp + (t + 1) * L_LD));
          s2 += bflo((unsigned)*(const bf16_t*)(kp + (t + 2) * L_LD)); s3 += bflo((unsigned)*(const bf16_t*)(kp + (t + 3) * L_LD));
        }
        nreg = g_end_c * nreg + ((s0 + s1) + (s2 + s3));
        scn[S_NV + ht] = nreg;
      }
      float wend = 0.f;
      if (more) wend = scalars((c + 1) & 1, lane);
      WG_BAR();
      if (more) stage_lds(wend, tid);
    }
    WG_BAR();
    if (half == 0) {
      p.out[(KIND == 0 ? O_NP : O_NS) + bh * 256 + (tid0 - 256)] = nreg;
      if (tid0 == 256) p.out[(KIND == 0 ? O_MPP : O_MSS) + bh] = m_prev;
    }
  }
}

DI void mixer_phase(const Params& p, int l, char* lds, int cidx, bool ml_only) {
  unsigned* ctr = (unsigned*)(p.ws + W_MISC) + 16 + cidx;
  int* s_item = (int*)(lds + LDS_BYTES - 16);
  const int total = 32 + 64 + 64 + 2048;
  for (;;) {
    __syncthreads();
    if (threadIdx.x == 0) *s_item = (int)atomicAdd(ctr, 1u);
    __syncthreads();
    const int it = *s_item;
    __syncthreads();
    if (it >= total) break;
    if (ml_only && it >= 96) break;
    if (it < 32) { mlstm_item<0>(p, l, it >> 3, (it >> 1) & 3, it & 1, lds); continue; }
    if (it < 96) { const int x = it - 32; mlstm_item<1>(p, l, x >> 3, (x >> 1) & 3, x & 1, lds); continue; }
    if (it < 160) { attn_item<1>(p, l, (it - 96) >> 3, (it - 96) & 7, 0, lds); continue; }
    { const int x = it - 160; attn_item<0>(p, l, (x & 31) >> 3, x & 7, 63 - (x >> 5), lds); }
  }
}

DI void merge_phase(const Params& p, int l) {
  const bf16_t* Z = (const bf16_t*)(p.ws + W_Z); const bf16_t* H = (const bf16_t*)(p.ws + W_H); bf16_t* Y = (bf16_t*)(p.ws + W_AB);
  const int tidq = otid(); const int lane = tidq & 63, gw = blockIdx.x * 8 + (tidq >> 6), ngw = gridDim.x * 8;
  const float* mhg = p.in[15] + (size_t)l * D;
  for (int row = gw; row < M; row += ngw) {
    const int col = lane * 16;
    const bf16_t* z = Z + (size_t)row * NIN + col;
    float hv[16];
    unpack8(*(const u32x4*)(H + (size_t)row * D + col), hv); unpack8(*(const u32x4*)(H + (size_t)row * D + col + 8), hv + 8);
    float s = 0.f;
#pragma unroll
    for (int e = 0; e < 16; ++e) s += hv[e];
#pragma unroll
    for (int o = 1; o < 16; o <<= 1) s += __shfl_xor(s, o);
    const float mean = s * (1.f / 256.f);
    float s2 = 0.f;
#pragma unroll
    for (int e = 0; e < 16; ++e) { hv[e] -= mean; s2 += hv[e] * hv[e]; }
#pragma unroll
    for (int o = 1; o < 16; o <<= 1) s2 += __shfl_xor(s2, o);
    const float rstd = rsqrtf(s2 * (1.f / 256.f) + LN_EPS);
#pragma unroll
    for (int hh = 0; hh < 2; ++hh) {
      float oa[8], om[8], ga[8], gb[8];
      unpack8(*(const u32x4*)(z + 3072 + hh * 8), oa); unpack8(*(const u32x4*)(z + 6144 + hh * 8), om);
      unpack8(*(const u32x4*)(z + 7168 + hh * 8), ga); unpack8(*(const u32x4*)(z + 8192 + hh * 8), gb);
      const f32x4 g0 = *(const f32x4*)(mhg + col + hh * 8), g1 = *(const f32x4*)(mhg + col + hh * 8 + 4);
      float y[8];
#pragma unroll
      for (int e = 0; e < 8; ++e) {
        const float hn = hv[hh * 8 + e] * rstd * (e < 4 ? g0[e] : g1[e - 4]);
        y[e] = sigmoidf_(ga[e]) * oa[e] + sigmoidf_(gb[e]) * (hn * sigmoidf_(om[e]));
      }
      u32x4 o; o[0] = pk2(y[0], y[1]); o[1] = pk2(y[2], y[3]); o[2] = pk2(y[4], y[5]); o[3] = pk2(y[6], y[7]);
      *(u32x4*)(Y + (size_t)row * D + col + hh * 8) = o;
    }
  }
}

DI void ln_phase(const Params& p, const float* g, const float* bta, bool final_out) {
  const int tidq = otid(); const int lane = tidq & 63, gw = blockIdx.x * 8 + (tidq >> 6), ngw = gridDim.x * 8;
  float* R = (float*)(p.ws + W_R); bf16_t* AB = (bf16_t*)(p.ws + W_AB);
  for (int row0 = gw; row0 < M; row0 += 2 * ngw) {
    f32x4 v[2][4]; float s[2] = {0.f, 0.f};
    const int row1 = row0 + ngw; const bool has1 = row1 < M;
#pragma unroll
    for (int q = 0; q < 2; ++q) {
      const float* xr = R + (size_t)(q == 0 ? row0 : (has1 ? row1 : row0)) * D;
#pragma unroll
      for (int j = 0; j < 4; ++j) { v[q][j] = *(const f32x4*)(xr + j * 256 + lane * 4); s[q] += (v[q][j][0] + v[q][j][1]) + (v[q][j][2] + v[q][j][3]); }
    }
#pragma unroll
    for (int q = 0; q < 2; ++q) {
      if (q == 1 && !has1) break;
      const int row = q == 0 ? row0 : row1;
      const float mean = wave_sum(s[q]) * (1.f / D);
      float s2 = 0.f;
#pragma unroll
      for (int j = 0; j < 4; ++j) { v[q][j] = v[q][j] - mean; s2 += (v[q][j][0] * v[q][j][0] + v[q][j][1] * v[q][j][1]) + (v[q][j][2] * v[q][j][2] + v[q][j][3] * v[q][j][3]); }
      const float rstd = rsqrtf(wave_sum(s2) * (1.f / D) + LN_EPS);
      float* dst = final_out ? (row < MP ? p.out + O_YP + (size_t)row * D : p.out + O_YS + (size_t)(row - MP) * D) : R + (size_t)row * D;
#pragma unroll
      for (int j = 0; j < 4; ++j) {
        const int c = j * 256 + lane * 4;
        const f32x4 gg = *(const f32x4*)(g + c), bb = *(const f32x4*)(bta + c);
        const f32x4 o = v[q][j] * rstd * gg + bb;
        *(f32x4*)(dst + c) = o;
        if (!final_out) { u32x2 ob; ob[0] = pk2(o[0], o[1]); ob[1] = pk2(o[2], o[3]); *(u32x2*)(AB + (size_t)row * D + c) = ob; }
      }
    }
  }
}

DI float gelu_f(float v) {
  const float av = fabsf(v), d = av * 0.2316418882f + 1.0f;
  const float t = __builtin_amdgcn_rcpf(d);
  float q = t * 0.5307027145f + (-0.7265760135f); q = q * t + 0.7107068705f; q = q * t + (-0.142248368f); q = q * t + 0.127414796f; q = q * t;
  const float e = __builtin_amdgcn_exp2f((v * v) * (-0.72134752044f));
  const float m = v * (q * e), r = v - m;
  return v < 0.f ? m : r;
}
DI void ffnconv_phase(const Params& p, int l) {
  const bf16_t* U = (const bf16_t*)(p.ws + W_Z); bf16_t* HF = (bf16_t*)(p.ws + W_Z + (size_t)M * NUP * 2);
  const float* cw = p.in[20] + (size_t)l * 3 * NUP; const float* cb = p.in[21] + (size_t)l * NUP;
  const unsigned total = (unsigned)(M / 4) * 352u;
  for (unsigned it = blockIdx.x * NTH + (unsigned)otid(); it < total; it += gridDim.x * NTH) {
    const unsigned rg = it / 352u, cc = it - rg * 352u;
    const int col = (int)cc * 8, row0 = (int)rg * 4;
    int t0; const float* st = nullptr;
    if (row0 < MP) t0 = row0 & (SEQ - 1); else { t0 = (row0 - MP) & 15; st = p.in[8] + ((size_t)(l * 8 + ((row0 - MP) >> 4)) * 2) * NUP; }
    float gl[4][8];
#pragma unroll
    for (int hf = 0; hf < 2; ++hf) {
      const int c2 = col + hf * DFF;
      float w[3][8], bias[8], x[6][8];
#pragma unroll
      for (int j = 0; j < 3; ++j) { const f32x4 a = *(const f32x4*)(cw + j * NUP + c2), b2 = *(const f32x4*)(cw + j * NUP + c2 + 4);
        w[j][0] = a[0]; w[j][1] = a[1]; w[j][2] = a[2]; w[j][3] = a[3]; w[j][4] = b2[0]; w[j][5] = b2[1]; w[j][6] = b2[2]; w[j][7] = b2[3]; }
      { const f32x4 a = *(const f32x4*)(cb + c2), b2 = *(const f32x4*)(cb + c2 + 4);
        bias[0] = a[0]; bias[1] = a[1]; bias[2] = a[2]; bias[3] = a[3]; bias[4] = b2[0]; bias[5] = b2[1]; bias[6] = b2[2]; bias[7] = b2[3]; }
#pragma unroll
      for (int j = 0; j < 6; ++j) {
        const int t = t0 - 2 + j;
        if (t >= 0) unpack8(*(const u32x4*)(U + (size_t)(row0 - 2 + j) * NUP + c2), x[j]);
        else if (st) { const float* sp = st + (size_t)(2 + t) * NUP + c2; const f32x4 a = *(const f32x4*)sp, b2 = *(const f32x4*)(sp + 4);
          x[j][0] = a[0]; x[j][1] = a[1]; x[j][2] = a[2]; x[j][3] = a[3]; x[j][4] = b2[0]; x[j][5] = b2[1]; x[j][6] = b2[2]; x[j][7] = b2[3]; }
        else {
#pragma unroll
          for (int e = 0; e < 8; ++e) x[j][e] = 0.f; }
      }
#pragma unroll
      for (int a = 0; a < 4; ++a) {
        float o[8];
#pragma unroll
        for (int e = 0; e < 8; ++e) {
          const float u = bias[e] + w[0][e] * x[a][e] + w[1][e] * x[a + 1][e] + w[2][e] * x[a + 2][e];
          if (hf == 0) gl[a][e] = gelu_f(u); else o[e] = gl[a][e] * u;
        }
        if (hf == 1) {
          u32x4 ov; ov[0] = pk2(o[0], o[1]); ov[1] = pk2(o[2], o[3]); ov[2] = pk2(o[4], o[5]); ov[3] = pk2(o[6], o[7]);
          *(u32x4*)(HF + (size_t)(row0 + a) * DFF + col) = ov;
        }
      }
    }
  }
}

#define XB_TMO      128
#define XB_XCNT(j)  (256  + 64 * (j))
#define XB_XSUB(j)  (1280 + 64 * (j))
#define XB_XGEN(j)  (2304 + 64 * (j))
#define XB_TOP      3328
#define XB_TOPGEN   3392
#define XCD_BAR_WORDS 3456
#define XB_SPIN_CAP (1u << 18)
#define XLAS __attribute__((address_space(3)))
DI unsigned xb_ld(unsigned* p)              { return __hip_atomic_load(p, __ATOMIC_RELAXED, __HIP_MEMORY_SCOPE_AGENT); }
DI unsigned xb_add(unsigned* p, unsigned v) { return __hip_atomic_fetch_add(p, v, __ATOMIC_RELAXED, __HIP_MEMORY_SCOPE_AGENT); }
DI unsigned xb_xcc_id() { return (unsigned)__builtin_amdgcn_s_getreg((3 << 11) | 20) & 0xFu; }
#define XB_SPIN(cond, bar) do { unsigned _sp = 0; while (cond) { __builtin_amdgcn_s_sleep(1); \
    if ((++_sp & 255u) == 0u) { if (xb_ld(&(bar)[XB_TMO])) break; if (_sp > XB_SPIN_CAP) { atomicAdd(&(bar)[XB_TMO], 1u); break; } } } } while (0)
struct XcdBarrier { unsigned* bar; unsigned x; volatile XLAS unsigned* st; };
DI XcdBarrier xcd_barrier_post(unsigned* bar, volatile XLAS unsigned* st) {
  XcdBarrier b; b.bar = bar; b.x = xb_xcc_id(); b.st = st;
  if (threadIdx.x == 0) (void)xb_add(&bar[XB_XCNT(b.x)], 1u);
  return b;
}
DI void xcd_barrier_complete(unsigned* bar, unsigned x, unsigned& nloc, unsigned& nx) {
  const unsigned G = gridDim.x * gridDim.y * gridDim.z;
  unsigned sum, cnt, mine, sp = 0u;
  for (;;) {
    sum = 0u; cnt = 0u; mine = 0u;
#pragma unroll
    for (unsigned j = 0; j < 16; ++j) { const unsigned c = xb_ld(&bar[XB_XCNT(j)]); sum += c; cnt += (c > 0u) ? 1u : 0u; mine = (j == x) ? c : mine; }
    if (sum == G) break;
    __builtin_amdgcn_s_sleep(1);
    if ((++sp & 255u) == 0u) { if (xb_ld(&bar[XB_TMO])) break; if (sp > XB_SPIN_CAP) { atomicAdd(&bar[XB_TMO], 1u); break; } }
  }
  nloc = mine > 0u ? mine : 1u; nx = cnt > 0u ? cnt : 1u;
}
DI void xcd_barrier(const XcdBarrier& b) {
  asm volatile("s_waitcnt vmcnt(0)" ::: "memory");
  __syncthreads();
  if (threadIdx.x == 0) {
    unsigned* bar = b.bar;
    __builtin_amdgcn_s_waitcnt(0);
    unsigned nloc = b.st[0], nx = b.st[1];
    if (nloc == 0u) { xcd_barrier_complete(bar, b.x, nloc, nx); b.st[0] = nloc; b.st[1] = nx; }
    const unsigned old = xb_add(&bar[XB_XSUB(b.x)], 1u);
    const unsigned gen = old / nloc;
    if (old + 1u == (gen + 1u) * nloc) {
      __builtin_amdgcn_fence(__ATOMIC_RELEASE, "agent");
      asm volatile("s_waitcnt vmcnt(0)" ::: "memory");
      const unsigned og = xb_add(&bar[XB_TOP], 1u);
      const unsigned tg = og / nx;
      if (og + 1u == (tg + 1u) * nx) xb_add(&bar[XB_TOPGEN], 1u);
      else XB_SPIN(xb_ld(&bar[XB_TOPGEN]) == tg, bar);
      __builtin_amdgcn_fence(__ATOMIC_ACQUIRE, "agent");
      xb_add(&bar[XB_XGEN(b.x)], 1u);
      asm volatile("s_waitcnt vmcnt(0)" ::: "memory");
    } else {
      XB_SPIN(xb_ld(&bar[XB_XGEN(b.x)]) == gen, bar);
      __builtin_amdgcn_fence(__ATOMIC_ACQUIRE, "agent");
      asm volatile("s_waitcnt vmcnt(0)" ::: "memory");
    }
  }
  __syncthreads();
}

constexpr int NPH = 21;
DI void run_phase(const Params& p, int ph, char* lds) {
#ifndef ONLY
  if (ph == 0) { phase0(p, lds); return; }
#else
  if (ph == 0) return;
#endif
  const int l = (ph - 1) / 10, s = (ph - 1) % 10;
#ifdef ONLY
  if (s != ONLY) return;
#endif
  switch (s) {
    case 0: gemm_phase<EPI_IN>(p, l, (const bf16_t*)(p.ws + W_AB), D, (const bf16_t*)(p.ws + W_WIN) + (size_t)l * NIN * D, D, NIN / 256, lds); break;
    case 1: qkconv_phase(p, l); gif_phase(p, l, lds, 0); break;
    case 2: mixer_phase(p, l, lds, l, false); break;
    case 3: merge_phase(p, l); break;
    case 4: gemm_phase<EPI_OUT>(p, l, (const bf16_t*)(p.ws + W_AB), D, (const bf16_t*)(p.ws + W_WOUT) + (size_t)l * D * D, D, D / 256, lds); break;
    case 5: ln_phase(p, p.in[17] + l * D, p.in[18] + l * D, false); break;
    case 6: gemm_phase<EPI_UP>(p, l, (const bf16_t*)(p.ws + W_AB), D, (const bf16_t*)(p.ws + W_WUP) + (size_t)l * NUP * D, D, NUP / 256, lds); break;
    case 7: ffnconv_phase(p, l); break;
    case 8: gemm_phase<EPI_DOWN>(p, l, (const bf16_t*)(p.ws + W_Z + (size_t)M * NUP * 2), DFF, (const bf16_t*)(p.ws + W_WDN) + (size_t)l * D * DFF, DFF, D / 256, lds); break;
    case 9: ln_phase(p, p.in[23] + l * D, p.in[24] + l * D, l == 1); break;
  }
}

__global__ void __launch_bounds__(NTH) mega(Params p, int ph_lo, int ph_hi) {
  extern __shared__ __attribute__((aligned(16))) char lds[];
#if MULTI_LAUNCH
  for (int ph = ph_lo; ph < ph_hi; ++ph) run_phase(p, ph, lds);
#else
  cg::grid_group grid = cg::this_grid();
  phase0(p, lds);
  grid.sync();
  volatile XLAS unsigned* xst = (volatile XLAS unsigned*)((XLAS char*)lds + (LDS_BYTES - 32));
  if (threadIdx.x == 0) { xst[0] = 0u; xst[1] = 0u; }
  __syncthreads();
  const XcdBarrier xb = xcd_barrier_post((unsigned*)(p.ws + W_BAR), xst);
#define GSYNC() xcd_barrier(xb)
  for (int l = 0; l < 2; ++l) {
    gemm_phase<EPI_IN>(p, l, (const bf16_t*)(p.ws + W_AB), D, (const bf16_t*)(p.ws + W_WIN) + (size_t)l * NIN * D, D, NIN / 256, lds);
    {
      const int nun = NTM * (NIN / 256), G = (int)gridDim.x;
      const int busy = nun % G;
      gif_phase(p, l, lds, (busy > 0 && busy * 2 < G) ? busy : 0);
    }
    GSYNC();
#ifdef PROBE_GIN2
    gemm_phase<EPI_IN>(p, l, (const bf16_t*)(p.ws + W_AB), D, (const bf16_t*)(p.ws + W_WIN) + (size_t)l * NIN * D, D, NIN / 256, lds);
    GSYNC();
#endif
    qkconv_phase(p, l);
    GSYNC();
#if defined(PROBE_EW2) || defined(PROBE_QKC2)
    qkconv_phase(p, l);
    GSYNC();
#endif
    mixer_phase(p, l, lds, l, false);
    GSYNC();
#ifdef PROBE_ML2
    mixer_phase(p, l, lds, l + 2, true);
    GSYNC();
#endif
#ifdef PROBE_MIX2
    mixer_phase(p, l, lds, l + 2, false);
    GSYNC();
#endif
    merge_phase(p, l);
    GSYNC();
#ifdef PROBE_SYNC
    for (int q = 0; q < 20; ++q) GSYNC();
#endif
#if defined(PROBE_EW2) || defined(PROBE_MRG2)
    merge_phase(p, l);
    GSYNC();
#endif
    gemm_phase<EPI_OUT>(p, l, (const bf16_t*)(p.ws + W_AB), D, (const bf16_t*)(p.ws + W_WOUT) + (size_t)l * D * D, D, D / 256, lds);
    GSYNC();
    ln_phase(p, p.in[17] + l * D, p.in[18] + l * D, false);
    GSYNC();
    gemm_phase<EPI_UP>(p, l, (const bf16_t*)(p.ws + W_AB), D, (const bf16_t*)(p.ws + W_WUP) + (size_t)l * NUP * D, D, NUP / 256, lds);
    GSYNC();
    ffnconv_phase(p, l);
    GSYNC();
#if defined(PROBE_EW2) || defined(PROBE_FFC2)
    ffnconv_phase(p, l);
    GSYNC();
#endif
    gemm_phase<EPI_DOWN>(p, l, (const bf16_t*)(p.ws + W_Z + (size_t)M * NUP * 2), DFF, (const bf16_t*)(p.ws + W_WDN) + (size_t)l * D * DFF, DFF, D / 256, lds);
    GSYNC();
    ln_phase(p, p.in[23] + l * D, p.in[24] + l * D, l == 1);
    if (l == 0) GSYNC();
  }
#endif
}

extern "C" void kernel_launch(void* const* d_in, const int* in_sizes, int n_in, void* d_out, int out_size, void* d_ws, size_t ws_size, hipStream_t stream) {
  static int grid = 0;
  if (grid == 0) {
    if (n_in != 25 || (size_t)out_size != O_END || ws_size < W_END) { fprintf(stderr, "kernel_launch: unexpected sizes n_in %d out %d (want %zu) ws %zu (want %zu)\n", n_in, out_size, (size_t)O_END, ws_size, (size_t)W_END); grid = -1; return; }
    int dev = 0, cus = 0, per_cu = 0;
    hipGetDevice(&dev);
    hipDeviceGetAttribute(&cus, hipDeviceAttributeMultiprocessorCount, dev);
    if (hipFuncSetAttribute((const void*)mega, hipFuncAttributeMaxDynamicSharedMemorySize, LDS_BYTES) != hipSuccess) { fprintf(stderr, "hipFuncSetAttribute failed\n"); grid = -1; return; }
    hipOccupancyMaxActiveBlocksPerMultiprocessor(&per_cu, (const void*)mega, NTH, LDS_BYTES);
    if (per_cu < 1) per_cu = 1;
    grid = cus * 1;
    (void)hipGetLastError();
  }
  if (grid < 0) return;
  Params p{};
  for (int i = 0; i < 25; ++i) p.in[i] = (const float*)d_in[i];
  p.out = (float*)d_out; p.ws = (unsigned char*)d_ws;
#if MULTI_LAUNCH
  for (int ph = 0; ph < NPH; ++ph) hipLaunchKernelGGL(mega, dim3(grid), dim3(NTH), LDS_BYTES, stream, p, ph, ph + 1);
#else
  int lo = 0, hi = NPH;
  void* args[] = {&p, &lo, &hi};
  hipError_t e = hipLaunchCooperativeKernel((const void*)mega, dim3(grid), dim3(NTH), args, LDS_BYTES, stream);
  if (e != hipSuccess) fprintf(stderr, "cooperative launch failed: %s (grid %d)\n", hipGetErrorString(e), grid);
#endif
}
```

```cpp
#include <hip/hip_runtime.h>
#include <hip/hip_cooperative_groups.h>
#include <cstdio>
namespace cg = cooperative_groups;

#ifndef MULTI_LAUNCH
#define MULTI_LAUNCH 0
#endif

typedef unsigned short bf16_t;
typedef short bf16x8 __attribute__((ext_vector_type(8)));
typedef short s16x4 __attribute__((ext_vector_type(4)));
typedef float f32x16 __attribute__((ext_vector_type(16)));
typedef float f32x4 __attribute__((ext_vector_type(4)));
typedef unsigned u32x4 __attribute__((ext_vector_type(4)));
typedef unsigned u32x2 __attribute__((ext_vector_type(2)));
#define DI __device__ __forceinline__
#define MFMA32(a, b, c) __builtin_amdgcn_mfma_f32_32x32x16_bf16((a), (b), (c), 0, 0, 0)

constexpr int NTH = 512;
constexpr int D = 1024, SEQ = 8192, NB = 4, MP = NB * SEQ, MS = 128, M = MP + MS, NTM = 129;
constexpr int DIN = 9224, NIN = 9216, DFF = 2816, NUP = 5632;
constexpr int PAST = 4096, NKS = PAST + 16;
constexpr float ALPHA = 1.4142135623730951f;
constexpr float LN_EPS = 1e-5f;
constexpr float LOG2E = 1.4426950408889634f;

constexpr size_t O_YP = 0;
constexpr size_t O_YS = O_YP + (size_t)MP * D;
constexpr size_t O_KP = O_YS + (size_t)MS * D;
constexpr size_t O_VP = O_KP + (size_t)2 * MP * 1024;
constexpr size_t O_MCP = O_VP + (size_t)2 * MP * 1024;
constexpr size_t O_CP = O_MCP + (size_t)2 * 4 * 3 * 2048;
constexpr size_t O_NP = O_CP + (size_t)2 * 4 * 4 * 65536;
constexpr size_t O_MPP = O_NP + (size_t)2 * 4 * 4 * 256;
constexpr size_t O_FCP = O_MPP + 32;
constexpr size_t O_KS = O_FCP + (size_t)2 * 4 * 2 * NUP;
constexpr size_t O_VS = O_KS + (size_t)2 * MS * 1024;
constexpr size_t O_MCS = O_VS + (size_t)2 * MS * 1024;
constexpr size_t O_CS = O_MCS + (size_t)2 * 8 * 3 * 2048;
constexpr size_t O_NS = O_CS + (size_t)2 * 8 * 4 * 65536;
constexpr size_t O_MSS = O_NS + (size_t)2 * 8 * 4 * 256;
constexpr size_t O_FCS = O_MSS + 64;
constexpr size_t O_END = O_FCS + (size_t)2 * 8 * 2 * NUP;

constexpr size_t W_Z = 0;
constexpr size_t W_H = W_Z + (size_t)M * NIN * 2;
constexpr size_t W_AB = W_H + (size_t)M * D * 2;
constexpr size_t W_KA = W_AB + (size_t)M * D * 2;
constexpr size_t W_R = W_KA + (size_t)M * D * 2;
constexpr size_t W_WIN = W_R + (size_t)M * D * 4;
constexpr size_t W_WOUT = W_WIN + (size_t)2 * NIN * D * 2;
constexpr size_t W_WUP = W_WOUT + (size_t)2 * D * D * 2;
constexpr size_t W_WDN = W_WUP + (size_t)2 * NUP * D * 2;
constexpr size_t W_GIF = W_WDN + (size_t)2 * D * DFF * 2;
constexpr size_t W_ROPE = W_GIF + (size_t)M * 8 * 4;
constexpr size_t W_MISC = W_ROPE + (size_t)8192 * 32 * 8;
constexpr size_t W_BAR = W_MISC + 4096;
constexpr size_t W_END = W_BAR + 16384;

struct Params {
  const float* in[25];
  float* out;
  unsigned char* ws;
};

DI unsigned f2bf(float x) { unsigned u = __float_as_uint(x); u += 0x7fffu + ((u >> 16) & 1u); return u >> 16; }
typedef __bf16 bf16v2 __attribute__((ext_vector_type(2)));
typedef float f32x2 __attribute__((ext_vector_type(2)));
DI unsigned pk2(float a, float b) { f32x2 v; v[0] = a; v[1] = b; return __builtin_bit_cast(unsigned, __builtin_convertvector(v, bf16v2)); }
DI float bflo(unsigned u) { return __uint_as_float(u << 16); }
DI float bfhi(unsigned u) { return __uint_as_float(u & 0xffff0000u); }
DI float sigmoidf_(float x) { return __builtin_amdgcn_rcpf(1.f + __builtin_amdgcn_exp2f(-1.4426950408889634f * x)); }
DI float wave_sum(float v) {
#pragma unroll
  for (int o = 1; o < 64; o <<= 1) v += __shfl_xor(v, o);
  return v;
}
DI int crow(int i, int h) { return (i & 3) + 8 * (i >> 2) + 4 * h; }
DI bf16x8 pack8(const f32x16& x, int s) {
  u32x4 p;
  p[0] = pk2(x[8 * s + 0], x[8 * s + 1]); p[1] = pk2(x[8 * s + 2], x[8 * s + 3]);
  p[2] = pk2(x[8 * s + 4], x[8 * s + 5]); p[3] = pk2(x[8 * s + 6], x[8 * s + 7]);
  return __builtin_bit_cast(bf16x8, p);
}
DI void unpack8(u32x4 v, float* f) {
  f[0] = bflo(v[0]); f[1] = bfhi(v[0]); f[2] = bflo(v[1]); f[3] = bfhi(v[1]);
  f[4] = bflo(v[2]); f[5] = bfhi(v[2]); f[6] = bflo(v[3]); f[7] = bfhi(v[3]);
}
typedef __attribute__((address_space(3))) s16x4 lds_s16x4;
DI bf16x8 tr_frag(unsigned a_lo, unsigned a_hi) {
  const s16x4 lo = __builtin_amdgcn_ds_read_tr16_b64_v4i16((lds_s16x4*)(size_t)a_lo);
  const s16x4 hi = __builtin_amdgcn_ds_read_tr16_b64_v4i16((lds_s16x4*)(size_t)a_hi);
  return __builtin_shufflevector(lo, hi, 0, 1, 2, 3, 4, 5, 6, 7);
}
template <int STEP, int HIOFF>
DI void tr_frag4(unsigned a, bf16x8 (&f)[4]) {
#pragma unroll
  for (int i = 0; i < 4; ++i) f[i] = tr_frag(a + i * STEP, a + i * STEP + HIOFF);
}
DI int otid() { int t = threadIdx.x; asm volatile("" : "+v"(t)); return t; }
DI int uni(int v) { return __builtin_amdgcn_readfirstlane(v); }
DI unsigned lds_addr(const void* p) { return (unsigned)(size_t)p; }

DI const float* xrow_ptr(const Params& p, int l, int row) {
  if (l == 0) return row < MP ? p.in[0] + (size_t)row * D : p.in[1] + (size_t)(row - MP) * D;
  return (const float*)(p.ws + W_R) + (size_t)row * D;
}

DI void transpose_w(const float* W, int K, int N, int src_ld, bf16_t* WT, bool remap, char* lds) {
  float* scr = (float*)lds;
  const int nkb = K / 64, nnb = N / 64, tid = otid();
  for (int it = blockIdx.x; it < nkb * nnb; it += gridDim.x) {
    const int kb = it / nnb, nb = it % nnb, k0 = kb * 64, n0 = nb * 64;
    const int ns = (remap && n0 >= 7168) ? n0 + 8 : n0;
#pragma unroll
    for (int i = 0; i < 8; ++i) {
      const int kk = (tid >> 6) + 8 * i, nn = tid & 63;
      scr[kk * 65 + nn] = W[(size_t)(k0 + kk) * src_ld + ns + nn];
    }
    __syncthreads();
    {
      const int n = tid >> 3, c = tid & 7;
      const float* s = scr + (8 * c) * 65 + n;
      u32x4 o;
      o[0] = pk2(s[0], s[65]); o[1] = pk2(s[2 * 65], s[3 * 65]); o[2] = pk2(s[4 * 65], s[5 * 65]); o[3] = pk2(s[6 * 65], s[7 * 65]);
      const int nd = (remap && n0 < 2048) ? ((n < 32) ? 2 * n : 2 * (n - 32) + 1) : n;
      *(u32x4*)(WT + (size_t)(n0 + nd) * K + k0 + 8 * c) = o;
    }
    __syncthreads();
  }
}

DI void phase0(const Params& p, char* lds) {
  const int tid = otid();
  for (int l = 0; l < 2; ++l) {
    transpose_w(p.in[9] + (size_t)l * D * DIN, D, NIN, DIN, (bf16_t*)(p.ws + W_WIN) + (size_t)l * NIN * D, true, lds);
    transpose_w(p.in[16] + (size_t)l * D * D, D, D, D, (bf16_t*)(p.ws + W_WOUT) + (size_t)l * D * D, false, lds);
    transpose_w(p.in[19] + (size_t)l * D * NUP, D, NUP, NUP, (bf16_t*)(p.ws + W_WUP) + (size_t)l * NUP * D, false, lds);
    transpose_w(p.in[22] + (size_t)l * DFF * D, DFF, D, D, (bf16_t*)(p.ws + W_WDN) + (size_t)l * D * DFF, false, lds);
  }
  bf16_t* ab = (bf16_t*)(p.ws + W_AB);
  {
    const unsigned total = (unsigned)M * 128u, S = gridDim.x * NTH;
    for (unsigned c0 = blockIdx.x * NTH + (unsigned)tid; c0 < total; c0 += 4u * S) {
      f32x4 a[4], b4[4];
#pragma unroll
      for (int u = 0; u < 4; ++u) {
        const unsigned c = c0 + (unsigned)u * S;
        if (c < total) { const float* src = xrow_ptr(p, 0, (int)(c >> 7)) + (c & 127u) * 8; a[u] = *(const f32x4*)src; b4[u] = *(const f32x4*)(src + 4); }
      }
#pragma unroll
      for (int u = 0; u < 4; ++u) {
        const unsigned c = c0 + (unsigned)u * S;
        if (c < total) {
          u32x4 o; o[0] = pk2(a[u][0], a[u][1]); o[1] = pk2(a[u][2], a[u][3]); o[2] = pk2(b4[u][0], b4[u][1]); o[3] = pk2(b4[u][2], b4[u][3]);
          *(u32x4*)(ab + (size_t)(c >> 7) * D + (c & 127u) * 8) = o;
        }
      }
    }
  }
  float2* rope = (float2*)(p.ws + W_ROPE);
  for (int i = blockIdx.x * NTH + tid; i < 8192 * 32; i += gridDim.x * NTH) {
    const int pos = i >> 5, d = i & 31;
    const double inv = exp2(-(double)d * (13.287712379549449 / 32.0));
    double ang = (double)pos * inv;
    const double twopi = 6.283185307179586476925;
    ang -= twopi * rint(ang / twopi);
    float s, c; sincosf((float)ang, &s, &c);
    rope[i] = make_float2(c, s);
  }
  if (blockIdx.x == 0 && tid < 128) {
    const int l = tid >> 6, ln = tid & 63;
    const float* lp = p.in[13] + (size_t)l * 4 * 64;
    const float s1 = wave_sum(lp[ln] * lp[64 + ln]), s2 = wave_sum(lp[128 + ln] * lp[192 + ln]);
    const float lam_init = (l == 0) ? 0.2f : (0.8f - 0.6f * 0.74081822068171788f);
    if (ln == 0) ((float*)(p.ws + W_MISC))[l] = __expf(s1) - __expf(s2) + lam_init;
  }
  if (blockIdx.x == 0 && tid < 8) ((unsigned*)(p.ws + W_MISC))[16 + tid] = 0u;
  if (blockIdx.x == 0) for (int i = tid; i < 3456; i += NTH) ((unsigned*)(p.ws + W_BAR))[i] = 0u;
}

namespace pg8 {
#define PG8_LAS __attribute__((address_space(3)))
typedef unsigned short bf16_t;
typedef short bf16x8 __attribute__((ext_vector_type(8)));
typedef float f32x4 __attribute__((ext_vector_type(4)));
typedef unsigned u32x4 __attribute__((ext_vector_type(4)));
constexpr int BM = 256, BK = 64, HALF = 128, HTB = HALF * BK * 2  , STAGE_BYTES = 8 * HTB, NXCD = 8, WGM = 8;

__host__ __device__ __forceinline__ int lds_byte(int r, int c) { const int st = (r >> 4) * 2 + (c >> 5), rr = r & 15, cc = c & 31, ob = rr * 64 + cc * 2; return st * 1024 + (ob ^ (((ob >> 9) & 1) << 5)); }
__host__ __device__ __forceinline__ void stage_rc(int b, int& R, int& C) { const int st = b / 1024, sb = b % 1024, swz = sb ^ (((sb >> 9) & 1) << 5); R = (st >> 1) * 16 + swz / 64; C = (st & 1) * 32 + (swz % 64) / 2; }
__host__ __device__ __forceinline__ int perm32(int rho) { const int n = rho >> 4, i = rho & 15; return 8 * (i >> 2) + 4 * n + (i & 3); }

struct Unit { int pm, pn; };
struct Gemm { const bf16_t* A; const bf16_t* Bt; int M, N, K; };

struct StaticOrder {
    int nM, nN, nwg, G, c;
    __host__ __device__ void init(int M, int N, int G_, int c_) { nM = M / BM; nN = N / BM; nwg = nM * nN; G = G_; c = c_; }
    __host__ __device__ bool next(int i, Unit& u) const {
        const long L = (long)i * G + c; if (L >= nwg) return false;
        int wgid = (int)L; { const int q = nwg / NXCD, r = nwg % NXCD, xcd = wgid % NXCD, off = wgid / NXCD; wgid = (xcd < r ? xcd * (q + 1) : r * (q + 1) + (xcd - r) * q) + off; }
        const int nig = WGM * nN, gid = wgid / nig, fm = gid * WGM, gsz = (nM - fm) < WGM ? (nM - fm) : WGM;
        u.pm = fm + ((wgid % nig) % gsz); u.pn = (wgid % nig) / gsz; return true;
    }
    __device__ __forceinline__ void a_ready(const Unit&) const {}
    __device__ __forceinline__ void done(const Unit&) const {}
};
template <class Epi, class Sched, bool STAMP = false>
__device__ __forceinline__ void gemm_phase(PG8_LAS unsigned char* lds, const Gemm g, const Sched& S, const Epi& E, unsigned long long* stamps) {
    const int tid = otid(), wid = __builtin_amdgcn_readfirstlane(tid >> 6), lane = tid & 63, wr = wid >> 2, wc = wid & 3, fr = lane & 15, fq = lane >> 4;
    const int K = g.K, nt = K / BK;
    int ts_lo = 0, ts_hi = 0, nts = 0; const unsigned long long rt_entry = STAMP ? (unsigned long long)wall_clock64() : 0ull;
#define PG8_STAMP() do { if (STAMP && wid == 0 && nts < 64) { const unsigned long long _c = (unsigned long long)clock64(); \
        ts_lo = (lane == nts) ? (int)(unsigned)_c : ts_lo; ts_hi = (lane == nts) ? (int)(unsigned)(_c >> 32) : ts_hi; ++nts; } } while (0)
    PG8_STAMP();
    unsigned voffA[2], voffB[2];
#pragma unroll
    for (int i = 0; i < 2; ++i) { int R, C; stage_rc(tid * 16 + i * 8192, R, C); const int Rb = Epi::PERM ? ((R & ~31) + perm32(R & 31)) : R;
        voffA[i] = (unsigned)(R * K + C) * 2u; voffB[i] = (unsigned)(Rb * K + C) * 2u; }
    const size_t kstep = (size_t)(BK * 2);
    const size_t hstep = (size_t)HALF * K * 2;
    const size_t tstep = 2 * hstep;
    const unsigned ldsw = (unsigned)wid * 1024u;
    const int aoff = lds_byte(wr * 64 + fr, fq * 8), boff = lds_byte(wc * 32 + fr, fq * 8);
#define PG8_SA(b, h) (((b) * 2 + (h)) * HTB)
#define PG8_SB(b, h) ((4 + (b) * 2 + (h)) * HTB)
#define PG8_STAGE(bufoff, gbase, voff) do { _Pragma("unroll") for (int _i = 0; _i < 2; ++_i) \
        __builtin_amdgcn_global_load_lds((const unsigned*)((const char*)(gbase) + (voff)[_i]), (PG8_LAS unsigned*)(lds + (bufoff) + ldsw + _i * 8192), 16, 0, 0); } while (0)
#define PG8_LDA(dst, b, h) do { _Pragma("unroll") for (int m = 0; m < 4; ++m) _Pragma("unroll") for (int k = 0; k < 2; ++k) dst[m][k] = *(const PG8_LAS bf16x8*)(lds + PG8_SA(b, h) + aoff + m * 2048 + k * 1024); } while (0)
#define PG8_LDB(dst, b, h) do { _Pragma("unroll") for (int n = 0; n < 2; ++n) _Pragma("unroll") for (int k = 0; k < 2; ++k) dst[n][k] = *(const PG8_LAS bf16x8*)(lds + PG8_SB(b, h) + boff + n * 2048 + k * 1024); } while (0)
#define PG8_MMA(ai, bj, At, Bt) do { __builtin_amdgcn_s_setprio(1); _Pragma("unroll") for (int m = 0; m < 4; ++m) _Pragma("unroll") for (int n = 0; n < 2; ++n) _Pragma("unroll") for (int k = 0; k < 2; ++k) \
        acc[ai][bj][m][n] = __builtin_amdgcn_mfma_f32_16x16x32_bf16(Bt[n][k], At[m][k], acc[ai][bj][m][n], 0, 0, 0); __builtin_amdgcn_s_setprio(0); } while (0)
#define PG8_WAIT_V(n) asm volatile("s_waitcnt vmcnt(" #n ")" ::: "memory")
#define PG8_WAIT_L(n) asm volatile("s_waitcnt lgkmcnt(" #n ")" ::: "memory")
#define PG8_BAR __builtin_amdgcn_s_barrier()
#define PG8_SCHED __builtin_amdgcn_sched_barrier(0)
    Unit cur, nxt; int ui = 0;
    if (!S.next(0, cur)) return;
    f32x4 acc[2][2][4][2];
#pragma unroll
    for (int a = 0; a < 2; ++a)
#pragma unroll
        for (int b = 0; b < 2; ++b)
#pragma unroll
            for (int m = 0; m < 4; ++m)
#pragma unroll
                for (int n = 0; n < 2; ++n) acc[a][b][m][n] = (f32x4){0.f, 0.f, 0.f, 0.f};
    bf16x8 At[4][2], B0[2][2], B1[2][2];
    const char* cA = (const char*)g.A + (size_t)cur.pm * tstep; const char* cB = (const char*)g.Bt + (size_t)cur.pn * tstep;
    S.a_ready(cur);
    PG8_STAGE(PG8_SB(0, 0), cB, voffB); PG8_STAGE(PG8_SA(0, 0), cA, voffA); PG8_STAGE(PG8_SB(0, 1), cB + hstep, voffB); PG8_STAGE(PG8_SA(0, 1), cA + hstep, voffA);
    if (wr == 1) PG8_BAR;
    PG8_WAIT_V(4); PG8_BAR;
    PG8_STAGE(PG8_SB(1, 0), cB + kstep, voffB); PG8_STAGE(PG8_SA(1, 0), cA + kstep, voffA); PG8_STAGE(PG8_SB(1, 1), cB + hstep + kstep, voffB);
    PG8_WAIT_V(6); PG8_BAR;
    PG8_STAMP();
    for (;;) {
        const bool has_next = S.next(ui + 1, nxt);
        const char* nA = has_next ? (const char*)g.A + (size_t)nxt.pm * tstep : cA; const char* nB = has_next ? (const char*)g.Bt + (size_t)nxt.pn * tstep : cB;
        for (int t = 0; t < nt; t += 2) {
            const bool last = (t == nt - 2);
            const char* a1 = cA + (size_t)(t + 1) * kstep;
            const char* a2 = last ? nA : cA + (size_t)(t + 2) * kstep; const char* b2 = last ? nB : cB + (size_t)(t + 2) * kstep;
            const char* a3 = a2 + kstep; const char* b3 = b2 + kstep;
            if (last && has_next) S.a_ready(nxt);
            PG8_LDB(B0, 0, 0); PG8_SCHED; PG8_LDA(At, 0, 0); PG8_STAGE(PG8_SA(1, 1), a1 + hstep, voffA);
            PG8_WAIT_L(8); PG8_BAR; PG8_WAIT_L(0); PG8_MMA(0, 0, At, B0); PG8_BAR; PG8_SCHED;
            PG8_LDB(B1, 0, 1); PG8_STAGE(PG8_SB(0, 0), b2, voffB);
            PG8_BAR; PG8_WAIT_L(0); PG8_MMA(0, 1, At, B1); PG8_BAR;
            PG8_LDA(At, 0, 1); PG8_STAGE(PG8_SA(0, 0), a2, voffA);
            PG8_BAR; PG8_WAIT_L(0); PG8_MMA(1, 0, At, B0); PG8_BAR; PG8_SCHED;
            PG8_STAGE(PG8_SB(0, 1), b2 + hstep, voffB);
            PG8_WAIT_V(6); PG8_BAR; PG8_MMA(1, 1, At, B1); PG8_BAR;
            PG8_LDB(B0, 1, 0); PG8_SCHED; PG8_LDA(At, 1, 0); PG8_STAGE(PG8_SA(0, 1), a2 + hstep, voffA);
            PG8_WAIT_L(8); PG8_BAR; PG8_WAIT_L(0); PG8_MMA(0, 0, At, B0); PG8_BAR; PG8_SCHED;
            PG8_LDB(B1, 1, 1); PG8_STAGE(PG8_SB(1, 0), b3, voffB);
            PG8_BAR; PG8_WAIT_L(0); PG8_MMA(0, 1, At, B1); PG8_BAR;
            PG8_LDA(At, 1, 1); PG8_STAGE(PG8_SA(1, 0), a3, voffA);
            PG8_BAR; PG8_WAIT_L(0); PG8_MMA(1, 0, At, B0); PG8_BAR; PG8_SCHED;
            PG8_STAGE(PG8_SB(1, 1), b3 + hstep, voffB);
            PG8_WAIT_V(6); PG8_BAR; PG8_MMA(1, 1, At, B1); PG8_BAR;
        }
        PG8_STAMP();
        if constexpr (!Epi::AFTER_DRAIN) { E(acc, cur, wr, wc, fr, fq); S.done(cur); }
        PG8_STAMP();
        if (!has_next) break;
#pragma unroll
        for (int a = 0; a < 2; ++a)
#pragma unroll
            for (int b = 0; b < 2; ++b)
#pragma unroll
                for (int m = 0; m < 4; ++m)
#pragma unroll
                    for (int n = 0; n < 2; ++n) acc[a][b][m][n] = (f32x4){0.f, 0.f, 0.f, 0.f};
        cur = nxt; cA = nA; cB = nB; ++ui;
    }
    PG8_WAIT_V(0);
    if (wr == 0) PG8_BAR;
    PG8_BAR;
    if constexpr (Epi::AFTER_DRAIN) { E.fused(acc, cur, wr, wc, fr, fq, lds, wid, lane); S.done(cur); }
    PG8_STAMP();
    if (STAMP && wid == 0) { stamps[lane] = lane < nts ? (((unsigned long long)(unsigned)ts_hi << 32) | (unsigned)ts_lo) : 0ull;
        if (lane == 62) stamps[62] = rt_entry; if (lane == 63) stamps[63] = (unsigned long long)wall_clock64(); }
#undef PG8_STAMP
#undef PG8_SA
#undef PG8_SB
#undef PG8_STAGE
#undef PG8_LDA
#undef PG8_LDB
#undef PG8_MMA
#undef PG8_WAIT_V
#undef PG8_WAIT_L
#undef PG8_BAR
#undef PG8_SCHED
}
}

enum { EPI_IN = 0, EPI_OUT = 1, EPI_UP = 2, EPI_DOWN = 3 };
template <int MODE>
struct Epi {
  static constexpr bool PERM = true, AFTER_DRAIN = false;
  Params p; int l;
  DI void operator()(const f32x4 (&acc)[2][2][4][2], const pg8::Unit& u, int wr, int wc, int fr, int fq) const {
    const int colb = u.pn * 256 + wc * 32 + 8 * fq;
    if (MODE == EPI_OUT || MODE == EPI_DOWN) {
      float* Rb = (float*)(p.ws + W_R);
#pragma unroll
      for (int ai = 0; ai < 2; ++ai) {
        f32x4 res[4][2][2];
#pragma unroll
        for (int m = 0; m < 4; ++m) {
          const int row = u.pm * 256 + ai * 128 + wr * 64 + m * 16 + fr;
          const float* rs = (MODE == EPI_OUT ? xrow_ptr(p, l, row < M ? row : M - 1) : Rb + (size_t)(row < M ? row : M - 1) * D) + colb;
#pragma unroll
          for (int bj = 0; bj < 2; ++bj) { res[m][bj][0] = *(const f32x4*)(rs + bj * 128); res[m][bj][1] = *(const f32x4*)(rs + bj * 128 + 4); }
        }
#pragma unroll
        for (int m = 0; m < 4; ++m) {
          const int row = u.pm * 256 + ai * 128 + wr * 64 + m * 16 + fr;
          if (row < M) {
            float* R = Rb + (size_t)row * D + colb;
#pragma unroll
            for (int bj = 0; bj < 2; ++bj) {
              *(f32x4*)(R + bj * 128) = res[m][bj][0] * ALPHA + acc[ai][bj][m][0];
              *(f32x4*)(R + bj * 128 + 4) = res[m][bj][1] * ALPHA + acc[ai][bj][m][1];
            }
          }
        }
      }
      return;
    }
    f32x4 rc0[8], rc1[8];
    if (MODE == EPI_IN && (u.pn >> 2) <= 1) {
      const int d0 = (colb & 63) >> 1;
#pragma unroll
      for (int i = 0; i < 8; ++i) {
        int row = u.pm * 256 + (i >> 2) * 128 + wr * 64 + (i & 3) * 16 + fr; row = row < M ? row : M - 1;
        const int pos = row < MP ? (row & (SEQ - 1)) : PAST + ((row - MP) & 15);
        const f32x4* rp = (const f32x4*)((const float2*)(p.ws + W_ROPE) + pos * 32 + d0);
        rc0[i] = rp[0]; rc1[i] = rp[1];
      }
    }
#pragma unroll
    for (int ai = 0; ai < 2; ++ai)
#pragma unroll
      for (int m = 0; m < 4; ++m) {
        const int row = u.pm * 256 + ai * 128 + wr * 64 + m * 16 + fr;
        if (row < M) {
#pragma unroll
          for (int bj = 0; bj < 2; ++bj) {
            const int col = colb + bj * 128;
            const f32x4 v0 = acc[ai][bj][m][0], v1 = acc[ai][bj][m][1];
            if (MODE == EPI_IN) {
              bf16_t* Z = (bf16_t*)(p.ws + W_Z);
              const int seg = u.pn >> 2;
              if (seg <= 1) {
                const int d0 = (col & 63) >> 1;
                const f32x4 c01 = rc0[ai * 4 + m], c23 = rc1[ai * 4 + m];
                const float a0 = v0[0] * c01[0] - v0[1] * c01[1], b0 = v0[1] * c01[0] + v0[0] * c01[1];
                const float a1 = v0[2] * c01[2] - v0[3] * c01[3], b1 = v0[3] * c01[2] + v0[2] * c01[3];
                const float a2 = v1[0] * c23[0] - v1[1] * c23[1], b2 = v1[1] * c23[0] + v1[0] * c23[1];
                const float a3 = v1[2] * c23[2] - v1[3] * c23[3], b3 = v1[3] * c23[2] + v1[2] * c23[3];
                const float qs = seg == 0 ? 0.125f : 1.f;
                u32x4 o; o[0] = pk2(a0 * qs, b0 * qs); o[1] = pk2(a1 * qs, b1 * qs); o[2] = pk2(a2 * qs, b2 * qs); o[3] = pk2(a3 * qs, b3 * qs);
                *(u32x4*)(Z + (size_t)row * NIN + col) = o;
                if (seg == 1) {
                  float* ob = (row < MP ? p.out + O_KP + ((size_t)l * MP + row) * 1024 : p.out + O_KS + ((size_t)l * MS + row - MP) * 1024) + ((col - 1024) & ~63) + d0;
                  f32x4 o1, o2; o1[0] = a0; o1[1] = a1; o1[2] = a2; o1[3] = a3; o2[0] = b0; o2[1] = b1; o2[2] = b2; o2[3] = b3;
                  *(f32x4*)ob = o1; *(f32x4*)(ob + 32) = o2;
                }
              } else {
                u32x4 o; o[0] = pk2(v0[0], v0[1]); o[1] = pk2(v0[2], v0[3]); o[2] = pk2(v1[0], v1[1]); o[3] = pk2(v1[2], v1[3]);
                *(u32x4*)(Z + (size_t)row * NIN + col) = o;
                if (seg == 2) {
                  float* ob = (row < MP ? p.out + O_VP + ((size_t)l * MP + row) * 1024 : p.out + O_VS + ((size_t)l * MS + row - MP) * 1024) + (col - 2048);
                  *(f32x4*)ob = v0; *(f32x4*)(ob + 4) = v1;
                } else if (seg == 3 || seg == 4) {
                  float* ob = nullptr;
                  if (row < MP) { const int s = row & (SEQ - 1); if (s >= SEQ - 3) ob = p.out + O_MCP + ((size_t)(l * 4 + (row >> 13)) * 3 + (s - (SEQ - 3))) * 2048 + col - 3072; }
                  else { const int t = (row - MP) & 15, b = (row - MP) >> 4; if (t >= 13) ob = p.out + O_MCS + ((size_t)(l * 8 + b) * 3 + (t - 13)) * 2048 + col - 3072; }
                  if (ob) { *(f32x4*)ob = v0; *(f32x4*)(ob + 4) = v1; }
                }
              }
            } else if (MODE == EPI_OUT || MODE == EPI_DOWN) {
              float* R = (float*)(p.ws + W_R) + (size_t)row * D + col;
              const float* rs = MODE == EPI_OUT ? xrow_ptr(p, l, row) + col : R;
              const f32x4 r0 = *(const f32x4*)rs, r1 = *(const f32x4*)(rs + 4);
              *(f32x4*)R = r0 * ALPHA + v0; *(f32x4*)(R + 4) = r1 * ALPHA + v1;
            } else {
              bf16_t* U = (bf16_t*)(p.ws + W_Z);
              u32x4 o; o[0] = pk2(v0[0], v0[1]); o[1] = pk2(v0[2], v0[3]); o[2] = pk2(v1[0], v1[1]); o[3] = pk2(v1[2], v1[3]);
              *(u32x4*)(U + (size_t)row * NUP + col) = o;
              float* ob = nullptr;
              if (row < MP) { const int s = row & (SEQ - 1); if (s >= SEQ - 2) ob = p.out + O_FCP + ((size_t)(l * 4 + (row >> 13)) * 2 + (s - (SEQ - 2))) * NUP + col; }
              else { const int t = (row - MP) & 15, b = (row - MP) >> 4; if (t >= 14) ob = p.out + O_FCS + ((size_t)(l * 8 + b) * 2 + (t - 14)) * NUP + col; }
              if (ob) { *(f32x4*)ob = v0; *(f32x4*)(ob + 4) = v1; }
            }
          }
        }
      }
  }
};

template <int MODE>
DI void gemm_phase(const Params& p, int l, const bf16_t* A, int lda, const bf16_t* Bt, int K, int ntn, char* lds) {
  (void)lda;
  pg8::Gemm g; g.A = A; g.Bt = Bt; g.M = ((MODE == EPI_OUT || MODE == EPI_DOWN) ? NTM - 1 : NTM) * 256; g.N = ntn * 256; g.K = K;
  if (MODE == EPI_OUT || MODE == EPI_DOWN) sample_gemm<MODE>(p, l, A, Bt, K);
  pg8::StaticOrder S; S.init(g.M, g.N, (int)gridDim.x, (int)blockIdx.x);
  Epi<MODE> E; E.p = p; E.l = l;
  pg8::gemm_phase<Epi<MODE>, pg8::StaticOrder, false>((PG8_LAS unsigned char*)lds, g, S, E, nullptr);
  __syncthreads();
}

typedef float f32x4v __attribute__((ext_vector_type(4)));
template <int MODE>
DI void sample_gemm(const Params& p, int l, const bf16_t* A, const bf16_t* Bt, int K) {
  if (blockIdx.x >= 64) return;
  const int tid = otid(), lane = tid & 63, wave = uni(tid >> 6), fr = lane & 15, fq = lane >> 4;
  const bf16_t* ap = A + (size_t)(MP + wave * 16 + fr) * K + fq * 8;
  const bf16_t* bp = Bt + (size_t)(blockIdx.x * 16 + fr) * K + fq * 8;
  f32x4v acc0 = {0.f, 0.f, 0.f, 0.f}, acc1 = {0.f, 0.f, 0.f, 0.f};
  for (int k0 = 0; k0 < K; k0 += 256) {
    bf16x8 a[8], bb[8];
#pragma unroll
    for (int i = 0; i < 8; ++i) { a[i] = *(const bf16x8*)(ap + k0 + i * 32); bb[i] = *(const bf16x8*)(bp + k0 + i * 32); }
#pragma unroll
    for (int i = 0; i < 8; i += 2) {
      acc0 = __builtin_amdgcn_mfma_f32_16x16x32_bf16(a[i], bb[i], acc0, 0, 0, 0);
      acc1 = __builtin_amdgcn_mfma_f32_16x16x32_bf16(a[i + 1], bb[i + 1], acc1, 0, 0, 0);
    }
  }
  const int col = blockIdx.x * 16 + fr;
  float* R = (float*)(p.ws + W_R);
#pragma unroll
  for (int j = 0; j < 4; ++j) {
    const int row = MP + wave * 16 + fq * 4 + j;
    const float res = MODE == EPI_OUT ? xrow_ptr(p, l, row)[col] : R[(size_t)row * D + col];
    R[(size_t)row * D + col] = ALPHA * res + (acc0[j] + acc1[j]);
  }
}

DI void gif_phase(const Params& p, int l, char* lds, int first_blk) {
  if ((int)blockIdx.x < first_blk) return;
  const int tidq = otid(); const int lane = tidq & 63, gw = ((int)blockIdx.x - first_blk) * 8 + (tidq >> 6), ngw = ((int)gridDim.x - first_blk) * 8;
  const float* w = p.in[9] + (size_t)l * D * DIN + 7168;
  const float* bif = p.in[10] + l * 8;
  float* gif = (float*)(p.ws + W_GIF);
  float* w8 = (float*)lds;
  __syncthreads();
#pragma unroll
  for (int i = 0; i < 2; ++i) {
    const int k = tidq + 512 * i;
    *(f32x4*)(w8 + k * 8) = *(const f32x4*)(w + (size_t)k * DIN); *(f32x4*)(w8 + k * 8 + 4) = *(const f32x4*)(w + (size_t)k * DIN + 4);
  }
  __syncthreads();
  for (int rg = gw; rg < M / 4; rg += ngw) {
    float acc[4][8];
#pragma unroll
    for (int a = 0; a < 4; ++a)
#pragma unroll
      for (int j = 0; j < 8; ++j) acc[a][j] = 0.f;
    const float* x0 = xrow_ptr(p, l, rg * 4);
#pragma unroll 4
    for (int kk = 0; kk < 16; ++kk) {
      const int k = kk * 64 + lane;
      const f32x4 w0 = *(const f32x4*)(w8 + k * 8), w1 = *(const f32x4*)(w8 + k * 8 + 4);
#pragma unroll
      for (int a = 0; a < 4; ++a) {
        const float xv = x0[(size_t)a * D + k];
        acc[a][0] += xv * w0[0]; acc[a][1] += xv * w0[1]; acc[a][2] += xv * w0[2]; acc[a][3] += xv * w0[3];
        acc[a][4] += xv * w1[0]; acc[a][5] += xv * w1[1]; acc[a][6] += xv * w1[2]; acc[a][7] += xv * w1[3];
      }
    }
#pragma unroll
    for (int a = 0; a < 4; ++a)
#pragma unroll
      for (int j = 0; j < 8; ++j) {
        const float s = wave_sum(acc[a][j]);
        if (lane == 0) gif[(size_t)(rg * 4 + a) * 8 + j] = s + bif[j];
      }
  }
  __syncthreads();
}

DI void qkconv_phase(const Params& p, int l) {
  const bf16_t* Z = (const bf16_t*)(p.ws + W_Z);
  bf16_t* QA = (bf16_t*)(p.ws + W_AB); bf16_t* KA = (bf16_t*)(p.ws + W_KA);
  const float* cw = p.in[11] + (size_t)l * 4 * 2048; const float* cb = p.in[12] + (size_t)l * 2048;
  constexpr int RG = 8;
  const size_t total = (size_t)(M / RG) * 256;
  for (size_t it = (size_t)blockIdx.x * NTH + otid(); it < total; it += (size_t)gridDim.x * NTH) {
    const int cc = (int)(it & 255), rg = (int)(it >> 8), col = cc * 8, row0 = rg * RG;
    int t0, hist_rows;
    const float* st = nullptr;
    if (row0 < MP) { t0 = row0 & (SEQ - 1); }
    else { t0 = (row0 - MP) & 15; st = p.in[4] + ((size_t)(l * 8 + ((row0 - MP) >> 4)) * 3) * 2048 + col; }
    (void)hist_rows;
    float w[4][8], bias[8];
#pragma unroll
    for (int j = 0; j < 4; ++j) { f32x4 a = *(const f32x4*)(cw + j * 2048 + col), b = *(const f32x4*)(cw + j * 2048 + col + 4);
      w[j][0] = a[0]; w[j][1] = a[1]; w[j][2] = a[2]; w[j][3] = a[3]; w[j][4] = b[0]; w[j][5] = b[1]; w[j][6] = b[2]; w[j][7] = b[3]; }
    { f32x4 a = *(const f32x4*)(cb + col), b = *(const f32x4*)(cb + col + 4);
      bias[0] = a[0]; bias[1] = a[1]; bias[2] = a[2]; bias[3] = a[3]; bias[4] = b[0]; bias[5] = b[1]; bias[6] = b[2]; bias[7] = b[3]; }
    float x[RG + 3][8];
#pragma unroll
    for (int j = 0; j < RG + 3; ++j) {
      const int t = t0 - 3 + j;
      if (t >= 0) { u32x4 v = *(const u32x4*)(Z + (size_t)(row0 - 3 + j) * NIN + 3072 + col); unpack8(v, x[j]); }
      else if (st) { f32x4 a = *(const f32x4*)(st + (size_t)(3 + t) * 2048), b = *(const f32x4*)(st + (size_t)(3 + t) * 2048 + 4);
        x[j][0] = a[0]; x[j][1] = a[1]; x[j][2] = a[2]; x[j][3] = a[3]; x[j][4] = b[0]; x[j][5] = b[1]; x[j][6] = b[2]; x[j][7] = b[3]; }
      else {
#pragma unroll
        for (int e = 0; e < 8; ++e) x[j][e] = 0.f; }
    }
    const float sc = col >= 1024 ? 0.0625f : 1.f;
    bf16_t* dst = col >= 1024 ? KA + (col - 1024) : QA + col;
#pragma unroll
    for (int a = 0; a < RG; ++a) {
      float o[8];
#pragma unroll
      for (int e = 0; e < 8; ++e) {
        float u = bias[e] + w[0][e] * x[a][e] + w[1][e] * x[a + 1][e] + w[2][e] * x[a + 2][e] + w[3][e] * x[a + 3][e];
        o[e] = u * sigmoidf_(u) * sc;
      }
      u32x4 ov; ov[0] = pk2(o[0], o[1]); ov[1] = pk2(o[2], o[3]); ov[2] = pk2(o[4], o[5]); ov[3] = pk2(o[6], o[7]);
      *(u32x4*)(dst + (size_t)(row0 + a) * D) = ov;
    }
  }
}

constexpr int A_LD = 272;
constexpr int A_TILE = 64 * A_LD;
constexpr int A_VLD = 320;
constexpr int A_VTILE = 64 * A_VLD;
template <int KIND>
DI void attn_item(const Params& p, int l, int b, int ha, int qb, char* lds) {
  const int tid = otid(), lane = tid & 63, wave = uni(tid >> 6);
  const int map = wave >> 2, qt = wave & 3, r = lane & 31, h = lane >> 5;
  const bf16_t* Z = (const bf16_t*)(p.ws + W_Z);
  const int NT = KIND == 0 ? 2 * (qb + 1) : (NKS + 63) / 64;
  const int ntw = KIND == 0 ? 2 * qb + (qt >> 1) + 1 : NT;
  const bool active = KIND == 0 ? true : (qt == 0);
  int qrow;
  if (KIND == 0) qrow = b * SEQ + qb * 128 + qt * 32 + r; else qrow = MP + b * 16 + (r < 16 ? r : 15);
  bf16x8 qf[4];
#pragma unroll
  for (int ks = 0; ks < 4; ++ks) {
    if (KIND == 0) qf[ks] = *(const bf16x8*)(Z + (size_t)qrow * NIN + ha * 128 + map * 64 + ks * 16 + h * 8);
    else {
      const int dn = ks * 16 + h * 8, par = dn >> 5, dd = dn & 31;
      const bf16_t* src = Z + (size_t)qrow * NIN + ha * 128 + map * 64 + 2 * dd;
      const u32x4 lo = *(const u32x4*)src, hi = *(const u32x4*)(src + 8);
      unsigned e[8];
#pragma unroll
      for (int i = 0; i < 4; ++i) { e[i] = par ? (lo[i] >> 16) : (lo[i] & 0xffffu); e[4 + i] = par ? (hi[i] >> 16) : (hi[i] & 0xffffu); }
      u32x4 o; o[0] = e[0] | (e[1] << 16); o[1] = e[2] | (e[3] << 16); o[2] = e[4] | (e[5] << 16); o[3] = e[6] | (e[7] << 16);
      qf[ks] = __builtin_bit_cast(bf16x8, o);
    }
  }
  const int skey = tid >> 4, part = tid & 15;
  u32x4 rk0, rk1, rv0, rv1;
  auto gload = [&](int j) {
    if (KIND == 0) {
      const bf16_t* base = Z + (size_t)(b * SEQ + j * 64 + skey) * NIN + 1024 + ha * 128 + part * 8;
      rk0 = *(const u32x4*)base; rk1 = *(const u32x4*)(base + (size_t)32 * NIN);
      rv0 = *(const u32x4*)(base + 1024); rv1 = *(const u32x4*)(base + (size_t)32 * NIN + 1024);
    } else {
#pragma unroll
      for (int i = 0; i < 2; ++i) {
        int kk = j * 64 + skey + 32 * i; if (kk > NKS - 1) kk = NKS - 1;
        const float *ks_, *vs_;
        if (kk < PAST) { const size_t o = (((size_t)(l * 8 + b) * PAST + kk) * 8 + ha) * 128 + part * 8; ks_ = p.in[2] + o; vs_ = p.in[3] + o; }
        else { const size_t o = (((size_t)l * MS + b * 16 + (kk - PAST)) * 8 + ha) * 128 + part * 8; ks_ = p.out + O_KS + o; vs_ = p.out + O_VS + o; }
        const f32x4 a0 = *(const f32x4*)ks_, a1 = *(const f32x4*)(ks_ + 4), c0 = *(const f32x4*)vs_, c1 = *(const f32x4*)(vs_ + 4);
        u32x4 ko, vo;
        ko[0] = pk2(a0[0], a0[1]); ko[1] = pk2(a0[2], a0[3]); ko[2] = pk2(a1[0], a1[1]); ko[3] = pk2(a1[2], a1[3]);
        vo[0] = pk2(c0[0], c0[1]); vo[1] = pk2(c0[2], c0[3]); vo[2] = pk2(c1[0], c1[1]); vo[3] = pk2(c1[2], c1[3]);
        if (i == 0) { rk0 = ko; rv0 = vo; } else { rk1 = ko; rv1 = vo; }
      }
    }
  };
  f32x16 O[4];
#pragma unroll
  for (int v = 0; v < 4; ++v)
#pragma unroll
    for (int i = 0; i < 16; ++i) O[v][i] = 0.f;
  float m_run = -1e30f, l_run = 0.f;
  const int q4 = (lane & 15) >> 2, p4 = lane & 3, blk = (lane >> 4) & 1;
  const unsigned sofs = skey * A_LD + part * 16, vofs = skey * A_VLD + part * 16;
  auto qk = [&](int j, f32x16 (&st)[2]) {
    const char* kb = lds + (j & 1) * A_TILE;
#pragma unroll
    for (int kt = 0; kt < 2; ++kt) {
#pragma unroll
      for (int i = 0; i < 16; ++i) st[kt][i] = 0.f;
#pragma unroll
      for (int ks = 0; ks < 4; ++ks) {
        const bf16x8 kf = *(const bf16x8*)(kb + (kt * 32 + r) * A_LD + (map * 64 + ks * 16 + h * 8) * 2);
        st[kt] = MFMA32(kf, qf[ks], st[kt]);
      }
    }
    if (KIND == 1 && j == NT - 1) {
#pragma unroll
      for (int kt = 0; kt < 2; ++kt)
#pragma unroll
        for (int i = 0; i < 16; ++i) if (j * 64 + kt * 32 + crow(i, h) >= NKS) st[kt][i] = -1e30f;
    }
  };
  bf16x8 pk[4];
  auto smax = [&](int j, f32x16 (&sc)[2], f32x16 (&sn)[2]) {
    if (j + 1 < ntw) qk(j + 1, sn);
    float mx = sc[0][0];
#pragma unroll
    for (int kt = 0; kt < 2; ++kt)
#pragma unroll
      for (int i = 0; i < 16; ++i) mx = fmaxf(mx, sc[kt][i]);
    mx = fmaxf(mx, __shfl_xor(mx, 32));
    const float m_new = fmaxf(m_run, mx);
    const float alpha = __builtin_amdgcn_exp2f((m_run - m_new) * LOG2E);
    const float mb = m_new * LOG2E;
    float rs = 0.f;
#pragma unroll
    for (int kt = 0; kt < 2; ++kt)
#pragma unroll
      for (int i = 0; i < 16; ++i) { const float e = __builtin_amdgcn_exp2f(sc[kt][i] * LOG2E - mb); sc[kt][i] = e; rs += e; }
    rs += __shfl_xor(rs, 32);
    l_run = l_run * alpha + rs; m_run = m_new;
    if (__builtin_amdgcn_ballot_w64(alpha != 1.f) != 0ull) {
#pragma unroll
      for (int v = 0; v < 4; ++v)
#pragma unroll
        for (int i = 0; i < 16; ++i) O[v][i] *= alpha;
    }
    pk[0] = pack8(sc[0], 0); pk[1] = pack8(sc[0], 1); pk[2] = pack8(sc[1], 0); pk[3] = pack8(sc[1], 1);
  };
  auto pv = [&](int j) {
    const unsigned vaddr = lds_addr(lds + 2 * A_TILE + (j % 3) * A_VTILE) + (4 * h + q4) * A_VLD + (16 * blk + 4 * p4) * 2;
#pragma unroll
    for (int vt = 0; vt < 4; ++vt) {
      bf16x8 vf[4];
      tr_frag4<16 * A_VLD, 8 * A_VLD>(vaddr + vt * 64, vf);
#pragma unroll
      for (int ks = 0; ks < 4; ++ks) O[vt] = MFMA32(vf[ks], pk[ks], O[vt]);
    }
  };
  gload(0);
  { char* kb = lds + sofs; *(u32x4*)kb = rk0; *(u32x4*)(kb + 32 * A_LD) = rk1; char* vb = lds + 2 * A_TILE + vofs; *(u32x4*)vb = rv0; *(u32x4*)(vb + 32 * A_VLD) = rv1; }
  gload(1);
  { char* kb = lds + A_TILE + sofs; *(u32x4*)kb = rk0; *(u32x4*)(kb + 32 * A_LD) = rk1; }
  __syncthreads();
  f32x16 sA[2], sB[2];
  if (active && 0 < ntw) qk(0, sA);
  for (int j = 0; j < NT; j += 2) {
#pragma unroll
    for (int u = 0; u < 2; ++u) {
      const int jj = j + u;
      if (jj < NT) {
        if (jj + 1 < NT) { char* vb = lds + 2 * A_TILE + ((jj + 1) % 3) * A_VTILE + vofs; *(u32x4*)vb = rv0; *(u32x4*)(vb + 32 * A_VLD) = rv1; }
        if (jj + 2 < NT) gload(jj + 2);
        if (active) {
          if (map == 1 && jj >= 1 && jj - 1 < ntw) pv(jj - 1);
          if (jj < ntw) { if (u == 0) smax(jj, sA, sB); else smax(jj, sB, sA); }
          if (map == 0 && jj < ntw) pv(jj);
        }
        if (jj + 2 < NT) { char* kb = lds + (jj & 1) * A_TILE + sofs; *(u32x4*)kb = rk0; *(u32x4*)(kb + 32 * A_LD) = rk1; }
        __syncthreads();
      }
    }
  }
  if (active && map == 1 && ntw == NT) pv(NT - 1);
  __syncthreads();
  float* ex = (float*)lds;
  const float inv_l = 1.f / l_run;
  if (map == 1) {
#pragma unroll
    for (int vt = 0; vt < 4; ++vt)
#pragma unroll
      for (int g = 0; g < 4; ++g) {
        f32x4 o; o[0] = O[vt][4 * g] * inv_l; o[1] = O[vt][4 * g + 1] * inv_l; o[2] = O[vt][4 * g + 2] * inv_l; o[3] = O[vt][4 * g + 3] * inv_l;
        *(f32x4*)(ex + (qt * 32 + r) * 132 + vt * 32 + 8 * g + 4 * h) = o;
      }
  }
  __syncthreads();
  if (map == 0) {
    const float lam = ((const float*)(p.ws + W_MISC))[l];
    const float lam_init = (l == 0) ? 0.2f : (0.8f - 0.6f * 0.74081822068171788f);
    float ssq = 0.f;
#pragma unroll
    for (int vt = 0; vt < 4; ++vt)
#pragma unroll
      for (int g = 0; g < 4; ++g) {
        const f32x4 o2 = *(const f32x4*)(ex + (qt * 32 + r) * 132 + vt * 32 + 8 * g + 4 * h);
#pragma unroll
        for (int e = 0; e < 4; ++e) { const float o = O[vt][4 * g + e] * inv_l - lam * o2[e]; O[vt][4 * g + e] = o; ssq += o * o; }
      }
    ssq += __shfl_xor(ssq, 32);
    const float rms = rsqrtf(ssq * (1.f / 128.f) + LN_EPS) * (1.f - lam_init);
    const float* sg = p.in[14] + l * 128;
    const bool valid = KIND == 0 ? true : (qt == 0 && r < 16);
    if (valid) {
      bf16_t* dst = (bf16_t*)(p.ws + W_Z) + (size_t)qrow * NIN + 3072 + ha * 128;
#pragma unroll
      for (int vt = 0; vt < 4; ++vt)
#pragma unroll
        for (int g = 0; g < 4; ++g) {
          const int v0 = vt * 32 + 8 * g + 4 * h;
          const f32x4 gg = *(const f32x4*)(sg + v0);
          u32x2 o; o[0] = pk2(O[vt][4 * g] * rms * gg[0], O[vt][4 * g + 1] * rms * gg[1]); o[1] = pk2(O[vt][4 * g + 2] * rms * gg[2], O[vt][4 * g + 3] * rms * gg[3]);
          *(u32x2*)(dst + v0) = o;
        }
    }
  }
  __syncthreads();
}

constexpr int L_LD = 528;
constexpr int L_VLD = 320;
constexpr int L_Q = 0, L_K = 64 * L_LD, L_V = 2 * 64 * L_LD, L_SW = L_V + 64 * L_VLD;
constexpr int L_SWLD = 144;
constexpr int L_SC = L_SW + 64 * L_SWLD;
constexpr int S_MX = 0, S_G = 64, S_EMT = 128, S_DS0 = 192, S_DS1 = 256, S_QN = 320  , S_NV = 576  , S_GEND = 832, S_PAR = 840;
constexpr int LDS_BYTES = 153376;
static_assert(L_SC + 2 * S_PAR * 4 <= 131072, "lds");
#define WG_BAR() do { __builtin_amdgcn_fence(__ATOMIC_RELEASE, "workgroup"); __builtin_amdgcn_s_barrier(); __builtin_amdgcn_fence(__ATOMIC_ACQUIRE, "workgroup"); } while (0)

template <int KIND>
DI void mlstm_item(const Params& p, int l, int b, int hm, int half, char* lds) {
  const int tid0 = otid(), wave = uni(tid0 >> 6);
  const bf16_t* QA = (const bf16_t*)(p.ws + W_AB); const bf16_t* KA = (const bf16_t*)(p.ws + W_KA);
  const bf16_t* Z = (const bf16_t*)(p.ws + W_Z); bf16_t* H = (bf16_t*)(p.ws + W_H);
  const float* GIF = (const float*)(p.ws + W_GIF);
  float* scb = (float*)(lds + L_SC);
  int nchunks = KIND == 0 ? SEQ / 64 : 1; asm volatile("" : "+s"(nchunks));
  const int Lv = KIND == 0 ? 64 : 16;
  const size_t bh = KIND == 0 ? (size_t)(l * 4 + b) * 4 + hm : (size_t)(l * 8 + b) * 4 + hm;
  if (wave < 4) {
    f32x16 C[8];
    { const int lane = tid0 & 63, r = lane & 31, h = lane >> 5; (void)r; (void)h;
      if (KIND == 0) {
#pragma unroll
        for (int d = 0; d < 8; ++d)
#pragma unroll
          for (int i = 0; i < 16; ++i) C[d][i] = 0.f;
      } else {
        const float* cp = p.in[5] + bh * 65536 + (size_t)(4 * h) * 256 + half * 128 + wave * 32 + r;
#pragma unroll
        for (int d = 0; d < 8; ++d)
#pragma unroll
          for (int g = 0; g < 4; ++g) {
            C[d][4 * g] = cp[0]; C[d][4 * g + 1] = cp[256]; C[d][4 * g + 2] = cp[512]; C[d][4 * g + 3] = cp[768];
            cp += 2048; asm volatile("" : "+v"(cp));
          }
      }
    }
    for (int c = 0; c < nchunks; ++c) {
      int tid = tid0; asm volatile("" : "+v"(tid));
      const int lane = tid & 63, r = lane & 31, h = lane >> 5;
      const int q4 = (lane & 15) >> 2, p4 = lane & 3, blk = (lane >> 4) & 1;
      const float* sc = scb + (c & 1) * S_PAR;
      const int rowbase = KIND == 0 ? b * SEQ + c * 64 : MP + b * 16;
      WG_BAR();
      f32x16 accB[2];
#pragma unroll
      for (int tt = 0; tt < 2; ++tt)
#pragma unroll
        for (int i = 0; i < 16; ++i) accB[tt][i] = 0.f;
#pragma unroll
      for (int d = 0; d < 8; ++d)
#pragma unroll
        for (int s = 0; s < 2; ++s) {
          __builtin_amdgcn_sched_barrier(0);
          const bf16x8 cf = pack8(C[d], s);
#pragma unroll
          for (int tt = 0; tt < 2; ++tt) {
            const char* qp = lds + L_Q + (tt * 32 + r) * L_LD + (d * 32 + 16 * s + 4 * h) * 2;
            const s16x4 lo = *(const s16x4*)qp, hi = *(const s16x4*)(qp + 16);
            const bf16x8 qfr = __builtin_shufflevector(lo, hi, 0, 1, 2, 3, 4, 5, 6, 7);
            accB[tt] = MFMA32(cf, qfr, accB[tt]);
          }
        }
      __builtin_amdgcn_sched_barrier(0);
      bf16x8 vf[4];
      tr_frag4<16 * L_VLD, 4 * L_VLD>(lds_addr(lds + L_V) + (8 * h + q4) * L_VLD + (wave * 32 + 16 * blk + 4 * p4) * 2, vf);
      const float g_end = sc[S_GEND];
#pragma unroll
      for (int d = 0; d < 8; ++d) {
#pragma unroll
        for (int i = 0; i < 16; ++i) C[d][i] *= g_end;
        bf16x8 kf[4];
        tr_frag4<16 * L_LD, 4 * L_LD>(lds_addr(lds + L_K) + (8 * h + q4) * L_LD + (d * 32 + 16 * blk + 4 * p4) * 2, kf);
#pragma unroll
        for (int ks = 0; ks < 4; ++ks) C[d] = MFMA32(kf[ks], vf[ks], C[d]);
      }
      WG_BAR();
#pragma unroll
      for (int tt = 0; tt < 2; ++tt) {
        const int t = tt * 32 + r;
        const float g = sc[S_G + t];
#pragma unroll
        for (int i = 0; i < 16; ++i) accB[tt][i] *= g;
        const char* sp = lds + L_SW + (tt * 32 + r) * L_SWLD + h * 16;
#pragma unroll
        for (int ks = 0; ks < 4; ++ks) accB[tt] = MFMA32(vf[ks], *(const bf16x8*)(sp + ks * 32), accB[tt]);
        const float qn = (sc[S_QN + t] + sc[S_QN + 64 + t]) + (sc[S_QN + 128 + t] + sc[S_QN + 192 + t]);
        float den = sc[S_DS0 + t] + sc[S_DS1 + t] + g * qn;
        den = fmaxf(fabsf(den), sc[S_EMT + t]);
        const float rden = 1.f / den;
        if (t < Lv) {
          bf16_t* dst = H + (size_t)(rowbase + t) * D + hm * 256 + half * 128 + wave * 32;
#pragma unroll
          for (int g4 = 0; g4 < 4; ++g4) {
            u32x2 o; o[0] = pk2(accB[tt][4 * g4] * rden, accB[tt][4 * g4 + 1] * rden); o[1] = pk2(accB[tt][4 * g4 + 2] * rden, accB[tt][4 * g4 + 3] * rden);
            *(u32x2*)(dst + 8 * g4 + 4 * h) = o;
          }
        }
      }
    }
    WG_BAR();
    {
      const int lane = tid0 & 63, r = lane & 31, h = lane >> 5;
      float* co = p.out + (KIND == 0 ? O_CP : O_CS) + bh * 65536 + (size_t)(4 * h) * 256 + half * 128 + wave * 32 + r;
#pragma unroll
      for (int d = 0; d < 8; ++d)
#pragma unroll
        for (int g = 0; g < 4; ++g) {
          co[0] = C[d][4 * g]; co[256] = C[d][4 * g + 1]; co[512] = C[d][4 * g + 2]; co[768] = C[d][4 * g + 3];
          co += 2048; asm volatile("" : "+v"(co));
        }
    }
  } else {
    const int hw = wave - 4;
    float nreg = 0.f, m_prev = 0.f;
    if (KIND == 1) { nreg = p.in[6][bh * 256 + (tid0 - 256)]; m_prev = p.in[7][bh]; }
    u32x4 pq[8], pk[8], pv[4];
    float gi = 0.f, gf = 0.f, g_end_cur = 0.f;
    auto issue_loads = [&](int c, int tid) {
      const int ht = tid - 256, lane = tid & 63;
      const int rowbase = KIND == 0 ? b * SEQ + c * 64 : MP + b * 16;
      const bool tvalid = lane < Lv;
      gi = tvalid ? GIF[(size_t)(rowbase + lane) * 8 + hm] : -1e30f;
      gf = tvalid ? GIF[(size_t)(rowbase + lane) * 8 + 4 + hm] : 0.f;
#pragma unroll
      for (int i = 0; i < 8; ++i) {
        const int cidx = ht + 256 * i, t = cidx >> 5, pc = cidx & 31;
        const int row = rowbase + (t < Lv ? t : Lv - 1);
        pq[i] = *(const u32x4*)(QA + (size_t)row * D + hm * 256 + pc * 8);
        pk[i] = *(const u32x4*)(KA + (size_t)row * D + hm * 256 + pc * 8);
      }
#pragma unroll
      for (int i = 0; i < 4; ++i) {
        const int cidx = ht + 256 * i, t = cidx >> 4, pc = cidx & 15;
        const int row = rowbase + (t < Lv ? t : Lv - 1);
        pv[i] = *(const u32x4*)(Z + (size_t)row * NIN + 5120 + hm * 256 + half * 128 + pc * 8);
      }
    };
    auto scalars = [&](int par, int lane) -> float {
      const bool tvalid = lane < Lv;
      const float lf = tvalid ? (fminf(gf, 0.f) - __logf(1.f + __expf(-fabsf(gf)))) : 0.f;
      float bc = lf;
#pragma unroll
      for (int o = 1; o < 64; o <<= 1) { const float v = __shfl_up(bc, o); if (lane >= o) bc += v; }
      const float a = gi - bc;
      float cm = a;
#pragma unroll
      for (int o = 1; o < 64; o <<= 1) { const float v = __shfl_up(cm, o); if (lane >= o) cm = fmaxf(cm, v); }
      const float mxv = fmaxf(m_prev, cm);
      const float m_t = bc + mxv;
      const float mx_end = __shfl(mxv, 63), bc_end = __shfl(bc, 63);
      const float wend = __expf(a - mx_end);
      g_end_cur = __expf(m_prev - mx_end);
      if (hw == 0) {
        float* sc = scb + par * S_PAR;
        sc[S_MX + lane] = __expf(mx_end - mxv);
        sc[S_G + lane] = __expf(m_prev - mxv);
        sc[S_EMT + lane] = __expf(-m_t);
        if (lane == 0) sc[S_GEND] = g_end_cur;
      }
      m_prev = bc_end + mx_end;
      return wend;
    };
    auto stage_lds = [&](float wend_l, int tid) {
      const int ht = tid - 256;
#pragma unroll
      for (int i = 0; i < 8; ++i) {
        const int cidx = ht + 256 * i, t = cidx >> 5, pc = cidx & 31;
        const float we = __shfl(wend_l, t);
        float f[8]; unpack8(pk[i], f);
        u32x4 o; o[0] = pk2(f[0] * we, f[1] * we); o[1] = pk2(f[2] * we, f[3] * we); o[2] = pk2(f[4] * we, f[5] * we); o[3] = pk2(f[6] * we, f[7] * we);
        *(u32x4*)(lds + L_Q + t * L_LD + pc * 16) = pq[i];
        *(u32x4*)(lds + L_K + t * L_LD + pc * 16) = o;
      }
#pragma unroll
      for (int i = 0; i < 4; ++i) {
        const int cidx = ht + 256 * i, t = cidx >> 4, pc = cidx & 15;
        *(u32x4*)(lds + L_V + t * L_VLD + pc * 16) = pv[i];
      }
    };
    {
      int tid = tid0; asm volatile("" : "+v"(tid));
      issue_loads(0, tid);
      scb[S_NV + (tid - 256)] = nreg;
      const float wend = scalars(0, tid & 63);
      stage_lds(wend, tid);
    }
    for (int c = 0; c < nchunks; ++c) {
      int tid = tid0; asm volatile("" : "+v"(tid));
      const int ht = tid - 256, lane = tid & 63, r = lane & 31, h = lane >> 5;
      float* sc = scb + (c & 1) * S_PAR;
      float* scn = scb + ((c + 1) & 1) * S_PAR;
      const float g_end_c = g_end_cur;
      WG_BAR();
      const bool more = c + 1 < nchunks;
      if (more) issue_loads(c + 1, tid);
      {
        const int t = ht & 63, part = ht >> 6;
        const char* qp = lds + L_Q + t * L_LD + part * 128;
        float s = 0.f;
#pragma unroll
        for (int e = 0; e < 8; ++e) {
          const u32x4 qq = *(const u32x4*)(qp + e * 16); float f[8]; unpack8(qq, f);
#pragma unroll
          for (int z = 0; z < 8; ++z) s += f[z] * sc[S_NV + part * 64 + e * 8 + z];
        }
        sc[S_QN + part * 64 + t] = s;
      }
      if (hw < 3) {
        const int stl = hw == 2 ? 1 : 0, tt = hw == 0 ? 0 : 1;
        f32x16 S, S2;
#pragma unroll
        for (int i = 0; i < 16; ++i) { S[i] = 0.f; S2[i] = 0.f; }
        const char* ka = lds + L_K + (stl * 32 + r) * L_LD + h * 16;
        const char* qa = lds + L_Q + (tt * 32 + r) * L_LD + h * 16;
#pragma unroll 4
        for (int ks = 0; ks < 16; ks += 2) {
          S = MFMA32(*(const bf16x8*)(ka + ks * 32), *(const bf16x8*)(qa + ks * 32), S);
          S2 = MFMA32(*(const bf16x8*)(ka + ks * 32 + 32), *(const bf16x8*)(qa + ks * 32 + 32), S2);
        }
        const int t = tt * 32 + r;
        const float cw = sc[S_MX + t];
        float rs = 0.f;
#pragma unroll
        for (int g = 0; g < 4; ++g) {
          float wv[4];
#pragma unroll
          for (int e = 0; e < 4; ++e) {
            const int s = stl * 32 + 8 * g + 4 * h + e;
            wv[e] = s <= t ? (S[4 * g + e] + S2[4 * g + e]) * cw : 0.f; rs += wv[e];
          }
          u32x2 o; o[0] = pk2(wv[0], wv[1]); o[1] = pk2(wv[2], wv[3]);
          *(u32x2*)(lds + L_SW + t * L_SWLD + (stl * 32 + 8 * g + 4 * h) * 2) = o;
        }
        rs += __shfl_xor(rs, 32);
        if (h == 0) {
          if (hw == 0) { sc[S_DS0 + t] = rs; sc[S_DS1 + t] = 0.f; }
          else if (hw == 1) sc[S_DS0 + t] = rs;
          else sc[S_DS1 + t] = rs;
        }
      } else {
        const int t = lane >> 1, hs = lane & 1;
        u32x4 z; z[0] = 0; z[1] = 0; z[2] = 0; z[3] = 0;
        *(u32x4*)(lds + L_SW + t * L_SWLD + 64 + hs * 32) = z; *(u32x4*)(lds + L_SW + t * L_SWLD + 64 + hs * 32 + 16) = z;
      }
      {
        float s0 = 0.f, s1 = 0.f, s2 = 0.f, s3 = 0.f;
        const char* kp = lds + L_K + ht * 2;
#pragma unroll
        for (int t = 0; t < 64; t += 4) {
          s0 += bflo((unsigned)*(const bf16_t*)(kp + t * L_LD)); s1 += bflo((unsigned)*(const bf16_t*)(kp + (t + 1) * L_LD));
          s2 += bflo((unsigned)*(const bf16_t*)(kp + (t + 2) * L_LD)); s3 += bflo((unsigned)*(const bf16_t*)(kp + (t + 3) * L_LD));
        }
        nreg = g_end_c * nreg + ((s0 + s1) + (s2 + s3));
        scn[S_NV + ht] = nreg;
      }
      float wend = 0.f;
      if (more) wend = scalars((c + 1) & 1, lane);
      WG_BAR();
      if (more) stage_lds(wend, tid);
    }
    WG_BAR();
    if (half == 0) {
      p.out[(KIND == 0 ? O_NP : O_NS) + bh * 256 + (tid0 - 256)] = nreg;
      if (tid0 == 256) p.out[(KIND == 0 ? O_MPP : O_MSS) + bh] = m_prev;
    }
  }
}

DI void mixer_phase(const Params& p, int l, char* lds, int cidx, bool ml_only) {
  unsigned* ctr = (unsigned*)(p.ws + W_MISC) + 16 + cidx;
  int* s_item = (int*)(lds + LDS_BYTES - 16);
  const int total = 32 + 64 + 64 + 2048;
  for (;;) {
    __syncthreads();
    if (threadIdx.x == 0) *s_item = (int)atomicAdd(ctr, 1u);
    __syncthreads();
    const int it = *s_item;
    __syncthreads();
    if (it >= total) break;
    if (ml_only && it >= 96) break;
    if (it < 32) { mlstm_item<0>(p, l, it >> 3, (it >> 1) & 3, it & 1, lds); continue; }
    if (it < 96) { const int x = it - 32; mlstm_item<1>(p, l, x >> 3, (x >> 1) & 3, x & 1, lds); continue; }
    if (it < 160) { attn_item<1>(p, l, (it - 96) >> 3, (it - 96) & 7, 0, lds); continue; }
    { const int x = it - 160; attn_item<0>(p, l, (x & 31) >> 3, x & 7, 63 - (x >> 5), lds); }
  }
}

DI void merge_phase(const Params& p, int l) {
  const bf16_t* Z = (const bf16_t*)(p.ws + W_Z); const bf16_t* H = (const bf16_t*)(p.ws + W_H); bf16_t* Y = (bf16_t*)(p.ws + W_AB);
  const int tidq = otid(); const int lane = tidq & 63, gw = blockIdx.x * 8 + (tidq >> 6), ngw = gridDim.x * 8;
  const float* mhg = p.in[15] + (size_t)l * D;
  for (int row = gw; row < M; row += ngw) {
    const int col = lane * 16;
    const bf16_t* z = Z + (size_t)row * NIN + col;
    float hv[16];
    unpack8(*(const u32x4*)(H + (size_t)row * D + col), hv); unpack8(*(const u32x4*)(H + (size_t)row * D + col + 8), hv + 8);
    float s = 0.f;
#pragma unroll
    for (int e = 0; e < 16; ++e) s += hv[e];
#pragma unroll
    for (int o = 1; o < 16; o <<= 1) s += __shfl_xor(s, o);
    const float mean = s * (1.f / 256.f);
    float s2 = 0.f;
#pragma unroll
    for (int e = 0; e < 16; ++e) { hv[e] -= mean; s2 += hv[e] * hv[e]; }
#pragma unroll
    for (int o = 1; o < 16; o <<= 1) s2 += __shfl_xor(s2, o);
    const float rstd = rsqrtf(s2 * (1.f / 256.f) + LN_EPS);
#pragma unroll
    for (int hh = 0; hh < 2; ++hh) {
      float oa[8], om[8], ga[8], gb[8];
      unpack8(*(const u32x4*)(z + 3072 + hh * 8), oa); unpack8(*(const u32x4*)(z + 6144 + hh * 8), om);
      unpack8(*(const u32x4*)(z + 7168 + hh * 8), ga); unpack8(*(const u32x4*)(z + 8192 + hh * 8), gb);
      const f32x4 g0 = *(const f32x4*)(mhg + col + hh * 8), g1 = *(const f32x4*)(mhg + col + hh * 8 + 4);
      float y[8];
#pragma unroll
      for (int e = 0; e < 8; ++e) {
        const float hn = hv[hh * 8 + e] * rstd * (e < 4 ? g0[e] : g1[e - 4]);
        y[e] = sigmoidf_(ga[e]) * oa[e] + sigmoidf_(gb[e]) * (hn * sigmoidf_(om[e]));
      }
      u32x4 o; o[0] = pk2(y[0], y[1]); o[1] = pk2(y[2], y[3]); o[2] = pk2(y[4], y[5]); o[3] = pk2(y[6], y[7]);
      *(u32x4*)(Y + (size_t)row * D + col + hh * 8) = o;
    }
  }
}

DI void ln_phase(const Params& p, const float* g, const float* bta, bool final_out) {
  const int tidq = otid(); const int lane = tidq & 63, gw = blockIdx.x * 8 + (tidq >> 6), ngw = gridDim.x * 8;
  float* R = (float*)(p.ws + W_R); bf16_t* AB = (bf16_t*)(p.ws + W_AB);
  for (int row0 = gw; row0 < M; row0 += 2 * ngw) {
    f32x4 v[2][4]; float s[2] = {0.f, 0.f};
    const int row1 = row0 + ngw; const bool has1 = row1 < M;
#pragma unroll
    for (int q = 0; q < 2; ++q) {
      const float* xr = R + (size_t)(q == 0 ? row0 : (has1 ? row1 : row0)) * D;
#pragma unroll
      for (int j = 0; j < 4; ++j) { v[q][j] = *(const f32x4*)(xr + j * 256 + lane * 4); s[q] += (v[q][j][0] + v[q][j][1]) + (v[q][j][2] + v[q][j][3]); }
    }
#pragma unroll
    for (int q = 0; q < 2; ++q) {
      if (q == 1 && !has1) break;
      const int row = q == 0 ? row0 : row1;
      const float mean = wave_sum(s[q]) * (1.f / D);
      float s2 = 0.f;
#pragma unroll
      for (int j = 0; j < 4; ++j) { v[q][j] = v[q][j] - mean; s2 += (v[q][j][0] * v[q][j][0] + v[q][j][1] * v[q][j][1]) + (v[q][j][2] * v[q][j][2] + v[q][j][3] * v[q][j][3]); }
      const float rstd = rsqrtf(wave_sum(s2) * (1.f / D) + LN_EPS);
      float* dst = final_out ? (row < MP ? p.out + O_YP + (size_t)row * D : p.out + O_YS + (size_t)(row - MP) * D) : R + (size_t)row * D;
#pragma unroll
      for (int j = 0; j < 4; ++j) {
        const int c = j * 256 + lane * 4;
        const f32x4 gg = *(const f32x4*)(g + c), bb = *(const f32x4*)(bta + c);
        const f32x4 o = v[q][j] * rstd * gg + bb;
        *(f32x4*)(dst + c) = o;
        if (!final_out) { u32x2 ob; ob[0] = pk2(o[0], o[1]); ob[1] = pk2(o[2], o[3]); *(u32x2*)(AB + (size_t)row * D + c) = ob; }
      }
    }
  }
}

DI float gelu_f(float v) {
  const float av = fabsf(v), d = av * 0.2316418882f + 1.0f;
  const float t = __builtin_amdgcn_rcpf(d);
  float q = t * 0.5307027145f + (-0.7265760135f); q = q * t + 0.7107068705f; q = q * t + (-0.142248368f); q = q * t + 0.127414796f; q = q * t;
  const float e = __builtin_amdgcn_exp2f((v * v) * (-0.72134752044f));
  const float m = v * (q * e), r = v - m;
  return v < 0.f ? m : r;
}
DI void ffnconv_phase(const Params& p, int l) {
  const bf16_t* U = (const bf16_t*)(p.ws + W_Z); bf16_t* HF = (bf16_t*)(p.ws + W_Z + (size_t)M * NUP * 2);
  const float* cw = p.in[20] + (size_t)l * 3 * NUP; const float* cb = p.in[21] + (size_t)l * NUP;
  constexpr int RG = 8;
  const unsigned total = (unsigned)(M / RG) * 352u;
  for (unsigned it = blockIdx.x * NTH + (unsigned)otid(); it < total; it += gridDim.x * NTH) {
    const unsigned rg = it / 352u, cc = it - rg * 352u;
    const int col = (int)cc * 8, row0 = (int)rg * RG;
    int t0; const float* st = nullptr;
    if (row0 < MP) t0 = row0 & (SEQ - 1); else { t0 = (row0 - MP) & 15; st = p.in[8] + ((size_t)(l * 8 + ((row0 - MP) >> 4)) * 2) * NUP; }
    float gl[RG][8];
#pragma unroll
    for (int hf = 0; hf < 2; ++hf) {
      const int c2 = col + hf * DFF;
      float w[3][8], bias[8], x[RG + 2][8];
#pragma unroll
      for (int j = 0; j < 3; ++j) { const f32x4 a = *(const f32x4*)(cw + j * NUP + c2), b2 = *(const f32x4*)(cw + j * NUP + c2 + 4);
        w[j][0] = a[0]; w[j][1] = a[1]; w[j][2] = a[2]; w[j][3] = a[3]; w[j][4] = b2[0]; w[j][5] = b2[1]; w[j][6] = b2[2]; w[j][7] = b2[3]; }
      { const f32x4 a = *(const f32x4*)(cb + c2), b2 = *(const f32x4*)(cb + c2 + 4);
        bias[0] = a[0]; bias[1] = a[1]; bias[2] = a[2]; bias[3] = a[3]; bias[4] = b2[0]; bias[5] = b2[1]; bias[6] = b2[2]; bias[7] = b2[3]; }
#pragma unroll
      for (int j = 0; j < RG + 2; ++j) {
        const int t = t0 - 2 + j;
        if (t >= 0) unpack8(*(const u32x4*)(U + (size_t)(row0 - 2 + j) * NUP + c2), x[j]);
        else if (st) { const float* sp = st + (size_t)(2 + t) * NUP + c2; const f32x4 a = *(const f32x4*)sp, b2 = *(const f32x4*)(sp + 4);
          x[j][0] = a[0]; x[j][1] = a[1]; x[j][2] = a[2]; x[j][3] = a[3]; x[j][4] = b2[0]; x[j][5] = b2[1]; x[j][6] = b2[2]; x[j][7] = b2[3]; }
        else {
#pragma unroll
          for (int e = 0; e < 8; ++e) x[j][e] = 0.f; }
      }
#pragma unroll
      for (int a = 0; a < RG; ++a) {
        float o[8];
#pragma unroll
        for (int e = 0; e < 8; ++e) {
          const float u = bias[e] + w[0][e] * x[a][e] + w[1][e] * x[a + 1][e] + w[2][e] * x[a + 2][e];
          if (hf == 0) gl[a][e] = gelu_f(u); else o[e] = gl[a][e] * u;
        }
        if (hf == 1) {
          u32x4 ov; ov[0] = pk2(o[0], o[1]); ov[1] = pk2(o[2], o[3]); ov[2] = pk2(o[4], o[5]); ov[3] = pk2(o[6], o[7]);
          *(u32x4*)(HF + (size_t)(row0 + a) * DFF + col) = ov;
        }
      }
    }
  }
}

#define XB_TMO      128
#define XB_XCNT(j)  (256  + 64 * (j))
#define XB_XSUB(j)  (1280 + 64 * (j))
#define XB_XGEN(j)  (2304 + 64 * (j))
#define XB_TOP      3328
#define XB_TOPGEN   3392
#define XCD_BAR_WORDS 3456
#define XB_SPIN_CAP (1u << 18)
#define XLAS __attribute__((address_space(3)))
DI unsigned xb_ld(unsigned* p)              { return __hip_atomic_load(p, __ATOMIC_RELAXED, __HIP_MEMORY_SCOPE_AGENT); }
DI unsigned xb_add(unsigned* p, unsigned v) { return __hip_atomic_fetch_add(p, v, __ATOMIC_RELAXED, __HIP_MEMORY_SCOPE_AGENT); }
DI unsigned xb_xcc_id() { return (unsigned)__builtin_amdgcn_s_getreg((3 << 11) | 20) & 0xFu; }
#define XB_SPIN(cond, bar) do { unsigned _sp = 0; while (cond) { __builtin_amdgcn_s_sleep(1); \
    if ((++_sp & 255u) == 0u) { if (xb_ld(&(bar)[XB_TMO])) break; if (_sp > XB_SPIN_CAP) { atomicAdd(&(bar)[XB_TMO], 1u); break; } } } } while (0)
struct XcdBarrier { unsigned* bar; unsigned x; volatile XLAS unsigned* st; };
DI XcdBarrier xcd_barrier_post(unsigned* bar, volatile XLAS unsigned* st) {
  XcdBarrier b; b.bar = bar; b.x = xb_xcc_id(); b.st = st;
  if (threadIdx.x == 0) (void)xb_add(&bar[XB_XCNT(b.x)], 1u);
  return b;
}
DI void xcd_barrier_complete(unsigned* bar, unsigned x, unsigned& nloc, unsigned& nx) {
  const unsigned G = gridDim.x * gridDim.y * gridDim.z;
  unsigned sum, cnt, mine, sp = 0u;
  for (;;) {
    sum = 0u; cnt = 0u; mine = 0u;
#pragma unroll
    for (unsigned j = 0; j < 16; ++j) { const unsigned c = xb_ld(&bar[XB_XCNT(j)]); sum += c; cnt += (c > 0u) ? 1u : 0u; mine = (j == x) ? c : mine; }
    if (sum == G) break;
    __builtin_amdgcn_s_sleep(1);
    if ((++sp & 255u) == 0u) { if (xb_ld(&bar[XB_TMO])) break; if (sp > XB_SPIN_CAP) { atomicAdd(&bar[XB_TMO], 1u); break; } }
  }
  nloc = mine > 0u ? mine : 1u; nx = cnt > 0u ? cnt : 1u;
}
DI void xcd_barrier(const XcdBarrier& b) {
  asm volatile("s_waitcnt vmcnt(0)" ::: "memory");
  __syncthreads();
  if (threadIdx.x == 0) {
    unsigned* bar = b.bar;
    __builtin_amdgcn_s_waitcnt(0);
    unsigned nloc = b.st[0], nx = b.st[1];
    if (nloc == 0u) { xcd_barrier_complete(bar, b.x, nloc, nx); b.st[0] = nloc; b.st[1] = nx; }
    const unsigned old = xb_add(&bar[XB_XSUB(b.x)], 1u);
    const unsigned gen = old / nloc;
    if (old + 1u == (gen + 1u) * nloc) {
      __builtin_amdgcn_fence(__ATOMIC_RELEASE, "agent");
      asm volatile("s_waitcnt vmcnt(0)" ::: "memory");
      const unsigned og = xb_add(&bar[XB_TOP], 1u);
      const unsigned tg = og / nx;
      if (og + 1u == (tg + 1u) * nx) xb_add(&bar[XB_TOPGEN], 1u);
      else XB_SPIN(xb_ld(&bar[XB_TOPGEN]) == tg, bar);
      __builtin_amdgcn_fence(__ATOMIC_ACQUIRE, "agent");
      xb_add(&bar[XB_XGEN(b.x)], 1u);
      asm volatile("s_waitcnt vmcnt(0)" ::: "memory");
    } else {
      XB_SPIN(xb_ld(&bar[XB_XGEN(b.x)]) == gen, bar);
      __builtin_amdgcn_fence(__ATOMIC_ACQUIRE, "agent");
      asm volatile("s_waitcnt vmcnt(0)" ::: "memory");
    }
  }
  __syncthreads();
}

constexpr int NPH = 21;
DI void run_phase(const Params& p, int ph, char* lds) {
#ifndef ONLY
  if (ph == 0) { phase0(p, lds); return; }
#else
  if (ph == 0) return;
#endif
  const int l = (ph - 1) / 10, s = (ph - 1) % 10;
#ifdef ONLY
  if (s != ONLY) return;
#endif
  switch (s) {
    case 0: gemm_phase<EPI_IN>(p, l, (const bf16_t*)(p.ws + W_AB), D, (const bf16_t*)(p.ws + W_WIN) + (size_t)l * NIN * D, D, NIN / 256, lds); break;
    case 1: qkconv_phase(p, l); gif_phase(p, l, lds, 0); break;
    case 2: mixer_phase(p, l, lds, l, false); break;
    case 3: merge_phase(p, l); break;
    case 4: gemm_phase<EPI_OUT>(p, l, (const bf16_t*)(p.ws + W_AB), D, (const bf16_t*)(p.ws + W_WOUT) + (size_t)l * D * D, D, D / 256, lds); break;
    case 5: ln_phase(p, p.in[17] + l * D, p.in[18] + l * D, false); break;
    case 6: gemm_phase<EPI_UP>(p, l, (const bf16_t*)(p.ws + W_AB), D, (const bf16_t*)(p.ws + W_WUP) + (size_t)l * NUP * D, D, NUP / 256, lds); break;
    case 7: ffnconv_phase(p, l); break;
    case 8: gemm_phase<EPI_DOWN>(p, l, (const bf16_t*)(p.ws + W_Z + (size_t)M * NUP * 2), DFF, (const bf16_t*)(p.ws + W_WDN) + (size_t)l * D * DFF, DFF, D / 256, lds); break;
    case 9: ln_phase(p, p.in[23] + l * D, p.in[24] + l * D, l == 1); break;
  }
}

__global__ void __launch_bounds__(NTH) mega(Params p, int ph_lo, int ph_hi) {
  extern __shared__ __attribute__((aligned(16))) char lds[];
#if MULTI_LAUNCH
  for (int ph = ph_lo; ph < ph_hi; ++ph) run_phase(p, ph, lds);
#else
  cg::grid_group grid = cg::this_grid();
  phase0(p, lds);
  grid.sync();
  volatile XLAS unsigned* xst = (volatile XLAS unsigned*)((XLAS char*)lds + (LDS_BYTES - 32));
  if (threadIdx.x == 0) { xst[0] = 0u; xst[1] = 0u; }
  __syncthreads();
  const XcdBarrier xb = xcd_barrier_post((unsigned*)(p.ws + W_BAR), xst);
#define GSYNC() xcd_barrier(xb)
  for (int l = 0; l < 2; ++l) {
    gemm_phase<EPI_IN>(p, l, (const bf16_t*)(p.ws + W_AB), D, (const bf16_t*)(p.ws + W_WIN) + (size_t)l * NIN * D, D, NIN / 256, lds);
    {
      const int nun = NTM * (NIN / 256), G = (int)gridDim.x;
      const int busy = nun % G;
      gif_phase(p, l, lds, (busy > 0 && busy * 2 < G) ? busy : 0);
    }
    GSYNC();
#ifdef PROBE_GIN2
    gemm_phase<EPI_IN>(p, l, (const bf16_t*)(p.ws + W_AB), D, (const bf16_t*)(p.ws + W_WIN) + (size_t)l * NIN * D, D, NIN / 256, lds);
    GSYNC();
#endif
    qkconv_phase(p, l);
    GSYNC();
#if defined(PROBE_EW2) || defined(PROBE_QKC2)
    qkconv_phase(p, l);
    GSYNC();
#endif
    mixer_phase(p, l, lds, l, false);
    GSYNC();
#ifdef PROBE_ML2
    mixer_phase(p, l, lds, l + 2, true);
    GSYNC();
#endif
#ifdef PROBE_MIX2
    mixer_phase(p, l, lds, l + 2, false);
    GSYNC();
#endif
    merge_phase(p, l);
    GSYNC();
#ifdef PROBE_SYNC
    for (int q = 0; q < 20; ++q) GSYNC();
#endif
#if defined(PROBE_EW2) || defined(PROBE_MRG2)
    merge_phase(p, l);
    GSYNC();
#endif
    gemm_phase<EPI_OUT>(p, l, (const bf16_t*)(p.ws + W_AB), D, (const bf16_t*)(p.ws + W_WOUT) + (size_t)l * D * D, D, D / 256, lds);
    GSYNC();
    ln_phase(p, p.in[17] + l * D, p.in[18] + l * D, false);
    GSYNC();
    gemm_phase<EPI_UP>(p, l, (const bf16_t*)(p.ws + W_AB), D, (const bf16_t*)(p.ws + W_WUP) + (size_t)l * NUP * D, D, NUP / 256, lds);
    GSYNC();
    ffnconv_phase(p, l);
    GSYNC();
#if defined(PROBE_EW2) || defined(PROBE_FFC2)
    ffnconv_phase(p, l);
    GSYNC();
#endif
    gemm_phase<EPI_DOWN>(p, l, (const bf16_t*)(p.ws + W_Z + (size_t)M * NUP * 2), DFF, (const bf16_t*)(p.ws + W_WDN) + (size_t)l * D * DFF, DFF, D / 256, lds);
    GSYNC();
    ln_phase(p, p.in[23] + l * D, p.in[24] + l * D, l == 1);
    if (l == 0) GSYNC();
  }
#endif
}

extern "C" void kernel_launch(void* const* d_in, const int* in_sizes, int n_in, void* d_out, int out_size, void* d_ws, size_t ws_size, hipStream_t stream) {
  static int grid = 0;
  if (grid == 0) {
    if (n_in != 25 || (size_t)out_size != O_END || ws_size < W_END) { fprintf(stderr, "kernel_launch: unexpected sizes n_in %d out %d (want %zu) ws %zu (want %zu)\n", n_in, out_size, (size_t)O_END, ws_size, (size_t)W_END); grid = -1; return; }
    int dev = 0, cus = 0, per_cu = 0;
    hipGetDevice(&dev);
    hipDeviceGetAttribute(&cus, hipDeviceAttributeMultiprocessorCount, dev);
    if (hipFuncSetAttribute((const void*)mega, hipFuncAttributeMaxDynamicSharedMemorySize, LDS_BYTES) != hipSuccess) { fprintf(stderr, "hipFuncSetAttribute failed\n"); grid = -1; return; }
    hipOccupancyMaxActiveBlocksPerMultiprocessor(&per_cu, (const void*)mega, NTH, LDS_BYTES);
    if (per_cu < 1) per_cu = 1;
    grid = cus * 1;
    (void)hipGetLastError();
  }
  if (grid < 0) return;
  Params p{};
  for (int i = 0; i < 25; ++i) p.in[i] = (const float*)d_in[i];
  p.out = (float*)d_out; p.ws = (unsigned char*)d_ws;
#if MULTI_LAUNCH
  for (int ph = 0; ph < NPH; ++ph) hipLaunchKernelGGL(mega, dim3(grid), dim3(NTH), LDS_BYTES, stream, p, ph, ph + 1);
#else
  int lo = 0, hi = NPH;
  void* args[] = {&p, &lo, &hi};
  hipError_t e = hipLaunchCooperativeKernel((const void*)mega, dim3(grid), dim3(NTH), args, LDS_BYTES, stream);
  if (e != hipSuccess) fprintf(stderr, "cooperative launch failed: %s (grid %d)\n", hipGetErrorString(e), grid);
#endif
}
```

```cpp
#include <hip/hip_runtime.h>
#include <hip/hip_cooperative_groups.h>
#include <cstdio>
namespace cg = cooperative_groups;

#ifndef MULTI_LAUNCH
#define MULTI_LAUNCH 0
#endif

typedef unsigned short bf16_t;
typedef short bf16x8 __attribute__((ext_vector_type(8)));
typedef short s16x4 __attribute__((ext_vector_type(4)));
typedef float f32x16 __attribute__((ext_vector_type(16)));
typedef float f32x4 __attribute__((ext_vector_type(4)));
typedef unsigned u32x4 __attribute__((ext_vector_type(4)));
typedef unsigned u32x2 __attribute__((ext_vector_type(2)));
#define DI __device__ __forceinline__
#define MFMA32(a, b, c) __builtin_amdgcn_mfma_f32_32x32x16_bf16((a), (b), (c), 0, 0, 0)

constexpr int NTH = 512;
constexpr int D = 1024, SEQ = 8192, NB = 4, MP = NB * SEQ, MS = 128, M = MP + MS, NTM = 129;
constexpr int DIN = 9224, NIN = 9216, DFF = 2816, NUP = 5632;
constexpr int PAST = 4096, NKS = PAST + 16;
constexpr float ALPHA = 1.4142135623730951f;
constexpr float LN_EPS = 1e-5f;
constexpr float LOG2E = 1.4426950408889634f;

constexpr size_t O_YP = 0;
constexpr size_t O_YS = O_YP + (size_t)MP * D;
constexpr size_t O_KP = O_YS + (size_t)MS * D;
constexpr size_t O_VP = O_KP + (size_t)2 * MP * 1024;
constexpr size_t O_MCP = O_VP + (size_t)2 * MP * 1024;
constexpr size_t O_CP = O_MCP + (size_t)2 * 4 * 3 * 2048;
constexpr size_t O_NP = O_CP + (size_t)2 * 4 * 4 * 65536;
constexpr size_t O_MPP = O_NP + (size_t)2 * 4 * 4 * 256;
constexpr size_t O_FCP = O_MPP + 32;
constexpr size_t O_KS = O_FCP + (size_t)2 * 4 * 2 * NUP;
constexpr size_t O_VS = O_KS + (size_t)2 * MS * 1024;
constexpr size_t O_MCS = O_VS + (size_t)2 * MS * 1024;
constexpr size_t O_CS = O_MCS + (size_t)2 * 8 * 3 * 2048;
constexpr size_t O_NS = O_CS + (size_t)2 * 8 * 4 * 65536;
constexpr size_t O_MSS = O_NS + (size_t)2 * 8 * 4 * 256;
constexpr size_t O_FCS = O_MSS + 64;
constexpr size_t O_END = O_FCS + (size_t)2 * 8 * 2 * NUP;

constexpr size_t W_Z = 0;
constexpr size_t W_H = W_Z + (size_t)M * NIN * 2;
constexpr size_t W_AB = W_H + (size_t)M * D * 2;
constexpr size_t W_KA = W_AB + (size_t)M * D * 2;
constexpr size_t W_R = W_KA + (size_t)M * D * 2;
constexpr size_t W_WIN = W_R + (size_t)M * D * 4;
constexpr size_t W_WOUT = W_WIN + (size_t)2 * NIN * D * 2;
constexpr size_t W_WUP = W_WOUT + (size_t)2 * D * D * 2;
constexpr size_t W_WDN = W_WUP + (size_t)2 * NUP * D * 2;
constexpr size_t W_GIF = W_WDN + (size_t)2 * D * DFF * 2;
constexpr size_t W_ROPE = W_GIF + (size_t)M * 8 * 4;
constexpr size_t W_MISC = W_ROPE + (size_t)8192 * 32 * 8;
constexpr size_t W_BAR = W_MISC + 4096;
constexpr size_t W_END = W_BAR + 16384;

struct Params {
  const float* in[25];
  float* out;
  unsigned char* ws;
};

DI unsigned f2bf(float x) { unsigned u = __float_as_uint(x); u += 0x7fffu + ((u >> 16) & 1u); return u >> 16; }
typedef __bf16 bf16v2 __attribute__((ext_vector_type(2)));
typedef float f32x2 __attribute__((ext_vector_type(2)));
DI unsigned pk2(float a, float b) { f32x2 v; v[0] = a; v[1] = b; return __builtin_bit_cast(unsigned, __builtin_convertvector(v, bf16v2)); }
DI float bflo(unsigned u) { return __uint_as_float(u << 16); }
DI float bfhi(unsigned u) { return __uint_as_float(u & 0xffff0000u); }
DI float sigmoidf_(float x) { return __builtin_amdgcn_rcpf(1.f + __builtin_amdgcn_exp2f(-1.4426950408889634f * x)); }
DI float wave_sum(float v) {
#pragma unroll
  for (int o = 1; o < 64; o <<= 1) v += __shfl_xor(v, o);
  return v;
}
DI int crow(int i, int h) { return (i & 3) + 8 * (i >> 2) + 4 * h; }
DI bf16x8 pack8(const f32x16& x, int s) {
  u32x4 p;
  p[0] = pk2(x[8 * s + 0], x[8 * s + 1]); p[1] = pk2(x[8 * s + 2], x[8 * s + 3]);
  p[2] = pk2(x[8 * s + 4], x[8 * s + 5]); p[3] = pk2(x[8 * s + 6], x[8 * s + 7]);
  return __builtin_bit_cast(bf16x8, p);
}
DI void unpack8(u32x4 v, float* f) {
  f[0] = bflo(v[0]); f[1] = bfhi(v[0]); f[2] = bflo(v[1]); f[3] = bfhi(v[1]);
  f[4] = bflo(v[2]); f[5] = bfhi(v[2]); f[6] = bflo(v[3]); f[7] = bfhi(v[3]);
}
typedef __attribute__((address_space(3))) s16x4 lds_s16x4;
DI bf16x8 tr_frag(unsigned a_lo, unsigned a_hi) {
  const s16x4 lo = __builtin_amdgcn_ds_read_tr16_b64_v4i16((lds_s16x4*)(size_t)a_lo);
  const s16x4 hi = __builtin_amdgcn_ds_read_tr16_b64_v4i16((lds_s16x4*)(size_t)a_hi);
  return __builtin_shufflevector(lo, hi, 0, 1, 2, 3, 4, 5, 6, 7);
}
template <int STEP, int HIOFF>
DI void tr_frag4(unsigned a, bf16x8 (&f)[4]) {
#pragma unroll
  for (int i = 0; i < 4; ++i) f[i] = tr_frag(a + i * STEP, a + i * STEP + HIOFF);
}
DI int otid() { int t = threadIdx.x; asm volatile("" : "+v"(t)); return t; }
DI int uni(int v) { return __builtin_amdgcn_readfirstlane(v); }
DI unsigned lds_addr(const void* p) { return (unsigned)(size_t)p; }

DI const float* xrow_ptr(const Params& p, int l, int row) {
  if (l == 0) return row < MP ? p.in[0] + (size_t)row * D : p.in[1] + (size_t)(row - MP) * D;
  return (const float*)(p.ws + W_R) + (size_t)row * D;
}

DI void transpose_w(const float* W, int K, int N, int src_ld, bf16_t* WT, bool remap, char* lds) {
  float* scr = (float*)lds;
  const int nkb = K / 64, nnb = N / 64, tid = otid();
  for (int it = blockIdx.x; it < nkb * nnb; it += gridDim.x) {
    const int kb = it / nnb, nb = it % nnb, k0 = kb * 64, n0 = nb * 64;
    const int ns = (remap && n0 >= 7168) ? n0 + 8 : n0;
#pragma unroll
    for (int i = 0; i < 8; ++i) {
      const int kk = (tid >> 6) + 8 * i, nn = tid & 63;
      scr[kk * 65 + nn] = W[(size_t)(k0 + kk) * src_ld + ns + nn];
    }
    __syncthreads();
    {
      const int n = tid >> 3, c = tid & 7;
      const float* s = scr + (8 * c) * 65 + n;
      u32x4 o;
      o[0] = pk2(s[0], s[65]); o[1] = pk2(s[2 * 65], s[3 * 65]); o[2] = pk2(s[4 * 65], s[5 * 65]); o[3] = pk2(s[6 * 65], s[7 * 65]);
      const int nd = (remap && n0 < 2048) ? ((n < 32) ? 2 * n : 2 * (n - 32) + 1) : n;
      *(u32x4*)(WT + (size_t)(n0 + nd) * K + k0 + 8 * c) = o;
    }
    __syncthreads();
  }
}

DI void phase0(const Params& p, char* lds) {
  const int tid = otid();
  for (int l = 0; l < 2; ++l) {
    transpose_w(p.in[9] + (size_t)l * D * DIN, D, NIN, DIN, (bf16_t*)(p.ws + W_WIN) + (size_t)l * NIN * D, true, lds);
    transpose_w(p.in[16] + (size_t)l * D * D, D, D, D, (bf16_t*)(p.ws + W_WOUT) + (size_t)l * D * D, false, lds);
    transpose_w(p.in[19] + (size_t)l * D * NUP, D, NUP, NUP, (bf16_t*)(p.ws + W_WUP) + (size_t)l * NUP * D, false, lds);
    transpose_w(p.in[22] + (size_t)l * DFF * D, DFF, D, D, (bf16_t*)(p.ws + W_WDN) + (size_t)l * D * DFF, false, lds);
  }
  bf16_t* ab = (bf16_t*)(p.ws + W_AB);
  {
    const unsigned total = (unsigned)M * 128u, S = gridDim.x * NTH;
    for (unsigned c0 = blockIdx.x * NTH + (unsigned)tid; c0 < total; c0 += 4u * S) {
      f32x4 a[4], b4[4];
#pragma unroll
      for (int u = 0; u < 4; ++u) {
        const unsigned c = c0 + (unsigned)u * S;
        if (c < total) { const float* src = xrow_ptr(p, 0, (int)(c >> 7)) + (c & 127u) * 8; a[u] = *(const f32x4*)src; b4[u] = *(const f32x4*)(src + 4); }
      }
#pragma unroll
      for (int u = 0; u < 4; ++u) {
        const unsigned c = c0 + (unsigned)u * S;
        if (c < total) {
          u32x4 o; o[0] = pk2(a[u][0], a[u][1]); o[1] = pk2(a[u][2], a[u][3]); o[2] = pk2(b4[u][0], b4[u][1]); o[3] = pk2(b4[u][2], b4[u][3]);
          *(u32x4*)(ab + (size_t)(c >> 7) * D + (c & 127u) * 8) = o;
        }
      }
    }
  }
  float2* rope = (float2*)(p.ws + W_ROPE);
  for (int i = blockIdx.x * NTH + tid; i < 8192 * 32; i += gridDim.x * NTH) {
    const int pos = i >> 5, d = i & 31;
    const double inv = exp2(-(double)d * (13.287712379549449 / 32.0));
    double ang = (double)pos * inv;
    const double twopi = 6.283185307179586476925;
    ang -= twopi * rint(ang / twopi);
    float s, c; sincosf((float)ang, &s, &c);
    rope[i] = make_float2(c, s);
  }
  if (blockIdx.x == 0 && tid < 128) {
    const int l = tid >> 6, ln = tid & 63;
    const float* lp = p.in[13] + (size_t)l * 4 * 64;
    const float s1 = wave_sum(lp[ln] * lp[64 + ln]), s2 = wave_sum(lp[128 + ln] * lp[192 + ln]);
    const float lam_init = (l == 0) ? 0.2f : (0.8f - 0.6f * 0.74081822068171788f);
    if (ln == 0) ((float*)(p.ws + W_MISC))[l] = __expf(s1) - __expf(s2) + lam_init;
  }
  if (blockIdx.x == 0 && tid < 8) ((unsigned*)(p.ws + W_MISC))[16 + tid] = 0u;
  if (blockIdx.x == 0) for (int i = tid; i < 3456; i += NTH) ((unsigned*)(p.ws + W_BAR))[i] = 0u;
}

namespace pg8 {
#define PG8_LAS __attribute__((address_space(3)))
typedef unsigned short bf16_t;
typedef short bf16x8 __attribute__((ext_vector_type(8)));
typedef float f32x4 __attribute__((ext_vector_type(4)));
typedef unsigned u32x4 __attribute__((ext_vector_type(4)));
constexpr int BM = 256, BK = 64, HALF = 128, HTB = HALF * BK * 2  , STAGE_BYTES = 8 * HTB, NXCD = 8, WGM = 8;

__host__ __device__ __forceinline__ int lds_byte(int r, int c) { const int st = (r >> 4) * 2 + (c >> 5), rr = r & 15, cc = c & 31, ob = rr * 64 + cc * 2; return st * 1024 + (ob ^ (((ob >> 9) & 1) << 5)); }
__host__ __device__ __forceinline__ void stage_rc(int b, int& R, int& C) { const int st = b / 1024, sb = b % 1024, swz = sb ^ (((sb >> 9) & 1) << 5); R = (st >> 1) * 16 + swz / 64; C = (st & 1) * 32 + (swz % 64) / 2; }
__host__ __device__ __forceinline__ int perm32(int rho) { const int n = rho >> 4, i = rho & 15; return 8 * (i >> 2) + 4 * n + (i & 3); }

struct Unit { int pm, pn; };
struct Gemm { const bf16_t* A; const bf16_t* Bt; int M, N, K; };

struct StaticOrder {
    int nM, nN, nwg, G, c;
    __host__ __device__ void init(int M, int N, int G_, int c_) { nM = M / BM; nN = N / BM; nwg = nM * nN; G = G_; c = c_; }
    __host__ __device__ bool next(int i, Unit& u) const {
        const long L = (long)i * G + c; if (L >= nwg) return false;
        int wgid = (int)L; { const int q = nwg / NXCD, r = nwg % NXCD, xcd = wgid % NXCD, off = wgid / NXCD; wgid = (xcd < r ? xcd * (q + 1) : r * (q + 1) + (xcd - r) * q) + off; }
        const int nig = WGM * nN, gid = wgid / nig, fm = gid * WGM, gsz = (nM - fm) < WGM ? (nM - fm) : WGM;
        u.pm = fm + ((wgid % nig) % gsz); u.pn = (wgid % nig) / gsz; return true;
    }
    __device__ __forceinline__ void a_ready(const Unit&) const {}
    __device__ __forceinline__ void done(const Unit&) const {}
};
template <class Epi, class Sched, bool STAMP = false>
__device__ __forceinline__ void gemm_phase(PG8_LAS unsigned char* lds, const Gemm g, const Sched& S, const Epi& E, unsigned long long* stamps) {
    const int tid = otid(), wid = __builtin_amdgcn_readfirstlane(tid >> 6), lane = tid & 63, wr = wid >> 2, wc = wid & 3, fr = lane & 15, fq = lane >> 4;
    const int K = g.K, nt = K / BK;
    int ts_lo = 0, ts_hi = 0, nts = 0; const unsigned long long rt_entry = STAMP ? (unsigned long long)wall_clock64() : 0ull;
#define PG8_STAMP() do { if (STAMP && wid == 0 && nts < 64) { const unsigned long long _c = (unsigned long long)clock64(); \
        ts_lo = (lane == nts) ? (int)(unsigned)_c : ts_lo; ts_hi = (lane == nts) ? (int)(unsigned)(_c >> 32) : ts_hi; ++nts; } } while (0)
    PG8_STAMP();
    unsigned voffA[2], voffB[2];
#pragma unroll
    for (int i = 0; i < 2; ++i) { int R, C; stage_rc(tid * 16 + i * 8192, R, C); const int Rb = Epi::PERM ? ((R & ~31) + perm32(R & 31)) : R;
        voffA[i] = (unsigned)(R * K + C) * 2u; voffB[i] = (unsigned)(Rb * K + C) * 2u; }
    const size_t kstep = (size_t)(BK * 2);
    const size_t hstep = (size_t)HALF * K * 2;
    const size_t tstep = 2 * hstep;
    const unsigned ldsw = (unsigned)wid * 1024u;
    const int aoff = lds_byte(wr * 64 + fr, fq * 8), boff = lds_byte(wc * 32 + fr, fq * 8);
#define PG8_SA(b, h) (((b) * 2 + (h)) * HTB)
#define PG8_SB(b, h) ((4 + (b) * 2 + (h)) * HTB)
#define PG8_STAGE(bufoff, gbase, voff) do { _Pragma("unroll") for (int _i = 0; _i < 2; ++_i) \
        __builtin_amdgcn_global_load_lds((const unsigned*)((const char*)(gbase) + (voff)[_i]), (PG8_LAS unsigned*)(lds + (bufoff) + ldsw + _i * 8192), 16, 0, 0); } while (0)
#define PG8_LDA(dst, b, h) do { _Pragma("unroll") for (int m = 0; m < 4; ++m) _Pragma("unroll") for (int k = 0; k < 2; ++k) dst[m][k] = *(const PG8_LAS bf16x8*)(lds + PG8_SA(b, h) + aoff + m * 2048 + k * 1024); } while (0)
#define PG8_LDB(dst, b, h) do { _Pragma("unroll") for (int n = 0; n < 2; ++n) _Pragma("unroll") for (int k = 0; k < 2; ++k) dst[n][k] = *(const PG8_LAS bf16x8*)(lds + PG8_SB(b, h) + boff + n * 2048 + k * 1024); } while (0)
#define PG8_MMA(ai, bj, At, Bt) do { __builtin_amdgcn_s_setprio(1); _Pragma("unroll") for (int m = 0; m < 4; ++m) _Pragma("unroll") for (int n = 0; n < 2; ++n) _Pragma("unroll") for (int k = 0; k < 2; ++k) \
        acc[ai][bj][m][n] = __builtin_amdgcn_mfma_f32_16x16x32_bf16(Bt[n][k], At[m][k], acc[ai][bj][m][n], 0, 0, 0); __builtin_amdgcn_s_setprio(0); } while (0)
#define PG8_WAIT_V(n) asm volatile("s_waitcnt vmcnt(" #n ")" ::: "memory")
#define PG8_WAIT_L(n) asm volatile("s_waitcnt lgkmcnt(" #n ")" ::: "memory")
#define PG8_BAR __builtin_amdgcn_s_barrier()
#define PG8_SCHED __builtin_amdgcn_sched_barrier(0)
    Unit cur, nxt; int ui = 0;
    if (!S.next(0, cur)) return;
    f32x4 acc[2][2][4][2];
#pragma unroll
    for (int a = 0; a < 2; ++a)
#pragma unroll
        for (int b = 0; b < 2; ++b)
#pragma unroll
            for (int m = 0; m < 4; ++m)
#pragma unroll
                for (int n = 0; n < 2; ++n) acc[a][b][m][n] = (f32x4){0.f, 0.f, 0.f, 0.f};
    bf16x8 At[4][2], B0[2][2], B1[2][2];
    const char* cA = (const char*)g.A + (size_t)cur.pm * tstep; const char* cB = (const char*)g.Bt + (size_t)cur.pn * tstep;
    S.a_ready(cur);
    PG8_STAGE(PG8_SB(0, 0), cB, voffB); PG8_STAGE(PG8_SA(0, 0), cA, voffA); PG8_STAGE(PG8_SB(0, 1), cB + hstep, voffB); PG8_STAGE(PG8_SA(0, 1), cA + hstep, voffA);
    if (wr == 1) PG8_BAR;
    PG8_WAIT_V(4); PG8_BAR;
    PG8_STAGE(PG8_SB(1, 0), cB + kstep, voffB); PG8_STAGE(PG8_SA(1, 0), cA + kstep, voffA); PG8_STAGE(PG8_SB(1, 1), cB + hstep + kstep, voffB);
    PG8_WAIT_V(6); PG8_BAR;
    PG8_STAMP();
    for (;;) {
        const bool has_next = S.next(ui + 1, nxt);
        const char* nA = has_next ? (const char*)g.A + (size_t)nxt.pm * tstep : cA; const char* nB = has_next ? (const char*)g.Bt + (size_t)nxt.pn * tstep : cB;
        for (int t = 0; t < nt; t += 2) {
            const bool last = (t == nt - 2);
            const char* a1 = cA + (size_t)(t + 1) * kstep;
            const char* a2 = last ? nA : cA + (size_t)(t + 2) * kstep; const char* b2 = last ? nB : cB + (size_t)(t + 2) * kstep;
            const char* a3 = a2 + kstep; const char* b3 = b2 + kstep;
            if (last && has_next) S.a_ready(nxt);
            PG8_LDB(B0, 0, 0); PG8_SCHED; PG8_LDA(At, 0, 0); PG8_STAGE(PG8_SA(1, 1), a1 + hstep, voffA);
            PG8_WAIT_L(8); PG8_BAR; PG8_WAIT_L(0); PG8_MMA(0, 0, At, B0); PG8_BAR; PG8_SCHED;
            PG8_LDB(B1, 0, 1); PG8_STAGE(PG8_SB(0, 0), b2, voffB);
            PG8_BAR; PG8_WAIT_L(0); PG8_MMA(0, 1, At, B1); PG8_BAR;
            PG8_LDA(At, 0, 1); PG8_STAGE(PG8_SA(0, 0), a2, voffA);
            PG8_BAR; PG8_WAIT_L(0); PG8_MMA(1, 0, At, B0); PG8_BAR; PG8_SCHED;
            PG8_STAGE(PG8_SB(0, 1), b2 + hstep, voffB);
            PG8_WAIT_V(6); PG8_BAR; PG8_MMA(1, 1, At, B1); PG8_BAR;
            PG8_LDB(B0, 1, 0); PG8_SCHED; PG8_LDA(At, 1, 0); PG8_STAGE(PG8_SA(0, 1), a2 + hstep, voffA);
            PG8_WAIT_L(8); PG8_BAR; PG8_WAIT_L(0); PG8_MMA(0, 0, At, B0); PG8_BAR; PG8_SCHED;
            PG8_LDB(B1, 1, 1); PG8_STAGE(PG8_SB(1, 0), b3, voffB);
            PG8_BAR; PG8_WAIT_L(0); PG8_MMA(0, 1, At, B1); PG8_BAR;
            PG8_LDA(At, 1, 1); PG8_STAGE(PG8_SA(1, 0), a3, voffA);
            PG8_BAR; PG8_WAIT_L(0); PG8_MMA(1, 0, At, B0); PG8_BAR; PG8_SCHED;
            PG8_STAGE(PG8_SB(1, 1), b3 + hstep, voffB);
            PG8_WAIT_V(6); PG8_BAR; PG8_MMA(1, 1, At, B1); PG8_BAR;
        }
        PG8_STAMP();
        if constexpr (!Epi::AFTER_DRAIN) { E(acc, cur, wr, wc, fr, fq); S.done(cur); }
        PG8_STAMP();
        if (!has_next) break;
#pragma unroll
        for (int a = 0; a < 2; ++a)
#pragma unroll
            for (int b = 0; b < 2; ++b)
#pragma unroll
                for (int m = 0; m < 4; ++m)
#pragma unroll
                    for (int n = 0; n < 2; ++n) acc[a][b][m][n] = (f32x4){0.f, 0.f, 0.f, 0.f};
        cur = nxt; cA = nA; cB = nB; ++ui;
    }
    PG8_WAIT_V(0);
    if (wr == 0) PG8_BAR;
    PG8_BAR;
    if constexpr (Epi::AFTER_DRAIN) { E.fused(acc, cur, wr, wc, fr, fq, lds, wid, lane); S.done(cur); }
    PG8_STAMP();
    if (STAMP && wid == 0) { stamps[lane] = lane < nts ? (((unsigned long long)(unsigned)ts_hi << 32) | (unsigned)ts_lo) : 0ull;
        if (lane == 62) stamps[62] = rt_entry; if (lane == 63) stamps[63] = (unsigned long long)wall_clock64(); }
#undef PG8_STAMP
#undef PG8_SA
#undef PG8_SB
#undef PG8_STAGE
#undef PG8_LDA
#undef PG8_LDB
#undef PG8_MMA
#undef PG8_WAIT_V
#undef PG8_WAIT_L
#undef PG8_BAR
#undef PG8_SCHED
}
}

enum { EPI_IN = 0, EPI_OUT = 1, EPI_UP = 2, EPI_DOWN = 3 };
template <int MODE>
struct Epi {
  static constexpr bool PERM = true, AFTER_DRAIN = false;
  Params p; int l;
  DI void operator()(const f32x4 (&acc)[2][2][4][2], const pg8::Unit& u, int wr, int wc, int fr, int fq) const {
    const int colb = u.pn * 256 + wc * 32 + 8 * fq;
    if (MODE == EPI_OUT || MODE == EPI_DOWN) {
      float* Rb = (float*)(p.ws + W_R);
#pragma unroll
      for (int ai = 0; ai < 2; ++ai) {
        f32x4 res[4][2][2];
#pragma unroll
        for (int m = 0; m < 4; ++m) {
          const int row = u.pm * 256 + ai * 128 + wr * 64 + m * 16 + fr;
          const float* rs = (MODE == EPI_OUT ? xrow_ptr(p, l, row < M ? row : M - 1) : Rb + (size_t)(row < M ? row : M - 1) * D) + colb;
#pragma unroll
          for (int bj = 0; bj < 2; ++bj) { res[m][bj][0] = *(const f32x4*)(rs + bj * 128); res[m][bj][1] = *(const f32x4*)(rs + bj * 128 + 4); }
        }
#pragma unroll
        for (int m = 0; m < 4; ++m) {
          const int row = u.pm * 256 + ai * 128 + wr * 64 + m * 16 + fr;
          if (row < M) {
            float* R = Rb + (size_t)row * D + colb;
#pragma unroll
            for (int bj = 0; bj < 2; ++bj) {
              *(f32x4*)(R + bj * 128) = res[m][bj][0] * ALPHA + acc[ai][bj][m][0];
              *(f32x4*)(R + bj * 128 + 4) = res[m][bj][1] * ALPHA + acc[ai][bj][m][1];
            }
          }
        }
      }
      return;
    }
    f32x4 rc0[8], rc1[8];
    if (MODE == EPI_IN && (u.pn >> 2) <= 1) {
      const int d0 = (colb & 63) >> 1;
#pragma unroll
      for (int i = 0; i < 8; ++i) {
        int row = u.pm * 256 + (i >> 2) * 128 + wr * 64 + (i & 3) * 16 + fr; row = row < M ? row : M - 1;
        const int pos = row < MP ? (row & (SEQ - 1)) : PAST + ((row - MP) & 15);
        const f32x4* rp = (const f32x4*)((const float2*)(p.ws + W_ROPE) + pos * 32 + d0);
        rc0[i] = rp[0]; rc1[i] = rp[1];
      }
    }
#pragma unroll
    for (int ai = 0; ai < 2; ++ai)
#pragma unroll
      for (int m = 0; m < 4; ++m) {
        const int row = u.pm * 256 + ai * 128 + wr * 64 + m * 16 + fr;
        if (row < M) {
#pragma unroll
          for (int bj = 0; bj < 2; ++bj) {
            const int col = colb + bj * 128;
            const f32x4 v0 = acc[ai][bj][m][0], v1 = acc[ai][bj][m][1];
            if (MODE == EPI_IN) {
              bf16_t* Z = (bf16_t*)(p.ws + W_Z);
              const int seg = u.pn >> 2;
              if (seg <= 1) {
                const int d0 = (col & 63) >> 1;
                const f32x4 c01 = rc0[ai * 4 + m], c23 = rc1[ai * 4 + m];
                const float a0 = v0[0] * c01[0] - v0[1] * c01[1], b0 = v0[1] * c01[0] + v0[0] * c01[1];
                const float a1 = v0[2] * c01[2] - v0[3] * c01[3], b1 = v0[3] * c01[2] + v0[2] * c01[3];
                const float a2 = v1[0] * c23[0] - v1[1] * c23[1], b2 = v1[1] * c23[0] + v1[0] * c23[1];
                const float a3 = v1[2] * c23[2] - v1[3] * c23[3], b3 = v1[3] * c23[2] + v1[2] * c23[3];
                const float qs = seg == 0 ? 0.125f : 1.f;
                u32x4 o; o[0] = pk2(a0 * qs, b0 * qs); o[1] = pk2(a1 * qs, b1 * qs); o[2] = pk2(a2 * qs, b2 * qs); o[3] = pk2(a3 * qs, b3 * qs);
                *(u32x4*)(Z + (size_t)row * NIN + col) = o;
                if (seg == 1) {
                  float* ob = (row < MP ? p.out + O_KP + ((size_t)l * MP + row) * 1024 : p.out + O_KS + ((size_t)l * MS + row - MP) * 1024) + ((col - 1024) & ~63) + d0;
                  f32x4 o1, o2; o1[0] = a0; o1[1] = a1; o1[2] = a2; o1[3] = a3; o2[0] = b0; o2[1] = b1; o2[2] = b2; o2[3] = b3;
                  *(f32x4*)ob = o1; *(f32x4*)(ob + 32) = o2;
                }
              } else {
                u32x4 o; o[0] = pk2(v0[0], v0[1]); o[1] = pk2(v0[2], v0[3]); o[2] = pk2(v1[0], v1[1]); o[3] = pk2(v1[2], v1[3]);
                *(u32x4*)(Z + (size_t)row * NIN + col) = o;
                if (seg == 2) {
                  float* ob = (row < MP ? p.out + O_VP + ((size_t)l * MP + row) * 1024 : p.out + O_VS + ((size_t)l * MS + row - MP) * 1024) + (col - 2048);
                  *(f32x4*)ob = v0; *(f32x4*)(ob + 4) = v1;
                } else if (seg == 3 || seg == 4) {
                  float* ob = nullptr;
                  if (row < MP) { const int s = row & (SEQ - 1); if (s >= SEQ - 3) ob = p.out + O_MCP + ((size_t)(l * 4 + (row >> 13)) * 3 + (s - (SEQ - 3))) * 2048 + col - 3072; }
                  else { const int t = (row - MP) & 15, b = (row - MP) >> 4; if (t >= 13) ob = p.out + O_MCS + ((size_t)(l * 8 + b) * 3 + (t - 13)) * 2048 + col - 3072; }
                  if (ob) { *(f32x4*)ob = v0; *(f32x4*)(ob + 4) = v1; }
                }
              }
            } else if (MODE == EPI_OUT || MODE == EPI_DOWN) {
              float* R = (float*)(p.ws + W_R) + (size_t)row * D + col;
              const float* rs = MODE == EPI_OUT ? xrow_ptr(p, l, row) + col : R;
              const f32x4 r0 = *(const f32x4*)rs, r1 = *(const f32x4*)(rs + 4);
              *(f32x4*)R = r0 * ALPHA + v0; *(f32x4*)(R + 4) = r1 * ALPHA + v1;
            } else {
              bf16_t* U = (bf16_t*)(p.ws + W_Z);
              u32x4 o; o[0] = pk2(v0[0], v0[1]); o[1] = pk2(v0[2], v0[3]); o[2] = pk2(v1[0], v1[1]); o[3] = pk2(v1[2], v1[3]);
              *(u32x4*)(U + (size_t)row * NUP + col) = o;
              float* ob = nullptr;
              if (row < MP) { const int s = row & (SEQ - 1); if (s >= SEQ - 2) ob = p.out + O_FCP + ((size_t)(l * 4 + (row >> 13)) * 2 + (s - (SEQ - 2))) * NUP + col; }
              else { const int t = (row - MP) & 15, b = (row - MP) >> 4; if (t >= 14) ob = p.out + O_FCS + ((size_t)(l * 8 + b) * 2 + (t - 14)) * NUP + col; }
              if (ob) { *(f32x4*)ob = v0; *(f32x4*)(ob + 4) = v1; }
            }
          }
        }
      }
  }
};

template <int MODE>
DI void gemm_phase(const Params& p, int l, const bf16_t* A, int lda, const bf16_t* Bt, int K, int ntn, char* lds) {
  (void)lda;
  pg8::Gemm g; g.A = A; g.Bt = Bt; g.M = ((MODE == EPI_OUT || MODE == EPI_DOWN) ? NTM - 1 : NTM) * 256; g.N = ntn * 256; g.K = K;
  if (MODE == EPI_OUT || MODE == EPI_DOWN) sample_gemm<MODE>(p, l, A, Bt, K);
  pg8::StaticOrder S; S.init(g.M, g.N, (int)gridDim.x, (int)blockIdx.x);
  Epi<MODE> E; E.p = p; E.l = l;
  pg8::gemm_phase<Epi<MODE>, pg8::StaticOrder, false>((PG8_LAS unsigned char*)lds, g, S, E, nullptr);
  __syncthreads();
}

typedef float f32x4v __attribute__((ext_vector_type(4)));
template <int MODE>
DI void sample_gemm(const Params& p, int l, const bf16_t* A, const bf16_t* Bt, int K) {
  if (blockIdx.x >= 64) return;
  const int tid = otid(), lane = tid & 63, wave = uni(tid >> 6), fr = lane & 15, fq = lane >> 4;
  const bf16_t* ap = A + (size_t)(MP + wave * 16 + fr) * K + fq * 8;
  const bf16_t* bp = Bt + (size_t)(blockIdx.x * 16 + fr) * K + fq * 8;
  f32x4v acc0 = {0.f, 0.f, 0.f, 0.f}, acc1 = {0.f, 0.f, 0.f, 0.f};
  for (int k0 = 0; k0 < K; k0 += 256) {
    bf16x8 a[8], bb[8];
#pragma unroll
    for (int i = 0; i < 8; ++i) { a[i] = *(const bf16x8*)(ap + k0 + i * 32); bb[i] = *(const bf16x8*)(bp + k0 + i * 32); }
#pragma unroll
    for (int i = 0; i < 8; i += 2) {
      acc0 = __builtin_amdgcn_mfma_f32_16x16x32_bf16(a[i], bb[i], acc0, 0, 0, 0);
      acc1 = __builtin_amdgcn_mfma_f32_16x16x32_bf16(a[i + 1], bb[i + 1], acc1, 0, 0, 0);
    }
  }
  const int col = blockIdx.x * 16 + fr;
  float* R = (float*)(p.ws + W_R);
#pragma unroll
  for (int j = 0; j < 4; ++j) {
    const int row = MP + wave * 16 + fq * 4 + j;
    const float res = MODE == EPI_OUT ? xrow_ptr(p, l, row)[col] : R[(size_t)row * D + col];
    R[(size_t)row * D + col] = ALPHA * res + (acc0[j] + acc1[j]);
  }
}

DI void gif_phase(const Params& p, int l, char* lds, int first_blk) {
  if ((int)blockIdx.x < first_blk) return;
  const int tidq = otid(); const int lane = tidq & 63, gw = ((int)blockIdx.x - first_blk) * 8 + (tidq >> 6), ngw = ((int)gridDim.x - first_blk) * 8;
  const float* w = p.in[9] + (size_t)l * D * DIN + 7168;
  const float* bif = p.in[10] + l * 8;
  float* gif = (float*)(p.ws + W_GIF);
  float* w8 = (float*)lds;
  __syncthreads();
#pragma unroll
  for (int i = 0; i < 2; ++i) {
    const int k = tidq + 512 * i;
    *(f32x4*)(w8 + k * 8) = *(const f32x4*)(w + (size_t)k * DIN); *(f32x4*)(w8 + k * 8 + 4) = *(const f32x4*)(w + (size_t)k * DIN + 4);
  }
  __syncthreads();
  for (int rg = gw; rg < M / 4; rg += ngw) {
    float acc[4][8];
#pragma unroll
    for (int a = 0; a < 4; ++a)
#pragma unroll
      for (int j = 0; j < 8; ++j) acc[a][j] = 0.f;
    const float* x0 = xrow_ptr(p, l, rg * 4);
#pragma unroll 4
    for (int kk = 0; kk < 16; ++kk) {
      const int k = kk * 64 + lane;
      const f32x4 w0 = *(const f32x4*)(w8 + k * 8), w1 = *(const f32x4*)(w8 + k * 8 + 4);
#pragma unroll
      for (int a = 0; a < 4; ++a) {
        const float xv = x0[(size_t)a * D + k];
        acc[a][0] += xv * w0[0]; acc[a][1] += xv * w0[1]; acc[a][2] += xv * w0[2]; acc[a][3] += xv * w0[3];
        acc[a][4] += xv * w1[0]; acc[a][5] += xv * w1[1]; acc[a][6] += xv * w1[2]; acc[a][7] += xv * w1[3];
      }
    }
#pragma unroll
    for (int a = 0; a < 4; ++a)
#pragma unroll
      for (int j = 0; j < 8; ++j) {
        const float s = wave_sum(acc[a][j]);
        if (lane == 0) gif[(size_t)(rg * 4 + a) * 8 + j] = s + bif[j];
      }
  }
  __syncthreads();
}

DI void qkconv_phase(const Params& p, int l) {
  const bf16_t* Z = (const bf16_t*)(p.ws + W_Z);
  bf16_t* QA = (bf16_t*)(p.ws + W_AB); bf16_t* KA = (bf16_t*)(p.ws + W_KA);
  const float* cw = p.in[11] + (size_t)l * 4 * 2048; const float* cb = p.in[12] + (size_t)l * 2048;
  constexpr int RG = 8;
  const size_t total = (size_t)(M / RG) * 256;
  for (size_t it = (size_t)blockIdx.x * NTH + otid(); it < total; it += (size_t)gridDim.x * NTH) {
    const int cc = (int)(it & 255), rg = (int)(it >> 8), col = cc * 8, row0 = rg * RG;
    int t0, hist_rows;
    const float* st = nullptr;
    if (row0 < MP) { t0 = row0 & (SEQ - 1); }
    else { t0 = (row0 - MP) & 15; st = p.in[4] + ((size_t)(l * 8 + ((row0 - MP) >> 4)) * 3) * 2048 + col; }
    (void)hist_rows;
    float w[4][8], bias[8];
#pragma unroll
    for (int j = 0; j < 4; ++j) { f32x4 a = *(const f32x4*)(cw + j * 2048 + col), b = *(const f32x4*)(cw + j * 2048 + col + 4);
      w[j][0] = a[0]; w[j][1] = a[1]; w[j][2] = a[2]; w[j][3] = a[3]; w[j][4] = b[0]; w[j][5] = b[1]; w[j][6] = b[2]; w[j][7] = b[3]; }
    { f32x4 a = *(const f32x4*)(cb + col), b = *(const f32x4*)(cb + col + 4);
      bias[0] = a[0]; bias[1] = a[1]; bias[2] = a[2]; bias[3] = a[3]; bias[4] = b[0]; bias[5] = b[1]; bias[6] = b[2]; bias[7] = b[3]; }
    float x[RG + 3][8];
#pragma unroll
    for (int j = 0; j < RG + 3; ++j) {
      const int t = t0 - 3 + j;
      if (t >= 0) { u32x4 v = *(const u32x4*)(Z + (size_t)(row0 - 3 + j) * NIN + 3072 + col); unpack8(v, x[j]); }
      else if (st) { f32x4 a = *(const f32x4*)(st + (size_t)(3 + t) * 2048), b = *(const f32x4*)(st + (size_t)(3 + t) * 2048 + 4);
        x[j][0] = a[0]; x[j][1] = a[1]; x[j][2] = a[2]; x[j][3] = a[3]; x[j][4] = b[0]; x[j][5] = b[1]; x[j][6] = b[2]; x[j][7] = b[3]; }
      else {
#pragma unroll
        for (int e = 0; e < 8; ++e) x[j][e] = 0.f; }
    }
    const float sc = col >= 1024 ? 0.0625f : 1.f;
    bf16_t* dst = col >= 1024 ? KA + (col - 1024) : QA + col;
#pragma unroll
    for (int a = 0; a < RG; ++a) {
      float o[8];
#pragma unroll
      for (int e = 0; e < 8; ++e) {
        float u = bias[e] + w[0][e] * x[a][e] + w[1][e] * x[a + 1][e] + w[2][e] * x[a + 2][e] + w[3][e] * x[a + 3][e];
        o[e] = u * sigmoidf_(u) * sc;
      }
      u32x4 ov; ov[0] = pk2(o[0], o[1]); ov[1] = pk2(o[2], o[3]); ov[2] = pk2(o[4], o[5]); ov[3] = pk2(o[6], o[7]);
      *(u32x4*)(dst + (size_t)(row0 + a) * D) = ov;
    }
  }
}

constexpr int A_LD = 272;
constexpr int A_TILE = 64 * A_LD;
constexpr int A_VLD = 320;
constexpr int A_VTILE = 64 * A_VLD;
template <int KIND>
DI void attn_item(const Params& p, int l, int b, int ha, int qb, char* lds) {
  const int tid = otid(), lane = tid & 63, wave = uni(tid >> 6);
  const int map = wave >> 2, qt = wave & 3, r = lane & 31, h = lane >> 5;
  const bf16_t* Z = (const bf16_t*)(p.ws + W_Z);
  const int NT = KIND == 0 ? 2 * (qb + 1) : (NKS + 63) / 64;
  const int ntw = KIND == 0 ? 2 * qb + (qt >> 1) + 1 : NT;
  const bool active = KIND == 0 ? true : (qt == 0);
  int qrow;
  if (KIND == 0) qrow = b * SEQ + qb * 128 + qt * 32 + r; else qrow = MP + b * 16 + (r < 16 ? r : 15);
  bf16x8 qf[4];
#pragma unroll
  for (int ks = 0; ks < 4; ++ks) {
    if (KIND == 0) qf[ks] = *(const bf16x8*)(Z + (size_t)qrow * NIN + ha * 128 + map * 64 + ks * 16 + h * 8);
    else {
      const int dn = ks * 16 + h * 8, par = dn >> 5, dd = dn & 31;
      const bf16_t* src = Z + (size_t)qrow * NIN + ha * 128 + map * 64 + 2 * dd;
      const u32x4 lo = *(const u32x4*)src, hi = *(const u32x4*)(src + 8);
      unsigned e[8];
#pragma unroll
      for (int i = 0; i < 4; ++i) { e[i] = par ? (lo[i] >> 16) : (lo[i] & 0xffffu); e[4 + i] = par ? (hi[i] >> 16) : (hi[i] & 0xffffu); }
      u32x4 o; o[0] = e[0] | (e[1] << 16); o[1] = e[2] | (e[3] << 16); o[2] = e[4] | (e[5] << 16); o[3] = e[6] | (e[7] << 16);
      qf[ks] = __builtin_bit_cast(bf16x8, o);
    }
  }
  const int skey = tid >> 4, part = tid & 15;
  u32x4 rk0, rk1, rv0, rv1;
  auto gload = [&](int j) {
    if (KIND == 0) {
      const bf16_t* base = Z + (size_t)(b * SEQ + j * 64 + skey) * NIN + 1024 + ha * 128 + part * 8;
      rk0 = *(const u32x4*)base; rk1 = *(const u32x4*)(base + (size_t)32 * NIN);
      rv0 = *(const u32x4*)(base + 1024); rv1 = *(const u32x4*)(base + (size_t)32 * NIN + 1024);
    } else {
#pragma unroll
      for (int i = 0; i < 2; ++i) {
        int kk = j * 64 + skey + 32 * i; if (kk > NKS - 1) kk = NKS - 1;
        const float *ks_, *vs_;
        if (kk < PAST) { const size_t o = (((size_t)(l * 8 + b) * PAST + kk) * 8 + ha) * 128 + part * 8; ks_ = p.in[2] + o; vs_ = p.in[3] + o; }
        else { const size_t o = (((size_t)l * MS + b * 16 + (kk - PAST)) * 8 + ha) * 128 + part * 8; ks_ = p.out + O_KS + o; vs_ = p.out + O_VS + o; }
        const f32x4 a0 = *(const f32x4*)ks_, a1 = *(const f32x4*)(ks_ + 4), c0 = *(const f32x4*)vs_, c1 = *(const f32x4*)(vs_ + 4);
        u32x4 ko, vo;
        ko[0] = pk2(a0[0], a0[1]); ko[1] = pk2(a0[2], a0[3]); ko[2] = pk2(a1[0], a1[1]); ko[3] = pk2(a1[2], a1[3]);
        vo[0] = pk2(c0[0], c0[1]); vo[1] = pk2(c0[2], c0[3]); vo[2] = pk2(c1[0], c1[1]); vo[3] = pk2(c1[2], c1[3]);
        if (i == 0) { rk0 = ko; rv0 = vo; } else { rk1 = ko; rv1 = vo; }
      }
    }
  };
  f32x16 O[4];
#pragma unroll
  for (int v = 0; v < 4; ++v)
#pragma unroll
    for (int i = 0; i < 16; ++i) O[v][i] = 0.f;
  float m_run = -1e30f, l_run = 0.f;
  const int q4 = (lane & 15) >> 2, p4 = lane & 3, blk = (lane >> 4) & 1;
  const unsigned sofs = skey * A_LD + part * 16, vofs = skey * A_VLD + part * 16;
  auto qk = [&](int j, f32x16 (&st)[2]) {
    const char* kb = lds + (j & 1) * A_TILE;
#pragma unroll
    for (int kt = 0; kt < 2; ++kt) {
#pragma unroll
      for (int i = 0; i < 16; ++i) st[kt][i] = 0.f;
#pragma unroll
      for (int ks = 0; ks < 4; ++ks) {
        const bf16x8 kf = *(const bf16x8*)(kb + (kt * 32 + r) * A_LD + (map * 64 + ks * 16 + h * 8) * 2);
        st[kt] = MFMA32(kf, qf[ks], st[kt]);
      }
    }
    if (KIND == 1 && j == NT - 1) {
#pragma unroll
      for (int kt = 0; kt < 2; ++kt)
#pragma unroll
        for (int i = 0; i < 16; ++i) if (j * 64 + kt * 32 + crow(i, h) >= NKS) st[kt][i] = -1e30f;
    }
  };
  bf16x8 pk[4];
  auto smax = [&](int j, f32x16 (&sc)[2], f32x16 (&sn)[2]) {
    if (j + 1 < ntw) qk(j + 1, sn);
    float mx = sc[0][0];
#pragma unroll
    for (int kt = 0; kt < 2; ++kt)
#pragma unroll
      for (int i = 0; i < 16; ++i) mx = fmaxf(mx, sc[kt][i]);
    mx = fmaxf(mx, __shfl_xor(mx, 32));
    const float m_new = fmaxf(m_run, mx);
    const float alpha = __builtin_amdgcn_exp2f((m_run - m_new) * LOG2E);
    const float mb = m_new * LOG2E;
    float rs = 0.f;
#pragma unroll
    for (int kt = 0; kt < 2; ++kt)
#pragma unroll
      for (int i = 0; i < 16; ++i) { const float e = __builtin_amdgcn_exp2f(sc[kt][i] * LOG2E - mb); sc[kt][i] = e; rs += e; }
    rs += __shfl_xor(rs, 32);
    l_run = l_run * alpha + rs; m_run = m_new;
    if (__builtin_amdgcn_ballot_w64(alpha != 1.f) != 0ull) {
#pragma unroll
      for (int v = 0; v < 4; ++v)
#pragma unroll
        for (int i = 0; i < 16; ++i) O[v][i] *= alpha;
    }
    pk[0] = pack8(sc[0], 0); pk[1] = pack8(sc[0], 1); pk[2] = pack8(sc[1], 0); pk[3] = pack8(sc[1], 1);
  };
  auto pv = [&](int j) {
    const unsigned vaddr = lds_addr(lds + 2 * A_TILE + (j % 3) * A_VTILE) + (4 * h + q4) * A_VLD + (16 * blk + 4 * p4) * 2;
#pragma unroll
    for (int vt = 0; vt < 4; ++vt) {
      bf16x8 vf[4];
      tr_frag4<16 * A_VLD, 8 * A_VLD>(vaddr + vt * 64, vf);
#pragma unroll
      for (int ks = 0; ks < 4; ++ks) O[vt] = MFMA32(vf[ks], pk[ks], O[vt]);
    }
  };
  gload(0);
  { char* kb = lds + sofs; *(u32x4*)kb = rk0; *(u32x4*)(kb + 32 * A_LD) = rk1; char* vb = lds + 2 * A_TILE + vofs; *(u32x4*)vb = rv0; *(u32x4*)(vb + 32 * A_VLD) = rv1; }
  gload(1);
  { char* kb = lds + A_TILE + sofs; *(u32x4*)kb = rk0; *(u32x4*)(kb + 32 * A_LD) = rk1; }
  __syncthreads();
  f32x16 sA[2], sB[2];
  if (active && 0 < ntw) qk(0, sA);
  for (int j = 0; j < NT; j += 2) {
#pragma unroll
    for (int u = 0; u < 2; ++u) {
      const int jj = j + u;
      if (jj < NT) {
        if (jj + 1 < NT) { char* vb = lds + 2 * A_TILE + ((jj + 1) % 3) * A_VTILE + vofs; *(u32x4*)vb = rv0; *(u32x4*)(vb + 32 * A_VLD) = rv1; }
        if (jj + 2 < NT) gload(jj + 2);
        if (active) {
          if (map == 1 && jj >= 1 && jj - 1 < ntw) pv(jj - 1);
          if (jj < ntw) { if (u == 0) smax(jj, sA, sB); else smax(jj, sB, sA); }
          if (map == 0 && jj < ntw) pv(jj);
        }
        if (jj + 2 < NT) { char* kb = lds + (jj & 1) * A_TILE + sofs; *(u32x4*)kb = rk0; *(u32x4*)(kb + 32 * A_LD) = rk1; }
        __syncthreads();
      }
    }
  }
  if (active && map == 1 && ntw == NT) pv(NT - 1);
  __syncthreads();
  float* ex = (float*)lds;
  const float inv_l = 1.f / l_run;
  if (map == 1) {
#pragma unroll
    for (int vt = 0; vt < 4; ++vt)
#pragma unroll
      for (int g = 0; g < 4; ++g) {
        f32x4 o; o[0] = O[vt][4 * g] * inv_l; o[1] = O[vt][4 * g + 1] * inv_l; o[2] = O[vt][4 * g + 2] * inv_l; o[3] = O[vt][4 * g + 3] * inv_l;
        *(f32x4*)(ex + (qt * 32 + r) * 132 + vt * 32 + 8 * g + 4 * h) = o;
      }
  }
  __syncthreads();
  if (map == 0) {
    const float lam = ((const float*)(p.ws + W_MISC))[l];
    const float lam_init = (l == 0) ? 0.2f : (0.8f - 0.6f * 0.74081822068171788f);
    float ssq = 0.f;
#pragma unroll
    for (int vt = 0; vt < 4; ++vt)
#pragma unroll
      for (int g = 0; g < 4; ++g) {
        const f32x4 o2 = *(const f32x4*)(ex + (qt * 32 + r) * 132 + vt * 32 + 8 * g + 4 * h);
#pragma unroll
        for (int e = 0; e < 4; ++e) { const float o = O[vt][4 * g + e] * inv_l - lam * o2[e]; O[vt][4 * g + e] = o; ssq += o * o; }
      }
    ssq += __shfl_xor(ssq, 32);
    const float rms = rsqrtf(ssq * (1.f / 128.f) + LN_EPS) * (1.f - lam_init);
    const float* sg = p.in[14] + l * 128;
    const bool valid = KIND == 0 ? true : (qt == 0 && r < 16);
    if (valid) {
      bf16_t* dst = (bf16_t*)(p.ws + W_Z) + (size_t)qrow * NIN + 3072 + ha * 128;
#pragma unroll
      for (int vt = 0; vt < 4; ++vt)
#pragma unroll
        for (int g = 0; g < 4; ++g) {
          const int v0 = vt * 32 + 8 * g + 4 * h;
          const f32x4 gg = *(const f32x4*)(sg + v0);
          u32x2 o; o[0] = pk2(O[vt][4 * g] * rms * gg[0], O[vt][4 * g + 1] * rms * gg[1]); o[1] = pk2(O[vt][4 * g + 2] * rms * gg[2], O[vt][4 * g + 3] * rms * gg[3]);
          *(u32x2*)(dst + v0) = o;
        }
    }
  }
  __syncthreads();
}

constexpr int L_LD = 528;
constexpr int L_VLD = 320;
constexpr int L_Q = 0, L_K = 64 * L_LD, L_V = 2 * 64 * L_LD, L_SW = L_V + 64 * L_VLD;
constexpr int L_SWLD = 144;
constexpr int L_SC = L_SW + 64 * L_SWLD;
constexpr int S_MX = 0, S_G = 64, S_EMT = 128, S_DS0 = 192, S_DS1 = 256, S_QN = 320  , S_NV = 576  , S_GEND = 832, S_PAR = 840;
constexpr int LDS_BYTES = 153376;
static_assert(L_SC + 2 * S_PAR * 4 <= 131072, "lds");
#define WG_BAR() do { __builtin_amdgcn_fence(__ATOMIC_RELEASE, "workgroup"); __builtin_amdgcn_s_barrier(); __builtin_amdgcn_fence(__ATOMIC_ACQUIRE, "workgroup"); } while (0)

template <int KIND>
DI void mlstm_item(const Params& p, int l, int b, int hm, int half, char* lds) {
  const int tid0 = otid(), wave = uni(tid0 >> 6);
  const bf16_t* QA = (const bf16_t*)(p.ws + W_AB); const bf16_t* KA = (const bf16_t*)(p.ws + W_KA);
  const bf16_t* Z = (const bf16_t*)(p.ws + W_Z); bf16_t* H = (bf16_t*)(p.ws + W_H);
  const float* GIF = (const float*)(p.ws + W_GIF);
  float* scb = (float*)(lds + L_SC);
  int nchunks = KIND == 0 ? SEQ / 64 : 1; asm volatile("" : "+s"(nchunks));
  const int Lv = KIND == 0 ? 64 : 16;
  const size_t bh = KIND == 0 ? (size_t)(l * 4 + b) * 4 + hm : (size_t)(l * 8 + b) * 4 + hm;
  if (wave < 4) {
    f32x16 C[8];
    { const int lane = tid0 & 63, r = lane & 31, h = lane >> 5; (void)r; (void)h;
      if (KIND == 0) {
#pragma unroll
        for (int d = 0; d < 8; ++d)
#pragma unroll
          for (int i = 0; i < 16; ++i) C[d][i] = 0.f;
      } else {
        const float* cp = p.in[5] + bh * 65536 + (size_t)(4 * h) * 256 + half * 128 + wave * 32 + r;
#pragma unroll
        for (int d = 0; d < 8; ++d)
#pragma unroll
          for (int g = 0; g < 4; ++g) {
            C[d][4 * g] = cp[0]; C[d][4 * g + 1] = cp[256]; C[d][4 * g + 2] = cp[512]; C[d][4 * g + 3] = cp[768];
            cp += 2048; asm volatile("" : "+v"(cp));
          }
      }
    }
    for (int c = 0; c < nchunks; ++c) {
      int tid = tid0; asm volatile("" : "+v"(tid));
      const int lane = tid & 63, r = lane & 31, h = lane >> 5;
      const int q4 = (lane & 15) >> 2, p4 = lane & 3, blk = (lane >> 4) & 1;
      const float* sc = scb + (c & 1) * S_PAR;
      const int rowbase = KIND == 0 ? b * SEQ + c * 64 : MP + b * 16;
      WG_BAR();
      f32x16 accB[2];
#pragma unroll
      for (int tt = 0; tt < 2; ++tt)
#pragma unroll
        for (int i = 0; i < 16; ++i) accB[tt][i] = 0.f;
#pragma unroll
      for (int d = 0; d < 8; ++d)
#pragma unroll
        for (int s = 0; s < 2; ++s) {
          __builtin_amdgcn_sched_barrier(0);
          const bf16x8 cf = pack8(C[d], s);
#pragma unroll
          for (int tt = 0; tt < 2; ++tt) {
            const char* qp = lds + L_Q + (tt * 32 + r) * L_LD + (d * 32 + 16 * s + 4 * h) * 2;
            const s16x4 lo = *(const s16x4*)qp, hi = *(const s16x4*)(qp + 16);
            const bf16x8 qfr = __builtin_shufflevector(lo, hi, 0, 1, 2, 3, 4, 5, 6, 7);
            accB[tt] = MFMA32(cf, qfr, accB[tt]);
          }
        }
      __builtin_amdgcn_sched_barrier(0);
      bf16x8 vf[4];
      tr_frag4<16 * L_VLD, 4 * L_VLD>(lds_addr(lds + L_V) + (8 * h + q4) * L_VLD + (wave * 32 + 16 * blk + 4 * p4) * 2, vf);
      const float g_end = sc[S_GEND];
#pragma unroll
      for (int d = 0; d < 8; ++d) {
#pragma unroll
        for (int i = 0; i < 16; ++i) C[d][i] *= g_end;
        bf16x8 kf[4];
        tr_frag4<16 * L_LD, 4 * L_LD>(lds_addr(lds + L_K) + (8 * h + q4) * L_LD + (d * 32 + 16 * blk + 4 * p4) * 2, kf);
#pragma unroll
        for (int ks = 0; ks < 4; ++ks) C[d] = MFMA32(kf[ks], vf[ks], C[d]);
      }
      WG_BAR();
#pragma unroll
      for (int tt = 0; tt < 2; ++tt) {
        const int t = tt * 32 + r;
        const float g = sc[S_G + t];
#pragma unroll
        for (int i = 0; i < 16; ++i) accB[tt][i] *= g;
        const char* sp = lds + L_SW + (tt * 32 + r) * L_SWLD + h * 16;
#pragma unroll
        for (int ks = 0; ks < 4; ++ks) accB[tt] = MFMA32(vf[ks], *(const bf16x8*)(sp + ks * 32), accB[tt]);
        const float qn = (sc[S_QN + t] + sc[S_QN + 64 + t]) + (sc[S_QN + 128 + t] + sc[S_QN + 192 + t]);
        float den = sc[S_DS0 + t] + sc[S_DS1 + t] + g * qn;
        den = fmaxf(fabsf(den), sc[S_EMT + t]);
        const float rden = 1.f / den;
        if (t < Lv) {
          bf16_t* dst = H + (size_t)(rowbase + t) * D + hm * 256 + half * 128 + wave * 32;
#pragma unroll
          for (int g4 = 0; g4 < 4; ++g4) {
            u32x2 o; o[0] = pk2(accB[tt][4 * g4] * rden, accB[tt][4 * g4 + 1] * rden); o[1] = pk2(accB[tt][4 * g4 + 2] * rden, accB[tt][4 * g4 + 3] * rden);
            *(u32x2*)(dst + 8 * g4 + 4 * h) = o;
          }
        }
      }
    }
    WG_BAR();
    {
      const int lane = tid0 & 63, r = lane & 31, h = lane >> 5;
      float* co = p.out + (KIND == 0 ? O_CP : O_CS) + bh * 65536 + (size_t)(4 * h) * 256 + half * 128 + wave * 32 + r;
#pragma unroll
      for (int d = 0; d < 8; ++d)
#pragma unroll
        for (int g = 0; g < 4; ++g) {
          co[0] = C[d][4 * g]; co[256] = C[d][4 * g + 1]; co[512] = C[d][4 * g + 2]; co[768] = C[d][4 * g + 3];
          co += 2048; asm volatile("" : "+v"(co));
        }
    }
  } else {
    const int hw = wave - 4;
    float nreg = 0.f, m_prev = 0.f;
    if (KIND == 1) { nreg = p.in[6][bh * 256 + (tid0 - 256)]; m_prev = p.in[7][bh]; }
    u32x4 pq[8], pk[8], pv[4];
    float gi = 0.f, gf = 0.f, g_end_cur = 0.f;
    auto issue_loads = [&](int c, int tid) {
      const int ht = tid - 256, lane = tid & 63;
      const int rowbase = KIND == 0 ? b * SEQ + c * 64 : MP + b * 16;
      const bool tvalid = lane < Lv;
      gi = tvalid ? GIF[(size_t)(rowbase + lane) * 8 + hm] : -1e30f;
      gf = tvalid ? GIF[(size_t)(rowbase + lane) * 8 + 4 + hm] : 0.f;
#pragma unroll
      for (int i = 0; i < 8; ++i) {
        const int cidx = ht + 256 * i, t = cidx >> 5, pc = cidx & 31;
        const int row = rowbase + (t < Lv ? t : Lv - 1);
        pq[i] = *(const u32x4*)(QA + (size_t)row * D + hm * 256 + pc * 8);
        pk[i] = *(const u32x4*)(KA + (size_t)row * D + hm * 256 + pc * 8);
      }
#pragma unroll
      for (int i = 0; i < 4; ++i) {
        const int cidx = ht + 256 * i, t = cidx >> 4, pc = cidx & 15;
        const int row = rowbase + (t < Lv ? t : Lv - 1);
        pv[i] = *(const u32x4*)(Z + (size_t)row * NIN + 5120 + hm * 256 + half * 128 + pc * 8);
      }
    };
    auto scalars = [&](int par, int lane) -> float {
      const bool tvalid = lane < Lv;
      const float lf = tvalid ? (fminf(gf, 0.f) - __logf(1.f + __expf(-fabsf(gf)))) : 0.f;
      float bc = lf;
#pragma unroll
      for (int o = 1; o < 64; o <<= 1) { const float v = __shfl_up(bc, o); if (lane >= o) bc += v; }
      const float a = gi - bc;
      float cm = a;
#pragma unroll
      for (int o = 1; o < 64; o <<= 1) { const float v = __shfl_up(cm, o); if (lane >= o) cm = fmaxf(cm, v); }
      const float mxv = fmaxf(m_prev, cm);
      const float m_t = bc + mxv;
      const float mx_end = __shfl(mxv, 63), bc_end = __shfl(bc, 63);
      const float wend = __expf(a - mx_end);
      g_end_cur = __expf(m_prev - mx_end);
      if (hw == 0) {
        float* sc = scb + par * S_PAR;
        sc[S_MX + lane] = __expf(mx_end - mxv);
        sc[S_G + lane] = __expf(m_prev - mxv);
        sc[S_EMT + lane] = __expf(-m_t);
        if (lane == 0) sc[S_GEND] = g_end_cur;
      }
      m_prev = bc_end + mx_end;
      return wend;
    };
    auto stage_lds = [&](float wend_l, int tid) {
      const int ht = tid - 256;
#pragma unroll
      for (int i = 0; i < 8; ++i) {
        const int cidx = ht + 256 * i, t = cidx >> 5, pc = cidx & 31;
        const float we = __shfl(wend_l, t);
        float f[8]; unpack8(pk[i], f);
        u32x4 o; o[0] = pk2(f[0] * we, f[1] * we); o[1] = pk2(f[2] * we, f[3] * we); o[2] = pk2(f[4] * we, f[5] * we); o[3] = pk2(f[6] * we, f[7] * we);
        *(u32x4*)(lds + L_Q + t * L_LD + pc * 16) = pq[i];
        *(u32x4*)(lds + L_K + t * L_LD + pc * 16) = o;
      }
#pragma unroll
      for (int i = 0; i < 4; ++i) {
        const int cidx = ht + 256 * i, t = cidx >> 4, pc = cidx & 15;
        *(u32x4*)(lds + L_V + t * L_VLD + pc * 16) = pv[i];
      }
    };
    {
      int tid = tid0; asm volatile("" : "+v"(tid));
      issue_loads(0, tid);
      scb[S_NV + (tid - 256)] = nreg;
      const float wend = scalars(0, tid & 63);
      stage_lds(wend, tid);
    }
    for (int c = 0; c < nchunks; ++c) {
      int tid = tid0; asm volatile("" : "+v"(tid));
      const int ht = tid - 256, lane = tid & 63, r = lane & 31, h = lane >> 5;
      float* sc = scb + (c & 1) * S_PAR;
      float* scn = scb + ((c + 1) & 1) * S_PAR;
      const float g_end_c = g_end_cur;
      WG_BAR();
      const bool more = c + 1 < nchunks;
      if (more) issue_loads(c + 1, tid);
      {
        const int t = ht & 63, part = ht >> 6;
        const char* qp = lds + L_Q + t * L_LD + part * 128;
        float s = 0.f;
#pragma unroll
        for (int e = 0; e < 8; ++e) {
          const u32x4 qq = *(const u32x4*)(qp + e * 16); float f[8]; unpack8(qq, f);
#pragma unroll
          for (int z = 0; z < 8; ++z) s += f[z] * sc[S_NV + part * 64 + e * 8 + z];
        }
        sc[S_QN + part * 64 + t] = s;
      }
      if (hw < 3) {
        const int stl = hw == 2 ? 1 : 0, tt = hw == 0 ? 0 : 1;
        f32x16 S, S2;
#pragma unroll
        for (int i = 0; i < 16; ++i) { S[i] = 0.f; S2[i] = 0.f; }
        const char* ka = lds + L_K + (stl * 32 + r) * L_LD + h * 16;
        const char* qa = lds + L_Q + (tt * 32 + r) * L_LD + h * 16;
#pragma unroll 4
        for (int ks = 0; ks < 16; ks += 2) {
          S = MFMA32(*(const bf16x8*)(ka + ks * 32), *(const bf16x8*)(qa + ks * 32), S);
          S2 = MFMA32(*(const bf16x8*)(ka + ks * 32 + 32), *(const bf16x8*)(qa + ks * 32 + 32), S2);
        }
        const int t = tt * 32 + r;
        const float cw = sc[S_MX + t];
        float rs = 0.f;
#pragma unroll
        for (int g = 0; g < 4; ++g) {
          float wv[4];
#pragma unroll
          for (int e = 0; e < 4; ++e) {
            const int s = stl * 32 + 8 * g + 4 * h + e;
            wv[e] = s <= t ? (S[4 * g + e] + S2[4 * g + e]) * cw : 0.f; rs += wv[e];
          }
          u32x2 o; o[0] = pk2(wv[0], wv[1]); o[1] = pk2(wv[2], wv[3]);
          *(u32x2*)(lds + L_SW + t * L_SWLD + (stl * 32 + 8 * g + 4 * h) * 2) = o;
        }
        rs += __shfl_xor(rs, 32);
        if (h == 0) {
          if (hw == 0) { sc[S_DS0 + t] = rs; sc[S_DS1 + t] = 0.f; }
          else if (hw == 1) sc[S_DS0 + t] = rs;
          else sc[S_DS1 + t] = rs;
        }
      } else {
        const int t = lane >> 1, hs = lane & 1;
        u32x4 z; z[0] = 0; z[1] = 0; z[2] = 0; z[3] = 0;
        *(u32x4*)(lds + L_SW + t * L_SWLD + 64 + hs * 32) = z; *(u32x4*)(lds + L_SW + t * L_SWLD + 64 + hs * 32 + 16) = z;
      }
      {
        float s0 = 0.f, s1 = 0.f, s2 = 0.f, s3 = 0.f;
        const char* kp = lds + L_K + ht * 2;
#pragma unroll
        for (int t = 0; t < 64; t += 4) {
          s0 += bflo((unsigned)*(const bf16_t*)(kp + t * L_LD)); s1 += bflo((unsigned)*(const bf16_t*)(kp + (t + 1) * L_LD));
          s2 += bflo((unsigned)*(const bf16_t*)(kp + (t + 2) * L_LD)); s3 += bflo((unsigned)*(const bf16_t*)(kp + (t + 3) * L_LD));
        }
        nreg = g_end_c * nreg + ((s0 + s1) + (s2 + s3));
        scn[S_NV + ht] = nreg;
      }
      float wend = 0.f;
      if (more) wend = scalars((c + 1) & 1, lane);
      WG_BAR();
      if (more) stage_lds(wend, tid);
    }
    WG_BAR();
    if (half == 0) {
      p.out[(KIND == 0 ? O_NP : O_NS) + bh * 256 + (tid0 - 256)] = nreg;
      if (tid0 == 256) p.out[(KIND == 0 ? O_MPP : O_MSS) + bh] = m_prev;
    }
  }
}

DI void mixer_phase(const Params& p, int l, char* lds, int cidx, bool ml_only) {
  unsigned* ctr = (unsigned*)(p.ws + W_MISC) + 16 + cidx;
  int* s_item = (int*)(lds + LDS_BYTES - 16);
  const int total = 32 + 64 + 64 + 2048;
  for (;;) {
    __syncthreads();
    if (threadIdx.x == 0) *s_item = (int)atomicAdd(ctr, 1u);
    __syncthreads();
    const int it = *s_item;
    __syncthreads();
    if (it >= total) break;
    if (ml_only && it >= 96) break;
    if (it < 32) { mlstm_item<0>(p, l, it >> 3, (it >> 1) & 3, it & 1, lds); continue; }
    if (it < 96) { const int x = it - 32; mlstm_item<1>(p, l, x >> 3, (x >> 1) & 3, x & 1, lds); continue; }
    if (it < 160) { attn_item<1>(p, l, (it - 96) >> 3, (it - 96) & 7, 0, lds); continue; }
    { const int x = it - 160; attn_item<0>(p, l, (x & 31) >> 3, x & 7, 63 - (x >> 5), lds); }
  }
}

DI void merge_phase(const Params& p, int l) {
  const bf16_t* Z = (const bf16_t*)(p.ws + W_Z); const bf16_t* H = (const bf16_t*)(p.ws + W_H); bf16_t* Y = (bf16_t*)(p.ws + W_AB);
  const int tidq = otid(); const int lane = tidq & 63, gw = blockIdx.x * 8 + (tidq >> 6), ngw = gridDim.x * 8;
  const int col = lane * 16;
  float mg[16];
  { const float* mhg = p.in[15] + (size_t)l * D + col;
#pragma unroll
    for (int i = 0; i < 4; ++i) { const f32x4 g = *(const f32x4*)(mhg + 4 * i); mg[4 * i] = g[0]; mg[4 * i + 1] = g[1]; mg[4 * i + 2] = g[2]; mg[4 * i + 3] = g[3]; } }
  for (int row0 = gw; row0 < M; row0 += 2 * ngw) {
    const int row1 = row0 + ngw; const bool has1 = row1 < M;
    u32x4 in[2][10];
#pragma unroll
    for (int q = 0; q < 2; ++q) {
      const size_t row = (size_t)(q == 0 ? row0 : (has1 ? row1 : row0));
      const bf16_t* z = Z + row * NIN + col; const bf16_t* hp = H + row * D + col;
      in[q][0] = *(const u32x4*)hp; in[q][1] = *(const u32x4*)(hp + 8);
#pragma unroll
      for (int hh = 0; hh < 2; ++hh) {
        in[q][2 + hh * 4] = *(const u32x4*)(z + 3072 + hh * 8); in[q][3 + hh * 4] = *(const u32x4*)(z + 6144 + hh * 8);
        in[q][4 + hh * 4] = *(const u32x4*)(z + 7168 + hh * 8); in[q][5 + hh * 4] = *(const u32x4*)(z + 8192 + hh * 8);
      }
    }
#pragma unroll
    for (int q = 0; q < 2; ++q) {
      if (q == 1 && !has1) break;
      const size_t row = (size_t)(q == 0 ? row0 : row1);
      float hv[16];
      unpack8(in[q][0], hv); unpack8(in[q][1], hv + 8);
      float s = 0.f;
#pragma unroll
      for (int e = 0; e < 16; ++e) s += hv[e];
#pragma unroll
      for (int o = 1; o < 16; o <<= 1) s += __shfl_xor(s, o);
      const float mean = s * (1.f / 256.f);
      float s2 = 0.f;
#pragma unroll
      for (int e = 0; e < 16; ++e) { hv[e] -= mean; s2 += hv[e] * hv[e]; }
#pragma unroll
      for (int o = 1; o < 16; o <<= 1) s2 += __shfl_xor(s2, o);
      const float rstd = rsqrtf(s2 * (1.f / 256.f) + LN_EPS);
      u32x4 out[2];
#pragma unroll
      for (int hh = 0; hh < 2; ++hh) {
        float oa[8], om[8], ga[8], gb[8];
        unpack8(in[q][2 + hh * 4], oa); unpack8(in[q][3 + hh * 4], om); unpack8(in[q][4 + hh * 4], ga); unpack8(in[q][5 + hh * 4], gb);
        float y[8];
#pragma unroll
        for (int e = 0; e < 8; ++e) {
          const float hn = hv[hh * 8 + e] * rstd * mg[hh * 8 + e];
          y[e] = sigmoidf_(ga[e]) * oa[e] + sigmoidf_(gb[e]) * (hn * sigmoidf_(om[e]));
        }
        out[hh][0] = pk2(y[0], y[1]); out[hh][1] = pk2(y[2], y[3]); out[hh][2] = pk2(y[4], y[5]); out[hh][3] = pk2(y[6], y[7]);
      }
      *(u32x4*)(Y + row * D + col) = out[0]; *(u32x4*)(Y + row * D + col + 8) = out[1];
    }
  }
}

DI void ln_phase(const Params& p, const float* g, const float* bta, bool final_out) {
  const int tidq = otid(); const int lane = tidq & 63, gw = blockIdx.x * 8 + (tidq >> 6), ngw = gridDim.x * 8;
  float* R = (float*)(p.ws + W_R); bf16_t* AB = (bf16_t*)(p.ws + W_AB);
  f32x4 gq[4], bq[4];
#pragma unroll
  for (int j = 0; j < 4; ++j) { gq[j] = *(const f32x4*)(g + j * 256 + lane * 4); bq[j] = *(const f32x4*)(bta + j * 256 + lane * 4); }
  for (int row0 = gw; row0 < M; row0 += 2 * ngw) {
    f32x4 v[2][4]; float s[2] = {0.f, 0.f};
    const int row1 = row0 + ngw; const bool has1 = row1 < M;
#pragma unroll
    for (int q = 0; q < 2; ++q) {
      const float* xr = R + (size_t)(q == 0 ? row0 : (has1 ? row1 : row0)) * D;
#pragma unroll
      for (int j = 0; j < 4; ++j) { v[q][j] = *(const f32x4*)(xr + j * 256 + lane * 4); s[q] += (v[q][j][0] + v[q][j][1]) + (v[q][j][2] + v[q][j][3]); }
    }
#pragma unroll
    for (int q = 0; q < 2; ++q) {
      if (q == 1 && !has1) break;
      const int row = q == 0 ? row0 : row1;
      const float mean = wave_sum(s[q]) * (1.f / D);
      float s2 = 0.f;
#pragma unroll
      for (int j = 0; j < 4; ++j) { v[q][j] = v[q][j] - mean; s2 += (v[q][j][0] * v[q][j][0] + v[q][j][1] * v[q][j][1]) + (v[q][j][2] * v[q][j][2] + v[q][j][3] * v[q][j][3]); }
      const float rstd = rsqrtf(wave_sum(s2) * (1.f / D) + LN_EPS);
      float* dst = final_out ? (row < MP ? p.out + O_YP + (size_t)row * D : p.out + O_YS + (size_t)(row - MP) * D) : R + (size_t)row * D;
#pragma unroll
      for (int j = 0; j < 4; ++j) {
        const int c = j * 256 + lane * 4;
        const f32x4 o = v[q][j] * rstd * gq[j] + bq[j];
        *(f32x4*)(dst + c) = o;
        if (!final_out) { u32x2 ob; ob[0] = pk2(o[0], o[1]); ob[1] = pk2(o[2], o[3]); *(u32x2*)(AB + (size_t)row * D + c) = ob; }
      }
    }
  }
}

DI float gelu_f(float v) {
  const float av = fabsf(v), d = av * 0.2316418882f + 1.0f;
  const float t = __builtin_amdgcn_rcpf(d);
  float q = t * 0.5307027145f + (-0.7265760135f); q = q * t + 0.7107068705f; q = q * t + (-0.142248368f); q = q * t + 0.127414796f; q = q * t;
  const float e = __builtin_amdgcn_exp2f((v * v) * (-0.72134752044f));
  const float m = v * (q * e), r = v - m;
  return v < 0.f ? m : r;
}
DI void ffnconv_phase(const Params& p, int l) {
  const bf16_t* U = (const bf16_t*)(p.ws + W_Z); bf16_t* HF = (bf16_t*)(p.ws + W_Z + (size_t)M * NUP * 2);
  const float* cw = p.in[20] + (size_t)l * 3 * NUP; const float* cb = p.in[21] + (size_t)l * NUP;
  constexpr int RG = 8;
  const unsigned total = (unsigned)(M / RG) * 352u;
  for (unsigned it = blockIdx.x * NTH + (unsigned)otid(); it < total; it += gridDim.x * NTH) {
    const unsigned rg = it / 352u, cc = it - rg * 352u;
    const int col = (int)cc * 8, row0 = (int)rg * RG;
    int t0; const float* st = nullptr;
    if (row0 < MP) t0 = row0 & (SEQ - 1); else { t0 = (row0 - MP) & 15; st = p.in[8] + ((size_t)(l * 8 + ((row0 - MP) >> 4)) * 2) * NUP; }
    float gl[RG][8];
#pragma unroll
    for (int hf = 0; hf < 2; ++hf) {
      const int c2 = col + hf * DFF;
      float w[3][8], bias[8], x[RG + 2][8];
#pragma unroll
      for (int j = 0; j < 3; ++j) { const f32x4 a = *(const f32x4*)(cw + j * NUP + c2), b2 = *(const f32x4*)(cw + j * NUP + c2 + 4);
        w[j][0] = a[0]; w[j][1] = a[1]; w[j][2] = a[2]; w[j][3] = a[3]; w[j][4] = b2[0]; w[j][5] = b2[1]; w[j][6] = b2[2]; w[j][7] = b2[3]; }
      { const f32x4 a = *(const f32x4*)(cb + c2), b2 = *(const f32x4*)(cb + c2 + 4);
        bias[0] = a[0]; bias[1] = a[1]; bias[2] = a[2]; bias[3] = a[3]; bias[4] = b2[0]; bias[5] = b2[1]; bias[6] = b2[2]; bias[7] = b2[3]; }
#pragma unroll
      for (int j = 0; j < RG + 2; ++j) {
        const int t = t0 - 2 + j;
        if (t >= 0) unpack8(*(const u32x4*)(U + (size_t)(row0 - 2 + j) * NUP + c2), x[j]);
        else if (st) { const float* sp = st + (size_t)(2 + t) * NUP + c2; const f32x4 a = *(const f32x4*)sp, b2 = *(const f32x4*)(sp + 4);
          x[j][0] = a[0]; x[j][1] = a[1]; x[j][2] = a[2]; x[j][3] = a[3]; x[j][4] = b2[0]; x[j][5] = b2[1]; x[j][6] = b2[2]; x[j][7] = b2[3]; }
        else {
#pragma unroll
          for (int e = 0; e < 8; ++e) x[j][e] = 0.f; }
      }
#pragma unroll
      for (int a = 0; a < RG; ++a) {
        float o[8];
#pragma unroll
        for (int e = 0; e < 8; ++e) {
          const float u = bias[e] + w[0][e] * x[a][e] + w[1][e] * x[a + 1][e] + w[2][e] * x[a + 2][e];
          if (hf == 0) gl[a][e] = gelu_f(u); else o[e] = gl[a][e] * u;
        }
        if (hf == 1) {
          u32x4 ov; ov[0] = pk2(o[0], o[1]); ov[1] = pk2(o[2], o[3]); ov[2] = pk2(o[4], o[5]); ov[3] = pk2(o[6], o[7]);
          *(u32x4*)(HF + (size_t)(row0 + a) * DFF + col) = ov;
        }
      }
    }
  }
}

#define XB_TMO      128
#define XB_XCNT(j)  (256  + 64 * (j))
#define XB_XSUB(j)  (1280 + 64 * (j))
#define XB_XGEN(j)  (2304 + 64 * (j))
#define XB_TOP      3328
#define XB_TOPGEN   3392
#define XCD_BAR_WORDS 3456
#define XB_SPIN_CAP (1u << 18)
#define XLAS __attribute__((address_space(3)))
DI unsigned xb_ld(unsigned* p)              { return __hip_atomic_load(p, __ATOMIC_RELAXED, __HIP_MEMORY_SCOPE_AGENT); }
DI unsigned xb_add(unsigned* p, unsigned v) { return __hip_atomic_fetch_add(p, v, __ATOMIC_RELAXED, __HIP_MEMORY_SCOPE_AGENT); }
DI unsigned xb_xcc_id() { return (unsigned)__builtin_amdgcn_s_getreg((3 << 11) | 20) & 0xFu; }
#define XB_SPIN(cond, bar) do { unsigned _sp = 0; while (cond) { __builtin_amdgcn_s_sleep(1); \
    if ((++_sp & 255u) == 0u) { if (xb_ld(&(bar)[XB_TMO])) break; if (_sp > XB_SPIN_CAP) { atomicAdd(&(bar)[XB_TMO], 1u); break; } } } } while (0)
struct XcdBarrier { unsigned* bar; unsigned x; volatile XLAS unsigned* st; };
DI XcdBarrier xcd_barrier_post(unsigned* bar, volatile XLAS unsigned* st) {
  XcdBarrier b; b.bar = bar; b.x = xb_xcc_id(); b.st = st;
  if (threadIdx.x == 0) (void)xb_add(&bar[XB_XCNT(b.x)], 1u);
  return b;
}
DI void xcd_barrier_complete(unsigned* bar, unsigned x, unsigned& nloc, unsigned& nx) {
  const unsigned G = gridDim.x * gridDim.y * gridDim.z;
  unsigned sum, cnt, mine, sp = 0u;
  for (;;) {
    sum = 0u; cnt = 0u; mine = 0u;
#pragma unroll
    for (unsigned j = 0; j < 16; ++j) { const unsigned c = xb_ld(&bar[XB_XCNT(j)]); sum += c; cnt += (c > 0u) ? 1u : 0u; mine = (j == x) ? c : mine; }
    if (sum == G) break;
    __builtin_amdgcn_s_sleep(1);
    if ((++sp & 255u) == 0u) { if (xb_ld(&bar[XB_TMO])) break; if (sp > XB_SPIN_CAP) { atomicAdd(&bar[XB_TMO], 1u); break; } }
  }
  nloc = mine > 0u ? mine : 1u; nx = cnt > 0u ? cnt : 1u;
}
DI void xcd_barrier(const XcdBarrier& b) {
  asm volatile("s_waitcnt vmcnt(0)" ::: "memory");
  __syncthreads();
  if (threadIdx.x == 0) {
    unsigned* bar = b.bar;
    __builtin_amdgcn_s_waitcnt(0);
    unsigned nloc = b.st[0], nx = b.st[1];
    if (nloc == 0u) { xcd_barrier_complete(bar, b.x, nloc, nx); b.st[0] = nloc; b.st[1] = nx; }
    const unsigned old = xb_add(&bar[XB_XSUB(b.x)], 1u);
    const unsigned gen = old / nloc;
    if (old + 1u == (gen + 1u) * nloc) {
      __builtin_amdgcn_fence(__ATOMIC_RELEASE, "agent");
      asm volatile("s_waitcnt vmcnt(0)" ::: "memory");
      const unsigned og = xb_add(&bar[XB_TOP], 1u);
      const unsigned tg = og / nx;
      if (og + 1u == (tg + 1u) * nx) xb_add(&bar[XB_TOPGEN], 1u);
      else XB_SPIN(xb_ld(&bar[XB_TOPGEN]) == tg, bar);
      __builtin_amdgcn_fence(__ATOMIC_ACQUIRE, "agent");
      xb_add(&bar[XB_XGEN(b.x)], 1u);
      asm volatile("s_waitcnt vmcnt(0)" ::: "memory");
    } else {
      XB_SPIN(xb_ld(&bar[XB_XGEN(b.x)]) == gen, bar);
      __builtin_amdgcn_fence(__ATOMIC_ACQUIRE, "agent");
      asm volatile("s_waitcnt vmcnt(0)" ::: "memory");
    }
  }
  __syncthreads();
}

constexpr int NPH = 21;
DI void run_phase(const Params& p, int ph, char* lds) {
#ifndef ONLY
  if (ph == 0) { phase0(p, lds); return; }
#else
  if (ph == 0) return;
#endif
  const int l = (ph - 1) / 10, s = (ph - 1) % 10;
#ifdef ONLY
  if (s != ONLY) return;
#endif
  switch (s) {
    case 0: gemm_phase<EPI_IN>(p, l, (const bf16_t*)(p.ws + W_AB), D, (const bf16_t*)(p.ws + W_WIN) + (size_t)l * NIN * D, D, NIN / 256, lds); break;
    case 1: qkconv_phase(p, l); gif_phase(p, l, lds, 0); break;
    case 2: mixer_phase(p, l, lds, l, false); break;
    case 3: merge_phase(p, l); break;
    case 4: gemm_phase<EPI_OUT>(p, l, (const bf16_t*)(p.ws + W_AB), D, (const bf16_t*)(p.ws + W_WOUT) + (size_t)l * D * D, D, D / 256, lds); break;
    case 5: ln_phase(p, p.in[17] + l * D, p.in[18] + l * D, false); break;
    case 6: gemm_phase<EPI_UP>(p, l, (const bf16_t*)(p.ws + W_AB), D, (const bf16_t*)(p.ws + W_WUP) + (size_t)l * NUP * D, D, NUP / 256, lds); break;
    case 7: ffnconv_phase(p, l); break;
    case 8: gemm_phase<EPI_DOWN>(p, l, (const bf16_t*)(p.ws + W_Z + (size_t)M * NUP * 2), DFF, (const bf16_t*)(p.ws + W_WDN) + (size_t)l * D * DFF, DFF, D / 256, lds); break;
    case 9: ln_phase(p, p.in[23] + l * D, p.in[24] + l * D, l == 1); break;
  }
}

__global__ void __launch_bounds__(NTH) mega(Params p, int ph_lo, int ph_hi) {
  extern __shared__ __attribute__((aligned(16))) char lds[];
#if MULTI_LAUNCH
  for (int ph = ph_lo; ph < ph_hi; ++ph) run_phase(p, ph, lds);
#else
  cg::grid_group grid = cg::this_grid();
  phase0(p, lds);
  grid.sync();
  volatile XLAS unsigned* xst = (volatile XLAS unsigned*)((XLAS char*)lds + (LDS_BYTES - 32));
  if (threadIdx.x == 0) { xst[0] = 0u; xst[1] = 0u; }
  __syncthreads();
  const XcdBarrier xb = xcd_barrier_post((unsigned*)(p.ws + W_BAR), xst);
#define GSYNC() xcd_barrier(xb)
  for (int l = 0; l < 2; ++l) {
    gemm_phase<EPI_IN>(p, l, (const bf16_t*)(p.ws + W_AB), D, (const bf16_t*)(p.ws + W_WIN) + (size_t)l * NIN * D, D, NIN / 256, lds);
    {
      const int nun = NTM * (NIN / 256), G = (int)gridDim.x;
      const int busy = nun % G;
      gif_phase(p, l, lds, (busy > 0 && busy * 2 < G) ? busy : 0);
    }
    GSYNC();
#ifdef PROBE_GIN2
    gemm_phase<EPI_IN>(p, l, (const bf16_t*)(p.ws + W_AB), D, (const bf16_t*)(p.ws + W_WIN) + (size_t)l * NIN * D, D, NIN / 256, lds);
    GSYNC();
#endif
    qkconv_phase(p, l);
    GSYNC();
#if defined(PROBE_EW2) || defined(PROBE_QKC2)
    qkconv_phase(p, l);
    GSYNC();
#endif
    mixer_phase(p, l, lds, l, false);
    GSYNC();
#ifdef PROBE_ML2
    mixer_phase(p, l, lds, l + 2, true);
    GSYNC();
#endif
#ifdef PROBE_MIX2
    mixer_phase(p, l, lds, l + 2, false);
    GSYNC();
#endif
    merge_phase(p, l);
    GSYNC();
#ifdef PROBE_SYNC
    for (int q = 0; q < 20; ++q) GSYNC();
#endif
#if defined(PROBE_EW2) || defined(PROBE_MRG2)
    merge_phase(p, l);
    GSYNC();
#endif
    gemm_phase<EPI_OUT>(p, l, (const bf16_t*)(p.ws + W_AB), D, (const bf16_t*)(p.ws + W_WOUT) + (size_t)l * D * D, D, D / 256, lds);
    GSYNC();
    ln_phase(p, p.in[17] + l * D, p.in[18] + l * D, false);
    GSYNC();
    gemm_phase<EPI_UP>(p, l, (const bf16_t*)(p.ws + W_AB), D, (const bf16_t*)(p.ws + W_WUP) + (size_t)l * NUP * D, D, NUP / 256, lds);
    GSYNC();
    ffnconv_phase(p, l);
    GSYNC();
#if defined(PROBE_EW2) || defined(PROBE_FFC2)
    ffnconv_phase(p, l);
    GSYNC();
#endif
    gemm_phase<EPI_DOWN>(p, l, (const bf16_t*)(p.ws + W_Z + (size_t)M * NUP * 2), DFF, (const bf16_t*)(p.ws + W_WDN) + (size_t)l * D * DFF, DFF, D / 256, lds);
    GSYNC();
    ln_phase(p, p.in[23] + l * D, p.in[24] + l * D, l == 1);
    if (l == 0) GSYNC();
  }
#endif
}

extern "C" void kernel_launch(void* const* d_in, const int* in_sizes, int n_in, void* d_out, int out_size, void* d_ws, size_t ws_size, hipStream_t stream) {
  static int grid = 0;
  if (grid == 0) {
    if (n_in != 25 || (size_t)out_size != O_END || ws_size < W_END) { fprintf(stderr, "kernel_launch: unexpected sizes n_in %d out %d (want %zu) ws %zu (want %zu)\n", n_in, out_size, (size_t)O_END, ws_size, (size_t)W_END); grid = -1; return; }
    int dev = 0, cus = 0, per_cu = 0;
    hipGetDevice(&dev);
    hipDeviceGetAttribute(&cus, hipDeviceAttributeMultiprocessorCount, dev);
    if (hipFuncSetAttribute((const void*)mega, hipFuncAttributeMaxDynamicSharedMemorySize, LDS_BYTES) != hipSuccess) { fprintf(stderr, "hipFuncSetAttribute failed\n"); grid = -1; return; }
    hipOccupancyMaxActiveBlocksPerMultiprocessor(&per_cu, (const void*)mega, NTH, LDS_BYTES);
    if (per_cu < 1) per_cu = 1;
    grid = cus * 1;
    (void)hipGetLastError();
  }
  if (grid < 0) return;
  Params p{};
  for (int i = 0; i < 25; ++i) p.in[i] = (const float*)d_in[i];
  p.out = (float*)d_out; p.ws = (unsigned char*)d_ws;
#if MULTI_LAUNCH
  for (int ph = 0; ph < NPH; ++ph) hipLaunchKernelGGL(mega, dim3(grid), dim3(NTH), LDS_BYTES, stream, p, ph, ph + 1);
#else
  int lo = 0, hi = NPH;
  void* args[] = {&p, &lo, &hi};
  hipError_t e = hipLaunchCooperativeKernel((const void*)mega, dim3(grid), dim3(NTH), args, LDS_BYTES, stream);
  if (e != hipSuccess) fprintf(stderr, "cooperative launch failed: %s (grid %d)\n", hipGetErrorString(e), grid);
#endif
}
```

```cpp
#include <hip/hip_runtime.h>
#include <hip/hip_cooperative_groups.h>
#include <cstdio>
namespace cg = cooperative_groups;

#ifndef MULTI_LAUNCH
#define MULTI_LAUNCH 0
#endif

typedef unsigned short bf16_t;
typedef short bf16x8 __attribute__((ext_vector_type(8)));
typedef short s16x4 __attribute__((ext_vector_type(4)));
typedef float f32x16 __attribute__((ext_vector_type(16)));
typedef float f32x4 __attribute__((ext_vector_type(4)));
typedef unsigned u32x4 __attribute__((ext_vector_type(4)));
typedef unsigned u32x2 __attribute__((ext_vector_type(2)));
#define DI __device__ __forceinline__
#define MFMA32(a, b, c) __builtin_amdgcn_mfma_f32_32x32x16_bf16((a), (b), (c), 0, 0, 0)

constexpr int NTH = 512;
constexpr int D = 1024, SEQ = 8192, NB = 4, MP = NB * SEQ, MS = 128, M = MP + MS, NTM = 129;
constexpr int DIN = 9224, NIN = 9216, DFF = 2816, NUP = 5632;
constexpr int PAST = 4096, NKS = PAST + 16;
constexpr float ALPHA = 1.4142135623730951f;
constexpr float LN_EPS = 1e-5f;
constexpr float LOG2E = 1.4426950408889634f;

constexpr size_t O_YP = 0;
constexpr size_t O_YS = O_YP + (size_t)MP * D;
constexpr size_t O_KP = O_YS + (size_t)MS * D;
constexpr size_t O_VP = O_KP + (size_t)2 * MP * 1024;
constexpr size_t O_MCP = O_VP + (size_t)2 * MP * 1024;
constexpr size_t O_CP = O_MCP + (size_t)2 * 4 * 3 * 2048;
constexpr size_t O_NP = O_CP + (size_t)2 * 4 * 4 * 65536;
constexpr size_t O_MPP = O_NP + (size_t)2 * 4 * 4 * 256;
constexpr size_t O_FCP = O_MPP + 32;
constexpr size_t O_KS = O_FCP + (size_t)2 * 4 * 2 * NUP;
constexpr size_t O_VS = O_KS + (size_t)2 * MS * 1024;
constexpr size_t O_MCS = O_VS + (size_t)2 * MS * 1024;
constexpr size_t O_CS = O_MCS + (size_t)2 * 8 * 3 * 2048;
constexpr size_t O_NS = O_CS + (size_t)2 * 8 * 4 * 65536;
constexpr size_t O_MSS = O_NS + (size_t)2 * 8 * 4 * 256;
constexpr size_t O_FCS = O_MSS + 64;
constexpr size_t O_END = O_FCS + (size_t)2 * 8 * 2 * NUP;

constexpr size_t W_Z = 0;
constexpr size_t W_H = W_Z + (size_t)M * NIN * 2;
constexpr size_t W_AB = W_H + (size_t)M * D * 2;
constexpr size_t W_KA = W_AB + (size_t)M * D * 2;
constexpr size_t W_R = W_KA + (size_t)M * D * 2;
constexpr size_t W_WIN = W_R + (size_t)M * D * 4;
constexpr size_t W_WOUT = W_WIN + (size_t)2 * NIN * D * 2;
constexpr size_t W_WUP = W_WOUT + (size_t)2 * D * D * 2;
constexpr size_t W_WDN = W_WUP + (size_t)2 * NUP * D * 2;
constexpr size_t W_GIF = W_WDN + (size_t)2 * D * DFF * 2;
constexpr size_t W_ROPE = W_GIF + (size_t)M * 8 * 4;
constexpr size_t W_MISC = W_ROPE + (size_t)8192 * 32 * 8;
constexpr size_t W_BAR = W_MISC + 4096;
constexpr size_t W_END = W_BAR + 16384;

struct Params {
  const float* in[25];
  float* out;
  unsigned char* ws;
};

DI unsigned f2bf(float x) { unsigned u = __float_as_uint(x); u += 0x7fffu + ((u >> 16) & 1u); return u >> 16; }
typedef __bf16 bf16v2 __attribute__((ext_vector_type(2)));
typedef float f32x2 __attribute__((ext_vector_type(2)));
DI unsigned pk2(float a, float b) { f32x2 v; v[0] = a; v[1] = b; return __builtin_bit_cast(unsigned, __builtin_convertvector(v, bf16v2)); }
DI float bflo(unsigned u) { return __uint_as_float(u << 16); }
DI float bfhi(unsigned u) { return __uint_as_float(u & 0xffff0000u); }
DI float sigmoidf_(float x) { return __builtin_amdgcn_rcpf(1.f + __builtin_amdgcn_exp2f(-1.4426950408889634f * x)); }
DI float wave_sum(float v) {
#pragma unroll
  for (int o = 1; o < 64; o <<= 1) v += __shfl_xor(v, o);
  return v;
}
DI int crow(int i, int h) { return (i & 3) + 8 * (i >> 2) + 4 * h; }
DI bf16x8 pack8(const f32x16& x, int s) {
  u32x4 p;
  p[0] = pk2(x[8 * s + 0], x[8 * s + 1]); p[1] = pk2(x[8 * s + 2], x[8 * s + 3]);
  p[2] = pk2(x[8 * s + 4], x[8 * s + 5]); p[3] = pk2(x[8 * s + 6], x[8 * s + 7]);
  return __builtin_bit_cast(bf16x8, p);
}
DI void unpack8(u32x4 v, float* f) {
  f[0] = bflo(v[0]); f[1] = bfhi(v[0]); f[2] = bflo(v[1]); f[3] = bfhi(v[1]);
  f[4] = bflo(v[2]); f[5] = bfhi(v[2]); f[6] = bflo(v[3]); f[7] = bfhi(v[3]);
}
typedef __attribute__((address_space(3))) s16x4 lds_s16x4;
DI bf16x8 tr_frag(unsigned a_lo, unsigned a_hi) {
  const s16x4 lo = __builtin_amdgcn_ds_read_tr16_b64_v4i16((lds_s16x4*)(size_t)a_lo);
  const s16x4 hi = __builtin_amdgcn_ds_read_tr16_b64_v4i16((lds_s16x4*)(size_t)a_hi);
  return __builtin_shufflevector(lo, hi, 0, 1, 2, 3, 4, 5, 6, 7);
}
template <int STEP, int HIOFF>
DI void tr_frag4(unsigned a, bf16x8 (&f)[4]) {
#pragma unroll
  for (int i = 0; i < 4; ++i) f[i] = tr_frag(a + i * STEP, a + i * STEP + HIOFF);
}
DI int otid() { int t = threadIdx.x; asm volatile("" : "+v"(t)); return t; }
DI int uni(int v) { return __builtin_amdgcn_readfirstlane(v); }
DI unsigned lds_addr(const void* p) { return (unsigned)(size_t)p; }

DI const float* xrow_ptr(const Params& p, int l, int row) {
  if (l == 0) return row < MP ? p.in[0] + (size_t)row * D : p.in[1] + (size_t)(row - MP) * D;
  return (const float*)(p.ws + W_R) + (size_t)row * D;
}

DI void transpose_w(const float* W, int K, int N, int src_ld, bf16_t* WT, bool remap, char* lds) {
  float* scr = (float*)lds;
  const int nkb = K / 64, nnb = N / 64, tid = otid();
  for (int it = blockIdx.x; it < nkb * nnb; it += gridDim.x) {
    const int kb = it / nnb, nb = it % nnb, k0 = kb * 64, n0 = nb * 64;
    const int ns = (remap && n0 >= 7168) ? n0 + 8 : n0;
#pragma unroll
    for (int i = 0; i < 8; ++i) {
      const int kk = (tid >> 6) + 8 * i, nn = tid & 63;
      scr[kk * 65 + nn] = W[(size_t)(k0 + kk) * src_ld + ns + nn];
    }
    __syncthreads();
    {
      const int n = tid >> 3, c = tid & 7;
      const float* s = scr + (8 * c) * 65 + n;
      u32x4 o;
      o[0] = pk2(s[0], s[65]); o[1] = pk2(s[2 * 65], s[3 * 65]); o[2] = pk2(s[4 * 65], s[5 * 65]); o[3] = pk2(s[6 * 65], s[7 * 65]);
      const int nd = (remap && n0 < 2048) ? ((n < 32) ? 2 * n : 2 * (n - 32) + 1) : n;
      *(u32x4*)(WT + (size_t)(n0 + nd) * K + k0 + 8 * c) = o;
    }
    __syncthreads();
  }
}

DI void phase0(const Params& p, char* lds) {
  const int tid = otid();
  for (int l = 0; l < 2; ++l) {
    transpose_w(p.in[9] + (size_t)l * D * DIN, D, NIN, DIN, (bf16_t*)(p.ws + W_WIN) + (size_t)l * NIN * D, true, lds);
    transpose_w(p.in[16] + (size_t)l * D * D, D, D, D, (bf16_t*)(p.ws + W_WOUT) + (size_t)l * D * D, false, lds);
    transpose_w(p.in[19] + (size_t)l * D * NUP, D, NUP, NUP, (bf16_t*)(p.ws + W_WUP) + (size_t)l * NUP * D, false, lds);
    transpose_w(p.in[22] + (size_t)l * DFF * D, DFF, D, D, (bf16_t*)(p.ws + W_WDN) + (size_t)l * D * DFF, false, lds);
  }
  bf16_t* ab = (bf16_t*)(p.ws + W_AB);
  {
    const unsigned total = (unsigned)M * 128u, S = gridDim.x * NTH;
    for (unsigned c0 = blockIdx.x * NTH + (unsigned)tid; c0 < total; c0 += 4u * S) {
      f32x4 a[4], b4[4];
#pragma unroll
      for (int u = 0; u < 4; ++u) {
        const unsigned c = c0 + (unsigned)u * S;
        if (c < total) { const float* src = xrow_ptr(p, 0, (int)(c >> 7)) + (c & 127u) * 8; a[u] = *(const f32x4*)src; b4[u] = *(const f32x4*)(src + 4); }
      }
#pragma unroll
      for (int u = 0; u < 4; ++u) {
        const unsigned c = c0 + (unsigned)u * S;
        if (c < total) {
          u32x4 o; o[0] = pk2(a[u][0], a[u][1]); o[1] = pk2(a[u][2], a[u][3]); o[2] = pk2(b4[u][0], b4[u][1]); o[3] = pk2(b4[u][2], b4[u][3]);
          *(u32x4*)(ab + (size_t)(c >> 7) * D + (c & 127u) * 8) = o;
        }
      }
    }
  }
  float2* rope = (float2*)(p.ws + W_ROPE);
  for (int i = blockIdx.x * NTH + tid; i < 8192 * 32; i += gridDim.x * NTH) {
    const int pos = i >> 5, d = i & 31;
    const double inv = exp2(-(double)d * (13.287712379549449 / 32.0));
    double ang = (double)pos * inv;
    const double twopi = 6.283185307179586476925;
    ang -= twopi * rint(ang / twopi);
    float s, c; sincosf((float)ang, &s, &c);
    rope[i] = make_float2(c, s);
  }
  if (blockIdx.x == 0 && tid < 128) {
    const int l = tid >> 6, ln = tid & 63;
    const float* lp = p.in[13] + (size_t)l * 4 * 64;
    const float s1 = wave_sum(lp[ln] * lp[64 + ln]), s2 = wave_sum(lp[128 + ln] * lp[192 + ln]);
    const float lam_init = (l == 0) ? 0.2f : (0.8f - 0.6f * 0.74081822068171788f);
    if (ln == 0) ((float*)(p.ws + W_MISC))[l] = __expf(s1) - __expf(s2) + lam_init;
  }
  if (blockIdx.x == 0 && tid < 8) ((unsigned*)(p.ws + W_MISC))[16 + tid] = 0u;
  if (blockIdx.x == 0) for (int i = tid; i < 3456; i += NTH) ((unsigned*)(p.ws + W_BAR))[i] = 0u;
}

namespace pg8 {
#define PG8_LAS __attribute__((address_space(3)))
typedef unsigned short bf16_t;
typedef short bf16x8 __attribute__((ext_vector_type(8)));
typedef float f32x4 __attribute__((ext_vector_type(4)));
typedef unsigned u32x4 __attribute__((ext_vector_type(4)));
constexpr int BM = 256, BK = 64, HALF = 128, HTB = HALF * BK * 2  , STAGE_BYTES = 8 * HTB, NXCD = 8, WGM = 8;

__host__ __device__ __forceinline__ int lds_byte(int r, int c) { const int st = (r >> 4) * 2 + (c >> 5), rr = r & 15, cc = c & 31, ob = rr * 64 + cc * 2; return st * 1024 + (ob ^ (((ob >> 9) & 1) << 5)); }
__host__ __device__ __forceinline__ void stage_rc(int b, int& R, int& C) { const int st = b / 1024, sb = b % 1024, swz = sb ^ (((sb >> 9) & 1) << 5); R = (st >> 1) * 16 + swz / 64; C = (st & 1) * 32 + (swz % 64) / 2; }
__host__ __device__ __forceinline__ int perm32(int rho) { const int n = rho >> 4, i = rho & 15; return 8 * (i >> 2) + 4 * n + (i & 3); }

struct Unit { int pm, pn; };
struct Gemm { const bf16_t* A; const bf16_t* Bt; int M, N, K; };

struct StaticOrder {
    int nM, nN, nwg, G, c;
    __host__ __device__ void init(int M, int N, int G_, int c_) { nM = M / BM; nN = N / BM; nwg = nM * nN; G = G_; c = c_; }
    __host__ __device__ bool next(int i, Unit& u) const {
        const long L = (long)i * G + c; if (L >= nwg) return false;
        int wgid = (int)L; { const int q = nwg / NXCD, r = nwg % NXCD, xcd = wgid % NXCD, off = wgid / NXCD; wgid = (xcd < r ? xcd * (q + 1) : r * (q + 1) + (xcd - r) * q) + off; }
        const int nig = WGM * nN, gid = wgid / nig, fm = gid * WGM, gsz = (nM - fm) < WGM ? (nM - fm) : WGM;
        u.pm = fm + ((wgid % nig) % gsz); u.pn = (wgid % nig) / gsz; return true;
    }
    __device__ __forceinline__ void a_ready(const Unit&) const {}
    __device__ __forceinline__ void done(const Unit&) const {}
};
template <class Epi, class Sched, bool STAMP = false>
__device__ __forceinline__ void gemm_phase(PG8_LAS unsigned char* lds, const Gemm g, const Sched& S, const Epi& E, unsigned long long* stamps) {
    const int tid = otid(), wid = __builtin_amdgcn_readfirstlane(tid >> 6), lane = tid & 63, wr = wid >> 2, wc = wid & 3, fr = lane & 15, fq = lane >> 4;
    const int K = g.K, nt = K / BK;
    int ts_lo = 0, ts_hi = 0, nts = 0; const unsigned long long rt_entry = STAMP ? (unsigned long long)wall_clock64() : 0ull;
#define PG8_STAMP() do { if (STAMP && wid == 0 && nts < 64) { const unsigned long long _c = (unsigned long long)clock64(); \
        ts_lo = (lane == nts) ? (int)(unsigned)_c : ts_lo; ts_hi = (lane == nts) ? (int)(unsigned)(_c >> 32) : ts_hi; ++nts; } } while (0)
    PG8_STAMP();
    unsigned voffA[2], voffB[2];
#pragma unroll
    for (int i = 0; i < 2; ++i) { int R, C; stage_rc(tid * 16 + i * 8192, R, C); const int Rb = Epi::PERM ? ((R & ~31) + perm32(R & 31)) : R;
        voffA[i] = (unsigned)(R * K + C) * 2u; voffB[i] = (unsigned)(Rb * K + C) * 2u; }
    const size_t kstep = (size_t)(BK * 2);
    const size_t hstep = (size_t)HALF * K * 2;
    const size_t tstep = 2 * hstep;
    const unsigned ldsw = (unsigned)wid * 1024u;
    const int aoff = lds_byte(wr * 64 + fr, fq * 8), boff = lds_byte(wc * 32 + fr, fq * 8);
#define PG8_SA(b, h) (((b) * 2 + (h)) * HTB)
#define PG8_SB(b, h) ((4 + (b) * 2 + (h)) * HTB)
#define PG8_STAGE(bufoff, gbase, voff) do { _Pragma("unroll") for (int _i = 0; _i < 2; ++_i) \
        __builtin_amdgcn_global_load_lds((const unsigned*)((const char*)(gbase) + (voff)[_i]), (PG8_LAS unsigned*)(lds + (bufoff) + ldsw + _i * 8192), 16, 0, 0); } while (0)
#define PG8_LDA(dst, b, h) do { _Pragma("unroll") for (int m = 0; m < 4; ++m) _Pragma("unroll") for (int k = 0; k < 2; ++k) dst[m][k] = *(const PG8_LAS bf16x8*)(lds + PG8_SA(b, h) + aoff + m * 2048 + k * 1024); } while (0)
#define PG8_LDB(dst, b, h) do { _Pragma("unroll") for (int n = 0; n < 2; ++n) _Pragma("unroll") for (int k = 0; k < 2; ++k) dst[n][k] = *(const PG8_LAS bf16x8*)(lds + PG8_SB(b, h) + boff + n * 2048 + k * 1024); } while (0)
#define PG8_MMA(ai, bj, At, Bt) do { __builtin_amdgcn_s_setprio(1); _Pragma("unroll") for (int m = 0; m < 4; ++m) _Pragma("unroll") for (int n = 0; n < 2; ++n) _Pragma("unroll") for (int k = 0; k < 2; ++k) \
        acc[ai][bj][m][n] = __builtin_amdgcn_mfma_f32_16x16x32_bf16(Bt[n][k], At[m][k], acc[ai][bj][m][n], 0, 0, 0); __builtin_amdgcn_s_setprio(0); } while (0)
#define PG8_WAIT_V(n) asm volatile("s_waitcnt vmcnt(" #n ")" ::: "memory")
#define PG8_WAIT_L(n) asm volatile("s_waitcnt lgkmcnt(" #n ")" ::: "memory")
#define PG8_BAR __builtin_amdgcn_s_barrier()
#define PG8_SCHED __builtin_amdgcn_sched_barrier(0)
    Unit cur, nxt; int ui = 0;
    if (!S.next(0, cur)) return;
    f32x4 acc[2][2][4][2];
#pragma unroll
    for (int a = 0; a < 2; ++a)
#pragma unroll
        for (int b = 0; b < 2; ++b)
#pragma unroll
            for (int m = 0; m < 4; ++m)
#pragma unroll
                for (int n = 0; n < 2; ++n) acc[a][b][m][n] = (f32x4){0.f, 0.f, 0.f, 0.f};
    bf16x8 At[4][2], B0[2][2], B1[2][2];
    const char* cA = (const char*)g.A + (size_t)cur.pm * tstep; const char* cB = (const char*)g.Bt + (size_t)cur.pn * tstep;
    S.a_ready(cur);
    PG8_STAGE(PG8_SB(0, 0), cB, voffB); PG8_STAGE(PG8_SA(0, 0), cA, voffA); PG8_STAGE(PG8_SB(0, 1), cB + hstep, voffB); PG8_STAGE(PG8_SA(0, 1), cA + hstep, voffA);
    if (wr == 1) PG8_BAR;
    PG8_WAIT_V(4); PG8_BAR;
    PG8_STAGE(PG8_SB(1, 0), cB + kstep, voffB); PG8_STAGE(PG8_SA(1, 0), cA + kstep, voffA); PG8_STAGE(PG8_SB(1, 1), cB + hstep + kstep, voffB);
    PG8_WAIT_V(6); PG8_BAR;
    PG8_STAMP();
    for (;;) {
        const bool has_next = S.next(ui + 1, nxt);
        const char* nA = has_next ? (const char*)g.A + (size_t)nxt.pm * tstep : cA; const char* nB = has_next ? (const char*)g.Bt + (size_t)nxt.pn * tstep : cB;
        for (int t = 0; t < nt; t += 2) {
            const bool last = (t == nt - 2);
            const char* a1 = cA + (size_t)(t + 1) * kstep;
            const char* a2 = last ? nA : cA + (size_t)(t + 2) * kstep; const char* b2 = last ? nB : cB + (size_t)(t + 2) * kstep;
            const char* a3 = a2 + kstep; const char* b3 = b2 + kstep;
            if (last && has_next) S.a_ready(nxt);
            PG8_LDB(B0, 0, 0); PG8_SCHED; PG8_LDA(At, 0, 0); PG8_STAGE(PG8_SA(1, 1), a1 + hstep, voffA);
            PG8_WAIT_L(8); PG8_BAR; PG8_WAIT_L(0); PG8_MMA(0, 0, At, B0); PG8_BAR; PG8_SCHED;
            PG8_LDB(B1, 0, 1); PG8_STAGE(PG8_SB(0, 0), b2, voffB);
            PG8_BAR; PG8_WAIT_L(0); PG8_MMA(0, 1, At, B1); PG8_BAR;
            PG8_LDA(At, 0, 1); PG8_STAGE(PG8_SA(0, 0), a2, voffA);
            PG8_BAR; PG8_WAIT_L(0); PG8_MMA(1, 0, At, B0); PG8_BAR; PG8_SCHED;
            PG8_STAGE(PG8_SB(0, 1), b2 + hstep, voffB);
            PG8_WAIT_V(6); PG8_BAR; PG8_MMA(1, 1, At, B1); PG8_BAR;
            PG8_LDB(B0, 1, 0); PG8_SCHED; PG8_LDA(At, 1, 0); PG8_STAGE(PG8_SA(0, 1), a2 + hstep, voffA);
            PG8_WAIT_L(8); PG8_BAR; PG8_WAIT_L(0); PG8_MMA(0, 0, At, B0); PG8_BAR; PG8_SCHED;
            PG8_LDB(B1, 1, 1); PG8_STAGE(PG8_SB(1, 0), b3, voffB);
            PG8_BAR; PG8_WAIT_L(0); PG8_MMA(0, 1, At, B1); PG8_BAR;
            PG8_LDA(At, 1, 1); PG8_STAGE(PG8_SA(1, 0), a3, voffA);
            PG8_BAR; PG8_WAIT_L(0); PG8_MMA(1, 0, At, B0); PG8_BAR; PG8_SCHED;
            PG8_STAGE(PG8_SB(1, 1), b3 + hstep, voffB);
            PG8_WAIT_V(6); PG8_BAR; PG8_MMA(1, 1, At, B1); PG8_BAR;
        }
        PG8_STAMP();
        if constexpr (!Epi::AFTER_DRAIN) { E(acc, cur, wr, wc, fr, fq); S.done(cur); }
        PG8_STAMP();
        if (!has_next) break;
#pragma unroll
        for (int a = 0; a < 2; ++a)
#pragma unroll
            for (int b = 0; b < 2; ++b)
#pragma unroll
                for (int m = 0; m < 4; ++m)
#pragma unroll
                    for (int n = 0; n < 2; ++n) acc[a][b][m][n] = (f32x4){0.f, 0.f, 0.f, 0.f};
        cur = nxt; cA = nA; cB = nB; ++ui;
    }
    PG8_WAIT_V(0);
    if (wr == 0) PG8_BAR;
    PG8_BAR;
    if constexpr (Epi::AFTER_DRAIN) { E.fused(acc, cur, wr, wc, fr, fq, lds, wid, lane); S.done(cur); }
    PG8_STAMP();
    if (STAMP && wid == 0) { stamps[lane] = lane < nts ? (((unsigned long long)(unsigned)ts_hi << 32) | (unsigned)ts_lo) : 0ull;
        if (lane == 62) stamps[62] = rt_entry; if (lane == 63) stamps[63] = (unsigned long long)wall_clock64(); }
#undef PG8_STAMP
#undef PG8_SA
#undef PG8_SB
#undef PG8_STAGE
#undef PG8_LDA
#undef PG8_LDB
#undef PG8_MMA
#undef PG8_WAIT_V
#undef PG8_WAIT_L
#undef PG8_BAR
#undef PG8_SCHED
}
}

enum { EPI_IN = 0, EPI_OUT = 1, EPI_UP = 2, EPI_DOWN = 3 };
template <int MODE>
struct Epi {
  static constexpr bool PERM = true, AFTER_DRAIN = false;
  Params p; int l;
  DI void operator()(const f32x4 (&acc)[2][2][4][2], const pg8::Unit& u, int wr, int wc, int fr, int fq) const {
    const int colb = u.pn * 256 + wc * 32 + 8 * fq;
    if (MODE == EPI_OUT || MODE == EPI_DOWN) {
      float* Rb = (float*)(p.ws + W_R);
#pragma unroll
      for (int ai = 0; ai < 2; ++ai) {
        f32x4 res[4][2][2];
#pragma unroll
        for (int m = 0; m < 4; ++m) {
          const int row = u.pm * 256 + ai * 128 + wr * 64 + m * 16 + fr;
          const float* rs = (MODE == EPI_OUT ? xrow_ptr(p, l, row < M ? row : M - 1) : Rb + (size_t)(row < M ? row : M - 1) * D) + colb;
#pragma unroll
          for (int bj = 0; bj < 2; ++bj) { res[m][bj][0] = *(const f32x4*)(rs + bj * 128); res[m][bj][1] = *(const f32x4*)(rs + bj * 128 + 4); }
        }
#pragma unroll
        for (int m = 0; m < 4; ++m) {
          const int row = u.pm * 256 + ai * 128 + wr * 64 + m * 16 + fr;
          if (row < M) {
            float* R = Rb + (size_t)row * D + colb;
#pragma unroll
            for (int bj = 0; bj < 2; ++bj) {
              *(f32x4*)(R + bj * 128) = res[m][bj][0] * ALPHA + acc[ai][bj][m][0];
              *(f32x4*)(R + bj * 128 + 4) = res[m][bj][1] * ALPHA + acc[ai][bj][m][1];
            }
          }
        }
      }
      return;
    }
    f32x4 rc0[8], rc1[8];
    if (MODE == EPI_IN && (u.pn >> 2) <= 1) {
      const int d0 = (colb & 63) >> 1;
#pragma unroll
      for (int i = 0; i < 8; ++i) {
        int row = u.pm * 256 + (i >> 2) * 128 + wr * 64 + (i & 3) * 16 + fr; row = row < M ? row : M - 1;
        const int pos = row < MP ? (row & (SEQ - 1)) : PAST + ((row - MP) & 15);
        const f32x4* rp = (const f32x4*)((const float2*)(p.ws + W_ROPE) + pos * 32 + d0);
        rc0[i] = rp[0]; rc1[i] = rp[1];
      }
    }
#pragma unroll
    for (int ai = 0; ai < 2; ++ai)
#pragma unroll
      for (int m = 0; m < 4; ++m) {
        const int row = u.pm * 256 + ai * 128 + wr * 64 + m * 16 + fr;
        if (row < M) {
#pragma unroll
          for (int bj = 0; bj < 2; ++bj) {
            const int col = colb + bj * 128;
            const f32x4 v0 = acc[ai][bj][m][0], v1 = acc[ai][bj][m][1];
            if (MODE == EPI_IN) {
              bf16_t* Z = (bf16_t*)(p.ws + W_Z);
              const int seg = u.pn >> 2;
              if (seg <= 1) {
                const int d0 = (col & 63) >> 1;
                const f32x4 c01 = rc0[ai * 4 + m], c23 = rc1[ai * 4 + m];
                const float a0 = v0[0] * c01[0] - v0[1] * c01[1], b0 = v0[1] * c01[0] + v0[0] * c01[1];
                const float a1 = v0[2] * c01[2] - v0[3] * c01[3], b1 = v0[3] * c01[2] + v0[2] * c01[3];
                const float a2 = v1[0] * c23[0] - v1[1] * c23[1], b2 = v1[1] * c23[0] + v1[0] * c23[1];
                const float a3 = v1[2] * c23[2] - v1[3] * c23[3], b3 = v1[3] * c23[2] + v1[2] * c23[3];
                const float qs = seg == 0 ? 0.125f : 1.f;
                u32x4 o; o[0] = pk2(a0 * qs, b0 * qs); o[1] = pk2(a1 * qs, b1 * qs); o[2] = pk2(a2 * qs, b2 * qs); o[3] = pk2(a3 * qs, b3 * qs);
                *(u32x4*)(Z + (size_t)row * NIN + col) = o;
                if (seg == 1) {
                  float* ob = (row < MP ? p.out + O_KP + ((size_t)l * MP + row) * 1024 : p.out + O_KS + ((size_t)l * MS + row - MP) * 1024) + ((col - 1024) & ~63) + d0;
                  f32x4 o1, o2; o1[0] = a0; o1[1] = a1; o1[2] = a2; o1[3] = a3; o2[0] = b0; o2[1] = b1; o2[2] = b2; o2[3] = b3;
                  *(f32x4*)ob = o1; *(f32x4*)(ob + 32) = o2;
                }
              } else {
                u32x4 o; o[0] = pk2(v0[0], v0[1]); o[1] = pk2(v0[2], v0[3]); o[2] = pk2(v1[0], v1[1]); o[3] = pk2(v1[2], v1[3]);
                *(u32x4*)(Z + (size_t)row * NIN + col) = o;
                if (seg == 2) {
                  float* ob = (row < MP ? p.out + O_VP + ((size_t)l * MP + row) * 1024 : p.out + O_VS + ((size_t)l * MS + row - MP) * 1024) + (col - 2048);
                  *(f32x4*)ob = v0; *(f32x4*)(ob + 4) = v1;
                } else if (seg == 3 || seg == 4) {
                  float* ob = nullptr;
                  if (row < MP) { const int s = row & (SEQ - 1); if (s >= SEQ - 3) ob = p.out + O_MCP + ((size_t)(l * 4 + (row >> 13)) * 3 + (s - (SEQ - 3))) * 2048 + col - 3072; }
                  else { const int t = (row - MP) & 15, b = (row - MP) >> 4; if (t >= 13) ob = p.out + O_MCS + ((size_t)(l * 8 + b) * 3 + (t - 13)) * 2048 + col - 3072; }
                  if (ob) { *(f32x4*)ob = v0; *(f32x4*)(ob + 4) = v1; }
                }
              }
            } else if (MODE == EPI_OUT || MODE == EPI_DOWN) {
              float* R = (float*)(p.ws + W_R) + (size_t)row * D + col;
              const float* rs = MODE == EPI_OUT ? xrow_ptr(p, l, row) + col : R;
              const f32x4 r0 = *(const f32x4*)rs, r1 = *(const f32x4*)(rs + 4);
              *(f32x4*)R = r0 * ALPHA + v0; *(f32x4*)(R + 4) = r1 * ALPHA + v1;
            } else {
              bf16_t* U = (bf16_t*)(p.ws + W_Z);
              u32x4 o; o[0] = pk2(v0[0], v0[1]); o[1] = pk2(v0[2], v0[3]); o[2] = pk2(v1[0], v1[1]); o[3] = pk2(v1[2], v1[3]);
              *(u32x4*)(U + (size_t)row * NUP + col) = o;
              float* ob = nullptr;
              if (row < MP) { const int s = row & (SEQ - 1); if (s >= SEQ - 2) ob = p.out + O_FCP + ((size_t)(l * 4 + (row >> 13)) * 2 + (s - (SEQ - 2))) * NUP + col; }
              else { const int t = (row - MP) & 15, b = (row - MP) >> 4; if (t >= 14) ob = p.out + O_FCS + ((size_t)(l * 8 + b) * 2 + (t - 14)) * NUP + col; }
              if (ob) { *(f32x4*)ob = v0; *(f32x4*)(ob + 4) = v1; }
            }
          }
        }
      }
  }
};

template <int MODE>
DI void gemm_phase(const Params& p, int l, const bf16_t* A, int lda, const bf16_t* Bt, int K, int ntn, char* lds) {
  (void)lda;
  pg8::Gemm g; g.A = A; g.Bt = Bt; g.M = ((MODE == EPI_OUT || MODE == EPI_DOWN) ? NTM - 1 : NTM) * 256; g.N = ntn * 256; g.K = K;
  if (MODE == EPI_OUT || MODE == EPI_DOWN) sample_gemm<MODE>(p, l, A, Bt, K);
  pg8::StaticOrder S; S.init(g.M, g.N, (int)gridDim.x, (int)blockIdx.x);
  Epi<MODE> E; E.p = p; E.l = l;
  pg8::gemm_phase<Epi<MODE>, pg8::StaticOrder, false>((PG8_LAS unsigned char*)lds, g, S, E, nullptr);
  __syncthreads();
}

typedef float f32x4v __attribute__((ext_vector_type(4)));
template <int MODE>
DI void sample_gemm(const Params& p, int l, const bf16_t* A, const bf16_t* Bt, int K) {
  if (blockIdx.x >= 64) return;
  const int tid = otid(), lane = tid & 63, wave = uni(tid >> 6), fr = lane & 15, fq = lane >> 4;
  const bf16_t* ap = A + (size_t)(MP + wave * 16 + fr) * K + fq * 8;
  const bf16_t* bp = Bt + (size_t)(blockIdx.x * 16 + fr) * K + fq * 8;
  f32x4v acc0 = {0.f, 0.f, 0.f, 0.f}, acc1 = {0.f, 0.f, 0.f, 0.f};
  for (int k0 = 0; k0 < K; k0 += 256) {
    bf16x8 a[8], bb[8];
#pragma unroll
    for (int i = 0; i < 8; ++i) { a[i] = *(const bf16x8*)(ap + k0 + i * 32); bb[i] = *(const bf16x8*)(bp + k0 + i * 32); }
#pragma unroll
    for (int i = 0; i < 8; i += 2) {
      acc0 = __builtin_amdgcn_mfma_f32_16x16x32_bf16(a[i], bb[i], acc0, 0, 0, 0);
      acc1 = __builtin_amdgcn_mfma_f32_16x16x32_bf16(a[i + 1], bb[i + 1], acc1, 0, 0, 0);
    }
  }
  const int col = blockIdx.x * 16 + fr;
  float* R = (float*)(p.ws + W_R);
#pragma unroll
  for (int j = 0; j < 4; ++j) {
    const int row = MP + wave * 16 + fq * 4 + j;
    const float res = MODE == EPI_OUT ? xrow_ptr(p, l, row)[col] : R[(size_t)row * D + col];
    R[(size_t)row * D + col] = ALPHA * res + (acc0[j] + acc1[j]);
  }
}

DI void gif_phase(const Params& p, int l, char* lds, int first_blk) {
  if ((int)blockIdx.x < first_blk) return;
  const int tidq = otid(); const int lane = tidq & 63, gw = ((int)blockIdx.x - first_blk) * 8 + (tidq >> 6), ngw = ((int)gridDim.x - first_blk) * 8;
  const float* w = p.in[9] + (size_t)l * D * DIN + 7168;
  const float* bif = p.in[10] + l * 8;
  float* gif = (float*)(p.ws + W_GIF);
  float* w8 = (float*)lds;
  __syncthreads();
#pragma unroll
  for (int i = 0; i < 2; ++i) {
    const int k = tidq + 512 * i;
    *(f32x4*)(w8 + k * 8) = *(const f32x4*)(w + (size_t)k * DIN); *(f32x4*)(w8 + k * 8 + 4) = *(const f32x4*)(w + (size_t)k * DIN + 4);
  }
  __syncthreads();
  for (int rg = gw; rg < M / 4; rg += ngw) {
    float acc[4][8];
#pragma unroll
    for (int a = 0; a < 4; ++a)
#pragma unroll
      for (int j = 0; j < 8; ++j) acc[a][j] = 0.f;
    const float* x0 = xrow_ptr(p, l, rg * 4);
#pragma unroll 4
    for (int kk = 0; kk < 16; ++kk) {
      const int k = kk * 64 + lane;
      const f32x4 w0 = *(const f32x4*)(w8 + k * 8), w1 = *(const f32x4*)(w8 + k * 8 + 4);
#pragma unroll
      for (int a = 0; a < 4; ++a) {
        const float xv = x0[(size_t)a * D + k];
        acc[a][0] += xv * w0[0]; acc[a][1] += xv * w0[1]; acc[a][2] += xv * w0[2]; acc[a][3] += xv * w0[3];
        acc[a][4] += xv * w1[0]; acc[a][5] += xv * w1[1]; acc[a][6] += xv * w1[2]; acc[a][7] += xv * w1[3];
      }
    }
#pragma unroll
    for (int a = 0; a < 4; ++a)
#pragma unroll
      for (int j = 0; j < 8; ++j) {
        const float s = wave_sum(acc[a][j]);
        if (lane == 0) gif[(size_t)(rg * 4 + a) * 8 + j] = s + bif[j];
      }
  }
  __syncthreads();
}

DI void qkconv_phase(const Params& p, int l) {
  const bf16_t* Z = (const bf16_t*)(p.ws + W_Z);
  bf16_t* QA = (bf16_t*)(p.ws + W_AB); bf16_t* KA = (bf16_t*)(p.ws + W_KA);
  const float* cw = p.in[11] + (size_t)l * 4 * 2048; const float* cb = p.in[12] + (size_t)l * 2048;
  constexpr int RG = 8;
  const size_t total = (size_t)(M / RG) * 256;
  for (size_t it = (size_t)blockIdx.x * NTH + otid(); it < total; it += (size_t)gridDim.x * NTH) {
    const int cc = (int)(it & 255), rg = (int)(it >> 8), col = cc * 8, row0 = rg * RG;
    int t0, hist_rows;
    const float* st = nullptr;
    if (row0 < MP) { t0 = row0 & (SEQ - 1); }
    else { t0 = (row0 - MP) & 15; st = p.in[4] + ((size_t)(l * 8 + ((row0 - MP) >> 4)) * 3) * 2048 + col; }
    (void)hist_rows;
    float w[4][8], bias[8];
#pragma unroll
    for (int j = 0; j < 4; ++j) { f32x4 a = *(const f32x4*)(cw + j * 2048 + col), b = *(const f32x4*)(cw + j * 2048 + col + 4);
      w[j][0] = a[0]; w[j][1] = a[1]; w[j][2] = a[2]; w[j][3] = a[3]; w[j][4] = b[0]; w[j][5] = b[1]; w[j][6] = b[2]; w[j][7] = b[3]; }
    { f32x4 a = *(const f32x4*)(cb + col), b = *(const f32x4*)(cb + col + 4);
      bias[0] = a[0]; bias[1] = a[1]; bias[2] = a[2]; bias[3] = a[3]; bias[4] = b[0]; bias[5] = b[1]; bias[6] = b[2]; bias[7] = b[3]; }
    float x[RG + 3][8];
#pragma unroll
    for (int j = 0; j < RG + 3; ++j) {
      const int t = t0 - 3 + j;
      if (t >= 0) { u32x4 v = *(const u32x4*)(Z + (size_t)(row0 - 3 + j) * NIN + 3072 + col); unpack8(v, x[j]); }
      else if (st) { f32x4 a = *(const f32x4*)(st + (size_t)(3 + t) * 2048), b = *(const f32x4*)(st + (size_t)(3 + t) * 2048 + 4);
        x[j][0] = a[0]; x[j][1] = a[1]; x[j][2] = a[2]; x[j][3] = a[3]; x[j][4] = b[0]; x[j][5] = b[1]; x[j][6] = b[2]; x[j][7] = b[3]; }
      else {
#pragma unroll
        for (int e = 0; e < 8; ++e) x[j][e] = 0.f; }
    }
    const float sc = col >= 1024 ? 0.0625f : 1.f;
    bf16_t* dst = col >= 1024 ? KA + (col - 1024) : QA + col;
#pragma unroll
    for (int a = 0; a < RG; ++a) {
      float o[8];
#pragma unroll
      for (int e = 0; e < 8; ++e) {
        float u = bias[e] + w[0][e] * x[a][e] + w[1][e] * x[a + 1][e] + w[2][e] * x[a + 2][e] + w[3][e] * x[a + 3][e];
        o[e] = u * sigmoidf_(u) * sc;
      }
      u32x4 ov; ov[0] = pk2(o[0], o[1]); ov[1] = pk2(o[2], o[3]); ov[2] = pk2(o[4], o[5]); ov[3] = pk2(o[6], o[7]);
      *(u32x4*)(dst + (size_t)(row0 + a) * D) = ov;
    }
  }
}

constexpr int A_LD = 272;
constexpr int A_TILE = 64 * A_LD;
constexpr int A_VLD = 320;
constexpr int A_VTILE = 64 * A_VLD;
template <int KIND>
DI void attn_item(const Params& p, int l, int b, int ha, int qb, char* lds) {
  const int tid = otid(), lane = tid & 63, wave = uni(tid >> 6);
  const int map = wave >> 2, qt = wave & 3, r = lane & 31, h = lane >> 5;
  const bf16_t* Z = (const bf16_t*)(p.ws + W_Z);
  const int NT = KIND == 0 ? 2 * (qb + 1) : (NKS + 63) / 64;
  const int ntw = KIND == 0 ? 2 * qb + (qt >> 1) + 1 : NT;
  const bool active = KIND == 0 ? true : (qt == 0);
  int qrow;
  if (KIND == 0) qrow = b * SEQ + qb * 128 + qt * 32 + r; else qrow = MP + b * 16 + (r < 16 ? r : 15);
  bf16x8 qf[4];
#pragma unroll
  for (int ks = 0; ks < 4; ++ks) {
    if (KIND == 0) qf[ks] = *(const bf16x8*)(Z + (size_t)qrow * NIN + ha * 128 + map * 64 + ks * 16 + h * 8);
    else {
      const int dn = ks * 16 + h * 8, par = dn >> 5, dd = dn & 31;
      const bf16_t* src = Z + (size_t)qrow * NIN + ha * 128 + map * 64 + 2 * dd;
      const u32x4 lo = *(const u32x4*)src, hi = *(const u32x4*)(src + 8);
      unsigned e[8];
#pragma unroll
      for (int i = 0; i < 4; ++i) { e[i] = par ? (lo[i] >> 16) : (lo[i] & 0xffffu); e[4 + i] = par ? (hi[i] >> 16) : (hi[i] & 0xffffu); }
      u32x4 o; o[0] = e[0] | (e[1] << 16); o[1] = e[2] | (e[3] << 16); o[2] = e[4] | (e[5] << 16); o[3] = e[6] | (e[7] << 16);
      qf[ks] = __builtin_bit_cast(bf16x8, o);
    }
  }
  const int skey = tid >> 4, part = tid & 15;
  u32x4 rk0, rk1, rv0, rv1;
  auto gload = [&](int j) {
    if (KIND == 0) {
      const bf16_t* base = Z + (size_t)(b * SEQ + j * 64 + skey) * NIN + 1024 + ha * 128 + part * 8;
      rk0 = *(const u32x4*)base; rk1 = *(const u32x4*)(base + (size_t)32 * NIN);
      rv0 = *(const u32x4*)(base + 1024); rv1 = *(const u32x4*)(base + (size_t)32 * NIN + 1024);
    } else {
#pragma unroll
      for (int i = 0; i < 2; ++i) {
        int kk = j * 64 + skey + 32 * i; if (kk > NKS - 1) kk = NKS - 1;
        const float *ks_, *vs_;
        if (kk < PAST) { const size_t o = (((size_t)(l * 8 + b) * PAST + kk) * 8 + ha) * 128 + part * 8; ks_ = p.in[2] + o; vs_ = p.in[3] + o; }
        else { const size_t o = (((size_t)l * MS + b * 16 + (kk - PAST)) * 8 + ha) * 128 + part * 8; ks_ = p.out + O_KS + o; vs_ = p.out + O_VS + o; }
        const f32x4 a0 = *(const f32x4*)ks_, a1 = *(const f32x4*)(ks_ + 4), c0 = *(const f32x4*)vs_, c1 = *(const f32x4*)(vs_ + 4);
        u32x4 ko, vo;
        ko[0] = pk2(a0[0], a0[1]); ko[1] = pk2(a0[2], a0[3]); ko[2] = pk2(a1[0], a1[1]); ko[3] = pk2(a1[2], a1[3]);
        vo[0] = pk2(c0[0], c0[1]); vo[1] = pk2(c0[2], c0[3]); vo[2] = pk2(c1[0], c1[1]); vo[3] = pk2(c1[2], c1[3]);
        if (i == 0) { rk0 = ko; rv0 = vo; } else { rk1 = ko; rv1 = vo; }
      }
    }
  };
  f32x16 O[4];
#pragma unroll
  for (int v = 0; v < 4; ++v)
#pragma unroll
    for (int i = 0; i < 16; ++i) O[v][i] = 0.f;
  float m_run = -1e30f, l_run = 0.f;
  const int q4 = (lane & 15) >> 2, p4 = lane & 3, blk = (lane >> 4) & 1;
  const unsigned sofs = skey * A_LD + part * 16, vofs = skey * A_VLD + part * 16;
  auto qk = [&](int j, f32x16 (&st)[2]) {
    const char* kb = lds + (j & 1) * A_TILE;
#pragma unroll
    for (int kt = 0; kt < 2; ++kt) {
#pragma unroll
      for (int i = 0; i < 16; ++i) st[kt][i] = 0.f;
#pragma unroll
      for (int ks = 0; ks < 4; ++ks) {
        const bf16x8 kf = *(const bf16x8*)(kb + (kt * 32 + r) * A_LD + (map * 64 + ks * 16 + h * 8) * 2);
        st[kt] = MFMA32(kf, qf[ks], st[kt]);
      }
    }
    if (KIND == 1 && j == NT - 1) {
#pragma unroll
      for (int kt = 0; kt < 2; ++kt)
#pragma unroll
        for (int i = 0; i < 16; ++i) if (j * 64 + kt * 32 + crow(i, h) >= NKS) st[kt][i] = -1e30f;
    }
  };
  bf16x8 pk[4];
  auto smax = [&](int j, f32x16 (&sc)[2], f32x16 (&sn)[2]) {
    if (j + 1 < ntw) qk(j + 1, sn);
    float mx = sc[0][0];
#pragma unroll
    for (int kt = 0; kt < 2; ++kt)
#pragma unroll
      for (int i = 0; i < 16; ++i) mx = fmaxf(mx, sc[kt][i]);
    mx = fmaxf(mx, __shfl_xor(mx, 32));
    const float m_new = fmaxf(m_run, mx);
    const float alpha = __builtin_amdgcn_exp2f((m_run - m_new) * LOG2E);
    const float mb = m_new * LOG2E;
    float rs = 0.f;
#pragma unroll
    for (int kt = 0; kt < 2; ++kt)
#pragma unroll
      for (int i = 0; i < 16; ++i) { const float e = __builtin_amdgcn_exp2f(sc[kt][i] * LOG2E - mb); sc[kt][i] = e; rs += e; }
    rs += __shfl_xor(rs, 32);
    l_run = l_run * alpha + rs; m_run = m_new;
    if (__builtin_amdgcn_ballot_w64(alpha != 1.f) != 0ull) {
#pragma unroll
      for (int v = 0; v < 4; ++v)
#pragma unroll
        for (int i = 0; i < 16; ++i) O[v][i] *= alpha;
    }
    pk[0] = pack8(sc[0], 0); pk[1] = pack8(sc[0], 1); pk[2] = pack8(sc[1], 0); pk[3] = pack8(sc[1], 1);
  };
  auto pv = [&](int j) {
    const unsigned vaddr = lds_addr(lds + 2 * A_TILE + (j % 3) * A_VTILE) + (4 * h + q4) * A_VLD + (16 * blk + 4 * p4) * 2;
    __builtin_amdgcn_s_setprio(1);
#pragma unroll
    for (int vt = 0; vt < 4; ++vt) {
      bf16x8 vf[4];
      tr_frag4<16 * A_VLD, 8 * A_VLD>(vaddr + vt * 64, vf);
#pragma unroll
      for (int ks = 0; ks < 4; ++ks) O[vt] = MFMA32(vf[ks], pk[ks], O[vt]);
    }
    __builtin_amdgcn_s_setprio(0);
  };
  gload(0);
  { char* kb = lds + sofs; *(u32x4*)kb = rk0; *(u32x4*)(kb + 32 * A_LD) = rk1; char* vb = lds + 2 * A_TILE + vofs; *(u32x4*)vb = rv0; *(u32x4*)(vb + 32 * A_VLD) = rv1; }
  gload(1);
  { char* kb = lds + A_TILE + sofs; *(u32x4*)kb = rk0; *(u32x4*)(kb + 32 * A_LD) = rk1; }
  __syncthreads();
  f32x16 sA[2], sB[2];
  if (active && 0 < ntw) qk(0, sA);
  for (int j = 0; j < NT; j += 2) {
#pragma unroll
    for (int u = 0; u < 2; ++u) {
      const int jj = j + u;
      if (jj < NT) {
        if (jj + 1 < NT) { char* vb = lds + 2 * A_TILE + ((jj + 1) % 3) * A_VTILE + vofs; *(u32x4*)vb = rv0; *(u32x4*)(vb + 32 * A_VLD) = rv1; }
        if (jj + 2 < NT) gload(jj + 2);
        if (active) {
          if (map == 1 && jj >= 1 && jj - 1 < ntw) pv(jj - 1);
          if (jj < ntw) { if (u == 0) smax(jj, sA, sB); else smax(jj, sB, sA); }
          if (map == 0 && jj < ntw) pv(jj);
        }
        if (jj + 2 < NT) { char* kb = lds + (jj & 1) * A_TILE + sofs; *(u32x4*)kb = rk0; *(u32x4*)(kb + 32 * A_LD) = rk1; }
        __syncthreads();
      }
    }
  }
  if (active && map == 1 && ntw == NT) pv(NT - 1);
  __syncthreads();
  float* ex = (float*)lds;
  const float inv_l = 1.f / l_run;
  if (map == 1) {
#pragma unroll
    for (int vt = 0; vt < 4; ++vt)
#pragma unroll
      for (int g = 0; g < 4; ++g) {
        f32x4 o; o[0] = O[vt][4 * g] * inv_l; o[1] = O[vt][4 * g + 1] * inv_l; o[2] = O[vt][4 * g + 2] * inv_l; o[3] = O[vt][4 * g + 3] * inv_l;
        *(f32x4*)(ex + (qt * 32 + r) * 132 + vt * 32 + 8 * g + 4 * h) = o;
      }
  }
  __syncthreads();
  if (map == 0) {
    const float lam = ((const float*)(p.ws + W_MISC))[l];
    const float lam_init = (l == 0) ? 0.2f : (0.8f - 0.6f * 0.74081822068171788f);
    float ssq = 0.f;
#pragma unroll
    for (int vt = 0; vt < 4; ++vt)
#pragma unroll
      for (int g = 0; g < 4; ++g) {
        const f32x4 o2 = *(const f32x4*)(ex + (qt * 32 + r) * 132 + vt * 32 + 8 * g + 4 * h);
#pragma unroll
        for (int e = 0; e < 4; ++e) { const float o = O[vt][4 * g + e] * inv_l - lam * o2[e]; O[vt][4 * g + e] = o; ssq += o * o; }
      }
    ssq += __shfl_xor(ssq, 32);
    const float rms = rsqrtf(ssq * (1.f / 128.f) + LN_EPS) * (1.f - lam_init);
    const float* sg = p.in[14] + l * 128;
    const bool valid = KIND == 0 ? true : (qt == 0 && r < 16);
    if (valid) {
      bf16_t* dst = (bf16_t*)(p.ws + W_Z) + (size_t)qrow * NIN + 3072 + ha * 128;
#pragma unroll
      for (int vt = 0; vt < 4; ++vt)
#pragma unroll
        for (int g = 0; g < 4; ++g) {
          const int v0 = vt * 32 + 8 * g + 4 * h;
          const f32x4 gg = *(const f32x4*)(sg + v0);
          u32x2 o; o[0] = pk2(O[vt][4 * g] * rms * gg[0], O[vt][4 * g + 1] * rms * gg[1]); o[1] = pk2(O[vt][4 * g + 2] * rms * gg[2], O[vt][4 * g + 3] * rms * gg[3]);
          *(u32x2*)(dst + v0) = o;
        }
    }
  }
  __syncthreads();
}

constexpr int L_LD = 528;
constexpr int L_VLD = 320;
constexpr int L_Q = 0, L_K = 64 * L_LD, L_V = 2 * 64 * L_LD, L_SW = L_V + 64 * L_VLD;
constexpr int L_SWLD = 144;
constexpr int L_SC = L_SW + 64 * L_SWLD;
constexpr int S_MX = 0, S_G = 64, S_EMT = 128, S_DS0 = 192, S_DS1 = 256, S_QN = 320  , S_NV = 576  , S_GEND = 832, S_PAR = 840;
constexpr int LDS_BYTES = 153376;
static_assert(L_SC + 2 * S_PAR * 4 <= 131072, "lds");
#define WG_BAR() do { __builtin_amdgcn_fence(__ATOMIC_RELEASE, "workgroup"); __builtin_amdgcn_s_barrier(); __builtin_amdgcn_fence(__ATOMIC_ACQUIRE, "workgroup"); } while (0)

template <int KIND>
DI void mlstm_item(const Params& p, int l, int b, int hm, int half, char* lds) {
  const int tid0 = otid(), wave = uni(tid0 >> 6);
  const bf16_t* QA = (const bf16_t*)(p.ws + W_AB); const bf16_t* KA = (const bf16_t*)(p.ws + W_KA);
  const bf16_t* Z = (const bf16_t*)(p.ws + W_Z); bf16_t* H = (bf16_t*)(p.ws + W_H);
  const float* GIF = (const float*)(p.ws + W_GIF);
  float* scb = (float*)(lds + L_SC);
  int nchunks = KIND == 0 ? SEQ / 64 : 1; asm volatile("" : "+s"(nchunks));
  const int Lv = KIND == 0 ? 64 : 16;
  const size_t bh = KIND == 0 ? (size_t)(l * 4 + b) * 4 + hm : (size_t)(l * 8 + b) * 4 + hm;
  if (wave < 4) {
    f32x16 C[8];
    { const int lane = tid0 & 63, r = lane & 31, h = lane >> 5; (void)r; (void)h;
      if (KIND == 0) {
#pragma unroll
        for (int d = 0; d < 8; ++d)
#pragma unroll
          for (int i = 0; i < 16; ++i) C[d][i] = 0.f;
      } else {
        const float* cp = p.in[5] + bh * 65536 + (size_t)(4 * h) * 256 + half * 128 + wave * 32 + r;
#pragma unroll
        for (int d = 0; d < 8; ++d)
#pragma unroll
          for (int g = 0; g < 4; ++g) {
            C[d][4 * g] = cp[0]; C[d][4 * g + 1] = cp[256]; C[d][4 * g + 2] = cp[512]; C[d][4 * g + 3] = cp[768];
            cp += 2048; asm volatile("" : "+v"(cp));
          }
      }
    }
    for (int c = 0; c < nchunks; ++c) {
      int tid = tid0; asm volatile("" : "+v"(tid));
      const int lane = tid & 63, r = lane & 31, h = lane >> 5;
      const int q4 = (lane & 15) >> 2, p4 = lane & 3, blk = (lane >> 4) & 1;
      const float* sc = scb + (c & 1) * S_PAR;
      const int rowbase = KIND == 0 ? b * SEQ + c * 64 : MP + b * 16;
      WG_BAR();
      f32x16 accB[2];
#pragma unroll
      for (int tt = 0; tt < 2; ++tt)
#pragma unroll
        for (int i = 0; i < 16; ++i) accB[tt][i] = 0.f;
#pragma unroll
      for (int d = 0; d < 8; ++d)
#pragma unroll
        for (int s = 0; s < 2; ++s) {
          __builtin_amdgcn_sched_barrier(0);
          const bf16x8 cf = pack8(C[d], s);
#pragma unroll
          for (int tt = 0; tt < 2; ++tt) {
            const char* qp = lds + L_Q + (tt * 32 + r) * L_LD + (d * 32 + 16 * s + 4 * h) * 2;
            const s16x4 lo = *(const s16x4*)qp, hi = *(const s16x4*)(qp + 16);
            const bf16x8 qfr = __builtin_shufflevector(lo, hi, 0, 1, 2, 3, 4, 5, 6, 7);
            accB[tt] = MFMA32(cf, qfr, accB[tt]);
          }
        }
      __builtin_amdgcn_sched_barrier(0);
      bf16x8 vf[4];
      tr_frag4<16 * L_VLD, 4 * L_VLD>(lds_addr(lds + L_V) + (8 * h + q4) * L_VLD + (wave * 32 + 16 * blk + 4 * p4) * 2, vf);
      const float g_end = sc[S_GEND];
#pragma unroll
      for (int d = 0; d < 8; ++d) {
#pragma unroll
        for (int i = 0; i < 16; ++i) C[d][i] *= g_end;
        bf16x8 kf[4];
        tr_frag4<16 * L_LD, 4 * L_LD>(lds_addr(lds + L_K) + (8 * h + q4) * L_LD + (d * 32 + 16 * blk + 4 * p4) * 2, kf);
#pragma unroll
        for (int ks = 0; ks < 4; ++ks) C[d] = MFMA32(kf[ks], vf[ks], C[d]);
      }
      WG_BAR();
#pragma unroll
      for (int tt = 0; tt < 2; ++tt) {
        const int t = tt * 32 + r;
        const float g = sc[S_G + t];
#pragma unroll
        for (int i = 0; i < 16; ++i) accB[tt][i] *= g;
        const char* sp = lds + L_SW + (tt * 32 + r) * L_SWLD + h * 16;
#pragma unroll
        for (int ks = 0; ks < 4; ++ks) accB[tt] = MFMA32(vf[ks], *(const bf16x8*)(sp + ks * 32), accB[tt]);
        const float qn = (sc[S_QN + t] + sc[S_QN + 64 + t]) + (sc[S_QN + 128 + t] + sc[S_QN + 192 + t]);
        float den = sc[S_DS0 + t] + sc[S_DS1 + t] + g * qn;
        den = fmaxf(fabsf(den), sc[S_EMT + t]);
        const float rden = 1.f / den;
        if (t < Lv) {
          bf16_t* dst = H + (size_t)(rowbase + t) * D + hm * 256 + half * 128 + wave * 32;
#pragma unroll
          for (int g4 = 0; g4 < 4; ++g4) {
            u32x2 o; o[0] = pk2(accB[tt][4 * g4] * rden, accB[tt][4 * g4 + 1] * rden); o[1] = pk2(accB[tt][4 * g4 + 2] * rden, accB[tt][4 * g4 + 3] * rden);
            *(u32x2*)(dst + 8 * g4 + 4 * h) = o;
          }
        }
      }
    }
    WG_BAR();
    {
      const int lane = tid0 & 63, r = lane & 31, h = lane >> 5;
      float* co = p.out + (KIND == 0 ? O_CP : O_CS) + bh * 65536 + (size_t)(4 * h) * 256 + half * 128 + wave * 32 + r;
#pragma unroll
      for (int d = 0; d < 8; ++d)
#pragma unroll
        for (int g = 0; g < 4; ++g) {
          co[0] = C[d][4 * g]; co[256] = C[d][4 * g + 1]; co[512] = C[d][4 * g + 2]; co[768] = C[d][4 * g + 3];
          co += 2048; asm volatile("" : "+v"(co));
        }
    }
  } else {
    const int hw = wave - 4;
    float nreg = 0.f, m_prev = 0.f;
    if (KIND == 1) { nreg = p.in[6][bh * 256 + (tid0 - 256)]; m_prev = p.in[7][bh]; }
    u32x4 pq[8], pk[8], pv[4];
    float gi = 0.f, gf = 0.f, g_end_cur = 0.f;
    auto issue_loads = [&](int c, int tid) {
      const int ht = tid - 256, lane = tid & 63;
      const int rowbase = KIND == 0 ? b * SEQ + c * 64 : MP + b * 16;
      const bool tvalid = lane < Lv;
      gi = tvalid ? GIF[(size_t)(rowbase + lane) * 8 + hm] : -1e30f;
      gf = tvalid ? GIF[(size_t)(rowbase + lane) * 8 + 4 + hm] : 0.f;
#pragma unroll
      for (int i = 0; i < 8; ++i) {
        const int cidx = ht + 256 * i, t = cidx >> 5, pc = cidx & 31;
        const int row = rowbase + (t < Lv ? t : Lv - 1);
        pq[i] = *(const u32x4*)(QA + (size_t)row * D + hm * 256 + pc * 8);
        pk[i] = *(const u32x4*)(KA + (size_t)row * D + hm * 256 + pc * 8);
      }
#pragma unroll
      for (int i = 0; i < 4; ++i) {
        const int cidx = ht + 256 * i, t = cidx >> 4, pc = cidx & 15;
        const int row = rowbase + (t < Lv ? t : Lv - 1);
        pv[i] = *(const u32x4*)(Z + (size_t)row * NIN + 5120 + hm * 256 + half * 128 + pc * 8);
      }
    };
    auto scalars = [&](int par, int lane) -> float {
      const bool tvalid = lane < Lv;
      const float lf = tvalid ? (fminf(gf, 0.f) - __logf(1.f + __expf(-fabsf(gf)))) : 0.f;
      float bc = lf;
#pragma unroll
      for (int o = 1; o < 64; o <<= 1) { const float v = __shfl_up(bc, o); if (lane >= o) bc += v; }
      const float a = gi - bc;
      float cm = a;
#pragma unroll
      for (int o = 1; o < 64; o <<= 1) { const float v = __shfl_up(cm, o); if (lane >= o) cm = fmaxf(cm, v); }
      const float mxv = fmaxf(m_prev, cm);
      const float m_t = bc + mxv;
      const float mx_end = __shfl(mxv, 63), bc_end = __shfl(bc, 63);
      const float wend = __expf(a - mx_end);
      g_end_cur = __expf(m_prev - mx_end);
      if (hw == 0) {
        float* sc = scb + par * S_PAR;
        sc[S_MX + lane] = __expf(mx_end - mxv);
        sc[S_G + lane] = __expf(m_prev - mxv);
        sc[S_EMT + lane] = __expf(-m_t);
        if (lane == 0) sc[S_GEND] = g_end_cur;
      }
      m_prev = bc_end + mx_end;
      return wend;
    };
    auto stage_lds = [&](float wend_l, int tid) {
      const int ht = tid - 256;
#pragma unroll
      for (int i = 0; i < 8; ++i) {
        const int cidx = ht + 256 * i, t = cidx >> 5, pc = cidx & 31;
        const float we = __shfl(wend_l, t);
        float f[8]; unpack8(pk[i], f);
        u32x4 o; o[0] = pk2(f[0] * we, f[1] * we); o[1] = pk2(f[2] * we, f[3] * we); o[2] = pk2(f[4] * we, f[5] * we); o[3] = pk2(f[6] * we, f[7] * we);
        *(u32x4*)(lds + L_Q + t * L_LD + pc * 16) = pq[i];
        *(u32x4*)(lds + L_K + t * L_LD + pc * 16) = o;
      }
#pragma unroll
      for (int i = 0; i < 4; ++i) {
        const int cidx = ht + 256 * i, t = cidx >> 4, pc = cidx & 15;
        *(u32x4*)(lds + L_V + t * L_VLD + pc * 16) = pv[i];
      }
    };
    {
      int tid = tid0; asm volatile("" : "+v"(tid));
      issue_loads(0, tid);
      scb[S_NV + (tid - 256)] = nreg;
      const float wend = scalars(0, tid & 63);
      stage_lds(wend, tid);
    }
    for (int c = 0; c < nchunks; ++c) {
      int tid = tid0; asm volatile("" : "+v"(tid));
      const int ht = tid - 256, lane = tid & 63, r = lane & 31, h = lane >> 5;
      float* sc = scb + (c & 1) * S_PAR;
      float* scn = scb + ((c + 1) & 1) * S_PAR;
      const float g_end_c = g_end_cur;
      WG_BAR();
      const bool more = c + 1 < nchunks;
      if (more) issue_loads(c + 1, tid);
      {
        const int t = ht & 63, part = ht >> 6;
        const char* qp = lds + L_Q + t * L_LD + part * 128;
        float s = 0.f;
#pragma unroll
        for (int e = 0; e < 8; ++e) {
          const u32x4 qq = *(const u32x4*)(qp + e * 16); float f[8]; unpack8(qq, f);
#pragma unroll
          for (int z = 0; z < 8; ++z) s += f[z] * sc[S_NV + part * 64 + e * 8 + z];
        }
        sc[S_QN + part * 64 + t] = s;
      }
      if (hw < 3) {
        const int stl = hw == 2 ? 1 : 0, tt = hw == 0 ? 0 : 1;
        f32x16 S, S2;
#pragma unroll
        for (int i = 0; i < 16; ++i) { S[i] = 0.f; S2[i] = 0.f; }
        const char* ka = lds + L_K + (stl * 32 + r) * L_LD + h * 16;
        const char* qa = lds + L_Q + (tt * 32 + r) * L_LD + h * 16;
#pragma unroll 4
        for (int ks = 0; ks < 16; ks += 2) {
          S = MFMA32(*(const bf16x8*)(ka + ks * 32), *(const bf16x8*)(qa + ks * 32), S);
          S2 = MFMA32(*(const bf16x8*)(ka + ks * 32 + 32), *(const bf16x8*)(qa + ks * 32 + 32), S2);
        }
        const int t = tt * 32 + r;
        const float cw = sc[S_MX + t];
        float rs = 0.f;
#pragma unroll
        for (int g = 0; g < 4; ++g) {
          float wv[4];
#pragma unroll
          for (int e = 0; e < 4; ++e) {
            const int s = stl * 32 + 8 * g + 4 * h + e;
            wv[e] = s <= t ? (S[4 * g + e] + S2[4 * g + e]) * cw : 0.f; rs += wv[e];
          }
          u32x2 o; o[0] = pk2(wv[0], wv[1]); o[1] = pk2(wv[2], wv[3]);
          *(u32x2*)(lds + L_SW + t * L_SWLD + (stl * 32 + 8 * g + 4 * h) * 2) = o;
        }
        rs += __shfl_xor(rs, 32);
        if (h == 0) {
          if (hw == 0) { sc[S_DS0 + t] = rs; sc[S_DS1 + t] = 0.f; }
          else if (hw == 1) sc[S_DS0 + t] = rs;
          else sc[S_DS1 + t] = rs;
        }
      } else {
        const int t = lane >> 1, hs = lane & 1;
        u32x4 z; z[0] = 0; z[1] = 0; z[2] = 0; z[3] = 0;
        *(u32x4*)(lds + L_SW + t * L_SWLD + 64 + hs * 32) = z; *(u32x4*)(lds + L_SW + t * L_SWLD + 64 + hs * 32 + 16) = z;
      }
      {
        float s0 = 0.f, s1 = 0.f, s2 = 0.f, s3 = 0.f;
        const char* kp = lds + L_K + ht * 2;
#pragma unroll
        for (int t = 0; t < 64; t += 4) {
          s0 += bflo((unsigned)*(const bf16_t*)(kp + t * L_LD)); s1 += bflo((unsigned)*(const bf16_t*)(kp + (t + 1) * L_LD));
          s2 += bflo((unsigned)*(const bf16_t*)(kp + (t + 2) * L_LD)); s3 += bflo((unsigned)*(const bf16_t*)(kp + (t + 3) * L_LD));
        }
        nreg = g_end_c * nreg + ((s0 + s1) + (s2 + s3));
        scn[S_NV + ht] = nreg;
      }
      float wend = 0.f;
      if (more) wend = scalars((c + 1) & 1, lane);
      WG_BAR();
      if (more) stage_lds(wend, tid);
    }
    WG_BAR();
    if (half == 0) {
      p.out[(KIND == 0 ? O_NP : O_NS) + bh * 256 + (tid0 - 256)] = nreg;
      if (tid0 == 256) p.out[(KIND == 0 ? O_MPP : O_MSS) + bh] = m_prev;
    }
  }
}

DI void mixer_phase(const Params& p, int l, char* lds, int cidx, bool ml_only) {
  unsigned* ctr = (unsigned*)(p.ws + W_MISC) + 16 + cidx;
  int* s_item = (int*)(lds + LDS_BYTES - 16);
  const int total = 32 + 64 + 64 + 2048;
  for (;;) {
    __syncthreads();
    if (threadIdx.x == 0) *s_item = (int)atomicAdd(ctr, 1u);
    __syncthreads();
    const int it = *s_item;
    __syncthreads();
    if (it >= total) break;
    if (ml_only && it >= 96) break;
    if (it < 32) { mlstm_item<0>(p, l, it >> 3, (it >> 1) & 3, it & 1, lds); continue; }
    if (it < 96) { const int x = it - 32; mlstm_item<1>(p, l, x >> 3, (x >> 1) & 3, x & 1, lds); continue; }
    if (it < 160) { attn_item<1>(p, l, (it - 96) >> 3, (it - 96) & 7, 0, lds); continue; }
    { const int x = it - 160; attn_item<0>(p, l, (x & 31) >> 3, x & 7, 63 - (x >> 5), lds); }
  }
}

DI void merge_phase(const Params& p, int l) {
  const bf16_t* Z = (const bf16_t*)(p.ws + W_Z); const bf16_t* H = (const bf16_t*)(p.ws + W_H); bf16_t* Y = (bf16_t*)(p.ws + W_AB);
  const int tidq = otid(); const int lane = tidq & 63, gw = blockIdx.x * 8 + (tidq >> 6), ngw = gridDim.x * 8;
  const int col = lane * 16;
  float mg[16];
  { const float* mhg = p.in[15] + (size_t)l * D + col;
#pragma unroll
    for (int i = 0; i < 4; ++i) { const f32x4 g = *(const f32x4*)(mhg + 4 * i); mg[4 * i] = g[0]; mg[4 * i + 1] = g[1]; mg[4 * i + 2] = g[2]; mg[4 * i + 3] = g[3]; } }
  for (int row0 = gw; row0 < M; row0 += 2 * ngw) {
    const int row1 = row0 + ngw; const bool has1 = row1 < M;
    u32x4 in[2][10];
#pragma unroll
    for (int q = 0; q < 2; ++q) {
      const size_t row = (size_t)(q == 0 ? row0 : (has1 ? row1 : row0));
      const bf16_t* z = Z + row * NIN + col; const bf16_t* hp = H + row * D + col;
      in[q][0] = *(const u32x4*)hp; in[q][1] = *(const u32x4*)(hp + 8);
#pragma unroll
      for (int hh = 0; hh < 2; ++hh) {
        in[q][2 + hh * 4] = *(const u32x4*)(z + 3072 + hh * 8); in[q][3 + hh * 4] = *(const u32x4*)(z + 6144 + hh * 8);
        in[q][4 + hh * 4] = *(const u32x4*)(z + 7168 + hh * 8); in[q][5 + hh * 4] = *(const u32x4*)(z + 8192 + hh * 8);
      }
    }
#pragma unroll
    for (int q = 0; q < 2; ++q) {
      if (q == 1 && !has1) break;
      const size_t row = (size_t)(q == 0 ? row0 : row1);
      float hv[16];
      unpack8(in[q][0], hv); unpack8(in[q][1], hv + 8);
      float s = 0.f;
#pragma unroll
      for (int e = 0; e < 16; ++e) s += hv[e];
#pragma unroll
      for (int o = 1; o < 16; o <<= 1) s += __shfl_xor(s, o);
      const float mean = s * (1.f / 256.f);
      float s2 = 0.f;
#pragma unroll
      for (int e = 0; e < 16; ++e) { hv[e] -= mean; s2 += hv[e] * hv[e]; }
#pragma unroll
      for (int o = 1; o < 16; o <<= 1) s2 += __shfl_xor(s2, o);
      const float rstd = rsqrtf(s2 * (1.f / 256.f) + LN_EPS);
      u32x4 out[2];
#pragma unroll
      for (int hh = 0; hh < 2; ++hh) {
        float oa[8], om[8], ga[8], gb[8];
        unpack8(in[q][2 + hh * 4], oa); unpack8(in[q][3 + hh * 4], om); unpack8(in[q][4 + hh * 4], ga); unpack8(in[q][5 + hh * 4], gb);
        float y[8];
#pragma unroll
        for (int e = 0; e < 8; ++e) {
          const float hn = hv[hh * 8 + e] * rstd * mg[hh * 8 + e];
          y[e] = sigmoidf_(ga[e]) * oa[e] + sigmoidf_(gb[e]) * (hn * sigmoidf_(om[e]));
        }
        out[hh][0] = pk2(y[0], y[1]); out[hh][1] = pk2(y[2], y[3]); out[hh][2] = pk2(y[4], y[5]); out[hh][3] = pk2(y[6], y[7]);
      }
      *(u32x4*)(Y + row * D + col) = out[0]; *(u32x4*)(Y + row * D + col + 8) = out[1];
    }
  }
}

DI void ln_phase(const Params& p, const float* g, const float* bta, bool final_out) {
  const int tidq = otid(); const int lane = tidq & 63, gw = blockIdx.x * 8 + (tidq >> 6), ngw = gridDim.x * 8;
  float* R = (float*)(p.ws + W_R); bf16_t* AB = (bf16_t*)(p.ws + W_AB);
  f32x4 gq[4], bq[4];
#pragma unroll
  for (int j = 0; j < 4; ++j) { gq[j] = *(const f32x4*)(g + j * 256 + lane * 4); bq[j] = *(const f32x4*)(bta + j * 256 + lane * 4); }
  for (int row0 = gw; row0 < M; row0 += 2 * ngw) {
    f32x4 v[2][4]; float s[2] = {0.f, 0.f};
    const int row1 = row0 + ngw; const bool has1 = row1 < M;
#pragma unroll
    for (int q = 0; q < 2; ++q) {
      const float* xr = R + (size_t)(q == 0 ? row0 : (has1 ? row1 : row0)) * D;
#pragma unroll
      for (int j = 0; j < 4; ++j) { v[q][j] = *(const f32x4*)(xr + j * 256 + lane * 4); s[q] += (v[q][j][0] + v[q][j][1]) + (v[q][j][2] + v[q][j][3]); }
    }
#pragma unroll
    for (int q = 0; q < 2; ++q) {
      if (q == 1 && !has1) break;
      const int row = q == 0 ? row0 : row1;
      const float mean = wave_sum(s[q]) * (1.f / D);
      float s2 = 0.f;
#pragma unroll
      for (int j = 0; j < 4; ++j) { v[q][j] = v[q][j] - mean; s2 += (v[q][j][0] * v[q][j][0] + v[q][j][1] * v[q][j][1]) + (v[q][j][2] * v[q][j][2] + v[q][j][3] * v[q][j][3]); }
      const float rstd = rsqrtf(wave_sum(s2) * (1.f / D) + LN_EPS);
      float* dst = final_out ? (row < MP ? p.out + O_YP + (size_t)row * D : p.out + O_YS + (size_t)(row - MP) * D) : R + (size_t)row * D;
#pragma unroll
      for (int j = 0; j < 4; ++j) {
        const int c = j * 256 + lane * 4;
        const f32x4 o = v[q][j] * rstd * gq[j] + bq[j];
        *(f32x4*)(dst + c) = o;
        if (!final_out) { u32x2 ob; ob[0] = pk2(o[0], o[1]); ob[1] = pk2(o[2], o[3]); *(u32x2*)(AB + (size_t)row * D + c) = ob; }
      }
    }
  }
}

DI float gelu_f(float v) {
  const float av = fabsf(v), d = av * 0.2316418882f + 1.0f;
  const float t = __builtin_amdgcn_rcpf(d);
  float q = t * 0.5307027145f + (-0.7265760135f); q = q * t + 0.7107068705f; q = q * t + (-0.142248368f); q = q * t + 0.127414796f; q = q * t;
  const float e = __builtin_amdgcn_exp2f((v * v) * (-0.72134752044f));
  const float m = v * (q * e), r = v - m;
  return v < 0.f ? m : r;
}
DI void ffnconv_phase(const Params& p, int l) {
  const bf16_t* U = (const bf16_t*)(p.ws + W_Z); bf16_t* HF = (bf16_t*)(p.ws + W_Z + (size_t)M * NUP * 2);
  const float* cw = p.in[20] + (size_t)l * 3 * NUP; const float* cb = p.in[21] + (size_t)l * NUP;
  constexpr int RG = 8;
  const unsigned total = (unsigned)(M / RG) * 352u;
  for (unsigned it = blockIdx.x * NTH + (unsigned)otid(); it < total; it += gridDim.x * NTH) {
    const unsigned rg = it / 352u, cc = it - rg * 352u;
    const int col = (int)cc * 8, row0 = (int)rg * RG;
    int t0; const float* st = nullptr;
    if (row0 < MP) t0 = row0 & (SEQ - 1); else { t0 = (row0 - MP) & 15; st = p.in[8] + ((size_t)(l * 8 + ((row0 - MP) >> 4)) * 2) * NUP; }
    float gl[RG][8];
#pragma unroll
    for (int hf = 0; hf < 2; ++hf) {
      const int c2 = col + hf * DFF;
      float w[3][8], bias[8], x[RG + 2][8];
#pragma unroll
      for (int j = 0; j < 3; ++j) { const f32x4 a = *(const f32x4*)(cw + j * NUP + c2), b2 = *(const f32x4*)(cw + j * NUP + c2 + 4);
        w[j][0] = a[0]; w[j][1] = a[1]; w[j][2] = a[2]; w[j][3] = a[3]; w[j][4] = b2[0]; w[j][5] = b2[1]; w[j][6] = b2[2]; w[j][7] = b2[3]; }
      { const f32x4 a = *(const f32x4*)(cb + c2), b2 = *(const f32x4*)(cb + c2 + 4);
        bias[0] = a[0]; bias[1] = a[1]; bias[2] = a[2]; bias[3] = a[3]; bias[4] = b2[0]; bias[5] = b2[1]; bias[6] = b2[2]; bias[7] = b2[3]; }
#pragma unroll
      for (int j = 0; j < RG + 2; ++j) {
        const int t = t0 - 2 + j;
        if (t >= 0) unpack8(*(const u32x4*)(U + (size_t)(row0 - 2 + j) * NUP + c2), x[j]);
        else if (st) { const float* sp = st + (size_t)(2 + t) * NUP + c2; const f32x4 a = *(const f32x4*)sp, b2 = *(const f32x4*)(sp + 4);
          x[j][0] = a[0]; x[j][1] = a[1]; x[j][2] = a[2]; x[j][3] = a[3]; x[j][4] = b2[0]; x[j][5] = b2[1]; x[j][6] = b2[2]; x[j][7] = b2[3]; }
        else {
#pragma unroll
          for (int e = 0; e < 8; ++e) x[j][e] = 0.f; }
      }
#pragma unroll
      for (int a = 0; a < RG; ++a) {
        float o[8];
#pragma unroll
        for (int e = 0; e < 8; ++e) {
          const float u = bias[e] + w[0][e] * x[a][e] + w[1][e] * x[a + 1][e] + w[2][e] * x[a + 2][e];
          if (hf == 0) gl[a][e] = gelu_f(u); else o[e] = gl[a][e] * u;
        }
        if (hf == 1) {
          u32x4 ov; ov[0] = pk2(o[0], o[1]); ov[1] = pk2(o[2], o[3]); ov[2] = pk2(o[4], o[5]); ov[3] = pk2(o[6], o[7]);
          *(u32x4*)(HF + (size_t)(row0 + a) * DFF + col) = ov;
        }
      }
    }
  }
}

#define XB_TMO      128
#define XB_XCNT(j)  (256  + 64 * (j))
#define XB_XSUB(j)  (1280 + 64 * (j))
#define XB_XGEN(j)  (2304 + 64 * (j))
#define XB_TOP      3328
#define XB_TOPGEN   3392
#define XCD_BAR_WORDS 3456
#define XB_SPIN_CAP (1u << 18)
#define XLAS __attribute__((address_space(3)))
DI unsigned xb_ld(unsigned* p)              { return __hip_atomic_load(p, __ATOMIC_RELAXED, __HIP_MEMORY_SCOPE_AGENT); }
DI unsigned xb_add(unsigned* p, unsigned v) { return __hip_atomic_fetch_add(p, v, __ATOMIC_RELAXED, __HIP_MEMORY_SCOPE_AGENT); }
DI unsigned xb_xcc_id() { return (unsigned)__builtin_amdgcn_s_getreg((3 << 11) | 20) & 0xFu; }
#define XB_SPIN(cond, bar) do { unsigned _sp = 0; while (cond) { __builtin_amdgcn_s_sleep(1); \
    if ((++_sp & 255u) == 0u) { if (xb_ld(&(bar)[XB_TMO])) break; if (_sp > XB_SPIN_CAP) { atomicAdd(&(bar)[XB_TMO], 1u); break; } } } } while (0)
struct XcdBarrier { unsigned* bar; unsigned x; volatile XLAS unsigned* st; };
DI XcdBarrier xcd_barrier_post(unsigned* bar, volatile XLAS unsigned* st) {
  XcdBarrier b; b.bar = bar; b.x = xb_xcc_id(); b.st = st;
  if (threadIdx.x == 0) (void)xb_add(&bar[XB_XCNT(b.x)], 1u);
  return b;
}
DI void xcd_barrier_complete(unsigned* bar, unsigned x, unsigned& nloc, unsigned& nx) {
  const unsigned G = gridDim.x * gridDim.y * gridDim.z;
  unsigned sum, cnt, mine, sp = 0u;
  for (;;) {
    sum = 0u; cnt = 0u; mine = 0u;
#pragma unroll
    for (unsigned j = 0; j < 16; ++j) { const unsigned c = xb_ld(&bar[XB_XCNT(j)]); sum += c; cnt += (c > 0u) ? 1u : 0u; mine = (j == x) ? c : mine; }
    if (sum == G) break;
    __builtin_amdgcn_s_sleep(1);
    if ((++sp & 255u) == 0u) { if (xb_ld(&bar[XB_TMO])) break; if (sp > XB_SPIN_CAP) { atomicAdd(&bar[XB_TMO], 1u); break; } }
  }
  nloc = mine > 0u ? mine : 1u; nx = cnt > 0u ? cnt : 1u;
}
DI void xcd_barrier(const XcdBarrier& b) {
  asm volatile("s_waitcnt vmcnt(0)" ::: "memory");
  __syncthreads();
  if (threadIdx.x == 0) {
    unsigned* bar = b.bar;
    __builtin_amdgcn_s_waitcnt(0);
    unsigned nloc = b.st[0], nx = b.st[1];
    if (nloc == 0u) { xcd_barrier_complete(bar, b.x, nloc, nx); b.st[0] = nloc; b.st[1] = nx; }
    const unsigned old = xb_add(&bar[XB_XSUB(b.x)], 1u);
    const unsigned gen = old / nloc;
    if (old + 1u == (gen + 1u) * nloc) {
      __builtin_amdgcn_fence(__ATOMIC_RELEASE, "agent");
      asm volatile("s_waitcnt vmcnt(0)" ::: "memory");
      const unsigned og = xb_add(&bar[XB_TOP], 1u);
      const unsigned tg = og / nx;
      if (og + 1u == (tg + 1u) * nx) xb_add(&bar[XB_TOPGEN], 1u);
      else XB_SPIN(xb_ld(&bar[XB_TOPGEN]) == tg, bar);
      __builtin_amdgcn_fence(__ATOMIC_ACQUIRE, "agent");
      xb_add(&bar[XB_XGEN(b.x)], 1u);
      asm volatile("s_waitcnt vmcnt(0)" ::: "memory");
    } else {
      XB_SPIN(xb_ld(&bar[XB_XGEN(b.x)]) == gen, bar);
      __builtin_amdgcn_fence(__ATOMIC_ACQUIRE, "agent");
      asm volatile("s_waitcnt vmcnt(0)" ::: "memory");
    }
  }
  __syncthreads();
}

constexpr int NPH = 21;
DI void run_phase(const Params& p, int ph, char* lds) {
#ifndef ONLY
  if (ph == 0) { phase0(p, lds); return; }
#else
  if (ph == 0) return;
#endif
  const int l = (ph - 1) / 10, s = (ph - 1) % 10;
#ifdef ONLY
  if (s != ONLY) return;
#endif
  switch (s) {
    case 0: gemm_phase<EPI_IN>(p, l, (const bf16_t*)(p.ws + W_AB), D, (const bf16_t*)(p.ws + W_WIN) + (size_t)l * NIN * D, D, NIN / 256, lds); break;
    case 1: qkconv_phase(p, l); gif_phase(p, l, lds, 0); break;
    case 2: mixer_phase(p, l, lds, l, false); break;
    case 3: merge_phase(p, l); break;
    case 4: gemm_phase<EPI_OUT>(p, l, (const bf16_t*)(p.ws + W_AB), D, (const bf16_t*)(p.ws + W_WOUT) + (size_t)l * D * D, D, D / 256, lds); break;
    case 5: ln_phase(p, p.in[17] + l * D, p.in[18] + l * D, false); break;
    case 6: gemm_phase<EPI_UP>(p, l, (const bf16_t*)(p.ws + W_AB), D, (const bf16_t*)(p.ws + W_WUP) + (size_t)l * NUP * D, D, NUP / 256, lds); break;
    case 7: ffnconv_phase(p, l); break;
    case 8: gemm_phase<EPI_DOWN>(p, l, (const bf16_t*)(p.ws + W_Z + (size_t)M * NUP * 2), DFF, (const bf16_t*)(p.ws + W_WDN) + (size_t)l * D * DFF, DFF, D / 256, lds); break;
    case 9: ln_phase(p, p.in[23] + l * D, p.in[24] + l * D, l == 1); break;
  }
}

__global__ void __launch_bounds__(NTH) mega(Params p, int ph_lo, int ph_hi) {
  extern __shared__ __attribute__((aligned(16))) char lds[];
#if MULTI_LAUNCH
  for (int ph = ph_lo; ph < ph_hi; ++ph) run_phase(p, ph, lds);
#else
  cg::grid_group grid = cg::this_grid();
  phase0(p, lds);
  grid.sync();
  volatile XLAS unsigned* xst = (volatile XLAS unsigned*)((XLAS char*)lds + (LDS_BYTES - 32));
  if (threadIdx.x == 0) { xst[0] = 0u; xst[1] = 0u; }
  __syncthreads();
  const XcdBarrier xb = xcd_barrier_post((unsigned*)(p.ws + W_BAR), xst);
#define GSYNC() xcd_barrier(xb)
  for (int l = 0; l < 2; ++l) {
    gemm_phase<EPI_IN>(p, l, (const bf16_t*)(p.ws + W_AB), D, (const bf16_t*)(p.ws + W_WIN) + (size_t)l * NIN * D, D, NIN / 256, lds);
    {
      const int nun = NTM * (NIN / 256), G = (int)gridDim.x;
      const int busy = nun % G;
      gif_phase(p, l, lds, (busy > 0 && busy * 2 < G) ? busy : 0);
    }
    GSYNC();
#ifdef PROBE_GIN2
    gemm_phase<EPI_IN>(p, l, (const bf16_t*)(p.ws + W_AB), D, (const bf16_t*)(p.ws + W_WIN) + (size_t)l * NIN * D, D, NIN / 256, lds);
    GSYNC();
#endif
    qkconv_phase(p, l);
    GSYNC();
#if defined(PROBE_EW2) || defined(PROBE_QKC2)
    qkconv_phase(p, l);
    GSYNC();
#endif
    mixer_phase(p, l, lds, l, false);
    GSYNC();
#ifdef PROBE_ML2
    mixer_phase(p, l, lds, l + 2, true);
    GSYNC();
#endif
#ifdef PROBE_MIX2
    mixer_phase(p, l, lds, l + 2, false);
    GSYNC();
#endif
    merge_phase(p, l);
    GSYNC();
#ifdef PROBE_SYNC
    for (int q = 0; q < 20; ++q) GSYNC();
#endif
#if defined(PROBE_EW2) || defined(PROBE_MRG2)
    merge_phase(p, l);
    GSYNC();
#endif
    gemm_phase<EPI_OUT>(p, l, (const bf16_t*)(p.ws + W_AB), D, (const bf16_t*)(p.ws + W_WOUT) + (size_t)l * D * D, D, D / 256, lds);
    GSYNC();
    ln_phase(p, p.in[17] + l * D, p.in[18] + l * D, false);
    GSYNC();
    gemm_phase<EPI_UP>(p, l, (const bf16_t*)(p.ws + W_AB), D, (const bf16_t*)(p.ws + W_WUP) + (size_t)l * NUP * D, D, NUP / 256, lds);
    GSYNC();
    ffnconv_phase(p, l);
    GSYNC();
#if defined(PROBE_EW2) || defined(PROBE_FFC2)
    ffnconv_phase(p, l);
    GSYNC();
#endif
    gemm_phase<EPI_DOWN>(p, l, (const bf16_t*)(p.ws + W_Z + (size_t)M * NUP * 2), DFF, (const bf16_t*)(p.ws + W_WDN) + (size_t)l * D * DFF, DFF, D / 256, lds);
    GSYNC();
    ln_phase(p, p.in[23] + l * D, p.in[24] + l * D, l == 1);
    if (l == 0) GSYNC();
  }
#endif
}

extern "C" void kernel_launch(void* const* d_in, const int* in_sizes, int n_in, void* d_out, int out_size, void* d_ws, size_t ws_size, hipStream_t stream) {
  static int grid = 0;
  if (grid == 0) {
    if (n_in != 25 || (size_t)out_size != O_END || ws_size < W_END) { fprintf(stderr, "kernel_launch: unexpected sizes n_in %d out %d (want %zu) ws %zu (want %zu)\n", n_in, out_size, (size_t)O_END, ws_size, (size_t)W_END); grid = -1; return; }
    int dev = 0, cus = 0, per_cu = 0;
    hipGetDevice(&dev);
    hipDeviceGetAttribute(&cus, hipDeviceAttributeMultiprocessorCount, dev);
    if (hipFuncSetAttribute((const void*)mega, hipFuncAttributeMaxDynamicSharedMemorySize, LDS_BYTES) != hipSuccess) { fprintf(stderr, "hipFuncSetAttribute failed\n"); grid = -1; return; }
    hipOccupancyMaxActiveBlocksPerMultiprocessor(&per_cu, (const void*)mega, NTH, LDS_BYTES);
    if (per_cu < 1) per_cu = 1;
    grid = cus * 1;
    (void)hipGetLastError();
  }
  if (grid < 0) return;
  Params p{};
  for (int i = 0; i < 25; ++i) p.in[i] = (const float*)d_in[i];
  p.out = (float*)d_out; p.ws = (unsigned char*)d_ws;
#if MULTI_LAUNCH
  for (int ph = 0; ph < NPH; ++ph) hipLaunchKernelGGL(mega, dim3(grid), dim3(NTH), LDS_BYTES, stream, p, ph, ph + 1);
#else
  int lo = 0, hi = NPH;
  void* args[] = {&p, &lo, &hi};
  hipError_t e = hipLaunchCooperativeKernel((const void*)mega, dim3(grid), dim3(NTH), args, LDS_BYTES, stream);
  if (e != hipSuccess) fprintf(stderr, "cooperative launch failed: %s (grid %d)\n", hipGetErrorString(e), grid);
#endif
}
```

```cpp
#include <hip/hip_runtime.h>
#include <hip/hip_cooperative_groups.h>
#include <cstdio>
namespace cg = cooperative_groups;

#ifndef MULTI_LAUNCH
#define MULTI_LAUNCH 0
#endif

typedef unsigned short bf16_t;
typedef short bf16x8 __attribute__((ext_vector_type(8)));
typedef short s16x4 __attribute__((ext_vector_type(4)));
typedef float f32x16 __attribute__((ext_vector_type(16)));
typedef float f32x4 __attribute__((ext_vector_type(4)));
typedef unsigned u32x4 __attribute__((ext_vector_type(4)));
typedef unsigned u32x2 __attribute__((ext_vector_type(2)));
#define DI __device__ __forceinline__
#define MFMA32(a, b, c) __builtin_amdgcn_mfma_f32_32x32x16_bf16((a), (b), (c), 0, 0, 0)

constexpr int NTH = 512;
constexpr int D = 1024, SEQ = 8192, NB = 4, MP = NB * SEQ, MS = 128, M = MP + MS, NTM = 129;
constexpr int DIN = 9224, NIN = 9216, DFF = 2816, NUP = 5632;
constexpr int PAST = 4096, NKS = PAST + 16;
constexpr float ALPHA = 1.4142135623730951f;
constexpr float LN_EPS = 1e-5f;
constexpr float LOG2E = 1.4426950408889634f;

constexpr size_t O_YP = 0;
constexpr size_t O_YS = O_YP + (size_t)MP * D;
constexpr size_t O_KP = O_YS + (size_t)MS * D;
constexpr size_t O_VP = O_KP + (size_t)2 * MP * 1024;
constexpr size_t O_MCP = O_VP + (size_t)2 * MP * 1024;
constexpr size_t O_CP = O_MCP + (size_t)2 * 4 * 3 * 2048;
constexpr size_t O_NP = O_CP + (size_t)2 * 4 * 4 * 65536;
constexpr size_t O_MPP = O_NP + (size_t)2 * 4 * 4 * 256;
constexpr size_t O_FCP = O_MPP + 32;
constexpr size_t O_KS = O_FCP + (size_t)2 * 4 * 2 * NUP;
constexpr size_t O_VS = O_KS + (size_t)2 * MS * 1024;
constexpr size_t O_MCS = O_VS + (size_t)2 * MS * 1024;
constexpr size_t O_CS = O_MCS + (size_t)2 * 8 * 3 * 2048;
constexpr size_t O_NS = O_CS + (size_t)2 * 8 * 4 * 65536;
constexpr size_t O_MSS = O_NS + (size_t)2 * 8 * 4 * 256;
constexpr size_t O_FCS = O_MSS + 64;
constexpr size_t O_END = O_FCS + (size_t)2 * 8 * 2 * NUP;

constexpr size_t W_Z = 0;
constexpr size_t W_H = W_Z + (size_t)M * NIN * 2;
constexpr size_t W_AB = W_H + (size_t)M * D * 2;
constexpr size_t W_KA = W_AB + (size_t)M * D * 2;
constexpr size_t W_R = W_KA + (size_t)M * D * 2;
constexpr size_t W_WIN = W_R + (size_t)M * D * 4;
constexpr size_t W_WOUT = W_WIN + (size_t)2 * NIN * D * 2;
constexpr size_t W_WUP = W_WOUT + (size_t)2 * D * D * 2;
constexpr size_t W_WDN = W_WUP + (size_t)2 * NUP * D * 2;
constexpr size_t W_GIF = W_WDN + (size_t)2 * D * DFF * 2;
constexpr size_t W_ROPE = W_GIF + (size_t)M * 8 * 4;
constexpr size_t W_MISC = W_ROPE + (size_t)8192 * 32 * 8;
constexpr size_t W_BAR = W_MISC + 4096;
constexpr size_t W_END = W_BAR + 16384;

struct Params {
  const float* in[25];
  float* out;
  unsigned char* ws;
};

DI unsigned f2bf(float x) { unsigned u = __float_as_uint(x); u += 0x7fffu + ((u >> 16) & 1u); return u >> 16; }
typedef __bf16 bf16v2 __attribute__((ext_vector_type(2)));
typedef float f32x2 __attribute__((ext_vector_type(2)));
DI unsigned pk2(float a, float b) { f32x2 v; v[0] = a; v[1] = b; return __builtin_bit_cast(unsigned, __builtin_convertvector(v, bf16v2)); }
DI float bflo(unsigned u) { return __uint_as_float(u << 16); }
DI float bfhi(unsigned u) { return __uint_as_float(u & 0xffff0000u); }
DI float sigmoidf_(float x) { return __builtin_amdgcn_rcpf(1.f + __builtin_amdgcn_exp2f(-1.4426950408889634f * x)); }
DI float wave_sum(float v) {
#pragma unroll
  for (int o = 1; o < 64; o <<= 1) v += __shfl_xor(v, o);
  return v;
}
DI int crow(int i, int h) { return (i & 3) + 8 * (i >> 2) + 4 * h; }
DI bf16x8 pack8(const f32x16& x, int s) {
  u32x4 p;
  p[0] = pk2(x[8 * s + 0], x[8 * s + 1]); p[1] = pk2(x[8 * s + 2], x[8 * s + 3]);
  p[2] = pk2(x[8 * s + 4], x[8 * s + 5]); p[3] = pk2(x[8 * s + 6], x[8 * s + 7]);
  return __builtin_bit_cast(bf16x8, p);
}
DI void unpack8(u32x4 v, float* f) {
  f[0] = bflo(v[0]); f[1] = bfhi(v[0]); f[2] = bflo(v[1]); f[3] = bfhi(v[1]);
  f[4] = bflo(v[2]); f[5] = bfhi(v[2]); f[6] = bflo(v[3]); f[7] = bfhi(v[3]);
}
typedef __attribute__((address_space(3))) s16x4 lds_s16x4;
DI bf16x8 tr_frag(unsigned a_lo, unsigned a_hi) {
  const s16x4 lo = __builtin_amdgcn_ds_read_tr16_b64_v4i16((lds_s16x4*)(size_t)a_lo);
  const s16x4 hi = __builtin_amdgcn_ds_read_tr16_b64_v4i16((lds_s16x4*)(size_t)a_hi);
  return __builtin_shufflevector(lo, hi, 0, 1, 2, 3, 4, 5, 6, 7);
}
template <int STEP, int HIOFF>
DI void tr_frag4(unsigned a, bf16x8 (&f)[4]) {
#pragma unroll
  for (int i = 0; i < 4; ++i) f[i] = tr_frag(a + i * STEP, a + i * STEP + HIOFF);
}
DI int otid() { int t = threadIdx.x; asm volatile("" : "+v"(t)); return t; }
DI int uni(int v) { return __builtin_amdgcn_readfirstlane(v); }
DI unsigned lds_addr(const void* p) { return (unsigned)(size_t)p; }

DI const float* xrow_ptr(const Params& p, int l, int row) {
  if (l == 0) return row < MP ? p.in[0] + (size_t)row * D : p.in[1] + (size_t)(row - MP) * D;
  return (const float*)(p.ws + W_R) + (size_t)row * D;
}

DI void transpose_w(const float* W, int K, int N, int src_ld, bf16_t* WT, bool remap, char* lds) {
  float* scr = (float*)lds;
  const int nkb = K / 64, nnb = N / 64, tid = otid();
  for (int it = blockIdx.x; it < nkb * nnb; it += gridDim.x) {
    const int kb = it / nnb, nb = it % nnb, k0 = kb * 64, n0 = nb * 64;
    const int ns = (remap && n0 >= 7168) ? n0 + 8 : n0;
#pragma unroll
    for (int i = 0; i < 8; ++i) {
      const int kk = (tid >> 6) + 8 * i, nn = tid & 63;
      scr[kk * 65 + nn] = W[(size_t)(k0 + kk) * src_ld + ns + nn];
    }
    __syncthreads();
    {
      const int n = tid >> 3, c = tid & 7;
      const float* s = scr + (8 * c) * 65 + n;
      u32x4 o;
      o[0] = pk2(s[0], s[65]); o[1] = pk2(s[2 * 65], s[3 * 65]); o[2] = pk2(s[4 * 65], s[5 * 65]); o[3] = pk2(s[6 * 65], s[7 * 65]);
      const int nd = (remap && n0 < 2048) ? ((n < 32) ? 2 * n : 2 * (n - 32) + 1) : n;
      *(u32x4*)(WT + (size_t)(n0 + nd) * K + k0 + 8 * c) = o;
    }
    __syncthreads();
  }
}

DI void phase0(const Params& p, char* lds) {
  const int tid = otid();
  for (int l = 0; l < 2; ++l) {
    transpose_w(p.in[9] + (size_t)l * D * DIN, D, NIN, DIN, (bf16_t*)(p.ws + W_WIN) + (size_t)l * NIN * D, true, lds);
    transpose_w(p.in[16] + (size_t)l * D * D, D, D, D, (bf16_t*)(p.ws + W_WOUT) + (size_t)l * D * D, false, lds);
    transpose_w(p.in[19] + (size_t)l * D * NUP, D, NUP, NUP, (bf16_t*)(p.ws + W_WUP) + (size_t)l * NUP * D, false, lds);
    transpose_w(p.in[22] + (size_t)l * DFF * D, DFF, D, D, (bf16_t*)(p.ws + W_WDN) + (size_t)l * D * DFF, false, lds);
  }
  bf16_t* ab = (bf16_t*)(p.ws + W_AB);
  {
    const unsigned total = (unsigned)M * 128u, S = gridDim.x * NTH;
    for (unsigned c0 = blockIdx.x * NTH + (unsigned)tid; c0 < total; c0 += 4u * S) {
      f32x4 a[4], b4[4];
#pragma unroll
      for (int u = 0; u < 4; ++u) {
        const unsigned c = c0 + (unsigned)u * S;
        if (c < total) { const float* src = xrow_ptr(p, 0, (int)(c >> 7)) + (c & 127u) * 8; a[u] = *(const f32x4*)src; b4[u] = *(const f32x4*)(src + 4); }
      }
#pragma unroll
      for (int u = 0; u < 4; ++u) {
        const unsigned c = c0 + (unsigned)u * S;
        if (c < total) {
          u32x4 o; o[0] = pk2(a[u][0], a[u][1]); o[1] = pk2(a[u][2], a[u][3]); o[2] = pk2(b4[u][0], b4[u][1]); o[3] = pk2(b4[u][2], b4[u][3]);
          *(u32x4*)(ab + (size_t)(c >> 7) * D + (c & 127u) * 8) = o;
        }
      }
    }
  }
  float2* rope = (float2*)(p.ws + W_ROPE);
  for (int i = blockIdx.x * NTH + tid; i < 8192 * 32; i += gridDim.x * NTH) {
    const int pos = i >> 5, d = i & 31;
    const double inv = exp2(-(double)d * (13.287712379549449 / 32.0));
    double ang = (double)pos * inv;
    const double twopi = 6.283185307179586476925;
    ang -= twopi * rint(ang / twopi);
    float s, c; sincosf((float)ang, &s, &c);
    rope[i] = make_float2(c, s);
  }
  if (blockIdx.x == 0 && tid < 128) {
    const int l = tid >> 6, ln = tid & 63;
    const float* lp = p.in[13] + (size_t)l * 4 * 64;
    const float s1 = wave_sum(lp[ln] * lp[64 + ln]), s2 = wave_sum(lp[128 + ln] * lp[192 + ln]);
    const float lam_init = (l == 0) ? 0.2f : (0.8f - 0.6f * 0.74081822068171788f);
    if (ln == 0) ((float*)(p.ws + W_MISC))[l] = __expf(s1) - __expf(s2) + lam_init;
  }
  if (blockIdx.x == 0 && tid < 8) ((unsigned*)(p.ws + W_MISC))[16 + tid] = 0u;
  if (blockIdx.x == 0) for (int i = tid; i < 3456; i += NTH) ((unsigned*)(p.ws + W_BAR))[i] = 0u;
}

namespace pg8 {
#define PG8_LAS __attribute__((address_space(3)))
typedef unsigned short bf16_t;
typedef short bf16x8 __attribute__((ext_vector_type(8)));
typedef float f32x4 __attribute__((ext_vector_type(4)));
typedef unsigned u32x4 __attribute__((ext_vector_type(4)));
constexpr int BM = 256, BK = 64, HALF = 128, HTB = HALF * BK * 2  , STAGE_BYTES = 8 * HTB, NXCD = 8, WGM = 8;

__host__ __device__ __forceinline__ int lds_byte(int r, int c) { const int st = (r >> 4) * 2 + (c >> 5), rr = r & 15, cc = c & 31, ob = rr * 64 + cc * 2; return st * 1024 + (ob ^ (((ob >> 9) & 1) << 5)); }
__host__ __device__ __forceinline__ void stage_rc(int b, int& R, int& C) { const int st = b / 1024, sb = b % 1024, swz = sb ^ (((sb >> 9) & 1) << 5); R = (st >> 1) * 16 + swz / 64; C = (st & 1) * 32 + (swz % 64) / 2; }
__host__ __device__ __forceinline__ int perm32(int rho) { const int n = rho >> 4, i = rho & 15; return 8 * (i >> 2) + 4 * n + (i & 3); }

struct Unit { int pm, pn; };
struct Gemm { const bf16_t* A; const bf16_t* Bt; int M, N, K; };

struct StaticOrder {
    int nM, nN, nwg, G, c;
    __host__ __device__ void init(int M, int N, int G_, int c_) { nM = M / BM; nN = N / BM; nwg = nM * nN; G = G_; c = c_; }
    __host__ __device__ bool next(int i, Unit& u) const {
        const long L = (long)i * G + c; if (L >= nwg) return false;
        int wgid = (int)L; { const int q = nwg / NXCD, r = nwg % NXCD, xcd = wgid % NXCD, off = wgid / NXCD; wgid = (xcd < r ? xcd * (q + 1) : r * (q + 1) + (xcd - r) * q) + off; }
        const int nig = WGM * nN, gid = wgid / nig, fm = gid * WGM, gsz = (nM - fm) < WGM ? (nM - fm) : WGM;
        u.pm = fm + ((wgid % nig) % gsz); u.pn = (wgid % nig) / gsz; return true;
    }
    __device__ __forceinline__ void a_ready(const Unit&) const {}
    __device__ __forceinline__ void done(const Unit&) const {}
};
template <class Epi, class Sched, bool STAMP = false>
__device__ __forceinline__ void gemm_phase(PG8_LAS unsigned char* lds, const Gemm g, const Sched& S, const Epi& E, unsigned long long* stamps) {
    const int tid = otid(), wid = __builtin_amdgcn_readfirstlane(tid >> 6), lane = tid & 63, wr = wid >> 2, wc = wid & 3, fr = lane & 15, fq = lane >> 4;
    const int K = g.K, nt = K / BK;
    int ts_lo = 0, ts_hi = 0, nts = 0; const unsigned long long rt_entry = STAMP ? (unsigned long long)wall_clock64() : 0ull;
#define PG8_STAMP() do { if (STAMP && wid == 0 && nts < 64) { const unsigned long long _c = (unsigned long long)clock64(); \
        ts_lo = (lane == nts) ? (int)(unsigned)_c : ts_lo; ts_hi = (lane == nts) ? (int)(unsigned)(_c >> 32) : ts_hi; ++nts; } } while (0)
    PG8_STAMP();
    unsigned voffA[2], voffB[2];
#pragma unroll
    for (int i = 0; i < 2; ++i) { int R, C; stage_rc(tid * 16 + i * 8192, R, C); const int Rb = Epi::PERM ? ((R & ~31) + perm32(R & 31)) : R;
        voffA[i] = (unsigned)(R * K + C) * 2u; voffB[i] = (unsigned)(Rb * K + C) * 2u; }
    const size_t kstep = (size_t)(BK * 2);
    const size_t hstep = (size_t)HALF * K * 2;
    const size_t tstep = 2 * hstep;
    const unsigned ldsw = (unsigned)wid * 1024u;
    const int aoff = lds_byte(wr * 64 + fr, fq * 8), boff = lds_byte(wc * 32 + fr, fq * 8);
#define PG8_SA(b, h) (((b) * 2 + (h)) * HTB)
#define PG8_SB(b, h) ((4 + (b) * 2 + (h)) * HTB)
#define PG8_STAGE(bufoff, gbase, voff) do { _Pragma("unroll") for (int _i = 0; _i < 2; ++_i) \
        __builtin_amdgcn_global_load_lds((const unsigned*)((const char*)(gbase) + (voff)[_i]), (PG8_LAS unsigned*)(lds + (bufoff) + ldsw + _i * 8192), 16, 0, 0); } while (0)
#define PG8_LDA(dst, b, h) do { _Pragma("unroll") for (int m = 0; m < 4; ++m) _Pragma("unroll") for (int k = 0; k < 2; ++k) dst[m][k] = *(const PG8_LAS bf16x8*)(lds + PG8_SA(b, h) + aoff + m * 2048 + k * 1024); } while (0)
#define PG8_LDB(dst, b, h) do { _Pragma("unroll") for (int n = 0; n < 2; ++n) _Pragma("unroll") for (int k = 0; k < 2; ++k) dst[n][k] = *(const PG8_LAS bf16x8*)(lds + PG8_SB(b, h) + boff + n * 2048 + k * 1024); } while (0)
#define PG8_MMA(ai, bj, At, Bt) do { __builtin_amdgcn_s_setprio(1); _Pragma("unroll") for (int m = 0; m < 4; ++m) _Pragma("unroll") for (int n = 0; n < 2; ++n) _Pragma("unroll") for (int k = 0; k < 2; ++k) \
        acc[ai][bj][m][n] = __builtin_amdgcn_mfma_f32_16x16x32_bf16(Bt[n][k], At[m][k], acc[ai][bj][m][n], 0, 0, 0); __builtin_amdgcn_s_setprio(0); } while (0)
#define PG8_WAIT_V(n) asm volatile("s_waitcnt vmcnt(" #n ")" ::: "memory")
#define PG8_WAIT_L(n) asm volatile("s_waitcnt lgkmcnt(" #n ")" ::: "memory")
#define PG8_BAR __builtin_amdgcn_s_barrier()
#define PG8_SCHED __builtin_amdgcn_sched_barrier(0)
    Unit cur, nxt; int ui = 0;
    if (!S.next(0, cur)) return;
    f32x4 acc[2][2][4][2];
#pragma unroll
    for (int a = 0; a < 2; ++a)
#pragma unroll
        for (int b = 0; b < 2; ++b)
#pragma unroll
            for (int m = 0; m < 4; ++m)
#pragma unroll
                for (int n = 0; n < 2; ++n) acc[a][b][m][n] = (f32x4){0.f, 0.f, 0.f, 0.f};
    bf16x8 At[4][2], B0[2][2], B1[2][2];
    const char* cA = (const char*)g.A + (size_t)cur.pm * tstep; const char* cB = (const char*)g.Bt + (size_t)cur.pn * tstep;
    S.a_ready(cur);
    PG8_STAGE(PG8_SB(0, 0), cB, voffB); PG8_STAGE(PG8_SA(0, 0), cA, voffA); PG8_STAGE(PG8_SB(0, 1), cB + hstep, voffB); PG8_STAGE(PG8_SA(0, 1), cA + hstep, voffA);
    if (wr == 1) PG8_BAR;
    PG8_WAIT_V(4); PG8_BAR;
    PG8_STAGE(PG8_SB(1, 0), cB + kstep, voffB); PG8_STAGE(PG8_SA(1, 0), cA + kstep, voffA); PG8_STAGE(PG8_SB(1, 1), cB + hstep + kstep, voffB);
    PG8_WAIT_V(6); PG8_BAR;
    PG8_STAMP();
    for (;;) {
        const bool has_next = S.next(ui + 1, nxt);
        const char* nA = has_next ? (const char*)g.A + (size_t)nxt.pm * tstep : cA; const char* nB = has_next ? (const char*)g.Bt + (size_t)nxt.pn * tstep : cB;
        for (int t = 0; t < nt; t += 2) {
            const bool last = (t == nt - 2);
            const char* a1 = cA + (size_t)(t + 1) * kstep;
            const char* a2 = last ? nA : cA + (size_t)(t + 2) * kstep; const char* b2 = last ? nB : cB + (size_t)(t + 2) * kstep;
            const char* a3 = a2 + kstep; const char* b3 = b2 + kstep;
            if (last && has_next) S.a_ready(nxt);
            PG8_LDB(B0, 0, 0); PG8_SCHED; PG8_LDA(At, 0, 0); PG8_STAGE(PG8_SA(1, 1), a1 + hstep, voffA);
            PG8_WAIT_L(8); PG8_BAR; PG8_WAIT_L(0); PG8_MMA(0, 0, At, B0); PG8_BAR; PG8_SCHED;
            PG8_LDB(B1, 0, 1); PG8_STAGE(PG8_SB(0, 0), b2, voffB);
            PG8_BAR; PG8_WAIT_L(0); PG8_MMA(0, 1, At, B1); PG8_BAR;
            PG8_LDA(At, 0, 1); PG8_STAGE(PG8_SA(0, 0), a2, voffA);
            PG8_BAR; PG8_WAIT_L(0); PG8_MMA(1, 0, At, B0); PG8_BAR; PG8_SCHED;
            PG8_STAGE(PG8_SB(0, 1), b2 + hstep, voffB);
            PG8_WAIT_V(6); PG8_BAR; PG8_MMA(1, 1, At, B1); PG8_BAR;
            PG8_LDB(B0, 1, 0); PG8_SCHED; PG8_LDA(At, 1, 0); PG8_STAGE(PG8_SA(0, 1), a2 + hstep, voffA);
            PG8_WAIT_L(8); PG8_BAR; PG8_WAIT_L(0); PG8_MMA(0, 0, At, B0); PG8_BAR; PG8_SCHED;
            PG8_LDB(B1, 1, 1); PG8_STAGE(PG8_SB(1, 0), b3, voffB);
            PG8_BAR; PG8_WAIT_L(0); PG8_MMA(0, 1, At, B1); PG8_BAR;
            PG8_LDA(At, 1, 1); PG8_STAGE(PG8_SA(1, 0), a3, voffA);
            PG8_BAR; PG8_WAIT_L(0); PG8_MMA(1, 0, At, B0); PG8_BAR; PG8_SCHED;
            PG8_STAGE(PG8_SB(1, 1), b3 + hstep, voffB);
            PG8_WAIT_V(6); PG8_BAR; PG8_MMA(1, 1, At, B1); PG8_BAR;
        }
        PG8_STAMP();
        if constexpr (!Epi::AFTER_DRAIN) { E(acc, cur, wr, wc, fr, fq); S.done(cur); }
        PG8_STAMP();
        if (!has_next) break;
#pragma unroll
        for (int a = 0; a < 2; ++a)
#pragma unroll
            for (int b = 0; b < 2; ++b)
#pragma unroll
                for (int m = 0; m < 4; ++m)
#pragma unroll
                    for (int n = 0; n < 2; ++n) acc[a][b][m][n] = (f32x4){0.f, 0.f, 0.f, 0.f};
        cur = nxt; cA = nA; cB = nB; ++ui;
    }
    PG8_WAIT_V(0);
    if (wr == 0) PG8_BAR;
    PG8_BAR;
    if constexpr (Epi::AFTER_DRAIN) { E.fused(acc, cur, wr, wc, fr, fq, lds, wid, lane); S.done(cur); }
    PG8_STAMP();
    if (STAMP && wid == 0) { stamps[lane] = lane < nts ? (((unsigned long long)(unsigned)ts_hi << 32) | (unsigned)ts_lo) : 0ull;
        if (lane == 62) stamps[62] = rt_entry; if (lane == 63) stamps[63] = (unsigned long long)wall_clock64(); }
#undef PG8_STAMP
#undef PG8_SA
#undef PG8_SB
#undef PG8_STAGE
#undef PG8_LDA
#undef PG8_LDB
#undef PG8_MMA
#undef PG8_WAIT_V
#undef PG8_WAIT_L
#undef PG8_BAR
#undef PG8_SCHED
}
}

enum { EPI_IN = 0, EPI_OUT = 1, EPI_UP = 2, EPI_DOWN = 3 };
template <int MODE>
struct Epi {
  static constexpr bool PERM = true, AFTER_DRAIN = false;
  Params p; int l;
  DI void operator()(const f32x4 (&acc)[2][2][4][2], const pg8::Unit& u, int wr, int wc, int fr, int fq) const {
    const int colb = u.pn * 256 + wc * 32 + 8 * fq;
    if (MODE == EPI_OUT || MODE == EPI_DOWN) {
      float* Rb = (float*)(p.ws + W_R);
#pragma unroll
      for (int ai = 0; ai < 2; ++ai) {
        f32x4 res[4][2][2];
#pragma unroll
        for (int m = 0; m < 4; ++m) {
          const int row = u.pm * 256 + ai * 128 + wr * 64 + m * 16 + fr;
          const float* rs = (MODE == EPI_OUT ? xrow_ptr(p, l, row < M ? row : M - 1) : Rb + (size_t)(row < M ? row : M - 1) * D) + colb;
#pragma unroll
          for (int bj = 0; bj < 2; ++bj) { res[m][bj][0] = *(const f32x4*)(rs + bj * 128); res[m][bj][1] = *(const f32x4*)(rs + bj * 128 + 4); }
        }
#pragma unroll
        for (int m = 0; m < 4; ++m) {
          const int row = u.pm * 256 + ai * 128 + wr * 64 + m * 16 + fr;
          if (row < M) {
            float* R = Rb + (size_t)row * D + colb;
#pragma unroll
            for (int bj = 0; bj < 2; ++bj) {
              *(f32x4*)(R + bj * 128) = res[m][bj][0] * ALPHA + acc[ai][bj][m][0];
              *(f32x4*)(R + bj * 128 + 4) = res[m][bj][1] * ALPHA + acc[ai][bj][m][1];
            }
          }
        }
      }
      return;
    }
    f32x4 rc0[8], rc1[8];
    if (MODE == EPI_IN && (u.pn >> 2) <= 1) {
      const int d0 = (colb & 63) >> 1;
#pragma unroll
      for (int i = 0; i < 8; ++i) {
        int row = u.pm * 256 + (i >> 2) * 128 + wr * 64 + (i & 3) * 16 + fr; row = row < M ? row : M - 1;
        const int pos = row < MP ? (row & (SEQ - 1)) : PAST + ((row - MP) & 15);
        const f32x4* rp = (const f32x4*)((const float2*)(p.ws + W_ROPE) + pos * 32 + d0);
        rc0[i] = rp[0]; rc1[i] = rp[1];
      }
    }
#pragma unroll
    for (int ai = 0; ai < 2; ++ai)
#pragma unroll
      for (int m = 0; m < 4; ++m) {
        const int row = u.pm * 256 + ai * 128 + wr * 64 + m * 16 + fr;
        if (row < M) {
#pragma unroll
          for (int bj = 0; bj < 2; ++bj) {
            const int col = colb + bj * 128;
            const f32x4 v0 = acc[ai][bj][m][0], v1 = acc[ai][bj][m][1];
            if (MODE == EPI_IN) {
              bf16_t* Z = (bf16_t*)(p.ws + W_Z);
              const int seg = u.pn >> 2;
              if (seg <= 1) {
                const int d0 = (col & 63) >> 1;
                const f32x4 c01 = rc0[ai * 4 + m], c23 = rc1[ai * 4 + m];
                const float a0 = v0[0] * c01[0] - v0[1] * c01[1], b0 = v0[1] * c01[0] + v0[0] * c01[1];
                const float a1 = v0[2] * c01[2] - v0[3] * c01[3], b1 = v0[3] * c01[2] + v0[2] * c01[3];
                const float a2 = v1[0] * c23[0] - v1[1] * c23[1], b2 = v1[1] * c23[0] + v1[0] * c23[1];
                const float a3 = v1[2] * c23[2] - v1[3] * c23[3], b3 = v1[3] * c23[2] + v1[2] * c23[3];
                const float qs = seg == 0 ? 0.125f : 1.f;
                u32x4 o; o[0] = pk2(a0 * qs, b0 * qs); o[1] = pk2(a1 * qs, b1 * qs); o[2] = pk2(a2 * qs, b2 * qs); o[3] = pk2(a3 * qs, b3 * qs);
                *(u32x4*)(Z + (size_t)row * NIN + col) = o;
                if (seg == 1) {
                  float* ob = (row < MP ? p.out + O_KP + ((size_t)l * MP + row) * 1024 : p.out + O_KS + ((size_t)l * MS + row - MP) * 1024) + ((col - 1024) & ~63) + d0;
                  f32x4 o1, o2; o1[0] = a0; o1[1] = a1; o1[2] = a2; o1[3] = a3; o2[0] = b0; o2[1] = b1; o2[2] = b2; o2[3] = b3;
                  *(f32x4*)ob = o1; *(f32x4*)(ob + 32) = o2;
                }
              } else {
                u32x4 o; o[0] = pk2(v0[0], v0[1]); o[1] = pk2(v0[2], v0[3]); o[2] = pk2(v1[0], v1[1]); o[3] = pk2(v1[2], v1[3]);
                *(u32x4*)(Z + (size_t)row * NIN + col) = o;
                if (seg == 2) {
                  float* ob = (row < MP ? p.out + O_VP + ((size_t)l * MP + row) * 1024 : p.out + O_VS + ((size_t)l * MS + row - MP) * 1024) + (col - 2048);
                  *(f32x4*)ob = v0; *(f32x4*)(ob + 4) = v1;
                } else if (seg == 3 || seg == 4) {
                  float* ob = nullptr;
                  if (row < MP) { const int s = row & (SEQ - 1); if (s >= SEQ - 3) ob = p.out + O_MCP + ((size_t)(l * 4 + (row >> 13)) * 3 + (s - (SEQ - 3))) * 2048 + col - 3072; }
                  else { const int t = (row - MP) & 15, b = (row - MP) >> 4; if (t >= 13) ob = p.out + O_MCS + ((size_t)(l * 8 + b) * 3 + (t - 13)) * 2048 + col - 3072; }
                  if (ob) { *(f32x4*)ob = v0; *(f32x4*)(ob + 4) = v1; }
                }
              }
            } else if (MODE == EPI_OUT || MODE == EPI_DOWN) {
              float* R = (float*)(p.ws + W_R) + (size_t)row * D + col;
              const float* rs = MODE == EPI_OUT ? xrow_ptr(p, l, row) + col : R;
              const f32x4 r0 = *(const f32x4*)rs, r1 = *(const f32x4*)(rs + 4);
              *(f32x4*)R = r0 * ALPHA + v0; *(f32x4*)(R + 4) = r1 * ALPHA + v1;
            } else {
              bf16_t* U = (bf16_t*)(p.ws + W_Z);
              u32x4 o; o[0] = pk2(v0[0], v0[1]); o[1] = pk2(v0[2], v0[3]); o[2] = pk2(v1[0], v1[1]); o[3] = pk2(v1[2], v1[3]);
              *(u32x4*)(U + (size_t)row * NUP + col) = o;
              float* ob = nullptr;
              if (row < MP) { const int s = row & (SEQ - 1); if (s >= SEQ - 2) ob = p.out + O_FCP + ((size_t)(l * 4 + (row >> 13)) * 2 + (s - (SEQ - 2))) * NUP + col; }
              else { const int t = (row - MP) & 15, b = (row - MP) >> 4; if (t >= 14) ob = p.out + O_FCS + ((size_t)(l * 8 + b) * 2 + (t - 14)) * NUP + col; }
              if (ob) { *(f32x4*)ob = v0; *(f32x4*)(ob + 4) = v1; }
            }
          }
        }
      }
  }
};

template <int MODE>
DI void gemm_phase(const Params& p, int l, const bf16_t* A, int lda, const bf16_t* Bt, int K, int ntn, char* lds) {
  (void)lda;
  pg8::Gemm g; g.A = A; g.Bt = Bt; g.M = ((MODE == EPI_OUT || MODE == EPI_DOWN) ? NTM - 1 : NTM) * 256; g.N = ntn * 256; g.K = K;
  if (MODE == EPI_OUT || MODE == EPI_DOWN) sample_gemm<MODE>(p, l, A, Bt, K);
  pg8::StaticOrder S; S.init(g.M, g.N, (int)gridDim.x, (int)blockIdx.x);
  Epi<MODE> E; E.p = p; E.l = l;
  pg8::gemm_phase<Epi<MODE>, pg8::StaticOrder, false>((PG8_LAS unsigned char*)lds, g, S, E, nullptr);
  __syncthreads();
}

typedef float f32x4v __attribute__((ext_vector_type(4)));
template <int MODE>
DI void sample_gemm(const Params& p, int l, const bf16_t* A, const bf16_t* Bt, int K) {
  if (blockIdx.x >= 64) return;
  const int tid = otid(), lane = tid & 63, wave = uni(tid >> 6), fr = lane & 15, fq = lane >> 4;
  const bf16_t* ap = A + (size_t)(MP + wave * 16 + fr) * K + fq * 8;
  const bf16_t* bp = Bt + (size_t)(blockIdx.x * 16 + fr) * K + fq * 8;
  f32x4v acc0 = {0.f, 0.f, 0.f, 0.f}, acc1 = {0.f, 0.f, 0.f, 0.f};
  for (int k0 = 0; k0 < K; k0 += 256) {
    bf16x8 a[8], bb[8];
#pragma unroll
    for (int i = 0; i < 8; ++i) { a[i] = *(const bf16x8*)(ap + k0 + i * 32); bb[i] = *(const bf16x8*)(bp + k0 + i * 32); }
#pragma unroll
    for (int i = 0; i < 8; i += 2) {
      acc0 = __builtin_amdgcn_mfma_f32_16x16x32_bf16(a[i], bb[i], acc0, 0, 0, 0);
      acc1 = __builtin_amdgcn_mfma_f32_16x16x32_bf16(a[i + 1], bb[i + 1], acc1, 0, 0, 0);
    }
  }
  const int col = blockIdx.x * 16 + fr;
  float* R = (float*)(p.ws + W_R);
#pragma unroll
  for (int j = 0; j < 4; ++j) {
    const int row = MP + wave * 16 + fq * 4 + j;
    const float res = MODE == EPI_OUT ? xrow_ptr(p, l, row)[col] : R[(size_t)row * D + col];
    R[(size_t)row * D + col] = ALPHA * res + (acc0[j] + acc1[j]);
  }
}

DI void gif_phase(const Params& p, int l, char* lds, int first_blk) {
  if ((int)blockIdx.x < first_blk) return;
  const int tidq = otid(); const int lane = tidq & 63, gw = ((int)blockIdx.x - first_blk) * 8 + (tidq >> 6), ngw = ((int)gridDim.x - first_blk) * 8;
  const float* w = p.in[9] + (size_t)l * D * DIN + 7168;
  const float* bif = p.in[10] + l * 8;
  float* gif = (float*)(p.ws + W_GIF);
  float* w8 = (float*)lds;
  __syncthreads();
#pragma unroll
  for (int i = 0; i < 2; ++i) {
    const int k = tidq + 512 * i;
    *(f32x4*)(w8 + k * 8) = *(const f32x4*)(w + (size_t)k * DIN); *(f32x4*)(w8 + k * 8 + 4) = *(const f32x4*)(w + (size_t)k * DIN + 4);
  }
  __syncthreads();
  for (int rg = gw; rg < M / 4; rg += ngw) {
    float acc[4][8];
#pragma unroll
    for (int a = 0; a < 4; ++a)
#pragma unroll
      for (int j = 0; j < 8; ++j) acc[a][j] = 0.f;
    const float* x0 = xrow_ptr(p, l, rg * 4);
#pragma unroll 4
    for (int kk = 0; kk < 16; ++kk) {
      const int k = kk * 64 + lane;
      const f32x4 w0 = *(const f32x4*)(w8 + k * 8), w1 = *(const f32x4*)(w8 + k * 8 + 4);
#pragma unroll
      for (int a = 0; a < 4; ++a) {
        const float xv = x0[(size_t)a * D + k];
        acc[a][0] += xv * w0[0]; acc[a][1] += xv * w0[1]; acc[a][2] += xv * w0[2]; acc[a][3] += xv * w0[3];
        acc[a][4] += xv * w1[0]; acc[a][5] += xv * w1[1]; acc[a][6] += xv * w1[2]; acc[a][7] += xv * w1[3];
      }
    }
#pragma unroll
    for (int a = 0; a < 4; ++a)
#pragma unroll
      for (int j = 0; j < 8; ++j) {
        const float s = wave_sum(acc[a][j]);
        if (lane == 0) gif[(size_t)(rg * 4 + a) * 8 + j] = s + bif[j];
      }
  }
  __syncthreads();
}

DI void qkconv_phase(const Params& p, int l) {
  const bf16_t* Z = (const bf16_t*)(p.ws + W_Z);
  bf16_t* QA = (bf16_t*)(p.ws + W_AB); bf16_t* KA = (bf16_t*)(p.ws + W_KA);
  const float* cw = p.in[11] + (size_t)l * 4 * 2048; const float* cb = p.in[12] + (size_t)l * 2048;
  constexpr int RG = 8;
  const size_t total = (size_t)(M / RG) * 256;
  const int tid_ = otid();
  const int col = (tid_ & 255) * 8;
  float w[4][8], bias[8];
#pragma unroll
  for (int j = 0; j < 4; ++j) { f32x4 a = *(const f32x4*)(cw + j * 2048 + col), b = *(const f32x4*)(cw + j * 2048 + col + 4);
    w[j][0] = a[0]; w[j][1] = a[1]; w[j][2] = a[2]; w[j][3] = a[3]; w[j][4] = b[0]; w[j][5] = b[1]; w[j][6] = b[2]; w[j][7] = b[3]; }
  { f32x4 a = *(const f32x4*)(cb + col), b = *(const f32x4*)(cb + col + 4);
    bias[0] = a[0]; bias[1] = a[1]; bias[2] = a[2]; bias[3] = a[3]; bias[4] = b[0]; bias[5] = b[1]; bias[6] = b[2]; bias[7] = b[3]; }
  for (size_t it = (size_t)blockIdx.x * NTH + tid_; it < total; it += (size_t)gridDim.x * NTH) {
    const int rg = (int)(it >> 8), row0 = rg * RG;
    int t0;
    const float* st = nullptr;
    if (row0 < MP) { t0 = row0 & (SEQ - 1); }
    else { t0 = (row0 - MP) & 15; st = p.in[4] + ((size_t)(l * 8 + ((row0 - MP) >> 4)) * 3) * 2048 + col; }
    float x[RG + 3][8];
#pragma unroll
    for (int j = 0; j < RG + 3; ++j) {
      const int t = t0 - 3 + j;
      if (t >= 0) { u32x4 v = *(const u32x4*)(Z + (size_t)(row0 - 3 + j) * NIN + 3072 + col); unpack8(v, x[j]); }
      else if (st) { f32x4 a = *(const f32x4*)(st + (size_t)(3 + t) * 2048), b = *(const f32x4*)(st + (size_t)(3 + t) * 2048 + 4);
        x[j][0] = a[0]; x[j][1] = a[1]; x[j][2] = a[2]; x[j][3] = a[3]; x[j][4] = b[0]; x[j][5] = b[1]; x[j][6] = b[2]; x[j][7] = b[3]; }
      else {
#pragma unroll
        for (int e = 0; e < 8; ++e) x[j][e] = 0.f; }
    }
    const float sc = col >= 1024 ? 0.0625f : 1.f;
    bf16_t* dst = col >= 1024 ? KA + (col - 1024) : QA + col;
#pragma unroll
    for (int a = 0; a < RG; ++a) {
      float o[8];
#pragma unroll
      for (int e = 0; e < 8; ++e) {
        float u = bias[e] + w[0][e] * x[a][e] + w[1][e] * x[a + 1][e] + w[2][e] * x[a + 2][e] + w[3][e] * x[a + 3][e];
        o[e] = u * sigmoidf_(u) * sc;
      }
      u32x4 ov; ov[0] = pk2(o[0], o[1]); ov[1] = pk2(o[2], o[3]); ov[2] = pk2(o[4], o[5]); ov[3] = pk2(o[6], o[7]);
      *(u32x4*)(dst + (size_t)(row0 + a) * D) = ov;
    }
  }
}

constexpr int A_LD = 272;
constexpr int A_TILE = 64 * A_LD;
constexpr int A_VLD = 320;
constexpr int A_VTILE = 64 * A_VLD;
template <int KIND>
DI void attn_item(const Params& p, int l, int b, int ha, int qb, char* lds) {
  const int tid = otid(), lane = tid & 63, wave = uni(tid >> 6);
  const int map = wave >> 2, qt = wave & 3, r = lane & 31, h = lane >> 5;
  const bf16_t* Z = (const bf16_t*)(p.ws + W_Z);
  const int NT = KIND == 0 ? 2 * (qb + 1) : (NKS + 63) / 64;
  const int ntw = KIND == 0 ? 2 * qb + (qt >> 1) + 1 : NT;
  const bool active = KIND == 0 ? true : (qt == 0);
  int qrow;
  if (KIND == 0) qrow = b * SEQ + qb * 128 + qt * 32 + r; else qrow = MP + b * 16 + (r < 16 ? r : 15);
  bf16x8 qf[4];
#pragma unroll
  for (int ks = 0; ks < 4; ++ks) {
    if (KIND == 0) qf[ks] = *(const bf16x8*)(Z + (size_t)qrow * NIN + ha * 128 + map * 64 + ks * 16 + h * 8);
    else {
      const int dn = ks * 16 + h * 8, par = dn >> 5, dd = dn & 31;
      const bf16_t* src = Z + (size_t)qrow * NIN + ha * 128 + map * 64 + 2 * dd;
      const u32x4 lo = *(const u32x4*)src, hi = *(const u32x4*)(src + 8);
      unsigned e[8];
#pragma unroll
      for (int i = 0; i < 4; ++i) { e[i] = par ? (lo[i] >> 16) : (lo[i] & 0xffffu); e[4 + i] = par ? (hi[i] >> 16) : (hi[i] & 0xffffu); }
      u32x4 o; o[0] = e[0] | (e[1] << 16); o[1] = e[2] | (e[3] << 16); o[2] = e[4] | (e[5] << 16); o[3] = e[6] | (e[7] << 16);
      qf[ks] = __builtin_bit_cast(bf16x8, o);
    }
  }
  const int skey = tid >> 4, part = tid & 15;
  u32x4 rk0, rk1, rv0, rv1;
  auto gload = [&](int j) {
    if (KIND == 0) {
      const bf16_t* base = Z + (size_t)(b * SEQ + j * 64 + skey) * NIN + 1024 + ha * 128 + part * 8;
      rk0 = *(const u32x4*)base; rk1 = *(const u32x4*)(base + (size_t)32 * NIN);
      rv0 = *(const u32x4*)(base + 1024); rv1 = *(const u32x4*)(base + (size_t)32 * NIN + 1024);
    } else {
#pragma unroll
      for (int i = 0; i < 2; ++i) {
        int kk = j * 64 + skey + 32 * i; if (kk > NKS - 1) kk = NKS - 1;
        const float *ks_, *vs_;
        if (kk < PAST) { const size_t o = (((size_t)(l * 8 + b) * PAST + kk) * 8 + ha) * 128 + part * 8; ks_ = p.in[2] + o; vs_ = p.in[3] + o; }
        else { const size_t o = (((size_t)l * MS + b * 16 + (kk - PAST)) * 8 + ha) * 128 + part * 8; ks_ = p.out + O_KS + o; vs_ = p.out + O_VS + o; }
        const f32x4 a0 = *(const f32x4*)ks_, a1 = *(const f32x4*)(ks_ + 4), c0 = *(const f32x4*)vs_, c1 = *(const f32x4*)(vs_ + 4);
        u32x4 ko, vo;
        ko[0] = pk2(a0[0], a0[1]); ko[1] = pk2(a0[2], a0[3]); ko[2] = pk2(a1[0], a1[1]); ko[3] = pk2(a1[2], a1[3]);
        vo[0] = pk2(c0[0], c0[1]); vo[1] = pk2(c0[2], c0[3]); vo[2] = pk2(c1[0], c1[1]); vo[3] = pk2(c1[2], c1[3]);
        if (i == 0) { rk0 = ko; rv0 = vo; } else { rk1 = ko; rv1 = vo; }
      }
    }
  };
  f32x16 O[4];
#pragma unroll
  for (int v = 0; v < 4; ++v)
#pragma unroll
    for (int i = 0; i < 16; ++i) O[v][i] = 0.f;
  float m_run = -1e30f, l_run = 0.f;
  const int q4 = (lane & 15) >> 2, p4 = lane & 3, blk = (lane >> 4) & 1;
  const unsigned sofs = skey * A_LD + part * 16, vofs = skey * A_VLD + part * 16;
  auto qk = [&](int j, f32x16 (&st)[2]) {
    const char* kb = lds + (j & 1) * A_TILE;
#pragma unroll
    for (int kt = 0; kt < 2; ++kt) {
#pragma unroll
      for (int i = 0; i < 16; ++i) st[kt][i] = 0.f;
#pragma unroll
      for (int ks = 0; ks < 4; ++ks) {
        const bf16x8 kf = *(const bf16x8*)(kb + (kt * 32 + r) * A_LD + (map * 64 + ks * 16 + h * 8) * 2);
        st[kt] = MFMA32(kf, qf[ks], st[kt]);
      }
    }
    if (KIND == 1 && j == NT - 1) {
#pragma unroll
      for (int kt = 0; kt < 2; ++kt)
#pragma unroll
        for (int i = 0; i < 16; ++i) if (j * 64 + kt * 32 + crow(i, h) >= NKS) st[kt][i] = -1e30f;
    }
  };
  bf16x8 pk[4];
  auto smax = [&](int j, f32x16 (&sc)[2], f32x16 (&sn)[2]) {
    if (j + 1 < ntw) qk(j + 1, sn);
    float mx = sc[0][0];
#pragma unroll
    for (int kt = 0; kt < 2; ++kt)
#pragma unroll
      for (int i = 0; i < 16; ++i) mx = fmaxf(mx, sc[kt][i]);
    mx = fmaxf(mx, __shfl_xor(mx, 32));
    const float m_new = fmaxf(m_run, mx);
    const float alpha = __builtin_amdgcn_exp2f((m_run - m_new) * LOG2E);
    const float mb = m_new * LOG2E;
    float rs = 0.f;
#pragma unroll
    for (int kt = 0; kt < 2; ++kt)
#pragma unroll
      for (int i = 0; i < 16; ++i) { const float e = __builtin_amdgcn_exp2f(sc[kt][i] * LOG2E - mb); sc[kt][i] = e; rs += e; }
    rs += __shfl_xor(rs, 32);
    l_run = l_run * alpha + rs; m_run = m_new;
    if (__builtin_amdgcn_ballot_w64(alpha != 1.f) != 0ull) {
#pragma unroll
      for (int v = 0; v < 4; ++v)
#pragma unroll
        for (int i = 0; i < 16; ++i) O[v][i] *= alpha;
    }
    pk[0] = pack8(sc[0], 0); pk[1] = pack8(sc[0], 1); pk[2] = pack8(sc[1], 0); pk[3] = pack8(sc[1], 1);
  };
  auto pv = [&](int j) {
    const unsigned vaddr = lds_addr(lds + 2 * A_TILE + (j % 3) * A_VTILE) + (4 * h + q4) * A_VLD + (16 * blk + 4 * p4) * 2;
    __builtin_amdgcn_s_setprio(1);
#pragma unroll
    for (int vt = 0; vt < 4; ++vt) {
      bf16x8 vf[4];
      tr_frag4<16 * A_VLD, 8 * A_VLD>(vaddr + vt * 64, vf);
#pragma unroll
      for (int ks = 0; ks < 4; ++ks) O[vt] = MFMA32(vf[ks], pk[ks], O[vt]);
    }
    __builtin_amdgcn_s_setprio(0);
  };
  gload(0);
  { char* kb = lds + sofs; *(u32x4*)kb = rk0; *(u32x4*)(kb + 32 * A_LD) = rk1; char* vb = lds + 2 * A_TILE + vofs; *(u32x4*)vb = rv0; *(u32x4*)(vb + 32 * A_VLD) = rv1; }
  gload(1);
  { char* kb = lds + A_TILE + sofs; *(u32x4*)kb = rk0; *(u32x4*)(kb + 32 * A_LD) = rk1; }
  __syncthreads();
  f32x16 sA[2], sB[2];
  if (active && 0 < ntw) qk(0, sA);
  for (int j = 0; j < NT; j += 2) {
#pragma unroll
    for (int u = 0; u < 2; ++u) {
      const int jj = j + u;
      if (jj < NT) {
        if (jj + 1 < NT) { char* vb = lds + 2 * A_TILE + ((jj + 1) % 3) * A_VTILE + vofs; *(u32x4*)vb = rv0; *(u32x4*)(vb + 32 * A_VLD) = rv1; }
        if (jj + 2 < NT) gload(jj + 2);
        if (active) {
          if (map == 1 && jj >= 1 && jj - 1 < ntw) pv(jj - 1);
          if (jj < ntw) { if (u == 0) smax(jj, sA, sB); else smax(jj, sB, sA); }
          if (map == 0 && jj < ntw) pv(jj);
        }
        if (jj + 2 < NT) { char* kb = lds + (jj & 1) * A_TILE + sofs; *(u32x4*)kb = rk0; *(u32x4*)(kb + 32 * A_LD) = rk1; }
        __syncthreads();
      }
    }
  }
  if (active && map == 1 && ntw == NT) pv(NT - 1);
  __syncthreads();
  float* ex = (float*)lds;
  const float inv_l = 1.f / l_run;
  if (map == 1) {
#pragma unroll
    for (int vt = 0; vt < 4; ++vt)
#pragma unroll
      for (int g = 0; g < 4; ++g) {
        f32x4 o; o[0] = O[vt][4 * g] * inv_l; o[1] = O[vt][4 * g + 1] * inv_l; o[2] = O[vt][4 * g + 2] * inv_l; o[3] = O[vt][4 * g + 3] * inv_l;
        *(f32x4*)(ex + (qt * 32 + r) * 132 + vt * 32 + 8 * g + 4 * h) = o;
      }
  }
  __syncthreads();
  if (map == 0) {
    const float lam = ((const float*)(p.ws + W_MISC))[l];
    const float lam_init = (l == 0) ? 0.2f : (0.8f - 0.6f * 0.74081822068171788f);
    float ssq = 0.f;
#pragma unroll
    for (int vt = 0; vt < 4; ++vt)
#pragma unroll
      for (int g = 0; g < 4; ++g) {
        const f32x4 o2 = *(const f32x4*)(ex + (qt * 32 + r) * 132 + vt * 32 + 8 * g + 4 * h);
#pragma unroll
        for (int e = 0; e < 4; ++e) { const float o = O[vt][4 * g + e] * inv_l - lam * o2[e]; O[vt][4 * g + e] = o; ssq += o * o; }
      }
    ssq += __shfl_xor(ssq, 32);
    const float rms = rsqrtf(ssq * (1.f / 128.f) + LN_EPS) * (1.f - lam_init);
    const float* sg = p.in[14] + l * 128;
    const bool valid = KIND == 0 ? true : (qt == 0 && r < 16);
    if (valid) {
      bf16_t* dst = (bf16_t*)(p.ws + W_Z) + (size_t)qrow * NIN + 3072 + ha * 128;
#pragma unroll
      for (int vt = 0; vt < 4; ++vt)
#pragma unroll
        for (int g = 0; g < 4; ++g) {
          const int v0 = vt * 32 + 8 * g + 4 * h;
          const f32x4 gg = *(const f32x4*)(sg + v0);
          u32x2 o; o[0] = pk2(O[vt][4 * g] * rms * gg[0], O[vt][4 * g + 1] * rms * gg[1]); o[1] = pk2(O[vt][4 * g + 2] * rms * gg[2], O[vt][4 * g + 3] * rms * gg[3]);
          *(u32x2*)(dst + v0) = o;
        }
    }
  }
  __syncthreads();
}

constexpr int L_LD = 528;
constexpr int L_VLD = 320;
constexpr int L_Q = 0, L_K = 64 * L_LD, L_V = 2 * 64 * L_LD, L_SW = L_V + 64 * L_VLD;
constexpr int L_SWLD = 144;
constexpr int L_SC = L_SW + 64 * L_SWLD;
constexpr int S_MX = 0, S_G = 64, S_EMT = 128, S_DS0 = 192, S_DS1 = 256, S_QN = 320  , S_NV = 576  , S_GEND = 832, S_PAR = 840;
constexpr int LDS_BYTES = 153376;
static_assert(L_SC + 2 * S_PAR * 4 <= 131072, "lds");
#define WG_BAR() do { __builtin_amdgcn_fence(__ATOMIC_RELEASE, "workgroup"); __builtin_amdgcn_s_barrier(); __builtin_amdgcn_fence(__ATOMIC_ACQUIRE, "workgroup"); } while (0)

template <int KIND>
DI void mlstm_item(const Params& p, int l, int b, int hm, int half, char* lds) {
  const int tid0 = otid(), wave = uni(tid0 >> 6);
  const bf16_t* QA = (const bf16_t*)(p.ws + W_AB); const bf16_t* KA = (const bf16_t*)(p.ws + W_KA);
  const bf16_t* Z = (const bf16_t*)(p.ws + W_Z); bf16_t* H = (bf16_t*)(p.ws + W_H);
  const float* GIF = (const float*)(p.ws + W_GIF);
  float* scb = (float*)(lds + L_SC);
  int nchunks = KIND == 0 ? SEQ / 64 : 1; asm volatile("" : "+s"(nchunks));
  const int Lv = KIND == 0 ? 64 : 16;
  const size_t bh = KIND == 0 ? (size_t)(l * 4 + b) * 4 + hm : (size_t)(l * 8 + b) * 4 + hm;
  if (wave < 4) {
    f32x16 C[8];
    { const int lane = tid0 & 63, r = lane & 31, h = lane >> 5; (void)r; (void)h;
      if (KIND == 0) {
#pragma unroll
        for (int d = 0; d < 8; ++d)
#pragma unroll
          for (int i = 0; i < 16; ++i) C[d][i] = 0.f;
      } else {
        const float* cp = p.in[5] + bh * 65536 + (size_t)(4 * h) * 256 + half * 128 + wave * 32 + r;
#pragma unroll
        for (int d = 0; d < 8; ++d)
#pragma unroll
          for (int g = 0; g < 4; ++g) {
            C[d][4 * g] = cp[0]; C[d][4 * g + 1] = cp[256]; C[d][4 * g + 2] = cp[512]; C[d][4 * g + 3] = cp[768];
            cp += 2048; asm volatile("" : "+v"(cp));
          }
      }
    }
    for (int c = 0; c < nchunks; ++c) {
      int tid = tid0; asm volatile("" : "+v"(tid));
      const int lane = tid & 63, r = lane & 31, h = lane >> 5;
      const int q4 = (lane & 15) >> 2, p4 = lane & 3, blk = (lane >> 4) & 1;
      const float* sc = scb + (c & 1) * S_PAR;
      const int rowbase = KIND == 0 ? b * SEQ + c * 64 : MP + b * 16;
      WG_BAR();
      f32x16 accB[2];
#pragma unroll
      for (int tt = 0; tt < 2; ++tt)
#pragma unroll
        for (int i = 0; i < 16; ++i) accB[tt][i] = 0.f;
#pragma unroll
      for (int d = 0; d < 8; ++d)
#pragma unroll
        for (int s = 0; s < 2; ++s) {
          __builtin_amdgcn_sched_barrier(0);
          const bf16x8 cf = pack8(C[d], s);
#pragma unroll
          for (int tt = 0; tt < 2; ++tt) {
            const char* qp = lds + L_Q + (tt * 32 + r) * L_LD + (d * 32 + 16 * s + 4 * h) * 2;
            const s16x4 lo = *(const s16x4*)qp, hi = *(const s16x4*)(qp + 16);
            const bf16x8 qfr = __builtin_shufflevector(lo, hi, 0, 1, 2, 3, 4, 5, 6, 7);
            accB[tt] = MFMA32(cf, qfr, accB[tt]);
          }
        }
      __builtin_amdgcn_sched_barrier(0);
      bf16x8 vf[4];
      tr_frag4<16 * L_VLD, 4 * L_VLD>(lds_addr(lds + L_V) + (8 * h + q4) * L_VLD + (wave * 32 + 16 * blk + 4 * p4) * 2, vf);
      const float g_end = sc[S_GEND];
#pragma unroll
      for (int d = 0; d < 8; ++d) {
#pragma unroll
        for (int i = 0; i < 16; ++i) C[d][i] *= g_end;
        bf16x8 kf[4];
        tr_frag4<16 * L_LD, 4 * L_LD>(lds_addr(lds + L_K) + (8 * h + q4) * L_LD + (d * 32 + 16 * blk + 4 * p4) * 2, kf);
#pragma unroll
        for (int ks = 0; ks < 4; ++ks) C[d] = MFMA32(kf[ks], vf[ks], C[d]);
      }
      WG_BAR();
#pragma unroll
      for (int tt = 0; tt < 2; ++tt) {
        const int t = tt * 32 + r;
        const float g = sc[S_G + t];
#pragma unroll
        for (int i = 0; i < 16; ++i) accB[tt][i] *= g;
        const char* sp = lds + L_SW + (tt * 32 + r) * L_SWLD + h * 16;
#pragma unroll
        for (int ks = 0; ks < 4; ++ks) accB[tt] = MFMA32(vf[ks], *(const bf16x8*)(sp + ks * 32), accB[tt]);
        const float qn = (sc[S_QN + t] + sc[S_QN + 64 + t]) + (sc[S_QN + 128 + t] + sc[S_QN + 192 + t]);
        float den = sc[S_DS0 + t] + sc[S_DS1 + t] + g * qn;
        den = fmaxf(fabsf(den), sc[S_EMT + t]);
        const float rden = 1.f / den;
        if (t < Lv) {
          bf16_t* dst = H + (size_t)(rowbase + t) * D + hm * 256 + half * 128 + wave * 32;
#pragma unroll
          for (int g4 = 0; g4 < 4; ++g4) {
            u32x2 o; o[0] = pk2(accB[tt][4 * g4] * rden, accB[tt][4 * g4 + 1] * rden); o[1] = pk2(accB[tt][4 * g4 + 2] * rden, accB[tt][4 * g4 + 3] * rden);
            *(u32x2*)(dst + 8 * g4 + 4 * h) = o;
          }
        }
      }
    }
    WG_BAR();
    {
      const int lane = tid0 & 63, r = lane & 31, h = lane >> 5;
      float* co = p.out + (KIND == 0 ? O_CP : O_CS) + bh * 65536 + (size_t)(4 * h) * 256 + half * 128 + wave * 32 + r;
#pragma unroll
      for (int d = 0; d < 8; ++d)
#pragma unroll
        for (int g = 0; g < 4; ++g) {
          co[0] = C[d][4 * g]; co[256] = C[d][4 * g + 1]; co[512] = C[d][4 * g + 2]; co[768] = C[d][4 * g + 3];
          co += 2048; asm volatile("" : "+v"(co));
        }
    }
  } else {
    const int hw = wave - 4;
    float nreg = 0.f, m_prev = 0.f;
    if (KIND == 1) { nreg = p.in[6][bh * 256 + (tid0 - 256)]; m_prev = p.in[7][bh]; }
    u32x4 pq[8], pk[8], pv[4];
    float gi = 0.f, gf = 0.f, g_end_cur = 0.f;
    auto issue_loads = [&](int c, int tid) {
      const int ht = tid - 256, lane = tid & 63;
      const int rowbase = KIND == 0 ? b * SEQ + c * 64 : MP + b * 16;
      const bool tvalid = lane < Lv;
      gi = tvalid ? GIF[(size_t)(rowbase + lane) * 8 + hm] : -1e30f;
      gf = tvalid ? GIF[(size_t)(rowbase + lane) * 8 + 4 + hm] : 0.f;
#pragma unroll
      for (int i = 0; i < 8; ++i) {
        const int cidx = ht + 256 * i, t = cidx >> 5, pc = cidx & 31;
        const int row = rowbase + (t < Lv ? t : Lv - 1);
        pq[i] = *(const u32x4*)(QA + (size_t)row * D + hm * 256 + pc * 8);
        pk[i] = *(const u32x4*)(KA + (size_t)row * D + hm * 256 + pc * 8);
      }
#pragma unroll
      for (int i = 0; i < 4; ++i) {
        const int cidx = ht + 256 * i, t = cidx >> 4, pc = cidx & 15;
        const int row = rowbase + (t < Lv ? t : Lv - 1);
        pv[i] = *(const u32x4*)(Z + (size_t)row * NIN + 5120 + hm * 256 + half * 128 + pc * 8);
      }
    };
    auto scalars = [&](int par, int lane) -> float {
      const bool tvalid = lane < Lv;
      const float lf = tvalid ? (fminf(gf, 0.f) - __logf(1.f + __expf(-fabsf(gf)))) : 0.f;
      float bc = lf;
#pragma unroll
      for (int o = 1; o < 64; o <<= 1) { const float v = __shfl_up(bc, o); if (lane >= o) bc += v; }
      const float a = gi - bc;
      float cm = a;
#pragma unroll
      for (int o = 1; o < 64; o <<= 1) { const float v = __shfl_up(cm, o); if (lane >= o) cm = fmaxf(cm, v); }
      const float mxv = fmaxf(m_prev, cm);
      const float m_t = bc + mxv;
      const float mx_end = __shfl(mxv, 63), bc_end = __shfl(bc, 63);
      const float wend = __expf(a - mx_end);
      g_end_cur = __expf(m_prev - mx_end);
      if (hw == 0) {
        float* sc = scb + par * S_PAR;
        sc[S_MX + lane] = __expf(mx_end - mxv);
        sc[S_G + lane] = __expf(m_prev - mxv);
        sc[S_EMT + lane] = __expf(-m_t);
        if (lane == 0) sc[S_GEND] = g_end_cur;
      }
      m_prev = bc_end + mx_end;
      return wend;
    };
    auto stage_lds = [&](float wend_l, int tid) {
      const int ht = tid - 256;
#pragma unroll
      for (int i = 0; i < 8; ++i) {
        const int cidx = ht + 256 * i, t = cidx >> 5, pc = cidx & 31;
        const float we = __shfl(wend_l, t);
        float f[8]; unpack8(pk[i], f);
        u32x4 o; o[0] = pk2(f[0] * we, f[1] * we); o[1] = pk2(f[2] * we, f[3] * we); o[2] = pk2(f[4] * we, f[5] * we); o[3] = pk2(f[6] * we, f[7] * we);
        *(u32x4*)(lds + L_Q + t * L_LD + pc * 16) = pq[i];
        *(u32x4*)(lds + L_K + t * L_LD + pc * 16) = o;
      }
#pragma unroll
      for (int i = 0; i < 4; ++i) {
        const int cidx = ht + 256 * i, t = cidx >> 4, pc = cidx & 15;
        *(u32x4*)(lds + L_V + t * L_VLD + pc * 16) = pv[i];
      }
    };
    {
      int tid = tid0; asm volatile("" : "+v"(tid));
      issue_loads(0, tid);
      scb[S_NV + (tid - 256)] = nreg;
      const float wend = scalars(0, tid & 63);
      stage_lds(wend, tid);
    }
    for (int c = 0; c < nchunks; ++c) {
      int tid = tid0; asm volatile("" : "+v"(tid));
      const int ht = tid - 256, lane = tid & 63, r = lane & 31, h = lane >> 5;
      float* sc = scb + (c & 1) * S_PAR;
      float* scn = scb + ((c + 1) & 1) * S_PAR;
      const float g_end_c = g_end_cur;
      WG_BAR();
      const bool more = c + 1 < nchunks;
      if (more) issue_loads(c + 1, tid);
      {
        const int t = ht & 63, part = ht >> 6;
        const char* qp = lds + L_Q + t * L_LD + part * 128;
        float s = 0.f;
#pragma unroll
        for (int e = 0; e < 8; ++e) {
          const u32x4 qq = *(const u32x4*)(qp + e * 16); float f[8]; unpack8(qq, f);
#pragma unroll
          for (int z = 0; z < 8; ++z) s += f[z] * sc[S_NV + part * 64 + e * 8 + z];
        }
        sc[S_QN + part * 64 + t] = s;
      }
      if (hw < 3) {
        const int stl = hw == 2 ? 1 : 0, tt = hw == 0 ? 0 : 1;
        f32x16 S, S2;
#pragma unroll
        for (int i = 0; i < 16; ++i) { S[i] = 0.f; S2[i] = 0.f; }
        const char* ka = lds + L_K + (stl * 32 + r) * L_LD + h * 16;
        const char* qa = lds + L_Q + (tt * 32 + r) * L_LD + h * 16;
#pragma unroll 4
        for (int ks = 0; ks < 16; ks += 2) {
          S = MFMA32(*(const bf16x8*)(ka + ks * 32), *(const bf16x8*)(qa + ks * 32), S);
          S2 = MFMA32(*(const bf16x8*)(ka + ks * 32 + 32), *(const bf16x8*)(qa + ks * 32 + 32), S2);
        }
        const int t = tt * 32 + r;
        const float cw = sc[S_MX + t];
        float rs = 0.f;
#pragma unroll
        for (int g = 0; g < 4; ++g) {
          float wv[4];
#pragma unroll
          for (int e = 0; e < 4; ++e) {
            const int s = stl * 32 + 8 * g + 4 * h + e;
            wv[e] = s <= t ? (S[4 * g + e] + S2[4 * g + e]) * cw : 0.f; rs += wv[e];
          }
          u32x2 o; o[0] = pk2(wv[0], wv[1]); o[1] = pk2(wv[2], wv[3]);
          *(u32x2*)(lds + L_SW + t * L_SWLD + (stl * 32 + 8 * g + 4 * h) * 2) = o;
        }
        rs += __shfl_xor(rs, 32);
        if (h == 0) {
          if (hw == 0) { sc[S_DS0 + t] = rs; sc[S_DS1 + t] = 0.f; }
          else if (hw == 1) sc[S_DS0 + t] = rs;
          else sc[S_DS1 + t] = rs;
        }
      } else {
        const int t = lane >> 1, hs = lane & 1;
        u32x4 z; z[0] = 0; z[1] = 0; z[2] = 0; z[3] = 0;
        *(u32x4*)(lds + L_SW + t * L_SWLD + 64 + hs * 32) = z; *(u32x4*)(lds + L_SW + t * L_SWLD + 64 + hs * 32 + 16) = z;
      }
      {
        float s0 = 0.f, s1 = 0.f, s2 = 0.f, s3 = 0.f;
        const char* kp = lds + L_K + ht * 2;
#pragma unroll
        for (int t = 0; t < 64; t += 4) {
          s0 += bflo((unsigned)*(const bf16_t*)(kp + t * L_LD)); s1 += bflo((unsigned)*(const bf16_t*)(kp + (t + 1) * L_LD));
          s2 += bflo((unsigned)*(const bf16_t*)(kp + (t + 2) * L_LD)); s3 += bflo((unsigned)*(const bf16_t*)(kp + (t + 3) * L_LD));
        }
        nreg = g_end_c * nreg + ((s0 + s1) + (s2 + s3));
        scn[S_NV + ht] = nreg;
      }
      float wend = 0.f;
      if (more) wend = scalars((c + 1) & 1, lane);
      WG_BAR();
      if (more) stage_lds(wend, tid);
    }
    WG_BAR();
    if (half == 0) {
      p.out[(KIND == 0 ? O_NP : O_NS) + bh * 256 + (tid0 - 256)] = nreg;
      if (tid0 == 256) p.out[(KIND == 0 ? O_MPP : O_MSS) + bh] = m_prev;
    }
  }
}

DI void mixer_phase(const Params& p, int l, char* lds, int cidx, bool ml_only) {
  unsigned* ctr = (unsigned*)(p.ws + W_MISC) + 16 + cidx;
  int* s_item = (int*)(lds + LDS_BYTES - 16);
  const int total = 32 + 64 + 64 + 2048;
  for (;;) {
    __syncthreads();
    if (threadIdx.x == 0) *s_item = (int)atomicAdd(ctr, 1u);
    __syncthreads();
    const int it = *s_item;
    __syncthreads();
    if (it >= total) break;
    if (ml_only && it >= 96) break;
    if (it < 32) { mlstm_item<0>(p, l, it >> 3, (it >> 1) & 3, it & 1, lds); continue; }
    if (it < 96) { const int x = it - 32; mlstm_item<1>(p, l, x >> 3, (x >> 1) & 3, x & 1, lds); continue; }
    if (it < 160) { attn_item<1>(p, l, (it - 96) >> 3, (it - 96) & 7, 0, lds); continue; }
    { const int x = it - 160; attn_item<0>(p, l, (x & 31) >> 3, x & 7, 63 - (x >> 5), lds); }
  }
}

DI void merge_phase(const Params& p, int l) {
  const bf16_t* Z = (const bf16_t*)(p.ws + W_Z); const bf16_t* H = (const bf16_t*)(p.ws + W_H); bf16_t* Y = (bf16_t*)(p.ws + W_AB);
  const int tidq = otid(); const int lane = tidq & 63, gw = blockIdx.x * 8 + (tidq >> 6), ngw = gridDim.x * 8;
  const int col = lane * 16;
  float mg[16];
  { const float* mhg = p.in[15] + (size_t)l * D + col;
#pragma unroll
    for (int i = 0; i < 4; ++i) { const f32x4 g = *(const f32x4*)(mhg + 4 * i); mg[4 * i] = g[0]; mg[4 * i + 1] = g[1]; mg[4 * i + 2] = g[2]; mg[4 * i + 3] = g[3]; } }
  for (int row0 = gw; row0 < M; row0 += 2 * ngw) {
    const int row1 = row0 + ngw; const bool has1 = row1 < M;
    u32x4 in[2][10];
#pragma unroll
    for (int q = 0; q < 2; ++q) {
      const size_t row = (size_t)(q == 0 ? row0 : (has1 ? row1 : row0));
      const bf16_t* z = Z + row * NIN + col; const bf16_t* hp = H + row * D + col;
      in[q][0] = *(const u32x4*)hp; in[q][1] = *(const u32x4*)(hp + 8);
#pragma unroll
      for (int hh = 0; hh < 2; ++hh) {
        in[q][2 + hh * 4] = *(const u32x4*)(z + 3072 + hh * 8); in[q][3 + hh * 4] = *(const u32x4*)(z + 6144 + hh * 8);
        in[q][4 + hh * 4] = *(const u32x4*)(z + 7168 + hh * 8); in[q][5 + hh * 4] = *(const u32x4*)(z + 8192 + hh * 8);
      }
    }
#pragma unroll
    for (int q = 0; q < 2; ++q) {
      if (q == 1 && !has1) break;
      const size_t row = (size_t)(q == 0 ? row0 : row1);
      float hv[16];
      unpack8(in[q][0], hv); unpack8(in[q][1], hv + 8);
      float s = 0.f;
#pragma unroll
      for (int e = 0; e < 16; ++e) s += hv[e];
#pragma unroll
      for (int o = 1; o < 16; o <<= 1) s += __shfl_xor(s, o);
      const float mean = s * (1.f / 256.f);
      float s2 = 0.f;
#pragma unroll
      for (int e = 0; e < 16; ++e) { hv[e] -= mean; s2 += hv[e] * hv[e]; }
#pragma unroll
      for (int o = 1; o < 16; o <<= 1) s2 += __shfl_xor(s2, o);
      const float rstd = rsqrtf(s2 * (1.f / 256.f) + LN_EPS);
      u32x4 out[2];
#pragma unroll
      for (int hh = 0; hh < 2; ++hh) {
        float oa[8], om[8], ga[8], gb[8];
        unpack8(in[q][2 + hh * 4], oa); unpack8(in[q][3 + hh * 4], om); unpack8(in[q][4 + hh * 4], ga); unpack8(in[q][5 + hh * 4], gb);
        float y[8];
#pragma unroll
        for (int e = 0; e < 8; ++e) {
          const float hn = hv[hh * 8 + e] * rstd * mg[hh * 8 + e];
          y[e] = sigmoidf_(ga[e]) * oa[e] + sigmoidf_(gb[e]) * (hn * sigmoidf_(om[e]));
        }
        out[hh][0] = pk2(y[0], y[1]); out[hh][1] = pk2(y[2], y[3]); out[hh][2] = pk2(y[4], y[5]); out[hh][3] = pk2(y[6], y[7]);
      }
      *(u32x4*)(Y + row * D + col) = out[0]; *(u32x4*)(Y + row * D + col + 8) = out[1];
    }
  }
}

DI void ln_phase(const Params& p, const float* g, const float* bta, bool final_out) {
  const int tidq = otid(); const int lane = tidq & 63, gw = blockIdx.x * 8 + (tidq >> 6), ngw = gridDim.x * 8;
  float* R = (float*)(p.ws + W_R); bf16_t* AB = (bf16_t*)(p.ws + W_AB);
  f32x4 gq[4], bq[4];
#pragma unroll
  for (int j = 0; j < 4; ++j) { gq[j] = *(const f32x4*)(g + j * 256 + lane * 4); bq[j] = *(const f32x4*)(bta + j * 256 + lane * 4); }
  for (int row0 = gw; row0 < M; row0 += 2 * ngw) {
    f32x4 v[2][4]; float s[2] = {0.f, 0.f};
    const int row1 = row0 + ngw; const bool has1 = row1 < M;
#pragma unroll
    for (int q = 0; q < 2; ++q) {
      const float* xr = R + (size_t)(q == 0 ? row0 : (has1 ? row1 : row0)) * D;
#pragma unroll
      for (int j = 0; j < 4; ++j) { v[q][j] = *(const f32x4*)(xr + j * 256 + lane * 4); s[q] += (v[q][j][0] + v[q][j][1]) + (v[q][j][2] + v[q][j][3]); }
    }
#pragma unroll
    for (int q = 0; q < 2; ++q) {
      if (q == 1 && !has1) break;
      const int row = q == 0 ? row0 : row1;
      const float mean = wave_sum(s[q]) * (1.f / D);
      float s2 = 0.f;
#pragma unroll
      for (int j = 0; j < 4; ++j) { v[q][j] = v[q][j] - mean; s2 += (v[q][j][0] * v[q][j][0] + v[q][j][1] * v[q][j][1]) + (v[q][j][2] * v[q][j][2] + v[q][j][3] * v[q][j][3]); }
      const float rstd = rsqrtf(wave_sum(s2) * (1.f / D) + LN_EPS);
      float* dst = final_out ? (row < MP ? p.out + O_YP + (size_t)row * D : p.out + O_YS + (size_t)(row - MP) * D) : R + (size_t)row * D;
#pragma unroll
      for (int j = 0; j < 4; ++j) {
        const int c = j * 256 + lane * 4;
        const f32x4 o = v[q][j] * rstd * gq[j] + bq[j];
        *(f32x4*)(dst + c) = o;
        if (!final_out) { u32x2 ob; ob[0] = pk2(o[0], o[1]); ob[1] = pk2(o[2], o[3]); *(u32x2*)(AB + (size_t)row * D + c) = ob; }
      }
    }
  }
}

DI float gelu_f(float v) {
  const float av = fabsf(v), d = av * 0.2316418882f + 1.0f;
  const float t = __builtin_amdgcn_rcpf(d);
  float q = t * 0.5307027145f + (-0.7265760135f); q = q * t + 0.7107068705f; q = q * t + (-0.142248368f); q = q * t + 0.127414796f; q = q * t;
  const float e = __builtin_amdgcn_exp2f((v * v) * (-0.72134752044f));
  const float m = v * (q * e), r = v - m;
  return v < 0.f ? m : r;
}
DI void ffnconv_phase(const Params& p, int l) {
  const bf16_t* U = (const bf16_t*)(p.ws + W_Z); bf16_t* HF = (bf16_t*)(p.ws + W_Z + (size_t)M * NUP * 2);
  const float* cw = p.in[20] + (size_t)l * 3 * NUP; const float* cb = p.in[21] + (size_t)l * NUP;
  constexpr int RG = 8;
  const unsigned gtid = blockIdx.x * NTH + (unsigned)otid();
  const unsigned nlan = gridDim.x * NTH / 352u;
  const unsigned r0 = gtid / 352u, cc = gtid - r0 * 352u;
  if (r0 >= nlan) return;
  const int col = (int)cc * 8;
  f32x4 wv[2][3][2], bv[2][2];
#pragma unroll
  for (int hf = 0; hf < 2; ++hf) {
    const int c2 = col + hf * DFF;
#pragma unroll
    for (int j = 0; j < 3; ++j) { wv[hf][j][0] = *(const f32x4*)(cw + j * NUP + c2); wv[hf][j][1] = *(const f32x4*)(cw + j * NUP + c2 + 4); }
    bv[hf][0] = *(const f32x4*)(cb + c2); bv[hf][1] = *(const f32x4*)(cb + c2 + 4);
  }
  for (unsigned rg = r0; rg < (unsigned)(M / RG); rg += nlan) {
    const int row0 = (int)rg * RG;
    int t0; const float* st = nullptr;
    if (row0 < MP) t0 = row0 & (SEQ - 1); else { t0 = (row0 - MP) & 15; st = p.in[8] + ((size_t)(l * 8 + ((row0 - MP) >> 4)) * 2) * NUP; }
    float gl[RG][8];
#pragma unroll
    for (int hf = 0; hf < 2; ++hf) {
      const int c2 = col + hf * DFF;
      float x[RG + 2][8];
#pragma unroll
      for (int j = 0; j < RG + 2; ++j) {
        const int t = t0 - 2 + j;
        if (t >= 0) unpack8(*(const u32x4*)(U + (size_t)(row0 - 2 + j) * NUP + c2), x[j]);
        else if (st) { const float* sp = st + (size_t)(2 + t) * NUP + c2; const f32x4 a = *(const f32x4*)sp, b2 = *(const f32x4*)(sp + 4);
          x[j][0] = a[0]; x[j][1] = a[1]; x[j][2] = a[2]; x[j][3] = a[3]; x[j][4] = b2[0]; x[j][5] = b2[1]; x[j][6] = b2[2]; x[j][7] = b2[3]; }
        else {
#pragma unroll
          for (int e = 0; e < 8; ++e) x[j][e] = 0.f; }
      }
#pragma unroll
      for (int a = 0; a < RG; ++a) {
        float o[8];
#pragma unroll
        for (int e = 0; e < 8; ++e) {
          const float u = bv[hf][e >> 2][e & 3] + wv[hf][0][e >> 2][e & 3] * x[a][e] + wv[hf][1][e >> 2][e & 3] * x[a + 1][e] + wv[hf][2][e >> 2][e & 3] * x[a + 2][e];
          if (hf == 0) gl[a][e] = gelu_f(u); else o[e] = gl[a][e] * u;
        }
        if (hf == 1) {
          u32x4 ov; ov[0] = pk2(o[0], o[1]); ov[1] = pk2(o[2], o[3]); ov[2] = pk2(o[4], o[5]); ov[3] = pk2(o[6], o[7]);
          *(u32x4*)(HF + (size_t)(row0 + a) * DFF + col) = ov;
        }
      }
    }
  }
}

#define XB_TMO      128
#define XB_XCNT(j)  (256  + 64 * (j))
#define XB_XSUB(j)  (1280 + 64 * (j))
#define XB_XGEN(j)  (2304 + 64 * (j))
#define XB_TOP      3328
#define XB_TOPGEN   3392
#define XCD_BAR_WORDS 3456
#define XB_SPIN_CAP (1u << 18)
#define XLAS __attribute__((address_space(3)))
DI unsigned xb_ld(unsigned* p)              { return __hip_atomic_load(p, __ATOMIC_RELAXED, __HIP_MEMORY_SCOPE_AGENT); }
DI unsigned xb_add(unsigned* p, unsigned v) { return __hip_atomic_fetch_add(p, v, __ATOMIC_RELAXED, __HIP_MEMORY_SCOPE_AGENT); }
DI unsigned xb_xcc_id() { return (unsigned)__builtin_amdgcn_s_getreg((3 << 11) | 20) & 0xFu; }
#define XB_SPIN(cond, bar) do { unsigned _sp = 0; while (cond) { __builtin_amdgcn_s_sleep(1); \
    if ((++_sp & 255u) == 0u) { if (xb_ld(&(bar)[XB_TMO])) break; if (_sp > XB_SPIN_CAP) { atomicAdd(&(bar)[XB_TMO], 1u); break; } } } } while (0)
struct XcdBarrier { unsigned* bar; unsigned x; volatile XLAS unsigned* st; };
DI XcdBarrier xcd_barrier_post(unsigned* bar, volatile XLAS unsigned* st) {
  XcdBarrier b; b.bar = bar; b.x = xb_xcc_id(); b.st = st;
  if (threadIdx.x == 0) (void)xb_add(&bar[XB_XCNT(b.x)], 1u);
  return b;
}
DI void xcd_barrier_complete(unsigned* bar, unsigned x, unsigned& nloc, unsigned& nx) {
  const unsigned G = gridDim.x * gridDim.y * gridDim.z;
  unsigned sum, cnt, mine, sp = 0u;
  for (;;) {
    sum = 0u; cnt = 0u; mine = 0u;
#pragma unroll
    for (unsigned j = 0; j < 16; ++j) { const unsigned c = xb_ld(&bar[XB_XCNT(j)]); sum += c; cnt += (c > 0u) ? 1u : 0u; mine = (j == x) ? c : mine; }
    if (sum == G) break;
    __builtin_amdgcn_s_sleep(1);
    if ((++sp & 255u) == 0u) { if (xb_ld(&bar[XB_TMO])) break; if (sp > XB_SPIN_CAP) { atomicAdd(&bar[XB_TMO], 1u); break; } }
  }
  nloc = mine > 0u ? mine : 1u; nx = cnt > 0u ? cnt : 1u;
}
DI void xcd_barrier(const XcdBarrier& b) {
  asm volatile("s_waitcnt vmcnt(0)" ::: "memory");
  __syncthreads();
  if (threadIdx.x == 0) {
    unsigned* bar = b.bar;
    __builtin_amdgcn_s_waitcnt(0);
    unsigned nloc = b.st[0], nx = b.st[1];
    if (nloc == 0u) { xcd_barrier_complete(bar, b.x, nloc, nx); b.st[0] = nloc; b.st[1] = nx; }
    const unsigned old = xb_add(&bar[XB_XSUB(b.x)], 1u);
    const unsigned gen = old / nloc;
    if (old + 1u == (gen + 1u) * nloc) {
      __builtin_amdgcn_fence(__ATOMIC_RELEASE, "agent");
      asm volatile("s_waitcnt vmcnt(0)" ::: "memory");
      const unsigned og = xb_add(&bar[XB_TOP], 1u);
      const unsigned tg = og / nx;
      if (og + 1u == (tg + 1u) * nx) xb_add(&bar[XB_TOPGEN], 1u);
      else XB_SPIN(xb_ld(&bar[XB_TOPGEN]) == tg, bar);
      __builtin_amdgcn_fence(__ATOMIC_ACQUIRE, "agent");
      xb_add(&bar[XB_XGEN(b.x)], 1u);
      asm volatile("s_waitcnt vmcnt(0)" ::: "memory");
    } else {
      XB_SPIN(xb_ld(&bar[XB_XGEN(b.x)]) == gen, bar);
      __builtin_amdgcn_fence(__ATOMIC_ACQUIRE, "agent");
      asm volatile("s_waitcnt vmcnt(0)" ::: "memory");
    }
  }
  __syncthreads();
}

constexpr int NPH = 21;
DI void run_phase(const Params& p, int ph, char* lds) {
#ifndef ONLY
  if (ph == 0) { phase0(p, lds); return; }
#else
  if (ph == 0) return;
#endif
  const int l = (ph - 1) / 10, s = (ph - 1) % 10;
#ifdef ONLY
  if (s != ONLY) return;
#endif
  switch (s) {
    case 0: gemm_phase<EPI_IN>(p, l, (const bf16_t*)(p.ws + W_AB), D, (const bf16_t*)(p.ws + W_WIN) + (size_t)l * NIN * D, D, NIN / 256, lds); break;
    case 1: qkconv_phase(p, l); gif_phase(p, l, lds, 0); break;
    case 2: mixer_phase(p, l, lds, l, false); break;
    case 3: merge_phase(p, l); break;
    case 4: gemm_phase<EPI_OUT>(p, l, (const bf16_t*)(p.ws + W_AB), D, (const bf16_t*)(p.ws + W_WOUT) + (size_t)l * D * D, D, D / 256, lds); break;
    case 5: ln_phase(p, p.in[17] + l * D, p.in[18] + l * D, false); break;
    case 6: gemm_phase<EPI_UP>(p, l, (const bf16_t*)(p.ws + W_AB), D, (const bf16_t*)(p.ws + W_WUP) + (size_t)l * NUP * D, D, NUP / 256, lds); break;
    case 7: ffnconv_phase(p, l); break;
    case 8: gemm_phase<EPI_DOWN>(p, l, (const bf16_t*)(p.ws + W_Z + (size_t)M * NUP * 2), DFF, (const bf16_t*)(p.ws + W_WDN) + (size_t)l * D * DFF, DFF, D / 256, lds); break;
    case 9: ln_phase(p, p.in[23] + l * D, p.in[24] + l * D, l == 1); break;
  }
}

__global__ void __launch_bounds__(NTH) mega(Params p, int ph_lo, int ph_hi) {
  extern __shared__ __attribute__((aligned(16))) char lds[];
#if MULTI_LAUNCH
  for (int ph = ph_lo; ph < ph_hi; ++ph) run_phase(p, ph, lds);
#else
  cg::grid_group grid = cg::this_grid();
  phase0(p, lds);
  grid.sync();
  volatile XLAS unsigned* xst = (volatile XLAS unsigned*)((XLAS char*)lds + (LDS_BYTES - 32));
  if (threadIdx.x == 0) { xst[0] = 0u; xst[1] = 0u; }
  __syncthreads();
  const XcdBarrier xb = xcd_barrier_post((unsigned*)(p.ws + W_BAR), xst);
#define GSYNC() xcd_barrier(xb)
  for (int l = 0; l < 2; ++l) {
    gemm_phase<EPI_IN>(p, l, (const bf16_t*)(p.ws + W_AB), D, (const bf16_t*)(p.ws + W_WIN) + (size_t)l * NIN * D, D, NIN / 256, lds);
    {
      const int nun = NTM * (NIN / 256), G = (int)gridDim.x;
      const int busy = nun % G;
      gif_phase(p, l, lds, (busy > 0 && busy * 2 < G) ? busy : 0);
    }
    GSYNC();
#ifdef PROBE_GIN2
    gemm_phase<EPI_IN>(p, l, (const bf16_t*)(p.ws + W_AB), D, (const bf16_t*)(p.ws + W_WIN) + (size_t)l * NIN * D, D, NIN / 256, lds);
    GSYNC();
#endif
    qkconv_phase(p, l);
    GSYNC();
#if defined(PROBE_EW2) || defined(PROBE_QKC2)
    qkconv_phase(p, l);
    GSYNC();
#endif
    mixer_phase(p, l, lds, l, false);
    GSYNC();
#ifdef PROBE_ML2
    mixer_phase(p, l, lds, l + 2, true);
    GSYNC();
#endif
#ifdef PROBE_MIX2
    mixer_phase(p, l, lds, l + 2, false);
    GSYNC();
#endif
    merge_phase(p, l);
    GSYNC();
#ifdef PROBE_SYNC
    for (int q = 0; q < 20; ++q) GSYNC();
#endif
#if defined(PROBE_EW2) || defined(PROBE_MRG2)
    merge_phase(p, l);
    GSYNC();
#endif
    gemm_phase<EPI_OUT>(p, l, (const bf16_t*)(p.ws + W_AB), D, (const bf16_t*)(p.ws + W_WOUT) + (size_t)l * D * D, D, D / 256, lds);
    GSYNC();
    ln_phase(p, p.in[17] + l * D, p.in[18] + l * D, false);
    GSYNC();
    gemm_phase<EPI_UP>(p, l, (const bf16_t*)(p.ws + W_AB), D, (const bf16_t*)(p.ws + W_WUP) + (size_t)l * NUP * D, D, NUP / 256, lds);
    GSYNC();
    ffnconv_phase(p, l);
    GSYNC();
#if defined(PROBE_EW2) || defined(PROBE_FFC2)
    ffnconv_phase(p, l);
    GSYNC();
#endif
    gemm_phase<EPI_DOWN>(p, l, (const bf16_t*)(p.ws + W_Z + (size_t)M * NUP * 2), DFF, (const bf16_t*)(p.ws + W_WDN) + (size_t)l * D * DFF, DFF, D / 256, lds);
    GSYNC();
    ln_phase(p, p.in[23] + l * D, p.in[24] + l * D, l == 1);
    if (l == 0) GSYNC();
  }
#endif
}

extern "C" void kernel_launch(void* const* d_in, const int* in_sizes, int n_in, void* d_out, int out_size, void* d_ws, size_t ws_size, hipStream_t stream) {
  static int grid = 0;
  if (grid == 0) {
    if (n_in != 25 || (size_t)out_size != O_END || ws_size < W_END) { fprintf(stderr, "kernel_launch: unexpected sizes n_in %d out %d (want %zu) ws %zu (want %zu)\n", n_in, out_size, (size_t)O_END, ws_size, (size_t)W_END); grid = -1; return; }
    int dev = 0, cus = 0, per_cu = 0;
    hipGetDevice(&dev);
    hipDeviceGetAttribute(&cus, hipDeviceAttributeMultiprocessorCount, dev);
    if (hipFuncSetAttribute((const void*)mega, hipFuncAttributeMaxDynamicSharedMemorySize, LDS_BYTES) != hipSuccess) { fprintf(stderr, "hipFuncSetAttribute failed\n"); grid = -1; return; }
    hipOccupancyMaxActiveBlocksPerMultiprocessor(&per_cu, (const void*)mega, NTH, LDS_BYTES);
    if (per_cu < 1) per_cu = 1;
    grid = cus * 1;
    (void)hipGetLastError();
  }
  if (grid < 0) return;
  Params p{};
  for (int i = 0; i < 25; ++i) p.in[i] = (const float*)d_in[i];
  p.out = (float*)d_out; p.ws = (unsigned char*)d_ws;
#if MULTI_LAUNCH
  for (int ph = 0; ph < NPH; ++ph) hipLaunchKernelGGL(mega, dim3(grid), dim3(NTH), LDS_BYTES, stream, p, ph, ph + 1);
#else
  int lo = 0, hi = NPH;
  void* args[] = {&p, &lo, &hi};
  hipError_t e = hipLaunchCooperativeKernel((const void*)mega, dim3(grid), dim3(NTH), args, LDS_BYTES, stream);
  if (e != hipSuccess) fprintf(stderr, "cooperative launch failed: %s (grid %d)\n", hipGetErrorString(e), grid);
#endif
}
```

```cpp
#include <hip/hip_runtime.h>
#include <hip/hip_cooperative_groups.h>
#include <cstdio>
namespace cg = cooperative_groups;

#ifndef MULTI_LAUNCH
#define MULTI_LAUNCH 0
#endif

typedef unsigned short bf16_t;
typedef short bf16x8 __attribute__((ext_vector_type(8)));
typedef short s16x4 __attribute__((ext_vector_type(4)));
typedef float f32x16 __attribute__((ext_vector_type(16)));
typedef float f32x4 __attribute__((ext_vector_type(4)));
typedef unsigned u32x4 __attribute__((ext_vector_type(4)));
typedef unsigned u32x2 __attribute__((ext_vector_type(2)));
#define DI __device__ __forceinline__
#define MFMA32(a, b, c) __builtin_amdgcn_mfma_f32_32x32x16_bf16((a), (b), (c), 0, 0, 0)

constexpr int NTH = 512;
constexpr int D = 1024, SEQ = 8192, NB = 4, MP = NB * SEQ, MS = 128, M = MP + MS, NTM = 129;
constexpr int DIN = 9224, NIN = 9216, DFF = 2816, NUP = 5632;
constexpr int PAST = 4096, NKS = PAST + 16;
constexpr float ALPHA = 1.4142135623730951f;
constexpr float LN_EPS = 1e-5f;
constexpr float LOG2E = 1.4426950408889634f;

constexpr size_t O_YP = 0;
constexpr size_t O_YS = O_YP + (size_t)MP * D;
constexpr size_t O_KP = O_YS + (size_t)MS * D;
constexpr size_t O_VP = O_KP + (size_t)2 * MP * 1024;
constexpr size_t O_MCP = O_VP + (size_t)2 * MP * 1024;
constexpr size_t O_CP = O_MCP + (size_t)2 * 4 * 3 * 2048;
constexpr size_t O_NP = O_CP + (size_t)2 * 4 * 4 * 65536;
constexpr size_t O_MPP = O_NP + (size_t)2 * 4 * 4 * 256;
constexpr size_t O_FCP = O_MPP + 32;
constexpr size_t O_KS = O_FCP + (size_t)2 * 4 * 2 * NUP;
constexpr size_t O_VS = O_KS + (size_t)2 * MS * 1024;
constexpr size_t O_MCS = O_VS + (size_t)2 * MS * 1024;
constexpr size_t O_CS = O_MCS + (size_t)2 * 8 * 3 * 2048;
constexpr size_t O_NS = O_CS + (size_t)2 * 8 * 4 * 65536;
constexpr size_t O_MSS = O_NS + (size_t)2 * 8 * 4 * 256;
constexpr size_t O_FCS = O_MSS + 64;
constexpr size_t O_END = O_FCS + (size_t)2 * 8 * 2 * NUP;

constexpr size_t W_Z = 0;
constexpr size_t W_H = W_Z + (size_t)M * NIN * 2;
constexpr size_t W_AB = W_H + (size_t)M * D * 2;
constexpr size_t W_KA = W_AB + (size_t)M * D * 2;
constexpr size_t W_R = W_KA + (size_t)M * D * 2;
constexpr size_t W_WIN = W_R + (size_t)M * D * 4;
constexpr size_t W_WOUT = W_WIN + (size_t)2 * NIN * D * 2;
constexpr size_t W_WUP = W_WOUT + (size_t)2 * D * D * 2;
constexpr size_t W_WDN = W_WUP + (size_t)2 * NUP * D * 2;
constexpr size_t W_GIF = W_WDN + (size_t)2 * D * DFF * 2;
constexpr size_t W_ROPE = W_GIF + (size_t)M * 8 * 4;
constexpr size_t W_MISC = W_ROPE + (size_t)8192 * 32 * 8;
constexpr size_t W_BAR = W_MISC + 4096;
constexpr size_t W_END = W_BAR + 16384;

struct Params {
  const float* in[25];
  float* out;
  unsigned char* ws;
};

DI unsigned f2bf(float x) { unsigned u = __float_as_uint(x); u += 0x7fffu + ((u >> 16) & 1u); return u >> 16; }
typedef __bf16 bf16v2 __attribute__((ext_vector_type(2)));
typedef float f32x2 __attribute__((ext_vector_type(2)));
DI unsigned pk2(float a, float b) { f32x2 v; v[0] = a; v[1] = b; return __builtin_bit_cast(unsigned, __builtin_convertvector(v, bf16v2)); }
DI float bflo(unsigned u) { return __uint_as_float(u << 16); }
DI float bfhi(unsigned u) { return __uint_as_float(u & 0xffff0000u); }
DI float sigmoidf_(float x) { return __builtin_amdgcn_rcpf(1.f + __builtin_amdgcn_exp2f(-1.4426950408889634f * x)); }
DI float wave_sum(float v) {
#pragma unroll
  for (int o = 1; o < 64; o <<= 1) v += __shfl_xor(v, o);
  return v;
}
DI int crow(int i, int h) { return (i & 3) + 8 * (i >> 2) + 4 * h; }
DI bf16x8 pack8(const f32x16& x, int s) {
  u32x4 p;
  p[0] = pk2(x[8 * s + 0], x[8 * s + 1]); p[1] = pk2(x[8 * s + 2], x[8 * s + 3]);
  p[2] = pk2(x[8 * s + 4], x[8 * s + 5]); p[3] = pk2(x[8 * s + 6], x[8 * s + 7]);
  return __builtin_bit_cast(bf16x8, p);
}
DI void unpack8(u32x4 v, float* f) {
  f[0] = bflo(v[0]); f[1] = bfhi(v[0]); f[2] = bflo(v[1]); f[3] = bfhi(v[1]);
  f[4] = bflo(v[2]); f[5] = bfhi(v[2]); f[6] = bflo(v[3]); f[7] = bfhi(v[3]);
}
typedef __attribute__((address_space(3))) s16x4 lds_s16x4;
DI bf16x8 tr_frag(unsigned a_lo, unsigned a_hi) {
  const s16x4 lo = __builtin_amdgcn_ds_read_tr16_b64_v4i16((lds_s16x4*)(size_t)a_lo);
  const s16x4 hi = __builtin_amdgcn_ds_read_tr16_b64_v4i16((lds_s16x4*)(size_t)a_hi);
  return __builtin_shufflevector(lo, hi, 0, 1, 2, 3, 4, 5, 6, 7);
}
template <int STEP, int HIOFF>
DI void tr_frag4(unsigned a, bf16x8 (&f)[4]) {
#pragma unroll
  for (int i = 0; i < 4; ++i) f[i] = tr_frag(a + i * STEP, a + i * STEP + HIOFF);
}
DI int otid() { int t = threadIdx.x; asm volatile("" : "+v"(t)); return t; }
DI int uni(int v) { return __builtin_amdgcn_readfirstlane(v); }
DI unsigned lds_addr(const void* p) { return (unsigned)(size_t)p; }

DI const float* xrow_ptr(const Params& p, int l, int row) {
  if (l == 0) return row < MP ? p.in[0] + (size_t)row * D : p.in[1] + (size_t)(row - MP) * D;
  return (const float*)(p.ws + W_R) + (size_t)row * D;
}

DI void transpose_w(const float* W, int K, int N, int src_ld, bf16_t* WT, bool remap, char* lds) {
  float* scr = (float*)lds;
  const int nkb = K / 64, nnb = N / 64, tid = otid();
  for (int it = blockIdx.x; it < nkb * nnb; it += gridDim.x) {
    const int kb = it / nnb, nb = it % nnb, k0 = kb * 64, n0 = nb * 64;
    const int ns = (remap && n0 >= 7168) ? n0 + 8 : n0;
#pragma unroll
    for (int i = 0; i < 8; ++i) {
      const int kk = (tid >> 6) + 8 * i, nn = tid & 63;
      scr[kk * 65 + nn] = W[(size_t)(k0 + kk) * src_ld + ns + nn];
    }
    __syncthreads();
    {
      const int n = tid >> 3, c = tid & 7;
      const float* s = scr + (8 * c) * 65 + n;
      u32x4 o;
      o[0] = pk2(s[0], s[65]); o[1] = pk2(s[2 * 65], s[3 * 65]); o[2] = pk2(s[4 * 65], s[5 * 65]); o[3] = pk2(s[6 * 65], s[7 * 65]);
      const int nd = (remap && n0 < 2048) ? ((n < 32) ? 2 * n : 2 * (n - 32) + 1) : n;
      *(u32x4*)(WT + (size_t)(n0 + nd) * K + k0 + 8 * c) = o;
    }
    __syncthreads();
  }
}

DI void phase0(const Params& p, char* lds) {
  const int tid = otid();
  for (int l = 0; l < 2; ++l) {
    transpose_w(p.in[9] + (size_t)l * D * DIN, D, NIN, DIN, (bf16_t*)(p.ws + W_WIN) + (size_t)l * NIN * D, true, lds);
    transpose_w(p.in[16] + (size_t)l * D * D, D, D, D, (bf16_t*)(p.ws + W_WOUT) + (size_t)l * D * D, false, lds);
    transpose_w(p.in[19] + (size_t)l * D * NUP, D, NUP, NUP, (bf16_t*)(p.ws + W_WUP) + (size_t)l * NUP * D, false, lds);
    transpose_w(p.in[22] + (size_t)l * DFF * D, DFF, D, D, (bf16_t*)(p.ws + W_WDN) + (size_t)l * D * DFF, false, lds);
  }
  bf16_t* ab = (bf16_t*)(p.ws + W_AB);
  {
    const unsigned total = (unsigned)M * 128u, S = gridDim.x * NTH;
    for (unsigned c0 = blockIdx.x * NTH + (unsigned)tid; c0 < total; c0 += 4u * S) {
      f32x4 a[4], b4[4];
#pragma unroll
      for (int u = 0; u < 4; ++u) {
        const unsigned c = c0 + (unsigned)u * S;
        if (c < total) { const float* src = xrow_ptr(p, 0, (int)(c >> 7)) + (c & 127u) * 8; a[u] = *(const f32x4*)src; b4[u] = *(const f32x4*)(src + 4); }
      }
#pragma unroll
      for (int u = 0; u < 4; ++u) {
        const unsigned c = c0 + (unsigned)u * S;
        if (c < total) {
          u32x4 o; o[0] = pk2(a[u][0], a[u][1]); o[1] = pk2(a[u][2], a[u][3]); o[2] = pk2(b4[u][0], b4[u][1]); o[3] = pk2(b4[u][2], b4[u][3]);
          *(u32x4*)(ab + (size_t)(c >> 7) * D + (c & 127u) * 8) = o;
        }
      }
    }
  }
  float2* rope = (float2*)(p.ws + W_ROPE);
  for (int i = blockIdx.x * NTH + tid; i < 8192 * 32; i += gridDim.x * NTH) {
    const int pos = i >> 5, d = i & 31;
    const double inv = exp2(-(double)d * (13.287712379549449 / 32.0));
    double ang = (double)pos * inv;
    const double twopi = 6.283185307179586476925;
    ang -= twopi * rint(ang / twopi);
    float s, c; sincosf((float)ang, &s, &c);
    rope[i] = make_float2(c, s);
  }
  if (blockIdx.x == 0 && tid < 128) {
    const int l = tid >> 6, ln = tid & 63;
    const float* lp = p.in[13] + (size_t)l * 4 * 64;
    const float s1 = wave_sum(lp[ln] * lp[64 + ln]), s2 = wave_sum(lp[128 + ln] * lp[192 + ln]);
    const float lam_init = (l == 0) ? 0.2f : (0.8f - 0.6f * 0.74081822068171788f);
    if (ln == 0) ((float*)(p.ws + W_MISC))[l] = __expf(s1) - __expf(s2) + lam_init;
  }
  if (blockIdx.x == 0 && tid < 8) ((unsigned*)(p.ws + W_MISC))[16 + tid] = 0u;
  if (blockIdx.x == 0) for (int i = tid; i < 3456; i += NTH) ((unsigned*)(p.ws + W_BAR))[i] = 0u;
}

namespace pg8 {
#define PG8_LAS __attribute__((address_space(3)))
typedef unsigned short bf16_t;
typedef short bf16x8 __attribute__((ext_vector_type(8)));
typedef float f32x4 __attribute__((ext_vector_type(4)));
typedef unsigned u32x4 __attribute__((ext_vector_type(4)));
constexpr int BM = 256, BK = 64, HALF = 128, HTB = HALF * BK * 2  , STAGE_BYTES = 8 * HTB, NXCD = 8, WGM = 8;

__host__ __device__ __forceinline__ int lds_byte(int r, int c) { const int st = (r >> 4) * 2 + (c >> 5), rr = r & 15, cc = c & 31, ob = rr * 64 + cc * 2; return st * 1024 + (ob ^ (((ob >> 9) & 1) << 5)); }
__host__ __device__ __forceinline__ void stage_rc(int b, int& R, int& C) { const int st = b / 1024, sb = b % 1024, swz = sb ^ (((sb >> 9) & 1) << 5); R = (st >> 1) * 16 + swz / 64; C = (st & 1) * 32 + (swz % 64) / 2; }
__host__ __device__ __forceinline__ int perm32(int rho) { const int n = rho >> 4, i = rho & 15; return 8 * (i >> 2) + 4 * n + (i & 3); }

struct Unit { int pm, pn; };
struct Gemm { const bf16_t* A; const bf16_t* Bt; int M, N, K; };

struct StaticOrder {
    int nM, nN, nwg, G, c;
    __host__ __device__ void init(int M, int N, int G_, int c_) { nM = M / BM; nN = N / BM; nwg = nM * nN; G = G_; c = c_; }
    __host__ __device__ bool next(int i, Unit& u) const {
        const long L = (long)i * G + c; if (L >= nwg) return false;
        int wgid = (int)L; { const int q = nwg / NXCD, r = nwg % NXCD, xcd = wgid % NXCD, off = wgid / NXCD; wgid = (xcd < r ? xcd * (q + 1) : r * (q + 1) + (xcd - r) * q) + off; }
        const int nig = WGM * nN, gid = wgid / nig, fm = gid * WGM, gsz = (nM - fm) < WGM ? (nM - fm) : WGM;
        u.pm = fm + ((wgid % nig) % gsz); u.pn = (wgid % nig) / gsz; return true;
    }
    __device__ __forceinline__ void a_ready(const Unit&) const {}
    __device__ __forceinline__ void done(const Unit&) const {}
};
template <class Epi, class Sched, bool STAMP = false>
__device__ __forceinline__ void gemm_phase(PG8_LAS unsigned char* lds, const Gemm g, const Sched& S, const Epi& E, unsigned long long* stamps) {
    const int tid = otid(), wid = __builtin_amdgcn_readfirstlane(tid >> 6), lane = tid & 63, wr = wid >> 2, wc = wid & 3, fr = lane & 15, fq = lane >> 4;
    const int K = g.K, nt = K / BK;
    int ts_lo = 0, ts_hi = 0, nts = 0; const unsigned long long rt_entry = STAMP ? (unsigned long long)wall_clock64() : 0ull;
#define PG8_STAMP() do { if (STAMP && wid == 0 && nts < 64) { const unsigned long long _c = (unsigned long long)clock64(); \
        ts_lo = (lane == nts) ? (int)(unsigned)_c : ts_lo; ts_hi = (lane == nts) ? (int)(unsigned)(_c >> 32) : ts_hi; ++nts; } } while (0)
    PG8_STAMP();
    unsigned voffA[2], voffB[2];
#pragma unroll
    for (int i = 0; i < 2; ++i) { int R, C; stage_rc(tid * 16 + i * 8192, R, C); const int Rb = Epi::PERM ? ((R & ~31) + perm32(R & 31)) : R;
        voffA[i] = (unsigned)(R * K + C) * 2u; voffB[i] = (unsigned)(Rb * K + C) * 2u; }
    const size_t kstep = (size_t)(BK * 2);
    const size_t hstep = (size_t)HALF * K * 2;
    const size_t tstep = 2 * hstep;
    const unsigned ldsw = (unsigned)wid * 1024u;
    const int aoff = lds_byte(wr * 64 + fr, fq * 8), boff = lds_byte(wc * 32 + fr, fq * 8);
#define PG8_SA(b, h) (((b) * 2 + (h)) * HTB)
#define PG8_SB(b, h) ((4 + (b) * 2 + (h)) * HTB)
#define PG8_STAGE(bufoff, gbase, voff) do { _Pragma("unroll") for (int _i = 0; _i < 2; ++_i) \
        __builtin_amdgcn_global_load_lds((const unsigned*)((const char*)(gbase) + (voff)[_i]), (PG8_LAS unsigned*)(lds + (bufoff) + ldsw + _i * 8192), 16, 0, 0); } while (0)
#define PG8_LDA(dst, b, h) do { _Pragma("unroll") for (int m = 0; m < 4; ++m) _Pragma("unroll") for (int k = 0; k < 2; ++k) dst[m][k] = *(const PG8_LAS bf16x8*)(lds + PG8_SA(b, h) + aoff + m * 2048 + k * 1024); } while (0)
#define PG8_LDB(dst, b, h) do { _Pragma("unroll") for (int n = 0; n < 2; ++n) _Pragma("unroll") for (int k = 0; k < 2; ++k) dst[n][k] = *(const PG8_LAS bf16x8*)(lds + PG8_SB(b, h) + boff + n * 2048 + k * 1024); } while (0)
#define PG8_MMA(ai, bj, At, Bt) do { __builtin_amdgcn_s_setprio(1); _Pragma("unroll") for (int m = 0; m < 4; ++m) _Pragma("unroll") for (int n = 0; n < 2; ++n) _Pragma("unroll") for (int k = 0; k < 2; ++k) \
        acc[ai][bj][m][n] = __builtin_amdgcn_mfma_f32_16x16x32_bf16(Bt[n][k], At[m][k], acc[ai][bj][m][n], 0, 0, 0); __builtin_amdgcn_s_setprio(0); } while (0)
#define PG8_WAIT_V(n) asm volatile("s_waitcnt vmcnt(" #n ")" ::: "memory")
#define PG8_WAIT_L(n) asm volatile("s_waitcnt lgkmcnt(" #n ")" ::: "memory")
#define PG8_BAR __builtin_amdgcn_s_barrier()
#define PG8_SCHED __builtin_amdgcn_sched_barrier(0)
    Unit cur, nxt; int ui = 0;
    if (!S.next(0, cur)) return;
    f32x4 acc[2][2][4][2];
#pragma unroll
    for (int a = 0; a < 2; ++a)
#pragma unroll
        for (int b = 0; b < 2; ++b)
#pragma unroll
            for (int m = 0; m < 4; ++m)
#pragma unroll
                for (int n = 0; n < 2; ++n) acc[a][b][m][n] = (f32x4){0.f, 0.f, 0.f, 0.f};
    bf16x8 At[4][2], B0[2][2], B1[2][2];
    const char* cA = (const char*)g.A + (size_t)cur.pm * tstep; const char* cB = (const char*)g.Bt + (size_t)cur.pn * tstep;
    S.a_ready(cur);
    PG8_STAGE(PG8_SB(0, 0), cB, voffB); PG8_STAGE(PG8_SA(0, 0), cA, voffA); PG8_STAGE(PG8_SB(0, 1), cB + hstep, voffB); PG8_STAGE(PG8_SA(0, 1), cA + hstep, voffA);
    if (wr == 1) PG8_BAR;
    PG8_WAIT_V(4); PG8_BAR;
    PG8_STAGE(PG8_SB(1, 0), cB + kstep, voffB); PG8_STAGE(PG8_SA(1, 0), cA + kstep, voffA); PG8_STAGE(PG8_SB(1, 1), cB + hstep + kstep, voffB);
    PG8_WAIT_V(6); PG8_BAR;
    PG8_STAMP();
    for (;;) {
        const bool has_next = S.next(ui + 1, nxt);
        const char* nA = has_next ? (const char*)g.A + (size_t)nxt.pm * tstep : cA; const char* nB = has_next ? (const char*)g.Bt + (size_t)nxt.pn * tstep : cB;
        for (int t = 0; t < nt; t += 2) {
            const bool last = (t == nt - 2);
            const char* a1 = cA + (size_t)(t + 1) * kstep;
            const char* a2 = last ? nA : cA + (size_t)(t + 2) * kstep; const char* b2 = last ? nB : cB + (size_t)(t + 2) * kstep;
            const char* a3 = a2 + kstep; const char* b3 = b2 + kstep;
            if (last && has_next) S.a_ready(nxt);
            PG8_LDB(B0, 0, 0); PG8_SCHED; PG8_LDA(At, 0, 0); PG8_STAGE(PG8_SA(1, 1), a1 + hstep, voffA);
            PG8_WAIT_L(8); PG8_BAR; PG8_WAIT_L(0); PG8_MMA(0, 0, At, B0); PG8_BAR; PG8_SCHED;
            PG8_LDB(B1, 0, 1); PG8_STAGE(PG8_SB(0, 0), b2, voffB);
            PG8_BAR; PG8_WAIT_L(0); PG8_MMA(0, 1, At, B1); PG8_BAR;
            PG8_LDA(At, 0, 1); PG8_STAGE(PG8_SA(0, 0), a2, voffA);
            PG8_BAR; PG8_WAIT_L(0); PG8_MMA(1, 0, At, B0); PG8_BAR; PG8_SCHED;
            PG8_STAGE(PG8_SB(0, 1), b2 + hstep, voffB);
            PG8_WAIT_V(6); PG8_BAR; PG8_MMA(1, 1, At, B1); PG8_BAR;
            PG8_LDB(B0, 1, 0); PG8_SCHED; PG8_LDA(At, 1, 0); PG8_STAGE(PG8_SA(0, 1), a2 + hstep, voffA);
            PG8_WAIT_L(8); PG8_BAR; PG8_WAIT_L(0); PG8_MMA(0, 0, At, B0); PG8_BAR; PG8_SCHED;
            PG8_LDB(B1, 1, 1); PG8_STAGE(PG8_SB(1, 0), b3, voffB);
            PG8_BAR; PG8_WAIT_L(0); PG8_MMA(0, 1, At, B1); PG8_BAR;
            PG8_LDA(At, 1, 1); PG8_STAGE(PG8_SA(1, 0), a3, voffA);
            PG8_BAR; PG8_WAIT_L(0); PG8_MMA(1, 0, At, B0); PG8_BAR; PG8_SCHED;
            PG8_STAGE(PG8_SB(1, 1), b3 + hstep, voffB);
            PG8_WAIT_V(6); PG8_BAR; PG8_MMA(1, 1, At, B1); PG8_BAR;
        }
        PG8_STAMP();
        if constexpr (!Epi::AFTER_DRAIN) { E(acc, cur, wr, wc, fr, fq); S.done(cur); }
        PG8_STAMP();
        if (!has_next) break;
#pragma unroll
        for (int a = 0; a < 2; ++a)
#pragma unroll
            for (int b = 0; b < 2; ++b)
#pragma unroll
                for (int m = 0; m < 4; ++m)
#pragma unroll
                    for (int n = 0; n < 2; ++n) acc[a][b][m][n] = (f32x4){0.f, 0.f, 0.f, 0.f};
        cur = nxt; cA = nA; cB = nB; ++ui;
    }
    PG8_WAIT_V(0);
    if (wr == 0) PG8_BAR;
    PG8_BAR;
    if constexpr (Epi::AFTER_DRAIN) { E.fused(acc, cur, wr, wc, fr, fq, lds, wid, lane); S.done(cur); }
    PG8_STAMP();
    if (STAMP && wid == 0) { stamps[lane] = lane < nts ? (((unsigned long long)(unsigned)ts_hi << 32) | (unsigned)ts_lo) : 0ull;
        if (lane == 62) stamps[62] = rt_entry; if (lane == 63) stamps[63] = (unsigned long long)wall_clock64(); }
#undef PG8_STAMP
#undef PG8_SA
#undef PG8_SB
#undef PG8_STAGE
#undef PG8_LDA
#undef PG8_LDB
#undef PG8_MMA
#undef PG8_WAIT_V
#undef PG8_WAIT_L
#undef PG8_BAR
#undef PG8_SCHED
}
}

enum { EPI_IN = 0, EPI_OUT = 1, EPI_UP = 2, EPI_DOWN = 3 };
template <int MODE>
struct Epi {
  static constexpr bool PERM = true, AFTER_DRAIN = false;
  Params p; int l;
  DI void operator()(const f32x4 (&acc)[2][2][4][2], const pg8::Unit& u, int wr, int wc, int fr, int fq) const {
    const int colb = u.pn * 256 + wc * 32 + 8 * fq;
    if (MODE == EPI_OUT || MODE == EPI_DOWN) {
      float* Rb = (float*)(p.ws + W_R);
#pragma unroll
      for (int ai = 0; ai < 2; ++ai) {
        f32x4 res[4][2][2];
#pragma unroll
        for (int m = 0; m < 4; ++m) {
          const int row = u.pm * 256 + ai * 128 + wr * 64 + m * 16 + fr;
          const float* rs = (MODE == EPI_OUT ? xrow_ptr(p, l, row < M ? row : M - 1) : Rb + (size_t)(row < M ? row : M - 1) * D) + colb;
#pragma unroll
          for (int bj = 0; bj < 2; ++bj) { res[m][bj][0] = *(const f32x4*)(rs + bj * 128); res[m][bj][1] = *(const f32x4*)(rs + bj * 128 + 4); }
        }
#pragma unroll
        for (int m = 0; m < 4; ++m) {
          const int row = u.pm * 256 + ai * 128 + wr * 64 + m * 16 + fr;
          if (row < M) {
            float* R = Rb + (size_t)row * D + colb;
#pragma unroll
            for (int bj = 0; bj < 2; ++bj) {
              *(f32x4*)(R + bj * 128) = res[m][bj][0] * ALPHA + acc[ai][bj][m][0];
              *(f32x4*)(R + bj * 128 + 4) = res[m][bj][1] * ALPHA + acc[ai][bj][m][1];
            }
          }
        }
      }
      return;
    }
    f32x4 rc0[8], rc1[8];
    if (MODE == EPI_IN && (u.pn >> 2) <= 1) {
      const int d0 = (colb & 63) >> 1;
#pragma unroll
      for (int i = 0; i < 8; ++i) {
        int row = u.pm * 256 + (i >> 2) * 128 + wr * 64 + (i & 3) * 16 + fr; row = row < M ? row : M - 1;
        const int pos = row < MP ? (row & (SEQ - 1)) : PAST + ((row - MP) & 15);
        const f32x4* rp = (const f32x4*)((const float2*)(p.ws + W_ROPE) + pos * 32 + d0);
        rc0[i] = rp[0]; rc1[i] = rp[1];
      }
    }
#pragma unroll
    for (int ai = 0; ai < 2; ++ai)
#pragma unroll
      for (int m = 0; m < 4; ++m) {
        const int row = u.pm * 256 + ai * 128 + wr * 64 + m * 16 + fr;
        if (row < M) {
#pragma unroll
          for (int bj = 0; bj < 2; ++bj) {
            const int col = colb + bj * 128;
            const f32x4 v0 = acc[ai][bj][m][0], v1 = acc[ai][bj][m][1];
            if (MODE == EPI_IN) {
              bf16_t* Z = (bf16_t*)(p.ws + W_Z);
              const int seg = u.pn >> 2;
              if (seg <= 1) {
                const int d0 = (col & 63) >> 1;
                const f32x4 c01 = rc0[ai * 4 + m], c23 = rc1[ai * 4 + m];
                const float a0 = v0[0] * c01[0] - v0[1] * c01[1], b0 = v0[1] * c01[0] + v0[0] * c01[1];
                const float a1 = v0[2] * c01[2] - v0[3] * c01[3], b1 = v0[3] * c01[2] + v0[2] * c01[3];
                const float a2 = v1[0] * c23[0] - v1[1] * c23[1], b2 = v1[1] * c23[0] + v1[0] * c23[1];
                const float a3 = v1[2] * c23[2] - v1[3] * c23[3], b3 = v1[3] * c23[2] + v1[2] * c23[3];
                const float qs = seg == 0 ? 0.125f : 1.f;
                u32x4 o; o[0] = pk2(a0 * qs, b0 * qs); o[1] = pk2(a1 * qs, b1 * qs); o[2] = pk2(a2 * qs, b2 * qs); o[3] = pk2(a3 * qs, b3 * qs);
                __builtin_nontemporal_store(o, (u32x4*)(Z + (size_t)row * NIN + col));
                if (seg == 1) {
                  float* ob = (row < MP ? p.out + O_KP + ((size_t)l * MP + row) * 1024 : p.out + O_KS + ((size_t)l * MS + row - MP) * 1024) + ((col - 1024) & ~63) + d0;
                  f32x4 o1, o2; o1[0] = a0; o1[1] = a1; o1[2] = a2; o1[3] = a3; o2[0] = b0; o2[1] = b1; o2[2] = b2; o2[3] = b3;
                  __builtin_nontemporal_store(o1, (f32x4*)ob); __builtin_nontemporal_store(o2, (f32x4*)(ob + 32));
                }
              } else {
                u32x4 o; o[0] = pk2(v0[0], v0[1]); o[1] = pk2(v0[2], v0[3]); o[2] = pk2(v1[0], v1[1]); o[3] = pk2(v1[2], v1[3]);
                __builtin_nontemporal_store(o, (u32x4*)(Z + (size_t)row * NIN + col));
                if (seg == 2) {
                  float* ob = (row < MP ? p.out + O_VP + ((size_t)l * MP + row) * 1024 : p.out + O_VS + ((size_t)l * MS + row - MP) * 1024) + (col - 2048);
                  __builtin_nontemporal_store(v0, (f32x4*)ob); __builtin_nontemporal_store(v1, (f32x4*)(ob + 4));
                } else if (seg == 3 || seg == 4) {
                  float* ob = nullptr;
                  if (row < MP) { const int s = row & (SEQ - 1); if (s >= SEQ - 3) ob = p.out + O_MCP + ((size_t)(l * 4 + (row >> 13)) * 3 + (s - (SEQ - 3))) * 2048 + col - 3072; }
                  else { const int t = (row - MP) & 15, b = (row - MP) >> 4; if (t >= 13) ob = p.out + O_MCS + ((size_t)(l * 8 + b) * 3 + (t - 13)) * 2048 + col - 3072; }
                  if (ob) { *(f32x4*)ob = v0; *(f32x4*)(ob + 4) = v1; }
                }
              }
            } else if (MODE == EPI_OUT || MODE == EPI_DOWN) {
              float* R = (float*)(p.ws + W_R) + (size_t)row * D + col;
              const float* rs = MODE == EPI_OUT ? xrow_ptr(p, l, row) + col : R;
              const f32x4 r0 = *(const f32x4*)rs, r1 = *(const f32x4*)(rs + 4);
              *(f32x4*)R = r0 * ALPHA + v0; *(f32x4*)(R + 4) = r1 * ALPHA + v1;
            } else {
              bf16_t* U = (bf16_t*)(p.ws + W_Z);
              u32x4 o; o[0] = pk2(v0[0], v0[1]); o[1] = pk2(v0[2], v0[3]); o[2] = pk2(v1[0], v1[1]); o[3] = pk2(v1[2], v1[3]);
              __builtin_nontemporal_store(o, (u32x4*)(U + (size_t)row * NUP + col));
              float* ob = nullptr;
              if (row < MP) { const int s = row & (SEQ - 1); if (s >= SEQ - 2) ob = p.out + O_FCP + ((size_t)(l * 4 + (row >> 13)) * 2 + (s - (SEQ - 2))) * NUP + col; }
              else { const int t = (row - MP) & 15, b = (row - MP) >> 4; if (t >= 14) ob = p.out + O_FCS + ((size_t)(l * 8 + b) * 2 + (t - 14)) * NUP + col; }
              if (ob) { *(f32x4*)ob = v0; *(f32x4*)(ob + 4) = v1; }
            }
          }
        }
      }
  }
};

template <int MODE>
DI void gemm_phase(const Params& p, int l, const bf16_t* A, int lda, const bf16_t* Bt, int K, int ntn, char* lds) {
  (void)lda;
  pg8::Gemm g; g.A = A; g.Bt = Bt; g.M = ((MODE == EPI_OUT || MODE == EPI_DOWN) ? NTM - 1 : NTM) * 256; g.N = ntn * 256; g.K = K;
  if (MODE == EPI_OUT || MODE == EPI_DOWN) sample_gemm<MODE>(p, l, A, Bt, K);
  pg8::StaticOrder S; S.init(g.M, g.N, (int)gridDim.x, (int)blockIdx.x);
  Epi<MODE> E; E.p = p; E.l = l;
  pg8::gemm_phase<Epi<MODE>, pg8::StaticOrder, false>((PG8_LAS unsigned char*)lds, g, S, E, nullptr);
  __syncthreads();
}

typedef float f32x4v __attribute__((ext_vector_type(4)));
template <int MODE>
DI void sample_gemm(const Params& p, int l, const bf16_t* A, const bf16_t* Bt, int K) {
  if (blockIdx.x >= 64) return;
  const int tid = otid(), lane = tid & 63, wave = uni(tid >> 6), fr = lane & 15, fq = lane >> 4;
  const bf16_t* ap = A + (size_t)(MP + wave * 16 + fr) * K + fq * 8;
  const bf16_t* bp = Bt + (size_t)(blockIdx.x * 16 + fr) * K + fq * 8;
  f32x4v acc0 = {0.f, 0.f, 0.f, 0.f}, acc1 = {0.f, 0.f, 0.f, 0.f};
  for (int k0 = 0; k0 < K; k0 += 256) {
    bf16x8 a[8], bb[8];
#pragma unroll
    for (int i = 0; i < 8; ++i) { a[i] = *(const bf16x8*)(ap + k0 + i * 32); bb[i] = *(const bf16x8*)(bp + k0 + i * 32); }
#pragma unroll
    for (int i = 0; i < 8; i += 2) {
      acc0 = __builtin_amdgcn_mfma_f32_16x16x32_bf16(a[i], bb[i], acc0, 0, 0, 0);
      acc1 = __builtin_amdgcn_mfma_f32_16x16x32_bf16(a[i + 1], bb[i + 1], acc1, 0, 0, 0);
    }
  }
  const int col = blockIdx.x * 16 + fr;
  float* R = (float*)(p.ws + W_R);
#pragma unroll
  for (int j = 0; j < 4; ++j) {
    const int row = MP + wave * 16 + fq * 4 + j;
    const float res = MODE == EPI_OUT ? xrow_ptr(p, l, row)[col] : R[(size_t)row * D + col];
    R[(size_t)row * D + col] = ALPHA * res + (acc0[j] + acc1[j]);
  }
}

DI void gif_phase(const Params& p, int l, char* lds, int first_blk) {
  if ((int)blockIdx.x < first_blk) return;
  const int tidq = otid(); const int lane = tidq & 63, gw = ((int)blockIdx.x - first_blk) * 8 + (tidq >> 6), ngw = ((int)gridDim.x - first_blk) * 8;
  const float* w = p.in[9] + (size_t)l * D * DIN + 7168;
  const float* bif = p.in[10] + l * 8;
  float* gif = (float*)(p.ws + W_GIF);
  float* w8 = (float*)lds;
  __syncthreads();
#pragma unroll
  for (int i = 0; i < 2; ++i) {
    const int k = tidq + 512 * i;
    *(f32x4*)(w8 + k * 8) = *(const f32x4*)(w + (size_t)k * DIN); *(f32x4*)(w8 + k * 8 + 4) = *(const f32x4*)(w + (size_t)k * DIN + 4);
  }
  __syncthreads();
  for (int rg = gw; rg < M / 4; rg += ngw) {
    float acc[4][8];
#pragma unroll
    for (int a = 0; a < 4; ++a)
#pragma unroll
      for (int j = 0; j < 8; ++j) acc[a][j] = 0.f;
    const float* x0 = xrow_ptr(p, l, rg * 4);
#pragma unroll 4
    for (int kk = 0; kk < 16; ++kk) {
      const int k = kk * 64 + lane;
      const f32x4 w0 = *(const f32x4*)(w8 + k * 8), w1 = *(const f32x4*)(w8 + k * 8 + 4);
#pragma unroll
      for (int a = 0; a < 4; ++a) {
        const float xv = x0[(size_t)a * D + k];
        acc[a][0] += xv * w0[0]; acc[a][1] += xv * w0[1]; acc[a][2] += xv * w0[2]; acc[a][3] += xv * w0[3];
        acc[a][4] += xv * w1[0]; acc[a][5] += xv * w1[1]; acc[a][6] += xv * w1[2]; acc[a][7] += xv * w1[3];
      }
    }
#pragma unroll
    for (int a = 0; a < 4; ++a)
#pragma unroll
      for (int j = 0; j < 8; ++j) {
        const float s = wave_sum(acc[a][j]);
        if (lane == 0) gif[(size_t)(rg * 4 + a) * 8 + j] = s + bif[j];
      }
  }
  __syncthreads();
}

DI void qkconv_phase(const Params& p, int l) {
  const bf16_t* Z = (const bf16_t*)(p.ws + W_Z);
  bf16_t* QA = (bf16_t*)(p.ws + W_AB); bf16_t* KA = (bf16_t*)(p.ws + W_KA);
  const float* cw = p.in[11] + (size_t)l * 4 * 2048; const float* cb = p.in[12] + (size_t)l * 2048;
  constexpr int RG = 8;
  const size_t total = (size_t)(M / RG) * 256;
  const int tid_ = otid();
  const int col = (tid_ & 255) * 8;
  float w[4][8], bias[8];
#pragma unroll
  for (int j = 0; j < 4; ++j) { f32x4 a = *(const f32x4*)(cw + j * 2048 + col), b = *(const f32x4*)(cw + j * 2048 + col + 4);
    w[j][0] = a[0]; w[j][1] = a[1]; w[j][2] = a[2]; w[j][3] = a[3]; w[j][4] = b[0]; w[j][5] = b[1]; w[j][6] = b[2]; w[j][7] = b[3]; }
  { f32x4 a = *(const f32x4*)(cb + col), b = *(const f32x4*)(cb + col + 4);
    bias[0] = a[0]; bias[1] = a[1]; bias[2] = a[2]; bias[3] = a[3]; bias[4] = b[0]; bias[5] = b[1]; bias[6] = b[2]; bias[7] = b[3]; }
  for (size_t it = (size_t)blockIdx.x * NTH + tid_; it < total; it += (size_t)gridDim.x * NTH) {
    const int rg = (int)(it >> 8), row0 = rg * RG;
    int t0;
    const float* st = nullptr;
    if (row0 < MP) { t0 = row0 & (SEQ - 1); }
    else { t0 = (row0 - MP) & 15; st = p.in[4] + ((size_t)(l * 8 + ((row0 - MP) >> 4)) * 3) * 2048 + col; }
    float x[RG + 3][8];
#pragma unroll
    for (int j = 0; j < RG + 3; ++j) {
      const int t = t0 - 3 + j;
      if (t >= 0) { u32x4 v = *(const u32x4*)(Z + (size_t)(row0 - 3 + j) * NIN + 3072 + col); unpack8(v, x[j]); }
      else if (st) { f32x4 a = *(const f32x4*)(st + (size_t)(3 + t) * 2048), b = *(const f32x4*)(st + (size_t)(3 + t) * 2048 + 4);
        x[j][0] = a[0]; x[j][1] = a[1]; x[j][2] = a[2]; x[j][3] = a[3]; x[j][4] = b[0]; x[j][5] = b[1]; x[j][6] = b[2]; x[j][7] = b[3]; }
      else {
#pragma unroll
        for (int e = 0; e < 8; ++e) x[j][e] = 0.f; }
    }
    const float sc = col >= 1024 ? 0.0625f : 1.f;
    bf16_t* dst = col >= 1024 ? KA + (col - 1024) : QA + col;
#pragma unroll
    for (int a = 0; a < RG; ++a) {
      float o[8];
#pragma unroll
      for (int e = 0; e < 8; ++e) {
        float u = bias[e] + w[0][e] * x[a][e] + w[1][e] * x[a + 1][e] + w[2][e] * x[a + 2][e] + w[3][e] * x[a + 3][e];
        o[e] = u * sigmoidf_(u) * sc;
      }
      u32x4 ov; ov[0] = pk2(o[0], o[1]); ov[1] = pk2(o[2], o[3]); ov[2] = pk2(o[4], o[5]); ov[3] = pk2(o[6], o[7]);
      *(u32x4*)(dst + (size_t)(row0 + a) * D) = ov;
    }
  }
}

constexpr int A_LD = 272;
constexpr int A_TILE = 64 * A_LD;
constexpr int A_VLD = 320;
constexpr int A_VTILE = 64 * A_VLD;
template <int KIND>
DI void attn_item(const Params& p, int l, int b, int ha, int qb, char* lds) {
  const int tid = otid(), lane = tid & 63, wave = uni(tid >> 6);
  const int map = wave >> 2, qt = wave & 3, r = lane & 31, h = lane >> 5;
  const bf16_t* Z = (const bf16_t*)(p.ws + W_Z);
  const int NT = KIND == 0 ? 2 * (qb + 1) : (NKS + 63) / 64;
  const int ntw = KIND == 0 ? 2 * qb + (qt >> 1) + 1 : NT;
  const bool active = KIND == 0 ? true : (qt == 0);
  int qrow;
  if (KIND == 0) qrow = b * SEQ + qb * 128 + qt * 32 + r; else qrow = MP + b * 16 + (r < 16 ? r : 15);
  bf16x8 qf[4];
#pragma unroll
  for (int ks = 0; ks < 4; ++ks) {
    if (KIND == 0) qf[ks] = *(const bf16x8*)(Z + (size_t)qrow * NIN + ha * 128 + map * 64 + ks * 16 + h * 8);
    else {
      const int dn = ks * 16 + h * 8, par = dn >> 5, dd = dn & 31;
      const bf16_t* src = Z + (size_t)qrow * NIN + ha * 128 + map * 64 + 2 * dd;
      const u32x4 lo = *(const u32x4*)src, hi = *(const u32x4*)(src + 8);
      unsigned e[8];
#pragma unroll
      for (int i = 0; i < 4; ++i) { e[i] = par ? (lo[i] >> 16) : (lo[i] & 0xffffu); e[4 + i] = par ? (hi[i] >> 16) : (hi[i] & 0xffffu); }
      u32x4 o; o[0] = e[0] | (e[1] << 16); o[1] = e[2] | (e[3] << 16); o[2] = e[4] | (e[5] << 16); o[3] = e[6] | (e[7] << 16);
      qf[ks] = __builtin_bit_cast(bf16x8, o);
    }
  }
  const int skey = tid >> 4, part = tid & 15;
  u32x4 rk0, rk1, rv0, rv1;
  auto gload = [&](int j) {
    if (KIND == 0) {
      const bf16_t* base = Z + (size_t)(b * SEQ + j * 64 + skey) * NIN + 1024 + ha * 128 + part * 8;
      rk0 = *(const u32x4*)base; rk1 = *(const u32x4*)(base + (size_t)32 * NIN);
      rv0 = *(const u32x4*)(base + 1024); rv1 = *(const u32x4*)(base + (size_t)32 * NIN + 1024);
    } else {
#pragma unroll
      for (int i = 0; i < 2; ++i) {
        int kk = j * 64 + skey + 32 * i; if (kk > NKS - 1) kk = NKS - 1;
        const float *ks_, *vs_;
        if (kk < PAST) { const size_t o = (((size_t)(l * 8 + b) * PAST + kk) * 8 + ha) * 128 + part * 8; ks_ = p.in[2] + o; vs_ = p.in[3] + o; }
        else { const size_t o = (((size_t)l * MS + b * 16 + (kk - PAST)) * 8 + ha) * 128 + part * 8; ks_ = p.out + O_KS + o; vs_ = p.out + O_VS + o; }
        const f32x4 a0 = *(const f32x4*)ks_, a1 = *(const f32x4*)(ks_ + 4), c0 = *(const f32x4*)vs_, c1 = *(const f32x4*)(vs_ + 4);
        u32x4 ko, vo;
        ko[0] = pk2(a0[0], a0[1]); ko[1] = pk2(a0[2], a0[3]); ko[2] = pk2(a1[0], a1[1]); ko[3] = pk2(a1[2], a1[3]);
        vo[0] = pk2(c0[0], c0[1]); vo[1] = pk2(c0[2], c0[3]); vo[2] = pk2(c1[0], c1[1]); vo[3] = pk2(c1[2], c1[3]);
        if (i == 0) { rk0 = ko; rv0 = vo; } else { rk1 = ko; rv1 = vo; }
      }
    }
  };
  f32x16 O[4];
#pragma unroll
  for (int v = 0; v < 4; ++v)
#pragma unroll
    for (int i = 0; i < 16; ++i) O[v][i] = 0.f;
  float m_run = -1e30f, l_run = 0.f;
  const int q4 = (lane & 15) >> 2, p4 = lane & 3, blk = (lane >> 4) & 1;
  const unsigned sofs = skey * A_LD + part * 16, vofs = skey * A_VLD + part * 16;
  auto qk = [&](int j, f32x16 (&st)[2]) {
    const char* kb = lds + (j & 1) * A_TILE;
#pragma unroll
    for (int kt = 0; kt < 2; ++kt) {
#pragma unroll
      for (int i = 0; i < 16; ++i) st[kt][i] = 0.f;
#pragma unroll
      for (int ks = 0; ks < 4; ++ks) {
        const bf16x8 kf = *(const bf16x8*)(kb + (kt * 32 + r) * A_LD + (map * 64 + ks * 16 + h * 8) * 2);
        st[kt] = MFMA32(kf, qf[ks], st[kt]);
      }
    }
    if (KIND == 1 && j == NT - 1) {
#pragma unroll
      for (int kt = 0; kt < 2; ++kt)
#pragma unroll
        for (int i = 0; i < 16; ++i) if (j * 64 + kt * 32 + crow(i, h) >= NKS) st[kt][i] = -1e30f;
    }
  };
  bf16x8 pk[4];
  auto smax = [&](int j, f32x16 (&sc)[2], f32x16 (&sn)[2]) {
    if (j + 1 < ntw) qk(j + 1, sn);
    float mx = sc[0][0];
#pragma unroll
    for (int kt = 0; kt < 2; ++kt)
#pragma unroll
      for (int i = 0; i < 16; ++i) mx = fmaxf(mx, sc[kt][i]);
    mx = fmaxf(mx, __shfl_xor(mx, 32));
    const float m_new = fmaxf(m_run, mx);
    const float alpha = __builtin_amdgcn_exp2f((m_run - m_new) * LOG2E);
    const float mb = m_new * LOG2E;
    float rs = 0.f;
#pragma unroll
    for (int kt = 0; kt < 2; ++kt)
#pragma unroll
      for (int i = 0; i < 16; ++i) { const float e = __builtin_amdgcn_exp2f(sc[kt][i] * LOG2E - mb); sc[kt][i] = e; rs += e; }
    rs += __shfl_xor(rs, 32);
    l_run = l_run * alpha + rs; m_run = m_new;
    if (__builtin_amdgcn_ballot_w64(alpha != 1.f) != 0ull) {
#pragma unroll
      for (int v = 0; v < 4; ++v)
#pragma unroll
        for (int i = 0; i < 16; ++i) O[v][i] *= alpha;
    }
    pk[0] = pack8(sc[0], 0); pk[1] = pack8(sc[0], 1); pk[2] = pack8(sc[1], 0); pk[3] = pack8(sc[1], 1);
  };
  auto pv = [&](int j) {
    const unsigned vaddr = lds_addr(lds + 2 * A_TILE + (j % 3) * A_VTILE) + (4 * h + q4) * A_VLD + (16 * blk + 4 * p4) * 2;
    __builtin_amdgcn_s_setprio(1);
#pragma unroll
    for (int vt = 0; vt < 4; ++vt) {
      bf16x8 vf[4];
      tr_frag4<16 * A_VLD, 8 * A_VLD>(vaddr + vt * 64, vf);
#pragma unroll
      for (int ks = 0; ks < 4; ++ks) O[vt] = MFMA32(vf[ks], pk[ks], O[vt]);
    }
    __builtin_amdgcn_s_setprio(0);
  };
  gload(0);
  { char* kb = lds + sofs; *(u32x4*)kb = rk0; *(u32x4*)(kb + 32 * A_LD) = rk1; char* vb = lds + 2 * A_TILE + vofs; *(u32x4*)vb = rv0; *(u32x4*)(vb + 32 * A_VLD) = rv1; }
  gload(1);
  { char* kb = lds + A_TILE + sofs; *(u32x4*)kb = rk0; *(u32x4*)(kb + 32 * A_LD) = rk1; }
  __syncthreads();
  f32x16 sA[2], sB[2];
  if (active && 0 < ntw) qk(0, sA);
  for (int j = 0; j < NT; j += 2) {
#pragma unroll
    for (int u = 0; u < 2; ++u) {
      const int jj = j + u;
      if (jj < NT) {
        if (jj + 1 < NT) { char* vb = lds + 2 * A_TILE + ((jj + 1) % 3) * A_VTILE + vofs; *(u32x4*)vb = rv0; *(u32x4*)(vb + 32 * A_VLD) = rv1; }
        if (jj + 2 < NT) gload(jj + 2);
        if (active) {
          if (map == 1 && jj >= 1 && jj - 1 < ntw) pv(jj - 1);
          if (jj < ntw) { if (u == 0) smax(jj, sA, sB); else smax(jj, sB, sA); }
          if (map == 0 && jj < ntw) pv(jj);
        }
        if (jj + 2 < NT) { char* kb = lds + (jj & 1) * A_TILE + sofs; *(u32x4*)kb = rk0; *(u32x4*)(kb + 32 * A_LD) = rk1; }
        __syncthreads();
      }
    }
  }
  if (active && map == 1 && ntw == NT) pv(NT - 1);
  __syncthreads();
  float* ex = (float*)lds;
  const float inv_l = 1.f / l_run;
  if (map == 1) {
#pragma unroll
    for (int vt = 0; vt < 4; ++vt)
#pragma unroll
      for (int g = 0; g < 4; ++g) {
        f32x4 o; o[0] = O[vt][4 * g] * inv_l; o[1] = O[vt][4 * g + 1] * inv_l; o[2] = O[vt][4 * g + 2] * inv_l; o[3] = O[vt][4 * g + 3] * inv_l;
        *(f32x4*)(ex + (qt * 32 + r) * 132 + vt * 32 + 8 * g + 4 * h) = o;
      }
  }
  __syncthreads();
  if (map == 0) {
    const float lam = ((const float*)(p.ws + W_MISC))[l];
    const float lam_init = (l == 0) ? 0.2f : (0.8f - 0.6f * 0.74081822068171788f);
    float ssq = 0.f;
#pragma unroll
    for (int vt = 0; vt < 4; ++vt)
#pragma unroll
      for (int g = 0; g < 4; ++g) {
        const f32x4 o2 = *(const f32x4*)(ex + (qt * 32 + r) * 132 + vt * 32 + 8 * g + 4 * h);
#pragma unroll
        for (int e = 0; e < 4; ++e) { const float o = O[vt][4 * g + e] * inv_l - lam * o2[e]; O[vt][4 * g + e] = o; ssq += o * o; }
      }
    ssq += __shfl_xor(ssq, 32);
    const float rms = rsqrtf(ssq * (1.f / 128.f) + LN_EPS) * (1.f - lam_init);
    const float* sg = p.in[14] + l * 128;
    const bool valid = KIND == 0 ? true : (qt == 0 && r < 16);
    if (valid) {
      bf16_t* dst = (bf16_t*)(p.ws + W_Z) + (size_t)qrow * NIN + 3072 + ha * 128;
#pragma unroll
      for (int vt = 0; vt < 4; ++vt)
#pragma unroll
        for (int g = 0; g < 4; ++g) {
          const int v0 = vt * 32 + 8 * g + 4 * h;
          const f32x4 gg = *(const f32x4*)(sg + v0);
          u32x2 o; o[0] = pk2(O[vt][4 * g] * rms * gg[0], O[vt][4 * g + 1] * rms * gg[1]); o[1] = pk2(O[vt][4 * g + 2] * rms * gg[2], O[vt][4 * g + 3] * rms * gg[3]);
          *(u32x2*)(dst + v0) = o;
        }
    }
  }
  __syncthreads();
}

constexpr int L_LD = 528;
constexpr int L_VLD = 320;
constexpr int L_Q = 0, L_K = 64 * L_LD, L_V = 2 * 64 * L_LD, L_SW = L_V + 64 * L_VLD;
constexpr int L_SWLD = 144;
constexpr int L_SC = L_SW + 64 * L_SWLD;
constexpr int S_MX = 0, S_G = 64, S_EMT = 128, S_DS0 = 192, S_DS1 = 256, S_QN = 320  , S_NV = 576  , S_GEND = 832, S_PAR = 840;
constexpr int LDS_BYTES = 153376;
static_assert(L_SC + 2 * S_PAR * 4 <= 131072, "lds");
#define WG_BAR() do { __builtin_amdgcn_fence(__ATOMIC_RELEASE, "workgroup"); __builtin_amdgcn_s_barrier(); __builtin_amdgcn_fence(__ATOMIC_ACQUIRE, "workgroup"); } while (0)

template <int KIND>
DI void mlstm_item(const Params& p, int l, int b, int hm, int half, char* lds) {
  const int tid0 = otid(), wave = uni(tid0 >> 6);
  const bf16_t* QA = (const bf16_t*)(p.ws + W_AB); const bf16_t* KA = (const bf16_t*)(p.ws + W_KA);
  const bf16_t* Z = (const bf16_t*)(p.ws + W_Z); bf16_t* H = (bf16_t*)(p.ws + W_H);
  const float* GIF = (const float*)(p.ws + W_GIF);
  float* scb = (float*)(lds + L_SC);
  int nchunks = KIND == 0 ? SEQ / 64 : 1; asm volatile("" : "+s"(nchunks));
  const int Lv = KIND == 0 ? 64 : 16;
  const size_t bh = KIND == 0 ? (size_t)(l * 4 + b) * 4 + hm : (size_t)(l * 8 + b) * 4 + hm;
  if (wave < 4) {
    f32x16 C[8];
    { const int lane = tid0 & 63, r = lane & 31, h = lane >> 5; (void)r; (void)h;
      if (KIND == 0) {
#pragma unroll
        for (int d = 0; d < 8; ++d)
#pragma unroll
          for (int i = 0; i < 16; ++i) C[d][i] = 0.f;
      } else {
        const float* cp = p.in[5] + bh * 65536 + (size_t)(4 * h) * 256 + half * 128 + wave * 32 + r;
#pragma unroll
        for (int d = 0; d < 8; ++d)
#pragma unroll
          for (int g = 0; g < 4; ++g) {
            C[d][4 * g] = cp[0]; C[d][4 * g + 1] = cp[256]; C[d][4 * g + 2] = cp[512]; C[d][4 * g + 3] = cp[768];
            cp += 2048; asm volatile("" : "+v"(cp));
          }
      }
    }
    for (int c = 0; c < nchunks; ++c) {
      int tid = tid0; asm volatile("" : "+v"(tid));
      const int lane = tid & 63, r = lane & 31, h = lane >> 5;
      const int q4 = (lane & 15) >> 2, p4 = lane & 3, blk = (lane >> 4) & 1;
      const float* sc = scb + (c & 1) * S_PAR;
      const int rowbase = KIND == 0 ? b * SEQ + c * 64 : MP + b * 16;
      WG_BAR();
      f32x16 accB[2];
#pragma unroll
      for (int tt = 0; tt < 2; ++tt)
#pragma unroll
        for (int i = 0; i < 16; ++i) accB[tt][i] = 0.f;
#pragma unroll
      for (int d = 0; d < 8; ++d)
#pragma unroll
        for (int s = 0; s < 2; ++s) {
          __builtin_amdgcn_sched_barrier(0);
          const bf16x8 cf = pack8(C[d], s);
#pragma unroll
          for (int tt = 0; tt < 2; ++tt) {
            const char* qp = lds + L_Q + (tt * 32 + r) * L_LD + (d * 32 + 16 * s + 4 * h) * 2;
            const s16x4 lo = *(const s16x4*)qp, hi = *(const s16x4*)(qp + 16);
            const bf16x8 qfr = __builtin_shufflevector(lo, hi, 0, 1, 2, 3, 4, 5, 6, 7);
            accB[tt] = MFMA32(cf, qfr, accB[tt]);
          }
        }
      __builtin_amdgcn_sched_barrier(0);
      bf16x8 vf[4];
      tr_frag4<16 * L_VLD, 4 * L_VLD>(lds_addr(lds + L_V) + (8 * h + q4) * L_VLD + (wave * 32 + 16 * blk + 4 * p4) * 2, vf);
      const float g_end = sc[S_GEND];
#pragma unroll
      for (int d = 0; d < 8; ++d) {
#pragma unroll
        for (int i = 0; i < 16; ++i) C[d][i] *= g_end;
        bf16x8 kf[4];
        tr_frag4<16 * L_LD, 4 * L_LD>(lds_addr(lds + L_K) + (8 * h + q4) * L_LD + (d * 32 + 16 * blk + 4 * p4) * 2, kf);
#pragma unroll
        for (int ks = 0; ks < 4; ++ks) C[d] = MFMA32(kf[ks], vf[ks], C[d]);
      }
      WG_BAR();
#pragma unroll
      for (int tt = 0; tt < 2; ++tt) {
        const int t = tt * 32 + r;
        const float g = sc[S_G + t];
#pragma unroll
        for (int i = 0; i < 16; ++i) accB[tt][i] *= g;
        const char* sp = lds + L_SW + (tt * 32 + r) * L_SWLD + h * 16;
#pragma unroll
        for (int ks = 0; ks < 4; ++ks) accB[tt] = MFMA32(vf[ks], *(const bf16x8*)(sp + ks * 32), accB[tt]);
        const float qn = (sc[S_QN + t] + sc[S_QN + 64 + t]) + (sc[S_QN + 128 + t] + sc[S_QN + 192 + t]);
        float den = sc[S_DS0 + t] + sc[S_DS1 + t] + g * qn;
        den = fmaxf(fabsf(den), sc[S_EMT + t]);
        const float rden = 1.f / den;
        if (t < Lv) {
          bf16_t* dst = H + (size_t)(rowbase + t) * D + hm * 256 + half * 128 + wave * 32;
#pragma unroll
          for (int g4 = 0; g4 < 4; ++g4) {
            u32x2 o; o[0] = pk2(accB[tt][4 * g4] * rden, accB[tt][4 * g4 + 1] * rden); o[1] = pk2(accB[tt][4 * g4 + 2] * rden, accB[tt][4 * g4 + 3] * rden);
            *(u32x2*)(dst + 8 * g4 + 4 * h) = o;
          }
        }
      }
    }
    WG_BAR();
    {
      const int lane = tid0 & 63, r = lane & 31, h = lane >> 5;
      float* co = p.out + (KIND == 0 ? O_CP : O_CS) + bh * 65536 + (size_t)(4 * h) * 256 + half * 128 + wave * 32 + r;
#pragma unroll
      for (int d = 0; d < 8; ++d)
#pragma unroll
        for (int g = 0; g < 4; ++g) {
          co[0] = C[d][4 * g]; co[256] = C[d][4 * g + 1]; co[512] = C[d][4 * g + 2]; co[768] = C[d][4 * g + 3];
          co += 2048; asm volatile("" : "+v"(co));
        }
    }
  } else {
    const int hw = wave - 4;
    float nreg = 0.f, m_prev = 0.f;
    if (KIND == 1) { nreg = p.in[6][bh * 256 + (tid0 - 256)]; m_prev = p.in[7][bh]; }
    u32x4 pq[8], pk[8], pv[4];
    float gi = 0.f, gf = 0.f, g_end_cur = 0.f;
    auto issue_loads = [&](int c, int tid) {
      const int ht = tid - 256, lane = tid & 63;
      const int rowbase = KIND == 0 ? b * SEQ + c * 64 : MP + b * 16;
      const bool tvalid = lane < Lv;
      gi = tvalid ? GIF[(size_t)(rowbase + lane) * 8 + hm] : -1e30f;
      gf = tvalid ? GIF[(size_t)(rowbase + lane) * 8 + 4 + hm] : 0.f;
#pragma unroll
      for (int i = 0; i < 8; ++i) {
        const int cidx = ht + 256 * i, t = cidx >> 5, pc = cidx & 31;
        const int row = rowbase + (t < Lv ? t : Lv - 1);
        pq[i] = *(const u32x4*)(QA + (size_t)row * D + hm * 256 + pc * 8);
        pk[i] = *(const u32x4*)(KA + (size_t)row * D + hm * 256 + pc * 8);
      }
#pragma unroll
      for (int i = 0; i < 4; ++i) {
        const int cidx = ht + 256 * i, t = cidx >> 4, pc = cidx & 15;
        const int row = rowbase + (t < Lv ? t : Lv - 1);
        pv[i] = *(const u32x4*)(Z + (size_t)row * NIN + 5120 + hm * 256 + half * 128 + pc * 8);
      }
    };
    auto scalars = [&](int par, int lane) -> float {
      const bool tvalid = lane < Lv;
      const float lf = tvalid ? (fminf(gf, 0.f) - __logf(1.f + __expf(-fabsf(gf)))) : 0.f;
      float bc = lf;
#pragma unroll
      for (int o = 1; o < 64; o <<= 1) { const float v = __shfl_up(bc, o); if (lane >= o) bc += v; }
      const float a = gi - bc;
      float cm = a;
#pragma unroll
      for (int o = 1; o < 64; o <<= 1) { const float v = __shfl_up(cm, o); if (lane >= o) cm = fmaxf(cm, v); }
      const float mxv = fmaxf(m_prev, cm);
      const float m_t = bc + mxv;
      const float mx_end = __shfl(mxv, 63), bc_end = __shfl(bc, 63);
      const float wend = __expf(a - mx_end);
      g_end_cur = __expf(m_prev - mx_end);
      if (hw == 0) {
        float* sc = scb + par * S_PAR;
        sc[S_MX + lane] = __expf(mx_end - mxv);
        sc[S_G + lane] = __expf(m_prev - mxv);
        sc[S_EMT + lane] = __expf(-m_t);
        if (lane == 0) sc[S_GEND] = g_end_cur;
      }
      m_prev = bc_end + mx_end;
      return wend;
    };
    auto stage_lds = [&](float wend_l, int tid) {
      const int ht = tid - 256;
#pragma unroll
      for (int i = 0; i < 8; ++i) {
        const int cidx = ht + 256 * i, t = cidx >> 5, pc = cidx & 31;
        const float we = __shfl(wend_l, t);
        float f[8]; unpack8(pk[i], f);
        u32x4 o; o[0] = pk2(f[0] * we, f[1] * we); o[1] = pk2(f[2] * we, f[3] * we); o[2] = pk2(f[4] * we, f[5] * we); o[3] = pk2(f[6] * we, f[7] * we);
        *(u32x4*)(lds + L_Q + t * L_LD + pc * 16) = pq[i];
        *(u32x4*)(lds + L_K + t * L_LD + pc * 16) = o;
      }
#pragma unroll
      for (int i = 0; i < 4; ++i) {
        const int cidx = ht + 256 * i, t = cidx >> 4, pc = cidx & 15;
        *(u32x4*)(lds + L_V + t * L_VLD + pc * 16) = pv[i];
      }
    };
    {
      int tid = tid0; asm volatile("" : "+v"(tid));
      issue_loads(0, tid);
      scb[S_NV + (tid - 256)] = nreg;
      const float wend = scalars(0, tid & 63);
      stage_lds(wend, tid);
    }
    for (int c = 0; c < nchunks; ++c) {
      int tid = tid0; asm volatile("" : "+v"(tid));
      const int ht = tid - 256, lane = tid & 63, r = lane & 31, h = lane >> 5;
      float* sc = scb + (c & 1) * S_PAR;
      float* scn = scb + ((c + 1) & 1) * S_PAR;
      const float g_end_c = g_end_cur;
      WG_BAR();
      const bool more = c + 1 < nchunks;
      if (more) issue_loads(c + 1, tid);
      {
        const int t = ht & 63, part = ht >> 6;
        const char* qp = lds + L_Q + t * L_LD + part * 128;
        float s = 0.f;
#pragma unroll
        for (int e = 0; e < 8; ++e) {
          const u32x4 qq = *(const u32x4*)(qp + e * 16); float f[8]; unpack8(qq, f);
#pragma unroll
          for (int z = 0; z < 8; ++z) s += f[z] * sc[S_NV + part * 64 + e * 8 + z];
        }
        sc[S_QN + part * 64 + t] = s;
      }
      if (hw < 3) {
        const int stl = hw == 2 ? 1 : 0, tt = hw == 0 ? 0 : 1;
        f32x16 S, S2;
#pragma unroll
        for (int i = 0; i < 16; ++i) { S[i] = 0.f; S2[i] = 0.f; }
        const char* ka = lds + L_K + (stl * 32 + r) * L_LD + h * 16;
        const char* qa = lds + L_Q + (tt * 32 + r) * L_LD + h * 16;
#pragma unroll 4
        for (int ks = 0; ks < 16; ks += 2) {
          S = MFMA32(*(const bf16x8*)(ka + ks * 32), *(const bf16x8*)(qa + ks * 32), S);
          S2 = MFMA32(*(const bf16x8*)(ka + ks * 32 + 32), *(const bf16x8*)(qa + ks * 32 + 32), S2);
        }
        const int t = tt * 32 + r;
        const float cw = sc[S_MX + t];
        float rs = 0.f;
#pragma unroll
        for (int g = 0; g < 4; ++g) {
          float wv[4];
#pragma unroll
          for (int e = 0; e < 4; ++e) {
            const int s = stl * 32 + 8 * g + 4 * h + e;
            wv[e] = s <= t ? (S[4 * g + e] + S2[4 * g + e]) * cw : 0.f; rs += wv[e];
          }
          u32x2 o; o[0] = pk2(wv[0], wv[1]); o[1] = pk2(wv[2], wv[3]);
          *(u32x2*)(lds + L_SW + t * L_SWLD + (stl * 32 + 8 * g + 4 * h) * 2) = o;
        }
        rs += __shfl_xor(rs, 32);
        if (h == 0) {
          if (hw == 0) { sc[S_DS0 + t] = rs; sc[S_DS1 + t] = 0.f; }
          else if (hw == 1) sc[S_DS0 + t] = rs;
          else sc[S_DS1 + t] = rs;
        }
      } else {
        const int t = lane >> 1, hs = lane & 1;
        u32x4 z; z[0] = 0; z[1] = 0; z[2] = 0; z[3] = 0;
        *(u32x4*)(lds + L_SW + t * L_SWLD + 64 + hs * 32) = z; *(u32x4*)(lds + L_SW + t * L_SWLD + 64 + hs * 32 + 16) = z;
      }
      {
        float s0 = 0.f, s1 = 0.f, s2 = 0.f, s3 = 0.f;
        const char* kp = lds + L_K + ht * 2;
#pragma unroll
        for (int t = 0; t < 64; t += 4) {
          s0 += bflo((unsigned)*(const bf16_t*)(kp + t * L_LD)); s1 += bflo((unsigned)*(const bf16_t*)(kp + (t + 1) * L_LD));
          s2 += bflo((unsigned)*(const bf16_t*)(kp + (t + 2) * L_LD)); s3 += bflo((unsigned)*(const bf16_t*)(kp + (t + 3) * L_LD));
        }
        nreg = g_end_c * nreg + ((s0 + s1) + (s2 + s3));
        scn[S_NV + ht] = nreg;
      }
      float wend = 0.f;
      if (more) wend = scalars((c + 1) & 1, lane);
      WG_BAR();
      if (more) stage_lds(wend, tid);
    }
    WG_BAR();
    if (half == 0) {
      p.out[(KIND == 0 ? O_NP : O_NS) + bh * 256 + (tid0 - 256)] = nreg;
      if (tid0 == 256) p.out[(KIND == 0 ? O_MPP : O_MSS) + bh] = m_prev;
    }
  }
}

DI void mixer_phase(const Params& p, int l, char* lds, int cidx, bool ml_only) {
  unsigned* ctr = (unsigned*)(p.ws + W_MISC) + 16 + cidx;
  int* s_item = (int*)(lds + LDS_BYTES - 16);
  const int total = 32 + 64 + 64 + 2048;
  for (;;) {
    __syncthreads();
    if (threadIdx.x == 0) *s_item = (int)atomicAdd(ctr, 1u);
    __syncthreads();
    const int it = *s_item;
    __syncthreads();
    if (it >= total) break;
    if (ml_only && it >= 96) break;
    if (it < 32) { mlstm_item<0>(p, l, it >> 3, (it >> 1) & 3, it & 1, lds); continue; }
    if (it < 96) { const int x = it - 32; mlstm_item<1>(p, l, x >> 3, (x >> 1) & 3, x & 1, lds); continue; }
    if (it < 160) { attn_item<1>(p, l, (it - 96) >> 3, (it - 96) & 7, 0, lds); continue; }
    { const int x = it - 160; attn_item<0>(p, l, (x & 31) >> 3, x & 7, 63 - (x >> 5), lds); }
  }
}

DI void merge_phase(const Params& p, int l) {
  const bf16_t* Z = (const bf16_t*)(p.ws + W_Z); const bf16_t* H = (const bf16_t*)(p.ws + W_H); bf16_t* Y = (bf16_t*)(p.ws + W_AB);
  const int tidq = otid(); const int lane = tidq & 63, gw = blockIdx.x * 8 + (tidq >> 6), ngw = gridDim.x * 8;
  const int col = lane * 16;
  float mg[16];
  { const float* mhg = p.in[15] + (size_t)l * D + col;
#pragma unroll
    for (int i = 0; i < 4; ++i) { const f32x4 g = *(const f32x4*)(mhg + 4 * i); mg[4 * i] = g[0]; mg[4 * i + 1] = g[1]; mg[4 * i + 2] = g[2]; mg[4 * i + 3] = g[3]; } }
  for (int row0 = gw; row0 < M; row0 += 2 * ngw) {
    const int row1 = row0 + ngw; const bool has1 = row1 < M;
    u32x4 in[2][10];
#pragma unroll
    for (int q = 0; q < 2; ++q) {
      const size_t row = (size_t)(q == 0 ? row0 : (has1 ? row1 : row0));
      const bf16_t* z = Z + row * NIN + col; const bf16_t* hp = H + row * D + col;
      in[q][0] = *(const u32x4*)hp; in[q][1] = *(const u32x4*)(hp + 8);
#pragma unroll
      for (int hh = 0; hh < 2; ++hh) {
        in[q][2 + hh * 4] = *(const u32x4*)(z + 3072 + hh * 8); in[q][3 + hh * 4] = *(const u32x4*)(z + 6144 + hh * 8);
        in[q][4 + hh * 4] = *(const u32x4*)(z + 7168 + hh * 8); in[q][5 + hh * 4] = *(const u32x4*)(z + 8192 + hh * 8);
      }
    }
#pragma unroll
    for (int q = 0; q < 2; ++q) {
      if (q == 1 && !has1) break;
      const size_t row = (size_t)(q == 0 ? row0 : row1);
      float hv[16];
      unpack8(in[q][0], hv); unpack8(in[q][1], hv + 8);
      float s = 0.f;
#pragma unroll
      for (int e = 0; e < 16; ++e) s += hv[e];
#pragma unroll
      for (int o = 1; o < 16; o <<= 1) s += __shfl_xor(s, o);
      const float mean = s * (1.f / 256.f);
      float s2 = 0.f;
#pragma unroll
      for (int e = 0; e < 16; ++e) { hv[e] -= mean; s2 += hv[e] * hv[e]; }
#pragma unroll
      for (int o = 1; o < 16; o <<= 1) s2 += __shfl_xor(s2, o);
      const float rstd = rsqrtf(s2 * (1.f / 256.f) + LN_EPS);
      u32x4 out[2];
#pragma unroll
      for (int hh = 0; hh < 2; ++hh) {
        float oa[8], om[8], ga[8], gb[8];
        unpack8(in[q][2 + hh * 4], oa); unpack8(in[q][3 + hh * 4], om); unpack8(in[q][4 + hh * 4], ga); unpack8(in[q][5 + hh * 4], gb);
        float y[8];
#pragma unroll
        for (int e = 0; e < 8; ++e) {
          const float hn = hv[hh * 8 + e] * rstd * mg[hh * 8 + e];
          y[e] = sigmoidf_(ga[e]) * oa[e] + sigmoidf_(gb[e]) * (hn * sigmoidf_(om[e]));
        }
        out[hh][0] = pk2(y[0], y[1]); out[hh][1] = pk2(y[2], y[3]); out[hh][2] = pk2(y[4], y[5]); out[hh][3] = pk2(y[6], y[7]);
      }
      *(u32x4*)(Y + row * D + col) = out[0]; *(u32x4*)(Y + row * D + col + 8) = out[1];
    }
  }
}

DI void ln_phase(const Params& p, const float* g, const float* bta, bool final_out) {
  const int tidq = otid(); const int lane = tidq & 63, gw = blockIdx.x * 8 + (tidq >> 6), ngw = gridDim.x * 8;
  float* R = (float*)(p.ws + W_R); bf16_t* AB = (bf16_t*)(p.ws + W_AB);
  f32x4 gq[4], bq[4];
#pragma unroll
  for (int j = 0; j < 4; ++j) { gq[j] = *(const f32x4*)(g + j * 256 + lane * 4); bq[j] = *(const f32x4*)(bta + j * 256 + lane * 4); }
  for (int row0 = gw; row0 < M; row0 += 2 * ngw) {
    f32x4 v[2][4]; float s[2] = {0.f, 0.f};
    const int row1 = row0 + ngw; const bool has1 = row1 < M;
#pragma unroll
    for (int q = 0; q < 2; ++q) {
      const float* xr = R + (size_t)(q == 0 ? row0 : (has1 ? row1 : row0)) * D;
#pragma unroll
      for (int j = 0; j < 4; ++j) { v[q][j] = *(const f32x4*)(xr + j * 256 + lane * 4); s[q] += (v[q][j][0] + v[q][j][1]) + (v[q][j][2] + v[q][j][3]); }
    }
#pragma unroll
    for (int q = 0; q < 2; ++q) {
      if (q == 1 && !has1) break;
      const int row = q == 0 ? row0 : row1;
      const float mean = wave_sum(s[q]) * (1.f / D);
      float s2 = 0.f;
#pragma unroll
      for (int j = 0; j < 4; ++j) { v[q][j] = v[q][j] - mean; s2 += (v[q][j][0] * v[q][j][0] + v[q][j][1] * v[q][j][1]) + (v[q][j][2] * v[q][j][2] + v[q][j][3] * v[q][j][3]); }
      const float rstd = rsqrtf(wave_sum(s2) * (1.f / D) + LN_EPS);
      float* dst = final_out ? (row < MP ? p.out + O_YP + (size_t)row * D : p.out + O_YS + (size_t)(row - MP) * D) : R + (size_t)row * D;
#pragma unroll
      for (int j = 0; j < 4; ++j) {
        const int c = j * 256 + lane * 4;
        const f32x4 o = v[q][j] * rstd * gq[j] + bq[j];
        *(f32x4*)(dst + c) = o;
        if (!final_out) { u32x2 ob; ob[0] = pk2(o[0], o[1]); ob[1] = pk2(o[2], o[3]); *(u32x2*)(AB + (size_t)row * D + c) = ob; }
      }
    }
  }
}

DI float gelu_f(float v) {
  const float av = fabsf(v), d = av * 0.2316418882f + 1.0f;
  const float t = __builtin_amdgcn_rcpf(d);
  float q = t * 0.5307027145f + (-0.7265760135f); q = q * t + 0.7107068705f; q = q * t + (-0.142248368f); q = q * t + 0.127414796f; q = q * t;
  const float e = __builtin_amdgcn_exp2f((v * v) * (-0.72134752044f));
  const float m = v * (q * e), r = v - m;
  return v < 0.f ? m : r;
}
DI void ffnconv_phase(const Params& p, int l) {
  const bf16_t* U = (const bf16_t*)(p.ws + W_Z); bf16_t* HF = (bf16_t*)(p.ws + W_Z + (size_t)M * NUP * 2);
  const float* cw = p.in[20] + (size_t)l * 3 * NUP; const float* cb = p.in[21] + (size_t)l * NUP;
  constexpr int RG = 8;
  const unsigned gtid = blockIdx.x * NTH + (unsigned)otid();
  const unsigned nlan = gridDim.x * NTH / 352u;
  const unsigned r0 = gtid / 352u, cc = gtid - r0 * 352u;
  if (r0 >= nlan) return;
  const int col = (int)cc * 8;
  f32x4 wv[2][3][2], bv[2][2];
#pragma unroll
  for (int hf = 0; hf < 2; ++hf) {
    const int c2 = col + hf * DFF;
#pragma unroll
    for (int j = 0; j < 3; ++j) { wv[hf][j][0] = *(const f32x4*)(cw + j * NUP + c2); wv[hf][j][1] = *(const f32x4*)(cw + j * NUP + c2 + 4); }
    bv[hf][0] = *(const f32x4*)(cb + c2); bv[hf][1] = *(const f32x4*)(cb + c2 + 4);
  }
  for (unsigned rg = r0; rg < (unsigned)(M / RG); rg += nlan) {
    const int row0 = (int)rg * RG;
    int t0; const float* st = nullptr;
    if (row0 < MP) t0 = row0 & (SEQ - 1); else { t0 = (row0 - MP) & 15; st = p.in[8] + ((size_t)(l * 8 + ((row0 - MP) >> 4)) * 2) * NUP; }
    float gl[RG][8];
#pragma unroll
    for (int hf = 0; hf < 2; ++hf) {
      const int c2 = col + hf * DFF;
      float x[RG + 2][8];
#pragma unroll
      for (int j = 0; j < RG + 2; ++j) {
        const int t = t0 - 2 + j;
        if (t >= 0) unpack8(*(const u32x4*)(U + (size_t)(row0 - 2 + j) * NUP + c2), x[j]);
        else if (st) { const float* sp = st + (size_t)(2 + t) * NUP + c2; const f32x4 a = *(const f32x4*)sp, b2 = *(const f32x4*)(sp + 4);
          x[j][0] = a[0]; x[j][1] = a[1]; x[j][2] = a[2]; x[j][3] = a[3]; x[j][4] = b2[0]; x[j][5] = b2[1]; x[j][6] = b2[2]; x[j][7] = b2[3]; }
        else {
#pragma unroll
          for (int e = 0; e < 8; ++e) x[j][e] = 0.f; }
      }
#pragma unroll
      for (int a = 0; a < RG; ++a) {
        float o[8];
#pragma unroll
        for (int e = 0; e < 8; ++e) {
          const float u = bv[hf][e >> 2][e & 3] + wv[hf][0][e >> 2][e & 3] * x[a][e] + wv[hf][1][e >> 2][e & 3] * x[a + 1][e] + wv[hf][2][e >> 2][e & 3] * x[a + 2][e];
          if (hf == 0) gl[a][e] = gelu_f(u); else o[e] = gl[a][e] * u;
        }
        if (hf == 1) {
          u32x4 ov; ov[0] = pk2(o[0], o[1]); ov[1] = pk2(o[2], o[3]); ov[2] = pk2(o[4], o[5]); ov[3] = pk2(o[6], o[7]);
          *(u32x4*)(HF + (size_t)(row0 + a) * DFF + col) = ov;
        }
      }
    }
  }
}

#define XB_TMO      128
#define XB_XCNT(j)  (256  + 64 * (j))
#define XB_XSUB(j)  (1280 + 64 * (j))
#define XB_XGEN(j)  (2304 + 64 * (j))
#define XB_TOP      3328
#define XB_TOPGEN   3392
#define XCD_BAR_WORDS 3456
#define XB_SPIN_CAP (1u << 18)
#define XLAS __attribute__((address_space(3)))
DI unsigned xb_ld(unsigned* p)              { return __hip_atomic_load(p, __ATOMIC_RELAXED, __HIP_MEMORY_SCOPE_AGENT); }
DI unsigned xb_add(unsigned* p, unsigned v) { return __hip_atomic_fetch_add(p, v, __ATOMIC_RELAXED, __HIP_MEMORY_SCOPE_AGENT); }
DI unsigned xb_xcc_id() { return (unsigned)__builtin_amdgcn_s_getreg((3 << 11) | 20) & 0xFu; }
#define XB_SPIN(cond, bar) do { unsigned _sp = 0; while (cond) { __builtin_amdgcn_s_sleep(1); \
    if ((++_sp & 255u) == 0u) { if (xb_ld(&(bar)[XB_TMO])) break; if (_sp > XB_SPIN_CAP) { atomicAdd(&(bar)[XB_TMO], 1u); break; } } } } while (0)
struct XcdBarrier { unsigned* bar; unsigned x; volatile XLAS unsigned* st; };
DI XcdBarrier xcd_barrier_post(unsigned* bar, volatile XLAS unsigned* st) {
  XcdBarrier b; b.bar = bar; b.x = xb_xcc_id(); b.st = st;
  if (threadIdx.x == 0) (void)xb_add(&bar[XB_XCNT(b.x)], 1u);
  return b;
}
DI void xcd_barrier_complete(unsigned* bar, unsigned x, unsigned& nloc, unsigned& nx) {
  const unsigned G = gridDim.x * gridDim.y * gridDim.z;
  unsigned sum, cnt, mine, sp = 0u;
  for (;;) {
    sum = 0u; cnt = 0u; mine = 0u;
#pragma unroll
    for (unsigned j = 0; j < 16; ++j) { const unsigned c = xb_ld(&bar[XB_XCNT(j)]); sum += c; cnt += (c > 0u) ? 1u : 0u; mine = (j == x) ? c : mine; }
    if (sum == G) break;
    __builtin_amdgcn_s_sleep(1);
    if ((++sp & 255u) == 0u) { if (xb_ld(&bar[XB_TMO])) break; if (sp > XB_SPIN_CAP) { atomicAdd(&bar[XB_TMO], 1u); break; } }
  }
  nloc = mine > 0u ? mine : 1u; nx = cnt > 0u ? cnt : 1u;
}
DI void xcd_barrier(const XcdBarrier& b) {
  asm volatile("s_waitcnt vmcnt(0)" ::: "memory");
  __syncthreads();
  if (threadIdx.x == 0) {
    unsigned* bar = b.bar;
    __builtin_amdgcn_s_waitcnt(0);
    unsigned nloc = b.st[0], nx = b.st[1];
    if (nloc == 0u) { xcd_barrier_complete(bar, b.x, nloc, nx); b.st[0] = nloc; b.st[1] = nx; }
    const unsigned old = xb_add(&bar[XB_XSUB(b.x)], 1u);
    const unsigned gen = old / nloc;
    if (old + 1u == (gen + 1u) * nloc) {
      __builtin_amdgcn_fence(__ATOMIC_RELEASE, "agent");
      asm volatile("s_waitcnt vmcnt(0)" ::: "memory");
      const unsigned og = xb_add(&bar[XB_TOP], 1u);
      const unsigned tg = og / nx;
      if (og + 1u == (tg + 1u) * nx) xb_add(&bar[XB_TOPGEN], 1u);
      else XB_SPIN(xb_ld(&bar[XB_TOPGEN]) == tg, bar);
      __builtin_amdgcn_fence(__ATOMIC_ACQUIRE, "agent");
      xb_add(&bar[XB_XGEN(b.x)], 1u);
      asm volatile("s_waitcnt vmcnt(0)" ::: "memory");
    } else {
      XB_SPIN(xb_ld(&bar[XB_XGEN(b.x)]) == gen, bar);
      __builtin_amdgcn_fence(__ATOMIC_ACQUIRE, "agent");
      asm volatile("s_waitcnt vmcnt(0)" ::: "memory");
    }
  }
  __syncthreads();
}

constexpr int NPH = 21;
DI void run_phase(const Params& p, int ph, char* lds) {
#ifndef ONLY
  if (ph == 0) { phase0(p, lds); return; }
#else
  if (ph == 0) return;
#endif
  const int l = (ph - 1) / 10, s = (ph - 1) % 10;
#ifdef ONLY
  if (s != ONLY) return;
#endif
  switch (s) {
    case 0: gemm_phase<EPI_IN>(p, l, (const bf16_t*)(p.ws + W_AB), D, (const bf16_t*)(p.ws + W_WIN) + (size_t)l * NIN * D, D, NIN / 256, lds); break;
    case 1: qkconv_phase(p, l); gif_phase(p, l, lds, 0); break;
    case 2: mixer_phase(p, l, lds, l, false); break;
    case 3: merge_phase(p, l); break;
    case 4: gemm_phase<EPI_OUT>(p, l, (const bf16_t*)(p.ws + W_AB), D, (const bf16_t*)(p.ws + W_WOUT) + (size_t)l * D * D, D, D / 256, lds); break;
    case 5: ln_phase(p, p.in[17] + l * D, p.in[18] + l * D, false); break;
    case 6: gemm_phase<EPI_UP>(p, l, (const bf16_t*)(p.ws + W_AB), D, (const bf16_t*)(p.ws + W_WUP) + (size_t)l * NUP * D, D, NUP / 256, lds); break;
    case 7: ffnconv_phase(p, l); break;
    case 8: gemm_phase<EPI_DOWN>(p, l, (const bf16_t*)(p.ws + W_Z + (size_t)M * NUP * 2), DFF, (const bf16_t*)(p.ws + W_WDN) + (size_t)l * D * DFF, DFF, D / 256, lds); break;
    case 9: ln_phase(p, p.in[23] + l * D, p.in[24] + l * D, l == 1); break;
  }
}

__global__ void __launch_bounds__(NTH) mega(Params p, int ph_lo, int ph_hi) {
  extern __shared__ __attribute__((aligned(16))) char lds[];
#if MULTI_LAUNCH
  for (int ph = ph_lo; ph < ph_hi; ++ph) run_phase(p, ph, lds);
#else
  cg::grid_group grid = cg::this_grid();
  phase0(p, lds);
  grid.sync();
  volatile XLAS unsigned* xst = (volatile XLAS unsigned*)((XLAS char*)lds + (LDS_BYTES - 32));
  if (threadIdx.x == 0) { xst[0] = 0u; xst[1] = 0u; }
  __syncthreads();
  const XcdBarrier xb = xcd_barrier_post((unsigned*)(p.ws + W_BAR), xst);
#define GSYNC() xcd_barrier(xb)
  for (int l = 0; l < 2; ++l) {
    gemm_phase<EPI_IN>(p, l, (const bf16_t*)(p.ws + W_AB), D, (const bf16_t*)(p.ws + W_WIN) + (size_t)l * NIN * D, D, NIN / 256, lds);
    {
      const int nun = NTM * (NIN / 256), G = (int)gridDim.x;
      const int busy = nun % G;
      gif_phase(p, l, lds, (busy > 0 && busy * 2 < G) ? busy : 0);
    }
    GSYNC();
#ifdef PROBE_GIN2
    gemm_phase<EPI_IN>(p, l, (const bf16_t*)(p.ws + W_AB), D, (const bf16_t*)(p.ws + W_WIN) + (size_t)l * NIN * D, D, NIN / 256, lds);
    GSYNC();
#endif
    qkconv_phase(p, l);
    GSYNC();
#if defined(PROBE_EW2) || defined(PROBE_QKC2)
    qkconv_phase(p, l);
    GSYNC();
#endif
    mixer_phase(p, l, lds, l, false);
    GSYNC();
#ifdef PROBE_ML2
    mixer_phase(p, l, lds, l + 2, true);
    GSYNC();
#endif
#ifdef PROBE_MIX2
    mixer_phase(p, l, lds, l + 2, false);
    GSYNC();
#endif
    merge_phase(p, l);
    GSYNC();
#ifdef PROBE_SYNC
    for (int q = 0; q < 20; ++q) GSYNC();
#endif
#if defined(PROBE_EW2) || defined(PROBE_MRG2)
    merge_phase(p, l);
    GSYNC();
#endif
    gemm_phase<EPI_OUT>(p, l, (const bf16_t*)(p.ws + W_AB), D, (const bf16_t*)(p.ws + W_WOUT) + (size_t)l * D * D, D, D / 256, lds);
    GSYNC();
    ln_phase(p, p.in[17] + l * D, p.in[18] + l * D, false);
    GSYNC();
    gemm_phase<EPI_UP>(p, l, (const bf16_t*)(p.ws + W_AB), D, (const bf16_t*)(p.ws + W_WUP) + (size_t)l * NUP * D, D, NUP / 256, lds);
    GSYNC();
    ffnconv_phase(p, l);
    GSYNC();
#if defined(PROBE_EW2) || defined(PROBE_FFC2)
    ffnconv_phase(p, l);
    GSYNC();
#endif
    gemm_phase<EPI_DOWN>(p, l, (const bf16_t*)(p.ws + W_Z + (size_t)M * NUP * 2), DFF, (const bf16_t*)(p.ws + W_WDN) + (size_t)l * D * DFF, DFF, D / 256, lds);
    GSYNC();
    ln_phase(p, p.in[23] + l * D, p.in[24] + l * D, l == 1);
    if (l == 0) GSYNC();
  }
#endif
}

extern "C" void kernel_launch(void* const* d_in, const int* in_sizes, int n_in, void* d_out, int out_size, void* d_ws, size_t ws_size, hipStream_t stream) {
  static int grid = 0;
  if (grid == 0) {
    if (n_in != 25 || (size_t)out_size != O_END || ws_size < W_END) { fprintf(stderr, "kernel_launch: unexpected sizes n_in %d out %d (want %zu) ws %zu (want %zu)\n", n_in, out_size, (size_t)O_END, ws_size, (size_t)W_END); grid = -1; return; }
    int dev = 0, cus = 0, per_cu = 0;
    hipGetDevice(&dev);
    hipDeviceGetAttribute(&cus, hipDeviceAttributeMultiprocessorCount, dev);
    if (hipFuncSetAttribute((const void*)mega, hipFuncAttributeMaxDynamicSharedMemorySize, LDS_BYTES) != hipSuccess) { fprintf(stderr, "hipFuncSetAttribute failed\n"); grid = -1; return; }
    hipOccupancyMaxActiveBlocksPerMultiprocessor(&per_cu, (const void*)mega, NTH, LDS_BYTES);
    if (per_cu < 1) per_cu = 1;
    grid = cus * 1;
    (void)hipGetLastError();
  }
  if (grid < 0) return;
  Params p{};
  for (int i = 0; i < 25; ++i) p.in[i] = (const float*)d_in[i];
  p.out = (float*)d_out; p.ws = (unsigned char*)d_ws;
#if MULTI_LAUNCH
  for (int ph = 0; ph < NPH; ++ph) hipLaunchKernelGGL(mega, dim3(grid), dim3(NTH), LDS_BYTES, stream, p, ph, ph + 1);
#else
  int lo = 0, hi = NPH;
  void* args[] = {&p, &lo, &hi};
  hipError_t e = hipLaunchCooperativeKernel((const void*)mega, dim3(grid), dim3(NTH), args, LDS_BYTES, stream);
  if (e != hipSuccess) fprintf(stderr, "cooperative launch failed: %s (grid %d)\n", hipGetErrorString(e), grid);
#endif
}
```

```cpp
#include <hip/hip_runtime.h>
#include <hip/hip_cooperative_groups.h>
#include <cstdio>
namespace cg = cooperative_groups;

#ifndef MULTI_LAUNCH
#define MULTI_LAUNCH 0
#endif

typedef unsigned short bf16_t;
typedef short bf16x8 __attribute__((ext_vector_type(8)));
typedef short s16x4 __attribute__((ext_vector_type(4)));
typedef float f32x16 __attribute__((ext_vector_type(16)));
typedef float f32x4 __attribute__((ext_vector_type(4)));
typedef unsigned u32x4 __attribute__((ext_vector_type(4)));
typedef unsigned u32x2 __attribute__((ext_vector_type(2)));
#define DI __device__ __forceinline__
#define MFMA32(a, b, c) __builtin_amdgcn_mfma_f32_32x32x16_bf16((a), (b), (c), 0, 0, 0)

constexpr int NTH = 512;
constexpr int D = 1024, SEQ = 8192, NB = 4, MP = NB * SEQ, MS = 128, M = MP + MS, NTM = 129;
constexpr int DIN = 9224, NIN = 9216, DFF = 2816, NUP = 5632;
constexpr int PAST = 4096, NKS = PAST + 16;
constexpr float ALPHA = 1.4142135623730951f;
constexpr float LN_EPS = 1e-5f;
constexpr float LOG2E = 1.4426950408889634f;

constexpr size_t O_YP = 0;
constexpr size_t O_YS = O_YP + (size_t)MP * D;
constexpr size_t O_KP = O_YS + (size_t)MS * D;
constexpr size_t O_VP = O_KP + (size_t)2 * MP * 1024;
constexpr size_t O_MCP = O_VP + (size_t)2 * MP * 1024;
constexpr size_t O_CP = O_MCP + (size_t)2 * 4 * 3 * 2048;
constexpr size_t O_NP = O_CP + (size_t)2 * 4 * 4 * 65536;
constexpr size_t O_MPP = O_NP + (size_t)2 * 4 * 4 * 256;
constexpr size_t O_FCP = O_MPP + 32;
constexpr size_t O_KS = O_FCP + (size_t)2 * 4 * 2 * NUP;
constexpr size_t O_VS = O_KS + (size_t)2 * MS * 1024;
constexpr size_t O_MCS = O_VS + (size_t)2 * MS * 1024;
constexpr size_t O_CS = O_MCS + (size_t)2 * 8 * 3 * 2048;
constexpr size_t O_NS = O_CS + (size_t)2 * 8 * 4 * 65536;
constexpr size_t O_MSS = O_NS + (size_t)2 * 8 * 4 * 256;
constexpr size_t O_FCS = O_MSS + 64;
constexpr size_t O_END = O_FCS + (size_t)2 * 8 * 2 * NUP;

constexpr size_t W_Z = 0;
constexpr size_t W_H = W_Z + (size_t)M * NIN * 2;
constexpr size_t W_AB = W_H + (size_t)M * D * 2;
constexpr size_t W_KA = W_AB + (size_t)M * D * 2;
constexpr size_t W_R = W_KA + (size_t)M * D * 2;
constexpr size_t W_WIN = W_R + (size_t)M * D * 4;
constexpr size_t W_WOUT = W_WIN + (size_t)2 * NIN * D * 2;
constexpr size_t W_WUP = W_WOUT + (size_t)2 * D * D * 2;
constexpr size_t W_WDN = W_WUP + (size_t)2 * NUP * D * 2;
constexpr size_t W_GIF = W_WDN + (size_t)2 * D * DFF * 2;
constexpr size_t W_ROPE = W_GIF + (size_t)M * 8 * 4;
constexpr size_t W_MISC = W_ROPE + (size_t)8192 * 32 * 8;
constexpr size_t W_BAR = W_MISC + 4096;
constexpr size_t W_END = W_BAR + 16384;

struct Params {
  const float* in[25];
  float* out;
  unsigned char* ws;
};

DI unsigned f2bf(float x) { unsigned u = __float_as_uint(x); u += 0x7fffu + ((u >> 16) & 1u); return u >> 16; }
typedef __bf16 bf16v2 __attribute__((ext_vector_type(2)));
typedef float f32x2 __attribute__((ext_vector_type(2)));
DI unsigned pk2(float a, float b) { f32x2 v; v[0] = a; v[1] = b; return __builtin_bit_cast(unsigned, __builtin_convertvector(v, bf16v2)); }
DI float bflo(unsigned u) { return __uint_as_float(u << 16); }
DI float bfhi(unsigned u) { return __uint_as_float(u & 0xffff0000u); }
DI float sigmoidf_(float x) { return __builtin_amdgcn_rcpf(1.f + __builtin_amdgcn_exp2f(-1.4426950408889634f * x)); }
DI float wave_sum(float v) {
#pragma unroll
  for (int o = 1; o < 64; o <<= 1) v += __shfl_xor(v, o);
  return v;
}
DI int crow(int i, int h) { return (i & 3) + 8 * (i >> 2) + 4 * h; }
DI bf16x8 pack8(const f32x16& x, int s) {
  u32x4 p;
  p[0] = pk2(x[8 * s + 0], x[8 * s + 1]); p[1] = pk2(x[8 * s + 2], x[8 * s + 3]);
  p[2] = pk2(x[8 * s + 4], x[8 * s + 5]); p[3] = pk2(x[8 * s + 6], x[8 * s + 7]);
  return __builtin_bit_cast(bf16x8, p);
}
DI void unpack8(u32x4 v, float* f) {
  f[0] = bflo(v[0]); f[1] = bfhi(v[0]); f[2] = bflo(v[1]); f[3] = bfhi(v[1]);
  f[4] = bflo(v[2]); f[5] = bfhi(v[2]); f[6] = bflo(v[3]); f[7] = bfhi(v[3]);
}
typedef __attribute__((address_space(3))) s16x4 lds_s16x4;
DI bf16x8 tr_frag(unsigned a_lo, unsigned a_hi) {
  const s16x4 lo = __builtin_amdgcn_ds_read_tr16_b64_v4i16((lds_s16x4*)(size_t)a_lo);
  const s16x4 hi = __builtin_amdgcn_ds_read_tr16_b64_v4i16((lds_s16x4*)(size_t)a_hi);
  return __builtin_shufflevector(lo, hi, 0, 1, 2, 3, 4, 5, 6, 7);
}
template <int STEP, int HIOFF>
DI void tr_frag4(unsigned a, bf16x8 (&f)[4]) {
#pragma unroll
  for (int i = 0; i < 4; ++i) f[i] = tr_frag(a + i * STEP, a + i * STEP + HIOFF);
}
DI int otid() { int t = threadIdx.x; asm volatile("" : "+v"(t)); return t; }
DI int uni(int v) { return __builtin_amdgcn_readfirstlane(v); }
DI unsigned lds_addr(const void* p) { return (unsigned)(size_t)p; }

DI const float* xrow_ptr(const Params& p, int l, int row) {
  if (l == 0) return row < MP ? p.in[0] + (size_t)row * D : p.in[1] + (size_t)(row - MP) * D;
  return (const float*)(p.ws + W_R) + (size_t)row * D;
}

DI void transpose_w(const float* W, int K, int N, int src_ld, bf16_t* WT, bool remap, char* lds) {
  float* scr = (float*)lds;
  const int nkb = K / 64, nnb = N / 64, tid = otid();
  for (int it = blockIdx.x; it < nkb * nnb; it += gridDim.x) {
    const int kb = it / nnb, nb = it % nnb, k0 = kb * 64, n0 = nb * 64;
    const int ns = (remap && n0 >= 7168) ? n0 + 8 : n0;
#pragma unroll
    for (int i = 0; i < 8; ++i) {
      const int kk = (tid >> 6) + 8 * i, nn = tid & 63;
      scr[kk * 65 + nn] = W[(size_t)(k0 + kk) * src_ld + ns + nn];
    }
    __syncthreads();
    {
      const int n = tid >> 3, c = tid & 7;
      const float* s = scr + (8 * c) * 65 + n;
      u32x4 o;
      o[0] = pk2(s[0], s[65]); o[1] = pk2(s[2 * 65], s[3 * 65]); o[2] = pk2(s[4 * 65], s[5 * 65]); o[3] = pk2(s[6 * 65], s[7 * 65]);
      const int nd = (remap && n0 < 2048) ? ((n < 32) ? 2 * n : 2 * (n - 32) + 1) : n;
      *(u32x4*)(WT + (size_t)(n0 + nd) * K + k0 + 8 * c) = o;
    }
    __syncthreads();
  }
}

DI void phase0(const Params& p, char* lds) {
  const int tid = otid();
  for (int l = 0; l < 2; ++l) {
    transpose_w(p.in[9] + (size_t)l * D * DIN, D, NIN, DIN, (bf16_t*)(p.ws + W_WIN) + (size_t)l * NIN * D, true, lds);
    transpose_w(p.in[16] + (size_t)l * D * D, D, D, D, (bf16_t*)(p.ws + W_WOUT) + (size_t)l * D * D, false, lds);
    transpose_w(p.in[19] + (size_t)l * D * NUP, D, NUP, NUP, (bf16_t*)(p.ws + W_WUP) + (size_t)l * NUP * D, false, lds);
    transpose_w(p.in[22] + (size_t)l * DFF * D, DFF, D, D, (bf16_t*)(p.ws + W_WDN) + (size_t)l * D * DFF, false, lds);
  }
  bf16_t* ab = (bf16_t*)(p.ws + W_AB);
  {
    const unsigned total = (unsigned)M * 128u, S = gridDim.x * NTH;
    for (unsigned c0 = blockIdx.x * NTH + (unsigned)tid; c0 < total; c0 += 4u * S) {
      f32x4 a[4], b4[4];
#pragma unroll
      for (int u = 0; u < 4; ++u) {
        const unsigned c = c0 + (unsigned)u * S;
        if (c < total) { const float* src = xrow_ptr(p, 0, (int)(c >> 7)) + (c & 127u) * 8; a[u] = *(const f32x4*)src; b4[u] = *(const f32x4*)(src + 4); }
      }
#pragma unroll
      for (int u = 0; u < 4; ++u) {
        const unsigned c = c0 + (unsigned)u * S;
        if (c < total) {
          u32x4 o; o[0] = pk2(a[u][0], a[u][1]); o[1] = pk2(a[u][2], a[u][3]); o[2] = pk2(b4[u][0], b4[u][1]); o[3] = pk2(b4[u][2], b4[u][3]);
          *(u32x4*)(ab + (size_t)(c >> 7) * D + (c & 127u) * 8) = o;
        }
      }
    }
  }
  float2* rope = (float2*)(p.ws + W_ROPE);
  for (int i = blockIdx.x * NTH + tid; i < 8192 * 32; i += gridDim.x * NTH) {
    const int pos = i >> 5, d = i & 31;
    const double inv = exp2(-(double)d * (13.287712379549449 / 32.0));
    double ang = (double)pos * inv;
    const double twopi = 6.283185307179586476925;
    ang -= twopi * rint(ang / twopi);
    float s, c; sincosf((float)ang, &s, &c);
    rope[i] = make_float2(c, s);
  }
  if (blockIdx.x == 0 && tid < 128) {
    const int l = tid >> 6, ln = tid & 63;
    const float* lp = p.in[13] + (size_t)l * 4 * 64;
    const float s1 = wave_sum(lp[ln] * lp[64 + ln]), s2 = wave_sum(lp[128 + ln] * lp[192 + ln]);
    const float lam_init = (l == 0) ? 0.2f : (0.8f - 0.6f * 0.74081822068171788f);
    if (ln == 0) ((float*)(p.ws + W_MISC))[l] = __expf(s1) - __expf(s2) + lam_init;
  }
  if (blockIdx.x == 0 && tid < 8) ((unsigned*)(p.ws + W_MISC))[16 + tid] = 0u;
  if (blockIdx.x == 0) for (int i = tid; i < 3456; i += NTH) ((unsigned*)(p.ws + W_BAR))[i] = 0u;
}

namespace pg8 {
#define PG8_LAS __attribute__((address_space(3)))
typedef unsigned short bf16_t;
typedef short bf16x8 __attribute__((ext_vector_type(8)));
typedef float f32x4 __attribute__((ext_vector_type(4)));
typedef unsigned u32x4 __attribute__((ext_vector_type(4)));
constexpr int BM = 256, BK = 64, HALF = 128, HTB = HALF * BK * 2  , STAGE_BYTES = 8 * HTB, NXCD = 8, WGM = 8;

__host__ __device__ __forceinline__ int lds_byte(int r, int c) { const int st = (r >> 4) * 2 + (c >> 5), rr = r & 15, cc = c & 31, ob = rr * 64 + cc * 2; return st * 1024 + (ob ^ (((ob >> 9) & 1) << 5)); }
__host__ __device__ __forceinline__ void stage_rc(int b, int& R, int& C) { const int st = b / 1024, sb = b % 1024, swz = sb ^ (((sb >> 9) & 1) << 5); R = (st >> 1) * 16 + swz / 64; C = (st & 1) * 32 + (swz % 64) / 2; }
__host__ __device__ __forceinline__ int perm32(int rho) { const int n = rho >> 4, i = rho & 15; return 8 * (i >> 2) + 4 * n + (i & 3); }

struct Unit { int pm, pn; };
struct Gemm { const bf16_t* A; const bf16_t* Bt; int M, N, K; };

struct StaticOrder {
    int nM, nN, nwg, G, c;
    __host__ __device__ void init(int M, int N, int G_, int c_) { nM = M / BM; nN = N / BM; nwg = nM * nN; G = G_; c = c_; }
    __host__ __device__ bool next(int i, Unit& u) const {
        const long L = (long)i * G + c; if (L >= nwg) return false;
        int wgid = (int)L; { const int q = nwg / NXCD, r = nwg % NXCD, xcd = wgid % NXCD, off = wgid / NXCD; wgid = (xcd < r ? xcd * (q + 1) : r * (q + 1) + (xcd - r) * q) + off; }
        const int nig = WGM * nN, gid = wgid / nig, fm = gid * WGM, gsz = (nM - fm) < WGM ? (nM - fm) : WGM;
        u.pm = fm + ((wgid % nig) % gsz); u.pn = (wgid % nig) / gsz; return true;
    }
    __device__ __forceinline__ void a_ready(const Unit&) const {}
    __device__ __forceinline__ void done(const Unit&) const {}
};
template <class Epi, class Sched, bool STAMP = false>
__device__ __forceinline__ void gemm_phase(PG8_LAS unsigned char* lds, const Gemm g, const Sched& S, const Epi& E, unsigned long long* stamps) {
    const int tid = otid(), wid = __builtin_amdgcn_readfirstlane(tid >> 6), lane = tid & 63, wr = wid >> 2, wc = wid & 3, fr = lane & 15, fq = lane >> 4;
    const int K = g.K, nt = K / BK;
    int ts_lo = 0, ts_hi = 0, nts = 0; const unsigned long long rt_entry = STAMP ? (unsigned long long)wall_clock64() : 0ull;
#define PG8_STAMP() do { if (STAMP && wid == 0 && nts < 64) { const unsigned long long _c = (unsigned long long)clock64(); \
        ts_lo = (lane == nts) ? (int)(unsigned)_c : ts_lo; ts_hi = (lane == nts) ? (int)(unsigned)(_c >> 32) : ts_hi; ++nts; } } while (0)
    PG8_STAMP();
    unsigned voffA[2], voffB[2];
#pragma unroll
    for (int i = 0; i < 2; ++i) { int R, C; stage_rc(tid * 16 + i * 8192, R, C); const int Rb = Epi::PERM ? ((R & ~31) + perm32(R & 31)) : R;
        voffA[i] = (unsigned)(R * K + C) * 2u; voffB[i] = (unsigned)(Rb * K + C) * 2u; }
    const size_t kstep = (size_t)(BK * 2);
    const size_t hstep = (size_t)HALF * K * 2;
    const size_t tstep = 2 * hstep;
    const unsigned ldsw = (unsigned)wid * 1024u;
    const int aoff = lds_byte(wr * 64 + fr, fq * 8), boff = lds_byte(wc * 32 + fr, fq * 8);
#define PG8_SA(b, h) (((b) * 2 + (h)) * HTB)
#define PG8_SB(b, h) ((4 + (b) * 2 + (h)) * HTB)
#define PG8_STAGE(bufoff, gbase, voff) do { _Pragma("unroll") for (int _i = 0; _i < 2; ++_i) \
        __builtin_amdgcn_global_load_lds((const unsigned*)((const char*)(gbase) + (voff)[_i]), (PG8_LAS unsigned*)(lds + (bufoff) + ldsw + _i * 8192), 16, 0, 0); } while (0)
#define PG8_LDA(dst, b, h) do { _Pragma("unroll") for (int m = 0; m < 4; ++m) _Pragma("unroll") for (int k = 0; k < 2; ++k) dst[m][k] = *(const PG8_LAS bf16x8*)(lds + PG8_SA(b, h) + aoff + m * 2048 + k * 1024); } while (0)
#define PG8_LDB(dst, b, h) do { _Pragma("unroll") for (int n = 0; n < 2; ++n) _Pragma("unroll") for (int k = 0; k < 2; ++k) dst[n][k] = *(const PG8_LAS bf16x8*)(lds + PG8_SB(b, h) + boff + n * 2048 + k * 1024); } while (0)
#define PG8_MMA(ai, bj, At, Bt) do { __builtin_amdgcn_s_setprio(1); _Pragma("unroll") for (int m = 0; m < 4; ++m) _Pragma("unroll") for (int n = 0; n < 2; ++n) _Pragma("unroll") for (int k = 0; k < 2; ++k) \
        acc[ai][bj][m][n] = __builtin_amdgcn_mfma_f32_16x16x32_bf16(Bt[n][k], At[m][k], acc[ai][bj][m][n], 0, 0, 0); __builtin_amdgcn_s_setprio(0); } while (0)
#define PG8_WAIT_V(n) asm volatile("s_waitcnt vmcnt(" #n ")" ::: "memory")
#define PG8_WAIT_L(n) asm volatile("s_waitcnt lgkmcnt(" #n ")" ::: "memory")
#define PG8_BAR __builtin_amdgcn_s_barrier()
#define PG8_SCHED __builtin_amdgcn_sched_barrier(0)
    Unit cur, nxt; int ui = 0;
    if (!S.next(0, cur)) return;
    f32x4 acc[2][2][4][2];
#pragma unroll
    for (int a = 0; a < 2; ++a)
#pragma unroll
        for (int b = 0; b < 2; ++b)
#pragma unroll
            for (int m = 0; m < 4; ++m)
#pragma unroll
                for (int n = 0; n < 2; ++n) acc[a][b][m][n] = (f32x4){0.f, 0.f, 0.f, 0.f};
    bf16x8 At[4][2], B0[2][2], B1[2][2];
    const char* cA = (const char*)g.A + (size_t)cur.pm * tstep; const char* cB = (const char*)g.Bt + (size_t)cur.pn * tstep;
    S.a_ready(cur);
    PG8_STAGE(PG8_SB(0, 0), cB, voffB); PG8_STAGE(PG8_SA(0, 0), cA, voffA); PG8_STAGE(PG8_SB(0, 1), cB + hstep, voffB); PG8_STAGE(PG8_SA(0, 1), cA + hstep, voffA);
    if (wr == 1) PG8_BAR;
    PG8_WAIT_V(4); PG8_BAR;
    PG8_STAGE(PG8_SB(1, 0), cB + kstep, voffB); PG8_STAGE(PG8_SA(1, 0), cA + kstep, voffA); PG8_STAGE(PG8_SB(1, 1), cB + hstep + kstep, voffB);
    PG8_WAIT_V(6); PG8_BAR;
    PG8_STAMP();
    for (;;) {
        const bool has_next = S.next(ui + 1, nxt);
        const char* nA = has_next ? (const char*)g.A + (size_t)nxt.pm * tstep : cA; const char* nB = has_next ? (const char*)g.Bt + (size_t)nxt.pn * tstep : cB;
        for (int t = 0; t < nt; t += 2) {
            const bool last = (t == nt - 2);
            const char* a1 = cA + (size_t)(t + 1) * kstep;
            const char* a2 = last ? nA : cA + (size_t)(t + 2) * kstep; const char* b2 = last ? nB : cB + (size_t)(t + 2) * kstep;
            const char* a3 = a2 + kstep; const char* b3 = b2 + kstep;
            if (last && has_next) S.a_ready(nxt);
            PG8_LDB(B0, 0, 0); PG8_SCHED; PG8_LDA(At, 0, 0); PG8_STAGE(PG8_SA(1, 1), a1 + hstep, voffA);
            PG8_WAIT_L(8); PG8_BAR; PG8_WAIT_L(0); PG8_MMA(0, 0, At, B0); PG8_BAR; PG8_SCHED;
            PG8_LDB(B1, 0, 1); PG8_STAGE(PG8_SB(0, 0), b2, voffB);
            PG8_BAR; PG8_WAIT_L(0); PG8_MMA(0, 1, At, B1); PG8_BAR;
            PG8_LDA(At, 0, 1); PG8_STAGE(PG8_SA(0, 0), a2, voffA);
            PG8_BAR; PG8_WAIT_L(0); PG8_MMA(1, 0, At, B0); PG8_BAR; PG8_SCHED;
            PG8_STAGE(PG8_SB(0, 1), b2 + hstep, voffB);
            PG8_WAIT_V(6); PG8_BAR; PG8_MMA(1, 1, At, B1); PG8_BAR;
            PG8_LDB(B0, 1, 0); PG8_SCHED; PG8_LDA(At, 1, 0); PG8_STAGE(PG8_SA(0, 1), a2 + hstep, voffA);
            PG8_WAIT_L(8); PG8_BAR; PG8_WAIT_L(0); PG8_MMA(0, 0, At, B0); PG8_BAR; PG8_SCHED;
            PG8_LDB(B1, 1, 1); PG8_STAGE(PG8_SB(1, 0), b3, voffB);
            PG8_BAR; PG8_WAIT_L(0); PG8_MMA(0, 1, At, B1); PG8_BAR;
            PG8_LDA(At, 1, 1); PG8_STAGE(PG8_SA(1, 0), a3, voffA);
            PG8_BAR; PG8_WAIT_L(0); PG8_MMA(1, 0, At, B0); PG8_BAR; PG8_SCHED;
            PG8_STAGE(PG8_SB(1, 1), b3 + hstep, voffB);
            PG8_WAIT_V(6); PG8_BAR; PG8_MMA(1, 1, At, B1); PG8_BAR;
        }
        PG8_STAMP();
        if constexpr (!Epi::AFTER_DRAIN) { E(acc, cur, wr, wc, fr, fq); S.done(cur); }
        PG8_STAMP();
        if (!has_next) break;
#pragma unroll
        for (int a = 0; a < 2; ++a)
#pragma unroll
            for (int b = 0; b < 2; ++b)
#pragma unroll
                for (int m = 0; m < 4; ++m)
#pragma unroll
                    for (int n = 0; n < 2; ++n) acc[a][b][m][n] = (f32x4){0.f, 0.f, 0.f, 0.f};
        cur = nxt; cA = nA; cB = nB; ++ui;
    }
    PG8_WAIT_V(0);
    if (wr == 0) PG8_BAR;
    PG8_BAR;
    if constexpr (Epi::AFTER_DRAIN) { E.fused(acc, cur, wr, wc, fr, fq, lds, wid, lane); S.done(cur); }
    PG8_STAMP();
    if (STAMP && wid == 0) { stamps[lane] = lane < nts ? (((unsigned long long)(unsigned)ts_hi << 32) | (unsigned)ts_lo) : 0ull;
        if (lane == 62) stamps[62] = rt_entry; if (lane == 63) stamps[63] = (unsigned long long)wall_clock64(); }
#undef PG8_STAMP
#undef PG8_SA
#undef PG8_SB
#undef PG8_STAGE
#undef PG8_LDA
#undef PG8_LDB
#undef PG8_MMA
#undef PG8_WAIT_V
#undef PG8_WAIT_L
#undef PG8_BAR
#undef PG8_SCHED
}
}

enum { EPI_IN = 0, EPI_OUT = 1, EPI_UP = 2, EPI_DOWN = 3 };
template <int MODE>
struct Epi {
  static constexpr bool PERM = true, AFTER_DRAIN = false;
  Params p; int l;
  DI void operator()(const f32x4 (&acc)[2][2][4][2], const pg8::Unit& u, int wr, int wc, int fr, int fq) const {
    const int colb = u.pn * 256 + wc * 32 + 8 * fq;
    if (MODE == EPI_OUT || MODE == EPI_DOWN) {
      float* Rb = (float*)(p.ws + W_R);
#pragma unroll
      for (int ai = 0; ai < 2; ++ai) {
        f32x4 res[4][2][2];
#pragma unroll
        for (int m = 0; m < 4; ++m) {
          const int row = u.pm * 256 + ai * 128 + wr * 64 + m * 16 + fr;
          const float* rs = (MODE == EPI_OUT ? xrow_ptr(p, l, row < M ? row : M - 1) : Rb + (size_t)(row < M ? row : M - 1) * D) + colb;
#pragma unroll
          for (int bj = 0; bj < 2; ++bj) { res[m][bj][0] = *(const f32x4*)(rs + bj * 128); res[m][bj][1] = *(const f32x4*)(rs + bj * 128 + 4); }
        }
#pragma unroll
        for (int m = 0; m < 4; ++m) {
          const int row = u.pm * 256 + ai * 128 + wr * 64 + m * 16 + fr;
          if (row < M) {
            float* R = Rb + (size_t)row * D + colb;
#pragma unroll
            for (int bj = 0; bj < 2; ++bj) {
              *(f32x4*)(R + bj * 128) = res[m][bj][0] * ALPHA + acc[ai][bj][m][0];
              *(f32x4*)(R + bj * 128 + 4) = res[m][bj][1] * ALPHA + acc[ai][bj][m][1];
            }
          }
        }
      }
      return;
    }
    f32x4 rc0[8], rc1[8];
    if (MODE == EPI_IN && (u.pn >> 2) <= 1) {
      const int d0 = (colb & 63) >> 1;
#pragma unroll
      for (int i = 0; i < 8; ++i) {
        int row = u.pm * 256 + (i >> 2) * 128 + wr * 64 + (i & 3) * 16 + fr; row = row < M ? row : M - 1;
        const int pos = row < MP ? (row & (SEQ - 1)) : PAST + ((row - MP) & 15);
        const f32x4* rp = (const f32x4*)((const float2*)(p.ws + W_ROPE) + pos * 32 + d0);
        rc0[i] = rp[0]; rc1[i] = rp[1];
      }
    }
#pragma unroll
    for (int ai = 0; ai < 2; ++ai)
#pragma unroll
      for (int m = 0; m < 4; ++m) {
        const int row = u.pm * 256 + ai * 128 + wr * 64 + m * 16 + fr;
        if (row < M) {
#pragma unroll
          for (int bj = 0; bj < 2; ++bj) {
            const int col = colb + bj * 128;
            const f32x4 v0 = acc[ai][bj][m][0], v1 = acc[ai][bj][m][1];
            if (MODE == EPI_IN) {
              bf16_t* Z = (bf16_t*)(p.ws + W_Z);
              const int seg = u.pn >> 2;
              if (seg <= 1) {
                const int d0 = (col & 63) >> 1;
                const f32x4 c01 = rc0[ai * 4 + m], c23 = rc1[ai * 4 + m];
                const float a0 = v0[0] * c01[0] - v0[1] * c01[1], b0 = v0[1] * c01[0] + v0[0] * c01[1];
                const float a1 = v0[2] * c01[2] - v0[3] * c01[3], b1 = v0[3] * c01[2] + v0[2] * c01[3];
                const float a2 = v1[0] * c23[0] - v1[1] * c23[1], b2 = v1[1] * c23[0] + v1[0] * c23[1];
                const float a3 = v1[2] * c23[2] - v1[3] * c23[3], b3 = v1[3] * c23[2] + v1[2] * c23[3];
                const float qs = seg == 0 ? 0.125f : 1.f;
                u32x4 o; o[0] = pk2(a0 * qs, b0 * qs); o[1] = pk2(a1 * qs, b1 * qs); o[2] = pk2(a2 * qs, b2 * qs); o[3] = pk2(a3 * qs, b3 * qs);
                __builtin_nontemporal_store(o, (u32x4*)(Z + (size_t)row * NIN + col));
                if (seg == 1) {
                  float* ob = (row < MP ? p.out + O_KP + ((size_t)l * MP + row) * 1024 : p.out + O_KS + ((size_t)l * MS + row - MP) * 1024) + ((col - 1024) & ~63) + d0;
                  f32x4 o1, o2; o1[0] = a0; o1[1] = a1; o1[2] = a2; o1[3] = a3; o2[0] = b0; o2[1] = b1; o2[2] = b2; o2[3] = b3;
                  __builtin_nontemporal_store(o1, (f32x4*)ob); __builtin_nontemporal_store(o2, (f32x4*)(ob + 32));
                }
              } else {
                u32x4 o; o[0] = pk2(v0[0], v0[1]); o[1] = pk2(v0[2], v0[3]); o[2] = pk2(v1[0], v1[1]); o[3] = pk2(v1[2], v1[3]);
                __builtin_nontemporal_store(o, (u32x4*)(Z + (size_t)row * NIN + col));
                if (seg == 2) {
                  float* ob = (row < MP ? p.out + O_VP + ((size_t)l * MP + row) * 1024 : p.out + O_VS + ((size_t)l * MS + row - MP) * 1024) + (col - 2048);
                  __builtin_nontemporal_store(v0, (f32x4*)ob); __builtin_nontemporal_store(v1, (f32x4*)(ob + 4));
                } else if (seg == 3 || seg == 4) {
                  float* ob = nullptr;
                  if (row < MP) { const int s = row & (SEQ - 1); if (s >= SEQ - 3) ob = p.out + O_MCP + ((size_t)(l * 4 + (row >> 13)) * 3 + (s - (SEQ - 3))) * 2048 + col - 3072; }
                  else { const int t = (row - MP) & 15, b = (row - MP) >> 4; if (t >= 13) ob = p.out + O_MCS + ((size_t)(l * 8 + b) * 3 + (t - 13)) * 2048 + col - 3072; }
                  if (ob) { *(f32x4*)ob = v0; *(f32x4*)(ob + 4) = v1; }
                }
              }
            } else if (MODE == EPI_OUT || MODE == EPI_DOWN) {
              float* R = (float*)(p.ws + W_R) + (size_t)row * D + col;
              const float* rs = MODE == EPI_OUT ? xrow_ptr(p, l, row) + col : R;
              const f32x4 r0 = *(const f32x4*)rs, r1 = *(const f32x4*)(rs + 4);
              *(f32x4*)R = r0 * ALPHA + v0; *(f32x4*)(R + 4) = r1 * ALPHA + v1;
            } else {
              bf16_t* U = (bf16_t*)(p.ws + W_Z);
              u32x4 o; o[0] = pk2(v0[0], v0[1]); o[1] = pk2(v0[2], v0[3]); o[2] = pk2(v1[0], v1[1]); o[3] = pk2(v1[2], v1[3]);
              __builtin_nontemporal_store(o, (u32x4*)(U + (size_t)row * NUP + col));
              float* ob = nullptr;
              if (row < MP) { const int s = row & (SEQ - 1); if (s >= SEQ - 2) ob = p.out + O_FCP + ((size_t)(l * 4 + (row >> 13)) * 2 + (s - (SEQ - 2))) * NUP + col; }
              else { const int t = (row - MP) & 15, b = (row - MP) >> 4; if (t >= 14) ob = p.out + O_FCS + ((size_t)(l * 8 + b) * 2 + (t - 14)) * NUP + col; }
              if (ob) { *(f32x4*)ob = v0; *(f32x4*)(ob + 4) = v1; }
            }
          }
        }
      }
  }
};

template <int MODE>
DI void gemm_phase(const Params& p, int l, const bf16_t* A, int lda, const bf16_t* Bt, int K, int ntn, char* lds) {
  (void)lda;
  pg8::Gemm g; g.A = A; g.Bt = Bt; g.M = ((MODE == EPI_OUT || MODE == EPI_DOWN) ? NTM - 1 : NTM) * 256; g.N = ntn * 256; g.K = K;
  if (MODE == EPI_OUT || MODE == EPI_DOWN) sample_gemm<MODE>(p, l, A, Bt, K);
  pg8::StaticOrder S; S.init(g.M, g.N, (int)gridDim.x, (int)blockIdx.x);
  Epi<MODE> E; E.p = p; E.l = l;
  pg8::gemm_phase<Epi<MODE>, pg8::StaticOrder, false>((PG8_LAS unsigned char*)lds, g, S, E, nullptr);
  __syncthreads();
}

typedef float f32x4v __attribute__((ext_vector_type(4)));
template <int MODE>
DI void sample_gemm(const Params& p, int l, const bf16_t* A, const bf16_t* Bt, int K) {
  if (blockIdx.x >= 64) return;
  const int tid = otid(), lane = tid & 63, wave = uni(tid >> 6), fr = lane & 15, fq = lane >> 4;
  const bf16_t* ap = A + (size_t)(MP + wave * 16 + fr) * K + fq * 8;
  const bf16_t* bp = Bt + (size_t)(blockIdx.x * 16 + fr) * K + fq * 8;
  f32x4v acc0 = {0.f, 0.f, 0.f, 0.f}, acc1 = {0.f, 0.f, 0.f, 0.f};
  for (int k0 = 0; k0 < K; k0 += 256) {
    bf16x8 a[8], bb[8];
#pragma unroll
    for (int i = 0; i < 8; ++i) { a[i] = *(const bf16x8*)(ap + k0 + i * 32); bb[i] = *(const bf16x8*)(bp + k0 + i * 32); }
#pragma unroll
    for (int i = 0; i < 8; i += 2) {
      acc0 = __builtin_amdgcn_mfma_f32_16x16x32_bf16(a[i], bb[i], acc0, 0, 0, 0);
      acc1 = __builtin_amdgcn_mfma_f32_16x16x32_bf16(a[i + 1], bb[i + 1], acc1, 0, 0, 0);
    }
  }
  const int col = blockIdx.x * 16 + fr;
  float* R = (float*)(p.ws + W_R);
#pragma unroll
  for (int j = 0; j < 4; ++j) {
    const int row = MP + wave * 16 + fq * 4 + j;
    const float res = MODE == EPI_OUT ? xrow_ptr(p, l, row)[col] : R[(size_t)row * D + col];
    R[(size_t)row * D + col] = ALPHA * res + (acc0[j] + acc1[j]);
  }
}

DI void gif_phase(const Params& p, int l, char* lds, int first_blk) {
  if ((int)blockIdx.x < first_blk) return;
  const int tidq = otid(); const int lane = tidq & 63, gw = ((int)blockIdx.x - first_blk) * 8 + (tidq >> 6), ngw = ((int)gridDim.x - first_blk) * 8;
  const float* w = p.in[9] + (size_t)l * D * DIN + 7168;
  const float* bif = p.in[10] + l * 8;
  float* gif = (float*)(p.ws + W_GIF);
  float* w8 = (float*)lds;
  __syncthreads();
#pragma unroll
  for (int i = 0; i < 2; ++i) {
    const int k = tidq + 512 * i;
    *(f32x4*)(w8 + k * 8) = *(const f32x4*)(w + (size_t)k * DIN); *(f32x4*)(w8 + k * 8 + 4) = *(const f32x4*)(w + (size_t)k * DIN + 4);
  }
  __syncthreads();
  for (int rg = gw; rg < M / 4; rg += ngw) {
    float acc[4][8];
#pragma unroll
    for (int a = 0; a < 4; ++a)
#pragma unroll
      for (int j = 0; j < 8; ++j) acc[a][j] = 0.f;
    const float* x0 = xrow_ptr(p, l, rg * 4);
#pragma unroll 4
    for (int kk = 0; kk < 16; ++kk) {
      const int k = kk * 64 + lane;
      const f32x4 w0 = *(const f32x4*)(w8 + k * 8), w1 = *(const f32x4*)(w8 + k * 8 + 4);
#pragma unroll
      for (int a = 0; a < 4; ++a) {
        const float xv = x0[(size_t)a * D + k];
        acc[a][0] += xv * w0[0]; acc[a][1] += xv * w0[1]; acc[a][2] += xv * w0[2]; acc[a][3] += xv * w0[3];
        acc[a][4] += xv * w1[0]; acc[a][5] += xv * w1[1]; acc[a][6] += xv * w1[2]; acc[a][7] += xv * w1[3];
      }
    }
#pragma unroll
    for (int a = 0; a < 4; ++a)
#pragma unroll
      for (int j = 0; j < 8; ++j) {
        const float s = wave_sum(acc[a][j]);
        if (lane == 0) gif[(size_t)(rg * 4 + a) * 8 + j] = s + bif[j];
      }
  }
  __syncthreads();
}

DI void qkconv_phase(const Params& p, int l) {
  const bf16_t* Z = (const bf16_t*)(p.ws + W_Z);
  bf16_t* QA = (bf16_t*)(p.ws + W_AB); bf16_t* KA = (bf16_t*)(p.ws + W_KA);
  const float* cw = p.in[11] + (size_t)l * 4 * 2048; const float* cb = p.in[12] + (size_t)l * 2048;
  constexpr int RG = 8;
  const size_t total = (size_t)(M / RG) * 256;
  const int tid_ = otid();
  const int col = (tid_ & 255) * 8;
  float w[4][8], bias[8];
#pragma unroll
  for (int j = 0; j < 4; ++j) { f32x4 a = *(const f32x4*)(cw + j * 2048 + col), b = *(const f32x4*)(cw + j * 2048 + col + 4);
    w[j][0] = a[0]; w[j][1] = a[1]; w[j][2] = a[2]; w[j][3] = a[3]; w[j][4] = b[0]; w[j][5] = b[1]; w[j][6] = b[2]; w[j][7] = b[3]; }
  { f32x4 a = *(const f32x4*)(cb + col), b = *(const f32x4*)(cb + col + 4);
    bias[0] = a[0]; bias[1] = a[1]; bias[2] = a[2]; bias[3] = a[3]; bias[4] = b[0]; bias[5] = b[1]; bias[6] = b[2]; bias[7] = b[3]; }
  for (size_t it = (size_t)blockIdx.x * NTH + tid_; it < total; it += (size_t)gridDim.x * NTH) {
    const int rg = (int)(it >> 8), row0 = rg * RG;
    int t0;
    const float* st = nullptr;
    if (row0 < MP) { t0 = row0 & (SEQ - 1); }
    else { t0 = (row0 - MP) & 15; st = p.in[4] + ((size_t)(l * 8 + ((row0 - MP) >> 4)) * 3) * 2048 + col; }
    float x[RG + 3][8];
#pragma unroll
    for (int j = 0; j < RG + 3; ++j) {
      const int t = t0 - 3 + j;
      if (t >= 0) { u32x4 v = *(const u32x4*)(Z + (size_t)(row0 - 3 + j) * NIN + 3072 + col); unpack8(v, x[j]); }
      else if (st) { f32x4 a = *(const f32x4*)(st + (size_t)(3 + t) * 2048), b = *(const f32x4*)(st + (size_t)(3 + t) * 2048 + 4);
        x[j][0] = a[0]; x[j][1] = a[1]; x[j][2] = a[2]; x[j][3] = a[3]; x[j][4] = b[0]; x[j][5] = b[1]; x[j][6] = b[2]; x[j][7] = b[3]; }
      else {
#pragma unroll
        for (int e = 0; e < 8; ++e) x[j][e] = 0.f; }
    }
    const float sc = col >= 1024 ? 0.0625f : 1.f;
    bf16_t* dst = col >= 1024 ? KA + (col - 1024) : QA + col;
#pragma unroll
    for (int a = 0; a < RG; ++a) {
      float o[8];
#pragma unroll
      for (int e = 0; e < 8; ++e) {
        float u = bias[e] + w[0][e] * x[a][e] + w[1][e] * x[a + 1][e] + w[2][e] * x[a + 2][e] + w[3][e] * x[a + 3][e];
        o[e] = u * sigmoidf_(u) * sc;
      }
      u32x4 ov; ov[0] = pk2(o[0], o[1]); ov[1] = pk2(o[2], o[3]); ov[2] = pk2(o[4], o[5]); ov[3] = pk2(o[6], o[7]);
      *(u32x4*)(dst + (size_t)(row0 + a) * D) = ov;
    }
  }
}

constexpr int A_LD = 272;
constexpr int A_TILE = 64 * A_LD;
constexpr int A_VLD = 320;
constexpr int A_VTILE = 64 * A_VLD;
template <int KIND>
DI void attn_item(const Params& p, int l, int b, int ha, int qb, char* lds) {
  const int tid = otid(), lane = tid & 63, wave = uni(tid >> 6);
  const int map = wave >> 2, qt = wave & 3, r = lane & 31, h = lane >> 5;
  const bf16_t* Z = (const bf16_t*)(p.ws + W_Z);
  const int NT = KIND == 0 ? 2 * (qb + 1) : (NKS + 63) / 64;
  const int ntw = KIND == 0 ? 2 * qb + (qt >> 1) + 1 : NT;
  const bool active = KIND == 0 ? true : (qt == 0);
  int qrow;
  if (KIND == 0) qrow = b * SEQ + qb * 128 + qt * 32 + r; else qrow = MP + b * 16 + (r < 16 ? r : 15);
  bf16x8 qf[4];
#pragma unroll
  for (int ks = 0; ks < 4; ++ks) {
    if (KIND == 0) qf[ks] = *(const bf16x8*)(Z + (size_t)qrow * NIN + ha * 128 + map * 64 + ks * 16 + h * 8);
    else {
      const int dn = ks * 16 + h * 8, par = dn >> 5, dd = dn & 31;
      const bf16_t* src = Z + (size_t)qrow * NIN + ha * 128 + map * 64 + 2 * dd;
      const u32x4 lo = *(const u32x4*)src, hi = *(const u32x4*)(src + 8);
      unsigned e[8];
#pragma unroll
      for (int i = 0; i < 4; ++i) { e[i] = par ? (lo[i] >> 16) : (lo[i] & 0xffffu); e[4 + i] = par ? (hi[i] >> 16) : (hi[i] & 0xffffu); }
      u32x4 o; o[0] = e[0] | (e[1] << 16); o[1] = e[2] | (e[3] << 16); o[2] = e[4] | (e[5] << 16); o[3] = e[6] | (e[7] << 16);
      qf[ks] = __builtin_bit_cast(bf16x8, o);
    }
  }
  const int skey = tid >> 4, part = tid & 15;
  u32x4 rk0, rk1, rv0, rv1;
  auto gload = [&](int j) {
    if (KIND == 0) {
      const bf16_t* base = Z + (size_t)(b * SEQ + j * 64 + skey) * NIN + 1024 + ha * 128 + part * 8;
      rk0 = *(const u32x4*)base; rk1 = *(const u32x4*)(base + (size_t)32 * NIN);
      rv0 = *(const u32x4*)(base + 1024); rv1 = *(const u32x4*)(base + (size_t)32 * NIN + 1024);
    } else {
#pragma unroll
      for (int i = 0; i < 2; ++i) {
        int kk = j * 64 + skey + 32 * i; if (kk > NKS - 1) kk = NKS - 1;
        const float *ks_, *vs_;
        if (kk < PAST) { const size_t o = (((size_t)(l * 8 + b) * PAST + kk) * 8 + ha) * 128 + part * 8; ks_ = p.in[2] + o; vs_ = p.in[3] + o; }
        else { const size_t o = (((size_t)l * MS + b * 16 + (kk - PAST)) * 8 + ha) * 128 + part * 8; ks_ = p.out + O_KS + o; vs_ = p.out + O_VS + o; }
        const f32x4 a0 = *(const f32x4*)ks_, a1 = *(const f32x4*)(ks_ + 4), c0 = *(const f32x4*)vs_, c1 = *(const f32x4*)(vs_ + 4);
        u32x4 ko, vo;
        ko[0] = pk2(a0[0], a0[1]); ko[1] = pk2(a0[2], a0[3]); ko[2] = pk2(a1[0], a1[1]); ko[3] = pk2(a1[2], a1[3]);
        vo[0] = pk2(c0[0], c0[1]); vo[1] = pk2(c0[2], c0[3]); vo[2] = pk2(c1[0], c1[1]); vo[3] = pk2(c1[2], c1[3]);
        if (i == 0) { rk0 = ko; rv0 = vo; } else { rk1 = ko; rv1 = vo; }
      }
    }
  };
  f32x16 O[4];
#pragma unroll
  for (int v = 0; v < 4; ++v)
#pragma unroll
    for (int i = 0; i < 16; ++i) O[v][i] = 0.f;
  float m_run = -1e30f, l_run = 0.f;
  const int q4 = (lane & 15) >> 2, p4 = lane & 3, blk = (lane >> 4) & 1;
  const unsigned sofs = skey * A_LD + part * 16, vofs = skey * A_VLD + part * 16;
  auto qk = [&](int j, f32x16 (&st)[2]) {
    const char* kb = lds + (j & 1) * A_TILE;
#pragma unroll
    for (int kt = 0; kt < 2; ++kt) {
#pragma unroll
      for (int i = 0; i < 16; ++i) st[kt][i] = 0.f;
#pragma unroll
      for (int ks = 0; ks < 4; ++ks) {
        const bf16x8 kf = *(const bf16x8*)(kb + (kt * 32 + r) * A_LD + (map * 64 + ks * 16 + h * 8) * 2);
        st[kt] = MFMA32(kf, qf[ks], st[kt]);
      }
    }
    if (KIND == 1 && j == NT - 1) {
#pragma unroll
      for (int kt = 0; kt < 2; ++kt)
#pragma unroll
        for (int i = 0; i < 16; ++i) if (j * 64 + kt * 32 + crow(i, h) >= NKS) st[kt][i] = -1e30f;
    }
  };
  bf16x8 pk[4];
  auto smax = [&](int j, f32x16 (&sc)[2], f32x16 (&sn)[2]) {
    if (j + 1 < ntw) qk(j + 1, sn);
    float mx = sc[0][0];
#pragma unroll
    for (int kt = 0; kt < 2; ++kt)
#pragma unroll
      for (int i = 0; i < 16; ++i) mx = fmaxf(mx, sc[kt][i]);
    mx = fmaxf(mx, __shfl_xor(mx, 32));
    const float m_cand = fmaxf(m_run, mx);
    const float m_new = (m_cand - m_run) * LOG2E > 8.f ? m_cand : m_run;
    const float alpha = __builtin_amdgcn_exp2f((m_run - m_new) * LOG2E);
    const float mb = m_new * LOG2E;
    float rs = 0.f;
#pragma unroll
    for (int kt = 0; kt < 2; ++kt)
#pragma unroll
      for (int i = 0; i < 16; ++i) { const float e = __builtin_amdgcn_exp2f(sc[kt][i] * LOG2E - mb); sc[kt][i] = e; rs += e; }
    rs += __shfl_xor(rs, 32);
    l_run = l_run * alpha + rs; m_run = m_new;
    if (__builtin_amdgcn_ballot_w64(alpha != 1.f) != 0ull) {
#pragma unroll
      for (int v = 0; v < 4; ++v)
#pragma unroll
        for (int i = 0; i < 16; ++i) O[v][i] *= alpha;
    }
    pk[0] = pack8(sc[0], 0); pk[1] = pack8(sc[0], 1); pk[2] = pack8(sc[1], 0); pk[3] = pack8(sc[1], 1);
  };
  auto pv = [&](int j) {
    const unsigned vaddr = lds_addr(lds + 2 * A_TILE + (j % 3) * A_VTILE) + (4 * h + q4) * A_VLD + (16 * blk + 4 * p4) * 2;
    __builtin_amdgcn_s_setprio(1);
#pragma unroll
    for (int vt = 0; vt < 4; ++vt) {
      bf16x8 vf[4];
      tr_frag4<16 * A_VLD, 8 * A_VLD>(vaddr + vt * 64, vf);
#pragma unroll
      for (int ks = 0; ks < 4; ++ks) O[vt] = MFMA32(vf[ks], pk[ks], O[vt]);
    }
    __builtin_amdgcn_s_setprio(0);
  };
  gload(0);
  { char* kb = lds + sofs; *(u32x4*)kb = rk0; *(u32x4*)(kb + 32 * A_LD) = rk1; char* vb = lds + 2 * A_TILE + vofs; *(u32x4*)vb = rv0; *(u32x4*)(vb + 32 * A_VLD) = rv1; }
  gload(1);
  { char* kb = lds + A_TILE + sofs; *(u32x4*)kb = rk0; *(u32x4*)(kb + 32 * A_LD) = rk1; }
  __syncthreads();
  f32x16 sA[2], sB[2];
  if (active && 0 < ntw) qk(0, sA);
  for (int j = 0; j < NT; j += 2) {
#pragma unroll
    for (int u = 0; u < 2; ++u) {
      const int jj = j + u;
      if (jj < NT) {
        if (jj + 1 < NT) { char* vb = lds + 2 * A_TILE + ((jj + 1) % 3) * A_VTILE + vofs; *(u32x4*)vb = rv0; *(u32x4*)(vb + 32 * A_VLD) = rv1; }
        if (jj + 2 < NT) gload(jj + 2);
        if (active) {
          if (map == 1 && jj >= 1 && jj - 1 < ntw) pv(jj - 1);
          if (jj < ntw) { if (u == 0) smax(jj, sA, sB); else smax(jj, sB, sA); }
          if (map == 0 && jj < ntw) pv(jj);
        }
        if (jj + 2 < NT) { char* kb = lds + (jj & 1) * A_TILE + sofs; *(u32x4*)kb = rk0; *(u32x4*)(kb + 32 * A_LD) = rk1; }
        __syncthreads();
      }
    }
  }
  if (active && map == 1 && ntw == NT) pv(NT - 1);
  __syncthreads();
  float* ex = (float*)lds;
  const float inv_l = 1.f / l_run;
  if (map == 1) {
#pragma unroll
    for (int vt = 0; vt < 4; ++vt)
#pragma unroll
      for (int g = 0; g < 4; ++g) {
        f32x4 o; o[0] = O[vt][4 * g] * inv_l; o[1] = O[vt][4 * g + 1] * inv_l; o[2] = O[vt][4 * g + 2] * inv_l; o[3] = O[vt][4 * g + 3] * inv_l;
        *(f32x4*)(ex + (qt * 32 + r) * 132 + vt * 32 + 8 * g + 4 * h) = o;
      }
  }
  __syncthreads();
  if (map == 0) {
    const float lam = ((const float*)(p.ws + W_MISC))[l];
    const float lam_init = (l == 0) ? 0.2f : (0.8f - 0.6f * 0.74081822068171788f);
    float ssq = 0.f;
#pragma unroll
    for (int vt = 0; vt < 4; ++vt)
#pragma unroll
      for (int g = 0; g < 4; ++g) {
        const f32x4 o2 = *(const f32x4*)(ex + (qt * 32 + r) * 132 + vt * 32 + 8 * g + 4 * h);
#pragma unroll
        for (int e = 0; e < 4; ++e) { const float o = O[vt][4 * g + e] * inv_l - lam * o2[e]; O[vt][4 * g + e] = o; ssq += o * o; }
      }
    ssq += __shfl_xor(ssq, 32);
    const float rms = rsqrtf(ssq * (1.f / 128.f) + LN_EPS) * (1.f - lam_init);
    const float* sg = p.in[14] + l * 128;
    const bool valid = KIND == 0 ? true : (qt == 0 && r < 16);
    if (valid) {
      bf16_t* dst = (bf16_t*)(p.ws + W_Z) + (size_t)qrow * NIN + 3072 + ha * 128;
#pragma unroll
      for (int vt = 0; vt < 4; ++vt)
#pragma unroll
        for (int g = 0; g < 4; ++g) {
          const int v0 = vt * 32 + 8 * g + 4 * h;
          const f32x4 gg = *(const f32x4*)(sg + v0);
          u32x2 o; o[0] = pk2(O[vt][4 * g] * rms * gg[0], O[vt][4 * g + 1] * rms * gg[1]); o[1] = pk2(O[vt][4 * g + 2] * rms * gg[2], O[vt][4 * g + 3] * rms * gg[3]);
          *(u32x2*)(dst + v0) = o;
        }
    }
  }
  __syncthreads();
}

constexpr int L_LD = 528;
constexpr int L_VLD = 320;
constexpr int L_Q = 0, L_K = 64 * L_LD, L_V = 2 * 64 * L_LD, L_SW = L_V + 64 * L_VLD;
constexpr int L_SWLD = 144;
constexpr int L_SC = L_SW + 64 * L_SWLD;
constexpr int S_MX = 0, S_G = 64, S_EMT = 128, S_DS0 = 192, S_DS1 = 256, S_QN = 320  , S_NV = 576  , S_GEND = 832, S_PAR = 840;
constexpr int LDS_BYTES = 153376;
static_assert(L_SC + 2 * S_PAR * 4 <= 131072, "lds");
#define WG_BAR() do { __builtin_amdgcn_fence(__ATOMIC_RELEASE, "workgroup"); __builtin_amdgcn_s_barrier(); __builtin_amdgcn_fence(__ATOMIC_ACQUIRE, "workgroup"); } while (0)

template <int KIND>
DI void mlstm_item(const Params& p, int l, int b, int hm, int half, char* lds) {
  const int tid0 = otid(), wave = uni(tid0 >> 6);
  const bf16_t* QA = (const bf16_t*)(p.ws + W_AB); const bf16_t* KA = (const bf16_t*)(p.ws + W_KA);
  const bf16_t* Z = (const bf16_t*)(p.ws + W_Z); bf16_t* H = (bf16_t*)(p.ws + W_H);
  const float* GIF = (const float*)(p.ws + W_GIF);
  float* scb = (float*)(lds + L_SC);
  int nchunks = KIND == 0 ? SEQ / 64 : 1; asm volatile("" : "+s"(nchunks));
  const int Lv = KIND == 0 ? 64 : 16;
  const size_t bh = KIND == 0 ? (size_t)(l * 4 + b) * 4 + hm : (size_t)(l * 8 + b) * 4 + hm;
  if (wave < 4) {
    f32x16 C[8];
    { const int lane = tid0 & 63, r = lane & 31, h = lane >> 5; (void)r; (void)h;
      if (KIND == 0) {
#pragma unroll
        for (int d = 0; d < 8; ++d)
#pragma unroll
          for (int i = 0; i < 16; ++i) C[d][i] = 0.f;
      } else {
        const float* cp = p.in[5] + bh * 65536 + (size_t)(4 * h) * 256 + half * 128 + wave * 32 + r;
#pragma unroll
        for (int d = 0; d < 8; ++d)
#pragma unroll
          for (int g = 0; g < 4; ++g) {
            C[d][4 * g] = cp[0]; C[d][4 * g + 1] = cp[256]; C[d][4 * g + 2] = cp[512]; C[d][4 * g + 3] = cp[768];
            cp += 2048; asm volatile("" : "+v"(cp));
          }
      }
    }
    for (int c = 0; c < nchunks; ++c) {
      int tid = tid0; asm volatile("" : "+v"(tid));
      const int lane = tid & 63, r = lane & 31, h = lane >> 5;
      const int q4 = (lane & 15) >> 2, p4 = lane & 3, blk = (lane >> 4) & 1;
      const float* sc = scb + (c & 1) * S_PAR;
      const int rowbase = KIND == 0 ? b * SEQ + c * 64 : MP + b * 16;
      WG_BAR();
      f32x16 accB[2];
#pragma unroll
      for (int tt = 0; tt < 2; ++tt)
#pragma unroll
        for (int i = 0; i < 16; ++i) accB[tt][i] = 0.f;
#pragma unroll
      for (int d = 0; d < 8; ++d)
#pragma unroll
        for (int s = 0; s < 2; ++s) {
          __builtin_amdgcn_sched_barrier(0);
          const bf16x8 cf = pack8(C[d], s);
#pragma unroll
          for (int tt = 0; tt < 2; ++tt) {
            const char* qp = lds + L_Q + (tt * 32 + r) * L_LD + (d * 32 + 16 * s + 4 * h) * 2;
            const s16x4 lo = *(const s16x4*)qp, hi = *(const s16x4*)(qp + 16);
            const bf16x8 qfr = __builtin_shufflevector(lo, hi, 0, 1, 2, 3, 4, 5, 6, 7);
            accB[tt] = MFMA32(cf, qfr, accB[tt]);
          }
        }
      __builtin_amdgcn_sched_barrier(0);
      bf16x8 vf[4];
      tr_frag4<16 * L_VLD, 4 * L_VLD>(lds_addr(lds + L_V) + (8 * h + q4) * L_VLD + (wave * 32 + 16 * blk + 4 * p4) * 2, vf);
      const float g_end = sc[S_GEND];
#pragma unroll
      for (int d = 0; d < 8; ++d) {
#pragma unroll
        for (int i = 0; i < 16; ++i) C[d][i] *= g_end;
        bf16x8 kf[4];
        tr_frag4<16 * L_LD, 4 * L_LD>(lds_addr(lds + L_K) + (8 * h + q4) * L_LD + (d * 32 + 16 * blk + 4 * p4) * 2, kf);
#pragma unroll
        for (int ks = 0; ks < 4; ++ks) C[d] = MFMA32(kf[ks], vf[ks], C[d]);
      }
      WG_BAR();
#pragma unroll
      for (int tt = 0; tt < 2; ++tt) {
        const int t = tt * 32 + r;
        const float g = sc[S_G + t];
#pragma unroll
        for (int i = 0; i < 16; ++i) accB[tt][i] *= g;
        const char* sp = lds + L_SW + (tt * 32 + r) * L_SWLD + h * 16;
#pragma unroll
        for (int ks = 0; ks < 4; ++ks) accB[tt] = MFMA32(vf[ks], *(const bf16x8*)(sp + ks * 32), accB[tt]);
        const float qn = (sc[S_QN + t] + sc[S_QN + 64 + t]) + (sc[S_QN + 128 + t] + sc[S_QN + 192 + t]);
        float den = sc[S_DS0 + t] + sc[S_DS1 + t] + g * qn;
        den = fmaxf(fabsf(den), sc[S_EMT + t]);
        const float rden = 1.f / den;
        if (t < Lv) {
          bf16_t* dst = H + (size_t)(rowbase + t) * D + hm * 256 + half * 128 + wave * 32;
#pragma unroll
          for (int g4 = 0; g4 < 4; ++g4) {
            u32x2 o; o[0] = pk2(accB[tt][4 * g4] * rden, accB[tt][4 * g4 + 1] * rden); o[1] = pk2(accB[tt][4 * g4 + 2] * rden, accB[tt][4 * g4 + 3] * rden);
            *(u32x2*)(dst + 8 * g4 + 4 * h) = o;
          }
        }
      }
    }
    WG_BAR();
    {
      const int lane = tid0 & 63, r = lane & 31, h = lane >> 5;
      float* co = p.out + (KIND == 0 ? O_CP : O_CS) + bh * 65536 + (size_t)(4 * h) * 256 + half * 128 + wave * 32 + r;
#pragma unroll
      for (int d = 0; d < 8; ++d)
#pragma unroll
        for (int g = 0; g < 4; ++g) {
          co[0] = C[d][4 * g]; co[256] = C[d][4 * g + 1]; co[512] = C[d][4 * g + 2]; co[768] = C[d][4 * g + 3];
          co += 2048; asm volatile("" : "+v"(co));
        }
    }
  } else {
    const int hw = wave - 4;
    float nreg = 0.f, m_prev = 0.f;
    if (KIND == 1) { nreg = p.in[6][bh * 256 + (tid0 - 256)]; m_prev = p.in[7][bh]; }
    u32x4 pq[8], pk[8], pv[4];
    float gi = 0.f, gf = 0.f, g_end_cur = 0.f;
    auto issue_loads = [&](int c, int tid) {
      const int ht = tid - 256, lane = tid & 63;
      const int rowbase = KIND == 0 ? b * SEQ + c * 64 : MP + b * 16;
      const bool tvalid = lane < Lv;
      gi = tvalid ? GIF[(size_t)(rowbase + lane) * 8 + hm] : -1e30f;
      gf = tvalid ? GIF[(size_t)(rowbase + lane) * 8 + 4 + hm] : 0.f;
#pragma unroll
      for (int i = 0; i < 8; ++i) {
        const int cidx = ht + 256 * i, t = cidx >> 5, pc = cidx & 31;
        const int row = rowbase + (t < Lv ? t : Lv - 1);
        pq[i] = *(const u32x4*)(QA + (size_t)row * D + hm * 256 + pc * 8);
        pk[i] = *(const u32x4*)(KA + (size_t)row * D + hm * 256 + pc * 8);
      }
#pragma unroll
      for (int i = 0; i < 4; ++i) {
        const int cidx = ht + 256 * i, t = cidx >> 4, pc = cidx & 15;
        const int row = rowbase + (t < Lv ? t : Lv - 1);
        pv[i] = *(const u32x4*)(Z + (size_t)row * NIN + 5120 + hm * 256 + half * 128 + pc * 8);
      }
    };
    auto scalars = [&](int par, int lane) -> float {
      const bool tvalid = lane < Lv;
      const float lf = tvalid ? (fminf(gf, 0.f) - __logf(1.f + __expf(-fabsf(gf)))) : 0.f;
      float bc = lf;
#pragma unroll
      for (int o = 1; o < 64; o <<= 1) { const float v = __shfl_up(bc, o); if (lane >= o) bc += v; }
      const float a = gi - bc;
      float cm = a;
#pragma unroll
      for (int o = 1; o < 64; o <<= 1) { const float v = __shfl_up(cm, o); if (lane >= o) cm = fmaxf(cm, v); }
      const float mxv = fmaxf(m_prev, cm);
      const float m_t = bc + mxv;
      const float mx_end = __shfl(mxv, 63), bc_end = __shfl(bc, 63);
      const float wend = __expf(a - mx_end);
      g_end_cur = __expf(m_prev - mx_end);
      if (hw == 0) {
        float* sc = scb + par * S_PAR;
        sc[S_MX + lane] = __expf(mx_end - mxv);
        sc[S_G + lane] = __expf(m_prev - mxv);
        sc[S_EMT + lane] = __expf(-m_t);
        if (lane == 0) sc[S_GEND] = g_end_cur;
      }
      m_prev = bc_end + mx_end;
      return wend;
    };
    auto stage_lds = [&](float wend_l, int tid) {
      const int ht = tid - 256;
#pragma unroll
      for (int i = 0; i < 8; ++i) {
        const int cidx = ht + 256 * i, t = cidx >> 5, pc = cidx & 31;
        const float we = __shfl(wend_l, t);
        float f[8]; unpack8(pk[i], f);
        u32x4 o; o[0] = pk2(f[0] * we, f[1] * we); o[1] = pk2(f[2] * we, f[3] * we); o[2] = pk2(f[4] * we, f[5] * we); o[3] = pk2(f[6] * we, f[7] * we);
        *(u32x4*)(lds + L_Q + t * L_LD + pc * 16) = pq[i];
        *(u32x4*)(lds + L_K + t * L_LD + pc * 16) = o;
      }
#pragma unroll
      for (int i = 0; i < 4; ++i) {
        const int cidx = ht + 256 * i, t = cidx >> 4, pc = cidx & 15;
        *(u32x4*)(lds + L_V + t * L_VLD + pc * 16) = pv[i];
      }
    };
    {
      int tid = tid0; asm volatile("" : "+v"(tid));
      issue_loads(0, tid);
      scb[S_NV + (tid - 256)] = nreg;
      const float wend = scalars(0, tid & 63);
      stage_lds(wend, tid);
    }
    for (int c = 0; c < nchunks; ++c) {
      int tid = tid0; asm volatile("" : "+v"(tid));
      const int ht = tid - 256, lane = tid & 63, r = lane & 31, h = lane >> 5;
      float* sc = scb + (c & 1) * S_PAR;
      float* scn = scb + ((c + 1) & 1) * S_PAR;
      const float g_end_c = g_end_cur;
      WG_BAR();
      const bool more = c + 1 < nchunks;
      if (more) issue_loads(c + 1, tid);
      {
        const int t = ht & 63, part = ht >> 6;
        const char* qp = lds + L_Q + t * L_LD + part * 128;
        float s = 0.f;
#pragma unroll
        for (int e = 0; e < 8; ++e) {
          const u32x4 qq = *(const u32x4*)(qp + e * 16); float f[8]; unpack8(qq, f);
#pragma unroll
          for (int z = 0; z < 8; ++z) s += f[z] * sc[S_NV + part * 64 + e * 8 + z];
        }
        sc[S_QN + part * 64 + t] = s;
      }
      if (hw < 3) {
        const int stl = hw == 2 ? 1 : 0, tt = hw == 0 ? 0 : 1;
        f32x16 S, S2;
#pragma unroll
        for (int i = 0; i < 16; ++i) { S[i] = 0.f; S2[i] = 0.f; }
        const char* ka = lds + L_K + (stl * 32 + r) * L_LD + h * 16;
        const char* qa = lds + L_Q + (tt * 32 + r) * L_LD + h * 16;
#pragma unroll 4
        for (int ks = 0; ks < 16; ks += 2) {
          S = MFMA32(*(const bf16x8*)(ka + ks * 32), *(const bf16x8*)(qa + ks * 32), S);
          S2 = MFMA32(*(const bf16x8*)(ka + ks * 32 + 32), *(const bf16x8*)(qa + ks * 32 + 32), S2);
        }
        const int t = tt * 32 + r;
        const float cw = sc[S_MX + t];
        float rs = 0.f;
#pragma unroll
        for (int g = 0; g < 4; ++g) {
          float wv[4];
#pragma unroll
          for (int e = 0; e < 4; ++e) {
            const int s = stl * 32 + 8 * g + 4 * h + e;
            wv[e] = s <= t ? (S[4 * g + e] + S2[4 * g + e]) * cw : 0.f; rs += wv[e];
          }
          u32x2 o; o[0] = pk2(wv[0], wv[1]); o[1] = pk2(wv[2], wv[3]);
          *(u32x2*)(lds + L_SW + t * L_SWLD + (stl * 32 + 8 * g + 4 * h) * 2) = o;
        }
        rs += __shfl_xor(rs, 32);
        if (h == 0) {
          if (hw == 0) { sc[S_DS0 + t] = rs; sc[S_DS1 + t] = 0.f; }
          else if (hw == 1) sc[S_DS0 + t] = rs;
          else sc[S_DS1 + t] = rs;
        }
      } else {
        const int t = lane >> 1, hs = lane & 1;
        u32x4 z; z[0] = 0; z[1] = 0; z[2] = 0; z[3] = 0;
        *(u32x4*)(lds + L_SW + t * L_SWLD + 64 + hs * 32) = z; *(u32x4*)(lds + L_SW + t * L_SWLD + 64 + hs * 32 + 16) = z;
      }
      {
        float s0 = 0.f, s1 = 0.f, s2 = 0.f, s3 = 0.f;
        const char* kp = lds + L_K + ht * 2;
#pragma unroll
        for (int t = 0; t < 64; t += 4) {
          s0 += bflo((unsigned)*(const bf16_t*)(kp + t * L_LD)); s1 += bflo((unsigned)*(const bf16_t*)(kp + (t + 1) * L_LD));
          s2 += bflo((unsigned)*(const bf16_t*)(kp + (t + 2) * L_LD)); s3 += bflo((unsigned)*(const bf16_t*)(kp + (t + 3) * L_LD));
        }
        nreg = g_end_c * nreg + ((s0 + s1) + (s2 + s3));
        scn[S_NV + ht] = nreg;
      }
      float wend = 0.f;
      if (more) wend = scalars((c + 1) & 1, lane);
      WG_BAR();
      if (more) stage_lds(wend, tid);
    }
    WG_BAR();
    if (half == 0) {
      p.out[(KIND == 0 ? O_NP : O_NS) + bh * 256 + (tid0 - 256)] = nreg;
      if (tid0 == 256) p.out[(KIND == 0 ? O_MPP : O_MSS) + bh] = m_prev;
    }
  }
}

DI void mixer_phase(const Params& p, int l, char* lds, int cidx, bool ml_only) {
  unsigned* ctr = (unsigned*)(p.ws + W_MISC) + 16 + cidx;
  int* s_item = (int*)(lds + LDS_BYTES - 16);
  const int total = 32 + 64 + 64 + 2048;
  for (;;) {
    __syncthreads();
    if (threadIdx.x == 0) *s_item = (int)atomicAdd(ctr, 1u);
    __syncthreads();
    const int it = *s_item;
    __syncthreads();
    if (it >= total) break;
    if (ml_only && it >= 96) break;
    if (it < 32) { mlstm_item<0>(p, l, it >> 3, (it >> 1) & 3, it & 1, lds); continue; }
    if (it < 96) { const int x = it - 32; mlstm_item<1>(p, l, x >> 3, (x >> 1) & 3, x & 1, lds); continue; }
    if (it < 160) { attn_item<1>(p, l, (it - 96) >> 3, (it - 96) & 7, 0, lds); continue; }
    { const int x = it - 160; attn_item<0>(p, l, (x & 31) >> 3, x & 7, 63 - (x >> 5), lds); }
  }
}

DI void merge_phase(const Params& p, int l) {
  const bf16_t* Z = (const bf16_t*)(p.ws + W_Z); const bf16_t* H = (const bf16_t*)(p.ws + W_H); bf16_t* Y = (bf16_t*)(p.ws + W_AB);
  const int tidq = otid(); const int lane = tidq & 63, gw = blockIdx.x * 8 + (tidq >> 6), ngw = gridDim.x * 8;
  const int col = lane * 16;
  float mg[16];
  { const float* mhg = p.in[15] + (size_t)l * D + col;
#pragma unroll
    for (int i = 0; i < 4; ++i) { const f32x4 g = *(const f32x4*)(mhg + 4 * i); mg[4 * i] = g[0]; mg[4 * i + 1] = g[1]; mg[4 * i + 2] = g[2]; mg[4 * i + 3] = g[3]; } }
  for (int row0 = gw; row0 < M; row0 += 2 * ngw) {
    const int row1 = row0 + ngw; const bool has1 = row1 < M;
    u32x4 in[2][10];
#pragma unroll
    for (int q = 0; q < 2; ++q) {
      const size_t row = (size_t)(q == 0 ? row0 : (has1 ? row1 : row0));
      const bf16_t* z = Z + row * NIN + col; const bf16_t* hp = H + row * D + col;
      in[q][0] = *(const u32x4*)hp; in[q][1] = *(const u32x4*)(hp + 8);
#pragma unroll
      for (int hh = 0; hh < 2; ++hh) {
        in[q][2 + hh * 4] = *(const u32x4*)(z + 3072 + hh * 8); in[q][3 + hh * 4] = *(const u32x4*)(z + 6144 + hh * 8);
        in[q][4 + hh * 4] = *(const u32x4*)(z + 7168 + hh * 8); in[q][5 + hh * 4] = *(const u32x4*)(z + 8192 + hh * 8);
      }
    }
#pragma unroll
    for (int q = 0; q < 2; ++q) {
      if (q == 1 && !has1) break;
      const size_t row = (size_t)(q == 0 ? row0 : row1);
      float hv[16];
      unpack8(in[q][0], hv); unpack8(in[q][1], hv + 8);
      float s = 0.f;
#pragma unroll
      for (int e = 0; e < 16; ++e) s += hv[e];
#pragma unroll
      for (int o = 1; o < 16; o <<= 1) s += __shfl_xor(s, o);
      const float mean = s * (1.f / 256.f);
      float s2 = 0.f;
#pragma unroll
      for (int e = 0; e < 16; ++e) { hv[e] -= mean; s2 += hv[e] * hv[e]; }
#pragma unroll
      for (int o = 1; o < 16; o <<= 1) s2 += __shfl_xor(s2, o);
      const float rstd = rsqrtf(s2 * (1.f / 256.f) + LN_EPS);
      u32x4 out[2];
#pragma unroll
      for (int hh = 0; hh < 2; ++hh) {
        float oa[8], om[8], ga[8], gb[8];
        unpack8(in[q][2 + hh * 4], oa); unpack8(in[q][3 + hh * 4], om); unpack8(in[q][4 + hh * 4], ga); unpack8(in[q][5 + hh * 4], gb);
        float y[8];
#pragma unroll
        for (int e = 0; e < 8; ++e) {
          const float hn = hv[hh * 8 + e] * rstd * mg[hh * 8 + e];
          y[e] = sigmoidf_(ga[e]) * oa[e] + sigmoidf_(gb[e]) * (hn * sigmoidf_(om[e]));
        }
        out[hh][0] = pk2(y[0], y[1]); out[hh][1] = pk2(y[2], y[3]); out[hh][2] = pk2(y[4], y[5]); out[hh][3] = pk2(y[6], y[7]);
      }
      *(u32x4*)(Y + row * D + col) = out[0]; *(u32x4*)(Y + row * D + col + 8) = out[1];
    }
  }
}

DI void ln_phase(const Params& p, const float* g, const float* bta, bool final_out) {
  const int tidq = otid(); const int lane = tidq & 63, gw = blockIdx.x * 8 + (tidq >> 6), ngw = gridDim.x * 8;
  float* R = (float*)(p.ws + W_R); bf16_t* AB = (bf16_t*)(p.ws + W_AB);
  f32x4 gq[4], bq[4];
#pragma unroll
  for (int j = 0; j < 4; ++j) { gq[j] = *(const f32x4*)(g + j * 256 + lane * 4); bq[j] = *(const f32x4*)(bta + j * 256 + lane * 4); }
  for (int row0 = gw; row0 < M; row0 += 2 * ngw) {
    f32x4 v[2][4]; float s[2] = {0.f, 0.f};
    const int row1 = row0 + ngw; const bool has1 = row1 < M;
#pragma unroll
    for (int q = 0; q < 2; ++q) {
      const float* xr = R + (size_t)(q == 0 ? row0 : (has1 ? row1 : row0)) * D;
#pragma unroll
      for (int j = 0; j < 4; ++j) { v[q][j] = *(const f32x4*)(xr + j * 256 + lane * 4); s[q] += (v[q][j][0] + v[q][j][1]) + (v[q][j][2] + v[q][j][3]); }
    }
#pragma unroll
    for (int q = 0; q < 2; ++q) {
      if (q == 1 && !has1) break;
      const int row = q == 0 ? row0 : row1;
      const float mean = wave_sum(s[q]) * (1.f / D);
      float s2 = 0.f;
#pragma unroll
      for (int j = 0; j < 4; ++j) { v[q][j] = v[q][j] - mean; s2 += (v[q][j][0] * v[q][j][0] + v[q][j][1] * v[q][j][1]) + (v[q][j][2] * v[q][j][2] + v[q][j][3] * v[q][j][3]); }
      const float rstd = rsqrtf(wave_sum(s2) * (1.f / D) + LN_EPS);
      float* dst = final_out ? (row < MP ? p.out + O_YP + (size_t)row * D : p.out + O_YS + (size_t)(row - MP) * D) : R + (size_t)row * D;
#pragma unroll
      for (int j = 0; j < 4; ++j) {
        const int c = j * 256 + lane * 4;
        const f32x4 o = v[q][j] * rstd * gq[j] + bq[j];
        *(f32x4*)(dst + c) = o;
        if (!final_out) { u32x2 ob; ob[0] = pk2(o[0], o[1]); ob[1] = pk2(o[2], o[3]); *(u32x2*)(AB + (size_t)row * D + c) = ob; }
      }
    }
  }
}

DI float gelu_f(float v) {
  const float av = fabsf(v), d = av * 0.2316418882f + 1.0f;
  const float t = __builtin_amdgcn_rcpf(d);
  float q = t * 0.5307027145f + (-0.7265760135f); q = q * t + 0.7107068705f; q = q * t + (-0.142248368f); q = q * t + 0.127414796f; q = q * t;
  const float e = __builtin_amdgcn_exp2f((v * v) * (-0.72134752044f));
  const float m = v * (q * e), r = v - m;
  return v < 0.f ? m : r;
}
DI void ffnconv_phase(const Params& p, int l) {
  const bf16_t* U = (const bf16_t*)(p.ws + W_Z); bf16_t* HF = (bf16_t*)(p.ws + W_Z + (size_t)M * NUP * 2);
  const float* cw = p.in[20] + (size_t)l * 3 * NUP; const float* cb = p.in[21] + (size_t)l * NUP;
  constexpr int RG = 8;
  const unsigned gtid = blockIdx.x * NTH + (unsigned)otid();
  const unsigned nlan = gridDim.x * NTH / 352u;
  const unsigned r0 = gtid / 352u, cc = gtid - r0 * 352u;
  if (r0 >= nlan) return;
  const int col = (int)cc * 8;
  f32x4 wv[2][3][2], bv[2][2];
#pragma unroll
  for (int hf = 0; hf < 2; ++hf) {
    const int c2 = col + hf * DFF;
#pragma unroll
    for (int j = 0; j < 3; ++j) { wv[hf][j][0] = *(const f32x4*)(cw + j * NUP + c2); wv[hf][j][1] = *(const f32x4*)(cw + j * NUP + c2 + 4); }
    bv[hf][0] = *(const f32x4*)(cb + c2); bv[hf][1] = *(const f32x4*)(cb + c2 + 4);
  }
  for (unsigned rg = r0; rg < (unsigned)(M / RG); rg += nlan) {
    const int row0 = (int)rg * RG;
    int t0; const float* st = nullptr;
    if (row0 < MP) t0 = row0 & (SEQ - 1); else { t0 = (row0 - MP) & 15; st = p.in[8] + ((size_t)(l * 8 + ((row0 - MP) >> 4)) * 2) * NUP; }
    float gl[RG][8];
#pragma unroll
    for (int hf = 0; hf < 2; ++hf) {
      const int c2 = col + hf * DFF;
      float x[RG + 2][8];
#pragma unroll
      for (int j = 0; j < RG + 2; ++j) {
        const int t = t0 - 2 + j;
        if (t >= 0) unpack8(*(const u32x4*)(U + (size_t)(row0 - 2 + j) * NUP + c2), x[j]);
        else if (st) { const float* sp = st + (size_t)(2 + t) * NUP + c2; const f32x4 a = *(const f32x4*)sp, b2 = *(const f32x4*)(sp + 4);
          x[j][0] = a[0]; x[j][1] = a[1]; x[j][2] = a[2]; x[j][3] = a[3]; x[j][4] = b2[0]; x[j][5] = b2[1]; x[j][6] = b2[2]; x[j][7] = b2[3]; }
        else {
#pragma unroll
          for (int e = 0; e < 8; ++e) x[j][e] = 0.f; }
      }
#pragma unroll
      for (int a = 0; a < RG; ++a) {
        float o[8];
#pragma unroll
        for (int e = 0; e < 8; ++e) {
          const float u = bv[hf][e >> 2][e & 3] + wv[hf][0][e >> 2][e & 3] * x[a][e] + wv[hf][1][e >> 2][e & 3] * x[a + 1][e] + wv[hf][2][e >> 2][e & 3] * x[a + 2][e];
          if (hf == 0) gl[a][e] = gelu_f(u); else o[e] = gl[a][e] * u;
        }
        if (hf == 1) {
          u32x4 ov; ov[0] = pk2(o[0], o[1]); ov[1] = pk2(o[2], o[3]); ov[2] = pk2(o[4], o[5]); ov[3] = pk2(o[6], o[7]);
          *(u32x4*)(HF + (size_t)(row0 + a) * DFF + col) = ov;
        }
      }
    }
  }
}

#define XB_TMO      128
#define XB_XCNT(j)  (256  + 64 * (j))
#define XB_XSUB(j)  (1280 + 64 * (j))
#define XB_XGEN(j)  (2304 + 64 * (j))
#define XB_TOP      3328
#define XB_TOPGEN   3392
#define XCD_BAR_WORDS 3456
#define XB_SPIN_CAP (1u << 18)
#define XLAS __attribute__((address_space(3)))
DI unsigned xb_ld(unsigned* p)              { return __hip_atomic_load(p, __ATOMIC_RELAXED, __HIP_MEMORY_SCOPE_AGENT); }
DI unsigned xb_add(unsigned* p, unsigned v) { return __hip_atomic_fetch_add(p, v, __ATOMIC_RELAXED, __HIP_MEMORY_SCOPE_AGENT); }
DI unsigned xb_xcc_id() { return (unsigned)__builtin_amdgcn_s_getreg((3 << 11) | 20) & 0xFu; }
#define XB_SPIN(cond, bar) do { unsigned _sp = 0; while (cond) { __builtin_amdgcn_s_sleep(1); \
    if ((++_sp & 255u) == 0u) { if (xb_ld(&(bar)[XB_TMO])) break; if (_sp > XB_SPIN_CAP) { atomicAdd(&(bar)[XB_TMO], 1u); break; } } } } while (0)
struct XcdBarrier { unsigned* bar; unsigned x; volatile XLAS unsigned* st; };
DI XcdBarrier xcd_barrier_post(unsigned* bar, volatile XLAS unsigned* st) {
  XcdBarrier b; b.bar = bar; b.x = xb_xcc_id(); b.st = st;
  if (threadIdx.x == 0) (void)xb_add(&bar[XB_XCNT(b.x)], 1u);
  return b;
}
DI void xcd_barrier_complete(unsigned* bar, unsigned x, unsigned& nloc, unsigned& nx) {
  const unsigned G = gridDim.x * gridDim.y * gridDim.z;
  unsigned sum, cnt, mine, sp = 0u;
  for (;;) {
    sum = 0u; cnt = 0u; mine = 0u;
#pragma unroll
    for (unsigned j = 0; j < 16; ++j) { const unsigned c = xb_ld(&bar[XB_XCNT(j)]); sum += c; cnt += (c > 0u) ? 1u : 0u; mine = (j == x) ? c : mine; }
    if (sum == G) break;
    __builtin_amdgcn_s_sleep(1);
    if ((++sp & 255u) == 0u) { if (xb_ld(&bar[XB_TMO])) break; if (sp > XB_SPIN_CAP) { atomicAdd(&bar[XB_TMO], 1u); break; } }
  }
  nloc = mine > 0u ? mine : 1u; nx = cnt > 0u ? cnt : 1u;
}
DI void xcd_barrier(const XcdBarrier& b) {
  asm volatile("s_waitcnt vmcnt(0)" ::: "memory");
  __syncthreads();
  if (threadIdx.x == 0) {
    unsigned* bar = b.bar;
    __builtin_amdgcn_s_waitcnt(0);
    unsigned nloc = b.st[0], nx = b.st[1];
    if (nloc == 0u) { xcd_barrier_complete(bar, b.x, nloc, nx); b.st[0] = nloc; b.st[1] = nx; }
    const unsigned old = xb_add(&bar[XB_XSUB(b.x)], 1u);
    const unsigned gen = old / nloc;
    if (old + 1u == (gen + 1u) * nloc) {
      __builtin_amdgcn_fence(__ATOMIC_RELEASE, "agent");
      asm volatile("s_waitcnt vmcnt(0)" ::: "memory");
      const unsigned og = xb_add(&bar[XB_TOP], 1u);
      const unsigned tg = og / nx;
      if (og + 1u == (tg + 1u) * nx) xb_add(&bar[XB_TOPGEN], 1u);
      else XB_SPIN(xb_ld(&bar[XB_TOPGEN]) == tg, bar);
      __builtin_amdgcn_fence(__ATOMIC_ACQUIRE, "agent");
      xb_add(&bar[XB_XGEN(b.x)], 1u);
      asm volatile("s_waitcnt vmcnt(0)" ::: "memory");
    } else {
      XB_SPIN(xb_ld(&bar[XB_XGEN(b.x)]) == gen, bar);
      __builtin_amdgcn_fence(__ATOMIC_ACQUIRE, "agent");
      asm volatile("s_waitcnt vmcnt(0)" ::: "memory");
    }
  }
  __syncthreads();
}

constexpr int NPH = 21;
DI void run_phase(const Params& p, int ph, char* lds) {
#ifndef ONLY
  if (ph == 0) { phase0(p, lds); return; }
#else
  if (ph == 0) return;
#endif
  const int l = (ph - 1) / 10, s = (ph - 1) % 10;
#ifdef ONLY
  if (s != ONLY) return;
#endif
  switch (s) {
    case 0: gemm_phase<EPI_IN>(p, l, (const bf16_t*)(p.ws + W_AB), D, (const bf16_t*)(p.ws + W_WIN) + (size_t)l * NIN * D, D, NIN / 256, lds); break;
    case 1: qkconv_phase(p, l); gif_phase(p, l, lds, 0); break;
    case 2: mixer_phase(p, l, lds, l, false); break;
    case 3: merge_phase(p, l); break;
    case 4: gemm_phase<EPI_OUT>(p, l, (const bf16_t*)(p.ws + W_AB), D, (const bf16_t*)(p.ws + W_WOUT) + (size_t)l * D * D, D, D / 256, lds); break;
    case 5: ln_phase(p, p.in[17] + l * D, p.in[18] + l * D, false); break;
    case 6: gemm_phase<EPI_UP>(p, l, (const bf16_t*)(p.ws + W_AB), D, (const bf16_t*)(p.ws + W_WUP) + (size_t)l * NUP * D, D, NUP / 256, lds); break;
    case 7: ffnconv_phase(p, l); break;
    case 8: gemm_phase<EPI_DOWN>(p, l, (const bf16_t*)(p.ws + W_Z + (size_t)M * NUP * 2), DFF, (const bf16_t*)(p.ws + W_WDN) + (size_t)l * D * DFF, DFF, D / 256, lds); break;
    case 9: ln_phase(p, p.in[23] + l * D, p.in[24] + l * D, l == 1); break;
  }
}

__global__ void __launch_bounds__(NTH) mega(Params p, int ph_lo, int ph_hi) {
  extern __shared__ __attribute__((aligned(16))) char lds[];
#if MULTI_LAUNCH
  for (int ph = ph_lo; ph < ph_hi; ++ph) run_phase(p, ph, lds);
#else
  cg::grid_group grid = cg::this_grid();
  phase0(p, lds);
  grid.sync();
  volatile XLAS unsigned* xst = (volatile XLAS unsigned*)((XLAS char*)lds + (LDS_BYTES - 32));
  if (threadIdx.x == 0) { xst[0] = 0u; xst[1] = 0u; }
  __syncthreads();
  const XcdBarrier xb = xcd_barrier_post((unsigned*)(p.ws + W_BAR), xst);
#define GSYNC() xcd_barrier(xb)
  for (int l = 0; l < 2; ++l) {
    gemm_phase<EPI_IN>(p, l, (const bf16_t*)(p.ws + W_AB), D, (const bf16_t*)(p.ws + W_WIN) + (size_t)l * NIN * D, D, NIN / 256, lds);
    {
      const int nun = NTM * (NIN / 256), G = (int)gridDim.x;
      const int busy = nun % G;
      gif_phase(p, l, lds, (busy > 0 && busy * 2 < G) ? busy : 0);
    }
    GSYNC();
#ifdef PROBE_GIN2
    gemm_phase<EPI_IN>(p, l, (const bf16_t*)(p.ws + W_AB), D, (const bf16_t*)(p.ws + W_WIN) + (size_t)l * NIN * D, D, NIN / 256, lds);
    GSYNC();
#endif
    qkconv_phase(p, l);
    GSYNC();
#if defined(PROBE_EW2) || defined(PROBE_QKC2)
    qkconv_phase(p, l);
    GSYNC();
#endif
    mixer_phase(p, l, lds, l, false);
    GSYNC();
#ifdef PROBE_ML2
    mixer_phase(p, l, lds, l + 2, true);
    GSYNC();
#endif
#ifdef PROBE_MIX2
    mixer_phase(p, l, lds, l + 2, false);
    GSYNC();
#endif
    merge_phase(p, l);
    GSYNC();
#ifdef PROBE_SYNC
    for (int q = 0; q < 20; ++q) GSYNC();
#endif
#if defined(PROBE_EW2) || defined(PROBE_MRG2)
    merge_phase(p, l);
    GSYNC();
#endif
    gemm_phase<EPI_OUT>(p, l, (const bf16_t*)(p.ws + W_AB), D, (const bf16_t*)(p.ws + W_WOUT) + (size_t)l * D * D, D, D / 256, lds);
    GSYNC();
    ln_phase(p, p.in[17] + l * D, p.in[18] + l * D, false);
    GSYNC();
    gemm_phase<EPI_UP>(p, l, (const bf16_t*)(p.ws + W_AB), D, (const bf16_t*)(p.ws + W_WUP) + (size_t)l * NUP * D, D, NUP / 256, lds);
    GSYNC();
    ffnconv_phase(p, l);
    GSYNC();
#if defined(PROBE_EW2) || defined(PROBE_FFC2)
    ffnconv_phase(p, l);
    GSYNC();
#endif
    gemm_phase<EPI_DOWN>(p, l, (const bf16_t*)(p.ws + W_Z + (size_t)M * NUP * 2), DFF, (const bf16_t*)(p.ws + W_WDN) + (size_t)l * D * DFF, DFF, D / 256, lds);
    GSYNC();
    ln_phase(p, p.in[23] + l * D, p.in[24] + l * D, l == 1);
    if (l == 0) GSYNC();
  }
#endif
}

extern "C" void kernel_launch(void* const* d_in, const int* in_sizes, int n_in, void* d_out, int out_size, void* d_ws, size_t ws_size, hipStream_t stream) {
  static int grid = 0;
  if (grid == 0) {
    if (n_in != 25 || (size_t)out_size != O_END || ws_size < W_END) { fprintf(stderr, "kernel_launch: unexpected sizes n_in %d out %d (want %zu) ws %zu (want %zu)\n", n_in, out_size, (size_t)O_END, ws_size, (size_t)W_END); grid = -1; return; }
    int dev = 0, cus = 0, per_cu = 0;
    hipGetDevice(&dev);
    hipDeviceGetAttribute(&cus, hipDeviceAttributeMultiprocessorCount, dev);
    if (hipFuncSetAttribute((const void*)mega, hipFuncAttributeMaxDynamicSharedMemorySize, LDS_BYTES) != hipSuccess) { fprintf(stderr, "hipFuncSetAttribute failed\n"); grid = -1; return; }
    hipOccupancyMaxActiveBlocksPerMultiprocessor(&per_cu, (const void*)mega, NTH, LDS_BYTES);
    if (per_cu < 1) per_cu = 1;
    grid = cus * 1;
    (void)hipGetLastError();
  }
  if (grid < 0) return;
  Params p{};
  for (int i = 0; i < 25; ++i) p.in[i] = (const float*)d_in[i];
  p.out = (float*)d_out; p.ws = (unsigned char*)d_ws;
#if MULTI_LAUNCH
  for (int ph = 0; ph < NPH; ++ph) hipLaunchKernelGGL(mega, dim3(grid), dim3(NTH), LDS_BYTES, stream, p, ph, ph + 1);
#else
  int lo = 0, hi = NPH;
  void* args[] = {&p, &lo, &hi};
  hipError_t e = hipLaunchCooperativeKernel((const void*)mega, dim3(grid), dim3(NTH), args, LDS_BYTES, stream);
  if (e != hipSuccess) fprintf(stderr, "cooperative launch failed: %s (grid %d)\n", hipGetErrorString(e), grid);
#endif
}
```
